# Optimizing an MI355X kernel written in HIP

```python
import math
import jax, jax.numpy as jnp
from jax import lax
import numpy as np

D_MODEL = 1024
BATCH = 4
SEQ = 4096
DEPTH = 1

SB_HEADS = 8
SB_HEAD_DIM = 64
SB_WIDTH = SB_HEADS * SB_HEAD_DIM
MLA_HEADS = 8
MLA_NOPE_DIM = 64
MLA_ROPE_DIM = 32
MLA_V_DIM = 64
MLA_Q_RANK = 384
MLA_KV_RANK = 256
MLA_WIDTH = MLA_HEADS * MLA_V_DIM
MLA_QK_DIM = MLA_NOPE_DIM + MLA_ROPE_DIM

Q_BLOCK = 128
ROPE_BASE = 10000.0
EPS = 1e-6

SPLITS = (SB_WIDTH, SB_WIDTH, SB_WIDTH, SB_WIDTH,
          MLA_Q_RANK, MLA_KV_RANK, MLA_ROPE_DIM, MLA_WIDTH,
          D_MODEL, D_MODEL)
IN_WIDTH = int(sum(SPLITS))
SPLIT_POINTS = tuple(int(v) for v in np.cumsum(SPLITS)[:-1])

kernel_name = "hybrid_stickbreaking_mla_adaln_block"


def rmsnorm(x, g):
    xf = x.astype(jnp.float32)
    y = xf * lax.rsqrt(jnp.mean(xf * xf, axis=-1, keepdims=True) + EPS)
    return (y * g.astype(jnp.float32)).astype(x.dtype)


def rope(x, positions):
    r = x.shape[-1]
    inv_freq = ROPE_BASE ** (-jnp.arange(0, r, 2, dtype=jnp.float32) / r)
    ang = positions.astype(jnp.float32)[:, :, None, None] * inv_freq
    cos, sin = jnp.cos(ang), jnp.sin(ang)
    xf = x.astype(jnp.float32)
    x1, x2 = xf[..., : r // 2], xf[..., r // 2:]
    return jnp.concatenate([x1 * cos - x2 * sin, x1 * sin + x2 * cos], axis=-1)


def to_blocks(t):
    b, h, s, d = t.shape
    return t.reshape(b, h, s // Q_BLOCK, Q_BLOCK, d).transpose(2, 0, 1, 3, 4)


def from_blocks(t):
    n, b, h, q, d = t.shape
    return t.transpose(1, 2, 0, 3, 4).reshape(b, h, n * q, d)


def stick_breaking_attention(q, k, v):
    s_len = k.shape[2]
    scale = 1.0 / math.sqrt(q.shape[-1])
    key_idx = jnp.arange(s_len)

    def block(args):
        qb, i = args
        z = jnp.einsum('bhqd,bhkd->bhqk', qb, k) * scale
        q_idx = i * Q_BLOCK + jnp.arange(Q_BLOCK)
        strict = key_idx[None, :] < q_idx[:, None]
        log_one_minus = jnp.where(strict, jax.nn.log_sigmoid(-z), 0.0)
        suffix = lax.cumsum(log_one_minus, axis=3, reverse=True) - log_one_minus
        w = jnp.where(strict, jnp.exp(jax.nn.log_sigmoid(z) + suffix), 0.0)
        return jnp.einsum('bhqk,bhkd->bhqd', w, v)

    n_blk = s_len // Q_BLOCK
    out = lax.map(block, (to_blocks(q), jnp.arange(n_blk)))
    return from_blocks(out)


def latent_attention(q_nope, q_pe, k_nope, k_pe, v):
    s_len = k_nope.shape[2]
    scale = 1.0 / math.sqrt(MLA_QK_DIM)
    key_idx = jnp.arange(s_len)

    def block(args):
        qn, qp, i = args
        sc = (jnp.einsum('bhqd,bhkd->bhqk', qn, k_nope)
              + jnp.einsum('bhqr,bkr->bhqk', qp, k_pe)) * scale
        q_idx = i * Q_BLOCK + jnp.arange(Q_BLOCK)
        causal = key_idx[None, :] <= q_idx[:, None]
        p = jax.nn.softmax(jnp.where(causal, sc, -jnp.inf), axis=-1)
        return jnp.einsum('bhqk,bhkd->bhqd', p, v)

    n_blk = s_len // Q_BLOCK
    out = lax.map(block, (to_blocks(q_nope), to_blocks(q_pe), jnp.arange(n_blk)))
    return from_blocks(out)


def split_heads(t, h):
    b, s, w = t.shape
    return t.reshape(b, s, h, w // h).transpose(0, 2, 1, 3)


def merge_heads(t):
    b, h, s, d = t.shape
    return t.transpose(0, 2, 1, 3).reshape(b, s, h * d)


def setup_inputs(seed: int = 0) -> dict:
    key = jax.random.key(seed)
    ks = jax.random.split(key, 16)
    f32 = jnp.float32

    def nrm(k, shape, fan_in, mult=1.0):
        return jax.random.normal(k, shape, f32) * (mult * fan_in ** -0.5)

    x = jax.random.normal(ks[0], (BATCH, SEQ, D_MODEL), f32)
    c = jax.random.normal(ks[1], (BATCH, D_MODEL), f32)
    positions = jnp.broadcast_to(jnp.arange(SEQ, dtype=jnp.int32), (BATCH, SEQ))
    w_ada = nrm(ks[2], (DEPTH, D_MODEL, 3 * D_MODEL), D_MODEL, 0.2)
    b_ada = jax.random.normal(ks[3], (DEPTH, 3 * D_MODEL), f32) * 0.02
    norm_gain = 1.0 + 0.02 * jax.random.normal(ks[4], (DEPTH, D_MODEL), f32)
    w_in = nrm(ks[5], (DEPTH, D_MODEL, IN_WIDTH), D_MODEL)
    q_norm_gain = 1.0 + 0.02 * jax.random.normal(ks[6], (DEPTH, MLA_Q_RANK), f32)
    w_uq = nrm(ks[7], (DEPTH, MLA_Q_RANK, MLA_HEADS * MLA_QK_DIM), MLA_Q_RANK)
    kv_norm_gain = 1.0 + 0.02 * jax.random.normal(ks[8], (DEPTH, MLA_KV_RANK), f32)
    w_ukv = nrm(ks[9], (DEPTH, MLA_KV_RANK, MLA_HEADS * (MLA_NOPE_DIM + MLA_V_DIM)), MLA_KV_RANK)
    w_branch_a = nrm(ks[10], (DEPTH, SB_WIDTH, D_MODEL), SB_WIDTH)
    w_branch_b = nrm(ks[11], (DEPTH, MLA_WIDTH, D_MODEL), MLA_WIDTH)
    w_out = nrm(ks[12], (DEPTH, D_MODEL, D_MODEL), D_MODEL)
    final_norm_gain = 1.0 + 0.02 * jax.random.normal(ks[13], (D_MODEL,), f32)
    return {"x": x, "c": c, "positions": positions, "w_ada": w_ada, "b_ada": b_ada,
            "norm_gain": norm_gain, "w_in": w_in, "q_norm_gain": q_norm_gain, "w_uq": w_uq,
            "kv_norm_gain": kv_norm_gain, "w_ukv": w_ukv, "w_branch_a": w_branch_a,
            "w_branch_b": w_branch_b, "w_out": w_out, "final_norm_gain": final_norm_gain}


def reference(x, c, positions, w_ada, b_ada, norm_gain, w_in, q_norm_gain, w_uq,
              kv_norm_gain, w_ukv, w_branch_a, w_branch_b, w_out, final_norm_gain):
    b, s, _ = x.shape
    f32 = jnp.float32
    for l in range(DEPTH):
        mod = c @ w_ada[l] + b_ada[l]
        shift, scale, gate = jnp.split(mod, 3, axis=-1)
        h = rmsnorm(x, norm_gain[l]) * (1.0 + scale[:, None, :]) + shift[:, None, :]

        proj = h @ w_in[l]
        (sb_q, sb_k, sb_v, sb_z, c_q, c_kv, k_rot, mla_z, g_a, g_b) = jnp.split(proj, SPLIT_POINTS, axis=-1)

        o_a = stick_breaking_attention(split_heads(sb_q, SB_HEADS).astype(f32),
                                       split_heads(sb_k, SB_HEADS).astype(f32),
                                       split_heads(sb_v, SB_HEADS).astype(f32))
        o_a = merge_heads(o_a).astype(x.dtype)
        y_a = (o_a * jax.nn.silu(sb_z)) @ w_branch_a[l]

        q = (rmsnorm(c_q, q_norm_gain[l]) @ w_uq[l]).reshape(b, s, MLA_HEADS, MLA_QK_DIM)
        q_nope = q[..., :MLA_NOPE_DIM].astype(f32)
        q_pe = rope(q[..., MLA_NOPE_DIM:], positions)
        kv = (rmsnorm(c_kv, kv_norm_gain[l]) @ w_ukv[l]).reshape(b, s, MLA_HEADS, MLA_NOPE_DIM + MLA_V_DIM)
        k_nope = kv[..., :MLA_NOPE_DIM].astype(f32)
        v_b = kv[..., MLA_NOPE_DIM:].astype(f32)
        k_pe = rope(k_rot[:, :, None, :], positions)[:, :, 0, :]
        o_b = latent_attention(q_nope.transpose(0, 2, 1, 3), q_pe.transpose(0, 2, 1, 3),
                               k_nope.transpose(0, 2, 1, 3), k_pe, v_b.transpose(0, 2, 1, 3))
        o_b = merge_heads(o_b).astype(x.dtype)
        y_b = (o_b * jax.nn.silu(mla_z)) @ w_branch_b[l]

        merged = jax.nn.sigmoid(g_a) * y_a + jax.nn.sigmoid(g_b) * y_b
        x = x + gate[:, None, :] * (merged @ w_out[l])
    return rmsnorm(x, final_norm_gain)
```

```cpp
#include <hip/hip_runtime.h>
#include <hip/hip_cooperative_groups.h>
#include <stdint.h>
#include <stdio.h>
namespace cg = cooperative_groups;

#define DI __device__ __forceinline__
typedef unsigned short bf16_t;
typedef __attribute__((ext_vector_type(8))) short bf16x8;
typedef __attribute__((ext_vector_type(4))) short s16x4;
typedef __attribute__((ext_vector_type(16))) float f32x16;
typedef __attribute__((ext_vector_type(2))) float f32x2;
typedef __attribute__((ext_vector_type(2))) __bf16 bf16x2v;
typedef __attribute__((ext_vector_type(4))) unsigned u32x4;
typedef __attribute__((ext_vector_type(2))) unsigned u32x2;
#define MFMA(a, b, c) __builtin_amdgcn_mfma_f32_32x32x16_bf16((a), (b), (c), 0, 0, 0)

constexpr int NTOK = 16384, SEQL = 4096, DM = 1024;
constexpr int INW = 5280, INWP = 5376;
constexpr int NTHREADS = 256;
constexpr float LOG2E = 1.4426950408889634f;
constexpr float QS_SCALE = 0.125f * 1.4426950408889634f;
constexpr float QM_SCALE = 1.4426950408889634f / 9.797958971132712f;
constexpr float EPSN = 1e-6f;

struct Params {
  const float *x, *c; const int* pos;
  const float *w_ada, *b_ada, *norm_gain, *w_in, *q_gain, *w_uq, *kv_gain, *w_ukv, *w_a, *w_b, *w_out, *fgain;
  float* out;
  bf16_t *Hb, *WinT, *WuqT, *WukvT, *WaT, *WbT, *WoT;
  float *MOD, *ROPE;
  bf16_t *Qsb, *Ksb, *VTsb, *Zsb, *CQ, *CKV, *Zmla, *GA, *GB, *KPE, *Qmla, *Knope, *VTmla, *OAg, *OBg, *MERGED;
  int* counter;
};

__device__ const float c_invfreq[16] = {
  1.0f, 0.5623413251903491f, 0.31622776601683794f, 0.1778279410038923f, 0.1f, 0.05623413251903491f, 0.03162277660168379f,
  0.01778279410038923f, 0.01f, 0.005623413251903491f, 0.0031622776601683794f, 0.001778279410038923f, 0.001f,
  0.0005623413251903491f, 0.00031622776601683794f, 0.0001778279410038923f};

DI unsigned pk2(float a, float b) { f32x2 v = {a, b}; bf16x2v r = __builtin_convertvector(v, bf16x2v); return __builtin_bit_cast(unsigned, r); }
DI bf16_t tobf(float a) { return (bf16_t)(pk2(a, 0.f) & 0xffffu); }
DI float bf2f(unsigned short u) { return __uint_as_float(((unsigned)u) << 16); }
DI bf16x8 pack8(float a0, float a1, float a2, float a3, float a4, float a5, float a6, float a7) {
  u32x4 p; p[0] = pk2(a0, a1); p[1] = pk2(a2, a3); p[2] = pk2(a4, a5); p[3] = pk2(a6, a7);
  return __builtin_bit_cast(bf16x8, p);
}
DI int crow(int reg, int h) { return (reg & 3) + 8 * (reg >> 2) + 4 * h; }
DI float half_max(float v) {
  unsigned u = __float_as_uint(v);
  auto r = __builtin_amdgcn_permlane32_swap(u, u, false, false);
  return fmaxf(__uint_as_float(r[0]), __uint_as_float(r[1]));
}
DI float half_sum(float v) {
  unsigned u = __float_as_uint(v);
  auto r = __builtin_amdgcn_permlane32_swap(u, u, false, false);
  return __uint_as_float(r[0]) + __uint_as_float(r[1]);
}
DI float sigmoidf_fast(float v) { return __builtin_amdgcn_rcpf(1.f + __builtin_amdgcn_exp2f(-v * LOG2E)); }
DI float siluf_fast(float v) { return v * sigmoidf_fast(v); }

constexpr int GSTR = 72;
constexpr int GBUF = 128 * GSTR;
constexpr int SMEM_BYTES = 4 * GBUF * 2 + 1024;

template <bool ROWSS>
DI void gemm_mainloop(const bf16_t* __restrict__ A, int lda, const bf16_t* __restrict__ B, int ldb, int K,
                      bf16_t* sA, bf16_t* sB, f32x16 (&acc)[2][2], float* rs) {
  const int tid = threadIdx.x, lane = tid & 63, w = tid >> 6;
  const int wm = w >> 1, wn = w & 1, r = lane & 31, hh = lane >> 5;
  const int lrow = tid >> 3, lch = tid & 7;
  const bf16_t* pa = A + (size_t)lrow * lda + lch * 8;
  const bf16_t* pb = B + (size_t)lrow * ldb + lch * 8;
  uint4 ra[4], rb[4];
  float ss[4] = {0.f, 0.f, 0.f, 0.f};
#pragma unroll
  for (int i = 0; i < 4; ++i) {
    ra[i] = *(const uint4*)(pa + (size_t)(32 * i) * lda);
    rb[i] = *(const uint4*)(pb + (size_t)(32 * i) * ldb);
  }
  const int nk = K >> 6;
  const int woff = lrow * GSTR + lch * 8;
#pragma unroll
  for (int i = 0; i < 4; ++i) {
    *(uint4*)(sA + woff + 32 * i * GSTR) = ra[i];
    *(uint4*)(sB + woff + 32 * i * GSTR) = rb[i];
  }
  if (ROWSS) {
#pragma unroll
    for (int i = 0; i < 4; ++i) {
      unsigned u[4] = {ra[i].x, ra[i].y, ra[i].z, ra[i].w};
#pragma unroll
      for (int j = 0; j < 4; ++j) { float lo = __uint_as_float(u[j] << 16), hi = __uint_as_float(u[j] & 0xffff0000u); ss[i] += lo * lo + hi * hi; }
    }
  }
  __syncthreads();
  for (int ks = 0; ks < nk; ++ks) {
    const int cur = ks & 1;
    const bool more = (ks + 1 < nk);
    if (more) {
      const int ko = (ks + 1) * 64;
#pragma unroll
      for (int i = 0; i < 4; ++i) {
        ra[i] = *(const uint4*)(pa + (size_t)(32 * i) * lda + ko);
        rb[i] = *(const uint4*)(pb + (size_t)(32 * i) * ldb + ko);
      }
    }
    const bf16_t* cA = sA + cur * GBUF + (wm * 64 + r) * GSTR + hh * 8;
    const bf16_t* cB = sB + cur * GBUF + (wn * 64 + r) * GSTR + hh * 8;
#pragma unroll
    for (int kk = 0; kk < 4; ++kk) {
      bf16x8 a0 = *(const bf16x8*)(cA + kk * 16);
      bf16x8 a1 = *(const bf16x8*)(cA + 32 * GSTR + kk * 16);
      bf16x8 b0 = *(const bf16x8*)(cB + kk * 16);
      bf16x8 b1 = *(const bf16x8*)(cB + 32 * GSTR + kk * 16);
      acc[0][0] = MFMA(a0, b0, acc[0][0]);
      acc[0][1] = MFMA(a0, b1, acc[0][1]);
      acc[1][0] = MFMA(a1, b0, acc[1][0]);
      acc[1][1] = MFMA(a1, b1, acc[1][1]);
    }
    if (more) {
      const int nb = (cur ^ 1) * GBUF;
#pragma unroll
      for (int i = 0; i < 4; ++i) {
        *(uint4*)(sA + nb + woff + 32 * i * GSTR) = ra[i];
        *(uint4*)(sB + nb + woff + 32 * i * GSTR) = rb[i];
      }
      if (ROWSS) {
#pragma unroll
        for (int i = 0; i < 4; ++i) {
          unsigned u[4] = {ra[i].x, ra[i].y, ra[i].z, ra[i].w};
#pragma unroll
          for (int j = 0; j < 4; ++j) { float lo = __uint_as_float(u[j] << 16), hi = __uint_as_float(u[j] & 0xffff0000u); ss[i] += lo * lo + hi * hi; }
        }
      }
    }
    __syncthreads();
  }
  if (ROWSS) {
#pragma unroll
    for (int i = 0; i < 4; ++i) {
      float v = ss[i];
      v += __shfl_xor(v, 1); v += __shfl_xor(v, 2); v += __shfl_xor(v, 4);
      if (lch == 0) rs[lrow + 32 * i] = __builtin_amdgcn_rsqf(v / (float)K + EPSN);
    }
    __syncthreads();
  }
}

DI void zero_acc(f32x16 (&acc)[2][2]) {
#pragma unroll
  for (int a = 0; a < 2; ++a)
#pragma unroll
    for (int b = 0; b < 2; ++b)
#pragma unroll
      for (int i = 0; i < 16; ++i) acc[a][b][i] = 0.f;
}

template <class F>
DI void epi_iter(f32x16 (&acc)[2][2], F f) {
  const int lane = threadIdx.x & 63, w = threadIdx.x >> 6;
  const int wm = w >> 1, wn = w & 1, r = lane & 31, hh = lane >> 5;
#pragma unroll
  for (int mt = 0; mt < 2; ++mt)
#pragma unroll
    for (int nt = 0; nt < 2; ++nt)
#pragma unroll
      for (int g = 0; g < 4; ++g)
        f(mt, nt, g, wm * 64 + mt * 32 + 8 * g + 4 * hh, wn * 64 + nt * 32 + r, acc[mt][nt][4 * g], acc[mt][nt][4 * g + 1], acc[mt][nt][4 * g + 2], acc[mt][nt][4 * g + 3]);
}

DI void store4_rows(bf16_t* base, int ld, int row, int col, float v0, float v1, float v2, float v3) {
  bf16_t* p = base + (size_t)row * ld + col;
  p[0] = tobf(v0); p[ld] = tobf(v1); p[2 * ld] = tobf(v2); p[3 * ld] = tobf(v3);
}
DI void store4_vt(bf16_t* base, int tok, int head, int d, float v0, float v1, float v2, float v3) {
  const int b = tok >> 12, s = tok & 4095;
  u32x2 pk; pk[0] = pk2(v0, v1); pk[1] = pk2(v2, v3);
  *(u32x2*)(base + ((size_t)((b * 8 + head) * 64 + d)) * SEQL + s) = pk;
}

DI void rope4(const float* ROPE, int tok, int r, float& v0, float& v1, float& v2, float& v3) {
  float v[4] = {v0, v1, v2, v3};
  const int fi = r & 15;
  const bool upper = (r & 16) != 0;
#pragma unroll
  for (int i = 0; i < 4; ++i) {
    const float o = __shfl_xor(v[i], 16);
    const float cs = ROPE[(size_t)(tok + i) * 32 + fi], sn = ROPE[(size_t)(tok + i) * 32 + 16 + fi];
    v[i] = upper ? (o * sn + v[i] * cs) : (v[i] * cs - o * sn);
  }
  v0 = v[0]; v1 = v[1]; v2 = v[2]; v3 = v[3];
}

DI void wconv_unit(const float* __restrict__ src, int Nsrc, int K, bf16_t* __restrict__ dst, const float* __restrict__ gain, int ng, int kc, int mode) {
  const int lane = threadIdx.x & 63, w = threadIdx.x >> 6;
  const int n = ng * 64 + lane;
  int sc = n;
  if (mode == 1) { sc = (n < 2688) ? n : (n < 5248 ? n + 32 : (n < 5280 ? n - 2560 : -1)); }
#pragma unroll
  for (int s = 0; s < 4; ++s) {
    const int k0 = kc * 128 + w * 32 + s * 8;
    float v[8];
#pragma unroll
    for (int j = 0; j < 8; ++j) {
      float t = 0.f;
      if (sc >= 0) { t = src[(size_t)(k0 + j) * Nsrc + sc]; if (gain) t *= gain[k0 + j]; }
      v[j] = t;
    }
    *(bf16x8*)(dst + (size_t)n * K + k0) = pack8(v[0], v[1], v[2], v[3], v[4], v[5], v[6], v[7]);
  }
}

DI void phase_prep(const Params& p, char* smem) {
  const int tid = threadIdx.x;
  if (blockIdx.x == 0 && tid == 0) { p.counter[0] = 0; }
  constexpr int U_MOD = 96, U_ROPE = 1024, U_WIN = 84 * 8, U_WUQ = 12 * 3, U_WUKV = 16 * 2, U_WA = 16 * 4, U_WB = 16 * 4, U_WO = 16 * 8;
  constexpr int U_TOTAL = U_MOD + U_ROPE + U_WIN + U_WUQ + U_WUKV + U_WA + U_WB + U_WO;
  for (int u = blockIdx.x; u < U_TOTAL; u += gridDim.x) {
    int v = u;
    if (v < U_MOD) {
      float4* sc = (float4*)smem;
      float* red = (float*)(smem + 16384);
      for (int k = tid; k < 1024; k += 256) sc[k] = make_float4(p.c[k], p.c[1024 + k], p.c[2048 + k], p.c[3072 + k]);
      __syncthreads();
      const int kg = tid >> 5, col = tid & 31, n0 = v * 32;
      float a0 = 0.f, a1 = 0.f, a2 = 0.f, a3 = 0.f;
      const float* wp = p.w_ada + (size_t)(kg * 128) * 3072 + n0 + col;
#pragma unroll 16
      for (int kk = 0; kk < 128; ++kk) {
        const float wv = wp[(size_t)kk * 3072];
        const float4 c4 = sc[kg * 128 + kk];
        a0 += wv * c4.x; a1 += wv * c4.y; a2 += wv * c4.z; a3 += wv * c4.w;
      }
      red[(kg * 4 + 0) * 32 + col] = a0; red[(kg * 4 + 1) * 32 + col] = a1; red[(kg * 4 + 2) * 32 + col] = a2; red[(kg * 4 + 3) * 32 + col] = a3;
      __syncthreads();
      if (tid < 128) {
        const int b = tid >> 5, cc = tid & 31;
        float s = 0.f;
#pragma unroll
        for (int g = 0; g < 8; ++g) s += red[(g * 4 + b) * 32 + cc];
        p.MOD[b * 3072 + n0 + cc] = s + p.b_ada[n0 + cc];
      }
      __syncthreads();
      continue;
    }
    v -= U_MOD;
    if (v < U_ROPE) {
      const int idx = v * 256 + tid, tok = idx >> 4, i = idx & 15;
      const float ang = (float)p.pos[tok] * c_invfreq[i];
      double t = (double)ang * 0.15915494309189535;
      t -= rint(t);
      const float tf = (float)t;
      p.ROPE[(size_t)tok * 32 + i] = __builtin_amdgcn_cosf(tf);
      p.ROPE[(size_t)tok * 32 + 16 + i] = __builtin_amdgcn_sinf(tf);
      continue;
    }
    v -= U_ROPE;
    if (v < U_WIN) { wconv_unit(p.w_in, INW, 1024, p.WinT, nullptr, v >> 3, v & 7, 1); continue; }
    v -= U_WIN;
    if (v < U_WUQ) { wconv_unit(p.w_uq, 768, 384, p.WuqT, p.q_gain, v / 3, v % 3, 0); continue; }
    v -= U_WUQ;
    if (v < U_WUKV) { wconv_unit(p.w_ukv, 1024, 256, p.WukvT, p.kv_gain, v >> 1, v & 1, 0); continue; }
    v -= U_WUKV;
    if (v < U_WA) { wconv_unit(p.w_a, 1024, 512, p.WaT, nullptr, v >> 2, v & 3, 0); continue; }
    v -= U_WA;
    if (v < U_WB) { wconv_unit(p.w_b, 1024, 512, p.WbT, nullptr, v >> 2, v & 3, 0); continue; }
    v -= U_WB;
    wconv_unit(p.w_out, 1024, 1024, p.WoT, nullptr, v >> 3, v & 7, 0);
  }
}

DI void phase_h(const Params& p) {
  const int lane = threadIdx.x & 63, w = threadIdx.x >> 6;
  const int gw = blockIdx.x * 4 + w, nw = gridDim.x * 4;
  for (int row = gw; row < NTOK; row += nw) {
    const int b = row >> 12;
    const float* xr = p.x + (size_t)row * DM;
    float4 v[4];
    float ss = 0.f;
#pragma unroll
    for (int i = 0; i < 2; ++i) {
      const int e = 8 * (lane + 64 * i);
      v[2 * i] = *(const float4*)(xr + e);
      v[2 * i + 1] = *(const float4*)(xr + e + 4);
      ss += v[2 * i].x * v[2 * i].x + v[2 * i].y * v[2 * i].y + v[2 * i].z * v[2 * i].z + v[2 * i].w * v[2 * i].w;
      ss += v[2 * i + 1].x * v[2 * i + 1].x + v[2 * i + 1].y * v[2 * i + 1].y + v[2 * i + 1].z * v[2 * i + 1].z + v[2 * i + 1].w * v[2 * i + 1].w;
    }
#pragma unroll
    for (int o = 32; o >= 1; o >>= 1) ss += __shfl_xor(ss, o);
    const float rn = __builtin_amdgcn_rsqf(ss * (1.f / DM) + EPSN);
    const float* shiftp = p.MOD + b * 3072;
    const float* scalep = p.MOD + b * 3072 + 1024;
#pragma unroll
    for (int i = 0; i < 2; ++i) {
      const int e = 8 * (lane + 64 * i);
      float o[8];
      const float xs[8] = {v[2 * i].x, v[2 * i].y, v[2 * i].z, v[2 * i].w, v[2 * i + 1].x, v[2 * i + 1].y, v[2 * i + 1].z, v[2 * i + 1].w};
#pragma unroll
      for (int j = 0; j < 8; ++j) o[j] = xs[j] * rn * p.norm_gain[e + j] * (1.f + scalep[e + j]) + shiftp[e + j];
      *(bf16x8*)(p.Hb + (size_t)row * DM + e) = pack8(o[0], o[1], o[2], o[3], o[4], o[5], o[6], o[7]);
    }
  }
}

DI void phase_g1(const Params& p, char* smem) {
  bf16_t* sA = (bf16_t*)smem;
  bf16_t* sB = sA + 2 * GBUF;
  float* rs = (float*)(smem + 4 * GBUF * 2);
  constexpr int NCT = INWP / 128;
  const int ntiles = (NTOK / 128) * NCT;
  const int lane = threadIdx.x & 63;
  for (int t = blockIdx.x; t < ntiles; t += gridDim.x) {
    const int rt = t / NCT, ct = t % NCT;
    const int m0 = rt * 128, n0 = ct * 128;
    f32x16 acc[2][2];
    zero_acc(acc);
    gemm_mainloop<false>(p.Hb + (size_t)m0 * DM, DM, p.WinT + (size_t)n0 * DM, DM, DM, sA, sB, acc, rs);
    if (ct < 4) {
      epi_iter(acc, [&](int, int, int, int rl, int cl, float v0, float v1, float v2, float v3) {
        store4_rows(p.Qsb, 512, m0 + rl, n0 + cl, v0 * QS_SCALE, v1 * QS_SCALE, v2 * QS_SCALE, v3 * QS_SCALE); });
    } else if (ct < 8) {
      epi_iter(acc, [&](int, int, int, int rl, int cl, float v0, float v1, float v2, float v3) {
        store4_rows(p.Ksb, 512, m0 + rl, n0 - 512 + cl, v0, v1, v2, v3); });
    } else if (ct < 12) {
      epi_iter(acc, [&](int, int, int, int rl, int cl, float v0, float v1, float v2, float v3) {
        const int cc = n0 - 1024 + cl;
        store4_vt(p.VTsb, m0 + rl, cc >> 6, cc & 63, v0, v1, v2, v3); });
    } else if (ct < 16) {
      epi_iter(acc, [&](int, int, int, int rl, int cl, float v0, float v1, float v2, float v3) {
        store4_rows(p.Zsb, 512, m0 + rl, n0 - 1536 + cl, siluf_fast(v0), siluf_fast(v1), siluf_fast(v2), siluf_fast(v3)); });
    } else if (ct < 19) {
      epi_iter(acc, [&](int, int, int, int rl, int cl, float v0, float v1, float v2, float v3) {
        store4_rows(p.CQ, 384, m0 + rl, n0 - 2048 + cl, v0, v1, v2, v3); });
    } else if (ct < 21) {
      epi_iter(acc, [&](int, int, int, int rl, int cl, float v0, float v1, float v2, float v3) {
        store4_rows(p.CKV, 256, m0 + rl, n0 - 2432 + cl, v0, v1, v2, v3); });
    } else if (ct < 25) {
      epi_iter(acc, [&](int, int, int, int rl, int cl, float v0, float v1, float v2, float v3) {
        store4_rows(p.Zmla, 512, m0 + rl, n0 - 2688 + cl, siluf_fast(v0), siluf_fast(v1), siluf_fast(v2), siluf_fast(v3)); });
    } else if (ct < 33) {
      epi_iter(acc, [&](int, int, int, int rl, int cl, float v0, float v1, float v2, float v3) {
        store4_rows(p.GA, 1024, m0 + rl, n0 - 3200 + cl, sigmoidf_fast(v0), sigmoidf_fast(v1), sigmoidf_fast(v2), sigmoidf_fast(v3)); });
    } else if (ct < 41) {
      epi_iter(acc, [&](int, int, int, int rl, int cl, float v0, float v1, float v2, float v3) {
        store4_rows(p.GB, 1024, m0 + rl, n0 - 4224 + cl, sigmoidf_fast(v0), sigmoidf_fast(v1), sigmoidf_fast(v2), sigmoidf_fast(v3)); });
    } else {
      epi_iter(acc, [&](int, int nt, int, int rl, int cl, float v0, float v1, float v2, float v3) {
        if (cl < 32) {
          rope4(p.ROPE, m0 + rl, lane & 31, v0, v1, v2, v3);
          store4_rows(p.KPE, 32, m0 + rl, cl, v0, v1, v2, v3);
        }
      });
    }
  }
}

DI void phase_g2(const Params& p, char* smem) {
  bf16_t* sA = (bf16_t*)smem;
  bf16_t* sB = sA + 2 * GBUF;
  float* rs = (float*)(smem + 4 * GBUF * 2);
  constexpr int NQ = 128 * 6, NKV = 128 * 8;
  const int lane = threadIdx.x & 63;
  for (int t = blockIdx.x; t < NQ + NKV; t += gridDim.x) {
    f32x16 acc[2][2];
    zero_acc(acc);
    if (t < NQ) {
      const int rt = t / 6, ct = t % 6, m0 = rt * 128, n0 = ct * 128;
      gemm_mainloop<true>(p.CQ + (size_t)m0 * 384, 384, p.WuqT + (size_t)n0 * 384, 384, 384, sA, sB, acc, rs);
      epi_iter(acc, [&](int, int, int, int rl, int cl, float v0, float v1, float v2, float v3) {
        const int col = n0 + cl;
        v0 *= rs[rl]; v1 *= rs[rl + 1]; v2 *= rs[rl + 2]; v3 *= rs[rl + 3];
        if (((col >> 5) % 3) == 2) rope4(p.ROPE, m0 + rl, lane & 31, v0, v1, v2, v3);
        store4_rows(p.Qmla, 768, m0 + rl, col, v0 * QM_SCALE, v1 * QM_SCALE, v2 * QM_SCALE, v3 * QM_SCALE);
      });
    } else {
      const int t2 = t - NQ;
      const int rt = t2 >> 3, head = t2 & 7, m0 = rt * 128, n0 = head * 128;
      gemm_mainloop<true>(p.CKV + (size_t)m0 * 256, 256, p.WukvT + (size_t)n0 * 256, 256, 256, sA, sB, acc, rs);
      epi_iter(acc, [&](int, int, int, int rl, int cl, float v0, float v1, float v2, float v3) {
        v0 *= rs[rl]; v1 *= rs[rl + 1]; v2 *= rs[rl + 2]; v3 *= rs[rl + 3];
        if (cl < 64) store4_rows(p.Knope, 512, m0 + rl, head * 64 + cl, v0, v1, v2, v3);
        else store4_vt(p.VTmla, m0 + rl, head, cl - 64, v0, v1, v2, v3);
      });
    }
    __syncthreads();
  }
}

constexpr int VSTR = 68;

template <bool MLA>
DI void attn_item(const Params& p, int b, int h, int qb, char* smem) {
  constexpr int DK = MLA ? 96 : 64;
  constexpr int KSTR = MLA ? 104 : 72;
  constexpr int NKS = DK / 16;
  bf16_t* sK = (bf16_t*)smem;
  bf16_t* sV = sK + 2 * 64 * KSTR;
  const int tid = threadIdx.x, lane = tid & 63, w = tid >> 6, r = lane & 31, hh = lane >> 5;
  const int tokb = b * SEQL;
  const int tok0 = tokb + qb * 128;
  const int qw = qb * 128 + w * 32;

  bf16x8 qf[NKS];
  {
    const bf16_t* qptr = MLA ? (p.Qmla + (size_t)(tok0 + w * 32 + r) * 768 + h * 96 + hh * 8) : (p.Qsb + (size_t)(tok0 + w * 32 + r) * 512 + h * 64 + hh * 8);
#pragma unroll
    for (int ks = 0; ks < NKS; ++ks) qf[ks] = *(const bf16x8*)(qptr + ks * 16);
  }
  bf16x8 tf[2];
  if (!MLA) {
#pragma unroll
    for (int st = 0; st < 2; ++st)
#pragma unroll
      for (int e = 0; e < 8; ++e) { const int j = 16 * st + 8 * (e >> 2) + 4 * hh + (e & 3); tf[st][e] = (j >= r) ? (short)0x3F80 : (short)0; }
  }

  f32x16 oacc[2];
#pragma unroll
  for (int i = 0; i < 16; ++i) { oacc[0][i] = 0.f; oacc[1][i] = 0.f; }
  float carry = 0.f;
  float mrun = -1e30f, lrun = 0.f;

  const bf16_t* Kg = MLA ? p.Knope : p.Ksb;
  const bf16_t* VTg = (MLA ? p.VTmla : p.VTsb) + (size_t)((b * 8 + h) * 64) * SEQL;
  const int nt = 2 * qb + 2;

  uint4 rk[2], rv[2], rp;
  const int prow = tid >> 3, pch = tid & 7;
  auto gload = [&](int kt) {
#pragma unroll
    for (int i = 0; i < 2; ++i) {
      rk[i] = *(const uint4*)(Kg + (size_t)(tokb + kt * 64 + prow + 32 * i) * 512 + h * 64 + pch * 8);
      rv[i] = *(const uint4*)(VTg + (size_t)(prow + 32 * i) * SEQL + kt * 64 + pch * 8);
    }
    if (MLA) rp = *(const uint4*)(p.KPE + (size_t)(tokb + kt * 64 + (tid >> 2)) * 32 + (tid & 3) * 8);
  };
  auto swrite = [&](int buf) {
    bf16_t* dK = sK + buf * 64 * KSTR;
    bf16_t* dV = sV + buf * 64 * VSTR;
#pragma unroll
    for (int i = 0; i < 2; ++i) {
      *(uint4*)(dK + (prow + 32 * i) * KSTR + pch * 8) = rk[i];
      uint2* dv = (uint2*)(dV + (prow + 32 * i) * VSTR + pch * 8);
      dv[0] = make_uint2(rv[i].x, rv[i].y);
      dv[1] = make_uint2(rv[i].z, rv[i].w);
    }
    if (MLA) *(uint4*)(dK + (tid >> 2) * KSTR + 64 + (tid & 3) * 8) = rp;
  };

  gload(MLA ? 0 : nt - 1);
  swrite(0);
  __syncthreads();
  for (int it = 0; it < nt; ++it) {
    const int kt = MLA ? it : (nt - 1 - it);
    const int cur = it & 1;
    const bool more = (it + 1 < nt);
    if (more) gload(MLA ? it + 1 : nt - 2 - it);
    const bf16_t* cK = sK + cur * 64 * KSTR;
    const bf16_t* cV = sV + cur * 64 * VSTR;
#pragma unroll
    for (int si = 0; si < 2; ++si) {
      const int sub = MLA ? si : (1 - si);
      const int kb = kt * 64 + sub * 32;
      if (kb > qw) continue;
      const bool diag = (kb == qw);
      f32x16 s;
#pragma unroll
      for (int i = 0; i < 16; ++i) s[i] = 0.f;
#pragma unroll
      for (int ks = 0; ks < NKS; ++ks) {
        const bf16x8 kf = *(const bf16x8*)(cK + (sub * 32 + r) * KSTR + ks * 16 + hh * 8);
        s = MFMA(kf, qf[ks], s);
      }
      bf16x8 pf[2];
      if (!MLA) {
        float sp[16];
        float tsum = 0.f;
#pragma unroll
        for (int i = 0; i < 16; ++i) {
          const float z = s[i];
          float v = fmaxf(z, 0.f) + __builtin_amdgcn_logf(1.f + __builtin_amdgcn_exp2f(-fabsf(z)));
          if (diag && !(crow(i, hh) < r)) v = 0.f;
          sp[i] = v;
          tsum += v;
        }
        f32x16 cacc;
#pragma unroll
        for (int i = 0; i < 16; ++i) cacc[i] = carry;
        cacc = MFMA(tf[0], pack8(sp[0], sp[1], sp[2], sp[3], sp[4], sp[5], sp[6], sp[7]), cacc);
        cacc = MFMA(tf[1], pack8(sp[8], sp[9], sp[10], sp[11], sp[12], sp[13], sp[14], sp[15]), cacc);
        float pr[16];
#pragma unroll
        for (int i = 0; i < 16; ++i) {
          float v = __builtin_amdgcn_exp2f(s[i] - cacc[i]);
          if (diag && !(crow(i, hh) < r)) v = 0.f;
          pr[i] = v;
        }
        carry += half_sum(tsum);
        pf[0] = pack8(pr[0], pr[1], pr[2], pr[3], pr[4], pr[5], pr[6], pr[7]);
        pf[1] = pack8(pr[8], pr[9], pr[10], pr[11], pr[12], pr[13], pr[14], pr[15]);
      } else {
        float mloc = -1e30f;
#pragma unroll
        for (int i = 0; i < 16; ++i) {
          if (diag && !(crow(i, hh) <= r)) s[i] = -1e30f;
          mloc = fmaxf(mloc, s[i]);
        }
        mloc = half_max(mloc);
        const float mnew = fmaxf(mrun, mloc);
        const float alpha = __builtin_amdgcn_exp2f(mrun - mnew);
        mrun = mnew;
        float pr[16];
        float psum = 0.f;
#pragma unroll
        for (int i = 0; i < 16; ++i) { pr[i] = __builtin_amdgcn_exp2f(s[i] - mnew); psum += pr[i]; }
        lrun = lrun * alpha + psum;
#pragma unroll
        for (int i = 0; i < 16; ++i) { oacc[0][i] *= alpha; oacc[1][i] *= alpha; }
        pf[0] = pack8(pr[0], pr[1], pr[2], pr[3], pr[4], pr[5], pr[6], pr[7]);
        pf[1] = pack8(pr[8], pr[9], pr[10], pr[11], pr[12], pr[13], pr[14], pr[15]);
      }
#pragma unroll
      for (int dt = 0; dt < 2; ++dt)
#pragma unroll
        for (int st = 0; st < 2; ++st) {
          const bf16_t* vp = cV + (dt * 32 + r) * VSTR + sub * 32 + st * 16 + 4 * hh;
          const s16x4 lo = *(const s16x4*)vp;
          const s16x4 hi = *(const s16x4*)(vp + 8);
          const bf16x8 vf = __builtin_shufflevector(lo, hi, 0, 1, 2, 3, 4, 5, 6, 7);
          oacc[dt] = MFMA(vf, pf[st], oacc[dt]);
        }
    }
    if (more) swrite(cur ^ 1);
    __syncthreads();
  }
  float inv = 1.f;
  if (MLA) { const float lt = half_sum(lrun); inv = 1.f / lt; }
  const int tok = tok0 + w * 32 + r;
  const bf16_t* zg = (MLA ? p.Zmla : p.Zsb) + (size_t)tok * 512 + h * 64;
  bf16_t* og = (MLA ? p.OBg : p.OAg) + (size_t)tok * 512 + h * 64;
#pragma unroll
  for (int dt = 0; dt < 2; ++dt)
#pragma unroll
    for (int g = 0; g < 4; ++g) {
      const int d = dt * 32 + 8 * g + 4 * hh;
      const u32x2 zz = *(const u32x2*)(zg + d);
      const float z0 = __uint_as_float(zz[0] << 16), z1 = __uint_as_float(zz[0] & 0xffff0000u);
      const float z2 = __uint_as_float(zz[1] << 16), z3 = __uint_as_float(zz[1] & 0xffff0000u);
      u32x2 o;
      o[0] = pk2(oacc[dt][4 * g] * inv * z0, oacc[dt][4 * g + 1] * inv * z1);
      o[1] = pk2(oacc[dt][4 * g + 2] * inv * z2, oacc[dt][4 * g + 3] * inv * z3);
      *(u32x2*)(og + d) = o;
    }
}

DI void phase_attn(const Params& p, char* smem) {
  int* s_item = (int*)(smem + SMEM_BYTES - 16);
  for (;;) {
    if (threadIdx.x == 0) *s_item = atomicAdd(p.counter, 1);
    __syncthreads();
    const int item = *s_item;
    __syncthreads();
    if (item >= 2048) break;
    const int qb = 31 - (item >> 6);
    const int sub = item & 63;
    const int bh = sub & 31;
    if (sub < 32) attn_item<true>(p, bh >> 3, bh & 7, qb, smem);
    else attn_item<false>(p, bh >> 3, bh & 7, qb, smem);
  }
}

DI void phase_g3(const Params& p, char* smem) {
  bf16_t* sA = (bf16_t*)smem;
  bf16_t* sB = sA + 2 * GBUF;
  float* rs = (float*)(smem + 4 * GBUF * 2);
  for (int t = blockIdx.x; t < 128 * 8; t += gridDim.x) {
    const int rt = t >> 3, ct = t & 7, m0 = rt * 128, n0 = ct * 128;
    f32x16 acc[2][2];
    unsigned ya[2][2][8];
    zero_acc(acc);
    gemm_mainloop<false>(p.OAg + (size_t)m0 * 512, 512, p.WaT + (size_t)n0 * 512, 512, 512, sA, sB, acc, rs);
    const int lane = threadIdx.x & 63, w = threadIdx.x >> 6;
    const int wm = w >> 1, wn = w & 1, r = lane & 31, hh = lane >> 5;
#pragma unroll
    for (int mt = 0; mt < 2; ++mt)
#pragma unroll
      for (int nt = 0; nt < 2; ++nt) {
        const bf16_t* gp = p.GA + (size_t)(m0 + wm * 64 + mt * 32 + 4 * hh) * 1024 + n0 + wn * 64 + nt * 32 + r;
#pragma unroll
        for (int i = 0; i < 16; i += 2) {
          const float g0 = bf2f(gp[(size_t)((i & 3) + 8 * (i >> 2)) * 1024]);
          const float g1 = bf2f(gp[(size_t)(((i + 1) & 3) + 8 * ((i + 1) >> 2)) * 1024]);
          ya[mt][nt][i >> 1] = pk2(acc[mt][nt][i] * g0, acc[mt][nt][i + 1] * g1);
        }
      }
    zero_acc(acc);
    gemm_mainloop<false>(p.OBg + (size_t)m0 * 512, 512, p.WbT + (size_t)n0 * 512, 512, 512, sA, sB, acc, rs);
#pragma unroll
    for (int mt = 0; mt < 2; ++mt)
#pragma unroll
      for (int nt = 0; nt < 2; ++nt) {
        const size_t eoff = (size_t)(m0 + wm * 64 + mt * 32 + 4 * hh) * 1024 + n0 + wn * 64 + nt * 32 + r;
#pragma unroll
        for (int i = 0; i < 16; ++i) {
          const size_t o = eoff + (size_t)((i & 3) + 8 * (i >> 2)) * 1024;
          const unsigned u = ya[mt][nt][i >> 1];
          const float y = (i & 1) ? __uint_as_float(u & 0xffff0000u) : __uint_as_float(u << 16);
          const float v = y + acc[mt][nt][i] * bf2f(p.GB[o]);
          p.MERGED[o] = tobf(v);
        }
      }
  }
}

DI void phase_g4(const Params& p, char* smem) {
  bf16_t* sA = (bf16_t*)smem;
  bf16_t* sB = sA + 2 * GBUF;
  float* rs = (float*)(smem + 4 * GBUF * 2);
  for (int t = blockIdx.x; t < 128 * 8; t += gridDim.x) {
    const int rt = t >> 3, ct = t & 7, m0 = rt * 128, n0 = ct * 128;
    f32x16 acc[2][2];
    zero_acc(acc);
    gemm_mainloop<false>(p.MERGED + (size_t)m0 * 1024, 1024, p.WoT + (size_t)n0 * 1024, 1024, 1024, sA, sB, acc, rs);
    const float* gate = p.MOD + (m0 >> 12) * 3072 + 2048;
    const int lane = threadIdx.x & 63, w = threadIdx.x >> 6;
    const int wm = w >> 1, wn = w & 1, r = lane & 31, hh = lane >> 5;
#pragma unroll
    for (int mt = 0; mt < 2; ++mt)
#pragma unroll
      for (int nt = 0; nt < 2; ++nt) {
        const int col = n0 + wn * 64 + nt * 32 + r;
        const float gt = gate[col];
#pragma unroll
        for (int i = 0; i < 16; ++i) {
          const int row = m0 + wm * 64 + mt * 32 + crow(i, hh);
          p.out[(size_t)row * 1024 + col] = p.x[(size_t)row * 1024 + col] + gt * acc[mt][nt][i];
        }
      }
  }
}

DI void phase_final(const Params& p) {
  const int lane = threadIdx.x & 63, w = threadIdx.x >> 6;
  const int gw = blockIdx.x * 4 + w, nw = gridDim.x * 4;
  for (int row = gw; row < NTOK; row += nw) {
    float* xr = p.out + (size_t)row * DM;
    float4 v[4];
    float ss = 0.f;
#pragma unroll
    for (int i = 0; i < 4; ++i) {
      v[i] = *(const float4*)(xr + 4 * (lane + 64 * i));
      ss += v[i].x * v[i].x + v[i].y * v[i].y + v[i].z * v[i].z + v[i].w * v[i].w;
    }
#pragma unroll
    for (int o = 32; o >= 1; o >>= 1) ss += __shfl_xor(ss, o);
    const float rn = __builtin_amdgcn_rsqf(ss * (1.f / DM) + EPSN);
#pragma unroll
    for (int i = 0; i < 4; ++i) {
      const int e = 4 * (lane + 64 * i);
      const float4 g = *(const float4*)(p.fgain + e);
      float4 o;
      o.x = v[i].x * rn * g.x; o.y = v[i].y * rn * g.y; o.z = v[i].z * rn * g.z; o.w = v[i].w * rn * g.w;
      *(float4*)(xr + e) = o;
    }
  }
}

template <int PH>
__global__ void __launch_bounds__(NTHREADS, 2) mega_kernel(Params p) {
  __shared__ __attribute__((aligned(16))) char smem[SMEM_BYTES];
  if (PH < 0) {
    cg::grid_group grid = cg::this_grid();
    phase_prep(p, smem); grid.sync();
    phase_h(p); grid.sync();
    phase_g1(p, smem); grid.sync();
    phase_g2(p, smem); grid.sync();
    phase_attn(p, smem); grid.sync();
    phase_g3(p, smem); grid.sync();
    phase_g4(p, smem); grid.sync();
    phase_final(p);
  } else {
    if (PH == 0) phase_prep(p, smem);
    if (PH == 1) phase_h(p);
    if (PH == 2) phase_g1(p, smem);
    if (PH == 3) phase_g2(p, smem);
    if (PH == 4) phase_attn(p, smem);
    if (PH == 5) phase_g3(p, smem);
    if (PH == 6) phase_g4(p, smem);
    if (PH == 7) phase_final(p);
  }
}

#ifndef MK_SPLIT
#define MK_SPLIT 0
#endif

extern "C" void kernel_launch(void* const* d_in, const int* in_sizes, int n_in, void* d_out, int out_size, void* d_ws, size_t ws_size, hipStream_t stream) {
  Params p{};
  p.x = (const float*)d_in[0]; p.c = (const float*)d_in[1]; p.pos = (const int*)d_in[2];
  p.w_ada = (const float*)d_in[3]; p.b_ada = (const float*)d_in[4]; p.norm_gain = (const float*)d_in[5];
  p.w_in = (const float*)d_in[6]; p.q_gain = (const float*)d_in[7]; p.w_uq = (const float*)d_in[8];
  p.kv_gain = (const float*)d_in[9]; p.w_ukv = (const float*)d_in[10]; p.w_a = (const float*)d_in[11];
  p.w_b = (const float*)d_in[12]; p.w_out = (const float*)d_in[13]; p.fgain = (const float*)d_in[14];
  p.out = (float*)d_out;
  char* ws = (char*)d_ws;
  size_t off = 0;
  auto take = [&](size_t bytes) { char* r = ws + off; off += (bytes + 255) & ~(size_t)255; return r; };
  p.counter = (int*)take(256);
  p.MOD = (float*)take(4 * 3072 * 4);
  p.ROPE = (float*)take((size_t)NTOK * 32 * 4);
  p.Hb = (bf16_t*)take((size_t)NTOK * 1024 * 2);
  p.MERGED = p.Hb;
  p.Qmla = (bf16_t*)take((size_t)NTOK * 768 * 2);
  p.WinT = p.Qmla;
  p.WuqT = (bf16_t*)take((size_t)768 * 384 * 2);
  p.WukvT = (bf16_t*)take((size_t)1024 * 256 * 2);
  p.WaT = (bf16_t*)take((size_t)1024 * 512 * 2);
  p.WbT = (bf16_t*)take((size_t)1024 * 512 * 2);
  p.WoT = (bf16_t*)take((size_t)1024 * 1024 * 2);
  p.Qsb = (bf16_t*)take((size_t)NTOK * 512 * 2);
  p.Ksb = (bf16_t*)take((size_t)NTOK * 512 * 2);
  p.VTsb = (bf16_t*)take((size_t)NTOK * 512 * 2);
  p.Zsb = (bf16_t*)take((size_t)NTOK * 512 * 2);
  p.OAg = (bf16_t*)take((size_t)NTOK * 512 * 2);
  p.OBg = (bf16_t*)take((size_t)NTOK * 512 * 2);
  p.CQ = p.OAg;
  p.CKV = p.OBg;
  p.Zmla = (bf16_t*)take((size_t)NTOK * 512 * 2);
  p.KPE = (bf16_t*)take((size_t)NTOK * 32 * 2);
  p.Knope = (bf16_t*)take((size_t)NTOK * 512 * 2);
  p.VTmla = (bf16_t*)take((size_t)NTOK * 512 * 2);
  p.GA = (bf16_t*)d_out;
  p.GB = p.GA + (size_t)NTOK * 1024;
  if (off > ws_size) { fprintf(stderr, "workspace too small: need %zu have %zu\n", off, ws_size); return; }

  static int grid_blocks = 0;
  if (!grid_blocks) {
    int dev = 0, cus = 0, per_cu = 0;
    hipGetDevice(&dev);
    hipDeviceGetAttribute(&cus, hipDeviceAttributeMultiprocessorCount, dev);
    hipOccupancyMaxActiveBlocksPerMultiprocessor(&per_cu, mega_kernel<-1>, NTHREADS, 0);
    if (per_cu > 2) per_cu = 2;
    if (per_cu < 1) per_cu = 1;
    grid_blocks = cus * per_cu;
  }
#if MK_SPLIT
  mega_kernel<0><<<grid_blocks, NTHREADS, 0, stream>>>(p);
  mega_kernel<1><<<grid_blocks, NTHREADS, 0, stream>>>(p);
  mega_kernel<2><<<grid_blocks, NTHREADS, 0, stream>>>(p);
  mega_kernel<3><<<grid_blocks, NTHREADS, 0, stream>>>(p);
  mega_kernel<4><<<grid_blocks, NTHREADS, 0, stream>>>(p);
  mega_kernel<5><<<grid_blocks, NTHREADS, 0, stream>>>(p);
  mega_kernel<6><<<grid_blocks, NTHREADS, 0, stream>>>(p);
  mega_kernel<7><<<grid_blocks, NTHREADS, 0, stream>>>(p);
#else
  void* args[] = {&p};
  hipError_t e = hipLaunchCooperativeKernel((void*)mega_kernel<-1>, dim3(grid_blocks), dim3(NTHREADS), args, 0, stream);
  if (e != hipSuccess) fprintf(stderr, "cooperative launch failed: %s (grid %d)\n", hipGetErrorString(e), grid_blocks);
#endif
}
```

```cpp
#include <hip/hip_runtime.h>
#include <hip/hip_cooperative_groups.h>
#include <stdint.h>
#include <stdio.h>
namespace cg = cooperative_groups;
#ifndef PROBE_DUP
#define PROBE_DUP 0
#endif

#define DI __device__ __forceinline__
typedef unsigned short bf16_t;
typedef __attribute__((ext_vector_type(8))) short bf16x8;
typedef __attribute__((ext_vector_type(4))) short s16x4;
typedef __attribute__((ext_vector_type(16))) float f32x16;
typedef __attribute__((ext_vector_type(2))) float f32x2;
typedef __attribute__((ext_vector_type(2))) __bf16 bf16x2v;
typedef __attribute__((ext_vector_type(4))) unsigned u32x4;
typedef __attribute__((ext_vector_type(2))) unsigned u32x2;
#define MFMA(a, b, c) __builtin_amdgcn_mfma_f32_32x32x16_bf16((a), (b), (c), 0, 0, 0)

constexpr int NTOK = 16384, SEQL = 4096, DM = 1024;
constexpr int INW = 5280, INWP = 5376;
constexpr int NTHREADS = 256;
constexpr float LOG2E = 1.4426950408889634f;
constexpr float QS_SCALE = 0.125f * 1.4426950408889634f;
constexpr float QM_SCALE = 1.4426950408889634f / 9.797958971132712f;
constexpr float EPSN = 1e-6f;

struct Params {
  const float *x, *c; const int* pos;
  const float *w_ada, *b_ada, *norm_gain, *w_in, *q_gain, *w_uq, *kv_gain, *w_ukv, *w_a, *w_b, *w_out, *fgain;
  float* out;
  bf16_t *Hb, *WinT, *WuqT, *WukvT, *WaT, *WbT, *WoT;
  float *MOD, *ROPE;
  bf16_t *Qsb, *Ksb, *VTsb, *Zsb, *CQ, *CKV, *Zmla, *GA, *GB, *KPE, *Qmla, *Knope, *VTmla, *OAg, *OBg, *MERGED;
  int* counter;
};

__device__ const float c_invfreq[16] = {
  1.0f, 0.5623413251903491f, 0.31622776601683794f, 0.1778279410038923f, 0.1f, 0.05623413251903491f, 0.03162277660168379f,
  0.01778279410038923f, 0.01f, 0.005623413251903491f, 0.0031622776601683794f, 0.001778279410038923f, 0.001f,
  0.0005623413251903491f, 0.00031622776601683794f, 0.0001778279410038923f};

DI unsigned pk2(float a, float b) { f32x2 v = {a, b}; bf16x2v r = __builtin_convertvector(v, bf16x2v); return __builtin_bit_cast(unsigned, r); }
DI bf16_t tobf(float a) { return (bf16_t)(pk2(a, 0.f) & 0xffffu); }
DI float bf2f(unsigned short u) { return __uint_as_float(((unsigned)u) << 16); }
DI bf16x8 pack8(float a0, float a1, float a2, float a3, float a4, float a5, float a6, float a7) {
  u32x4 p; p[0] = pk2(a0, a1); p[1] = pk2(a2, a3); p[2] = pk2(a4, a5); p[3] = pk2(a6, a7);
  return __builtin_bit_cast(bf16x8, p);
}
DI int crow(int reg, int h) { return (reg & 3) + 8 * (reg >> 2) + 4 * h; }
DI float half_max(float v) {
  unsigned u = __float_as_uint(v);
  auto r = __builtin_amdgcn_permlane32_swap(u, u, false, false);
  return fmaxf(__uint_as_float(r[0]), __uint_as_float(r[1]));
}
DI float half_sum(float v) {
  unsigned u = __float_as_uint(v);
  auto r = __builtin_amdgcn_permlane32_swap(u, u, false, false);
  return __uint_as_float(r[0]) + __uint_as_float(r[1]);
}
DI float sigmoidf_fast(float v) { return __builtin_amdgcn_rcpf(1.f + __builtin_amdgcn_exp2f(-v * LOG2E)); }
DI float siluf_fast(float v) { return v * sigmoidf_fast(v); }

constexpr int GSTR = 72;
constexpr int GBUF = 128 * GSTR;
constexpr int SMEM_BYTES = 4 * GBUF * 2 + 1024;

template <bool ROWSS>
DI void gemm_mainloop(const bf16_t* __restrict__ A, int lda, const bf16_t* __restrict__ B, int ldb, int K,
                      bf16_t* sA, bf16_t* sB, f32x16 (&acc)[2][2], float* rs) {
  const int tid = threadIdx.x, lane = tid & 63, w = tid >> 6;
  const int wm = w >> 1, wn = w & 1, r = lane & 31, hh = lane >> 5;
  const int lrow = tid >> 3, lch = tid & 7;
  const bf16_t* pa = A + (size_t)lrow * lda + lch * 8;
  const bf16_t* pb = B + (size_t)lrow * ldb + lch * 8;
  uint4 ra[4], rb[4];
  float ss[4] = {0.f, 0.f, 0.f, 0.f};
#pragma unroll
  for (int i = 0; i < 4; ++i) {
    ra[i] = *(const uint4*)(pa + (size_t)(32 * i) * lda);
    rb[i] = *(const uint4*)(pb + (size_t)(32 * i) * ldb);
  }
  const int nk = K >> 6;
  const int woff = lrow * GSTR + lch * 8;
#pragma unroll
  for (int i = 0; i < 4; ++i) {
    *(uint4*)(sA + woff + 32 * i * GSTR) = ra[i];
    *(uint4*)(sB + woff + 32 * i * GSTR) = rb[i];
  }
  if (ROWSS) {
#pragma unroll
    for (int i = 0; i < 4; ++i) {
      unsigned u[4] = {ra[i].x, ra[i].y, ra[i].z, ra[i].w};
#pragma unroll
      for (int j = 0; j < 4; ++j) { float lo = __uint_as_float(u[j] << 16), hi = __uint_as_float(u[j] & 0xffff0000u); ss[i] += lo * lo + hi * hi; }
    }
  }
  __syncthreads();
  for (int ks = 0; ks < nk; ++ks) {
    const int cur = ks & 1;
    const bool more = (ks + 1 < nk);
    if (more) {
      const int ko = (ks + 1) * 64;
#pragma unroll
      for (int i = 0; i < 4; ++i) {
        ra[i] = *(const uint4*)(pa + (size_t)(32 * i) * lda + ko);
        rb[i] = *(const uint4*)(pb + (size_t)(32 * i) * ldb + ko);
      }
    }
    const bf16_t* cA = sA + cur * GBUF + (wm * 64 + r) * GSTR + hh * 8;
    const bf16_t* cB = sB + cur * GBUF + (wn * 64 + r) * GSTR + hh * 8;
#pragma unroll
    for (int kk = 0; kk < 4; ++kk) {
      bf16x8 a0 = *(const bf16x8*)(cA + kk * 16);
      bf16x8 a1 = *(const bf16x8*)(cA + 32 * GSTR + kk * 16);
      bf16x8 b0 = *(const bf16x8*)(cB + kk * 16);
      bf16x8 b1 = *(const bf16x8*)(cB + 32 * GSTR + kk * 16);
      acc[0][0] = MFMA(a0, b0, acc[0][0]);
      acc[0][1] = MFMA(a0, b1, acc[0][1]);
      acc[1][0] = MFMA(a1, b0, acc[1][0]);
      acc[1][1] = MFMA(a1, b1, acc[1][1]);
    }
    if (more) {
      const int nb = (cur ^ 1) * GBUF;
#pragma unroll
      for (int i = 0; i < 4; ++i) {
        *(uint4*)(sA + nb + woff + 32 * i * GSTR) = ra[i];
        *(uint4*)(sB + nb + woff + 32 * i * GSTR) = rb[i];
      }
      if (ROWSS) {
#pragma unroll
        for (int i = 0; i < 4; ++i) {
          unsigned u[4] = {ra[i].x, ra[i].y, ra[i].z, ra[i].w};
#pragma unroll
          for (int j = 0; j < 4; ++j) { float lo = __uint_as_float(u[j] << 16), hi = __uint_as_float(u[j] & 0xffff0000u); ss[i] += lo * lo + hi * hi; }
        }
      }
    }
    __syncthreads();
  }
  if (ROWSS) {
#pragma unroll
    for (int i = 0; i < 4; ++i) {
      float v = ss[i];
      v += __shfl_xor(v, 1); v += __shfl_xor(v, 2); v += __shfl_xor(v, 4);
      if (lch == 0) rs[lrow + 32 * i] = __builtin_amdgcn_rsqf(v / (float)K + EPSN);
    }
    __syncthreads();
  }
}

DI void zero_acc(f32x16 (&acc)[2][2]) {
#pragma unroll
  for (int a = 0; a < 2; ++a)
#pragma unroll
    for (int b = 0; b < 2; ++b)
#pragma unroll
      for (int i = 0; i < 16; ++i) acc[a][b][i] = 0.f;
}

template <class F>
DI void epi_iter(f32x16 (&acc)[2][2], F f) {
  const int lane = threadIdx.x & 63, w = threadIdx.x >> 6;
  const int wm = w >> 1, wn = w & 1, r = lane & 31, hh = lane >> 5;
#pragma unroll
  for (int mt = 0; mt < 2; ++mt)
#pragma unroll
    for (int nt = 0; nt < 2; ++nt)
#pragma unroll
      for (int g = 0; g < 4; ++g)
        f(mt, nt, g, wm * 64 + mt * 32 + 8 * g + 4 * hh, wn * 64 + nt * 32 + r, acc[mt][nt][4 * g], acc[mt][nt][4 * g + 1], acc[mt][nt][4 * g + 2], acc[mt][nt][4 * g + 3]);
}

DI void store4_rows(bf16_t* base, int ld, int row, int col, float v0, float v1, float v2, float v3) {
  bf16_t* p = base + (size_t)row * ld + col;
  p[0] = tobf(v0); p[ld] = tobf(v1); p[2 * ld] = tobf(v2); p[3 * ld] = tobf(v3);
}
DI void store4_vt(bf16_t* base, int tok, int head, int d, float v0, float v1, float v2, float v3) {
  const int b = tok >> 12, s = tok & 4095;
  u32x2 pk; pk[0] = pk2(v0, v1); pk[1] = pk2(v2, v3);
  *(u32x2*)(base + ((size_t)((b * 8 + head) * 64 + d)) * SEQL + s) = pk;
}

DI void rope4(const float* ROPE, int tok, int r, float& v0, float& v1, float& v2, float& v3) {
  float v[4] = {v0, v1, v2, v3};
  const int fi = r & 15;
  const bool upper = (r & 16) != 0;
#pragma unroll
  for (int i = 0; i < 4; ++i) {
    const float o = __shfl_xor(v[i], 16);
    const float cs = ROPE[(size_t)(tok + i) * 32 + fi], sn = ROPE[(size_t)(tok + i) * 32 + 16 + fi];
    v[i] = upper ? (o * sn + v[i] * cs) : (v[i] * cs - o * sn);
  }
  v0 = v[0]; v1 = v[1]; v2 = v[2]; v3 = v[3];
}

DI void wconv_unit(const float* __restrict__ src, int Nsrc, int K, bf16_t* __restrict__ dst, const float* __restrict__ gain, int ng, int kg, int mode, float* tile) {
  const int tid = threadIdx.x;
  {
    const int k = tid >> 2, cq = tid & 3;
    const int n = ng * 64 + cq * 16;
    int sc = n;
    if (mode == 1) { sc = (n < 2688) ? n : (n < 5248 ? n + 32 : (n < 5280 ? n - 2560 : -1)); }
    const int kk = kg * 64 + k;
    float4 v[4];
    if (sc >= 0) {
      const float* sp = src + (size_t)kk * Nsrc + sc;
#pragma unroll
      for (int i = 0; i < 4; ++i) v[i] = *(const float4*)(sp + 4 * i);
      if (gain) { const float g = gain[kk];
#pragma unroll
        for (int i = 0; i < 4; ++i) { v[i].x *= g; v[i].y *= g; v[i].z *= g; v[i].w *= g; } }
    } else {
#pragma unroll
      for (int i = 0; i < 4; ++i) v[i] = make_float4(0.f, 0.f, 0.f, 0.f);
    }
    float* tp = tile + k * 65 + cq * 16;
#pragma unroll
    for (int i = 0; i < 4; ++i) { tp[4 * i] = v[i].x; tp[4 * i + 1] = v[i].y; tp[4 * i + 2] = v[i].z; tp[4 * i + 3] = v[i].w; }
  }
  __syncthreads();
  {
    const int n = tid >> 2, kc = tid & 3;
    float o[16];
#pragma unroll
    for (int j = 0; j < 16; ++j) o[j] = tile[(kc * 16 + j) * 65 + n];
    bf16_t* dp = dst + (size_t)(ng * 64 + n) * K + kg * 64 + kc * 16;
    *(bf16x8*)dp = pack8(o[0], o[1], o[2], o[3], o[4], o[5], o[6], o[7]);
    *(bf16x8*)(dp + 8) = pack8(o[8], o[9], o[10], o[11], o[12], o[13], o[14], o[15]);
  }
  __syncthreads();
}

DI void phase_prep(const Params& p, char* smem) {
  const int tid = threadIdx.x;
  if (blockIdx.x == 0 && tid == 0) { p.counter[0] = 0; p.counter[1] = 0; }
  constexpr int U_MOD = 96 * 4, U_WIN = 84 * 16, U_WUQ = 12 * 6, U_WUKV = 16 * 4, U_WA = 16 * 8, U_WB = 16 * 8, U_WO = 16 * 16, U_ROPE = 1024;
  constexpr int U_TOTAL = U_MOD + U_ROPE + U_WIN + U_WUQ + U_WUKV + U_WA + U_WB + U_WO;
  float* tile = (float*)smem;
  for (int u = blockIdx.x; u < U_TOTAL; u += gridDim.x) {
    int v = u;
    if (v < U_MOD) {
      const int cg32 = v >> 2, kq = v & 3, n0 = cg32 * 32;
      const int kgp = tid >> 5, col = tid & 31;
      const int kb = kq * 256 + kgp * 32;
      float a0 = 0.f, a1 = 0.f, a2 = 0.f, a3 = 0.f;
      const float* wp = p.w_ada + (size_t)kb * 3072 + n0 + col;
      float wv[32];
#pragma unroll
      for (int kk = 0; kk < 32; ++kk) wv[kk] = wp[(size_t)kk * 3072];
#pragma unroll
      for (int kk = 0; kk < 32; ++kk) {
        a0 += wv[kk] * p.c[kb + kk]; a1 += wv[kk] * p.c[1024 + kb + kk]; a2 += wv[kk] * p.c[2048 + kb + kk]; a3 += wv[kk] * p.c[3072 + kb + kk];
      }
      float* red = (float*)smem;
      red[(kgp * 4 + 0) * 32 + col] = a0; red[(kgp * 4 + 1) * 32 + col] = a1; red[(kgp * 4 + 2) * 32 + col] = a2; red[(kgp * 4 + 3) * 32 + col] = a3;
      __syncthreads();
      if (tid < 128) {
        const int b = tid >> 5, cc = tid & 31;
        float s = (kq == 0) ? p.b_ada[n0 + cc] : 0.f;
#pragma unroll
        for (int g = 0; g < 8; ++g) s += red[(g * 4 + b) * 32 + cc];
        p.MOD[(size_t)(b * 3072 + n0 + cc) * 4 + kq] = s;
      }
      __syncthreads();
      continue;
    }
    v -= U_MOD;
    if (v < U_WIN) { wconv_unit(p.w_in, INW, 1024, p.WinT, nullptr, v >> 4, v & 15, 1, tile); continue; }
    v -= U_WIN;
    if (v < U_WUQ) { wconv_unit(p.w_uq, 768, 384, p.WuqT, p.q_gain, v / 6, v % 6, 0, tile); continue; }
    v -= U_WUQ;
    if (v < U_WUKV) { wconv_unit(p.w_ukv, 1024, 256, p.WukvT, p.kv_gain, v >> 2, v & 3, 0, tile); continue; }
    v -= U_WUKV;
    if (v < U_WA) { wconv_unit(p.w_a, 1024, 512, p.WaT, nullptr, v >> 3, v & 7, 0, tile); continue; }
    v -= U_WA;
    if (v < U_WB) { wconv_unit(p.w_b, 1024, 512, p.WbT, nullptr, v >> 3, v & 7, 0, tile); continue; }
    v -= U_WB;
    if (v < U_WO) { wconv_unit(p.w_out, 1024, 1024, p.WoT, nullptr, v >> 4, v & 15, 0, tile); continue; }
    v -= U_WO;
    {
      const int idx = v * 256 + tid, tok = idx >> 4, i = idx & 15;
      const float ang = (float)p.pos[tok] * c_invfreq[i];
      double t = (double)ang * 0.15915494309189535;
      t -= rint(t);
      const float tf = (float)t;
      p.ROPE[(size_t)tok * 32 + i] = __builtin_amdgcn_cosf(tf);
      p.ROPE[(size_t)tok * 32 + 16 + i] = __builtin_amdgcn_sinf(tf);
    }
  }
}

DI float mod_get(const float* MOD, int b, int n) { const float4 q = *(const float4*)(MOD + (size_t)(b * 3072 + n) * 4); return (q.x + q.y) + (q.z + q.w); }

DI void phase_h(const Params& p) {
  const int lane = threadIdx.x & 63, w = threadIdx.x >> 6;
  const int gw = blockIdx.x * 4 + w, nw = gridDim.x * 4;
  for (int row = gw; row < NTOK; row += nw) {
    const int b = row >> 12;
    const float* xr = p.x + (size_t)row * DM;
    float4 v[4];
    float ss = 0.f;
#pragma unroll
    for (int i = 0; i < 2; ++i) {
      const int e = 8 * (lane + 64 * i);
      v[2 * i] = *(const float4*)(xr + e);
      v[2 * i + 1] = *(const float4*)(xr + e + 4);
      ss += v[2 * i].x * v[2 * i].x + v[2 * i].y * v[2 * i].y + v[2 * i].z * v[2 * i].z + v[2 * i].w * v[2 * i].w;
      ss += v[2 * i + 1].x * v[2 * i + 1].x + v[2 * i + 1].y * v[2 * i + 1].y + v[2 * i + 1].z * v[2 * i + 1].z + v[2 * i + 1].w * v[2 * i + 1].w;
    }
#pragma unroll
    for (int o = 32; o >= 1; o >>= 1) ss += __shfl_xor(ss, o);
    const float rn = __builtin_amdgcn_rsqf(ss * (1.f / DM) + EPSN);

#pragma unroll
    for (int i = 0; i < 2; ++i) {
      const int e = 8 * (lane + 64 * i);
      float o[8];
      const float xs[8] = {v[2 * i].x, v[2 * i].y, v[2 * i].z, v[2 * i].w, v[2 * i + 1].x, v[2 * i + 1].y, v[2 * i + 1].z, v[2 * i + 1].w};
#pragma unroll
      for (int j = 0; j < 8; ++j) o[j] = xs[j] * rn * p.norm_gain[e + j] * (1.f + mod_get(p.MOD, b, 1024 + e + j)) + mod_get(p.MOD, b, e + j);
      *(bf16x8*)(p.Hb + (size_t)row * DM + e) = pack8(o[0], o[1], o[2], o[3], o[4], o[5], o[6], o[7]);
    }
  }
}

DI void phase_g1(const Params& p, char* smem) {
  bf16_t* sA = (bf16_t*)smem;
  bf16_t* sB = sA + 2 * GBUF;
  float* rs = (float*)(smem + 4 * GBUF * 2);
  constexpr int NCT = INWP / 128;
  const int ntiles = (NTOK / 128) * NCT;
  const int lane = threadIdx.x & 63;
  for (int t = blockIdx.x; t < ntiles; t += gridDim.x) {
    const int rt = t / NCT, ct = t % NCT;
    const int m0 = rt * 128, n0 = ct * 128;
    f32x16 acc[2][2];
    zero_acc(acc);
    gemm_mainloop<false>(p.Hb + (size_t)m0 * DM, DM, p.WinT + (size_t)n0 * DM, DM, DM, sA, sB, acc, rs);
    if (ct < 4) {
      epi_iter(acc, [&](int, int, int, int rl, int cl, float v0, float v1, float v2, float v3) {
        store4_rows(p.Qsb, 512, m0 + rl, n0 + cl, v0 * QS_SCALE, v1 * QS_SCALE, v2 * QS_SCALE, v3 * QS_SCALE); });
    } else if (ct < 8) {
      epi_iter(acc, [&](int, int, int, int rl, int cl, float v0, float v1, float v2, float v3) {
        store4_rows(p.Ksb, 512, m0 + rl, n0 - 512 + cl, v0, v1, v2, v3); });
    } else if (ct < 12) {
      epi_iter(acc, [&](int, int, int, int rl, int cl, float v0, float v1, float v2, float v3) {
        const int cc = n0 - 1024 + cl;
        store4_vt(p.VTsb, m0 + rl, cc >> 6, cc & 63, v0, v1, v2, v3); });
    } else if (ct < 16) {
      epi_iter(acc, [&](int, int, int, int rl, int cl, float v0, float v1, float v2, float v3) {
        store4_rows(p.Zsb, 512, m0 + rl, n0 - 1536 + cl, siluf_fast(v0), siluf_fast(v1), siluf_fast(v2), siluf_fast(v3)); });
    } else if (ct < 19) {
      epi_iter(acc, [&](int, int, int, int rl, int cl, float v0, float v1, float v2, float v3) {
        store4_rows(p.CQ, 384, m0 + rl, n0 - 2048 + cl, v0, v1, v2, v3); });
    } else if (ct < 21) {
      epi_iter(acc, [&](int, int, int, int rl, int cl, float v0, float v1, float v2, float v3) {
        store4_rows(p.CKV, 256, m0 + rl, n0 - 2432 + cl, v0, v1, v2, v3); });
    } else if (ct < 25) {
      epi_iter(acc, [&](int, int, int, int rl, int cl, float v0, float v1, float v2, float v3) {
        store4_rows(p.Zmla, 512, m0 + rl, n0 - 2688 + cl, siluf_fast(v0), siluf_fast(v1), siluf_fast(v2), siluf_fast(v3)); });
    } else if (ct < 33) {
      epi_iter(acc, [&](int, int, int, int rl, int cl, float v0, float v1, float v2, float v3) {
        store4_rows(p.GA, 1024, m0 + rl, n0 - 3200 + cl, sigmoidf_fast(v0), sigmoidf_fast(v1), sigmoidf_fast(v2), sigmoidf_fast(v3)); });
    } else if (ct < 41) {
      epi_iter(acc, [&](int, int, int, int rl, int cl, float v0, float v1, float v2, float v3) {
        store4_rows(p.GB, 1024, m0 + rl, n0 - 4224 + cl, sigmoidf_fast(v0), sigmoidf_fast(v1), sigmoidf_fast(v2), sigmoidf_fast(v3)); });
    } else {
      epi_iter(acc, [&](int, int nt, int, int rl, int cl, float v0, float v1, float v2, float v3) {
        if (cl < 32) {
          rope4(p.ROPE, m0 + rl, lane & 31, v0, v1, v2, v3);
          store4_rows(p.KPE, 32, m0 + rl, cl, v0, v1, v2, v3);
        }
      });
    }
  }
}

DI void phase_g2(const Params& p, char* smem) {
  bf16_t* sA = (bf16_t*)smem;
  bf16_t* sB = sA + 2 * GBUF;
  float* rs = (float*)(smem + 4 * GBUF * 2);
  constexpr int NQ = 128 * 6, NKV = 128 * 8;
  const int lane = threadIdx.x & 63;
  for (int t = blockIdx.x; t < NQ + NKV; t += gridDim.x) {
    f32x16 acc[2][2];
    zero_acc(acc);
    if (t < NQ) {
      const int rt = t / 6, ct = t % 6, m0 = rt * 128, n0 = ct * 128;
      gemm_mainloop<true>(p.CQ + (size_t)m0 * 384, 384, p.WuqT + (size_t)n0 * 384, 384, 384, sA, sB, acc, rs);
      epi_iter(acc, [&](int, int, int, int rl, int cl, float v0, float v1, float v2, float v3) {
        const int col = n0 + cl;
        v0 *= rs[rl]; v1 *= rs[rl + 1]; v2 *= rs[rl + 2]; v3 *= rs[rl + 3];
        if (((col >> 5) % 3) == 2) rope4(p.ROPE, m0 + rl, lane & 31, v0, v1, v2, v3);
        store4_rows(p.Qmla, 768, m0 + rl, col, v0 * QM_SCALE, v1 * QM_SCALE, v2 * QM_SCALE, v3 * QM_SCALE);
      });
    } else {
      const int t2 = t - NQ;
      const int rt = t2 >> 3, head = t2 & 7, m0 = rt * 128, n0 = head * 128;
      gemm_mainloop<true>(p.CKV + (size_t)m0 * 256, 256, p.WukvT + (size_t)n0 * 256, 256, 256, sA, sB, acc, rs);
      epi_iter(acc, [&](int, int, int, int rl, int cl, float v0, float v1, float v2, float v3) {
        v0 *= rs[rl]; v1 *= rs[rl + 1]; v2 *= rs[rl + 2]; v3 *= rs[rl + 3];
        if (cl < 64) store4_rows(p.Knope, 512, m0 + rl, head * 64 + cl, v0, v1, v2, v3);
        else store4_vt(p.VTmla, m0 + rl, head, cl - 64, v0, v1, v2, v3);
      });
    }
    __syncthreads();
  }
}

constexpr int VSTR = 68;

template <bool MLA>
DI void attn_item(const Params& p, int b, int h, int qb, char* smem) {
  constexpr int DK = MLA ? 96 : 64;
  constexpr int KSTR = MLA ? 104 : 72;
  constexpr int NKS = DK / 16;
  bf16_t* sK = (bf16_t*)smem;
  bf16_t* sV = sK + 2 * 64 * KSTR;
  const int tid = threadIdx.x, lane = tid & 63, w = tid >> 6, r = lane & 31, hh = lane >> 5;
  const int tokb = b * SEQL;
  const int tok0 = tokb + qb * 128;
  const int qw = qb * 128 + w * 32;

  bf16x8 qf[NKS];
  {
    const bf16_t* qptr = MLA ? (p.Qmla + (size_t)(tok0 + w * 32 + r) * 768 + h * 96 + hh * 8) : (p.Qsb + (size_t)(tok0 + w * 32 + r) * 512 + h * 64 + hh * 8);
#pragma unroll
    for (int ks = 0; ks < NKS; ++ks) qf[ks] = *(const bf16x8*)(qptr + ks * 16);
  }
  bf16x8 tf[2];
  if (!MLA) {
#pragma unroll
    for (int st = 0; st < 2; ++st)
#pragma unroll
      for (int e = 0; e < 8; ++e) { const int j = 16 * st + 8 * (e >> 2) + 4 * hh + (e & 3); tf[st][e] = (j >= r) ? (short)0x3F80 : (short)0; }
  }

  f32x16 oacc[2];
#pragma unroll
  for (int i = 0; i < 16; ++i) { oacc[0][i] = 0.f; oacc[1][i] = 0.f; }
  float carry = 0.f;
  float mrun = -1e30f, lrun = 0.f;

  const bf16_t* Kg = MLA ? p.Knope : p.Ksb;
  const bf16_t* VTg = (MLA ? p.VTmla : p.VTsb) + (size_t)((b * 8 + h) * 64) * SEQL;
  const int nt = 2 * qb + 2;

  uint4 rk0, rk1, rv0, rv1, rp;
  rp = make_uint4(0, 0, 0, 0);
  const int prow = tid >> 3, pch = tid & 7;
  const bf16_t* kgp = Kg + (size_t)(tokb + prow) * 512 + h * 64 + pch * 8;
  const bf16_t* vgp = VTg + (size_t)prow * SEQL + pch * 8;
  const bf16_t* pgp = p.KPE + (size_t)(tokb + (tid >> 2)) * 32 + (tid & 3) * 8;
#define ATT_GLOAD(kt_)                                                             \
  {                                                                                \
    const int kt__ = (kt_);                                                        \
    rk0 = *(const uint4*)(kgp + (size_t)(kt__ * 64) * 512);                        \
    rk1 = *(const uint4*)(kgp + (size_t)(kt__ * 64 + 32) * 512);                   \
    rv0 = *(const uint4*)(vgp + kt__ * 64);                                        \
    rv1 = *(const uint4*)(vgp + (size_t)32 * SEQL + kt__ * 64);                    \
    if (MLA) rp = *(const uint4*)(pgp + (size_t)(kt__ * 64) * 32);                 \
  }
#define ATT_SWRITE(buf_)                                                           \
  {                                                                                \
    bf16_t* dK = sK + (buf_) * 64 * KSTR;                                          \
    bf16_t* dV = sV + (buf_) * 64 * VSTR;                                          \
    *(uint4*)(dK + prow * KSTR + pch * 8) = rk0;                                   \
    *(uint4*)(dK + (prow + 32) * KSTR + pch * 8) = rk1;                            \
    uint2* dv0 = (uint2*)(dV + prow * VSTR + pch * 8);                             \
    dv0[0] = make_uint2(rv0.x, rv0.y); dv0[1] = make_uint2(rv0.z, rv0.w);          \
    uint2* dv1 = (uint2*)(dV + (prow + 32) * VSTR + pch * 8);                      \
    dv1[0] = make_uint2(rv1.x, rv1.y); dv1[1] = make_uint2(rv1.z, rv1.w);          \
    if (MLA) *(uint4*)(dK + (tid >> 2) * KSTR + 64 + (tid & 3) * 8) = rp;          \
  }

  ATT_GLOAD(MLA ? 0 : nt - 1);
  ATT_SWRITE(0);
  __syncthreads();
  bool alive = true;
  for (int it = 0; alive; ++it) {
    const int kt = MLA ? it : (nt - 1 - it);
    const int cur = it & 1;
    const bool more = (it + 1 < nt);
    if (more) ATT_GLOAD(MLA ? it + 1 : nt - 2 - it);
    const bf16_t* cK = sK + cur * 64 * KSTR;
    const bf16_t* cV = sV + cur * 64 * VSTR;
#pragma unroll
    for (int si = 0; si < 2; ++si) {
      const int sub = MLA ? si : (1 - si);
      const int kb = kt * 64 + sub * 32;
      if (kb > qw) continue;
      const bool diag = (kb == qw);
      f32x16 s;
#pragma unroll
      for (int i = 0; i < 16; ++i) s[i] = 0.f;
#pragma unroll
      for (int ks = 0; ks < NKS; ++ks) {
        const bf16x8 kf = *(const bf16x8*)(cK + (sub * 32 + r) * KSTR + ks * 16 + hh * 8);
        s = MFMA(kf, qf[ks], s);
      }
      bf16x8 pf[2];
      if (!MLA) {
        float sp[16];
        float tsum = 0.f;
#pragma unroll
        for (int i = 0; i < 16; ++i) {
          const float z = s[i];
          float v = fmaxf(z, 0.f) + __builtin_amdgcn_logf(1.f + __builtin_amdgcn_exp2f(-fabsf(z)));
          if (diag && !(crow(i, hh) < r)) v = 0.f;
          sp[i] = v;
          tsum += v;
        }
        f32x16 cacc;
#pragma unroll
        for (int i = 0; i < 16; ++i) cacc[i] = carry;
        cacc = MFMA(tf[0], pack8(sp[0], sp[1], sp[2], sp[3], sp[4], sp[5], sp[6], sp[7]), cacc);
        cacc = MFMA(tf[1], pack8(sp[8], sp[9], sp[10], sp[11], sp[12], sp[13], sp[14], sp[15]), cacc);
        float pr[16];
#pragma unroll
        for (int i = 0; i < 16; ++i) {
          float v = __builtin_amdgcn_exp2f(s[i] - cacc[i]);
          if (diag && !(crow(i, hh) < r)) v = 0.f;
          pr[i] = v;
        }
        carry += half_sum(tsum);
        pf[0] = pack8(pr[0], pr[1], pr[2], pr[3], pr[4], pr[5], pr[6], pr[7]);
        pf[1] = pack8(pr[8], pr[9], pr[10], pr[11], pr[12], pr[13], pr[14], pr[15]);
      } else {
        float mloc = -1e30f;
#pragma unroll
        for (int i = 0; i < 16; ++i) {
          if (diag && !(crow(i, hh) <= r)) s[i] = -1e30f;
          mloc = fmaxf(mloc, s[i]);
        }
        mloc = half_max(mloc);
        const float mnew = fmaxf(mrun, mloc);
        const float alpha = __builtin_amdgcn_exp2f(mrun - mnew);
        mrun = mnew;
        float pr[16];
        float psum = 0.f;
#pragma unroll
        for (int i = 0; i < 16; ++i) { pr[i] = __builtin_amdgcn_exp2f(s[i] - mnew); psum += pr[i]; }
        lrun = lrun * alpha + psum;
#pragma unroll
        for (int i = 0; i < 16; ++i) { oacc[0][i] *= alpha; oacc[1][i] *= alpha; }
        pf[0] = pack8(pr[0], pr[1], pr[2], pr[3], pr[4], pr[5], pr[6], pr[7]);
        pf[1] = pack8(pr[8], pr[9], pr[10], pr[11], pr[12], pr[13], pr[14], pr[15]);
      }
#pragma unroll
      for (int dt = 0; dt < 2; ++dt)
#pragma unroll
        for (int st = 0; st < 2; ++st) {
          const bf16_t* vp = cV + (dt * 32 + r) * VSTR + sub * 32 + st * 16 + 4 * hh;
          const s16x4 lo = *(const s16x4*)vp;
          const s16x4 hi = *(const s16x4*)(vp + 8);
          const bf16x8 vf = __builtin_shufflevector(lo, hi, 0, 1, 2, 3, 4, 5, 6, 7);
          oacc[dt] = MFMA(vf, pf[st], oacc[dt]);
        }
    }
    if (more) ATT_SWRITE(cur ^ 1);
    if (!MLA) {
      int* flg = (int*)(smem + SMEM_BYTES - 64) + (it & 1) * 4;
      const bool wok = (__builtin_amdgcn_ballot_w64(carry >= 160.f) == ~0ull);
      if (lane == 0) flg[w] = wok ? 1 : 0;
      __syncthreads();
      alive = more && ((flg[0] & flg[1] & flg[2] & flg[3]) == 0);
    } else {
      __syncthreads();
      alive = more;
    }
  }
  float inv = 1.f;
  if (MLA) { const float lt = half_sum(lrun); inv = 1.f / lt; }
  const int tok = tok0 + w * 32 + r;
  const bf16_t* zg = (MLA ? p.Zmla : p.Zsb) + (size_t)tok * 512 + h * 64;
  bf16_t* og = (MLA ? p.OBg : p.OAg) + (size_t)tok * 512 + h * 64;
#pragma unroll
  for (int dt = 0; dt < 2; ++dt)
#pragma unroll
    for (int g = 0; g < 4; ++g) {
      const int d = dt * 32 + 8 * g + 4 * hh;
      const u32x2 zz = *(const u32x2*)(zg + d);
      const float z0 = __uint_as_float(zz[0] << 16), z1 = __uint_as_float(zz[0] & 0xffff0000u);
      const float z2 = __uint_as_float(zz[1] << 16), z3 = __uint_as_float(zz[1] & 0xffff0000u);
      u32x2 o;
      o[0] = pk2(oacc[dt][4 * g] * inv * z0, oacc[dt][4 * g + 1] * inv * z1);
      o[1] = pk2(oacc[dt][4 * g + 2] * inv * z2, oacc[dt][4 * g + 3] * inv * z3);
      *(u32x2*)(og + d) = o;
    }
}

DI void phase_attn(const Params& p, char* smem, int cidx, int only) {
  int* s_item = (int*)(smem + SMEM_BYTES - 16);
  for (;;) {
    if (threadIdx.x == 0) *s_item = atomicAdd(p.counter + cidx, 1);
    __syncthreads();
    const int item = *s_item;
    __syncthreads();
    if (item >= 2048) break;
    const int it2 = item & 1023;
    const int qb = 31 - (it2 >> 5);
    const int bh = it2 & 31;
    if (item < 1024) { if (only != 2) attn_item<true>(p, bh >> 3, bh & 7, qb, smem); }
    else { if (only != 1) attn_item<false>(p, bh >> 3, bh & 7, qb, smem); }
  }
}

DI void phase_g3(const Params& p, char* smem) {
  bf16_t* sA = (bf16_t*)smem;
  bf16_t* sB = sA + 2 * GBUF;
  float* rs = (float*)(smem + 4 * GBUF * 2);
  for (int t = blockIdx.x; t < 128 * 8; t += gridDim.x) {
    const int rt = t >> 3, ct = t & 7, m0 = rt * 128, n0 = ct * 128;
    f32x16 acc[2][2];
    unsigned ya[2][2][8];
    zero_acc(acc);
    gemm_mainloop<false>(p.OAg + (size_t)m0 * 512, 512, p.WaT + (size_t)n0 * 512, 512, 512, sA, sB, acc, rs);
    const int lane = threadIdx.x & 63, w = threadIdx.x >> 6;
    const int wm = w >> 1, wn = w & 1, r = lane & 31, hh = lane >> 5;
#pragma unroll
    for (int mt = 0; mt < 2; ++mt)
#pragma unroll
      for (int nt = 0; nt < 2; ++nt) {
        const bf16_t* gp = p.GA + (size_t)(m0 + wm * 64 + mt * 32 + 4 * hh) * 1024 + n0 + wn * 64 + nt * 32 + r;
#pragma unroll
        for (int i = 0; i < 16; i += 2) {
          const float g0 = bf2f(gp[(size_t)((i & 3) + 8 * (i >> 2)) * 1024]);
          const float g1 = bf2f(gp[(size_t)(((i + 1) & 3) + 8 * ((i + 1) >> 2)) * 1024]);
          ya[mt][nt][i >> 1] = pk2(acc[mt][nt][i] * g0, acc[mt][nt][i + 1] * g1);
        }
      }
    zero_acc(acc);
    gemm_mainloop<false>(p.OBg + (size_t)m0 * 512, 512, p.WbT + (size_t)n0 * 512, 512, 512, sA, sB, acc, rs);
#pragma unroll
    for (int mt = 0; mt < 2; ++mt)
#pragma unroll
      for (int nt = 0; nt < 2; ++nt) {
        const size_t eoff = (size_t)(m0 + wm * 64 + mt * 32 + 4 * hh) * 1024 + n0 + wn * 64 + nt * 32 + r;
#pragma unroll
        for (int i = 0; i < 16; ++i) {
          const size_t o = eoff + (size_t)((i & 3) + 8 * (i >> 2)) * 1024;
          const unsigned u = ya[mt][nt][i >> 1];
          const float y = (i & 1) ? __uint_as_float(u & 0xffff0000u) : __uint_as_float(u << 16);
          const float v = y + acc[mt][nt][i] * bf2f(p.GB[o]);
          p.MERGED[o] = tobf(v);
        }
      }
  }
}

DI void phase_g4(const Params& p, char* smem) {
  bf16_t* sA = (bf16_t*)smem;
  bf16_t* sB = sA + 2 * GBUF;
  float* rs = (float*)(smem + 4 * GBUF * 2);
  for (int t = blockIdx.x; t < 128 * 8; t += gridDim.x) {
    const int rt = t >> 3, ct = t & 7, m0 = rt * 128, n0 = ct * 128;
    f32x16 acc[2][2];
    zero_acc(acc);
    gemm_mainloop<false>(p.MERGED + (size_t)m0 * 1024, 1024, p.WoT + (size_t)n0 * 1024, 1024, 1024, sA, sB, acc, rs);

    const int lane = threadIdx.x & 63, w = threadIdx.x >> 6;
    const int wm = w >> 1, wn = w & 1, r = lane & 31, hh = lane >> 5;
#pragma unroll
    for (int mt = 0; mt < 2; ++mt)
#pragma unroll
      for (int nt = 0; nt < 2; ++nt) {
        const int col = n0 + wn * 64 + nt * 32 + r;
        const float gt = mod_get(p.MOD, m0 >> 12, 2048 + col);
#pragma unroll
        for (int i = 0; i < 16; ++i) {
          const int row = m0 + wm * 64 + mt * 32 + crow(i, hh);
          p.out[(size_t)row * 1024 + col] = p.x[(size_t)row * 1024 + col] + gt * acc[mt][nt][i];
        }
      }
  }
}

DI void phase_final(const Params& p) {
  const int lane = threadIdx.x & 63, w = threadIdx.x >> 6;
  const int gw = blockIdx.x * 4 + w, nw = gridDim.x * 4;
  for (int row = gw; row < NTOK; row += nw) {
    float* xr = p.out + (size_t)row * DM;
    float4 v[4];
    float ss = 0.f;
#pragma unroll
    for (int i = 0; i < 4; ++i) {
      v[i] = *(const float4*)(xr + 4 * (lane + 64 * i));
      ss += v[i].x * v[i].x + v[i].y * v[i].y + v[i].z * v[i].z + v[i].w * v[i].w;
    }
#pragma unroll
    for (int o = 32; o >= 1; o >>= 1) ss += __shfl_xor(ss, o);
    const float rn = __builtin_amdgcn_rsqf(ss * (1.f / DM) + EPSN);
#pragma unroll
    for (int i = 0; i < 4; ++i) {
      const int e = 4 * (lane + 64 * i);
      const float4 g = *(const float4*)(p.fgain + e);
      float4 o;
      o.x = v[i].x * rn * g.x; o.y = v[i].y * rn * g.y; o.z = v[i].z * rn * g.z; o.w = v[i].w * rn * g.w;
      *(float4*)(xr + e) = o;
    }
  }
}

template <int PH>
__global__ void __launch_bounds__(NTHREADS, 2) mega_kernel(Params p) {
  __shared__ __attribute__((aligned(16))) char smem[SMEM_BYTES];
  if (PH < 0) {
    cg::grid_group grid = cg::this_grid();
    phase_prep(p, smem); grid.sync();
    phase_h(p); grid.sync();
    phase_g1(p, smem); grid.sync();
#if PROBE_DUP == 1
    phase_g1(p, smem); grid.sync();
#endif
    phase_g2(p, smem); grid.sync();
    phase_attn(p, smem, 0, 0); grid.sync();
#if PROBE_DUP == 2
    phase_attn(p, smem, 1, 1); grid.sync();
#endif
#if PROBE_DUP == 3
    phase_attn(p, smem, 1, 2); grid.sync();
#endif
    phase_g3(p, smem); grid.sync();
    phase_g4(p, smem); grid.sync();
    phase_final(p);
  } else {
    if (PH == 0) phase_prep(p, smem);
    if (PH == 1) phase_h(p);
    if (PH == 2) phase_g1(p, smem);
    if (PH == 3) phase_g2(p, smem);
    if (PH == 4) phase_attn(p, smem, 0, 0);
    if (PH == 5) phase_g3(p, smem);
    if (PH == 6) phase_g4(p, smem);
    if (PH == 7) phase_final(p);
  }
}

#ifndef PROBE_DUP
#define PROBE_DUP 0
#endif
#ifndef MK_SPLIT
#define MK_SPLIT 0
#endif

extern "C" void kernel_launch(void* const* d_in, const int* in_sizes, int n_in, void* d_out, int out_size, void* d_ws, size_t ws_size, hipStream_t stream) {
  Params p{};
  p.x = (const float*)d_in[0]; p.c = (const float*)d_in[1]; p.pos = (const int*)d_in[2];
  p.w_ada = (const float*)d_in[3]; p.b_ada = (const float*)d_in[4]; p.norm_gain = (const float*)d_in[5];
  p.w_in = (const float*)d_in[6]; p.q_gain = (const float*)d_in[7]; p.w_uq = (const float*)d_in[8];
  p.kv_gain = (const float*)d_in[9]; p.w_ukv = (const float*)d_in[10]; p.w_a = (const float*)d_in[11];
  p.w_b = (const float*)d_in[12]; p.w_out = (const float*)d_in[13]; p.fgain = (const float*)d_in[14];
  p.out = (float*)d_out;
  char* ws = (char*)d_ws;
  size_t off = 0;
  auto take = [&](size_t bytes) { char* r = ws + off; off += (bytes + 255) & ~(size_t)255; return r; };
  p.counter = (int*)take(256);
  p.MOD = (float*)take(4 * 3072 * 4 * 4);
  p.ROPE = (float*)take((size_t)NTOK * 32 * 4);
  p.Hb = (bf16_t*)take((size_t)NTOK * 1024 * 2);
  p.MERGED = p.Hb;
  p.Qmla = (bf16_t*)take((size_t)NTOK * 768 * 2);
  p.WinT = p.Qmla;
  p.WuqT = (bf16_t*)take((size_t)768 * 384 * 2);
  p.WukvT = (bf16_t*)take((size_t)1024 * 256 * 2);
  p.WaT = (bf16_t*)take((size_t)1024 * 512 * 2);
  p.WbT = (bf16_t*)take((size_t)1024 * 512 * 2);
  p.WoT = (bf16_t*)take((size_t)1024 * 1024 * 2);
  p.Qsb = (bf16_t*)take((size_t)NTOK * 512 * 2);
  p.Ksb = (bf16_t*)take((size_t)NTOK * 512 * 2);
  p.VTsb = (bf16_t*)take((size_t)NTOK * 512 * 2);
  p.Zsb = (bf16_t*)take((size_t)NTOK * 512 * 2);
  p.OAg = (bf16_t*)take((size_t)NTOK * 512 * 2);
  p.OBg = (bf16_t*)take((size_t)NTOK * 512 * 2);
  p.CQ = p.OAg;
  p.CKV = p.OBg;
  p.Zmla = (bf16_t*)take((size_t)NTOK * 512 * 2);
  p.KPE = (bf16_t*)take((size_t)NTOK * 32 * 2);
  p.Knope = (bf16_t*)take((size_t)NTOK * 512 * 2);
  p.VTmla = (bf16_t*)take((size_t)NTOK * 512 * 2);
  p.GA = (bf16_t*)d_out;
  p.GB = p.GA + (size_t)NTOK * 1024;
  if (off > ws_size) { fprintf(stderr, "workspace too small: need %zu have %zu\n", off, ws_size); return; }

  static int grid_blocks = 0;
  if (!grid_blocks) {
    int dev = 0, cus = 0, per_cu = 0;
    hipGetDevice(&dev);
    hipDeviceGetAttribute(&cus, hipDeviceAttributeMultiprocessorCount, dev);
    hipOccupancyMaxActiveBlocksPerMultiprocessor(&per_cu, mega_kernel<-1>, NTHREADS, 0);
    if (per_cu > 2) per_cu = 2;
    if (per_cu < 1) per_cu = 1;
    grid_blocks = cus * per_cu;
  }
#if MK_SPLIT
  mega_kernel<0><<<grid_blocks, NTHREADS, 0, stream>>>(p);
  mega_kernel<1><<<grid_blocks, NTHREADS, 0, stream>>>(p);
  mega_kernel<2><<<grid_blocks, NTHREADS, 0, stream>>>(p);
  mega_kernel<3><<<grid_blocks, NTHREADS, 0, stream>>>(p);
  mega_kernel<4><<<grid_blocks, NTHREADS, 0, stream>>>(p);
  mega_kernel<5><<<grid_blocks, NTHREADS, 0, stream>>>(p);
  mega_kernel<6><<<grid_blocks, NTHREADS, 0, stream>>>(p);
  mega_kernel<7><<<grid_blocks, NTHREADS, 0, stream>>>(p);
#else
  void* args[] = {&p};
  hipError_t e = hipLaunchCooperativeKernel((void*)mega_kernel<-1>, dim3(grid_blocks), dim3(NTHREADS), args, 0, stream);
  if (e != hipSuccess) fprintf(stderr, "cooperative launch failed: %s (grid %d)\n", hipGetErrorString(e), grid_blocks);
#endif
}
```

```cpp
#include <hip/hip_runtime.h>
#include <hip/hip_cooperative_groups.h>
#include <stdint.h>
#include <stdio.h>
namespace cg = cooperative_groups;
#ifndef PROBE_DUP
#define PROBE_DUP 0
#endif

#define DI __device__ __forceinline__
typedef unsigned short bf16_t;
typedef __attribute__((ext_vector_type(8))) short bf16x8;
typedef __attribute__((ext_vector_type(4))) short s16x4;
typedef __attribute__((ext_vector_type(16))) float f32x16;
typedef __attribute__((ext_vector_type(2))) float f32x2;
typedef __attribute__((ext_vector_type(2))) __bf16 bf16x2v;
typedef __attribute__((ext_vector_type(4))) unsigned u32x4;
typedef __attribute__((ext_vector_type(2))) unsigned u32x2;
#define MFMA(a, b, c) __builtin_amdgcn_mfma_f32_32x32x16_bf16((a), (b), (c), 0, 0, 0)

constexpr int NTOK = 16384, SEQL = 4096, DM = 1024;
constexpr int INW = 5280, INWP = 5376;
constexpr int NTHREADS = 256;
constexpr float LOG2E = 1.4426950408889634f;
constexpr float QS_SCALE = 0.125f * 1.4426950408889634f;
constexpr float QM_SCALE = 1.4426950408889634f / 9.797958971132712f;
constexpr float EPSN = 1e-6f;

struct Params {
  const float *x, *c; const int* pos;
  const float *w_ada, *b_ada, *norm_gain, *w_in, *q_gain, *w_uq, *kv_gain, *w_ukv, *w_a, *w_b, *w_out, *fgain;
  float* out;
  bf16_t *Hb, *WinT, *WuqT, *WukvT, *WaT, *WbT, *WoT;
  float *MOD, *ROPE, *SSQ;
  bf16_t *Qsb, *Ksb, *VTsb, *Zsb, *CQ, *CKV, *Zmla, *GA, *GB, *KPE, *Qmla, *Knope, *VTmla, *OAg, *OBg, *MERGED;
  int* counter;
};

__device__ const float c_invfreq[16] = {
  1.0f, 0.5623413251903491f, 0.31622776601683794f, 0.1778279410038923f, 0.1f, 0.05623413251903491f, 0.03162277660168379f,
  0.01778279410038923f, 0.01f, 0.005623413251903491f, 0.0031622776601683794f, 0.001778279410038923f, 0.001f,
  0.0005623413251903491f, 0.00031622776601683794f, 0.0001778279410038923f};

DI unsigned pk2(float a, float b) { f32x2 v = {a, b}; bf16x2v r = __builtin_convertvector(v, bf16x2v); return __builtin_bit_cast(unsigned, r); }
DI bf16_t tobf(float a) { return (bf16_t)(pk2(a, 0.f) & 0xffffu); }
DI float bf2f(unsigned short u) { return __uint_as_float(((unsigned)u) << 16); }
DI bf16x8 pack8(float a0, float a1, float a2, float a3, float a4, float a5, float a6, float a7) {
  u32x4 p; p[0] = pk2(a0, a1); p[1] = pk2(a2, a3); p[2] = pk2(a4, a5); p[3] = pk2(a6, a7);
  return __builtin_bit_cast(bf16x8, p);
}
DI int crow(int reg, int h) { return (reg & 3) + 8 * (reg >> 2) + 4 * h; }
DI float half_max(float v) {
  unsigned u = __float_as_uint(v);
  auto r = __builtin_amdgcn_permlane32_swap(u, u, false, false);
  return fmaxf(__uint_as_float(r[0]), __uint_as_float(r[1]));
}
DI float half_sum(float v) {
  unsigned u = __float_as_uint(v);
  auto r = __builtin_amdgcn_permlane32_swap(u, u, false, false);
  return __uint_as_float(r[0]) + __uint_as_float(r[1]);
}
DI float sigmoidf_fast(float v) { return __builtin_amdgcn_rcpf(1.f + __builtin_amdgcn_exp2f(-v * LOG2E)); }
DI float siluf_fast(float v) { return v * sigmoidf_fast(v); }

constexpr int GSTR = 72;
constexpr int GBUF = 128 * GSTR;
constexpr int SMEM_BYTES = 4 * GBUF * 2 + 1024;

template <bool ROWSS>
DI void gemm_mainloop(const bf16_t* __restrict__ A, int lda, const bf16_t* __restrict__ B, int ldb, int K,
                      bf16_t* sA, bf16_t* sB, f32x16 (&acc)[2][2], float* rs) {
  const int tid = threadIdx.x, lane = tid & 63, w = tid >> 6;
  const int wm = w >> 1, wn = w & 1, r = lane & 31, hh = lane >> 5;
  const int lrow = tid >> 3, lch = tid & 7;
  const bf16_t* pa = A + (size_t)lrow * lda + lch * 8;
  const bf16_t* pb = B + (size_t)lrow * ldb + lch * 8;
  const size_t a32 = (size_t)32 * lda, b32 = (size_t)32 * ldb;
  uint4 xa0, xa1, xa2, xa3, xb0, xb1, xb2, xb3, ya0, ya1, ya2, ya3, yb0, yb1, yb2, yb3;
  float ss0 = 0.f, ss1 = 0.f, ss2 = 0.f, ss3 = 0.f;
  const int nk = K >> 6;
#define G_LOAD(P, ko)                                                                                                    \
  { P##a0 = *(const uint4*)(pa + (ko)); P##a1 = *(const uint4*)(pa + a32 + (ko)); P##a2 = *(const uint4*)(pa + 2 * a32 + (ko)); \
    P##a3 = *(const uint4*)(pa + 3 * a32 + (ko)); P##b0 = *(const uint4*)(pb + (ko)); P##b1 = *(const uint4*)(pb + b32 + (ko)); \
    P##b2 = *(const uint4*)(pb + 2 * b32 + (ko)); P##b3 = *(const uint4*)(pb + 3 * b32 + (ko)); }
#define G_SSQ(v, s) { unsigned u_[4] = {v.x, v.y, v.z, v.w}; _Pragma("unroll") for (int j_ = 0; j_ < 4; ++j_) { \
    const float lo_ = __uint_as_float(u_[j_] << 16), hi_ = __uint_as_float(u_[j_] & 0xffff0000u); s += lo_ * lo_ + hi_ * hi_; } }
#define G_WRITE(P, bufo)                                                                                                 \
  { *(uint4*)(sA + (bufo) + woff) = P##a0; *(uint4*)(sA + (bufo) + woff + 32 * GSTR) = P##a1;                            \
    *(uint4*)(sA + (bufo) + woff + 64 * GSTR) = P##a2; *(uint4*)(sA + (bufo) + woff + 96 * GSTR) = P##a3;                \
    *(uint4*)(sB + (bufo) + woff) = P##b0; *(uint4*)(sB + (bufo) + woff + 32 * GSTR) = P##b1;                            \
    *(uint4*)(sB + (bufo) + woff + 64 * GSTR) = P##b2; *(uint4*)(sB + (bufo) + woff + 96 * GSTR) = P##b3;                \
    if (ROWSS) { G_SSQ(P##a0, ss0) G_SSQ(P##a1, ss1) G_SSQ(P##a2, ss2) G_SSQ(P##a3, ss3) } }
#define G_COMPUTE(bufo)                                                                                                  \
  { const bf16_t* cA = sA + (bufo) + (wm * 64 + r) * GSTR + hh * 8;                                                      \
    const bf16_t* cB = sB + (bufo) + (wn * 64 + r) * GSTR + hh * 8;                                                      \
    _Pragma("unroll") for (int kk = 0; kk < 4; ++kk) {                                                                   \
      const bf16x8 a0 = *(const bf16x8*)(cA + kk * 16), a1 = *(const bf16x8*)(cA + 32 * GSTR + kk * 16);                 \
      const bf16x8 b0 = *(const bf16x8*)(cB + kk * 16), b1 = *(const bf16x8*)(cB + 32 * GSTR + kk * 16);                 \
      acc[0][0] = MFMA(a0, b0, acc[0][0]); acc[0][1] = MFMA(a0, b1, acc[0][1]);                                          \
      acc[1][0] = MFMA(a1, b0, acc[1][0]); acc[1][1] = MFMA(a1, b1, acc[1][1]); } }
  const int woff = lrow * GSTR + lch * 8;
  G_LOAD(x, 0)
  G_LOAD(y, 64)
  G_WRITE(x, 0)
  __syncthreads();
  for (int ks = 0; ks < nk; ks += 2) {
    if (ks + 2 < nk) G_LOAD(x, (ks + 2) * 64)
    G_COMPUTE(0)
    G_WRITE(y, GBUF)
    __syncthreads();
    if (ks + 3 < nk) G_LOAD(y, (ks + 3) * 64)
    G_COMPUTE(GBUF)
    if (ks + 2 < nk) G_WRITE(x, 0)
    __syncthreads();
  }
#undef G_LOAD
#undef G_SSQ
#undef G_WRITE
#undef G_COMPUTE
  if (ROWSS) {
    float sv[4] = {ss0, ss1, ss2, ss3};
#pragma unroll
    for (int i = 0; i < 4; ++i) {
      float v = sv[i];
      v += __shfl_xor(v, 1); v += __shfl_xor(v, 2); v += __shfl_xor(v, 4);
      if (lch == 0) rs[lrow + 32 * i] = __builtin_amdgcn_rsqf(v / (float)K + EPSN);
    }
  }
}

DI void zero_acc(f32x16 (&acc)[2][2]) {
#pragma unroll
  for (int a = 0; a < 2; ++a)
#pragma unroll
    for (int b = 0; b < 2; ++b)
#pragma unroll
      for (int i = 0; i < 16; ++i) acc[a][b][i] = 0.f;
}

constexpr int CSTR = 132;
DI void acc_to_lds(f32x16 (&acc)[2][2], float* sC) {
  const int lane = threadIdx.x & 63, w = threadIdx.x >> 6;
  const int wm = w >> 1, wn = w & 1, r = lane & 31, hh = lane >> 5;
#pragma unroll
  for (int mt = 0; mt < 2; ++mt)
#pragma unroll
    for (int nt = 0; nt < 2; ++nt)
#pragma unroll
      for (int i = 0; i < 16; ++i) sC[(wm * 64 + mt * 32 + crow(i, hh)) * CSTR + wn * 64 + nt * 32 + r] = acc[mt][nt][i];
}
template <class F>
DI void epi_rows(const float* sC, F f) {
#pragma unroll
  for (int i = 0; i < 8; ++i) {
    const int c = threadIdx.x + 256 * i, row = c >> 4, cc = (c & 15) * 8;
    const float4 a = *(const float4*)(sC + row * CSTR + cc), b = *(const float4*)(sC + row * CSTR + cc + 4);
    const float v[8] = {a.x, a.y, a.z, a.w, b.x, b.y, b.z, b.w};
    f(i, row, cc, v);
  }
}
DI void store8(bf16_t* p, const float (&v)[8]) { *(bf16x8*)p = pack8(v[0], v[1], v[2], v[3], v[4], v[5], v[6], v[7]); }
DI void epi_vt(const float* sC, bf16_t* VT, int m0, int head0, int c0, int ncol_log2) {
  const int b = m0 >> 12, s0 = m0 & 4095;
  const int nitems = 16 << ncol_log2;
  for (int c = threadIdx.x; c < nitems; c += 256) {
    const int col = c & ((1 << ncol_log2) - 1), rc = c >> ncol_log2;
    float v[8];
#pragma unroll
    for (int j = 0; j < 8; ++j) v[j] = sC[(rc * 8 + j) * CSTR + c0 + col];
    const int head = head0 + (col >> 6), d = col & 63;
    store8(VT + ((size_t)((b * 8 + head) * 64 + d)) * SEQL + s0 + rc * 8, v);
  }
}
DI void rope8(const float* sC, const float* ROPE, int tok, int row, int cc, float (&v)[8]) {
  const float* pr = sC + row * CSTR + (cc ^ 16);
  const bool upper = (cc & 16) != 0;
  const int f0 = cc & 15;
  const float* tb = ROPE + (size_t)tok * 32;
#pragma unroll
  for (int j = 0; j < 8; ++j) {
    const float o = pr[j], cs = tb[f0 + j], sn = tb[16 + f0 + j];
    v[j] = upper ? (o * sn + v[j] * cs) : (v[j] * cs - o * sn);
  }
}

DI void wconv_unit(const float* __restrict__ src, int Nsrc, int K, bf16_t* __restrict__ dst, const float* __restrict__ gain, int ng, int kg, int mode, float* tile) {
  const int tid = threadIdx.x;
  {
    const int k = tid >> 2, cq = tid & 3;
    const int n = ng * 64 + cq * 16;
    int sc = n;
    if (mode == 1) { sc = (n < 2688) ? n : (n < 5248 ? n + 32 : (n < 5280 ? n - 2560 : -1)); }
    const int kk = kg * 64 + k;
    float4 v[4];
    if (sc >= 0) {
      const float* sp = src + (size_t)kk * Nsrc + sc;
#pragma unroll
      for (int i = 0; i < 4; ++i) v[i] = *(const float4*)(sp + 4 * i);
      if (gain) { const float g = gain[kk];
#pragma unroll
        for (int i = 0; i < 4; ++i) { v[i].x *= g; v[i].y *= g; v[i].z *= g; v[i].w *= g; } }
    } else {
#pragma unroll
      for (int i = 0; i < 4; ++i) v[i] = make_float4(0.f, 0.f, 0.f, 0.f);
    }
    float* tp = tile + k * 65 + cq * 16;
#pragma unroll
    for (int i = 0; i < 4; ++i) { tp[4 * i] = v[i].x; tp[4 * i + 1] = v[i].y; tp[4 * i + 2] = v[i].z; tp[4 * i + 3] = v[i].w; }
  }
  __syncthreads();
  {
    const int n = tid >> 2, kc = tid & 3;
    float o[16];
#pragma unroll
    for (int j = 0; j < 16; ++j) o[j] = tile[(kc * 16 + j) * 65 + n];
    bf16_t* dp = dst + (size_t)(ng * 64 + n) * K + kg * 64 + kc * 16;
    *(bf16x8*)dp = pack8(o[0], o[1], o[2], o[3], o[4], o[5], o[6], o[7]);
    *(bf16x8*)(dp + 8) = pack8(o[8], o[9], o[10], o[11], o[12], o[13], o[14], o[15]);
  }
  __syncthreads();
}

DI void phase_prep(const Params& p, char* smem) {
  const int tid = threadIdx.x;
  if (blockIdx.x == 0 && tid == 0) { p.counter[0] = 0; p.counter[1] = 0; }
  for (int i = blockIdx.x * NTHREADS + tid; i < 2 * NTOK; i += gridDim.x * NTHREADS) p.SSQ[i] = 0.f;
  constexpr int U_MOD = 96 * 4, U_WIN = 84 * 16, U_WUQ = 12 * 6, U_WUKV = 16 * 4, U_WA = 16 * 8, U_WB = 16 * 8, U_WO = 16 * 16, U_ROPE = 1024;
  constexpr int U_TOTAL = U_MOD + U_ROPE + U_WIN + U_WUQ + U_WUKV + U_WA + U_WB + U_WO;
  float* tile = (float*)smem;
  for (int u = blockIdx.x; u < U_TOTAL; u += gridDim.x) {
    int v = u;
    if (v < U_MOD) {
      const int cg32 = v >> 2, kq = v & 3, n0 = cg32 * 32;
      const int kgp = tid >> 5, col = tid & 31;
      const int kb = kq * 256 + kgp * 32;
      float a0 = 0.f, a1 = 0.f, a2 = 0.f, a3 = 0.f;
      const float* wp = p.w_ada + (size_t)kb * 3072 + n0 + col;
      float wv[32];
#pragma unroll
      for (int kk = 0; kk < 32; ++kk) wv[kk] = wp[(size_t)kk * 3072];
#pragma unroll
      for (int kk = 0; kk < 32; ++kk) {
        a0 += wv[kk] * p.c[kb + kk]; a1 += wv[kk] * p.c[1024 + kb + kk]; a2 += wv[kk] * p.c[2048 + kb + kk]; a3 += wv[kk] * p.c[3072 + kb + kk];
      }
      float* red = (float*)smem;
      red[(kgp * 4 + 0) * 32 + col] = a0; red[(kgp * 4 + 1) * 32 + col] = a1; red[(kgp * 4 + 2) * 32 + col] = a2; red[(kgp * 4 + 3) * 32 + col] = a3;
      __syncthreads();
      if (tid < 128) {
        const int b = tid >> 5, cc = tid & 31;
        float s = (kq == 0) ? p.b_ada[n0 + cc] : 0.f;
#pragma unroll
        for (int g = 0; g < 8; ++g) s += red[(g * 4 + b) * 32 + cc];
        p.MOD[(size_t)(b * 3072 + n0 + cc) * 4 + kq] = s;
      }
      __syncthreads();
      continue;
    }
    v -= U_MOD;
    if (v < U_WIN) { wconv_unit(p.w_in, INW, 1024, p.WinT, nullptr, v >> 4, v & 15, 1, tile); continue; }
    v -= U_WIN;
    if (v < U_WUQ) { wconv_unit(p.w_uq, 768, 384, p.WuqT, p.q_gain, v / 6, v % 6, 0, tile); continue; }
    v -= U_WUQ;
    if (v < U_WUKV) { wconv_unit(p.w_ukv, 1024, 256, p.WukvT, p.kv_gain, v >> 2, v & 3, 0, tile); continue; }
    v -= U_WUKV;
    if (v < U_WA) { wconv_unit(p.w_a, 1024, 512, p.WaT, nullptr, v >> 3, v & 7, 0, tile); continue; }
    v -= U_WA;
    if (v < U_WB) { wconv_unit(p.w_b, 1024, 512, p.WbT, nullptr, v >> 3, v & 7, 0, tile); continue; }
    v -= U_WB;
    if (v < U_WO) { wconv_unit(p.w_out, 1024, 1024, p.WoT, nullptr, v >> 4, v & 15, 0, tile); continue; }
    v -= U_WO;
    {
      const int idx = v * 256 + tid, tok = idx >> 4, i = idx & 15;
      const float ang = (float)p.pos[tok] * c_invfreq[i];
      double t = (double)ang * 0.15915494309189535;
      t -= rint(t);
      const float tf = (float)t;
      p.ROPE[(size_t)tok * 32 + i] = __builtin_amdgcn_cosf(tf);
      p.ROPE[(size_t)tok * 32 + 16 + i] = __builtin_amdgcn_sinf(tf);
    }
  }
}

DI float mod_get(const float* MOD, int b, int n) { const float4 q = *(const float4*)(MOD + (size_t)(b * 3072 + n) * 4); return (q.x + q.y) + (q.z + q.w); }

DI void phase_h(const Params& p) {
  const int lane = threadIdx.x & 63, w = threadIdx.x >> 6;
  const int gw = blockIdx.x * 4 + w, nw = gridDim.x * 4;
  for (int row = gw; row < NTOK; row += nw) {
    const int b = row >> 12;
    const float* xr = p.x + (size_t)row * DM;
    float4 v[4];
    float ss = 0.f;
#pragma unroll
    for (int i = 0; i < 2; ++i) {
      const int e = 8 * (lane + 64 * i);
      v[2 * i] = *(const float4*)(xr + e);
      v[2 * i + 1] = *(const float4*)(xr + e + 4);
      ss += v[2 * i].x * v[2 * i].x + v[2 * i].y * v[2 * i].y + v[2 * i].z * v[2 * i].z + v[2 * i].w * v[2 * i].w;
      ss += v[2 * i + 1].x * v[2 * i + 1].x + v[2 * i + 1].y * v[2 * i + 1].y + v[2 * i + 1].z * v[2 * i + 1].z + v[2 * i + 1].w * v[2 * i + 1].w;
    }
#pragma unroll
    for (int o = 32; o >= 1; o >>= 1) ss += __shfl_xor(ss, o);
    const float rn = __builtin_amdgcn_rsqf(ss * (1.f / DM) + EPSN);

#pragma unroll
    for (int i = 0; i < 2; ++i) {
      const int e = 8 * (lane + 64 * i);
      float o[8];
      const float xs[8] = {v[2 * i].x, v[2 * i].y, v[2 * i].z, v[2 * i].w, v[2 * i + 1].x, v[2 * i + 1].y, v[2 * i + 1].z, v[2 * i + 1].w};
#pragma unroll
      for (int j = 0; j < 8; ++j) o[j] = xs[j] * rn * p.norm_gain[e + j] * (1.f + mod_get(p.MOD, b, 1024 + e + j)) + mod_get(p.MOD, b, e + j);
      *(bf16x8*)(p.Hb + (size_t)row * DM + e) = pack8(o[0], o[1], o[2], o[3], o[4], o[5], o[6], o[7]);
    }
  }
}

DI void phase_g1(const Params& p, char* smem) {
  bf16_t* sA = (bf16_t*)smem;
  bf16_t* sB = sA + 2 * GBUF;
  float* sC = (float*)smem;
  float* rs = (float*)(smem + 4 * GBUF * 2);
  constexpr int NCT = INWP / 128;
  const int ntiles = (NTOK / 128) * NCT;
  for (int t = blockIdx.x; t < ntiles; t += gridDim.x) {
    const int rt = t / NCT, ct = t % NCT;
    const int m0 = rt * 128, n0 = ct * 128;
    f32x16 acc[2][2];
    zero_acc(acc);
    gemm_mainloop<false>(p.Hb + (size_t)m0 * DM, DM, p.WinT + (size_t)n0 * DM, DM, DM, sA, sB, acc, rs);
    acc_to_lds(acc, sC);
    __syncthreads();
    if (ct < 4) {
      epi_rows(sC, [&](int, int row, int cc, const float (&v)[8]) {
        float o[8];
#pragma unroll
        for (int j = 0; j < 8; ++j) o[j] = v[j] * QS_SCALE;
        store8(p.Qsb + (size_t)(m0 + row) * 512 + n0 + cc, o); });
    } else if (ct < 8) {
      epi_rows(sC, [&](int, int row, int cc, const float (&v)[8]) { store8(p.Ksb + (size_t)(m0 + row) * 512 + n0 - 512 + cc, v); });
    } else if (ct < 12) {
      epi_vt(sC, p.VTsb, m0, (n0 - 1024) >> 6, 0, 7);
    } else if (ct < 16) {
      epi_rows(sC, [&](int, int row, int cc, const float (&v)[8]) {
        float o[8];
#pragma unroll
        for (int j = 0; j < 8; ++j) o[j] = siluf_fast(v[j]);
        store8(p.Zsb + (size_t)(m0 + row) * 512 + n0 - 1536 + cc, o); });
    } else if (ct < 19) {
      epi_rows(sC, [&](int, int row, int cc, const float (&v)[8]) {
        store8(p.CQ + (size_t)(m0 + row) * 384 + n0 - 2048 + cc, v);
        float q = 0.f;
#pragma unroll
        for (int j = 0; j < 8; ++j) q += v[j] * v[j];
        q += __shfl_xor(q, 1); q += __shfl_xor(q, 2); q += __shfl_xor(q, 4); q += __shfl_xor(q, 8);
        if ((threadIdx.x & 15) == 0) atomicAdd(p.SSQ + m0 + row, q); });
    } else if (ct < 21) {
      epi_rows(sC, [&](int, int row, int cc, const float (&v)[8]) {
        store8(p.CKV + (size_t)(m0 + row) * 256 + n0 - 2432 + cc, v);
        float q = 0.f;
#pragma unroll
        for (int j = 0; j < 8; ++j) q += v[j] * v[j];
        q += __shfl_xor(q, 1); q += __shfl_xor(q, 2); q += __shfl_xor(q, 4); q += __shfl_xor(q, 8);
        if ((threadIdx.x & 15) == 0) atomicAdd(p.SSQ + NTOK + m0 + row, q); });
    } else if (ct < 25) {
      epi_rows(sC, [&](int, int row, int cc, const float (&v)[8]) {
        float o[8];
#pragma unroll
        for (int j = 0; j < 8; ++j) o[j] = siluf_fast(v[j]);
        store8(p.Zmla + (size_t)(m0 + row) * 512 + n0 - 2688 + cc, o); });
    } else if (ct < 33) {
      epi_rows(sC, [&](int, int row, int cc, const float (&v)[8]) {
        float o[8];
#pragma unroll
        for (int j = 0; j < 8; ++j) o[j] = sigmoidf_fast(v[j]);
        store8(p.GA + (size_t)(m0 + row) * 1024 + n0 - 3200 + cc, o); });
    } else if (ct < 41) {
      epi_rows(sC, [&](int, int row, int cc, const float (&v)[8]) {
        float o[8];
#pragma unroll
        for (int j = 0; j < 8; ++j) o[j] = sigmoidf_fast(v[j]);
        store8(p.GB + (size_t)(m0 + row) * 1024 + n0 - 4224 + cc, o); });
    } else {
      epi_rows(sC, [&](int, int row, int cc, const float (&v)[8]) {
        if (cc < 32) {
          float o[8];
#pragma unroll
          for (int j = 0; j < 8; ++j) o[j] = v[j];
          rope8(sC, p.ROPE, m0 + row, row, cc, o);
          store8(p.KPE + (size_t)(m0 + row) * 32 + cc, o);
        } });
    }
    __syncthreads();
  }
}

DI void phase_g2(const Params& p, char* smem) {
  bf16_t* sA = (bf16_t*)smem;
  bf16_t* sB = sA + 2 * GBUF;
  float* sC = (float*)smem;
  float* rs = (float*)(smem + 4 * GBUF * 2);
  constexpr int NQ = 128 * 6, NKV = 128 * 8;
  for (int t = blockIdx.x; t < NQ + NKV; t += gridDim.x) {
    f32x16 acc[2][2];
    zero_acc(acc);
    if (t < NQ) {
      const int rt = t / 6, ct = t % 6, m0 = rt * 128, n0 = ct * 128;
      if (threadIdx.x < 128) rs[threadIdx.x] = __builtin_amdgcn_rsqf(p.SSQ[m0 + threadIdx.x] * (1.f / 384.f) + EPSN);
      gemm_mainloop<false>(p.CQ + (size_t)m0 * 384, 384, p.WuqT + (size_t)n0 * 384, 384, 384, sA, sB, acc, rs);
      acc_to_lds(acc, sC);
      __syncthreads();
      epi_rows(sC, [&](int, int row, int cc, const float (&v)[8]) {
        const int col = n0 + cc;
        float o[8];
#pragma unroll
        for (int j = 0; j < 8; ++j) o[j] = v[j];
        if (((col >> 5) % 3) == 2) rope8(sC, p.ROPE, m0 + row, row, cc, o);
        const float sc = rs[row] * QM_SCALE;
#pragma unroll
        for (int j = 0; j < 8; ++j) o[j] *= sc;
        store8(p.Qmla + (size_t)(m0 + row) * 768 + col, o);
      });
    } else {
      const int t2 = t - NQ;
      const int rt = t2 >> 3, head = t2 & 7, m0 = rt * 128, n0 = head * 128;
      if (threadIdx.x < 128) rs[threadIdx.x] = __builtin_amdgcn_rsqf(p.SSQ[NTOK + m0 + threadIdx.x] * (1.f / 256.f) + EPSN);
      gemm_mainloop<false>(p.CKV + (size_t)m0 * 256, 256, p.WukvT + (size_t)n0 * 256, 256, 256, sA, sB, acc, rs);
      acc_to_lds(acc, sC);
      __syncthreads();
      epi_rows(sC, [&](int, int row, int cc, const float (&v)[8]) {
        if (cc < 64) {
          const float sc = rs[row];
          float o[8];
#pragma unroll
          for (int j = 0; j < 8; ++j) o[j] = v[j] * sc;
          store8(p.Knope + (size_t)(m0 + row) * 512 + head * 64 + cc, o);
        } });
      {
        const int b = m0 >> 12, s0 = m0 & 4095;
        for (int c = threadIdx.x; c < 1024; c += 256) {
          const int col = c & 63, rc = c >> 6;
          float v[8];
#pragma unroll
          for (int j = 0; j < 8; ++j) v[j] = sC[(rc * 8 + j) * CSTR + 64 + col] * rs[rc * 8 + j];
          store8(p.VTmla + ((size_t)((b * 8 + head) * 64 + col)) * SEQL + s0 + rc * 8, v);
        }
      }
    }
    __syncthreads();
  }
}

constexpr int VSTR = 68;

template <bool MLA>
DI void attn_item(const Params& p, int b, int h, int qb, char* smem) {
  constexpr int DK = MLA ? 96 : 64;
  constexpr int KSTR = MLA ? 104 : 72;
  constexpr int NKS = DK / 16;
  bf16_t* sK = (bf16_t*)smem;
  bf16_t* sV = sK + 2 * 64 * KSTR;
  const int tid = threadIdx.x, lane = tid & 63, w = tid >> 6, r = lane & 31, hh = lane >> 5;
  const int tokb = b * SEQL;
  const int tok0 = tokb + qb * 128;
  const int qw = qb * 128 + w * 32;

  bf16x8 qf[NKS];
  {
    const bf16_t* qptr = MLA ? (p.Qmla + (size_t)(tok0 + w * 32 + r) * 768 + h * 96 + hh * 8) : (p.Qsb + (size_t)(tok0 + w * 32 + r) * 512 + h * 64 + hh * 8);
#pragma unroll
    for (int ks = 0; ks < NKS; ++ks) qf[ks] = *(const bf16x8*)(qptr + ks * 16);
  }
  bf16x8 tf[2];
  if (!MLA) {
#pragma unroll
    for (int st = 0; st < 2; ++st)
#pragma unroll
      for (int e = 0; e < 8; ++e) { const int j = 16 * st + 8 * (e >> 2) + 4 * hh + (e & 3); tf[st][e] = (j >= r) ? (short)0x3F80 : (short)0; }
  }

  f32x16 oacc[2];
#pragma unroll
  for (int i = 0; i < 16; ++i) { oacc[0][i] = 0.f; oacc[1][i] = 0.f; }
  float carry = 0.f;
  float mrun = -1e30f, lrun = 0.f;

  const bf16_t* Kg = MLA ? p.Knope : p.Ksb;
  const bf16_t* VTg = (MLA ? p.VTmla : p.VTsb) + (size_t)((b * 8 + h) * 64) * SEQL;
  const int nt = 2 * qb + 2;

  uint4 rk0, rk1, rv0, rv1, rp;
  rp = make_uint4(0, 0, 0, 0);
  const int prow = tid >> 3, pch = tid & 7;
  const bf16_t* kgp = Kg + (size_t)(tokb + prow) * 512 + h * 64 + pch * 8;
  const bf16_t* vgp = VTg + (size_t)prow * SEQL + pch * 8;
  const bf16_t* pgp = p.KPE + (size_t)(tokb + (tid >> 2)) * 32 + (tid & 3) * 8;
#define ATT_GLOAD(kt_)                                                             \
  {                                                                                \
    const int kt__ = (kt_);                                                        \
    rk0 = *(const uint4*)(kgp + (size_t)(kt__ * 64) * 512);                        \
    rk1 = *(const uint4*)(kgp + (size_t)(kt__ * 64 + 32) * 512);                   \
    rv0 = *(const uint4*)(vgp + kt__ * 64);                                        \
    rv1 = *(const uint4*)(vgp + (size_t)32 * SEQL + kt__ * 64);                    \
    if (MLA) rp = *(const uint4*)(pgp + (size_t)(kt__ * 64) * 32);                 \
  }
#define ATT_SWRITE(buf_)                                                           \
  {                                                                                \
    bf16_t* dK = sK + (buf_) * 64 * KSTR;                                          \
    bf16_t* dV = sV + (buf_) * 64 * VSTR;                                          \
    *(uint4*)(dK + prow * KSTR + pch * 8) = rk0;                                   \
    *(uint4*)(dK + (prow + 32) * KSTR + pch * 8) = rk1;                            \
    uint2* dv0 = (uint2*)(dV + prow * VSTR + pch * 8);                             \
    dv0[0] = make_uint2(rv0.x, rv0.y); dv0[1] = make_uint2(rv0.z, rv0.w);          \
    uint2* dv1 = (uint2*)(dV + (prow + 32) * VSTR + pch * 8);                      \
    dv1[0] = make_uint2(rv1.x, rv1.y); dv1[1] = make_uint2(rv1.z, rv1.w);          \
    if (MLA) *(uint4*)(dK + (tid >> 2) * KSTR + 64 + (tid & 3) * 8) = rp;          \
  }

  ATT_GLOAD(MLA ? 0 : nt - 1);
  ATT_SWRITE(0);
  __syncthreads();
  bool alive = true;
  for (int it = 0; alive; ++it) {
    const int kt = MLA ? it : (nt - 1 - it);
    const int cur = it & 1;
    const bool more = (it + 1 < nt);
    if (more) ATT_GLOAD(MLA ? it + 1 : nt - 2 - it);
    const bf16_t* cK = sK + cur * 64 * KSTR;
    const bf16_t* cV = sV + cur * 64 * VSTR;
#pragma unroll
    for (int si = 0; si < 2; ++si) {
      const int sub = MLA ? si : (1 - si);
      const int kb = kt * 64 + sub * 32;
      if (kb > qw) continue;
      const bool diag = (kb == qw);
      f32x16 s;
#pragma unroll
      for (int i = 0; i < 16; ++i) s[i] = 0.f;
#pragma unroll
      for (int ks = 0; ks < NKS; ++ks) {
        const bf16x8 kf = *(const bf16x8*)(cK + (sub * 32 + r) * KSTR + ks * 16 + hh * 8);
        s = MFMA(kf, qf[ks], s);
      }
      bf16x8 pf[2];
      if (!MLA) {
        float sp[16];
        float tsum = 0.f;
#pragma unroll
        for (int i = 0; i < 16; ++i) {
          const float z = s[i];
          float v = fmaxf(z, 0.f) + __builtin_amdgcn_logf(1.f + __builtin_amdgcn_exp2f(-fabsf(z)));
          if (diag && !(crow(i, hh) < r)) v = 0.f;
          sp[i] = v;
          tsum += v;
        }
        f32x16 cacc;
#pragma unroll
        for (int i = 0; i < 16; ++i) cacc[i] = carry;
        cacc = MFMA(tf[0], pack8(sp[0], sp[1], sp[2], sp[3], sp[4], sp[5], sp[6], sp[7]), cacc);
        cacc = MFMA(tf[1], pack8(sp[8], sp[9], sp[10], sp[11], sp[12], sp[13], sp[14], sp[15]), cacc);
        float pr[16];
#pragma unroll
        for (int i = 0; i < 16; ++i) {
          float v = __builtin_amdgcn_exp2f(s[i] - cacc[i]);
          if (diag && !(crow(i, hh) < r)) v = 0.f;
          pr[i] = v;
        }
        carry += half_sum(tsum);
        pf[0] = pack8(pr[0], pr[1], pr[2], pr[3], pr[4], pr[5], pr[6], pr[7]);
        pf[1] = pack8(pr[8], pr[9], pr[10], pr[11], pr[12], pr[13], pr[14], pr[15]);
      } else {
        float mloc = -1e30f;
#pragma unroll
        for (int i = 0; i < 16; ++i) {
          if (diag && !(crow(i, hh) <= r)) s[i] = -1e30f;
          mloc = fmaxf(mloc, s[i]);
        }
        mloc = half_max(mloc);
        const float mnew = fmaxf(mrun, mloc);
        const float alpha = __builtin_amdgcn_exp2f(mrun - mnew);
        mrun = mnew;
        float pr[16];
        float psum = 0.f;
#pragma unroll
        for (int i = 0; i < 16; ++i) { pr[i] = __builtin_amdgcn_exp2f(s[i] - mnew); psum += pr[i]; }
        lrun = lrun * alpha + psum;
#pragma unroll
        for (int i = 0; i < 16; ++i) { oacc[0][i] *= alpha; oacc[1][i] *= alpha; }
        pf[0] = pack8(pr[0], pr[1], pr[2], pr[3], pr[4], pr[5], pr[6], pr[7]);
        pf[1] = pack8(pr[8], pr[9], pr[10], pr[11], pr[12], pr[13], pr[14], pr[15]);
      }
#pragma unroll
      for (int dt = 0; dt < 2; ++dt)
#pragma unroll
        for (int st = 0; st < 2; ++st) {
          const bf16_t* vp = cV + (dt * 32 + r) * VSTR + sub * 32 + st * 16 + 4 * hh;
          const s16x4 lo = *(const s16x4*)vp;
          const s16x4 hi = *(const s16x4*)(vp + 8);
          const bf16x8 vf = __builtin_shufflevector(lo, hi, 0, 1, 2, 3, 4, 5, 6, 7);
          oacc[dt] = MFMA(vf, pf[st], oacc[dt]);
        }
    }
    if (more) ATT_SWRITE(cur ^ 1);
    if (!MLA) {
      int* flg = (int*)(smem + SMEM_BYTES - 64) + (it & 1) * 4;
      const bool wok = (__builtin_amdgcn_ballot_w64(carry >= 160.f) == ~0ull);
      if (lane == 0) flg[w] = wok ? 1 : 0;
      __syncthreads();
      alive = more && ((flg[0] & flg[1] & flg[2] & flg[3]) == 0);
    } else {
      __syncthreads();
      alive = more;
    }
  }
  float inv = 1.f;
  if (MLA) { const float lt = half_sum(lrun); inv = 1.f / lt; }
  const int tok = tok0 + w * 32 + r;
  const bf16_t* zg = (MLA ? p.Zmla : p.Zsb) + (size_t)tok * 512 + h * 64;
  bf16_t* og = (MLA ? p.OBg : p.OAg) + (size_t)tok * 512 + h * 64;
#pragma unroll
  for (int dt = 0; dt < 2; ++dt)
#pragma unroll
    for (int g = 0; g < 4; ++g) {
      const int d = dt * 32 + 8 * g + 4 * hh;
      const u32x2 zz = *(const u32x2*)(zg + d);
      const float z0 = __uint_as_float(zz[0] << 16), z1 = __uint_as_float(zz[0] & 0xffff0000u);
      const float z2 = __uint_as_float(zz[1] << 16), z3 = __uint_as_float(zz[1] & 0xffff0000u);
      u32x2 o;
      o[0] = pk2(oacc[dt][4 * g] * inv * z0, oacc[dt][4 * g + 1] * inv * z1);
      o[1] = pk2(oacc[dt][4 * g + 2] * inv * z2, oacc[dt][4 * g + 3] * inv * z3);
      *(u32x2*)(og + d) = o;
    }
}

DI void phase_attn(const Params& p, char* smem, int cidx, int only) {
  int* s_item = (int*)(smem + SMEM_BYTES - 16);
  for (;;) {
    if (threadIdx.x == 0) *s_item = atomicAdd(p.counter + cidx, 1);
    __syncthreads();
    const int item = *s_item;
    __syncthreads();
    if (item >= 2048) break;
    const int it2 = item & 1023;
    const int qb = 31 - (it2 >> 5);
    const int bh = it2 & 31;
    if (item < 1024) { if (only != 2) attn_item<true>(p, bh >> 3, bh & 7, qb, smem); }
    else { if (only != 1) attn_item<false>(p, bh >> 3, bh & 7, qb, smem); }
  }
}

DI void phase_g3(const Params& p, char* smem) {
  bf16_t* sA = (bf16_t*)smem;
  bf16_t* sB = sA + 2 * GBUF;
  float* sC = (float*)smem;
  float* rs = (float*)(smem + 4 * GBUF * 2);
  for (int t = blockIdx.x; t < 128 * 8; t += gridDim.x) {
    const int rt = t >> 3, ct = t & 7, m0 = rt * 128, n0 = ct * 128;
    f32x16 acc[2][2];
    zero_acc(acc);
    gemm_mainloop<false>(p.OAg + (size_t)m0 * 512, 512, p.WaT + (size_t)n0 * 512, 512, 512, sA, sB, acc, rs);
    acc_to_lds(acc, sC);
    __syncthreads();
#pragma unroll
    for (int i = 0; i < 8; ++i) {
      const int c = threadIdx.x + 256 * i, row = c >> 4, cc = (c & 15) * 8;
      const u32x4 g = *(const u32x4*)(p.GA + (size_t)(m0 + row) * 1024 + n0 + cc);
      const float4 a = *(const float4*)(sC + row * CSTR + cc), b = *(const float4*)(sC + row * CSTR + cc + 4);
      u32x4 y;
      y[0] = pk2(a.x * __uint_as_float(g[0] << 16), a.y * __uint_as_float(g[0] & 0xffff0000u));
      y[1] = pk2(a.z * __uint_as_float(g[1] << 16), a.w * __uint_as_float(g[1] & 0xffff0000u));
      y[2] = pk2(b.x * __uint_as_float(g[2] << 16), b.y * __uint_as_float(g[2] & 0xffff0000u));
      y[3] = pk2(b.z * __uint_as_float(g[3] << 16), b.w * __uint_as_float(g[3] & 0xffff0000u));
      *(u32x4*)(p.MERGED + (size_t)(m0 + row) * 1024 + n0 + cc) = y;
    }
    __syncthreads();
    zero_acc(acc);
    gemm_mainloop<false>(p.OBg + (size_t)m0 * 512, 512, p.WbT + (size_t)n0 * 512, 512, 512, sA, sB, acc, rs);
    acc_to_lds(acc, sC);
    __syncthreads();
#pragma unroll
    for (int i = 0; i < 8; ++i) {
      const int c = threadIdx.x + 256 * i, row = c >> 4, cc = (c & 15) * 8;
      const u32x4 g = *(const u32x4*)(p.GB + (size_t)(m0 + row) * 1024 + n0 + cc);
      const u32x4 yv = *(const u32x4*)(p.MERGED + (size_t)(m0 + row) * 1024 + n0 + cc);
      const float4 a = *(const float4*)(sC + row * CSTR + cc), b = *(const float4*)(sC + row * CSTR + cc + 4);
      u32x4 o;
      o[0] = pk2(__uint_as_float(yv[0] << 16) + a.x * __uint_as_float(g[0] << 16), __uint_as_float(yv[0] & 0xffff0000u) + a.y * __uint_as_float(g[0] & 0xffff0000u));
      o[1] = pk2(__uint_as_float(yv[1] << 16) + a.z * __uint_as_float(g[1] << 16), __uint_as_float(yv[1] & 0xffff0000u) + a.w * __uint_as_float(g[1] & 0xffff0000u));
      o[2] = pk2(__uint_as_float(yv[2] << 16) + b.x * __uint_as_float(g[2] << 16), __uint_as_float(yv[2] & 0xffff0000u) + b.y * __uint_as_float(g[2] & 0xffff0000u));
      o[3] = pk2(__uint_as_float(yv[3] << 16) + b.z * __uint_as_float(g[3] << 16), __uint_as_float(yv[3] & 0xffff0000u) + b.w * __uint_as_float(g[3] & 0xffff0000u));
      *(u32x4*)(p.MERGED + (size_t)(m0 + row) * 1024 + n0 + cc) = o;
    }
    __syncthreads();
  }
}

DI void phase_g4(const Params& p, char* smem) {
  bf16_t* sA = (bf16_t*)smem;
  bf16_t* sB = sA + 2 * GBUF;
  float* sC = (float*)smem;
  float* rs = (float*)(smem + 4 * GBUF * 2);
  for (int t = blockIdx.x; t < 128 * 8; t += gridDim.x) {
    const int rt = t >> 3, ct = t & 7, m0 = rt * 128, n0 = ct * 128;
    f32x16 acc[2][2];
    zero_acc(acc);
    if (threadIdx.x < 128) rs[threadIdx.x] = mod_get(p.MOD, m0 >> 12, 2048 + n0 + threadIdx.x);
    gemm_mainloop<false>(p.MERGED + (size_t)m0 * 1024, 1024, p.WoT + (size_t)n0 * 1024, 1024, 1024, sA, sB, acc, rs);
    acc_to_lds(acc, sC);
    __syncthreads();
#pragma unroll
    for (int i = 0; i < 8; ++i) {
      const int c = threadIdx.x + 256 * i, row = c >> 4, cc = (c & 15) * 8;
      const size_t go = (size_t)(m0 + row) * 1024 + n0 + cc;
      const float4 x0 = *(const float4*)(p.x + go), x1 = *(const float4*)(p.x + go + 4);
      const float4 a = *(const float4*)(sC + row * CSTR + cc), b = *(const float4*)(sC + row * CSTR + cc + 4);
      const float4 g0 = *(const float4*)(rs + cc), g1 = *(const float4*)(rs + cc + 4);
      float4 o0, o1;
      o0.x = x0.x + g0.x * a.x; o0.y = x0.y + g0.y * a.y; o0.z = x0.z + g0.z * a.z; o0.w = x0.w + g0.w * a.w;
      o1.x = x1.x + g1.x * b.x; o1.y = x1.y + g1.y * b.y; o1.z = x1.z + g1.z * b.z; o1.w = x1.w + g1.w * b.w;
      *(float4*)(p.out + go) = o0;
      *(float4*)(p.out + go + 4) = o1;
    }
    __syncthreads();
  }
}

DI void phase_final(const Params& p) {
  const int lane = threadIdx.x & 63, w = threadIdx.x >> 6;
  const int gw = blockIdx.x * 4 + w, nw = gridDim.x * 4;
  for (int row = gw; row < NTOK; row += nw) {
    float* xr = p.out + (size_t)row * DM;
    float4 v[4];
    float ss = 0.f;
#pragma unroll
    for (int i = 0; i < 4; ++i) {
      v[i] = *(const float4*)(xr + 4 * (lane + 64 * i));
      ss += v[i].x * v[i].x + v[i].y * v[i].y + v[i].z * v[i].z + v[i].w * v[i].w;
    }
#pragma unroll
    for (int o = 32; o >= 1; o >>= 1) ss += __shfl_xor(ss, o);
    const float rn = __builtin_amdgcn_rsqf(ss * (1.f / DM) + EPSN);
#pragma unroll
    for (int i = 0; i < 4; ++i) {
      const int e = 4 * (lane + 64 * i);
      const float4 g = *(const float4*)(p.fgain + e);
      float4 o;
      o.x = v[i].x * rn * g.x; o.y = v[i].y * rn * g.y; o.z = v[i].z * rn * g.z; o.w = v[i].w * rn * g.w;
      *(float4*)(xr + e) = o;
    }
  }
}

template <int PH>
__global__ void __launch_bounds__(NTHREADS, 2) mega_kernel(Params p) {
  __shared__ __attribute__((aligned(16))) char smem[SMEM_BYTES];
  if (PH < 0) {
    cg::grid_group grid = cg::this_grid();
    phase_prep(p, smem); grid.sync();
    phase_h(p); grid.sync();
    phase_g1(p, smem); grid.sync();
#if PROBE_DUP == 1
    phase_g1(p, smem); grid.sync();
#endif
    phase_g2(p, smem); grid.sync();
    phase_attn(p, smem, 0, 0); grid.sync();
#if PROBE_DUP == 2
    phase_attn(p, smem, 1, 1); grid.sync();
#endif
#if PROBE_DUP == 3
    phase_attn(p, smem, 1, 2); grid.sync();
#endif
    phase_g3(p, smem); grid.sync();
    phase_g4(p, smem); grid.sync();
    phase_final(p);
  } else {
    if (PH == 0) phase_prep(p, smem);
    if (PH == 1) phase_h(p);
    if (PH == 2) phase_g1(p, smem);
    if (PH == 3) phase_g2(p, smem);
    if (PH == 4) phase_attn(p, smem, 0, 0);
    if (PH == 5) phase_g3(p, smem);
    if (PH == 6) phase_g4(p, smem);
    if (PH == 7) phase_final(p);
  }
}

#ifndef PROBE_DUP
#define PROBE_DUP 0
#endif
#ifndef MK_SPLIT
#define MK_SPLIT 0
#endif

extern "C" void kernel_launch(void* const* d_in, const int* in_sizes, int n_in, void* d_out, int out_size, void* d_ws, size_t ws_size, hipStream_t stream) {
  Params p{};
  p.x = (const float*)d_in[0]; p.c = (const float*)d_in[1]; p.pos = (const int*)d_in[2];
  p.w_ada = (const float*)d_in[3]; p.b_ada = (const float*)d_in[4]; p.norm_gain = (const float*)d_in[5];
  p.w_in = (const float*)d_in[6]; p.q_gain = (const float*)d_in[7]; p.w_uq = (const float*)d_in[8];
  p.kv_gain = (const float*)d_in[9]; p.w_ukv = (const float*)d_in[10]; p.w_a = (const float*)d_in[11];
  p.w_b = (const float*)d_in[12]; p.w_out = (const float*)d_in[13]; p.fgain = (const float*)d_in[14];
  p.out = (float*)d_out;
  char* ws = (char*)d_ws;
  size_t off = 0;
  auto take = [&](size_t bytes) { char* r = ws + off; off += (bytes + 255) & ~(size_t)255; return r; };
  p.counter = (int*)take(256);
  p.MOD = (float*)take(4 * 3072 * 4 * 4);
  p.ROPE = (float*)take((size_t)NTOK * 32 * 4);
  p.SSQ = (float*)take((size_t)2 * NTOK * 4);
  p.Hb = (bf16_t*)take((size_t)NTOK * 1024 * 2);
  p.MERGED = p.Hb;
  p.Qmla = (bf16_t*)take((size_t)NTOK * 768 * 2);
  p.WinT = p.Qmla;
  p.WuqT = (bf16_t*)take((size_t)768 * 384 * 2);
  p.WukvT = (bf16_t*)take((size_t)1024 * 256 * 2);
  p.WaT = (bf16_t*)take((size_t)1024 * 512 * 2);
  p.WbT = (bf16_t*)take((size_t)1024 * 512 * 2);
  p.WoT = (bf16_t*)take((size_t)1024 * 1024 * 2);
  p.Qsb = (bf16_t*)take((size_t)NTOK * 512 * 2);
  p.Ksb = (bf16_t*)take((size_t)NTOK * 512 * 2);
  p.VTsb = (bf16_t*)take((size_t)NTOK * 512 * 2);
  p.Zsb = (bf16_t*)take((size_t)NTOK * 512 * 2);
  p.OAg = (bf16_t*)take((size_t)NTOK * 512 * 2);
  p.OBg = (bf16_t*)take((size_t)NTOK * 512 * 2);
  p.CQ = p.OAg;
  p.CKV = p.OBg;
  p.Zmla = (bf16_t*)take((size_t)NTOK * 512 * 2);
  p.KPE = (bf16_t*)take((size_t)NTOK * 32 * 2);
  p.Knope = (bf16_t*)take((size_t)NTOK * 512 * 2);
  p.VTmla = (bf16_t*)take((size_t)NTOK * 512 * 2);
  p.GA = (bf16_t*)d_out;
  p.GB = p.GA + (size_t)NTOK * 1024;
  if (off > ws_size) { fprintf(stderr, "workspace too small: need %zu have %zu\n", off, ws_size); return; }

  static int grid_blocks = 0;
  if (!grid_blocks) {
    int dev = 0, cus = 0, per_cu = 0;
    hipGetDevice(&dev);
    hipDeviceGetAttribute(&cus, hipDeviceAttributeMultiprocessorCount, dev);
    hipOccupancyMaxActiveBlocksPerMultiprocessor(&per_cu, mega_kernel<-1>, NTHREADS, 0);
    if (per_cu > 2) per_cu = 2;
    if (per_cu < 1) per_cu = 1;
    grid_blocks = cus * per_cu;
  }
#if MK_SPLIT
  mega_kernel<0><<<grid_blocks, NTHREADS, 0, stream>>>(p);
  mega_kernel<1><<<grid_blocks, NTHREADS, 0, stream>>>(p);
  mega_kernel<2><<<grid_blocks, NTHREADS, 0, stream>>>(p);
  mega_kernel<3><<<grid_blocks, NTHREADS, 0, stream>>>(p);
  mega_kernel<4><<<grid_blocks, NTHREADS, 0, stream>>>(p);
  mega_kernel<5><<<grid_blocks, NTHREADS, 0, stream>>>(p);
  mega_kernel<6><<<grid_blocks, NTHREADS, 0, stream>>>(p);
  mega_kernel<7><<<grid_blocks, NTHREADS, 0, stream>>>(p);
#else
  void* args[] = {&p};
  hipError_t e = hipLaunchCooperativeKernel((void*)mega_kernel<-1>, dim3(grid_blocks), dim3(NTHREADS), args, 0, stream);
  if (e != hipSuccess) fprintf(stderr, "cooperative launch failed: %s (grid %d)\n", hipGetErrorString(e), grid_blocks);
#endif
}
```

```cpp
#include <hip/hip_runtime.h>
#include <hip/hip_cooperative_groups.h>
#include <stdint.h>
#include <stdio.h>
namespace cg = cooperative_groups;
#ifndef PROBE_DUP
#define PROBE_DUP 0
#endif

#define DI __device__ __forceinline__
typedef unsigned short bf16_t;
typedef __attribute__((ext_vector_type(8))) short bf16x8;
typedef __attribute__((ext_vector_type(4))) short s16x4;
typedef __attribute__((ext_vector_type(16))) float f32x16;
typedef __attribute__((ext_vector_type(2))) float f32x2;
typedef __attribute__((ext_vector_type(2))) __bf16 bf16x2v;
typedef __attribute__((ext_vector_type(4))) unsigned u32x4;
typedef __attribute__((ext_vector_type(2))) unsigned u32x2;
#define MFMA(a, b, c) __builtin_amdgcn_mfma_f32_32x32x16_bf16((a), (b), (c), 0, 0, 0)

constexpr int NTOK = 16384, SEQL = 4096, DM = 1024;
constexpr int INW = 5280, INWP = 5376;
constexpr int NTHREADS = 256;
constexpr float LOG2E = 1.4426950408889634f;
constexpr float QS_SCALE = 0.125f * 1.4426950408889634f;
constexpr float QM_SCALE = 1.4426950408889634f / 9.797958971132712f;
constexpr float EPSN = 1e-6f;

constexpr int XCD_BAR_WORDS_C = 3456;
constexpr size_t al256(size_t v) { return (v + 255) & ~(size_t)255; }
constexpr size_t OFF_counter = 0;
constexpr size_t OFF_bar = OFF_counter + al256(256);
constexpr size_t OFF_MOD = OFF_bar + al256(XCD_BAR_WORDS_C * 4);
constexpr size_t OFF_ROPE = OFF_MOD + al256(4 * 3072 * 4 * 4);
constexpr size_t OFF_SSQ = OFF_ROPE + al256((size_t)NTOK * 32 * 4);
constexpr size_t OFF_Hb = OFF_SSQ + al256((size_t)2 * NTOK * 4);
constexpr size_t OFF_Qmla = OFF_Hb + al256((size_t)NTOK * 1024 * 2);
constexpr size_t OFF_WuqT = OFF_Qmla + al256((size_t)NTOK * 768 * 2);
constexpr size_t OFF_WukvT = OFF_WuqT + al256((size_t)768 * 384 * 2);
constexpr size_t OFF_WaT = OFF_WukvT + al256((size_t)1024 * 256 * 2);
constexpr size_t OFF_WbT = OFF_WaT + al256((size_t)1024 * 512 * 2);
constexpr size_t OFF_WoT = OFF_WbT + al256((size_t)1024 * 512 * 2);
constexpr size_t OFF_Qsb = OFF_WoT + al256((size_t)1024 * 1024 * 2);
constexpr size_t OFF_Ksb = OFF_Qsb + al256((size_t)NTOK * 512 * 2);
constexpr size_t OFF_VTsb = OFF_Ksb + al256((size_t)NTOK * 512 * 2);
constexpr size_t OFF_Zsb = OFF_VTsb + al256((size_t)NTOK * 512 * 2);
constexpr size_t OFF_OAg = OFF_Zsb + al256((size_t)NTOK * 512 * 2);
constexpr size_t OFF_OBg = OFF_OAg + al256((size_t)NTOK * 512 * 2);
constexpr size_t OFF_Zmla = OFF_OBg + al256((size_t)NTOK * 512 * 2);
constexpr size_t OFF_KPE = OFF_Zmla + al256((size_t)NTOK * 512 * 2);
constexpr size_t OFF_Knope = OFF_KPE + al256((size_t)NTOK * 32 * 2);
constexpr size_t OFF_VTmla = OFF_Knope + al256((size_t)NTOK * 512 * 2);
constexpr size_t WS_NEED = OFF_VTmla + al256((size_t)NTOK * 512 * 2);
struct Params {
  const float *x, *c; const int* pos;
  const float *w_ada, *b_ada, *norm_gain, *w_in, *q_gain, *w_uq, *kv_gain, *w_ukv, *w_a, *w_b, *w_out, *fgain;
  float* out;
  char* ws;
  DI int* counter() const { return (int*)(ws + OFF_counter); }
  DI unsigned* bar() const { return (unsigned*)(ws + OFF_bar); }
  DI float* MOD() const { return (float*)(ws + OFF_MOD); }
  DI float* ROPE() const { return (float*)(ws + OFF_ROPE); }
  DI float* SSQ() const { return (float*)(ws + OFF_SSQ); }
  DI bf16_t* Hb() const { return (bf16_t*)(ws + OFF_Hb); }
  DI bf16_t* Qmla() const { return (bf16_t*)(ws + OFF_Qmla); }
  DI bf16_t* WuqT() const { return (bf16_t*)(ws + OFF_WuqT); }
  DI bf16_t* WukvT() const { return (bf16_t*)(ws + OFF_WukvT); }
  DI bf16_t* WaT() const { return (bf16_t*)(ws + OFF_WaT); }
  DI bf16_t* WbT() const { return (bf16_t*)(ws + OFF_WbT); }
  DI bf16_t* WoT() const { return (bf16_t*)(ws + OFF_WoT); }
  DI bf16_t* Qsb() const { return (bf16_t*)(ws + OFF_Qsb); }
  DI bf16_t* Ksb() const { return (bf16_t*)(ws + OFF_Ksb); }
  DI bf16_t* VTsb() const { return (bf16_t*)(ws + OFF_VTsb); }
  DI bf16_t* Zsb() const { return (bf16_t*)(ws + OFF_Zsb); }
  DI bf16_t* OAg() const { return (bf16_t*)(ws + OFF_OAg); }
  DI bf16_t* OBg() const { return (bf16_t*)(ws + OFF_OBg); }
  DI bf16_t* Zmla() const { return (bf16_t*)(ws + OFF_Zmla); }
  DI bf16_t* KPE() const { return (bf16_t*)(ws + OFF_KPE); }
  DI bf16_t* Knope() const { return (bf16_t*)(ws + OFF_Knope); }
  DI bf16_t* VTmla() const { return (bf16_t*)(ws + OFF_VTmla); }
  DI bf16_t* MERGED() const { return Hb(); }
  DI bf16_t* WinT() const { return Qmla(); }
  DI bf16_t* CQ() const { return OAg(); }
  DI bf16_t* CKV() const { return OBg(); }
  DI bf16_t* GA() const { return (bf16_t*)out; }
  DI bf16_t* GB() const { return (bf16_t*)out + (size_t)NTOK * 1024; }
};


__device__ const float c_invfreq[16] = {
  1.0f, 0.5623413251903491f, 0.31622776601683794f, 0.1778279410038923f, 0.1f, 0.05623413251903491f, 0.03162277660168379f,
  0.01778279410038923f, 0.01f, 0.005623413251903491f, 0.0031622776601683794f, 0.001778279410038923f, 0.001f,
  0.0005623413251903491f, 0.00031622776601683794f, 0.0001778279410038923f};

DI unsigned pk2(float a, float b) { f32x2 v = {a, b}; bf16x2v r = __builtin_convertvector(v, bf16x2v); return __builtin_bit_cast(unsigned, r); }
DI bf16_t tobf(float a) { return (bf16_t)(pk2(a, 0.f) & 0xffffu); }
DI float bf2f(unsigned short u) { return __uint_as_float(((unsigned)u) << 16); }
DI bf16x8 pack8(float a0, float a1, float a2, float a3, float a4, float a5, float a6, float a7) {
  u32x4 p; p[0] = pk2(a0, a1); p[1] = pk2(a2, a3); p[2] = pk2(a4, a5); p[3] = pk2(a6, a7);
  return __builtin_bit_cast(bf16x8, p);
}
DI int crow(int reg, int h) { return (reg & 3) + 8 * (reg >> 2) + 4 * h; }
DI int opaque_tid() { int t = threadIdx.x; asm volatile("" : "+v"(t)); return t; }
DI float half_max(float v) {
  unsigned u = __float_as_uint(v);
  auto r = __builtin_amdgcn_permlane32_swap(u, u, false, false);
  return fmaxf(__uint_as_float(r[0]), __uint_as_float(r[1]));
}
DI float half_sum(float v) {
  unsigned u = __float_as_uint(v);
  auto r = __builtin_amdgcn_permlane32_swap(u, u, false, false);
  return __uint_as_float(r[0]) + __uint_as_float(r[1]);
}
DI float sigmoidf_fast(float v) { return __builtin_amdgcn_rcpf(1.f + __builtin_amdgcn_exp2f(-v * LOG2E)); }
DI float siluf_fast(float v) { return v * sigmoidf_fast(v); }

#define XB_TMO      128
#define XB_XCNT(j)  (256  + 64 * (j))
#define XB_XSUB(j)  (1280 + 64 * (j))
#define XB_XGEN(j)  (2304 + 64 * (j))
#define XB_TOP      3328
#define XB_TOPGEN   3392
#define XCD_BAR_WORDS 3456
#define XB_SPIN_CAP (1u << 18)
#define LAS __attribute__((address_space(3)))
DI unsigned xb_ld(unsigned* p)              { return __hip_atomic_load(p, __ATOMIC_RELAXED, __HIP_MEMORY_SCOPE_AGENT); }
DI unsigned xb_add(unsigned* p, unsigned v) { return __hip_atomic_fetch_add(p, v, __ATOMIC_RELAXED, __HIP_MEMORY_SCOPE_AGENT); }
DI unsigned xb_xcc_id() { return (unsigned)__builtin_amdgcn_s_getreg((3 << 11) | 20) & 0xFu; }
#define XB_SPIN(cond, bar) do { unsigned _sp = 0; while (cond) { __builtin_amdgcn_s_sleep(1); \
    if ((++_sp & 255u) == 0u) { if (xb_ld(&(bar)[XB_TMO])) break; if (_sp > XB_SPIN_CAP) { atomicAdd(&(bar)[XB_TMO], 1u); break; } } } } while (0)
struct XcdBarrier { unsigned* bar; unsigned x; volatile LAS unsigned* st; };
DI XcdBarrier xcd_barrier_post(unsigned* bar, volatile LAS unsigned* st) {
  XcdBarrier b; b.bar = bar; b.x = xb_xcc_id(); b.st = st;
  if (threadIdx.x == 0) (void)xb_add(&bar[XB_XCNT(b.x)], 1u);
  return b;
}
DI void xcd_barrier_complete(unsigned* bar, unsigned x, unsigned& nloc, unsigned& nx) {
  const unsigned G = gridDim.x * gridDim.y * gridDim.z;
  unsigned sum, cnt, mine, sp = 0u;
  for (;;) {
    sum = 0u; cnt = 0u; mine = 0u;
#pragma unroll
    for (unsigned j = 0; j < 16; ++j) { const unsigned c = xb_ld(&bar[XB_XCNT(j)]); sum += c; cnt += (c > 0u) ? 1u : 0u; mine = (j == x) ? c : mine; }
    if (sum == G) break;
    __builtin_amdgcn_s_sleep(1);
    if ((++sp & 255u) == 0u) { if (xb_ld(&bar[XB_TMO])) break; if (sp > XB_SPIN_CAP) { atomicAdd(&bar[XB_TMO], 1u); break; } }
  }
  nloc = mine > 0u ? mine : 1u; nx = cnt > 0u ? cnt : 1u;
}
DI void xcd_barrier(unsigned* bar_, volatile LAS unsigned* st_) {
  XcdBarrier b; b.bar = bar_; b.st = st_; b.x = 0;
  asm volatile("s_waitcnt vmcnt(0)" ::: "memory");
  __syncthreads();
  if (threadIdx.x == 0) {
    unsigned* bar = b.bar;
    b.x = xb_xcc_id();
    __builtin_amdgcn_s_waitcnt(0);
    unsigned nloc = b.st[0], nx = b.st[1];
    if (nloc == 0u) { xcd_barrier_complete(bar, b.x, nloc, nx); b.st[0] = nloc; b.st[1] = nx; }
    const unsigned old = xb_add(&bar[XB_XSUB(b.x)], 1u);
    const unsigned gen = old / nloc;
    if (old + 1u == (gen + 1u) * nloc) {
      __builtin_amdgcn_fence(__ATOMIC_RELEASE, "agent");
      asm volatile("s_waitcnt vmcnt(0)" ::: "memory");
      const unsigned og = xb_add(&bar[XB_TOP], 1u);
      const unsigned tg = og / nx;
      if (og + 1u == (tg + 1u) * nx) xb_add(&bar[XB_TOPGEN], 1u);
      else XB_SPIN(xb_ld(&bar[XB_TOPGEN]) == tg, bar);
      __builtin_amdgcn_fence(__ATOMIC_ACQUIRE, "agent");
      xb_add(&bar[XB_XGEN(b.x)], 1u);
      asm volatile("s_waitcnt vmcnt(0)" ::: "memory");
    } else {
      XB_SPIN(xb_ld(&bar[XB_XGEN(b.x)]) == gen, bar);
      __builtin_amdgcn_fence(__ATOMIC_ACQUIRE, "agent");
      asm volatile("s_waitcnt vmcnt(0)" ::: "memory");
    }
  }
  __syncthreads();
}

constexpr int GSTR = 72;
constexpr int GBUF = 128 * GSTR;
constexpr int SMEM_BYTES = 4 * GBUF * 2 + 1024;

template <bool ROWSS>
DI void gemm_mainloop(const bf16_t* __restrict__ A, int lda, const bf16_t* __restrict__ B, int ldb, int K,
                      bf16_t* sA, bf16_t* sB, f32x16 (&acc)[2][2], float* rs) {
  const int tid = threadIdx.x, lane = tid & 63, w = tid >> 6;
  const int wm = w >> 1, wn = w & 1, r = lane & 31, hh = lane >> 5;
  const int lrow = tid >> 3, lch = tid & 7;
  const char* Ab = (const char*)A;
  const char* Bb = (const char*)B;
  const unsigned voA = (unsigned)(lrow * lda + lch * 8) * 2u, voB = (unsigned)(lrow * ldb + lch * 8) * 2u;
  uint4 xa0, xa1, xa2, xa3, xb0, xb1, xb2, xb3, ya0, ya1, ya2, ya3, yb0, yb1, yb2, yb3;
  float ss0 = 0.f, ss1 = 0.f, ss2 = 0.f, ss3 = 0.f;
  const int nk = K >> 6;
#define G_LD1(base, i, ld, ko, vo) (*(const uint4*)((base) + (size_t)((i) * 32 * (ld) + (ko)) * 2 + (vo)))
#define G_LOAD(P, ko)                                                                                                    \
  { P##a0 = G_LD1(Ab, 0, lda, ko, voA); P##a1 = G_LD1(Ab, 1, lda, ko, voA); P##a2 = G_LD1(Ab, 2, lda, ko, voA); P##a3 = G_LD1(Ab, 3, lda, ko, voA); \
    P##b0 = G_LD1(Bb, 0, ldb, ko, voB); P##b1 = G_LD1(Bb, 1, ldb, ko, voB); P##b2 = G_LD1(Bb, 2, ldb, ko, voB); P##b3 = G_LD1(Bb, 3, ldb, ko, voB); }
#define G_SSQ(v, s) { unsigned u_[4] = {v.x, v.y, v.z, v.w}; _Pragma("unroll") for (int j_ = 0; j_ < 4; ++j_) { \
    const float lo_ = __uint_as_float(u_[j_] << 16), hi_ = __uint_as_float(u_[j_] & 0xffff0000u); s += lo_ * lo_ + hi_ * hi_; } }
#define G_WRITE(P, bufo)                                                                                                 \
  { *(uint4*)(sA + (bufo) + woff) = P##a0; *(uint4*)(sA + (bufo) + woff + 32 * GSTR) = P##a1;                            \
    *(uint4*)(sA + (bufo) + woff + 64 * GSTR) = P##a2; *(uint4*)(sA + (bufo) + woff + 96 * GSTR) = P##a3;                \
    *(uint4*)(sB + (bufo) + woff) = P##b0; *(uint4*)(sB + (bufo) + woff + 32 * GSTR) = P##b1;                            \
    *(uint4*)(sB + (bufo) + woff + 64 * GSTR) = P##b2; *(uint4*)(sB + (bufo) + woff + 96 * GSTR) = P##b3;                \
    if (ROWSS) { G_SSQ(P##a0, ss0) G_SSQ(P##a1, ss1) G_SSQ(P##a2, ss2) G_SSQ(P##a3, ss3) } }
#define G_COMPUTE(bufo)                                                                                                  \
  { const bf16_t* cA = sA + (bufo) + (wm * 64 + r) * GSTR + hh * 8;                                                      \
    const bf16_t* cB = sB + (bufo) + (wn * 64 + r) * GSTR + hh * 8;                                                      \
    _Pragma("unroll") for (int kk = 0; kk < 4; ++kk) {                                                                   \
      const bf16x8 a0 = *(const bf16x8*)(cA + kk * 16), a1 = *(const bf16x8*)(cA + 32 * GSTR + kk * 16);                 \
      const bf16x8 b0 = *(const bf16x8*)(cB + kk * 16), b1 = *(const bf16x8*)(cB + 32 * GSTR + kk * 16);                 \
      acc[0][0] = MFMA(a0, b0, acc[0][0]); acc[0][1] = MFMA(a0, b1, acc[0][1]);                                          \
      acc[1][0] = MFMA(a1, b0, acc[1][0]); acc[1][1] = MFMA(a1, b1, acc[1][1]); } }
  const int woff = lrow * GSTR + lch * 8;
  G_LOAD(x, 0)
  G_LOAD(y, 64)
  G_WRITE(x, 0)
  __syncthreads();
  for (int ks = 0; ks < nk; ks += 2) {
    if (ks + 2 < nk) G_LOAD(x, (ks + 2) * 64)
    G_COMPUTE(0)
    G_WRITE(y, GBUF)
    __syncthreads();
    if (ks + 3 < nk) G_LOAD(y, (ks + 3) * 64)
    G_COMPUTE(GBUF)
    if (ks + 2 < nk) G_WRITE(x, 0)
    __syncthreads();
  }
#undef G_LOAD
#undef G_LD1
#undef G_SSQ
#undef G_WRITE
#undef G_COMPUTE
  if (ROWSS) {
    float sv[4] = {ss0, ss1, ss2, ss3};
#pragma unroll
    for (int i = 0; i < 4; ++i) {
      float v = sv[i];
      v += __shfl_xor(v, 1); v += __shfl_xor(v, 2); v += __shfl_xor(v, 4);
      if (lch == 0) rs[lrow + 32 * i] = __builtin_amdgcn_rsqf(v / (float)K + EPSN);
    }
  }
}

DI void zero_acc(f32x16 (&acc)[2][2]) {
#pragma unroll
  for (int a = 0; a < 2; ++a)
#pragma unroll
    for (int b = 0; b < 2; ++b)
#pragma unroll
      for (int i = 0; i < 16; ++i) acc[a][b][i] = 0.f;
}

constexpr int CSTR = 132;
DI void acc_to_lds(f32x16 (&acc)[2][2], float* sC) {
  const int lane = threadIdx.x & 63, w = threadIdx.x >> 6;
  const int wm = w >> 1, wn = w & 1, r = lane & 31, hh = lane >> 5;
#pragma unroll
  for (int mt = 0; mt < 2; ++mt)
#pragma unroll
    for (int nt = 0; nt < 2; ++nt)
#pragma unroll
      for (int i = 0; i < 16; ++i) sC[(wm * 64 + mt * 32 + crow(i, hh)) * CSTR + wn * 64 + nt * 32 + r] = acc[mt][nt][i];
}
template <class F>
DI void epi_rows(const float* sC, F f) {
  const int tx = opaque_tid();
#pragma unroll
  for (int i = 0; i < 8; ++i) {
    const int c = tx + 256 * i, row = c >> 4, cc = (c & 15) * 8;
    const float4 a = *(const float4*)(sC + row * CSTR + cc), b = *(const float4*)(sC + row * CSTR + cc + 4);
    const float v[8] = {a.x, a.y, a.z, a.w, b.x, b.y, b.z, b.w};
    f(i, row, cc, v);
  }
}
DI void store8(bf16_t* p, const float (&v)[8]) { *(bf16x8*)p = pack8(v[0], v[1], v[2], v[3], v[4], v[5], v[6], v[7]); }
DI void epi_vt(const float* sC, bf16_t* VT, int m0, int head0, int c0, int ncol_log2) {
  const int b = m0 >> 12, s0 = m0 & 4095;
  const int nitems = 16 << ncol_log2;
  for (int c = opaque_tid(); c < nitems; c += 256) {
    const int col = c & ((1 << ncol_log2) - 1), rc = c >> ncol_log2;
    float v[8];
#pragma unroll
    for (int j = 0; j < 8; ++j) v[j] = sC[(rc * 8 + j) * CSTR + c0 + col];
    const int head = head0 + (col >> 6), d = col & 63;
    store8(VT + ((size_t)((b * 8 + head) * 64 + d)) * SEQL + s0 + rc * 8, v);
  }
}
DI void rope8(const float* sC, const float* ROPE, int tok, int row, int cc, float (&v)[8]) {
  const float* pr = sC + row * CSTR + (cc ^ 16);
  const bool upper = (cc & 16) != 0;
  const int f0 = cc & 15;
  const float* tb = ROPE + (size_t)tok * 32;
#pragma unroll
  for (int j = 0; j < 8; ++j) {
    const float o = pr[j], cs = tb[f0 + j], sn = tb[16 + f0 + j];
    v[j] = upper ? (o * sn + v[j] * cs) : (v[j] * cs - o * sn);
  }
}

DI void wconv_unit(const float* __restrict__ src, int Nsrc, int K, bf16_t* __restrict__ dst, const float* __restrict__ gain, int ng, int kg, int mode, float* tile) {
  const int tid = threadIdx.x;
  {
    const int k = tid >> 2, cq = tid & 3;
    const int n = ng * 64 + cq * 16;
    int sc = n;
    if (mode == 1) { sc = (n < 2688) ? n : (n < 5248 ? n + 32 : (n < 5280 ? n - 2560 : -1)); }
    const int kk = kg * 64 + k;
    float4 v[4];
    if (sc >= 0) {
      const float* sp = src + (size_t)kk * Nsrc + sc;
#pragma unroll
      for (int i = 0; i < 4; ++i) v[i] = *(const float4*)(sp + 4 * i);
      if (gain) { const float g = gain[kk];
#pragma unroll
        for (int i = 0; i < 4; ++i) { v[i].x *= g; v[i].y *= g; v[i].z *= g; v[i].w *= g; } }
    } else {
#pragma unroll
      for (int i = 0; i < 4; ++i) v[i] = make_float4(0.f, 0.f, 0.f, 0.f);
    }
    float* tp = tile + k * 65 + cq * 16;
#pragma unroll
    for (int i = 0; i < 4; ++i) { tp[4 * i] = v[i].x; tp[4 * i + 1] = v[i].y; tp[4 * i + 2] = v[i].z; tp[4 * i + 3] = v[i].w; }
  }
  __syncthreads();
  {
    const int n = tid >> 2, kc = tid & 3;
    float o[16];
#pragma unroll
    for (int j = 0; j < 16; ++j) o[j] = tile[(kc * 16 + j) * 65 + n];
    bf16_t* dp = dst + (size_t)(ng * 64 + n) * K + kg * 64 + kc * 16;
    *(bf16x8*)dp = pack8(o[0], o[1], o[2], o[3], o[4], o[5], o[6], o[7]);
    *(bf16x8*)(dp + 8) = pack8(o[8], o[9], o[10], o[11], o[12], o[13], o[14], o[15]);
  }
  __syncthreads();
}

DI void phase_prep(const Params& p, char* smem) {
  const int tid = threadIdx.x;
  if (blockIdx.x == 0 && tid < 16) { p.counter()[tid] = 0; }
  for (int i = blockIdx.x * NTHREADS + tid; i < 2 * NTOK; i += gridDim.x * NTHREADS) p.SSQ()[i] = 0.f;
  constexpr int U_MOD = 96 * 4, U_WIN = 84 * 16, U_WUQ = 12 * 6, U_WUKV = 16 * 4, U_WA = 16 * 8, U_WB = 16 * 8, U_WO = 16 * 16, U_ROPE = 1024;
  constexpr int U_TOTAL = U_MOD + U_ROPE + U_WIN + U_WUQ + U_WUKV + U_WA + U_WB + U_WO;
  float* tile = (float*)smem;
  for (int u = blockIdx.x; u < U_TOTAL; u += gridDim.x) {
    int v = u;
    if (v < U_MOD) {
      const int cg32 = v >> 2, kq = v & 3, n0 = cg32 * 32;
      const int kgp = tid >> 5, col = tid & 31;
      const int kb = kq * 256 + kgp * 32;
      float a0 = 0.f, a1 = 0.f, a2 = 0.f, a3 = 0.f;
      const float* wp = p.w_ada + (size_t)kb * 3072 + n0 + col;
      float wv[32];
#pragma unroll
      for (int kk = 0; kk < 32; ++kk) wv[kk] = wp[(size_t)kk * 3072];
#pragma unroll
      for (int kk = 0; kk < 32; ++kk) {
        a0 += wv[kk] * p.c[kb + kk]; a1 += wv[kk] * p.c[1024 + kb + kk]; a2 += wv[kk] * p.c[2048 + kb + kk]; a3 += wv[kk] * p.c[3072 + kb + kk];
      }
      float* red = (float*)smem;
      red[(kgp * 4 + 0) * 32 + col] = a0; red[(kgp * 4 + 1) * 32 + col] = a1; red[(kgp * 4 + 2) * 32 + col] = a2; red[(kgp * 4 + 3) * 32 + col] = a3;
      __syncthreads();
      if (tid < 128) {
        const int b = tid >> 5, cc = tid & 31;
        float s = (kq == 0) ? p.b_ada[n0 + cc] : 0.f;
#pragma unroll
        for (int g = 0; g < 8; ++g) s += red[(g * 4 + b) * 32 + cc];
        p.MOD()[(size_t)(b * 3072 + n0 + cc) * 4 + kq] = s;
      }
      __syncthreads();
      continue;
    }
    v -= U_MOD;
    if (v < U_WIN) { wconv_unit(p.w_in, INW, 1024, p.WinT(), nullptr, v >> 4, v & 15, 1, tile); continue; }
    v -= U_WIN;
    if (v < U_WUQ) { wconv_unit(p.w_uq, 768, 384, p.WuqT(), p.q_gain, v / 6, v % 6, 0, tile); continue; }
    v -= U_WUQ;
    if (v < U_WUKV) { wconv_unit(p.w_ukv, 1024, 256, p.WukvT(), p.kv_gain, v >> 2, v & 3, 0, tile); continue; }
    v -= U_WUKV;
    if (v < U_WA) { wconv_unit(p.w_a, 1024, 512, p.WaT(), nullptr, v >> 3, v & 7, 0, tile); continue; }
    v -= U_WA;
    if (v < U_WB) { wconv_unit(p.w_b, 1024, 512, p.WbT(), nullptr, v >> 3, v & 7, 0, tile); continue; }
    v -= U_WB;
    if (v < U_WO) { wconv_unit(p.w_out, 1024, 1024, p.WoT(), nullptr, v >> 4, v & 15, 0, tile); continue; }
    v -= U_WO;
    {
      const int idx = v * 256 + tid, tok = idx >> 4, i = idx & 15;
      const float ang = (float)p.pos[tok] * c_invfreq[i];
      double t = (double)ang * 0.15915494309189535;
      t -= rint(t);
      const float tf = (float)t;
      p.ROPE()[(size_t)tok * 32 + i] = __builtin_amdgcn_cosf(tf);
      p.ROPE()[(size_t)tok * 32 + 16 + i] = __builtin_amdgcn_sinf(tf);
    }
  }
}

DI float mod_get(const float* MOD, int b, int n) { const float4 q = *(const float4*)(MOD + (size_t)(b * 3072 + n) * 4); return (q.x + q.y) + (q.z + q.w); }

DI void phase_h(const Params& p) {
  const int lane = threadIdx.x & 63, w = threadIdx.x >> 6;
  const int gw = blockIdx.x * 4 + w, nw = gridDim.x * 4;
  for (int row = gw; row < NTOK; row += nw) {
    const int b = row >> 12;
    const float* xr = p.x + (size_t)row * DM;
    float4 v[4];
    float ss = 0.f;
#pragma unroll
    for (int i = 0; i < 2; ++i) {
      const int e = 8 * (lane + 64 * i);
      v[2 * i] = *(const float4*)(xr + e);
      v[2 * i + 1] = *(const float4*)(xr + e + 4);
      ss += v[2 * i].x * v[2 * i].x + v[2 * i].y * v[2 * i].y + v[2 * i].z * v[2 * i].z + v[2 * i].w * v[2 * i].w;
      ss += v[2 * i + 1].x * v[2 * i + 1].x + v[2 * i + 1].y * v[2 * i + 1].y + v[2 * i + 1].z * v[2 * i + 1].z + v[2 * i + 1].w * v[2 * i + 1].w;
    }
#pragma unroll
    for (int o = 32; o >= 1; o >>= 1) ss += __shfl_xor(ss, o);
    const float rn = __builtin_amdgcn_rsqf(ss * (1.f / DM) + EPSN);

#pragma unroll
    for (int i = 0; i < 2; ++i) {
      const int e = 8 * (lane + 64 * i);
      float o[8];
      const float xs[8] = {v[2 * i].x, v[2 * i].y, v[2 * i].z, v[2 * i].w, v[2 * i + 1].x, v[2 * i + 1].y, v[2 * i + 1].z, v[2 * i + 1].w};
#pragma unroll
      for (int j = 0; j < 8; ++j) o[j] = xs[j] * rn * p.norm_gain[e + j] * (1.f + mod_get(p.MOD(), b, 1024 + e + j)) + mod_get(p.MOD(), b, e + j);
      *(bf16x8*)(p.Hb() + (size_t)row * DM + e) = pack8(o[0], o[1], o[2], o[3], o[4], o[5], o[6], o[7]);
    }
  }
}

DI void phase_g1(const Params& p, char* smem) {
  bf16_t* sA = (bf16_t*)smem;
  bf16_t* sB = sA + 2 * GBUF;
  float* sC = (float*)smem;
  float* rs = (float*)(smem + 4 * GBUF * 2);
  constexpr int NCT = INWP / 128;
  const int ntiles = (NTOK / 128) * NCT;
  for (int t = blockIdx.x; t < ntiles; t += gridDim.x) {
    const int rt = t / NCT, ct = t % NCT;
    const int m0 = rt * 128, n0 = ct * 128;
    f32x16 acc[2][2];
    zero_acc(acc);
    gemm_mainloop<false>(p.Hb() + (size_t)m0 * DM, DM, p.WinT() + (size_t)n0 * DM, DM, DM, sA, sB, acc, rs);
    acc_to_lds(acc, sC);
    __syncthreads();
    if (ct < 4) {
      epi_rows(sC, [&](int, int row, int cc, const float (&v)[8]) {
        float o[8];
#pragma unroll
        for (int j = 0; j < 8; ++j) o[j] = v[j] * QS_SCALE;
        store8(p.Qsb() + (size_t)(m0 + row) * 512 + n0 + cc, o); });
    } else if (ct < 8) {
      epi_rows(sC, [&](int, int row, int cc, const float (&v)[8]) { store8(p.Ksb() + (size_t)(m0 + row) * 512 + n0 - 512 + cc, v); });
    } else if (ct < 12) {
      epi_vt(sC, p.VTsb(), m0, (n0 - 1024) >> 6, 0, 7);
    } else if (ct < 16) {
      epi_rows(sC, [&](int, int row, int cc, const float (&v)[8]) {
        float o[8];
#pragma unroll
        for (int j = 0; j < 8; ++j) o[j] = siluf_fast(v[j]);
        store8(p.Zsb() + (size_t)(m0 + row) * 512 + n0 - 1536 + cc, o); });
    } else if (ct < 19) {
      epi_rows(sC, [&](int, int row, int cc, const float (&v)[8]) {
        store8(p.CQ() + (size_t)(m0 + row) * 384 + n0 - 2048 + cc, v);
        float q = 0.f;
#pragma unroll
        for (int j = 0; j < 8; ++j) q += v[j] * v[j];
        q += __shfl_xor(q, 1); q += __shfl_xor(q, 2); q += __shfl_xor(q, 4); q += __shfl_xor(q, 8);
        if ((threadIdx.x & 15) == 0) atomicAdd(p.SSQ() + m0 + row, q); });
    } else if (ct < 21) {
      epi_rows(sC, [&](int, int row, int cc, const float (&v)[8]) {
        store8(p.CKV() + (size_t)(m0 + row) * 256 + n0 - 2432 + cc, v);
        float q = 0.f;
#pragma unroll
        for (int j = 0; j < 8; ++j) q += v[j] * v[j];
        q += __shfl_xor(q, 1); q += __shfl_xor(q, 2); q += __shfl_xor(q, 4); q += __shfl_xor(q, 8);
        if ((threadIdx.x & 15) == 0) atomicAdd(p.SSQ() + NTOK + m0 + row, q); });
    } else if (ct < 25) {
      epi_rows(sC, [&](int, int row, int cc, const float (&v)[8]) {
        float o[8];
#pragma unroll
        for (int j = 0; j < 8; ++j) o[j] = siluf_fast(v[j]);
        store8(p.Zmla() + (size_t)(m0 + row) * 512 + n0 - 2688 + cc, o); });
    } else if (ct < 33) {
      epi_rows(sC, [&](int, int row, int cc, const float (&v)[8]) {
        float o[8];
#pragma unroll
        for (int j = 0; j < 8; ++j) o[j] = sigmoidf_fast(v[j]);
        store8(p.GA() + (size_t)(m0 + row) * 1024 + n0 - 3200 + cc, o); });
    } else if (ct < 41) {
      epi_rows(sC, [&](int, int row, int cc, const float (&v)[8]) {
        float o[8];
#pragma unroll
        for (int j = 0; j < 8; ++j) o[j] = sigmoidf_fast(v[j]);
        store8(p.GB() + (size_t)(m0 + row) * 1024 + n0 - 4224 + cc, o); });
    } else {
      epi_rows(sC, [&](int, int row, int cc, const float (&v)[8]) {
        if (cc < 32) {
          float o[8];
#pragma unroll
          for (int j = 0; j < 8; ++j) o[j] = v[j];
          rope8(sC, p.ROPE(), m0 + row, row, cc, o);
          store8(p.KPE() + (size_t)(m0 + row) * 32 + cc, o);
        } });
    }
    __syncthreads();
  }
}

DI void phase_g2(const Params& p, char* smem) {
  bf16_t* sA = (bf16_t*)smem;
  bf16_t* sB = sA + 2 * GBUF;
  float* sC = (float*)smem;
  float* rs = (float*)(smem + 4 * GBUF * 2);
  constexpr int NQ = 128 * 6, NKV = 128 * 8;
  for (int t = blockIdx.x; t < NQ + NKV; t += gridDim.x) {
    f32x16 acc[2][2];
    zero_acc(acc);
    if (t < NQ) {
      const int rt = t / 6, ct = t % 6, m0 = rt * 128, n0 = ct * 128;
      if (threadIdx.x < 128) rs[threadIdx.x] = __builtin_amdgcn_rsqf(p.SSQ()[m0 + threadIdx.x] * (1.f / 384.f) + EPSN);
      gemm_mainloop<false>(p.CQ() + (size_t)m0 * 384, 384, p.WuqT() + (size_t)n0 * 384, 384, 384, sA, sB, acc, rs);
      acc_to_lds(acc, sC);
      __syncthreads();
      epi_rows(sC, [&](int, int row, int cc, const float (&v)[8]) {
        const int col = n0 + cc;
        float o[8];
#pragma unroll
        for (int j = 0; j < 8; ++j) o[j] = v[j];
        if (((col >> 5) % 3) == 2) rope8(sC, p.ROPE(), m0 + row, row, cc, o);
        const float sc = rs[row] * QM_SCALE;
#pragma unroll
        for (int j = 0; j < 8; ++j) o[j] *= sc;
        store8(p.Qmla() + (size_t)(m0 + row) * 768 + col, o);
      });
    } else {
      const int t2 = t - NQ;
      const int rt = t2 >> 3, head = t2 & 7, m0 = rt * 128, n0 = head * 128;
      if (threadIdx.x < 128) rs[threadIdx.x] = __builtin_amdgcn_rsqf(p.SSQ()[NTOK + m0 + threadIdx.x] * (1.f / 256.f) + EPSN);
      gemm_mainloop<false>(p.CKV() + (size_t)m0 * 256, 256, p.WukvT() + (size_t)n0 * 256, 256, 256, sA, sB, acc, rs);
      acc_to_lds(acc, sC);
      __syncthreads();
      epi_rows(sC, [&](int, int row, int cc, const float (&v)[8]) {
        if (cc < 64) {
          const float sc = rs[row];
          float o[8];
#pragma unroll
          for (int j = 0; j < 8; ++j) o[j] = v[j] * sc;
          store8(p.Knope() + (size_t)(m0 + row) * 512 + head * 64 + cc, o);
        } });
      {
        const int b = m0 >> 12, s0 = m0 & 4095;
        for (int c = opaque_tid(); c < 1024; c += 256) {
          const int col = c & 63, rc = c >> 6;
          float v[8];
#pragma unroll
          for (int j = 0; j < 8; ++j) v[j] = sC[(rc * 8 + j) * CSTR + 64 + col] * rs[rc * 8 + j];
          store8(p.VTmla() + ((size_t)((b * 8 + head) * 64 + col)) * SEQL + s0 + rc * 8, v);
        }
      }
    }
    __syncthreads();
  }
}

constexpr int VSTR = 68;

template <bool MLA>
DI void attn_item(const Params& p, int b, int h, int qb, char* smem) {
  constexpr int DK = MLA ? 96 : 64;
  constexpr int KSTR = MLA ? 104 : 72;
  constexpr int NKS = DK / 16;
  bf16_t* sK = (bf16_t*)smem;
  bf16_t* sV = sK + 2 * 64 * KSTR;
  const int tid = threadIdx.x, lane = tid & 63, w = tid >> 6, r = lane & 31, hh = lane >> 5;
  const int tokb = b * SEQL;
  const int tok0 = tokb + qb * 128;
  const int qw = qb * 128 + w * 32;

  bf16x8 qf[NKS];
  {
    const bf16_t* qptr = MLA ? (p.Qmla() + (size_t)(tok0 + w * 32 + r) * 768 + h * 96 + hh * 8) : (p.Qsb() + (size_t)(tok0 + w * 32 + r) * 512 + h * 64 + hh * 8);
#pragma unroll
    for (int ks = 0; ks < NKS; ++ks) qf[ks] = *(const bf16x8*)(qptr + ks * 16);
  }
  bf16x8 tf[2];
  if (!MLA) {
#pragma unroll
    for (int st = 0; st < 2; ++st)
#pragma unroll
      for (int e = 0; e < 8; ++e) { const int j = 16 * st + 8 * (e >> 2) + 4 * hh + (e & 3); tf[st][e] = (j >= r) ? (short)0x3F80 : (short)0; }
  }

  f32x16 oacc[2];
#pragma unroll
  for (int i = 0; i < 16; ++i) { oacc[0][i] = 0.f; oacc[1][i] = 0.f; }
  float carry = 0.f;
  float mrun = -1e30f, lrun = 0.f;

  const bf16_t* Kg = MLA ? p.Knope() : p.Ksb();
  const bf16_t* VTg = (MLA ? p.VTmla() : p.VTsb()) + (size_t)((b * 8 + h) * 64) * SEQL;
  const int nt = 2 * qb + 2;

  uint4 xk0, xk1, xv0, xv1, xp, yk0, yk1, yv0, yv1, yp;
  xp = make_uint4(0, 0, 0, 0); yp = xp;
  const int prow = tid >> 3, pch = tid & 7;
  const bf16_t* kgp = Kg + (size_t)(tokb + prow) * 512 + h * 64 + pch * 8;
  const bf16_t* vgp = VTg + (size_t)prow * SEQL + pch * 8;
  const bf16_t* pgp = p.KPE() + (size_t)(tokb + (tid >> 2)) * 32 + (tid & 3) * 8;
#define ATT_GLOAD(P, kt_)                                                          \
  {                                                                                \
    const int kt__ = (kt_);                                                        \
    P##k0 = *(const uint4*)(kgp + (size_t)(kt__ * 64) * 512);                      \
    P##k1 = *(const uint4*)(kgp + (size_t)(kt__ * 64 + 32) * 512);                 \
    P##v0 = *(const uint4*)(vgp + kt__ * 64);                                      \
    P##v1 = *(const uint4*)(vgp + (size_t)32 * SEQL + kt__ * 64);                  \
    if (MLA) P##p = *(const uint4*)(pgp + (size_t)(kt__ * 64) * 32);               \
  }
#define ATT_SWRITE(P, buf_)                                                        \
  {                                                                                \
    bf16_t* dK = sK + (buf_) * 64 * KSTR;                                          \
    bf16_t* dV = sV + (buf_) * 64 * VSTR;                                          \
    *(uint4*)(dK + prow * KSTR + pch * 8) = P##k0;                                 \
    *(uint4*)(dK + (prow + 32) * KSTR + pch * 8) = P##k1;                          \
    uint2* dv0 = (uint2*)(dV + prow * VSTR + pch * 8);                             \
    dv0[0] = make_uint2(P##v0.x, P##v0.y); dv0[1] = make_uint2(P##v0.z, P##v0.w);  \
    uint2* dv1 = (uint2*)(dV + (prow + 32) * VSTR + pch * 8);                      \
    dv1[0] = make_uint2(P##v1.x, P##v1.y); dv1[1] = make_uint2(P##v1.z, P##v1.w);  \
    if (MLA) *(uint4*)(dK + (tid >> 2) * KSTR + 64 + (tid & 3) * 8) = P##p;        \
  }
#define ATT_KT(i_) (MLA ? (i_) : (nt - 1 - (i_)))

  ATT_GLOAD(x, ATT_KT(0));
  ATT_GLOAD(y, ATT_KT(1));
  ATT_SWRITE(x, 0);
  __syncthreads();
  bool alive = true;
  for (int it0 = 0; alive; it0 += 2) {
#pragma unroll
   for (int half = 0; half < 2; ++half) {
    const int it = it0 + half;
    const int kt = ATT_KT(it);
    const int cur = half;
    const bool more = (it + 1 < nt);
    if (it + 2 < nt) { if (half == 0) ATT_GLOAD(x, ATT_KT(it + 2)) else ATT_GLOAD(y, ATT_KT(it + 2)) }
    const bf16_t* cK = sK + cur * 64 * KSTR;
    const bf16_t* cV = sV + cur * 64 * VSTR;
#pragma unroll
    for (int si = 0; si < 2; ++si) {
      const int sub = MLA ? si : (1 - si);
      const int kb = kt * 64 + sub * 32;
      if (kb > qw) continue;
      const bool diag = (kb == qw);
      f32x16 s;
#pragma unroll
      for (int i = 0; i < 16; ++i) s[i] = 0.f;
#pragma unroll
      for (int ks = 0; ks < NKS; ++ks) {
        const bf16x8 kf = *(const bf16x8*)(cK + (sub * 32 + r) * KSTR + ks * 16 + hh * 8);
        s = MFMA(kf, qf[ks], s);
      }
      bf16x8 pf[2];
      if (!MLA) {
        float sp[16];
        float tsum = 0.f;
#pragma unroll
        for (int i = 0; i < 16; ++i) {
          const float z = s[i];
          float v = fmaxf(z, 0.f) + __builtin_amdgcn_logf(1.f + __builtin_amdgcn_exp2f(-fabsf(z)));
          if (diag && !(crow(i, hh) < r)) v = 0.f;
          sp[i] = v;
          tsum += v;
        }
        f32x16 cacc;
#pragma unroll
        for (int i = 0; i < 16; ++i) cacc[i] = carry;
        cacc = MFMA(tf[0], pack8(sp[0], sp[1], sp[2], sp[3], sp[4], sp[5], sp[6], sp[7]), cacc);
        cacc = MFMA(tf[1], pack8(sp[8], sp[9], sp[10], sp[11], sp[12], sp[13], sp[14], sp[15]), cacc);
        float pr[16];
#pragma unroll
        for (int i = 0; i < 16; ++i) {
          float v = __builtin_amdgcn_exp2f(s[i] - cacc[i]);
          if (diag && !(crow(i, hh) < r)) v = 0.f;
          pr[i] = v;
        }
        carry += half_sum(tsum);
        pf[0] = pack8(pr[0], pr[1], pr[2], pr[3], pr[4], pr[5], pr[6], pr[7]);
        pf[1] = pack8(pr[8], pr[9], pr[10], pr[11], pr[12], pr[13], pr[14], pr[15]);
      } else {
        float mloc = -1e30f;
#pragma unroll
        for (int i = 0; i < 16; ++i) {
          if (diag && !(crow(i, hh) <= r)) s[i] = -1e30f;
          mloc = fmaxf(mloc, s[i]);
        }
        mloc = half_max(mloc);
        const float mnew = fmaxf(mrun, mloc);
        const float alpha = __builtin_amdgcn_exp2f(mrun - mnew);
        mrun = mnew;
        float pr[16];
        float psum = 0.f;
#pragma unroll
        for (int i = 0; i < 16; ++i) { pr[i] = __builtin_amdgcn_exp2f(s[i] - mnew); psum += pr[i]; }
        lrun = lrun * alpha + psum;
#pragma unroll
        for (int i = 0; i < 16; ++i) { oacc[0][i] *= alpha; oacc[1][i] *= alpha; }
        pf[0] = pack8(pr[0], pr[1], pr[2], pr[3], pr[4], pr[5], pr[6], pr[7]);
        pf[1] = pack8(pr[8], pr[9], pr[10], pr[11], pr[12], pr[13], pr[14], pr[15]);
      }
#pragma unroll
      for (int dt = 0; dt < 2; ++dt)
#pragma unroll
        for (int st = 0; st < 2; ++st) {
          const bf16_t* vp = cV + (dt * 32 + r) * VSTR + sub * 32 + st * 16 + 4 * hh;
          const s16x4 lo = *(const s16x4*)vp;
          const s16x4 hi = *(const s16x4*)(vp + 8);
          const bf16x8 vf = __builtin_shufflevector(lo, hi, 0, 1, 2, 3, 4, 5, 6, 7);
          oacc[dt] = MFMA(vf, pf[st], oacc[dt]);
        }
    }
    if (more) { if (half == 0) ATT_SWRITE(y, 1) else ATT_SWRITE(x, 0) }
    if (!MLA) {
      int* flg = (int*)(smem + SMEM_BYTES - 64) + (it & 1) * 4;
      const bool wok = (__builtin_amdgcn_ballot_w64(carry >= 160.f) == ~0ull);
      if (lane == 0) flg[w] = wok ? 1 : 0;
      __syncthreads();
      alive = more && ((flg[0] & flg[1] & flg[2] & flg[3]) == 0);
    } else {
      __syncthreads();
      alive = more;
    }
    if (!alive) break;
   }
  }
#undef ATT_GLOAD
#undef ATT_SWRITE
#undef ATT_KT
  float inv = 1.f;
  if (MLA) { const float lt = half_sum(lrun); inv = 1.f / lt; }
  const int tok = tok0 + w * 32 + r;
  const bf16_t* zg = (MLA ? p.Zmla() : p.Zsb()) + (size_t)tok * 512 + h * 64;
  bf16_t* og = (MLA ? p.OBg() : p.OAg()) + (size_t)tok * 512 + h * 64;
#pragma unroll
  for (int dt = 0; dt < 2; ++dt)
#pragma unroll
    for (int g = 0; g < 4; ++g) {
      const int d = dt * 32 + 8 * g + 4 * hh;
      const u32x2 zz = *(const u32x2*)(zg + d);
      const float z0 = __uint_as_float(zz[0] << 16), z1 = __uint_as_float(zz[0] & 0xffff0000u);
      const float z2 = __uint_as_float(zz[1] << 16), z3 = __uint_as_float(zz[1] & 0xffff0000u);
      u32x2 o;
      o[0] = pk2(oacc[dt][4 * g] * inv * z0, oacc[dt][4 * g + 1] * inv * z1);
      o[1] = pk2(oacc[dt][4 * g + 2] * inv * z2, oacc[dt][4 * g + 3] * inv * z3);
      *(u32x2*)(og + d) = o;
    }
}

DI void phase_attn(const Params& p, char* smem, int cbase, int only) {
  int* s_item = (int*)(smem + SMEM_BYTES - 16);
  const int q0 = blockIdx.x & 7;
  int qi = 0;
  for (;;) {
    if (threadIdx.x == 0) {
      int item = -1;
      while (qi < 8) {
        const int q = (q0 + qi) & 7;
        const int idx = atomicAdd(p.counter() + cbase + q, 1);
        if (idx < 256) { item = q * 256 + idx; break; }
        ++qi;
      }
      *s_item = item;
    }
    __syncthreads();
    const int item = *s_item;
    __syncthreads();
    if (item < 0) break;
    const int q = item >> 8, idx = item & 255;
    const int grp = idx >> 5;
    const int bh = q + 8 * (grp >> 1);
    const int qb = 31 - (idx & 31);
    if ((grp & 1) == 0) { if (only != 2) attn_item<true>(p, bh >> 3, bh & 7, qb, smem); }
    else { if (only != 1) attn_item<false>(p, bh >> 3, bh & 7, qb, smem); }
  }
}

DI void phase_g3(const Params& p, char* smem) {
  bf16_t* sA = (bf16_t*)smem;
  bf16_t* sB = sA + 2 * GBUF;
  float* sC = (float*)smem;
  float* rs = (float*)(smem + 4 * GBUF * 2);
  for (int t = blockIdx.x; t < 128 * 8; t += gridDim.x) {
    const int rt = t >> 3, ct = t & 7, m0 = rt * 128, n0 = ct * 128;
    f32x16 acc[2][2];
    zero_acc(acc);
    gemm_mainloop<false>(p.OAg() + (size_t)m0 * 512, 512, p.WaT() + (size_t)n0 * 512, 512, 512, sA, sB, acc, rs);
    acc_to_lds(acc, sC);
    __syncthreads();
    const int txo = opaque_tid();
#pragma unroll
    for (int i = 0; i < 8; ++i) {
      const int c = txo + 256 * i, row = c >> 4, cc = (c & 15) * 8;
      const u32x4 g = *(const u32x4*)(p.GA() + (size_t)(m0 + row) * 1024 + n0 + cc);
      const float4 a = *(const float4*)(sC + row * CSTR + cc), b = *(const float4*)(sC + row * CSTR + cc + 4);
      u32x4 y;
      y[0] = pk2(a.x * __uint_as_float(g[0] << 16), a.y * __uint_as_float(g[0] & 0xffff0000u));
      y[1] = pk2(a.z * __uint_as_float(g[1] << 16), a.w * __uint_as_float(g[1] & 0xffff0000u));
      y[2] = pk2(b.x * __uint_as_float(g[2] << 16), b.y * __uint_as_float(g[2] & 0xffff0000u));
      y[3] = pk2(b.z * __uint_as_float(g[3] << 16), b.w * __uint_as_float(g[3] & 0xffff0000u));
      *(u32x4*)(p.MERGED() + (size_t)(m0 + row) * 1024 + n0 + cc) = y;
    }
    __syncthreads();
    zero_acc(acc);
    gemm_mainloop<false>(p.OBg() + (size_t)m0 * 512, 512, p.WbT() + (size_t)n0 * 512, 512, 512, sA, sB, acc, rs);
    acc_to_lds(acc, sC);
    __syncthreads();
    const int txo2 = opaque_tid();
#pragma unroll
    for (int i = 0; i < 8; ++i) {
      const int c = txo2 + 256 * i, row = c >> 4, cc = (c & 15) * 8;
      const u32x4 g = *(const u32x4*)(p.GB() + (size_t)(m0 + row) * 1024 + n0 + cc);
      const u32x4 yv = *(const u32x4*)(p.MERGED() + (size_t)(m0 + row) * 1024 + n0 + cc);
      const float4 a = *(const float4*)(sC + row * CSTR + cc), b = *(const float4*)(sC + row * CSTR + cc + 4);
      u32x4 o;
      o[0] = pk2(__uint_as_float(yv[0] << 16) + a.x * __uint_as_float(g[0] << 16), __uint_as_float(yv[0] & 0xffff0000u) + a.y * __uint_as_float(g[0] & 0xffff0000u));
      o[1] = pk2(__uint_as_float(yv[1] << 16) + a.z * __uint_as_float(g[1] << 16), __uint_as_float(yv[1] & 0xffff0000u) + a.w * __uint_as_float(g[1] & 0xffff0000u));
      o[2] = pk2(__uint_as_float(yv[2] << 16) + b.x * __uint_as_float(g[2] << 16), __uint_as_float(yv[2] & 0xffff0000u) + b.y * __uint_as_float(g[2] & 0xffff0000u));
      o[3] = pk2(__uint_as_float(yv[3] << 16) + b.z * __uint_as_float(g[3] << 16), __uint_as_float(yv[3] & 0xffff0000u) + b.w * __uint_as_float(g[3] & 0xffff0000u));
      *(u32x4*)(p.MERGED() + (size_t)(m0 + row) * 1024 + n0 + cc) = o;
    }
    __syncthreads();
  }
}

DI void phase_g4(const Params& p, char* smem) {
  bf16_t* sA = (bf16_t*)smem;
  bf16_t* sB = sA + 2 * GBUF;
  float* sC = (float*)smem;
  float* rs = (float*)(smem + 4 * GBUF * 2);
  for (int t = blockIdx.x; t < 128 * 8; t += gridDim.x) {
    const int rt = t >> 3, ct = t & 7, m0 = rt * 128, n0 = ct * 128;
    f32x16 acc[2][2];
    zero_acc(acc);
    if (threadIdx.x < 128) rs[threadIdx.x] = mod_get(p.MOD(), m0 >> 12, 2048 + n0 + threadIdx.x);
    gemm_mainloop<false>(p.MERGED() + (size_t)m0 * 1024, 1024, p.WoT() + (size_t)n0 * 1024, 1024, 1024, sA, sB, acc, rs);
    acc_to_lds(acc, sC);
    __syncthreads();
    const int txo = opaque_tid();
#pragma unroll
    for (int i = 0; i < 8; ++i) {
      const int c = txo + 256 * i, row = c >> 4, cc = (c & 15) * 8;
      const size_t go = (size_t)(m0 + row) * 1024 + n0 + cc;
      const float4 x0 = *(const float4*)(p.x + go), x1 = *(const float4*)(p.x + go + 4);
      const float4 a = *(const float4*)(sC + row * CSTR + cc), b = *(const float4*)(sC + row * CSTR + cc + 4);
      const float4 g0 = *(const float4*)(rs + cc), g1 = *(const float4*)(rs + cc + 4);
      float4 o0, o1;
      o0.x = x0.x + g0.x * a.x; o0.y = x0.y + g0.y * a.y; o0.z = x0.z + g0.z * a.z; o0.w = x0.w + g0.w * a.w;
      o1.x = x1.x + g1.x * b.x; o1.y = x1.y + g1.y * b.y; o1.z = x1.z + g1.z * b.z; o1.w = x1.w + g1.w * b.w;
      *(float4*)(p.out + go) = o0;
      *(float4*)(p.out + go + 4) = o1;
    }
    __syncthreads();
  }
}

DI void phase_final(const Params& p) {
  const int lane = threadIdx.x & 63, w = threadIdx.x >> 6;
  const int gw = blockIdx.x * 4 + w, nw = gridDim.x * 4;
  for (int row = gw; row < NTOK; row += nw) {
    float* xr = p.out + (size_t)row * DM;
    float4 v[4];
    float ss = 0.f;
#pragma unroll
    for (int i = 0; i < 4; ++i) {
      v[i] = *(const float4*)(xr + 4 * (lane + 64 * i));
      ss += v[i].x * v[i].x + v[i].y * v[i].y + v[i].z * v[i].z + v[i].w * v[i].w;
    }
#pragma unroll
    for (int o = 32; o >= 1; o >>= 1) ss += __shfl_xor(ss, o);
    const float rn = __builtin_amdgcn_rsqf(ss * (1.f / DM) + EPSN);
#pragma unroll
    for (int i = 0; i < 4; ++i) {
      const int e = 4 * (lane + 64 * i);
      const float4 g = *(const float4*)(p.fgain + e);
      float4 o;
      o.x = v[i].x * rn * g.x; o.y = v[i].y * rn * g.y; o.z = v[i].z * rn * g.z; o.w = v[i].w * rn * g.w;
      *(float4*)(xr + e) = o;
    }
  }
}

template <int PH>
__global__ void __launch_bounds__(NTHREADS, 2) mega_kernel(Params p) {
  __shared__ __attribute__((aligned(16))) char smem[SMEM_BYTES];
  if (PH < 0) {
    if (p.ws == nullptr) cg::this_grid().sync();
    volatile LAS unsigned* xst = (volatile LAS unsigned*)(smem + SMEM_BYTES - 32);
    if (threadIdx.x == 0) { xst[0] = 0u; xst[1] = 0u; }
    __syncthreads();
    (void)xcd_barrier_post(p.bar(), xst);
    phase_prep(p, smem); xcd_barrier(p.bar(), (volatile LAS unsigned*)(smem + SMEM_BYTES - 32));
    phase_h(p); xcd_barrier(p.bar(), (volatile LAS unsigned*)(smem + SMEM_BYTES - 32));
    phase_g1(p, smem); xcd_barrier(p.bar(), (volatile LAS unsigned*)(smem + SMEM_BYTES - 32));
#if PROBE_DUP == 1
    phase_g1(p, smem); xcd_barrier(p.bar(), (volatile LAS unsigned*)(smem + SMEM_BYTES - 32));
#endif
    phase_g2(p, smem); xcd_barrier(p.bar(), (volatile LAS unsigned*)(smem + SMEM_BYTES - 32));
    phase_attn(p, smem, 0, 0); xcd_barrier(p.bar(), (volatile LAS unsigned*)(smem + SMEM_BYTES - 32));
#if PROBE_DUP == 2
    phase_attn(p, smem, 8, 1); xcd_barrier(p.bar(), (volatile LAS unsigned*)(smem + SMEM_BYTES - 32));
#endif
#if PROBE_DUP == 3
    phase_attn(p, smem, 8, 2); xcd_barrier(p.bar(), (volatile LAS unsigned*)(smem + SMEM_BYTES - 32));
#endif
    phase_g3(p, smem); xcd_barrier(p.bar(), (volatile LAS unsigned*)(smem + SMEM_BYTES - 32));
    phase_g4(p, smem); xcd_barrier(p.bar(), (volatile LAS unsigned*)(smem + SMEM_BYTES - 32));
    phase_final(p);
  } else {
    if (PH == 0) phase_prep(p, smem);
    if (PH == 1) phase_h(p);
    if (PH == 2) phase_g1(p, smem);
    if (PH == 3) phase_g2(p, smem);
    if (PH == 4) phase_attn(p, smem, 0, 0);
    if (PH == 5) phase_g3(p, smem);
    if (PH == 6) phase_g4(p, smem);
    if (PH == 7) phase_final(p);
  }
}

#ifndef PROBE_DUP
#define PROBE_DUP 0
#endif
#ifndef MK_SPLIT
#define MK_SPLIT 0
#endif

extern "C" void kernel_launch(void* const* d_in, const int* in_sizes, int n_in, void* d_out, int out_size, void* d_ws, size_t ws_size, hipStream_t stream) {
  Params p{};
  p.x = (const float*)d_in[0]; p.c = (const float*)d_in[1]; p.pos = (const int*)d_in[2];
  p.w_ada = (const float*)d_in[3]; p.b_ada = (const float*)d_in[4]; p.norm_gain = (const float*)d_in[5];
  p.w_in = (const float*)d_in[6]; p.q_gain = (const float*)d_in[7]; p.w_uq = (const float*)d_in[8];
  p.kv_gain = (const float*)d_in[9]; p.w_ukv = (const float*)d_in[10]; p.w_a = (const float*)d_in[11];
  p.w_b = (const float*)d_in[12]; p.w_out = (const float*)d_in[13]; p.fgain = (const float*)d_in[14];
  p.out = (float*)d_out;
  p.ws = (char*)d_ws;
  if (WS_NEED > ws_size) { fprintf(stderr, "workspace too small: need %zu have %zu\n", (size_t)WS_NEED, ws_size); return; }

  static int grid_blocks = 0;
  if (!grid_blocks) {
    int dev = 0, cus = 0, per_cu = 0;
    hipGetDevice(&dev);
    hipDeviceGetAttribute(&cus, hipDeviceAttributeMultiprocessorCount, dev);
    hipOccupancyMaxActiveBlocksPerMultiprocessor(&per_cu, mega_kernel<-1>, NTHREADS, 0);
    if (per_cu > 2) per_cu = 2;
    if (per_cu < 1) per_cu = 1;
    grid_blocks = cus * per_cu;
  }
#if MK_SPLIT
  mega_kernel<0><<<grid_blocks, NTHREADS, 0, stream>>>(p);
  mega_kernel<1><<<grid_blocks, NTHREADS, 0, stream>>>(p);
  mega_kernel<2><<<grid_blocks, NTHREADS, 0, stream>>>(p);
  mega_kernel<3><<<grid_blocks, NTHREADS, 0, stream>>>(p);
  mega_kernel<4><<<grid_blocks, NTHREADS, 0, stream>>>(p);
  mega_kernel<5><<<grid_blocks, NTHREADS, 0, stream>>>(p);
  mega_kernel<6><<<grid_blocks, NTHREADS, 0, stream>>>(p);
  mega_kernel<7><<<grid_blocks, NTHREADS, 0, stream>>>(p);
#else
  hipMemsetAsync((char*)d_ws + OFF_bar, 0, XCD_BAR_WORDS * 4, stream);
  void* args[] = {&p};
  hipError_t e = hipLaunchCooperativeKernel((void*)mega_kernel<-1>, dim3(grid_blocks), dim3(NTHREADS), args, 0, stream);
  if (e != hipSuccess) fprintf(stderr, "cooperative launch failed: %s (grid %d)\n", hipGetErrorString(e), grid_blocks);
#endif
}
```

```cpp
#include <hip/hip_runtime.h>
#include <hip/hip_cooperative_groups.h>
#include <stdint.h>
#include <stdio.h>
namespace cg = cooperative_groups;
#ifndef PROBE_DUP
#define PROBE_DUP 0
#endif

#define DI __device__ __forceinline__
typedef unsigned short bf16_t;
typedef __attribute__((ext_vector_type(8))) short bf16x8;
typedef __attribute__((ext_vector_type(4))) short s16x4;
typedef __attribute__((ext_vector_type(16))) float f32x16;
typedef __attribute__((ext_vector_type(2))) float f32x2;
typedef __attribute__((ext_vector_type(2))) __bf16 bf16x2v;
typedef __attribute__((ext_vector_type(4))) unsigned u32x4;
typedef __attribute__((ext_vector_type(2))) unsigned u32x2;
#define MFMA(a, b, c) __builtin_amdgcn_mfma_f32_32x32x16_bf16((a), (b), (c), 0, 0, 0)

constexpr int NTOK = 16384, SEQL = 4096, DM = 1024;
constexpr int INW = 5280, INWP = 5376;
constexpr int NTHREADS = 256;
constexpr float LOG2E = 1.4426950408889634f;
constexpr float QS_SCALE = 0.125f * 1.4426950408889634f;
constexpr float QM_SCALE = 1.4426950408889634f / 9.797958971132712f;
constexpr float EPSN = 1e-6f;

constexpr int XCD_BAR_WORDS_C = 3456;
constexpr size_t al256(size_t v) { return (v + 255) & ~(size_t)255; }
constexpr size_t OFF_counter = 0;
constexpr size_t OFF_bar = OFF_counter + al256(256);
constexpr size_t OFF_MOD = OFF_bar + al256(XCD_BAR_WORDS_C * 4);
constexpr size_t OFF_ROPE = OFF_MOD + al256(4 * 3072 * 4 * 4);
constexpr size_t OFF_SSQ = OFF_ROPE + al256((size_t)NTOK * 32 * 4);
constexpr size_t OFF_Hb = OFF_SSQ + al256((size_t)2 * NTOK * 4);
constexpr size_t OFF_Qmla = OFF_Hb + al256((size_t)NTOK * 1024 * 2);
constexpr size_t OFF_WuqT = OFF_Qmla + al256((size_t)NTOK * 768 * 2);
constexpr size_t OFF_WukvT = OFF_WuqT + al256((size_t)768 * 384 * 2);
constexpr size_t OFF_WaT = OFF_WukvT + al256((size_t)1024 * 256 * 2);
constexpr size_t OFF_WbT = OFF_WaT + al256((size_t)1024 * 512 * 2);
constexpr size_t OFF_WoT = OFF_WbT + al256((size_t)1024 * 512 * 2);
constexpr size_t OFF_Qsb = OFF_WoT + al256((size_t)1024 * 1024 * 2);
constexpr size_t OFF_Ksb = OFF_Qsb + al256((size_t)NTOK * 512 * 2);
constexpr size_t OFF_VTsb = OFF_Ksb + al256((size_t)NTOK * 512 * 2);
constexpr size_t OFF_Zsb = OFF_VTsb + al256((size_t)NTOK * 512 * 2);
constexpr size_t OFF_OAg = OFF_Zsb + al256((size_t)NTOK * 512 * 2);
constexpr size_t OFF_OBg = OFF_OAg + al256((size_t)NTOK * 512 * 2);
constexpr size_t OFF_Zmla = OFF_OBg + al256((size_t)NTOK * 512 * 2);
constexpr size_t OFF_KPE = OFF_Zmla + al256((size_t)NTOK * 512 * 2);
constexpr size_t OFF_Knope = OFF_KPE + al256((size_t)NTOK * 32 * 2);
constexpr size_t OFF_VTmla = OFF_Knope + al256((size_t)NTOK * 512 * 2);
constexpr size_t WS_NEED = OFF_VTmla + al256((size_t)NTOK * 512 * 2);
struct Params {
  const float *x, *c; const int* pos;
  const float *w_ada, *b_ada, *norm_gain, *w_in, *q_gain, *w_uq, *kv_gain, *w_ukv, *w_a, *w_b, *w_out, *fgain;
  float* out;
  char* ws;
  DI int* counter() const { return (int*)(ws + OFF_counter); }
  DI unsigned* bar() const { return (unsigned*)(ws + OFF_bar); }
  DI float* MOD() const { return (float*)(ws + OFF_MOD); }
  DI float* ROPE() const { return (float*)(ws + OFF_ROPE); }
  DI float* SSQ() const { return (float*)(ws + OFF_SSQ); }
  DI bf16_t* Hb() const { return (bf16_t*)(ws + OFF_Hb); }
  DI bf16_t* Qmla() const { return (bf16_t*)(ws + OFF_Qmla); }
  DI bf16_t* WuqT() const { return (bf16_t*)(ws + OFF_WuqT); }
  DI bf16_t* WukvT() const { return (bf16_t*)(ws + OFF_WukvT); }
  DI bf16_t* WaT() const { return (bf16_t*)(ws + OFF_WaT); }
  DI bf16_t* WbT() const { return (bf16_t*)(ws + OFF_WbT); }
  DI bf16_t* WoT() const { return (bf16_t*)(ws + OFF_WoT); }
  DI bf16_t* Qsb() const { return (bf16_t*)(ws + OFF_Qsb); }
  DI bf16_t* Ksb() const { return (bf16_t*)(ws + OFF_Ksb); }
  DI bf16_t* VTsb() const { return (bf16_t*)(ws + OFF_VTsb); }
  DI bf16_t* Zsb() const { return (bf16_t*)(ws + OFF_Zsb); }
  DI bf16_t* OAg() const { return (bf16_t*)(ws + OFF_OAg); }
  DI bf16_t* OBg() const { return (bf16_t*)(ws + OFF_OBg); }
  DI bf16_t* Zmla() const { return (bf16_t*)(ws + OFF_Zmla); }
  DI bf16_t* KPE() const { return (bf16_t*)(ws + OFF_KPE); }
  DI bf16_t* Knope() const { return (bf16_t*)(ws + OFF_Knope); }
  DI bf16_t* VTmla() const { return (bf16_t*)(ws + OFF_VTmla); }
  DI bf16_t* MERGED() const { return Hb(); }
  DI bf16_t* WinT() const { return Qmla(); }
  DI bf16_t* CQ() const { return OAg(); }
  DI bf16_t* CKV() const { return OBg(); }
  DI bf16_t* GA() const { return (bf16_t*)out; }
  DI bf16_t* GB() const { return (bf16_t*)out + (size_t)NTOK * 1024; }
};


__device__ const float c_invfreq[16] = {
  1.0f, 0.5623413251903491f, 0.31622776601683794f, 0.1778279410038923f, 0.1f, 0.05623413251903491f, 0.03162277660168379f,
  0.01778279410038923f, 0.01f, 0.005623413251903491f, 0.0031622776601683794f, 0.001778279410038923f, 0.001f,
  0.0005623413251903491f, 0.00031622776601683794f, 0.0001778279410038923f};

DI unsigned pk2(float a, float b) { f32x2 v = {a, b}; bf16x2v r = __builtin_convertvector(v, bf16x2v); return __builtin_bit_cast(unsigned, r); }
DI bf16_t tobf(float a) { return (bf16_t)(pk2(a, 0.f) & 0xffffu); }
DI float bf2f(unsigned short u) { return __uint_as_float(((unsigned)u) << 16); }
DI bf16x8 pack8(float a0, float a1, float a2, float a3, float a4, float a5, float a6, float a7) {
  u32x4 p; p[0] = pk2(a0, a1); p[1] = pk2(a2, a3); p[2] = pk2(a4, a5); p[3] = pk2(a6, a7);
  return __builtin_bit_cast(bf16x8, p);
}
DI int crow(int reg, int h) { return (reg & 3) + 8 * (reg >> 2) + 4 * h; }
DI int opaque_tid() { int t = threadIdx.x; asm volatile("" : "+v"(t)); return t; }
DI float half_max(float v) {
  unsigned u = __float_as_uint(v);
  auto r = __builtin_amdgcn_permlane32_swap(u, u, false, false);
  return fmaxf(__uint_as_float(r[0]), __uint_as_float(r[1]));
}
DI float half_sum(float v) {
  unsigned u = __float_as_uint(v);
  auto r = __builtin_amdgcn_permlane32_swap(u, u, false, false);
  return __uint_as_float(r[0]) + __uint_as_float(r[1]);
}
DI float sigmoidf_fast(float v) { return __builtin_amdgcn_rcpf(1.f + __builtin_amdgcn_exp2f(-v * LOG2E)); }
DI float siluf_fast(float v) { return v * sigmoidf_fast(v); }

#define XB_TMO      128
#define XB_XCNT(j)  (256  + 64 * (j))
#define XB_XSUB(j)  (1280 + 64 * (j))
#define XB_XGEN(j)  (2304 + 64 * (j))
#define XB_TOP      3328
#define XB_TOPGEN   3392
#define XCD_BAR_WORDS 3456
#define XB_SPIN_CAP (1u << 18)
#define LAS __attribute__((address_space(3)))
DI unsigned xb_ld(unsigned* p)              { return __hip_atomic_load(p, __ATOMIC_RELAXED, __HIP_MEMORY_SCOPE_AGENT); }
DI unsigned xb_add(unsigned* p, unsigned v) { return __hip_atomic_fetch_add(p, v, __ATOMIC_RELAXED, __HIP_MEMORY_SCOPE_AGENT); }
DI unsigned xb_xcc_id() { return (unsigned)__builtin_amdgcn_s_getreg((3 << 11) | 20) & 0xFu; }
#define XB_SPIN(cond, bar) do { unsigned _sp = 0; while (cond) { __builtin_amdgcn_s_sleep(1); \
    if ((++_sp & 255u) == 0u) { if (xb_ld(&(bar)[XB_TMO])) break; if (_sp > XB_SPIN_CAP) { atomicAdd(&(bar)[XB_TMO], 1u); break; } } } } while (0)
struct XcdBarrier { unsigned* bar; unsigned x; volatile LAS unsigned* st; };
DI XcdBarrier xcd_barrier_post(unsigned* bar, volatile LAS unsigned* st) {
  XcdBarrier b; b.bar = bar; b.x = xb_xcc_id(); b.st = st;
  if (threadIdx.x == 0) (void)xb_add(&bar[XB_XCNT(b.x)], 1u);
  return b;
}
DI void xcd_barrier_complete(unsigned* bar, unsigned x, unsigned& nloc, unsigned& nx) {
  const unsigned G = gridDim.x * gridDim.y * gridDim.z;
  unsigned sum, cnt, mine, sp = 0u;
  for (;;) {
    sum = 0u; cnt = 0u; mine = 0u;
#pragma unroll
    for (unsigned j = 0; j < 16; ++j) { const unsigned c = xb_ld(&bar[XB_XCNT(j)]); sum += c; cnt += (c > 0u) ? 1u : 0u; mine = (j == x) ? c : mine; }
    if (sum == G) break;
    __builtin_amdgcn_s_sleep(1);
    if ((++sp & 255u) == 0u) { if (xb_ld(&bar[XB_TMO])) break; if (sp > XB_SPIN_CAP) { atomicAdd(&bar[XB_TMO], 1u); break; } }
  }
  nloc = mine > 0u ? mine : 1u; nx = cnt > 0u ? cnt : 1u;
}
DI void xcd_barrier(unsigned* bar_, volatile LAS unsigned* st_) {
  XcdBarrier b; b.bar = bar_; b.st = st_; b.x = 0;
  asm volatile("s_waitcnt vmcnt(0)" ::: "memory");
  __syncthreads();
  if (threadIdx.x == 0) {
    unsigned* bar = b.bar;
    b.x = xb_xcc_id();
    __builtin_amdgcn_s_waitcnt(0);
    unsigned nloc = b.st[0], nx = b.st[1];
    if (nloc == 0u) { xcd_barrier_complete(bar, b.x, nloc, nx); b.st[0] = nloc; b.st[1] = nx; }
    const unsigned old = xb_add(&bar[XB_XSUB(b.x)], 1u);
    const unsigned gen = old / nloc;
    if (old + 1u == (gen + 1u) * nloc) {
      __builtin_amdgcn_fence(__ATOMIC_RELEASE, "agent");
      asm volatile("s_waitcnt vmcnt(0)" ::: "memory");
      const unsigned og = xb_add(&bar[XB_TOP], 1u);
      const unsigned tg = og / nx;
      if (og + 1u == (tg + 1u) * nx) xb_add(&bar[XB_TOPGEN], 1u);
      else XB_SPIN(xb_ld(&bar[XB_TOPGEN]) == tg, bar);
      __builtin_amdgcn_fence(__ATOMIC_ACQUIRE, "agent");
      xb_add(&bar[XB_XGEN(b.x)], 1u);
      asm volatile("s_waitcnt vmcnt(0)" ::: "memory");
    } else {
      XB_SPIN(xb_ld(&bar[XB_XGEN(b.x)]) == gen, bar);
      __builtin_amdgcn_fence(__ATOMIC_ACQUIRE, "agent");
      asm volatile("s_waitcnt vmcnt(0)" ::: "memory");
    }
  }
  __syncthreads();
}

constexpr int GSTR = 72;
constexpr int GBUF = 128 * GSTR;
constexpr int SMEM_BYTES = 4 * GBUF * 2 + 1024;

#ifndef GEMM_GLDS
#define GEMM_GLDS 1
#endif
#if GEMM_GLDS
template <bool ROWSS>
DI void gemm_mainloop(const bf16_t* __restrict__ A, int lda, const bf16_t* __restrict__ B, int ldb, int K,
                      bf16_t* sA_, bf16_t* sB_, f32x16 (&acc)[2][2], float* rs) {
  char* smem = (char*)sA_;
  const int tid = opaque_tid(), lane = tid & 63, w = tid >> 6;
  const int wm = w >> 1, wn = w & 1, r = lane & 31, hh = lane >> 5;
  const int lr = lane >> 3, cp = lane & 7;
  const int cl = cp ^ (((w & 1) << 2) + (lr >> 1));
  const unsigned voA = (unsigned)((w * 8 + lr) * lda + cl * 8) * 2u, voB = (unsigned)((w * 8 + lr) * ldb + cl * 8) * 2u;
  const char* Ab = (const char*)A;
  const char* Bb = (const char*)B;
  const int nk = K >> 6;
  char* sw = smem + __builtin_amdgcn_readfirstlane(w) * 1024;
#define GL_STAGE(buf, ko)                                                                                                \
  { _Pragma("unroll") for (int i_ = 0; i_ < 4; ++i_) {                                                                   \
      __builtin_amdgcn_global_load_lds((const unsigned*)(Ab + (size_t)(i_ * 32 * lda + (ko)) * 2 + voA),                \
                                       (unsigned*)(sw + (buf) * 32768 + i_ * 4096), 16, 0, 0);                          \
      __builtin_amdgcn_global_load_lds((const unsigned*)(Bb + (size_t)(i_ * 32 * ldb + (ko)) * 2 + voB),                \
                                       (unsigned*)(sw + (buf) * 32768 + 16384 + i_ * 4096), 16, 0, 0); } }
  const int t3 = hh ^ ((r >> 1) & 7);
  const int arow = (wm * 64 + r) * 128, brow = 16384 + (wn * 64 + r) * 128;
  const int c0 = ((0 ^ t3) << 4), c1 = ((2 ^ t3) << 4), c2 = ((4 ^ t3) << 4), c3 = ((6 ^ t3) << 4);
#define GL_KK(bufp, cx)                                                                                                  \
  { const bf16x8 a0 = *(const bf16x8*)((bufp) + arow + (cx)), a1 = *(const bf16x8*)((bufp) + arow + 4096 + (cx));        \
    const bf16x8 b0 = *(const bf16x8*)((bufp) + brow + (cx)), b1 = *(const bf16x8*)((bufp) + brow + 4096 + (cx));        \
    acc[0][0] = MFMA(a0, b0, acc[0][0]); acc[0][1] = MFMA(a0, b1, acc[0][1]);                                            \
    acc[1][0] = MFMA(a1, b0, acc[1][0]); acc[1][1] = MFMA(a1, b1, acc[1][1]); }
  GL_STAGE(0, 0)
  asm volatile("s_waitcnt vmcnt(0)" ::: "memory");
  __syncthreads();
  for (int ks = 0; ks < nk; ++ks) {
    const int cur = ks & 1;
    if (ks + 1 < nk) GL_STAGE(cur ^ 1, (ks + 1) * 64)
    const char* bp = smem + cur * 32768;
    GL_KK(bp, c0) GL_KK(bp, c1) GL_KK(bp, c2) GL_KK(bp, c3)
    asm volatile("s_waitcnt vmcnt(0)" ::: "memory");
    __syncthreads();
  }
#undef GL_STAGE
#undef GL_KK
}
#else
template <bool ROWSS>
DI void gemm_mainloop(const bf16_t* __restrict__ A, int lda, const bf16_t* __restrict__ B, int ldb, int K,
                      bf16_t* sA, bf16_t* sB, f32x16 (&acc)[2][2], float* rs) {
  const int tid = threadIdx.x, lane = tid & 63, w = tid >> 6;
  const int wm = w >> 1, wn = w & 1, r = lane & 31, hh = lane >> 5;
  const int lrow = tid >> 3, lch = tid & 7;
  const char* Ab = (const char*)A;
  const char* Bb = (const char*)B;
  const unsigned voA = (unsigned)(lrow * lda + lch * 8) * 2u, voB = (unsigned)(lrow * ldb + lch * 8) * 2u;
  uint4 xa0, xa1, xa2, xa3, xb0, xb1, xb2, xb3, ya0, ya1, ya2, ya3, yb0, yb1, yb2, yb3;
  float ss0 = 0.f, ss1 = 0.f, ss2 = 0.f, ss3 = 0.f;
  const int nk = K >> 6;
#define G_LD1(base, i, ld, ko, vo) (*(const uint4*)((base) + (size_t)((i) * 32 * (ld) + (ko)) * 2 + (vo)))
#define G_LOAD(P, ko)                                                                                                    \
  { P##a0 = G_LD1(Ab, 0, lda, ko, voA); P##a1 = G_LD1(Ab, 1, lda, ko, voA); P##a2 = G_LD1(Ab, 2, lda, ko, voA); P##a3 = G_LD1(Ab, 3, lda, ko, voA); \
    P##b0 = G_LD1(Bb, 0, ldb, ko, voB); P##b1 = G_LD1(Bb, 1, ldb, ko, voB); P##b2 = G_LD1(Bb, 2, ldb, ko, voB); P##b3 = G_LD1(Bb, 3, ldb, ko, voB); }
#define G_SSQ(v, s) { unsigned u_[4] = {v.x, v.y, v.z, v.w}; _Pragma("unroll") for (int j_ = 0; j_ < 4; ++j_) { \
    const float lo_ = __uint_as_float(u_[j_] << 16), hi_ = __uint_as_float(u_[j_] & 0xffff0000u); s += lo_ * lo_ + hi_ * hi_; } }
#define G_WRITE(P, bufo)                                                                                                 \
  { *(uint4*)(sA + (bufo) + woff) = P##a0; *(uint4*)(sA + (bufo) + woff + 32 * GSTR) = P##a1;                            \
    *(uint4*)(sA + (bufo) + woff + 64 * GSTR) = P##a2; *(uint4*)(sA + (bufo) + woff + 96 * GSTR) = P##a3;                \
    *(uint4*)(sB + (bufo) + woff) = P##b0; *(uint4*)(sB + (bufo) + woff + 32 * GSTR) = P##b1;                            \
    *(uint4*)(sB + (bufo) + woff + 64 * GSTR) = P##b2; *(uint4*)(sB + (bufo) + woff + 96 * GSTR) = P##b3;                \
    if (ROWSS) { G_SSQ(P##a0, ss0) G_SSQ(P##a1, ss1) G_SSQ(P##a2, ss2) G_SSQ(P##a3, ss3) } }
#define G_COMPUTE(bufo)                                                                                                  \
  { const bf16_t* cA = sA + (bufo) + (wm * 64 + r) * GSTR + hh * 8;                                                      \
    const bf16_t* cB = sB + (bufo) + (wn * 64 + r) * GSTR + hh * 8;                                                      \
    _Pragma("unroll") for (int kk = 0; kk < 4; ++kk) {                                                                   \
      const bf16x8 a0 = *(const bf16x8*)(cA + kk * 16), a1 = *(const bf16x8*)(cA + 32 * GSTR + kk * 16);                 \
      const bf16x8 b0 = *(const bf16x8*)(cB + kk * 16), b1 = *(const bf16x8*)(cB + 32 * GSTR + kk * 16);                 \
      acc[0][0] = MFMA(a0, b0, acc[0][0]); acc[0][1] = MFMA(a0, b1, acc[0][1]);                                          \
      acc[1][0] = MFMA(a1, b0, acc[1][0]); acc[1][1] = MFMA(a1, b1, acc[1][1]); } }
  const int woff = lrow * GSTR + lch * 8;
  G_LOAD(x, 0)
  G_LOAD(y, 64)
  G_WRITE(x, 0)
  __syncthreads();
  for (int ks = 0; ks < nk; ks += 2) {
    if (ks + 2 < nk) G_LOAD(x, (ks + 2) * 64)
    G_COMPUTE(0)
    G_WRITE(y, GBUF)
    __syncthreads();
    if (ks + 3 < nk) G_LOAD(y, (ks + 3) * 64)
    G_COMPUTE(GBUF)
    if (ks + 2 < nk) G_WRITE(x, 0)
    __syncthreads();
  }
#undef G_LOAD
#undef G_LD1
#undef G_SSQ
#undef G_WRITE
#undef G_COMPUTE
  if (ROWSS) {
    float sv[4] = {ss0, ss1, ss2, ss3};
#pragma unroll
    for (int i = 0; i < 4; ++i) {
      float v = sv[i];
      v += __shfl_xor(v, 1); v += __shfl_xor(v, 2); v += __shfl_xor(v, 4);
      if (lch == 0) rs[lrow + 32 * i] = __builtin_amdgcn_rsqf(v / (float)K + EPSN);
    }
  }
}

#endif

DI void zero_acc(f32x16 (&acc)[2][2]) {
#pragma unroll
  for (int a = 0; a < 2; ++a)
#pragma unroll
    for (int b = 0; b < 2; ++b)
#pragma unroll
      for (int i = 0; i < 16; ++i) acc[a][b][i] = 0.f;
}

constexpr int CSTR = 132;
DI void acc_to_lds(f32x16 (&acc)[2][2], float* sC) {
  const int lane = threadIdx.x & 63, w = threadIdx.x >> 6;
  const int wm = w >> 1, wn = w & 1, r = lane & 31, hh = lane >> 5;
#pragma unroll
  for (int mt = 0; mt < 2; ++mt)
#pragma unroll
    for (int nt = 0; nt < 2; ++nt)
#pragma unroll
      for (int i = 0; i < 16; ++i) sC[(wm * 64 + mt * 32 + crow(i, hh)) * CSTR + wn * 64 + nt * 32 + r] = acc[mt][nt][i];
}
template <class F>
DI void epi_rows(const float* sC, F f) {
  const int tx = opaque_tid();
#pragma unroll
  for (int i = 0; i < 8; ++i) {
    const int c = tx + 256 * i, row = c >> 4, cc = (c & 15) * 8;
    const float4 a = *(const float4*)(sC + row * CSTR + cc), b = *(const float4*)(sC + row * CSTR + cc + 4);
    const float v[8] = {a.x, a.y, a.z, a.w, b.x, b.y, b.z, b.w};
    f(i, row, cc, v);
  }
}
DI void store8(bf16_t* p, const float (&v)[8]) { *(bf16x8*)p = pack8(v[0], v[1], v[2], v[3], v[4], v[5], v[6], v[7]); }
DI void epi_vt(const float* sC, bf16_t* VT, int m0, int head0, int c0, int ncol_log2) {
  const int b = m0 >> 12, s0 = m0 & 4095;
  const int nitems = 16 << ncol_log2;
  for (int c = opaque_tid(); c < nitems; c += 256) {
    const int col = c & ((1 << ncol_log2) - 1), rc = c >> ncol_log2;
    float v[8];
#pragma unroll
    for (int j = 0; j < 8; ++j) v[j] = sC[(rc * 8 + j) * CSTR + c0 + col];
    const int head = head0 + (col >> 6), d = col & 63;
    store8(VT + ((size_t)((b * 8 + head) * 64 + d)) * SEQL + s0 + rc * 8, v);
  }
}
DI void rope8(const float* sC, const float* ROPE, int tok, int row, int cc, float (&v)[8]) {
  const float* pr = sC + row * CSTR + (cc ^ 16);
  const bool upper = (cc & 16) != 0;
  const int f0 = cc & 15;
  const float* tb = ROPE + (size_t)tok * 32;
#pragma unroll
  for (int j = 0; j < 8; ++j) {
    const float o = pr[j], cs = tb[f0 + j], sn = tb[16 + f0 + j];
    v[j] = upper ? (o * sn + v[j] * cs) : (v[j] * cs - o * sn);
  }
}

DI void wconv_unit(const float* __restrict__ src, int Nsrc, int K, bf16_t* __restrict__ dst, const float* __restrict__ gain, int ng, int kg, int mode, float* tile) {
  const int tid = threadIdx.x;
  {
    const int k = tid >> 2, cq = tid & 3;
    const int n = ng * 64 + cq * 16;
    int sc = n;
    if (mode == 1) { sc = (n < 2688) ? n : (n < 5248 ? n + 32 : (n < 5280 ? n - 2560 : -1)); }
    const int kk = kg * 64 + k;
    float4 v[4];
    if (sc >= 0) {
      const float* sp = src + (size_t)kk * Nsrc + sc;
#pragma unroll
      for (int i = 0; i < 4; ++i) v[i] = *(const float4*)(sp + 4 * i);
      if (gain) { const float g = gain[kk];
#pragma unroll
        for (int i = 0; i < 4; ++i) { v[i].x *= g; v[i].y *= g; v[i].z *= g; v[i].w *= g; } }
    } else {
#pragma unroll
      for (int i = 0; i < 4; ++i) v[i] = make_float4(0.f, 0.f, 0.f, 0.f);
    }
    float* tp = tile + k * 65 + cq * 16;
#pragma unroll
    for (int i = 0; i < 4; ++i) { tp[4 * i] = v[i].x; tp[4 * i + 1] = v[i].y; tp[4 * i + 2] = v[i].z; tp[4 * i + 3] = v[i].w; }
  }
  __syncthreads();
  {
    const int n = tid >> 2, kc = tid & 3;
    float o[16];
#pragma unroll
    for (int j = 0; j < 16; ++j) o[j] = tile[(kc * 16 + j) * 65 + n];
    bf16_t* dp = dst + (size_t)(ng * 64 + n) * K + kg * 64 + kc * 16;
    *(bf16x8*)dp = pack8(o[0], o[1], o[2], o[3], o[4], o[5], o[6], o[7]);
    *(bf16x8*)(dp + 8) = pack8(o[8], o[9], o[10], o[11], o[12], o[13], o[14], o[15]);
  }
  __syncthreads();
}

DI void phase_prep(const Params& p, char* smem) {
  const int tid = threadIdx.x;
  if (blockIdx.x == 0 && tid < 16) { p.counter()[tid] = 0; }
  for (int i = blockIdx.x * NTHREADS + tid; i < 2 * NTOK; i += gridDim.x * NTHREADS) p.SSQ()[i] = 0.f;
  constexpr int U_MOD = 96 * 4, U_WIN = 84 * 16, U_WUQ = 12 * 6, U_WUKV = 16 * 4, U_WA = 16 * 8, U_WB = 16 * 8, U_WO = 16 * 16, U_ROPE = 1024;
  constexpr int U_TOTAL = U_MOD + U_ROPE + U_WIN + U_WUQ + U_WUKV + U_WA + U_WB + U_WO;
  float* tile = (float*)smem;
  for (int u = blockIdx.x; u < U_TOTAL; u += gridDim.x) {
    int v = u;
    if (v < U_MOD) {
      const int cg32 = v >> 2, kq = v & 3, n0 = cg32 * 32;
      const int kgp = tid >> 5, col = tid & 31;
      const int kb = kq * 256 + kgp * 32;
      float a0 = 0.f, a1 = 0.f, a2 = 0.f, a3 = 0.f;
      const float* wp = p.w_ada + (size_t)kb * 3072 + n0 + col;
      float wv[32];
#pragma unroll
      for (int kk = 0; kk < 32; ++kk) wv[kk] = wp[(size_t)kk * 3072];
#pragma unroll
      for (int kk = 0; kk < 32; ++kk) {
        a0 += wv[kk] * p.c[kb + kk]; a1 += wv[kk] * p.c[1024 + kb + kk]; a2 += wv[kk] * p.c[2048 + kb + kk]; a3 += wv[kk] * p.c[3072 + kb + kk];
      }
      float* red = (float*)smem;
      red[(kgp * 4 + 0) * 32 + col] = a0; red[(kgp * 4 + 1) * 32 + col] = a1; red[(kgp * 4 + 2) * 32 + col] = a2; red[(kgp * 4 + 3) * 32 + col] = a3;
      __syncthreads();
      if (tid < 128) {
        const int b = tid >> 5, cc = tid & 31;
        float s = (kq == 0) ? p.b_ada[n0 + cc] : 0.f;
#pragma unroll
        for (int g = 0; g < 8; ++g) s += red[(g * 4 + b) * 32 + cc];
        p.MOD()[(size_t)(b * 3072 + n0 + cc) * 4 + kq] = s;
      }
      __syncthreads();
      continue;
    }
    v -= U_MOD;
    if (v < U_WIN) { wconv_unit(p.w_in, INW, 1024, p.WinT(), nullptr, v >> 4, v & 15, 1, tile); continue; }
    v -= U_WIN;
    if (v < U_WUQ) { wconv_unit(p.w_uq, 768, 384, p.WuqT(), p.q_gain, v / 6, v % 6, 0, tile); continue; }
    v -= U_WUQ;
    if (v < U_WUKV) { wconv_unit(p.w_ukv, 1024, 256, p.WukvT(), p.kv_gain, v >> 2, v & 3, 0, tile); continue; }
    v -= U_WUKV;
    if (v < U_WA) { wconv_unit(p.w_a, 1024, 512, p.WaT(), nullptr, v >> 3, v & 7, 0, tile); continue; }
    v -= U_WA;
    if (v < U_WB) { wconv_unit(p.w_b, 1024, 512, p.WbT(), nullptr, v >> 3, v & 7, 0, tile); continue; }
    v -= U_WB;
    if (v < U_WO) { wconv_unit(p.w_out, 1024, 1024, p.WoT(), nullptr, v >> 4, v & 15, 0, tile); continue; }
    v -= U_WO;
    {
      const int idx = v * 256 + tid, tok = idx >> 4, i = idx & 15;
      const float ang = (float)p.pos[tok] * c_invfreq[i];
      double t = (double)ang * 0.15915494309189535;
      t -= rint(t);
      const float tf = (float)t;
      p.ROPE()[(size_t)tok * 32 + i] = __builtin_amdgcn_cosf(tf);
      p.ROPE()[(size_t)tok * 32 + 16 + i] = __builtin_amdgcn_sinf(tf);
    }
  }
}

DI float mod_get(const float* MOD, int b, int n) { const float4 q = *(const float4*)(MOD + (size_t)(b * 3072 + n) * 4); return (q.x + q.y) + (q.z + q.w); }

DI void phase_h(const Params& p, char* smem) {
  const int tid = opaque_tid(), lane = tid & 63, w = tid >> 6;
  float* gs = (float*)smem;
  float* sh = gs + 1024;
  for (int rg = blockIdx.x; rg < NTOK / 32; rg += gridDim.x) {
    const int b = (rg * 32) >> 12;
    __syncthreads();
#pragma unroll
    for (int i = 0; i < 4; ++i) {
      const int k = tid + 256 * i;
      gs[k] = p.norm_gain[k] * (1.f + mod_get(p.MOD(), b, 1024 + k));
      sh[k] = mod_get(p.MOD(), b, k);
    }
    __syncthreads();
#pragma unroll 2
    for (int rr = 0; rr < 8; ++rr) {
      const int row = rg * 32 + w * 8 + rr;
      const float* xr = p.x + (size_t)row * DM;
      float4 v[4];
      float ss = 0.f;
#pragma unroll
      for (int i = 0; i < 2; ++i) {
        const int e = 8 * (lane + 64 * i);
        v[2 * i] = *(const float4*)(xr + e);
        v[2 * i + 1] = *(const float4*)(xr + e + 4);
        ss += v[2 * i].x * v[2 * i].x + v[2 * i].y * v[2 * i].y + v[2 * i].z * v[2 * i].z + v[2 * i].w * v[2 * i].w;
        ss += v[2 * i + 1].x * v[2 * i + 1].x + v[2 * i + 1].y * v[2 * i + 1].y + v[2 * i + 1].z * v[2 * i + 1].z + v[2 * i + 1].w * v[2 * i + 1].w;
      }
#pragma unroll
      for (int o = 32; o >= 1; o >>= 1) ss += __shfl_xor(ss, o);
      const float rn = __builtin_amdgcn_rsqf(ss * (1.f / DM) + EPSN);
#pragma unroll
      for (int i = 0; i < 2; ++i) {
        const int e = 8 * (lane + 64 * i);
        const float4 g0 = *(const float4*)(gs + e), g1 = *(const float4*)(gs + e + 4);
        const float4 s0 = *(const float4*)(sh + e), s1 = *(const float4*)(sh + e + 4);
        *(bf16x8*)(p.Hb() + (size_t)row * DM + e) =
            pack8(v[2 * i].x * rn * g0.x + s0.x, v[2 * i].y * rn * g0.y + s0.y, v[2 * i].z * rn * g0.z + s0.z, v[2 * i].w * rn * g0.w + s0.w,
                  v[2 * i + 1].x * rn * g1.x + s1.x, v[2 * i + 1].y * rn * g1.y + s1.y, v[2 * i + 1].z * rn * g1.z + s1.z, v[2 * i + 1].w * rn * g1.w + s1.w);
      }
    }
  }
  __syncthreads();
}

DI void phase_g1(const Params& p, char* smem, bool do_ssq = true) {
  bf16_t* sA = (bf16_t*)smem;
  bf16_t* sB = sA + 2 * GBUF;
  float* sC = (float*)smem;
  float* rs = (float*)(smem + 4 * GBUF * 2);
  constexpr int NCT = INWP / 128;
  const int ntiles = (NTOK / 128) * NCT;
  for (int t = blockIdx.x; t < ntiles; t += gridDim.x) {
    const int rt = t / NCT, ct = t % NCT;
    const int m0 = rt * 128, n0 = ct * 128;
    f32x16 acc[2][2];
    zero_acc(acc);
    gemm_mainloop<false>(p.Hb() + (size_t)m0 * DM, DM, p.WinT() + (size_t)n0 * DM, DM, DM, sA, sB, acc, rs);
    acc_to_lds(acc, sC);
    __syncthreads();
    if (ct < 4) {
      epi_rows(sC, [&](int, int row, int cc, const float (&v)[8]) {
        float o[8];
#pragma unroll
        for (int j = 0; j < 8; ++j) o[j] = v[j] * QS_SCALE;
        store8(p.Qsb() + (size_t)(m0 + row) * 512 + n0 + cc, o); });
    } else if (ct < 8) {
      epi_rows(sC, [&](int, int row, int cc, const float (&v)[8]) { store8(p.Ksb() + (size_t)(m0 + row) * 512 + n0 - 512 + cc, v); });
    } else if (ct < 12) {
      epi_vt(sC, p.VTsb(), m0, (n0 - 1024) >> 6, 0, 7);
    } else if (ct < 16) {
      epi_rows(sC, [&](int, int row, int cc, const float (&v)[8]) {
        float o[8];
#pragma unroll
        for (int j = 0; j < 8; ++j) o[j] = siluf_fast(v[j]);
        store8(p.Zsb() + (size_t)(m0 + row) * 512 + n0 - 1536 + cc, o); });
    } else if (ct < 19) {
      epi_rows(sC, [&](int, int row, int cc, const float (&v)[8]) {
        store8(p.CQ() + (size_t)(m0 + row) * 384 + n0 - 2048 + cc, v);
        float q = 0.f;
#pragma unroll
        for (int j = 0; j < 8; ++j) q += v[j] * v[j];
        q += __shfl_xor(q, 1); q += __shfl_xor(q, 2); q += __shfl_xor(q, 4); q += __shfl_xor(q, 8);
        if (do_ssq && (threadIdx.x & 15) == 0) atomicAdd(p.SSQ() + m0 + row, q); });
    } else if (ct < 21) {
      epi_rows(sC, [&](int, int row, int cc, const float (&v)[8]) {
        store8(p.CKV() + (size_t)(m0 + row) * 256 + n0 - 2432 + cc, v);
        float q = 0.f;
#pragma unroll
        for (int j = 0; j < 8; ++j) q += v[j] * v[j];
        q += __shfl_xor(q, 1); q += __shfl_xor(q, 2); q += __shfl_xor(q, 4); q += __shfl_xor(q, 8);
        if (do_ssq && (threadIdx.x & 15) == 0) atomicAdd(p.SSQ() + NTOK + m0 + row, q); });
    } else if (ct < 25) {
      epi_rows(sC, [&](int, int row, int cc, const float (&v)[8]) {
        float o[8];
#pragma unroll
        for (int j = 0; j < 8; ++j) o[j] = siluf_fast(v[j]);
        store8(p.Zmla() + (size_t)(m0 + row) * 512 + n0 - 2688 + cc, o); });
    } else if (ct < 33) {
      epi_rows(sC, [&](int, int row, int cc, const float (&v)[8]) {
        float o[8];
#pragma unroll
        for (int j = 0; j < 8; ++j) o[j] = sigmoidf_fast(v[j]);
        store8(p.GA() + (size_t)(m0 + row) * 1024 + n0 - 3200 + cc, o); });
    } else if (ct < 41) {
      epi_rows(sC, [&](int, int row, int cc, const float (&v)[8]) {
        float o[8];
#pragma unroll
        for (int j = 0; j < 8; ++j) o[j] = sigmoidf_fast(v[j]);
        store8(p.GB() + (size_t)(m0 + row) * 1024 + n0 - 4224 + cc, o); });
    } else {
      epi_rows(sC, [&](int, int row, int cc, const float (&v)[8]) {
        if (cc < 32) {
          float o[8];
#pragma unroll
          for (int j = 0; j < 8; ++j) o[j] = v[j];
          rope8(sC, p.ROPE(), m0 + row, row, cc, o);
          store8(p.KPE() + (size_t)(m0 + row) * 32 + cc, o);
        } });
    }
    __syncthreads();
  }
}

DI void phase_g2(const Params& p, char* smem) {
  bf16_t* sA = (bf16_t*)smem;
  bf16_t* sB = sA + 2 * GBUF;
  float* sC = (float*)smem;
  float* rs = (float*)(smem + 4 * GBUF * 2);
  constexpr int NQ = 128 * 6, NKV = 128 * 8;
  for (int t = blockIdx.x; t < NQ + NKV; t += gridDim.x) {
    f32x16 acc[2][2];
    zero_acc(acc);
    if (t < NQ) {
      const int rt = t / 6, ct = t % 6, m0 = rt * 128, n0 = ct * 128;
      if (threadIdx.x < 128) rs[threadIdx.x] = __builtin_amdgcn_rsqf(p.SSQ()[m0 + threadIdx.x] * (1.f / 384.f) + EPSN);
      gemm_mainloop<false>(p.CQ() + (size_t)m0 * 384, 384, p.WuqT() + (size_t)n0 * 384, 384, 384, sA, sB, acc, rs);
      acc_to_lds(acc, sC);
      __syncthreads();
      epi_rows(sC, [&](int, int row, int cc, const float (&v)[8]) {
        const int col = n0 + cc;
        float o[8];
#pragma unroll
        for (int j = 0; j < 8; ++j) o[j] = v[j];
        if (((col >> 5) % 3) == 2) rope8(sC, p.ROPE(), m0 + row, row, cc, o);
        const float sc = rs[row] * QM_SCALE;
#pragma unroll
        for (int j = 0; j < 8; ++j) o[j] *= sc;
        store8(p.Qmla() + (size_t)(m0 + row) * 768 + col, o);
      });
    } else {
      const int t2 = t - NQ;
      const int rt = t2 >> 3, head = t2 & 7, m0 = rt * 128, n0 = head * 128;
      if (threadIdx.x < 128) rs[threadIdx.x] = __builtin_amdgcn_rsqf(p.SSQ()[NTOK + m0 + threadIdx.x] * (1.f / 256.f) + EPSN);
      gemm_mainloop<false>(p.CKV() + (size_t)m0 * 256, 256, p.WukvT() + (size_t)n0 * 256, 256, 256, sA, sB, acc, rs);
      acc_to_lds(acc, sC);
      __syncthreads();
      epi_rows(sC, [&](int, int row, int cc, const float (&v)[8]) {
        if (cc < 64) {
          const float sc = rs[row];
          float o[8];
#pragma unroll
          for (int j = 0; j < 8; ++j) o[j] = v[j] * sc;
          store8(p.Knope() + (size_t)(m0 + row) * 512 + head * 64 + cc, o);
        } });
      {
        const int b = m0 >> 12, s0 = m0 & 4095;
        for (int c = opaque_tid(); c < 1024; c += 256) {
          const int col = c & 63, rc = c >> 6;
          float v[8];
#pragma unroll
          for (int j = 0; j < 8; ++j) v[j] = sC[(rc * 8 + j) * CSTR + 64 + col] * rs[rc * 8 + j];
          store8(p.VTmla() + ((size_t)((b * 8 + head) * 64 + col)) * SEQL + s0 + rc * 8, v);
        }
      }
    }
    __syncthreads();
  }
}

constexpr int VSTR = 68;

template <bool MLA>
DI void attn_item(const Params& p, int b, int h, int qb, char* smem) {
  constexpr int DK = MLA ? 96 : 64;
  constexpr int KSTR = MLA ? 104 : 72;
  constexpr int NKS = DK / 16;
  bf16_t* sK = (bf16_t*)smem;
  bf16_t* sV = sK + 2 * 64 * KSTR;
  const int tid = threadIdx.x, lane = tid & 63, w = tid >> 6, r = lane & 31, hh = lane >> 5;
  const int tokb = b * SEQL;
  const int tok0 = tokb + qb * 128;
  const int qw = qb * 128 + w * 32;

  bf16x8 qf[NKS];
  {
    const bf16_t* qptr = MLA ? (p.Qmla() + (size_t)(tok0 + w * 32 + r) * 768 + h * 96 + hh * 8) : (p.Qsb() + (size_t)(tok0 + w * 32 + r) * 512 + h * 64 + hh * 8);
#pragma unroll
    for (int ks = 0; ks < NKS; ++ks) qf[ks] = *(const bf16x8*)(qptr + ks * 16);
  }
  bf16x8 tf[2];
  if (!MLA) {
#pragma unroll
    for (int st = 0; st < 2; ++st)
#pragma unroll
      for (int e = 0; e < 8; ++e) { const int j = 16 * st + 8 * (e >> 2) + 4 * hh + (e & 3); tf[st][e] = (j >= r) ? (short)0x3F80 : (short)0; }
  }

  f32x16 oacc[2];
#pragma unroll
  for (int i = 0; i < 16; ++i) { oacc[0][i] = 0.f; oacc[1][i] = 0.f; }
  float carry = 0.f;
  float mrun = -1e30f, lrun = 0.f;

  const bf16_t* Kg = MLA ? p.Knope() : p.Ksb();
  const bf16_t* VTg = (MLA ? p.VTmla() : p.VTsb()) + (size_t)((b * 8 + h) * 64) * SEQL;
  const int nt = 2 * qb + 2;

  uint4 xk0, xk1, xv0, xv1, xp, yk0, yk1, yv0, yv1, yp;
  xp = make_uint4(0, 0, 0, 0); yp = xp;
  const int prow = tid >> 3, pch = tid & 7;
  const bf16_t* kgp = Kg + (size_t)(tokb + prow) * 512 + h * 64 + pch * 8;
  const bf16_t* vgp = VTg + (size_t)prow * SEQL + pch * 8;
  const bf16_t* pgp = p.KPE() + (size_t)(tokb + (tid >> 2)) * 32 + (tid & 3) * 8;
#define ATT_GLOAD(P, kt_)                                                          \
  {                                                                                \
    const int kt__ = (kt_);                                                        \
    P##k0 = *(const uint4*)(kgp + (size_t)(kt__ * 64) * 512);                      \
    P##k1 = *(const uint4*)(kgp + (size_t)(kt__ * 64 + 32) * 512);                 \
    P##v0 = *(const uint4*)(vgp + kt__ * 64);                                      \
    P##v1 = *(const uint4*)(vgp + (size_t)32 * SEQL + kt__ * 64);                  \
    if (MLA) P##p = *(const uint4*)(pgp + (size_t)(kt__ * 64) * 32);               \
  }
#define ATT_SWRITE(P, buf_)                                                        \
  {                                                                                \
    bf16_t* dK = sK + (buf_) * 64 * KSTR;                                          \
    bf16_t* dV = sV + (buf_) * 64 * VSTR;                                          \
    *(uint4*)(dK + prow * KSTR + pch * 8) = P##k0;                                 \
    *(uint4*)(dK + (prow + 32) * KSTR + pch * 8) = P##k1;                          \
    uint2* dv0 = (uint2*)(dV + prow * VSTR + pch * 8);                             \
    dv0[0] = make_uint2(P##v0.x, P##v0.y); dv0[1] = make_uint2(P##v0.z, P##v0.w);  \
    uint2* dv1 = (uint2*)(dV + (prow + 32) * VSTR + pch * 8);                      \
    dv1[0] = make_uint2(P##v1.x, P##v1.y); dv1[1] = make_uint2(P##v1.z, P##v1.w);  \
    if (MLA) *(uint4*)(dK + (tid >> 2) * KSTR + 64 + (tid & 3) * 8) = P##p;        \
  }
#define ATT_KT(i_) (MLA ? (i_) : (nt - 1 - (i_)))

  ATT_GLOAD(x, ATT_KT(0));
  ATT_GLOAD(y, ATT_KT(1));
  ATT_SWRITE(x, 0);
  __syncthreads();
  bool alive = true;
  for (int it0 = 0; alive; it0 += 2) {
#pragma unroll
   for (int half = 0; half < 2; ++half) {
    const int it = it0 + half;
    const int kt = ATT_KT(it);
    const int cur = half;
    const bool more = (it + 1 < nt);
    if (it + 2 < nt) { if (half == 0) ATT_GLOAD(x, ATT_KT(it + 2)) else ATT_GLOAD(y, ATT_KT(it + 2)) }
    const bf16_t* cK = sK + cur * 64 * KSTR;
    const bf16_t* cV = sV + cur * 64 * VSTR;
#pragma unroll
    for (int si = 0; si < 2; ++si) {
      const int sub = MLA ? si : (1 - si);
      const int kb = kt * 64 + sub * 32;
      if (kb > qw) continue;
      const bool diag = (kb == qw);
      f32x16 s;
#pragma unroll
      for (int i = 0; i < 16; ++i) s[i] = 0.f;
#pragma unroll
      for (int ks = 0; ks < NKS; ++ks) {
        const bf16x8 kf = *(const bf16x8*)(cK + (sub * 32 + r) * KSTR + ks * 16 + hh * 8);
        s = MFMA(kf, qf[ks], s);
      }
      bf16x8 pf[2];
      if (!MLA) {
        float sp[16];
        float tsum = 0.f;
#pragma unroll
        for (int i = 0; i < 16; ++i) {
          const float z = s[i];
          float v = fmaxf(z, 0.f) + __builtin_amdgcn_logf(1.f + __builtin_amdgcn_exp2f(-fabsf(z)));
          if (diag && !(crow(i, hh) < r)) v = 0.f;
          sp[i] = v;
          tsum += v;
        }
        f32x16 cacc;
#pragma unroll
        for (int i = 0; i < 16; ++i) cacc[i] = carry;
        cacc = MFMA(tf[0], pack8(sp[0], sp[1], sp[2], sp[3], sp[4], sp[5], sp[6], sp[7]), cacc);
        cacc = MFMA(tf[1], pack8(sp[8], sp[9], sp[10], sp[11], sp[12], sp[13], sp[14], sp[15]), cacc);
        float pr[16];
#pragma unroll
        for (int i = 0; i < 16; ++i) {
          float v = __builtin_amdgcn_exp2f(s[i] - cacc[i]);
          if (diag && !(crow(i, hh) < r)) v = 0.f;
          pr[i] = v;
        }
        carry += half_sum(tsum);
        pf[0] = pack8(pr[0], pr[1], pr[2], pr[3], pr[4], pr[5], pr[6], pr[7]);
        pf[1] = pack8(pr[8], pr[9], pr[10], pr[11], pr[12], pr[13], pr[14], pr[15]);
      } else {
        float mloc = -1e30f;
#pragma unroll
        for (int i = 0; i < 16; ++i) {
          if (diag && !(crow(i, hh) <= r)) s[i] = -1e30f;
          mloc = fmaxf(mloc, s[i]);
        }
        mloc = half_max(mloc);
        const float mnew = fmaxf(mrun, mloc);
        const float alpha = __builtin_amdgcn_exp2f(mrun - mnew);
        mrun = mnew;
        float pr[16];
        float psum = 0.f;
#pragma unroll
        for (int i = 0; i < 16; ++i) { pr[i] = __builtin_amdgcn_exp2f(s[i] - mnew); psum += pr[i]; }
        lrun = lrun * alpha + psum;
#pragma unroll
        for (int i = 0; i < 16; ++i) { oacc[0][i] *= alpha; oacc[1][i] *= alpha; }
        pf[0] = pack8(pr[0], pr[1], pr[2], pr[3], pr[4], pr[5], pr[6], pr[7]);
        pf[1] = pack8(pr[8], pr[9], pr[10], pr[11], pr[12], pr[13], pr[14], pr[15]);
      }
#pragma unroll
      for (int dt = 0; dt < 2; ++dt)
#pragma unroll
        for (int st = 0; st < 2; ++st) {
          const bf16_t* vp = cV + (dt * 32 + r) * VSTR + sub * 32 + st * 16 + 4 * hh;
          const s16x4 lo = *(const s16x4*)vp;
          const s16x4 hi = *(const s16x4*)(vp + 8);
          const bf16x8 vf = __builtin_shufflevector(lo, hi, 0, 1, 2, 3, 4, 5, 6, 7);
          oacc[dt] = MFMA(vf, pf[st], oacc[dt]);
        }
    }
    if (more) { if (half == 0) ATT_SWRITE(y, 1) else ATT_SWRITE(x, 0) }
    if (!MLA) {
      int* flg = (int*)(smem + SMEM_BYTES - 64) + (it & 1) * 4;
      const bool wok = (__builtin_amdgcn_ballot_w64(carry >= 160.f) == ~0ull);
      if (lane == 0) flg[w] = wok ? 1 : 0;
      __syncthreads();
      alive = more && ((flg[0] & flg[1] & flg[2] & flg[3]) == 0);
    } else {
      __syncthreads();
      alive = more;
    }
    if (!alive) break;
   }
  }
#undef ATT_GLOAD
#undef ATT_SWRITE
#undef ATT_KT
  float inv = 1.f;
  if (MLA) { const float lt = half_sum(lrun); inv = 1.f / lt; }
  const int tok = tok0 + w * 32 + r;
  const bf16_t* zg = (MLA ? p.Zmla() : p.Zsb()) + (size_t)tok * 512 + h * 64;
  bf16_t* og = (MLA ? p.OBg() : p.OAg()) + (size_t)tok * 512 + h * 64;
#pragma unroll
  for (int dt = 0; dt < 2; ++dt)
#pragma unroll
    for (int g = 0; g < 4; ++g) {
      const int d = dt * 32 + 8 * g + 4 * hh;
      const u32x2 zz = *(const u32x2*)(zg + d);
      const float z0 = __uint_as_float(zz[0] << 16), z1 = __uint_as_float(zz[0] & 0xffff0000u);
      const float z2 = __uint_as_float(zz[1] << 16), z3 = __uint_as_float(zz[1] & 0xffff0000u);
      u32x2 o;
      o[0] = pk2(oacc[dt][4 * g] * inv * z0, oacc[dt][4 * g + 1] * inv * z1);
      o[1] = pk2(oacc[dt][4 * g + 2] * inv * z2, oacc[dt][4 * g + 3] * inv * z3);
      *(u32x2*)(og + d) = o;
    }
}

DI void phase_attn(const Params& p, char* smem, int cbase, int only) {
  int* s_item = (int*)(smem + SMEM_BYTES - 16);
  const int q0 = blockIdx.x & 7;
  int qi = 0;
  for (;;) {
    if (threadIdx.x == 0) {
      int item = -1;
      while (qi < 8) {
        const int q = (q0 + qi) & 7;
        const int idx = atomicAdd(p.counter() + cbase + q, 1);
        if (idx < 256) { item = q * 256 + idx; break; }
        ++qi;
      }
      *s_item = item;
    }
    __syncthreads();
    const int item = *s_item;
    __syncthreads();
    if (item < 0) break;
    const int q = item >> 8, idx = item & 255;
    const int grp = idx >> 5;
    const int bh = q + 8 * (grp >> 1);
    const int qb = 31 - (idx & 31);
    if ((grp & 1) == 0) { if (only != 2) attn_item<true>(p, bh >> 3, bh & 7, qb, smem); }
    else { if (only != 1) attn_item<false>(p, bh >> 3, bh & 7, qb, smem); }
  }
}

DI void phase_g3(const Params& p, char* smem) {
  bf16_t* sA = (bf16_t*)smem;
  bf16_t* sB = sA + 2 * GBUF;
  float* sC = (float*)smem;
  float* rs = (float*)(smem + 4 * GBUF * 2);
  for (int t = blockIdx.x; t < 128 * 8; t += gridDim.x) {
    const int rt = t >> 3, ct = t & 7, m0 = rt * 128, n0 = ct * 128;
    f32x16 acc[2][2];
    zero_acc(acc);
    gemm_mainloop<false>(p.OAg() + (size_t)m0 * 512, 512, p.WaT() + (size_t)n0 * 512, 512, 512, sA, sB, acc, rs);
    acc_to_lds(acc, sC);
    __syncthreads();
    const int txo = opaque_tid();
#pragma unroll
    for (int i = 0; i < 8; ++i) {
      const int c = txo + 256 * i, row = c >> 4, cc = (c & 15) * 8;
      const u32x4 g = *(const u32x4*)(p.GA() + (size_t)(m0 + row) * 1024 + n0 + cc);
      const float4 a = *(const float4*)(sC + row * CSTR + cc), b = *(const float4*)(sC + row * CSTR + cc + 4);
      u32x4 y;
      y[0] = pk2(a.x * __uint_as_float(g[0] << 16), a.y * __uint_as_float(g[0] & 0xffff0000u));
      y[1] = pk2(a.z * __uint_as_float(g[1] << 16), a.w * __uint_as_float(g[1] & 0xffff0000u));
      y[2] = pk2(b.x * __uint_as_float(g[2] << 16), b.y * __uint_as_float(g[2] & 0xffff0000u));
      y[3] = pk2(b.z * __uint_as_float(g[3] << 16), b.w * __uint_as_float(g[3] & 0xffff0000u));
      *(u32x4*)(p.MERGED() + (size_t)(m0 + row) * 1024 + n0 + cc) = y;
    }
    __syncthreads();
    zero_acc(acc);
    gemm_mainloop<false>(p.OBg() + (size_t)m0 * 512, 512, p.WbT() + (size_t)n0 * 512, 512, 512, sA, sB, acc, rs);
    acc_to_lds(acc, sC);
    __syncthreads();
    const int txo2 = opaque_tid();
#pragma unroll
    for (int i = 0; i < 8; ++i) {
      const int c = txo2 + 256 * i, row = c >> 4, cc = (c & 15) * 8;
      const u32x4 g = *(const u32x4*)(p.GB() + (size_t)(m0 + row) * 1024 + n0 + cc);
      const u32x4 yv = *(const u32x4*)(p.MERGED() + (size_t)(m0 + row) * 1024 + n0 + cc);
      const float4 a = *(const float4*)(sC + row * CSTR + cc), b = *(const float4*)(sC + row * CSTR + cc + 4);
      u32x4 o;
      o[0] = pk2(__uint_as_float(yv[0] << 16) + a.x * __uint_as_float(g[0] << 16), __uint_as_float(yv[0] & 0xffff0000u) + a.y * __uint_as_float(g[0] & 0xffff0000u));
      o[1] = pk2(__uint_as_float(yv[1] << 16) + a.z * __uint_as_float(g[1] << 16), __uint_as_float(yv[1] & 0xffff0000u) + a.w * __uint_as_float(g[1] & 0xffff0000u));
      o[2] = pk2(__uint_as_float(yv[2] << 16) + b.x * __uint_as_float(g[2] << 16), __uint_as_float(yv[2] & 0xffff0000u) + b.y * __uint_as_float(g[2] & 0xffff0000u));
      o[3] = pk2(__uint_as_float(yv[3] << 16) + b.z * __uint_as_float(g[3] << 16), __uint_as_float(yv[3] & 0xffff0000u) + b.w * __uint_as_float(g[3] & 0xffff0000u));
      *(u32x4*)(p.MERGED() + (size_t)(m0 + row) * 1024 + n0 + cc) = o;
    }
    __syncthreads();
  }
}

DI void phase_g4(const Params& p, char* smem) {
  bf16_t* sA = (bf16_t*)smem;
  bf16_t* sB = sA + 2 * GBUF;
  float* sC = (float*)smem;
  float* rs = (float*)(smem + 4 * GBUF * 2);
  for (int t = blockIdx.x; t < 128 * 8; t += gridDim.x) {
    const int rt = t >> 3, ct = t & 7, m0 = rt * 128, n0 = ct * 128;
    f32x16 acc[2][2];
    zero_acc(acc);
    if (threadIdx.x < 128) rs[threadIdx.x] = mod_get(p.MOD(), m0 >> 12, 2048 + n0 + threadIdx.x);
    gemm_mainloop<false>(p.MERGED() + (size_t)m0 * 1024, 1024, p.WoT() + (size_t)n0 * 1024, 1024, 1024, sA, sB, acc, rs);
    acc_to_lds(acc, sC);
    __syncthreads();
    const int txo = opaque_tid();
#pragma unroll
    for (int i = 0; i < 8; ++i) {
      const int c = txo + 256 * i, row = c >> 4, cc = (c & 15) * 8;
      const size_t go = (size_t)(m0 + row) * 1024 + n0 + cc;
      const float4 x0 = *(const float4*)(p.x + go), x1 = *(const float4*)(p.x + go + 4);
      const float4 a = *(const float4*)(sC + row * CSTR + cc), b = *(const float4*)(sC + row * CSTR + cc + 4);
      const float4 g0 = *(const float4*)(rs + cc), g1 = *(const float4*)(rs + cc + 4);
      float4 o0, o1;
      o0.x = x0.x + g0.x * a.x; o0.y = x0.y + g0.y * a.y; o0.z = x0.z + g0.z * a.z; o0.w = x0.w + g0.w * a.w;
      o1.x = x1.x + g1.x * b.x; o1.y = x1.y + g1.y * b.y; o1.z = x1.z + g1.z * b.z; o1.w = x1.w + g1.w * b.w;
      *(float4*)(p.out + go) = o0;
      *(float4*)(p.out + go + 4) = o1;
    }
    __syncthreads();
  }
}

DI void phase_final(const Params& p) {
  const int lane = threadIdx.x & 63, w = threadIdx.x >> 6;
  const int gw = blockIdx.x * 4 + w, nw = gridDim.x * 4;
  for (int row = gw; row < NTOK; row += nw) {
    float* xr = p.out + (size_t)row * DM;
    float4 v[4];
    float ss = 0.f;
#pragma unroll
    for (int i = 0; i < 4; ++i) {
      v[i] = *(const float4*)(xr + 4 * (lane + 64 * i));
      ss += v[i].x * v[i].x + v[i].y * v[i].y + v[i].z * v[i].z + v[i].w * v[i].w;
    }
#pragma unroll
    for (int o = 32; o >= 1; o >>= 1) ss += __shfl_xor(ss, o);
    const float rn = __builtin_amdgcn_rsqf(ss * (1.f / DM) + EPSN);
#pragma unroll
    for (int i = 0; i < 4; ++i) {
      const int e = 4 * (lane + 64 * i);
      const float4 g = *(const float4*)(p.fgain + e);
      float4 o;
      o.x = v[i].x * rn * g.x; o.y = v[i].y * rn * g.y; o.z = v[i].z * rn * g.z; o.w = v[i].w * rn * g.w;
      *(float4*)(xr + e) = o;
    }
  }
}

template <int PH>
__global__ void __launch_bounds__(NTHREADS, 2) mega_kernel(Params p) {
  __shared__ __attribute__((aligned(16))) char smem[SMEM_BYTES];
  if (PH < 0) {
    if (p.ws == nullptr) cg::this_grid().sync();
    volatile LAS unsigned* xst = (volatile LAS unsigned*)(smem + SMEM_BYTES - 32);
    if (threadIdx.x == 0) { xst[0] = 0u; xst[1] = 0u; }
    __syncthreads();
    (void)xcd_barrier_post(p.bar(), xst);
    phase_prep(p, smem); xcd_barrier(p.bar(), (volatile LAS unsigned*)(smem + SMEM_BYTES - 32));
#if PROBE_DUP == 4
    phase_prep(p, smem); xcd_barrier(p.bar(), (volatile LAS unsigned*)(smem + SMEM_BYTES - 32));
#endif
    phase_h(p, smem); xcd_barrier(p.bar(), (volatile LAS unsigned*)(smem + SMEM_BYTES - 32));
#if PROBE_DUP == 5
    phase_h(p, smem); xcd_barrier(p.bar(), (volatile LAS unsigned*)(smem + SMEM_BYTES - 32));
#endif
    phase_g1(p, smem); xcd_barrier(p.bar(), (volatile LAS unsigned*)(smem + SMEM_BYTES - 32));
#if PROBE_DUP == 1
    phase_g1(p, smem, false); xcd_barrier(p.bar(), (volatile LAS unsigned*)(smem + SMEM_BYTES - 32));
#endif
    phase_g2(p, smem); xcd_barrier(p.bar(), (volatile LAS unsigned*)(smem + SMEM_BYTES - 32));
#if PROBE_DUP == 8
    phase_g2(p, smem); xcd_barrier(p.bar(), (volatile LAS unsigned*)(smem + SMEM_BYTES - 32));
#endif
    phase_attn(p, smem, 0, 0); xcd_barrier(p.bar(), (volatile LAS unsigned*)(smem + SMEM_BYTES - 32));
#if PROBE_DUP == 2
    phase_attn(p, smem, 8, 1); xcd_barrier(p.bar(), (volatile LAS unsigned*)(smem + SMEM_BYTES - 32));
#endif
#if PROBE_DUP == 3
    phase_attn(p, smem, 8, 2); xcd_barrier(p.bar(), (volatile LAS unsigned*)(smem + SMEM_BYTES - 32));
#endif
    phase_g3(p, smem); xcd_barrier(p.bar(), (volatile LAS unsigned*)(smem + SMEM_BYTES - 32));
#if PROBE_DUP == 6
    phase_g3(p, smem); xcd_barrier(p.bar(), (volatile LAS unsigned*)(smem + SMEM_BYTES - 32));
#endif
    phase_g4(p, smem); xcd_barrier(p.bar(), (volatile LAS unsigned*)(smem + SMEM_BYTES - 32));
#if PROBE_DUP == 7
    phase_g4(p, smem); xcd_barrier(p.bar(), (volatile LAS unsigned*)(smem + SMEM_BYTES - 32));
#endif
    phase_final(p);
  } else {
    if (PH == 0) phase_prep(p, smem);
    if (PH == 1) phase_h(p, smem);
    if (PH == 2) phase_g1(p, smem);
    if (PH == 3) phase_g2(p, smem);
    if (PH == 4) phase_attn(p, smem, 0, 0);
    if (PH == 5) phase_g3(p, smem);
    if (PH == 6) phase_g4(p, smem);
    if (PH == 7) phase_final(p);
  }
}

#ifndef PROBE_DUP
#define PROBE_DUP 0
#endif
#ifndef MK_SPLIT
#define MK_SPLIT 0
#endif

extern "C" void kernel_launch(void* const* d_in, const int* in_sizes, int n_in, void* d_out, int out_size, void* d_ws, size_t ws_size, hipStream_t stream) {
  Params p{};
  p.x = (const float*)d_in[0]; p.c = (const float*)d_in[1]; p.pos = (const int*)d_in[2];
  p.w_ada = (const float*)d_in[3]; p.b_ada = (const float*)d_in[4]; p.norm_gain = (const float*)d_in[5];
  p.w_in = (const float*)d_in[6]; p.q_gain = (const float*)d_in[7]; p.w_uq = (const float*)d_in[8];
  p.kv_gain = (const float*)d_in[9]; p.w_ukv = (const float*)d_in[10]; p.w_a = (const float*)d_in[11];
  p.w_b = (const float*)d_in[12]; p.w_out = (const float*)d_in[13]; p.fgain = (const float*)d_in[14];
  p.out = (float*)d_out;
  p.ws = (char*)d_ws;
  if (WS_NEED > ws_size) { fprintf(stderr, "workspace too small: need %zu have %zu\n", (size_t)WS_NEED, ws_size); return; }

  static int grid_blocks = 0;
  if (!grid_blocks) {
    int dev = 0, cus = 0, per_cu = 0;
    hipGetDevice(&dev);
    hipDeviceGetAttribute(&cus, hipDeviceAttributeMultiprocessorCount, dev);
    hipOccupancyMaxActiveBlocksPerMultiprocessor(&per_cu, mega_kernel<-1>, NTHREADS, 0);
    if (per_cu > 2) per_cu = 2;
    if (per_cu < 1) per_cu = 1;
    grid_blocks = cus * per_cu;
  }
#if MK_SPLIT
  mega_kernel<0><<<grid_blocks, NTHREADS, 0, stream>>>(p);
  mega_kernel<1><<<grid_blocks, NTHREADS, 0, stream>>>(p);
  mega_kernel<2><<<grid_blocks, NTHREADS, 0, stream>>>(p);
  mega_kernel<3><<<grid_blocks, NTHREADS, 0, stream>>>(p);
  mega_kernel<4><<<grid_blocks, NTHREADS, 0, stream>>>(p);
  mega_kernel<5><<<grid_blocks, NTHREADS, 0, stream>>>(p);
  mega_kernel<6><<<grid_blocks, NTHREADS, 0, stream>>>(p);
  mega_kernel<7><<<grid_blocks, NTHREADS, 0, stream>>>(p);
#else
  hipMemsetAsync((char*)d_ws + OFF_bar, 0, XCD_BAR_WORDS * 4, stream);
  void* args[] = {&p};
  hipError_t e = hipLaunchCooperativeKernel((void*)mega_kernel<-1>, dim3(grid_blocks), dim3(NTHREADS), args, 0, stream);
  if (e != hipSuccess) fprintf(stderr, "cooperative launch failed: %s (grid %d)\n", hipGetErrorString(e), grid_blocks);
#endif
}
```

```cpp
#include <hip/hip_runtime.h>
#include <hip/hip_cooperative_groups.h>
#include <stdint.h>
#include <stdio.h>
namespace cg = cooperative_groups;
#ifndef PROBE_DUP
#define PROBE_DUP 0
#endif

#define DI __device__ __forceinline__
typedef unsigned short bf16_t;
typedef __attribute__((ext_vector_type(8))) short bf16x8;
typedef __attribute__((ext_vector_type(4))) short s16x4;
typedef __attribute__((ext_vector_type(16))) float f32x16;
typedef __attribute__((ext_vector_type(2))) float f32x2;
typedef __attribute__((ext_vector_type(2))) __bf16 bf16x2v;
typedef __attribute__((ext_vector_type(4))) unsigned u32x4;
typedef __attribute__((ext_vector_type(2))) unsigned u32x2;
#define MFMA(a, b, c) __builtin_amdgcn_mfma_f32_32x32x16_bf16((a), (b), (c), 0, 0, 0)

constexpr int NTOK = 16384, SEQL = 4096, DM = 1024;
constexpr int INW = 5280, INWP = 5376;
constexpr int NTHREADS = 256;
constexpr float LOG2E = 1.4426950408889634f;
constexpr float QS_SCALE = 0.125f * 1.4426950408889634f;
constexpr float QM_SCALE = 1.4426950408889634f / 9.797958971132712f;
constexpr float EPSN = 1e-6f;

constexpr int XCD_BAR_WORDS_C = 3456;
constexpr size_t al256(size_t v) { return (v + 255) & ~(size_t)255; }
constexpr size_t OFF_counter = 0;
constexpr size_t OFF_bar = OFF_counter + al256(256);
constexpr size_t OFF_MOD = OFF_bar + al256(XCD_BAR_WORDS_C * 4);
constexpr size_t OFF_ROPE = OFF_MOD + al256(4 * 3072 * 4 * 4);
constexpr size_t OFF_SSQ = OFF_ROPE + al256((size_t)NTOK * 32 * 4);
constexpr size_t OFF_Hb = OFF_SSQ + al256((size_t)2 * NTOK * 4);
constexpr size_t OFF_Qmla = OFF_Hb + al256((size_t)NTOK * 1024 * 2);
constexpr size_t OFF_WuqT = OFF_Qmla + al256((size_t)NTOK * 768 * 2);
constexpr size_t OFF_WukvT = OFF_WuqT + al256((size_t)768 * 384 * 2);
constexpr size_t OFF_WaT = OFF_WukvT + al256((size_t)1024 * 256 * 2);
constexpr size_t OFF_WbT = OFF_WaT + al256((size_t)1024 * 512 * 2);
constexpr size_t OFF_WoT = OFF_WbT + al256((size_t)1024 * 512 * 2);
constexpr size_t OFF_Qsb = OFF_WoT + al256((size_t)1024 * 1024 * 2);
constexpr size_t OFF_Ksb = OFF_Qsb + al256((size_t)NTOK * 512 * 2);
constexpr size_t OFF_VTsb = OFF_Ksb + al256((size_t)NTOK * 512 * 2);
constexpr size_t OFF_Zsb = OFF_VTsb + al256((size_t)NTOK * 512 * 2);
constexpr size_t OFF_OAg = OFF_Zsb + al256((size_t)NTOK * 512 * 2);
constexpr size_t OFF_OBg = OFF_OAg + al256((size_t)NTOK * 512 * 2);
constexpr size_t OFF_Zmla = OFF_OBg + al256((size_t)NTOK * 512 * 2);
constexpr size_t OFF_KPE = OFF_Zmla + al256((size_t)NTOK * 512 * 2);
constexpr size_t OFF_Knope = OFF_KPE + al256((size_t)NTOK * 32 * 2);
constexpr size_t OFF_VTmla = OFF_Knope + al256((size_t)NTOK * 512 * 2);
constexpr size_t WS_NEED = OFF_VTmla + al256((size_t)NTOK * 512 * 2);
struct Params {
  const float *x, *c; const int* pos;
  const float *w_ada, *b_ada, *norm_gain, *w_in, *q_gain, *w_uq, *kv_gain, *w_ukv, *w_a, *w_b, *w_out, *fgain;
  float* out;
  char* ws;
  DI int* counter() const { return (int*)(ws + OFF_counter); }
  DI unsigned* bar() const { return (unsigned*)(ws + OFF_bar); }
  DI float* MOD() const { return (float*)(ws + OFF_MOD); }
  DI float* ROPE() const { return (float*)(ws + OFF_ROPE); }
  DI float* SSQ() const { return (float*)(ws + OFF_SSQ); }
  DI bf16_t* Hb() const { return (bf16_t*)(ws + OFF_Hb); }
  DI bf16_t* Qmla() const { return (bf16_t*)(ws + OFF_Qmla); }
  DI bf16_t* WuqT() const { return (bf16_t*)(ws + OFF_WuqT); }
  DI bf16_t* WukvT() const { return (bf16_t*)(ws + OFF_WukvT); }
  DI bf16_t* WaT() const { return (bf16_t*)(ws + OFF_WaT); }
  DI bf16_t* WbT() const { return (bf16_t*)(ws + OFF_WbT); }
  DI bf16_t* WoT() const { return (bf16_t*)(ws + OFF_WoT); }
  DI bf16_t* Qsb() const { return (bf16_t*)(ws + OFF_Qsb); }
  DI bf16_t* Ksb() const { return (bf16_t*)(ws + OFF_Ksb); }
  DI bf16_t* VTsb() const { return (bf16_t*)(ws + OFF_VTsb); }
  DI bf16_t* Zsb() const { return (bf16_t*)(ws + OFF_Zsb); }
  DI bf16_t* OAg() const { return (bf16_t*)(ws + OFF_OAg); }
  DI bf16_t* OBg() const { return (bf16_t*)(ws + OFF_OBg); }
  DI bf16_t* Zmla() const { return (bf16_t*)(ws + OFF_Zmla); }
  DI bf16_t* KPE() const { return (bf16_t*)(ws + OFF_KPE); }
  DI bf16_t* Knope() const { return (bf16_t*)(ws + OFF_Knope); }
  DI bf16_t* VTmla() const { return (bf16_t*)(ws + OFF_VTmla); }
  DI bf16_t* MERGED() const { return Hb(); }
  DI bf16_t* WinT() const { return Qmla(); }
  DI bf16_t* CQ() const { return OAg(); }
  DI bf16_t* CKV() const { return OBg(); }
  DI bf16_t* GA() const { return (bf16_t*)out; }
  DI bf16_t* GB() const { return (bf16_t*)out + (size_t)NTOK * 1024; }
};


__device__ const float c_invfreq[16] = {
  1.0f, 0.5623413251903491f, 0.31622776601683794f, 0.1778279410038923f, 0.1f, 0.05623413251903491f, 0.03162277660168379f,
  0.01778279410038923f, 0.01f, 0.005623413251903491f, 0.0031622776601683794f, 0.001778279410038923f, 0.001f,
  0.0005623413251903491f, 0.00031622776601683794f, 0.0001778279410038923f};

DI unsigned pk2(float a, float b) { f32x2 v = {a, b}; bf16x2v r = __builtin_convertvector(v, bf16x2v); return __builtin_bit_cast(unsigned, r); }
DI bf16_t tobf(float a) { return (bf16_t)(pk2(a, 0.f) & 0xffffu); }
DI float bf2f(unsigned short u) { return __uint_as_float(((unsigned)u) << 16); }
DI bf16x8 pack8(float a0, float a1, float a2, float a3, float a4, float a5, float a6, float a7) {
  u32x4 p; p[0] = pk2(a0, a1); p[1] = pk2(a2, a3); p[2] = pk2(a4, a5); p[3] = pk2(a6, a7);
  return __builtin_bit_cast(bf16x8, p);
}
DI int crow(int reg, int h) { return (reg & 3) + 8 * (reg >> 2) + 4 * h; }
DI int opaque_tid() { int t = threadIdx.x; asm volatile("" : "+v"(t)); return t; }
DI float half_max(float v) {
  unsigned u = __float_as_uint(v);
  auto r = __builtin_amdgcn_permlane32_swap(u, u, false, false);
  return fmaxf(__uint_as_float(r[0]), __uint_as_float(r[1]));
}
DI float half_sum(float v) {
  unsigned u = __float_as_uint(v);
  auto r = __builtin_amdgcn_permlane32_swap(u, u, false, false);
  return __uint_as_float(r[0]) + __uint_as_float(r[1]);
}
DI float sigmoidf_fast(float v) { return __builtin_amdgcn_rcpf(1.f + __builtin_amdgcn_exp2f(-v * LOG2E)); }
DI float siluf_fast(float v) { return v * sigmoidf_fast(v); }

#define XB_TMO      128
#define XB_XCNT(j)  (256  + 64 * (j))
#define XB_XSUB(j)  (1280 + 64 * (j))
#define XB_XGEN(j)  (2304 + 64 * (j))
#define XB_TOP      3328
#define XB_TOPGEN   3392
#define XCD_BAR_WORDS 3456
#define XB_SPIN_CAP (1u << 18)
#define LAS __attribute__((address_space(3)))
DI unsigned xb_ld(unsigned* p)              { return __hip_atomic_load(p, __ATOMIC_RELAXED, __HIP_MEMORY_SCOPE_AGENT); }
DI unsigned xb_add(unsigned* p, unsigned v) { return __hip_atomic_fetch_add(p, v, __ATOMIC_RELAXED, __HIP_MEMORY_SCOPE_AGENT); }
DI unsigned xb_xcc_id() { return (unsigned)__builtin_amdgcn_s_getreg((3 << 11) | 20) & 0xFu; }
#define XB_SPIN(cond, bar) do { unsigned _sp = 0; while (cond) { __builtin_amdgcn_s_sleep(1); \
    if ((++_sp & 255u) == 0u) { if (xb_ld(&(bar)[XB_TMO])) break; if (_sp > XB_SPIN_CAP) { atomicAdd(&(bar)[XB_TMO], 1u); break; } } } } while (0)
struct XcdBarrier { unsigned* bar; unsigned x; volatile LAS unsigned* st; };
DI XcdBarrier xcd_barrier_post(unsigned* bar, volatile LAS unsigned* st) {
  XcdBarrier b; b.bar = bar; b.x = xb_xcc_id(); b.st = st;
  if (threadIdx.x == 0) (void)xb_add(&bar[XB_XCNT(b.x)], 1u);
  return b;
}
DI void xcd_barrier_complete(unsigned* bar, unsigned x, unsigned& nloc, unsigned& nx) {
  const unsigned G = gridDim.x * gridDim.y * gridDim.z;
  unsigned sum, cnt, mine, sp = 0u;
  for (;;) {
    sum = 0u; cnt = 0u; mine = 0u;
#pragma unroll
    for (unsigned j = 0; j < 16; ++j) { const unsigned c = xb_ld(&bar[XB_XCNT(j)]); sum += c; cnt += (c > 0u) ? 1u : 0u; mine = (j == x) ? c : mine; }
    if (sum == G) break;
    __builtin_amdgcn_s_sleep(1);
    if ((++sp & 255u) == 0u) { if (xb_ld(&bar[XB_TMO])) break; if (sp > XB_SPIN_CAP) { atomicAdd(&bar[XB_TMO], 1u); break; } }
  }
  nloc = mine > 0u ? mine : 1u; nx = cnt > 0u ? cnt : 1u;
}
DI void xcd_barrier(unsigned* bar_, volatile LAS unsigned* st_) {
  XcdBarrier b; b.bar = bar_; b.st = st_; b.x = 0;
  asm volatile("s_waitcnt vmcnt(0)" ::: "memory");
  __syncthreads();
  if (threadIdx.x == 0) {
    unsigned* bar = b.bar;
    b.x = xb_xcc_id();
    __builtin_amdgcn_s_waitcnt(0);
    unsigned nloc = b.st[0], nx = b.st[1];
    if (nloc == 0u) { xcd_barrier_complete(bar, b.x, nloc, nx); b.st[0] = nloc; b.st[1] = nx; }
    const unsigned old = xb_add(&bar[XB_XSUB(b.x)], 1u);
    const unsigned gen = old / nloc;
    if (old + 1u == (gen + 1u) * nloc) {
      __builtin_amdgcn_fence(__ATOMIC_RELEASE, "agent");
      asm volatile("s_waitcnt vmcnt(0)" ::: "memory");
      const unsigned og = xb_add(&bar[XB_TOP], 1u);
      const unsigned tg = og / nx;
      if (og + 1u == (tg + 1u) * nx) xb_add(&bar[XB_TOPGEN], 1u);
      else XB_SPIN(xb_ld(&bar[XB_TOPGEN]) == tg, bar);
      __builtin_amdgcn_fence(__ATOMIC_ACQUIRE, "agent");
      xb_add(&bar[XB_XGEN(b.x)], 1u);
      asm volatile("s_waitcnt vmcnt(0)" ::: "memory");
    } else {
      XB_SPIN(xb_ld(&bar[XB_XGEN(b.x)]) == gen, bar);
      __builtin_amdgcn_fence(__ATOMIC_ACQUIRE, "agent");
      asm volatile("s_waitcnt vmcnt(0)" ::: "memory");
    }
  }
  __syncthreads();
}

constexpr int GSTR = 72;
constexpr int GBUF = 128 * GSTR;
constexpr int SMEM_BYTES = 4 * GBUF * 2 + 1024;

#ifndef GEMM_GLDS
#define GEMM_GLDS 1
#endif
#if GEMM_GLDS
template <bool ROWSS>
DI void gemm_mainloop(const bf16_t* __restrict__ A, int lda, const bf16_t* __restrict__ B, int ldb, int K,
                      bf16_t* sA_, bf16_t* sB_, f32x16 (&acc)[2][2], float* rs) {
  char* smem = (char*)sA_;
  const int tid = opaque_tid(), lane = tid & 63, w = tid >> 6;
  const int wm = w >> 1, wn = w & 1, r = lane & 31, hh = lane >> 5;
  const int lr = lane >> 3, cp = lane & 7;
  const int cl = cp ^ (((w & 1) << 2) + (lr >> 1));
  const unsigned voA = (unsigned)((w * 8 + lr) * lda + cl * 8) * 2u, voB = (unsigned)((w * 8 + lr) * ldb + cl * 8) * 2u;
  const char* Ab = (const char*)A;
  const char* Bb = (const char*)B;
  const int nk = K >> 6;
  char* sw = smem + __builtin_amdgcn_readfirstlane(w) * 1024;
#define GL_STAGE(buf, ko)                                                                                                \
  { _Pragma("unroll") for (int i_ = 0; i_ < 4; ++i_) {                                                                   \
      __builtin_amdgcn_global_load_lds((const unsigned*)(Ab + (size_t)(i_ * 32 * lda + (ko)) * 2 + voA),                \
                                       (unsigned*)(sw + (buf) * 32768 + i_ * 4096), 16, 0, 0);                          \
      __builtin_amdgcn_global_load_lds((const unsigned*)(Bb + (size_t)(i_ * 32 * ldb + (ko)) * 2 + voB),                \
                                       (unsigned*)(sw + (buf) * 32768 + 16384 + i_ * 4096), 16, 0, 0); } }
  const int t3 = hh ^ ((r >> 1) & 7);
  const int arow = (wm * 64 + r) * 128, brow = 16384 + (wn * 64 + r) * 128;
  const int c0 = ((0 ^ t3) << 4), c1 = ((2 ^ t3) << 4), c2 = ((4 ^ t3) << 4), c3 = ((6 ^ t3) << 4);
#define GL_KK(bufp, cx)                                                                                                  \
  { const bf16x8 a0 = *(const bf16x8*)((bufp) + arow + (cx)), a1 = *(const bf16x8*)((bufp) + arow + 4096 + (cx));        \
    const bf16x8 b0 = *(const bf16x8*)((bufp) + brow + (cx)), b1 = *(const bf16x8*)((bufp) + brow + 4096 + (cx));        \
    acc[0][0] = MFMA(a0, b0, acc[0][0]); acc[0][1] = MFMA(a0, b1, acc[0][1]);                                            \
    acc[1][0] = MFMA(a1, b0, acc[1][0]); acc[1][1] = MFMA(a1, b1, acc[1][1]); }
  GL_STAGE(0, 0)
  asm volatile("s_waitcnt vmcnt(0)" ::: "memory");
  __syncthreads();
  for (int ks = 0; ks < nk; ++ks) {
    const int cur = ks & 1;
    if (ks + 1 < nk) GL_STAGE(cur ^ 1, (ks + 1) * 64)
    const char* bp = smem + cur * 32768;
    GL_KK(bp, c0) GL_KK(bp, c1) GL_KK(bp, c2) GL_KK(bp, c3)
    asm volatile("s_waitcnt vmcnt(0)" ::: "memory");
    __syncthreads();
  }
#undef GL_STAGE
#undef GL_KK
}
#else
template <bool ROWSS>
DI void gemm_mainloop(const bf16_t* __restrict__ A, int lda, const bf16_t* __restrict__ B, int ldb, int K,
                      bf16_t* sA, bf16_t* sB, f32x16 (&acc)[2][2], float* rs) {
  const int tid = threadIdx.x, lane = tid & 63, w = tid >> 6;
  const int wm = w >> 1, wn = w & 1, r = lane & 31, hh = lane >> 5;
  const int lrow = tid >> 3, lch = tid & 7;
  const char* Ab = (const char*)A;
  const char* Bb = (const char*)B;
  const unsigned voA = (unsigned)(lrow * lda + lch * 8) * 2u, voB = (unsigned)(lrow * ldb + lch * 8) * 2u;
  uint4 xa0, xa1, xa2, xa3, xb0, xb1, xb2, xb3, ya0, ya1, ya2, ya3, yb0, yb1, yb2, yb3;
  float ss0 = 0.f, ss1 = 0.f, ss2 = 0.f, ss3 = 0.f;
  const int nk = K >> 6;
#define G_LD1(base, i, ld, ko, vo) (*(const uint4*)((base) + (size_t)((i) * 32 * (ld) + (ko)) * 2 + (vo)))
#define G_LOAD(P, ko)                                                                                                    \
  { P##a0 = G_LD1(Ab, 0, lda, ko, voA); P##a1 = G_LD1(Ab, 1, lda, ko, voA); P##a2 = G_LD1(Ab, 2, lda, ko, voA); P##a3 = G_LD1(Ab, 3, lda, ko, voA); \
    P##b0 = G_LD1(Bb, 0, ldb, ko, voB); P##b1 = G_LD1(Bb, 1, ldb, ko, voB); P##b2 = G_LD1(Bb, 2, ldb, ko, voB); P##b3 = G_LD1(Bb, 3, ldb, ko, voB); }
#define G_SSQ(v, s) { unsigned u_[4] = {v.x, v.y, v.z, v.w}; _Pragma("unroll") for (int j_ = 0; j_ < 4; ++j_) { \
    const float lo_ = __uint_as_float(u_[j_] << 16), hi_ = __uint_as_float(u_[j_] & 0xffff0000u); s += lo_ * lo_ + hi_ * hi_; } }
#define G_WRITE(P, bufo)                                                                                                 \
  { *(uint4*)(sA + (bufo) + woff) = P##a0; *(uint4*)(sA + (bufo) + woff + 32 * GSTR) = P##a1;                            \
    *(uint4*)(sA + (bufo) + woff + 64 * GSTR) = P##a2; *(uint4*)(sA + (bufo) + woff + 96 * GSTR) = P##a3;                \
    *(uint4*)(sB + (bufo) + woff) = P##b0; *(uint4*)(sB + (bufo) + woff + 32 * GSTR) = P##b1;                            \
    *(uint4*)(sB + (bufo) + woff + 64 * GSTR) = P##b2; *(uint4*)(sB + (bufo) + woff + 96 * GSTR) = P##b3;                \
    if (ROWSS) { G_SSQ(P##a0, ss0) G_SSQ(P##a1, ss1) G_SSQ(P##a2, ss2) G_SSQ(P##a3, ss3) } }
#define G_COMPUTE(bufo)                                                                                                  \
  { const bf16_t* cA = sA + (bufo) + (wm * 64 + r) * GSTR + hh * 8;                                                      \
    const bf16_t* cB = sB + (bufo) + (wn * 64 + r) * GSTR + hh * 8;                                                      \
    _Pragma("unroll") for (int kk = 0; kk < 4; ++kk) {                                                                   \
      const bf16x8 a0 = *(const bf16x8*)(cA + kk * 16), a1 = *(const bf16x8*)(cA + 32 * GSTR + kk * 16);                 \
      const bf16x8 b0 = *(const bf16x8*)(cB + kk * 16), b1 = *(const bf16x8*)(cB + 32 * GSTR + kk * 16);                 \
      acc[0][0] = MFMA(a0, b0, acc[0][0]); acc[0][1] = MFMA(a0, b1, acc[0][1]);                                          \
      acc[1][0] = MFMA(a1, b0, acc[1][0]); acc[1][1] = MFMA(a1, b1, acc[1][1]); } }
  const int woff = lrow * GSTR + lch * 8;
  G_LOAD(x, 0)
  G_LOAD(y, 64)
  G_WRITE(x, 0)
  __syncthreads();
  for (int ks = 0; ks < nk; ks += 2) {
    if (ks + 2 < nk) G_LOAD(x, (ks + 2) * 64)
    G_COMPUTE(0)
    G_WRITE(y, GBUF)
    __syncthreads();
    if (ks + 3 < nk) G_LOAD(y, (ks + 3) * 64)
    G_COMPUTE(GBUF)
    if (ks + 2 < nk) G_WRITE(x, 0)
    __syncthreads();
  }
#undef G_LOAD
#undef G_LD1
#undef G_SSQ
#undef G_WRITE
#undef G_COMPUTE
  if (ROWSS) {
    float sv[4] = {ss0, ss1, ss2, ss3};
#pragma unroll
    for (int i = 0; i < 4; ++i) {
      float v = sv[i];
      v += __shfl_xor(v, 1); v += __shfl_xor(v, 2); v += __shfl_xor(v, 4);
      if (lch == 0) rs[lrow + 32 * i] = __builtin_amdgcn_rsqf(v / (float)K + EPSN);
    }
  }
}

#endif

DI void zero_acc(f32x16 (&acc)[2][2]) {
#pragma unroll
  for (int a = 0; a < 2; ++a)
#pragma unroll
    for (int b = 0; b < 2; ++b)
#pragma unroll
      for (int i = 0; i < 16; ++i) acc[a][b][i] = 0.f;
}

constexpr int CSTR = 132;
DI void acc_to_lds(f32x16 (&acc)[2][2], float* sC) {
  const int lane = threadIdx.x & 63, w = threadIdx.x >> 6;
  const int wm = w >> 1, wn = w & 1, r = lane & 31, hh = lane >> 5;
#pragma unroll
  for (int mt = 0; mt < 2; ++mt)
#pragma unroll
    for (int nt = 0; nt < 2; ++nt)
#pragma unroll
      for (int i = 0; i < 16; ++i) sC[(wm * 64 + mt * 32 + crow(i, hh)) * CSTR + wn * 64 + nt * 32 + r] = acc[mt][nt][i];
}
template <class F>
DI void epi_rows(const float* sC, F f) {
  const int tx = opaque_tid();
#pragma unroll
  for (int i = 0; i < 8; ++i) {
    const int c = tx + 256 * i, row = c >> 4, cc = (c & 15) * 8;
    const float4 a = *(const float4*)(sC + row * CSTR + cc), b = *(const float4*)(sC + row * CSTR + cc + 4);
    const float v[8] = {a.x, a.y, a.z, a.w, b.x, b.y, b.z, b.w};
    f(i, row, cc, v);
  }
}
DI void store8(bf16_t* p, const float (&v)[8]) { *(bf16x8*)p = pack8(v[0], v[1], v[2], v[3], v[4], v[5], v[6], v[7]); }
DI void epi_vt(const float* sC, bf16_t* VT, int m0, int head0, int c0, int ncol_log2) {
  const int b = m0 >> 12, s0 = m0 & 4095;
  const int nitems = 16 << ncol_log2;
  for (int c = opaque_tid(); c < nitems; c += 256) {
    const int col = c & ((1 << ncol_log2) - 1), rc = c >> ncol_log2;
    float v[8];
#pragma unroll
    for (int j = 0; j < 8; ++j) v[j] = sC[(rc * 8 + j) * CSTR + c0 + col];
    const int head = head0 + (col >> 6), d = col & 63;
    store8(VT + ((size_t)((b * 8 + head) * 64 + d)) * SEQL + s0 + rc * 8, v);
  }
}
DI void rope8(const float* sC, const float* ROPE, int tok, int row, int cc, float (&v)[8]) {
  const float* pr = sC + row * CSTR + (cc ^ 16);
  const bool upper = (cc & 16) != 0;
  const int f0 = cc & 15;
  const float* tb = ROPE + (size_t)tok * 32;
#pragma unroll
  for (int j = 0; j < 8; ++j) {
    const float o = pr[j], cs = tb[f0 + j], sn = tb[16 + f0 + j];
    v[j] = upper ? (o * sn + v[j] * cs) : (v[j] * cs - o * sn);
  }
}

DI void wconv_unit(const float* __restrict__ src, int Nsrc, int K, bf16_t* __restrict__ dst, const float* __restrict__ gain, int ng, int kg, int mode, float* tile) {
  const int tid = threadIdx.x;
  {
    const int k = tid >> 2, cq = tid & 3;
    const int n = ng * 64 + cq * 16;
    int sc = n;
    if (mode == 1) { sc = (n < 2688) ? n : (n < 5248 ? n + 32 : (n < 5280 ? n - 2560 : -1)); }
    const int kk = kg * 64 + k;
    float4 v[4];
    if (sc >= 0) {
      const float* sp = src + (size_t)kk * Nsrc + sc;
#pragma unroll
      for (int i = 0; i < 4; ++i) v[i] = *(const float4*)(sp + 4 * i);
      if (gain) { const float g = gain[kk];
#pragma unroll
        for (int i = 0; i < 4; ++i) { v[i].x *= g; v[i].y *= g; v[i].z *= g; v[i].w *= g; } }
    } else {
#pragma unroll
      for (int i = 0; i < 4; ++i) v[i] = make_float4(0.f, 0.f, 0.f, 0.f);
    }
    float* tp = tile + k * 65 + cq * 16;
#pragma unroll
    for (int i = 0; i < 4; ++i) { tp[4 * i] = v[i].x; tp[4 * i + 1] = v[i].y; tp[4 * i + 2] = v[i].z; tp[4 * i + 3] = v[i].w; }
  }
  __syncthreads();
  {
    const int n = tid >> 2, kc = tid & 3;
    float o[16];
#pragma unroll
    for (int j = 0; j < 16; ++j) o[j] = tile[(kc * 16 + j) * 65 + n];
    bf16_t* dp = dst + (size_t)(ng * 64 + n) * K + kg * 64 + kc * 16;
    *(bf16x8*)dp = pack8(o[0], o[1], o[2], o[3], o[4], o[5], o[6], o[7]);
    *(bf16x8*)(dp + 8) = pack8(o[8], o[9], o[10], o[11], o[12], o[13], o[14], o[15]);
  }
  __syncthreads();
}

DI void phase_prep(const Params& p, char* smem) {
  const int tid = threadIdx.x;
  if (blockIdx.x == 0 && tid < 16) { p.counter()[tid] = 0; }
  for (int i = blockIdx.x * NTHREADS + tid; i < 2 * NTOK; i += gridDim.x * NTHREADS) p.SSQ()[i] = 0.f;
  constexpr int U_MOD = 96 * 4, U_WIN = 84 * 16, U_WUQ = 12 * 6, U_WUKV = 16 * 4, U_WA = 16 * 8, U_WB = 16 * 8, U_WO = 16 * 16, U_ROPE = 1024;
  constexpr int U_TOTAL = U_MOD + U_ROPE + U_WIN + U_WUQ + U_WUKV + U_WA + U_WB + U_WO;
  float* tile = (float*)smem;
  for (int u = blockIdx.x; u < U_TOTAL; u += gridDim.x) {
    int v = u;
    if (v < U_MOD) {
      const int cg32 = v >> 2, kq = v & 3, n0 = cg32 * 32;
      const int kgp = tid >> 5, col = tid & 31;
      const int kb = kq * 256 + kgp * 32;
      float a0 = 0.f, a1 = 0.f, a2 = 0.f, a3 = 0.f;
      const float* wp = p.w_ada + (size_t)kb * 3072 + n0 + col;
      float wv[32];
#pragma unroll
      for (int kk = 0; kk < 32; ++kk) wv[kk] = wp[(size_t)kk * 3072];
#pragma unroll
      for (int kk = 0; kk < 32; ++kk) {
        a0 += wv[kk] * p.c[kb + kk]; a1 += wv[kk] * p.c[1024 + kb + kk]; a2 += wv[kk] * p.c[2048 + kb + kk]; a3 += wv[kk] * p.c[3072 + kb + kk];
      }
      float* red = (float*)smem;
      red[(kgp * 4 + 0) * 32 + col] = a0; red[(kgp * 4 + 1) * 32 + col] = a1; red[(kgp * 4 + 2) * 32 + col] = a2; red[(kgp * 4 + 3) * 32 + col] = a3;
      __syncthreads();
      if (tid < 128) {
        const int b = tid >> 5, cc = tid & 31;
        float s = (kq == 0) ? p.b_ada[n0 + cc] : 0.f;
#pragma unroll
        for (int g = 0; g < 8; ++g) s += red[(g * 4 + b) * 32 + cc];
        p.MOD()[(size_t)(b * 3072 + n0 + cc) * 4 + kq] = s;
      }
      __syncthreads();
      continue;
    }
    v -= U_MOD;
    if (v < U_WIN) { wconv_unit(p.w_in, INW, 1024, p.WinT(), nullptr, v >> 4, v & 15, 1, tile); continue; }
    v -= U_WIN;
    if (v < U_WUQ) { wconv_unit(p.w_uq, 768, 384, p.WuqT(), p.q_gain, v / 6, v % 6, 0, tile); continue; }
    v -= U_WUQ;
    if (v < U_WUKV) { wconv_unit(p.w_ukv, 1024, 256, p.WukvT(), p.kv_gain, v >> 2, v & 3, 0, tile); continue; }
    v -= U_WUKV;
    if (v < U_WA) { wconv_unit(p.w_a, 1024, 512, p.WaT(), nullptr, v >> 3, v & 7, 0, tile); continue; }
    v -= U_WA;
    if (v < U_WB) { wconv_unit(p.w_b, 1024, 512, p.WbT(), nullptr, v >> 3, v & 7, 0, tile); continue; }
    v -= U_WB;
    if (v < U_WO) { wconv_unit(p.w_out, 1024, 1024, p.WoT(), nullptr, v >> 4, v & 15, 0, tile); continue; }
    v -= U_WO;
    {
      const int idx = v * 256 + tid, tok = idx >> 4, i = idx & 15;
      const float ang = (float)p.pos[tok] * c_invfreq[i];
      double t = (double)ang * 0.15915494309189535;
      t -= rint(t);
      const float tf = (float)t;
      p.ROPE()[(size_t)tok * 32 + i] = __builtin_amdgcn_cosf(tf);
      p.ROPE()[(size_t)tok * 32 + 16 + i] = __builtin_amdgcn_sinf(tf);
    }
  }
}

DI float mod_get(const float* MOD, int b, int n) { const float4 q = *(const float4*)(MOD + (size_t)(b * 3072 + n) * 4); return (q.x + q.y) + (q.z + q.w); }

DI void phase_h(const Params& p, char* smem) {
  const int tid = opaque_tid(), lane = tid & 63, w = tid >> 6;
  float* gs = (float*)smem;
  float* sh = gs + 1024;
  for (int rg = blockIdx.x; rg < NTOK / 32; rg += gridDim.x) {
    const int b = (rg * 32) >> 12;
    __syncthreads();
#pragma unroll
    for (int i = 0; i < 4; ++i) {
      const int k = tid + 256 * i;
      gs[k] = p.norm_gain[k] * (1.f + mod_get(p.MOD(), b, 1024 + k));
      sh[k] = mod_get(p.MOD(), b, k);
    }
    __syncthreads();
#pragma unroll 2
    for (int rr = 0; rr < 8; ++rr) {
      const int row = rg * 32 + w * 8 + rr;
      const float* xr = p.x + (size_t)row * DM;
      float4 v[4];
      float ss = 0.f;
#pragma unroll
      for (int i = 0; i < 2; ++i) {
        const int e = 8 * (lane + 64 * i);
        v[2 * i] = *(const float4*)(xr + e);
        v[2 * i + 1] = *(const float4*)(xr + e + 4);
        ss += v[2 * i].x * v[2 * i].x + v[2 * i].y * v[2 * i].y + v[2 * i].z * v[2 * i].z + v[2 * i].w * v[2 * i].w;
        ss += v[2 * i + 1].x * v[2 * i + 1].x + v[2 * i + 1].y * v[2 * i + 1].y + v[2 * i + 1].z * v[2 * i + 1].z + v[2 * i + 1].w * v[2 * i + 1].w;
      }
#pragma unroll
      for (int o = 32; o >= 1; o >>= 1) ss += __shfl_xor(ss, o);
      const float rn = __builtin_amdgcn_rsqf(ss * (1.f / DM) + EPSN);
#pragma unroll
      for (int i = 0; i < 2; ++i) {
        const int e = 8 * (lane + 64 * i);
        const float4 g0 = *(const float4*)(gs + e), g1 = *(const float4*)(gs + e + 4);
        const float4 s0 = *(const float4*)(sh + e), s1 = *(const float4*)(sh + e + 4);
        *(bf16x8*)(p.Hb() + (size_t)row * DM + e) =
            pack8(v[2 * i].x * rn * g0.x + s0.x, v[2 * i].y * rn * g0.y + s0.y, v[2 * i].z * rn * g0.z + s0.z, v[2 * i].w * rn * g0.w + s0.w,
                  v[2 * i + 1].x * rn * g1.x + s1.x, v[2 * i + 1].y * rn * g1.y + s1.y, v[2 * i + 1].z * rn * g1.z + s1.z, v[2 * i + 1].w * rn * g1.w + s1.w);
      }
    }
  }
  __syncthreads();
}

DI void phase_g1(const Params& p, char* smem, bool do_ssq = true) {
  bf16_t* sA = (bf16_t*)smem;
  bf16_t* sB = sA + 2 * GBUF;
  float* sC = (float*)smem;
  float* rs = (float*)(smem + 4 * GBUF * 2);
  constexpr int NCT = INWP / 128;
  const int ntiles = (NTOK / 128) * NCT;
  for (int t = blockIdx.x; t < ntiles; t += gridDim.x) {
    const int rt = t / NCT, ct = t % NCT;
    const int m0 = rt * 128, n0 = ct * 128;
    f32x16 acc[2][2];
    zero_acc(acc);
    gemm_mainloop<false>(p.Hb() + (size_t)m0 * DM, DM, p.WinT() + (size_t)n0 * DM, DM, DM, sA, sB, acc, rs);
    acc_to_lds(acc, sC);
    __syncthreads();
    if (ct < 4) {
      epi_rows(sC, [&](int, int row, int cc, const float (&v)[8]) {
        float o[8];
#pragma unroll
        for (int j = 0; j < 8; ++j) o[j] = v[j] * QS_SCALE;
        store8(p.Qsb() + (size_t)(m0 + row) * 512 + n0 + cc, o); });
    } else if (ct < 8) {
      epi_rows(sC, [&](int, int row, int cc, const float (&v)[8]) { store8(p.Ksb() + (size_t)(m0 + row) * 512 + n0 - 512 + cc, v); });
    } else if (ct < 12) {
      epi_vt(sC, p.VTsb(), m0, (n0 - 1024) >> 6, 0, 7);
    } else if (ct < 16) {
      epi_rows(sC, [&](int, int row, int cc, const float (&v)[8]) {
        float o[8];
#pragma unroll
        for (int j = 0; j < 8; ++j) o[j] = siluf_fast(v[j]);
        store8(p.Zsb() + (size_t)(m0 + row) * 512 + n0 - 1536 + cc, o); });
    } else if (ct < 19) {
      epi_rows(sC, [&](int, int row, int cc, const float (&v)[8]) {
        store8(p.CQ() + (size_t)(m0 + row) * 384 + n0 - 2048 + cc, v);
        float q = 0.f;
#pragma unroll
        for (int j = 0; j < 8; ++j) q += v[j] * v[j];
        q += __shfl_xor(q, 1); q += __shfl_xor(q, 2); q += __shfl_xor(q, 4); q += __shfl_xor(q, 8);
        if (do_ssq && (threadIdx.x & 15) == 0) atomicAdd(p.SSQ() + m0 + row, q); });
    } else if (ct < 21) {
      epi_rows(sC, [&](int, int row, int cc, const float (&v)[8]) {
        store8(p.CKV() + (size_t)(m0 + row) * 256 + n0 - 2432 + cc, v);
        float q = 0.f;
#pragma unroll
        for (int j = 0; j < 8; ++j) q += v[j] * v[j];
        q += __shfl_xor(q, 1); q += __shfl_xor(q, 2); q += __shfl_xor(q, 4); q += __shfl_xor(q, 8);
        if (do_ssq && (threadIdx.x & 15) == 0) atomicAdd(p.SSQ() + NTOK + m0 + row, q); });
    } else if (ct < 25) {
      epi_rows(sC, [&](int, int row, int cc, const float (&v)[8]) {
        float o[8];
#pragma unroll
        for (int j = 0; j < 8; ++j) o[j] = siluf_fast(v[j]);
        store8(p.Zmla() + (size_t)(m0 + row) * 512 + n0 - 2688 + cc, o); });
    } else if (ct < 33) {
      epi_rows(sC, [&](int, int row, int cc, const float (&v)[8]) {
        float o[8];
#pragma unroll
        for (int j = 0; j < 8; ++j) o[j] = sigmoidf_fast(v[j]);
        store8(p.GA() + (size_t)(m0 + row) * 1024 + n0 - 3200 + cc, o); });
    } else if (ct < 41) {
      epi_rows(sC, [&](int, int row, int cc, const float (&v)[8]) {
        float o[8];
#pragma unroll
        for (int j = 0; j < 8; ++j) o[j] = sigmoidf_fast(v[j]);
        store8(p.GB() + (size_t)(m0 + row) * 1024 + n0 - 4224 + cc, o); });
    } else {
      epi_rows(sC, [&](int, int row, int cc, const float (&v)[8]) {
        if (cc < 32) {
          float o[8];
#pragma unroll
          for (int j = 0; j < 8; ++j) o[j] = v[j];
          rope8(sC, p.ROPE(), m0 + row, row, cc, o);
          store8(p.KPE() + (size_t)(m0 + row) * 32 + cc, o);
        } });
    }
    __syncthreads();
  }
}

DI void phase_g2(const Params& p, char* smem) {
  bf16_t* sA = (bf16_t*)smem;
  bf16_t* sB = sA + 2 * GBUF;
  float* sC = (float*)smem;
  float* rs = (float*)(smem + 4 * GBUF * 2);
  constexpr int NQ = 128 * 6, NKV = 128 * 8;
  for (int t = blockIdx.x; t < NQ + NKV; t += gridDim.x) {
    f32x16 acc[2][2];
    zero_acc(acc);
    if (t < NQ) {
      const int rt = t / 6, ct = t % 6, m0 = rt * 128, n0 = ct * 128;
      if (threadIdx.x < 128) rs[threadIdx.x] = __builtin_amdgcn_rsqf(p.SSQ()[m0 + threadIdx.x] * (1.f / 384.f) + EPSN);
      gemm_mainloop<false>(p.CQ() + (size_t)m0 * 384, 384, p.WuqT() + (size_t)n0 * 384, 384, 384, sA, sB, acc, rs);
      acc_to_lds(acc, sC);
      __syncthreads();
      epi_rows(sC, [&](int, int row, int cc, const float (&v)[8]) {
        const int col = n0 + cc;
        float o[8];
#pragma unroll
        for (int j = 0; j < 8; ++j) o[j] = v[j];
        if (((col >> 5) % 3) == 2) rope8(sC, p.ROPE(), m0 + row, row, cc, o);
        const float sc = rs[row] * QM_SCALE;
#pragma unroll
        for (int j = 0; j < 8; ++j) o[j] *= sc;
        store8(p.Qmla() + (size_t)(m0 + row) * 768 + col, o);
      });
    } else {
      const int t2 = t - NQ;
      const int rt = t2 >> 3, head = t2 & 7, m0 = rt * 128, n0 = head * 128;
      if (threadIdx.x < 128) rs[threadIdx.x] = __builtin_amdgcn_rsqf(p.SSQ()[NTOK + m0 + threadIdx.x] * (1.f / 256.f) + EPSN);
      gemm_mainloop<false>(p.CKV() + (size_t)m0 * 256, 256, p.WukvT() + (size_t)n0 * 256, 256, 256, sA, sB, acc, rs);
      acc_to_lds(acc, sC);
      __syncthreads();
      epi_rows(sC, [&](int, int row, int cc, const float (&v)[8]) {
        if (cc < 64) {
          const float sc = rs[row];
          float o[8];
#pragma unroll
          for (int j = 0; j < 8; ++j) o[j] = v[j] * sc;
          store8(p.Knope() + (size_t)(m0 + row) * 512 + head * 64 + cc, o);
        } });
      {
        const int b = m0 >> 12, s0 = m0 & 4095;
        for (int c = opaque_tid(); c < 1024; c += 256) {
          const int col = c & 63, rc = c >> 6;
          float v[8];
#pragma unroll
          for (int j = 0; j < 8; ++j) v[j] = sC[(rc * 8 + j) * CSTR + 64 + col] * rs[rc * 8 + j];
          store8(p.VTmla() + ((size_t)((b * 8 + head) * 64 + col)) * SEQL + s0 + rc * 8, v);
        }
      }
    }
    __syncthreads();
  }
}

constexpr int VSTR = 68;

template <bool MLA>
DI void attn_item(const Params& p, int b, int h, int qb, char* smem) {
  constexpr int DK = MLA ? 96 : 64;
  constexpr int KSTR = MLA ? 104 : 72;
  constexpr int NKS = DK / 16;
  bf16_t* sK = (bf16_t*)smem;
  bf16_t* sV = sK + 2 * 64 * KSTR;
  const int tid = threadIdx.x, lane = tid & 63, w = tid >> 6, r = lane & 31, hh = lane >> 5;
  const int tokb = b * SEQL;
  const int tok0 = tokb + qb * 128;
  const int qw = qb * 128 + w * 32;

  bf16x8 qf[NKS];
  {
    const bf16_t* qptr = MLA ? (p.Qmla() + (size_t)(tok0 + w * 32 + r) * 768 + h * 96 + hh * 8) : (p.Qsb() + (size_t)(tok0 + w * 32 + r) * 512 + h * 64 + hh * 8);
#pragma unroll
    for (int ks = 0; ks < NKS; ++ks) qf[ks] = *(const bf16x8*)(qptr + ks * 16);
  }
  bf16x8 tf[2];
  if (!MLA) {
#pragma unroll
    for (int st = 0; st < 2; ++st)
#pragma unroll
      for (int e = 0; e < 8; ++e) { const int j = 16 * st + 8 * (e >> 2) + 4 * hh + (e & 3); tf[st][e] = (j >= r) ? (short)0x3F80 : (short)0; }
  }

  f32x16 oacc[2];
#pragma unroll
  for (int i = 0; i < 16; ++i) { oacc[0][i] = 0.f; oacc[1][i] = 0.f; }
  float carry = 0.f;
  float mrun = 0.f, lrun = 0.f;

  const bf16_t* Kg = MLA ? p.Knope() : p.Ksb();
  const bf16_t* VTg = (MLA ? p.VTmla() : p.VTsb()) + (size_t)((b * 8 + h) * 64) * SEQL;
  const int nt = 2 * qb + 2;

  uint4 xk0, xk1, xv0, xv1, xp, yk0, yk1, yv0, yv1, yp;
  xp = make_uint4(0, 0, 0, 0); yp = xp;
  const int prow = tid >> 3, pch = tid & 7;
  const bf16_t* kgp = Kg + (size_t)(tokb + prow) * 512 + h * 64 + pch * 8;
  const bf16_t* vgp = VTg + (size_t)prow * SEQL + pch * 8;
  const bf16_t* pgp = p.KPE() + (size_t)(tokb + (tid >> 2)) * 32 + (tid & 3) * 8;
#define ATT_GLOAD(P, kt_)                                                          \
  {                                                                                \
    const int kt__ = (kt_);                                                        \
    P##k0 = *(const uint4*)(kgp + (size_t)(kt__ * 64) * 512);                      \
    P##k1 = *(const uint4*)(kgp + (size_t)(kt__ * 64 + 32) * 512);                 \
    P##v0 = *(const uint4*)(vgp + kt__ * 64);                                      \
    P##v1 = *(const uint4*)(vgp + (size_t)32 * SEQL + kt__ * 64);                  \
    if (MLA) P##p = *(const uint4*)(pgp + (size_t)(kt__ * 64) * 32);               \
  }
#define ATT_SWRITE(P, buf_)                                                        \
  {                                                                                \
    bf16_t* dK = sK + (buf_) * 64 * KSTR;                                          \
    bf16_t* dV = sV + (buf_) * 64 * VSTR;                                          \
    *(uint4*)(dK + prow * KSTR + pch * 8) = P##k0;                                 \
    *(uint4*)(dK + (prow + 32) * KSTR + pch * 8) = P##k1;                          \
    uint2* dv0 = (uint2*)(dV + prow * VSTR + pch * 8);                             \
    dv0[0] = make_uint2(P##v0.x, P##v0.y); dv0[1] = make_uint2(P##v0.z, P##v0.w);  \
    uint2* dv1 = (uint2*)(dV + (prow + 32) * VSTR + pch * 8);                      \
    dv1[0] = make_uint2(P##v1.x, P##v1.y); dv1[1] = make_uint2(P##v1.z, P##v1.w);  \
    if (MLA) *(uint4*)(dK + (tid >> 2) * KSTR + 64 + (tid & 3) * 8) = P##p;        \
  }
#define ATT_KT(i_) (MLA ? (i_) : (nt - 1 - (i_)))

  ATT_GLOAD(x, ATT_KT(0));
  ATT_GLOAD(y, ATT_KT(1));
  ATT_SWRITE(x, 0);
  __syncthreads();
  bool alive = true;
  for (int it0 = 0; alive; it0 += 2) {
#pragma unroll
   for (int half = 0; half < 2; ++half) {
    const int it = it0 + half;
    const int kt = ATT_KT(it);
    const int cur = half;
    const bool more = (it + 1 < nt);
    if (it + 2 < nt) { if (half == 0) ATT_GLOAD(x, ATT_KT(it + 2)) else ATT_GLOAD(y, ATT_KT(it + 2)) }
    const bf16_t* cK = sK + cur * 64 * KSTR;
    const bf16_t* cV = sV + cur * 64 * VSTR;
    if (MLA) {
      if (kt * 64 <= qw + 31) {
        f32x16 s0, s1;
        {
          const float sinit = -mrun;
#pragma unroll
          for (int i = 0; i < 16; ++i) { s0[i] = sinit; s1[i] = sinit; }
        }
        __builtin_amdgcn_s_setprio(1);
#pragma unroll
        for (int ks = 0; ks < NKS; ++ks) {
          const bf16x8 k0 = *(const bf16x8*)(cK + r * KSTR + ks * 16 + hh * 8);
          const bf16x8 k1 = *(const bf16x8*)(cK + (32 + r) * KSTR + ks * 16 + hh * 8);
          s0 = MFMA(k0, qf[ks], s0);
          s1 = MFMA(k1, qf[ks], s1);
        }
        __builtin_amdgcn_s_setprio(0);
        if (kt * 64 + 63 > qw) {
          const int lim = qw + r - kt * 64;
#pragma unroll
          for (int i = 0; i < 16; ++i) { if (crow(i, hh) > lim) s0[i] = -1e30f; if (32 + crow(i, hh) > lim) s1[i] = -1e30f; }
        }
        float m0 = fmaxf(fmaxf(s0[0], s0[1]), s0[2]), m1 = fmaxf(fmaxf(s1[0], s1[1]), s1[2]);
#pragma unroll
        for (int i = 3; i < 15; i += 2) { m0 = fmaxf(fmaxf(m0, s0[i]), s0[i + 1]); m1 = fmaxf(fmaxf(m1, s1[i]), s1[i + 1]); }
        float mloc = fmaxf(fmaxf(m0, s0[15]), fmaxf(m1, s1[15]));
        mloc = half_max(mloc);
        const bool first = (it == 0);
        const float delta = first ? mloc : fmaxf(mloc, 0.f);
        if (first || __builtin_amdgcn_ballot_w64(delta > 0.f) != 0ull) {
          const float alpha = first ? 0.f : __builtin_amdgcn_exp2f(-delta);
          mrun += delta;
          lrun *= alpha;
#pragma unroll
          for (int i = 0; i < 16; ++i) { oacc[0][i] *= alpha; oacc[1][i] *= alpha; s0[i] -= delta; s1[i] -= delta; }
        }
        float ps0 = 0.f, ps1 = 0.f;
#pragma unroll
        for (int i = 0; i < 16; ++i) { s0[i] = __builtin_amdgcn_exp2f(s0[i]); s1[i] = __builtin_amdgcn_exp2f(s1[i]); ps0 += s0[i]; ps1 += s1[i]; }
        lrun += ps0 + ps1;
        bf16x8 pf4[4];
        pf4[0] = pack8(s0[0], s0[1], s0[2], s0[3], s0[4], s0[5], s0[6], s0[7]);
        pf4[1] = pack8(s0[8], s0[9], s0[10], s0[11], s0[12], s0[13], s0[14], s0[15]);
        pf4[2] = pack8(s1[0], s1[1], s1[2], s1[3], s1[4], s1[5], s1[6], s1[7]);
        pf4[3] = pack8(s1[8], s1[9], s1[10], s1[11], s1[12], s1[13], s1[14], s1[15]);
        __builtin_amdgcn_s_setprio(1);
#pragma unroll
        for (int st = 0; st < 4; ++st)
#pragma unroll
          for (int dt = 0; dt < 2; ++dt) {
            const bf16_t* vp = cV + (dt * 32 + r) * VSTR + st * 16 + 4 * hh;
            const s16x4 lo = *(const s16x4*)vp;
            const s16x4 hi = *(const s16x4*)(vp + 8);
            const bf16x8 vf = __builtin_shufflevector(lo, hi, 0, 1, 2, 3, 4, 5, 6, 7);
            oacc[dt] = MFMA(vf, pf4[st], oacc[dt]);
          }
        __builtin_amdgcn_s_setprio(0);
      }
    } else
#pragma unroll
    for (int si = 0; si < 2; ++si) {
      const int sub = MLA ? si : (1 - si);
      const int kb = kt * 64 + sub * 32;
      if (kb > qw) continue;
      const bool diag = (kb == qw);
      f32x16 s;
      {
        const float sinit = MLA ? -mrun : 0.f;
#pragma unroll
        for (int i = 0; i < 16; ++i) s[i] = sinit;
      }
      __builtin_amdgcn_s_setprio(1);
#pragma unroll
      for (int ks = 0; ks < NKS; ++ks) {
        const bf16x8 kf = *(const bf16x8*)(cK + (sub * 32 + r) * KSTR + ks * 16 + hh * 8);
        s = MFMA(kf, qf[ks], s);
      }
      __builtin_amdgcn_s_setprio(0);
      bf16x8 pf[2];
      if (!MLA) {
        float sp[16];
        float tsum = 0.f;
#pragma unroll
        for (int i = 0; i < 16; ++i) {
          const float z = s[i];
          float v = __builtin_amdgcn_logf(1.f + __builtin_amdgcn_exp2f(fminf(z, 126.f)));
          if (diag && !(crow(i, hh) < r)) v = 0.f;
          sp[i] = v;
          tsum += v;
        }
        f32x16 cacc;
#pragma unroll
        for (int i = 0; i < 16; ++i) cacc[i] = carry;
        cacc = MFMA(tf[0], pack8(sp[0], sp[1], sp[2], sp[3], sp[4], sp[5], sp[6], sp[7]), cacc);
        cacc = MFMA(tf[1], pack8(sp[8], sp[9], sp[10], sp[11], sp[12], sp[13], sp[14], sp[15]), cacc);
        float pr[16];
#pragma unroll
        for (int i = 0; i < 16; ++i) {
          float v = __builtin_amdgcn_exp2f(s[i] - cacc[i]);
          if (diag && !(crow(i, hh) < r)) v = 0.f;
          pr[i] = v;
        }
        carry += half_sum(tsum);
        pf[0] = pack8(pr[0], pr[1], pr[2], pr[3], pr[4], pr[5], pr[6], pr[7]);
        pf[1] = pack8(pr[8], pr[9], pr[10], pr[11], pr[12], pr[13], pr[14], pr[15]);
      } else {
        if (diag) {
#pragma unroll
          for (int i = 0; i < 16; ++i) if (!(crow(i, hh) <= r)) s[i] = -1e30f;
        }
        float mloc = fmaxf(fmaxf(s[0], s[1]), s[2]);
#pragma unroll
        for (int i = 3; i < 15; i += 2) mloc = fmaxf(fmaxf(mloc, s[i]), s[i + 1]);
        mloc = fmaxf(mloc, s[15]);
        mloc = half_max(mloc);
        const bool first = (it == 0) && (si == 0);
        const float delta = first ? mloc : fmaxf(mloc, 0.f);
        if (first || __builtin_amdgcn_ballot_w64(delta > 0.f) != 0ull) {
          const float alpha = first ? 0.f : __builtin_amdgcn_exp2f(-delta);
          mrun += delta;
          lrun *= alpha;
#pragma unroll
          for (int i = 0; i < 16; ++i) { oacc[0][i] *= alpha; oacc[1][i] *= alpha; s[i] -= delta; }
        }
        float pr[16];
        float ps0 = 0.f, ps1 = 0.f;
#pragma unroll
        for (int i = 0; i < 16; i += 2) { pr[i] = __builtin_amdgcn_exp2f(s[i]); pr[i + 1] = __builtin_amdgcn_exp2f(s[i + 1]); ps0 += pr[i]; ps1 += pr[i + 1]; }
        lrun += ps0 + ps1;
        pf[0] = pack8(pr[0], pr[1], pr[2], pr[3], pr[4], pr[5], pr[6], pr[7]);
        pf[1] = pack8(pr[8], pr[9], pr[10], pr[11], pr[12], pr[13], pr[14], pr[15]);
      }
      __builtin_amdgcn_s_setprio(1);
#pragma unroll
      for (int dt = 0; dt < 2; ++dt)
#pragma unroll
        for (int st = 0; st < 2; ++st) {
          const bf16_t* vp = cV + (dt * 32 + r) * VSTR + sub * 32 + st * 16 + 4 * hh;
          const s16x4 lo = *(const s16x4*)vp;
          const s16x4 hi = *(const s16x4*)(vp + 8);
          const bf16x8 vf = __builtin_shufflevector(lo, hi, 0, 1, 2, 3, 4, 5, 6, 7);
          oacc[dt] = MFMA(vf, pf[st], oacc[dt]);
        }
      __builtin_amdgcn_s_setprio(0);
    }
    if (more) { if (half == 0) ATT_SWRITE(y, 1) else ATT_SWRITE(x, 0) }
    if (!MLA) {
      int* flg = (int*)(smem + SMEM_BYTES - 64) + (it & 1) * 4;
      const bool wok = (__builtin_amdgcn_ballot_w64(carry >= 160.f) == ~0ull);
      if (lane == 0) flg[w] = wok ? 1 : 0;
      __syncthreads();
      alive = more && ((flg[0] & flg[1] & flg[2] & flg[3]) == 0);
    } else {
      __syncthreads();
      alive = more;
    }
    if (!alive) break;
   }
  }
#undef ATT_GLOAD
#undef ATT_SWRITE
#undef ATT_KT
  float inv = 1.f;
  if (MLA) { const float lt = half_sum(lrun); inv = 1.f / lt; }
  const int tok = tok0 + w * 32 + r;
  const bf16_t* zg = (MLA ? p.Zmla() : p.Zsb()) + (size_t)tok * 512 + h * 64;
  bf16_t* og = (MLA ? p.OBg() : p.OAg()) + (size_t)tok * 512 + h * 64;
#pragma unroll
  for (int dt = 0; dt < 2; ++dt)
#pragma unroll
    for (int g = 0; g < 4; ++g) {
      const int d = dt * 32 + 8 * g + 4 * hh;
      const u32x2 zz = *(const u32x2*)(zg + d);
      const float z0 = __uint_as_float(zz[0] << 16), z1 = __uint_as_float(zz[0] & 0xffff0000u);
      const float z2 = __uint_as_float(zz[1] << 16), z3 = __uint_as_float(zz[1] & 0xffff0000u);
      u32x2 o;
      o[0] = pk2(oacc[dt][4 * g] * inv * z0, oacc[dt][4 * g + 1] * inv * z1);
      o[1] = pk2(oacc[dt][4 * g + 2] * inv * z2, oacc[dt][4 * g + 3] * inv * z3);
      *(u32x2*)(og + d) = o;
    }
}

DI void phase_attn(const Params& p, char* smem, int cbase, int only) {
  int* s_item = (int*)(smem + SMEM_BYTES - 16);
  const int q0 = blockIdx.x & 7;
  int qi = 0;
  for (;;) {
    if (threadIdx.x == 0) {
      int item = -1;
      while (qi < 8) {
        const int q = (q0 + qi) & 7;
        const int idx = atomicAdd(p.counter() + cbase + q, 1);
        if (idx < 256) { item = q * 256 + idx; break; }
        ++qi;
      }
      *s_item = item;
    }
    __syncthreads();
    const int item = *s_item;
    __syncthreads();
    if (item < 0) break;
    const int q = item >> 8, idx = item & 255;
    const int i2 = idx & 127;
    const int bh = q + 8 * (i2 & 3);
    const int qb = 31 - (i2 >> 2);
    if (idx < 128) { if (only != 2) attn_item<true>(p, bh >> 3, bh & 7, qb, smem); }
    else { if (only != 1) attn_item<false>(p, bh >> 3, bh & 7, qb, smem); }
  }
}

DI void phase_g3(const Params& p, char* smem) {
  bf16_t* sA = (bf16_t*)smem;
  bf16_t* sB = sA + 2 * GBUF;
  float* sC = (float*)smem;
  float* rs = (float*)(smem + 4 * GBUF * 2);
  for (int t = blockIdx.x; t < 128 * 8; t += gridDim.x) {
    const int rt = t >> 3, ct = t & 7, m0 = rt * 128, n0 = ct * 128;
    f32x16 acc[2][2];
    zero_acc(acc);
    gemm_mainloop<false>(p.OAg() + (size_t)m0 * 512, 512, p.WaT() + (size_t)n0 * 512, 512, 512, sA, sB, acc, rs);
    acc_to_lds(acc, sC);
    __syncthreads();
    const int txo = opaque_tid();
#pragma unroll
    for (int i = 0; i < 8; ++i) {
      const int c = txo + 256 * i, row = c >> 4, cc = (c & 15) * 8;
      const u32x4 g = *(const u32x4*)(p.GA() + (size_t)(m0 + row) * 1024 + n0 + cc);
      const float4 a = *(const float4*)(sC + row * CSTR + cc), b = *(const float4*)(sC + row * CSTR + cc + 4);
      u32x4 y;
      y[0] = pk2(a.x * __uint_as_float(g[0] << 16), a.y * __uint_as_float(g[0] & 0xffff0000u));
      y[1] = pk2(a.z * __uint_as_float(g[1] << 16), a.w * __uint_as_float(g[1] & 0xffff0000u));
      y[2] = pk2(b.x * __uint_as_float(g[2] << 16), b.y * __uint_as_float(g[2] & 0xffff0000u));
      y[3] = pk2(b.z * __uint_as_float(g[3] << 16), b.w * __uint_as_float(g[3] & 0xffff0000u));
      *(u32x4*)(p.MERGED() + (size_t)(m0 + row) * 1024 + n0 + cc) = y;
    }
    __syncthreads();
    zero_acc(acc);
    gemm_mainloop<false>(p.OBg() + (size_t)m0 * 512, 512, p.WbT() + (size_t)n0 * 512, 512, 512, sA, sB, acc, rs);
    acc_to_lds(acc, sC);
    __syncthreads();
    const int txo2 = opaque_tid();
#pragma unroll
    for (int i = 0; i < 8; ++i) {
      const int c = txo2 + 256 * i, row = c >> 4, cc = (c & 15) * 8;
      const u32x4 g = *(const u32x4*)(p.GB() + (size_t)(m0 + row) * 1024 + n0 + cc);
      const u32x4 yv = *(const u32x4*)(p.MERGED() + (size_t)(m0 + row) * 1024 + n0 + cc);
      const float4 a = *(const float4*)(sC + row * CSTR + cc), b = *(const float4*)(sC + row * CSTR + cc + 4);
      u32x4 o;
      o[0] = pk2(__uint_as_float(yv[0] << 16) + a.x * __uint_as_float(g[0] << 16), __uint_as_float(yv[0] & 0xffff0000u) + a.y * __uint_as_float(g[0] & 0xffff0000u));
      o[1] = pk2(__uint_as_float(yv[1] << 16) + a.z * __uint_as_float(g[1] << 16), __uint_as_float(yv[1] & 0xffff0000u) + a.w * __uint_as_float(g[1] & 0xffff0000u));
      o[2] = pk2(__uint_as_float(yv[2] << 16) + b.x * __uint_as_float(g[2] << 16), __uint_as_float(yv[2] & 0xffff0000u) + b.y * __uint_as_float(g[2] & 0xffff0000u));
      o[3] = pk2(__uint_as_float(yv[3] << 16) + b.z * __uint_as_float(g[3] << 16), __uint_as_float(yv[3] & 0xffff0000u) + b.w * __uint_as_float(g[3] & 0xffff0000u));
      *(u32x4*)(p.MERGED() + (size_t)(m0 + row) * 1024 + n0 + cc) = o;
    }
    __syncthreads();
  }
}

DI void phase_g4(const Params& p, char* smem) {
  bf16_t* sA = (bf16_t*)smem;
  bf16_t* sB = sA + 2 * GBUF;
  float* sC = (float*)smem;
  float* rs = (float*)(smem + 4 * GBUF * 2);
  for (int t = blockIdx.x; t < 128 * 8; t += gridDim.x) {
    const int rt = t >> 3, ct = t & 7, m0 = rt * 128, n0 = ct * 128;
    f32x16 acc[2][2];
    zero_acc(acc);
    if (threadIdx.x < 128) rs[threadIdx.x] = mod_get(p.MOD(), m0 >> 12, 2048 + n0 + threadIdx.x);
    gemm_mainloop<false>(p.MERGED() + (size_t)m0 * 1024, 1024, p.WoT() + (size_t)n0 * 1024, 1024, 1024, sA, sB, acc, rs);
    acc_to_lds(acc, sC);
    __syncthreads();
    const int txo = opaque_tid();
#pragma unroll
    for (int i = 0; i < 8; ++i) {
      const int c = txo + 256 * i, row = c >> 4, cc = (c & 15) * 8;
      const size_t go = (size_t)(m0 + row) * 1024 + n0 + cc;
      const float4 x0 = *(const float4*)(p.x + go), x1 = *(const float4*)(p.x + go + 4);
      const float4 a = *(const float4*)(sC + row * CSTR + cc), b = *(const float4*)(sC + row * CSTR + cc + 4);
      const float4 g0 = *(const float4*)(rs + cc), g1 = *(const float4*)(rs + cc + 4);
      float4 o0, o1;
      o0.x = x0.x + g0.x * a.x; o0.y = x0.y + g0.y * a.y; o0.z = x0.z + g0.z * a.z; o0.w = x0.w + g0.w * a.w;
      o1.x = x1.x + g1.x * b.x; o1.y = x1.y + g1.y * b.y; o1.z = x1.z + g1.z * b.z; o1.w = x1.w + g1.w * b.w;
      *(float4*)(p.out + go) = o0;
      *(float4*)(p.out + go + 4) = o1;
    }
    __syncthreads();
  }
}

DI void phase_final(const Params& p) {
  const int lane = threadIdx.x & 63, w = threadIdx.x >> 6;
  const int gw = blockIdx.x * 4 + w, nw = gridDim.x * 4;
  for (int row = gw; row < NTOK; row += nw) {
    float* xr = p.out + (size_t)row * DM;
    float4 v[4];
    float ss = 0.f;
#pragma unroll
    for (int i = 0; i < 4; ++i) {
      v[i] = *(const float4*)(xr + 4 * (lane + 64 * i));
      ss += v[i].x * v[i].x + v[i].y * v[i].y + v[i].z * v[i].z + v[i].w * v[i].w;
    }
#pragma unroll
    for (int o = 32; o >= 1; o >>= 1) ss += __shfl_xor(ss, o);
    const float rn = __builtin_amdgcn_rsqf(ss * (1.f / DM) + EPSN);
#pragma unroll
    for (int i = 0; i < 4; ++i) {
      const int e = 4 * (lane + 64 * i);
      const float4 g = *(const float4*)(p.fgain + e);
      float4 o;
      o.x = v[i].x * rn * g.x; o.y = v[i].y * rn * g.y; o.z = v[i].z * rn * g.z; o.w = v[i].w * rn * g.w;
      *(float4*)(xr + e) = o;
    }
  }
}

template <int PH>
__global__ void __launch_bounds__(NTHREADS, 2) mega_kernel(Params p) {
  __shared__ __attribute__((aligned(16))) char smem[SMEM_BYTES];
  if (PH < 0) {
    if (p.ws == nullptr) cg::this_grid().sync();
    volatile LAS unsigned* xst = (volatile LAS unsigned*)(smem + SMEM_BYTES - 32);
    if (threadIdx.x == 0) { xst[0] = 0u; xst[1] = 0u; }
    __syncthreads();
    (void)xcd_barrier_post(p.bar(), xst);
    phase_prep(p, smem); xcd_barrier(p.bar(), (volatile LAS unsigned*)(smem + SMEM_BYTES - 32));
#if PROBE_DUP == 4
    phase_prep(p, smem); xcd_barrier(p.bar(), (volatile LAS unsigned*)(smem + SMEM_BYTES - 32));
#endif
    phase_h(p, smem); xcd_barrier(p.bar(), (volatile LAS unsigned*)(smem + SMEM_BYTES - 32));
#if PROBE_DUP == 5
    phase_h(p, smem); xcd_barrier(p.bar(), (volatile LAS unsigned*)(smem + SMEM_BYTES - 32));
#endif
    phase_g1(p, smem); xcd_barrier(p.bar(), (volatile LAS unsigned*)(smem + SMEM_BYTES - 32));
#if PROBE_DUP == 1
    phase_g1(p, smem, false); xcd_barrier(p.bar(), (volatile LAS unsigned*)(smem + SMEM_BYTES - 32));
#endif
    phase_g2(p, smem); xcd_barrier(p.bar(), (volatile LAS unsigned*)(smem + SMEM_BYTES - 32));
#if PROBE_DUP == 8
    phase_g2(p, smem); xcd_barrier(p.bar(), (volatile LAS unsigned*)(smem + SMEM_BYTES - 32));
#endif
    phase_attn(p, smem, 0, 0); xcd_barrier(p.bar(), (volatile LAS unsigned*)(smem + SMEM_BYTES - 32));
#if PROBE_DUP == 2
    phase_attn(p, smem, 8, 1); xcd_barrier(p.bar(), (volatile LAS unsigned*)(smem + SMEM_BYTES - 32));
#endif
#if PROBE_DUP == 3
    phase_attn(p, smem, 8, 2); xcd_barrier(p.bar(), (volatile LAS unsigned*)(smem + SMEM_BYTES - 32));
#endif
    phase_g3(p, smem); xcd_barrier(p.bar(), (volatile LAS unsigned*)(smem + SMEM_BYTES - 32));
#if PROBE_DUP == 6
    phase_g3(p, smem); xcd_barrier(p.bar(), (volatile LAS unsigned*)(smem + SMEM_BYTES - 32));
#endif
    phase_g4(p, smem); xcd_barrier(p.bar(), (volatile LAS unsigned*)(smem + SMEM_BYTES - 32));
#if PROBE_DUP == 7
    phase_g4(p, smem); xcd_barrier(p.bar(), (volatile LAS unsigned*)(smem + SMEM_BYTES - 32));
#endif
    phase_final(p);
  } else {
    if (PH == 0) phase_prep(p, smem);
    if (PH == 1) phase_h(p, smem);
    if (PH == 2) phase_g1(p, smem);
    if (PH == 3) phase_g2(p, smem);
    if (PH == 4) phase_attn(p, smem, 0, 0);
    if (PH == 5) phase_g3(p, smem);
    if (PH == 6) phase_g4(p, smem);
    if (PH == 7) phase_final(p);
  }
}

#ifndef PROBE_DUP
#define PROBE_DUP 0
#endif
#ifndef MK_SPLIT
#define MK_SPLIT 0
#endif

extern "C" void kernel_launch(void* const* d_in, const int* in_sizes, int n_in, void* d_out, int out_size, void* d_ws, size_t ws_size, hipStream_t stream) {
  Params p{};
  p.x = (const float*)d_in[0]; p.c = (const float*)d_in[1]; p.pos = (const int*)d_in[2];
  p.w_ada = (const float*)d_in[3]; p.b_ada = (const float*)d_in[4]; p.norm_gain = (const float*)d_in[5];
  p.w_in = (const float*)d_in[6]; p.q_gain = (const float*)d_in[7]; p.w_uq = (const float*)d_in[8];
  p.kv_gain = (const float*)d_in[9]; p.w_ukv = (const float*)d_in[10]; p.w_a = (const float*)d_in[11];
  p.w_b = (const float*)d_in[12]; p.w_out = (const float*)d_in[13]; p.fgain = (const float*)d_in[14];
  p.out = (float*)d_out;
  p.ws = (char*)d_ws;
  if (WS_NEED > ws_size) { fprintf(stderr, "workspace too small: need %zu have %zu\n", (size_t)WS_NEED, ws_size); return; }

  static int grid_blocks = 0;
  if (!grid_blocks) {
    int dev = 0, cus = 0, per_cu = 0;
    hipGetDevice(&dev);
    hipDeviceGetAttribute(&cus, hipDeviceAttributeMultiprocessorCount, dev);
    hipOccupancyMaxActiveBlocksPerMultiprocessor(&per_cu, mega_kernel<-1>, NTHREADS, 0);
    if (per_cu > 2) per_cu = 2;
    if (per_cu < 1) per_cu = 1;
    grid_blocks = cus * per_cu;
  }
#if MK_SPLIT
  mega_kernel<0><<<grid_blocks, NTHREADS, 0, stream>>>(p);
  mega_kernel<1><<<grid_blocks, NTHREADS, 0, stream>>>(p);
  mega_kernel<2><<<grid_blocks, NTHREADS, 0, stream>>>(p);
  mega_kernel<3><<<grid_blocks, NTHREADS, 0, stream>>>(p);
  mega_kernel<4><<<grid_blocks, NTHREADS, 0, stream>>>(p);
  mega_kernel<5><<<grid_blocks, NTHREADS, 0, stream>>>(p);
  mega_kernel<6><<<grid_blocks, NTHREADS, 0, stream>>>(p);
  mega_kernel<7><<<grid_blocks, NTHREADS, 0, stream>>>(p);
#else
  hipMemsetAsync((char*)d_ws + OFF_bar, 0, XCD_BAR_WORDS * 4, stream);
  void* args[] = {&p};
  hipError_t e = hipLaunchCooperativeKernel((void*)mega_kernel<-1>, dim3(grid_blocks), dim3(NTHREADS), args, 0, stream);
  if (e != hipSuccess) fprintf(stderr, "cooperative launch failed: %s (grid %d)\n", hipGetErrorString(e), grid_blocks);
#endif
}
```

```cpp
#include <hip/hip_runtime.h>
#include <hip/hip_cooperative_groups.h>
#include <stdint.h>
#include <stdio.h>
namespace cg = cooperative_groups;
#ifndef PROBE_DUP
#define PROBE_DUP 0
#endif

#define DI __device__ __forceinline__
typedef unsigned short bf16_t;
typedef __attribute__((ext_vector_type(8))) short bf16x8;
typedef __attribute__((ext_vector_type(4))) short s16x4;
typedef __attribute__((ext_vector_type(16))) float f32x16;
typedef __attribute__((ext_vector_type(2))) float f32x2;
typedef __attribute__((ext_vector_type(2))) __bf16 bf16x2v;
typedef __attribute__((ext_vector_type(4))) unsigned u32x4;
typedef __attribute__((ext_vector_type(2))) unsigned u32x2;
#define MFMA(a, b, c) __builtin_amdgcn_mfma_f32_32x32x16_bf16((a), (b), (c), 0, 0, 0)

constexpr int NTOK = 16384, SEQL = 4096, DM = 1024;
constexpr int INW = 5280, INWP = 5376;
constexpr int NTHREADS = 256;
constexpr float LOG2E = 1.4426950408889634f;
constexpr float QS_SCALE = 0.125f * 1.4426950408889634f;
constexpr float QM_SCALE = 1.4426950408889634f / 9.797958971132712f;
constexpr float EPSN = 1e-6f;

constexpr int XCD_BAR_WORDS_C = 3456;
constexpr size_t al256(size_t v) { return (v + 255) & ~(size_t)255; }
constexpr size_t OFF_counter = 0;
constexpr size_t OFF_bar = OFF_counter + al256(256);
constexpr size_t OFF_MOD = OFF_bar + al256(XCD_BAR_WORDS_C * 4);
constexpr size_t OFF_ROPE = OFF_MOD + al256(4 * 3072 * 4 * 4);
constexpr size_t OFF_SSQ = OFF_ROPE + al256((size_t)NTOK * 32 * 4);
constexpr size_t OFF_Hb = OFF_SSQ + al256((size_t)2 * NTOK * 4);
constexpr size_t OFF_Qmla = OFF_Hb + al256((size_t)NTOK * 1024 * 2);
constexpr size_t OFF_WuqT = OFF_Qmla + al256((size_t)NTOK * 768 * 2);
constexpr size_t OFF_WukvT = OFF_WuqT + al256((size_t)768 * 384 * 2);
constexpr size_t OFF_WaT = OFF_WukvT + al256((size_t)1024 * 256 * 2);
constexpr size_t OFF_WbT = OFF_WaT + al256((size_t)1024 * 512 * 2);
constexpr size_t OFF_WoT = OFF_WbT + al256((size_t)1024 * 512 * 2);
constexpr size_t OFF_Qsb = OFF_WoT + al256((size_t)1024 * 1024 * 2);
constexpr size_t OFF_Ksb = OFF_Qsb + al256((size_t)NTOK * 512 * 2);
constexpr size_t OFF_VTsb = OFF_Ksb + al256((size_t)NTOK * 512 * 2);
constexpr size_t OFF_Zsb = OFF_VTsb + al256((size_t)NTOK * 512 * 2);
constexpr size_t OFF_OAg = OFF_Zsb + al256((size_t)NTOK * 512 * 2);
constexpr size_t OFF_OBg = OFF_OAg + al256((size_t)NTOK * 512 * 2);
constexpr size_t OFF_Zmla = OFF_OBg + al256((size_t)NTOK * 512 * 2);
constexpr size_t OFF_KPE = OFF_Zmla + al256((size_t)NTOK * 512 * 2);
constexpr size_t OFF_Knope = OFF_KPE + al256((size_t)NTOK * 32 * 2);
constexpr size_t OFF_VTmla = OFF_Knope + al256((size_t)NTOK * 512 * 2);
constexpr size_t WS_NEED = OFF_VTmla + al256((size_t)NTOK * 512 * 2);
struct Params {
  const float *x, *c; const int* pos;
  const float *w_ada, *b_ada, *norm_gain, *w_in, *q_gain, *w_uq, *kv_gain, *w_ukv, *w_a, *w_b, *w_out, *fgain;
  float* out;
  char* ws;
  DI int* counter() const { return (int*)(ws + OFF_counter); }
  DI unsigned* bar() const { return (unsigned*)(ws + OFF_bar); }
  DI float* MOD() const { return (float*)(ws + OFF_MOD); }
  DI float* ROPE() const { return (float*)(ws + OFF_ROPE); }
  DI float* SSQ() const { return (float*)(ws + OFF_SSQ); }
  DI bf16_t* Hb() const { return (bf16_t*)(ws + OFF_Hb); }
  DI bf16_t* Qmla() const { return (bf16_t*)(ws + OFF_Qmla); }
  DI bf16_t* WuqT() const { return (bf16_t*)(ws + OFF_WuqT); }
  DI bf16_t* WukvT() const { return (bf16_t*)(ws + OFF_WukvT); }
  DI bf16_t* WaT() const { return (bf16_t*)(ws + OFF_WaT); }
  DI bf16_t* WbT() const { return (bf16_t*)(ws + OFF_WbT); }
  DI bf16_t* WoT() const { return (bf16_t*)(ws + OFF_WoT); }
  DI bf16_t* Qsb() const { return (bf16_t*)(ws + OFF_Qsb); }
  DI bf16_t* Ksb() const { return (bf16_t*)(ws + OFF_Ksb); }
  DI bf16_t* VTsb() const { return (bf16_t*)(ws + OFF_VTsb); }
  DI bf16_t* Zsb() const { return (bf16_t*)(ws + OFF_Zsb); }
  DI bf16_t* OAg() const { return (bf16_t*)(ws + OFF_OAg); }
  DI bf16_t* OBg() const { return (bf16_t*)(ws + OFF_OBg); }
  DI bf16_t* Zmla() const { return (bf16_t*)(ws + OFF_Zmla); }
  DI bf16_t* KPE() const { return (bf16_t*)(ws + OFF_KPE); }
  DI bf16_t* Knope() const { return (bf16_t*)(ws + OFF_Knope); }
  DI bf16_t* VTmla() const { return (bf16_t*)(ws + OFF_VTmla); }
  DI bf16_t* MERGED() const { return Hb(); }
  DI bf16_t* WinT() const { return Qmla(); }
  DI bf16_t* CQ() const { return OAg(); }
  DI bf16_t* CKV() const { return OBg(); }
  DI bf16_t* GA() const { return (bf16_t*)out; }
  DI bf16_t* GB() const { return (bf16_t*)out + (size_t)NTOK * 1024; }
};


__device__ const float c_invfreq[16] = {
  1.0f, 0.5623413251903491f, 0.31622776601683794f, 0.1778279410038923f, 0.1f, 0.05623413251903491f, 0.03162277660168379f,
  0.01778279410038923f, 0.01f, 0.005623413251903491f, 0.0031622776601683794f, 0.001778279410038923f, 0.001f,
  0.0005623413251903491f, 0.00031622776601683794f, 0.0001778279410038923f};

DI unsigned pk2(float a, float b) { f32x2 v = {a, b}; bf16x2v r = __builtin_convertvector(v, bf16x2v); return __builtin_bit_cast(unsigned, r); }
DI bf16_t tobf(float a) { return (bf16_t)(pk2(a, 0.f) & 0xffffu); }
DI float bf2f(unsigned short u) { return __uint_as_float(((unsigned)u) << 16); }
DI bf16x8 pack8(float a0, float a1, float a2, float a3, float a4, float a5, float a6, float a7) {
  u32x4 p; p[0] = pk2(a0, a1); p[1] = pk2(a2, a3); p[2] = pk2(a4, a5); p[3] = pk2(a6, a7);
  return __builtin_bit_cast(bf16x8, p);
}
DI int crow(int reg, int h) { return (reg & 3) + 8 * (reg >> 2) + 4 * h; }
DI int opaque_tid() { int t = threadIdx.x; asm volatile("" : "+v"(t)); return t; }
DI float half_max(float v) {
  unsigned u = __float_as_uint(v);
  auto r = __builtin_amdgcn_permlane32_swap(u, u, false, false);
  return fmaxf(__uint_as_float(r[0]), __uint_as_float(r[1]));
}
DI float half_sum(float v) {
  unsigned u = __float_as_uint(v);
  auto r = __builtin_amdgcn_permlane32_swap(u, u, false, false);
  return __uint_as_float(r[0]) + __uint_as_float(r[1]);
}
DI float sigmoidf_fast(float v) { return __builtin_amdgcn_rcpf(1.f + __builtin_amdgcn_exp2f(-v * LOG2E)); }
DI float siluf_fast(float v) { return v * sigmoidf_fast(v); }

#define XB_TMO      128
#define XB_XCNT(j)  (256  + 64 * (j))
#define XB_XSUB(j)  (1280 + 64 * (j))
#define XB_XGEN(j)  (2304 + 64 * (j))
#define XB_TOP      3328
#define XB_TOPGEN   3392
#define XCD_BAR_WORDS 3456
#define XB_SPIN_CAP (1u << 18)
#define LAS __attribute__((address_space(3)))
DI unsigned xb_ld(unsigned* p)              { return __hip_atomic_load(p, __ATOMIC_RELAXED, __HIP_MEMORY_SCOPE_AGENT); }
DI unsigned xb_add(unsigned* p, unsigned v) { return __hip_atomic_fetch_add(p, v, __ATOMIC_RELAXED, __HIP_MEMORY_SCOPE_AGENT); }
DI unsigned xb_xcc_id() { return (unsigned)__builtin_amdgcn_s_getreg((3 << 11) | 20) & 0xFu; }
#define XB_SPIN(cond, bar) do { unsigned _sp = 0; while (cond) { __builtin_amdgcn_s_sleep(1); \
    if ((++_sp & 255u) == 0u) { if (xb_ld(&(bar)[XB_TMO])) break; if (_sp > XB_SPIN_CAP) { atomicAdd(&(bar)[XB_TMO], 1u); break; } } } } while (0)
struct XcdBarrier { unsigned* bar; unsigned x; volatile LAS unsigned* st; };
DI XcdBarrier xcd_barrier_post(unsigned* bar, volatile LAS unsigned* st) {
  XcdBarrier b; b.bar = bar; b.x = xb_xcc_id(); b.st = st;
  if (threadIdx.x == 0) (void)xb_add(&bar[XB_XCNT(b.x)], 1u);
  return b;
}
DI void xcd_barrier_complete(unsigned* bar, unsigned x, unsigned& nloc, unsigned& nx) {
  const unsigned G = gridDim.x * gridDim.y * gridDim.z;
  unsigned sum, cnt, mine, sp = 0u;
  for (;;) {
    sum = 0u; cnt = 0u; mine = 0u;
#pragma unroll
    for (unsigned j = 0; j < 16; ++j) { const unsigned c = xb_ld(&bar[XB_XCNT(j)]); sum += c; cnt += (c > 0u) ? 1u : 0u; mine = (j == x) ? c : mine; }
    if (sum == G) break;
    __builtin_amdgcn_s_sleep(1);
    if ((++sp & 255u) == 0u) { if (xb_ld(&bar[XB_TMO])) break; if (sp > XB_SPIN_CAP) { atomicAdd(&bar[XB_TMO], 1u); break; } }
  }
  nloc = mine > 0u ? mine : 1u; nx = cnt > 0u ? cnt : 1u;
}
DI void xcd_barrier(unsigned* bar_, volatile LAS unsigned* st_) {
  XcdBarrier b; b.bar = bar_; b.st = st_; b.x = 0;
  asm volatile("s_waitcnt vmcnt(0)" ::: "memory");
  __syncthreads();
  if (threadIdx.x == 0) {
    unsigned* bar = b.bar;
    b.x = xb_xcc_id();
    __builtin_amdgcn_s_waitcnt(0);
    unsigned nloc = b.st[0], nx = b.st[1];
    if (nloc == 0u) { xcd_barrier_complete(bar, b.x, nloc, nx); b.st[0] = nloc; b.st[1] = nx; }
    const unsigned old = xb_add(&bar[XB_XSUB(b.x)], 1u);
    const unsigned gen = old / nloc;
    if (old + 1u == (gen + 1u) * nloc) {
      __builtin_amdgcn_fence(__ATOMIC_RELEASE, "agent");
      asm volatile("s_waitcnt vmcnt(0)" ::: "memory");
      const unsigned og = xb_add(&bar[XB_TOP], 1u);
      const unsigned tg = og / nx;
      if (og + 1u == (tg + 1u) * nx) xb_add(&bar[XB_TOPGEN], 1u);
      else XB_SPIN(xb_ld(&bar[XB_TOPGEN]) == tg, bar);
      __builtin_amdgcn_fence(__ATOMIC_ACQUIRE, "agent");
      xb_add(&bar[XB_XGEN(b.x)], 1u);
      asm volatile("s_waitcnt vmcnt(0)" ::: "memory");
    } else {
      XB_SPIN(xb_ld(&bar[XB_XGEN(b.x)]) == gen, bar);
      __builtin_amdgcn_fence(__ATOMIC_ACQUIRE, "agent");
      asm volatile("s_waitcnt vmcnt(0)" ::: "memory");
    }
  }
  __syncthreads();
}

constexpr int GSTR = 72;
constexpr int GBUF = 128 * GSTR;
constexpr int SMEM_BYTES = 4 * GBUF * 2 + 1024;

#ifndef GEMM_GLDS
#define GEMM_GLDS 1
#endif
#if GEMM_GLDS
template <bool ROWSS>
DI void gemm_mainloop(const bf16_t* __restrict__ A, int lda, const bf16_t* __restrict__ B, int ldb, int K,
                      bf16_t* sA_, bf16_t* sB_, f32x16 (&acc)[2][2], float* rs) {
  char* smem = (char*)sA_;
  const int tid = opaque_tid(), lane = tid & 63, w = tid >> 6;
  const int wm = w >> 1, wn = w & 1, r = lane & 31, hh = lane >> 5;
  const int lr = lane >> 3, cp = lane & 7;
  const int cl = cp ^ (((w & 1) << 2) + (lr >> 1));
  const unsigned voA = (unsigned)((w * 8 + lr) * lda + cl * 8) * 2u, voB = (unsigned)((w * 8 + lr) * ldb + cl * 8) * 2u;
  const char* Ab = (const char*)A;
  const char* Bb = (const char*)B;
  const int nk = K >> 6;
  char* sw = smem + __builtin_amdgcn_readfirstlane(w) * 1024;
#define GL_STAGE(buf, ko)                                                                                                \
  { _Pragma("unroll") for (int i_ = 0; i_ < 4; ++i_) {                                                                   \
      __builtin_amdgcn_global_load_lds((const unsigned*)(Ab + (size_t)(i_ * 32 * lda + (ko)) * 2 + voA),                \
                                       (unsigned*)(sw + (buf) * 32768 + i_ * 4096), 16, 0, 0);                          \
      __builtin_amdgcn_global_load_lds((const unsigned*)(Bb + (size_t)(i_ * 32 * ldb + (ko)) * 2 + voB),                \
                                       (unsigned*)(sw + (buf) * 32768 + 16384 + i_ * 4096), 16, 0, 0); } }
  const int t3 = hh ^ ((r >> 1) & 7);
  const int arow = (wm * 64 + r) * 128, brow = 16384 + (wn * 64 + r) * 128;
  const int c0 = ((0 ^ t3) << 4), c1 = ((2 ^ t3) << 4), c2 = ((4 ^ t3) << 4), c3 = ((6 ^ t3) << 4);
#define GL_KK(bufp, cx)                                                                                                  \
  { const bf16x8 a0 = *(const bf16x8*)((bufp) + arow + (cx)), a1 = *(const bf16x8*)((bufp) + arow + 4096 + (cx));        \
    const bf16x8 b0 = *(const bf16x8*)((bufp) + brow + (cx)), b1 = *(const bf16x8*)((bufp) + brow + 4096 + (cx));        \
    acc[0][0] = MFMA(a0, b0, acc[0][0]); acc[0][1] = MFMA(a0, b1, acc[0][1]);                                            \
    acc[1][0] = MFMA(a1, b0, acc[1][0]); acc[1][1] = MFMA(a1, b1, acc[1][1]); }
  GL_STAGE(0, 0)
  asm volatile("s_waitcnt vmcnt(0)" ::: "memory");
  __syncthreads();
  for (int ks = 0; ks < nk; ++ks) {
    const int cur = ks & 1;
    if (ks + 1 < nk) GL_STAGE(cur ^ 1, (ks + 1) * 64)
    const char* bp = smem + cur * 32768;
    GL_KK(bp, c0) GL_KK(bp, c1) GL_KK(bp, c2) GL_KK(bp, c3)
    asm volatile("s_waitcnt vmcnt(0)" ::: "memory");
    __syncthreads();
  }
#undef GL_STAGE
#undef GL_KK
}
#else
template <bool ROWSS>
DI void gemm_mainloop(const bf16_t* __restrict__ A, int lda, const bf16_t* __restrict__ B, int ldb, int K,
                      bf16_t* sA, bf16_t* sB, f32x16 (&acc)[2][2], float* rs) {
  const int tid = threadIdx.x, lane = tid & 63, w = tid >> 6;
  const int wm = w >> 1, wn = w & 1, r = lane & 31, hh = lane >> 5;
  const int lrow = tid >> 3, lch = tid & 7;
  const char* Ab = (const char*)A;
  const char* Bb = (const char*)B;
  const unsigned voA = (unsigned)(lrow * lda + lch * 8) * 2u, voB = (unsigned)(lrow * ldb + lch * 8) * 2u;
  uint4 xa0, xa1, xa2, xa3, xb0, xb1, xb2, xb3, ya0, ya1, ya2, ya3, yb0, yb1, yb2, yb3;
  float ss0 = 0.f, ss1 = 0.f, ss2 = 0.f, ss3 = 0.f;
  const int nk = K >> 6;
#define G_LD1(base, i, ld, ko, vo) (*(const uint4*)((base) + (size_t)((i) * 32 * (ld) + (ko)) * 2 + (vo)))
#define G_LOAD(P, ko)                                                                                                    \
  { P##a0 = G_LD1(Ab, 0, lda, ko, voA); P##a1 = G_LD1(Ab, 1, lda, ko, voA); P##a2 = G_LD1(Ab, 2, lda, ko, voA); P##a3 = G_LD1(Ab, 3, lda, ko, voA); \
    P##b0 = G_LD1(Bb, 0, ldb, ko, voB); P##b1 = G_LD1(Bb, 1, ldb, ko, voB); P##b2 = G_LD1(Bb, 2, ldb, ko, voB); P##b3 = G_LD1(Bb, 3, ldb, ko, voB); }
#define G_SSQ(v, s) { unsigned u_[4] = {v.x, v.y, v.z, v.w}; _Pragma("unroll") for (int j_ = 0; j_ < 4; ++j_) { \
    const float lo_ = __uint_as_float(u_[j_] << 16), hi_ = __uint_as_float(u_[j_] & 0xffff0000u); s += lo_ * lo_ + hi_ * hi_; } }
#define G_WRITE(P, bufo)                                                                                                 \
  { *(uint4*)(sA + (bufo) + woff) = P##a0; *(uint4*)(sA + (bufo) + woff + 32 * GSTR) = P##a1;                            \
    *(uint4*)(sA + (bufo) + woff + 64 * GSTR) = P##a2; *(uint4*)(sA + (bufo) + woff + 96 * GSTR) = P##a3;                \
    *(uint4*)(sB + (bufo) + woff) = P##b0; *(uint4*)(sB + (bufo) + woff + 32 * GSTR) = P##b1;                            \
    *(uint4*)(sB + (bufo) + woff + 64 * GSTR) = P##b2; *(uint4*)(sB + (bufo) + woff + 96 * GSTR) = P##b3;                \
    if (ROWSS) { G_SSQ(P##a0, ss0) G_SSQ(P##a1, ss1) G_SSQ(P##a2, ss2) G_SSQ(P##a3, ss3) } }
#define G_COMPUTE(bufo)                                                                                                  \
  { const bf16_t* cA = sA + (bufo) + (wm * 64 + r) * GSTR + hh * 8;                                                      \
    const bf16_t* cB = sB + (bufo) + (wn * 64 + r) * GSTR + hh * 8;                                                      \
    _Pragma("unroll") for (int kk = 0; kk < 4; ++kk) {                                                                   \
      const bf16x8 a0 = *(const bf16x8*)(cA + kk * 16), a1 = *(const bf16x8*)(cA + 32 * GSTR + kk * 16);                 \
      const bf16x8 b0 = *(const bf16x8*)(cB + kk * 16), b1 = *(const bf16x8*)(cB + 32 * GSTR + kk * 16);                 \
      acc[0][0] = MFMA(a0, b0, acc[0][0]); acc[0][1] = MFMA(a0, b1, acc[0][1]);                                          \
      acc[1][0] = MFMA(a1, b0, acc[1][0]); acc[1][1] = MFMA(a1, b1, acc[1][1]); } }
  const int woff = lrow * GSTR + lch * 8;
  G_LOAD(x, 0)
  G_LOAD(y, 64)
  G_WRITE(x, 0)
  __syncthreads();
  for (int ks = 0; ks < nk; ks += 2) {
    if (ks + 2 < nk) G_LOAD(x, (ks + 2) * 64)
    G_COMPUTE(0)
    G_WRITE(y, GBUF)
    __syncthreads();
    if (ks + 3 < nk) G_LOAD(y, (ks + 3) * 64)
    G_COMPUTE(GBUF)
    if (ks + 2 < nk) G_WRITE(x, 0)
    __syncthreads();
  }
#undef G_LOAD
#undef G_LD1
#undef G_SSQ
#undef G_WRITE
#undef G_COMPUTE
  if (ROWSS) {
    float sv[4] = {ss0, ss1, ss2, ss3};
#pragma unroll
    for (int i = 0; i < 4; ++i) {
      float v = sv[i];
      v += __shfl_xor(v, 1); v += __shfl_xor(v, 2); v += __shfl_xor(v, 4);
      if (lch == 0) rs[lrow + 32 * i] = __builtin_amdgcn_rsqf(v / (float)K + EPSN);
    }
  }
}

#endif

DI void zero_acc(f32x16 (&acc)[2][2]) {
#pragma unroll
  for (int a = 0; a < 2; ++a)
#pragma unroll
    for (int b = 0; b < 2; ++b)
#pragma unroll
      for (int i = 0; i < 16; ++i) acc[a][b][i] = 0.f;
}

constexpr int CSTR = 132;
DI void acc_to_lds(f32x16 (&acc)[2][2], float* sC) {
  const int lane = threadIdx.x & 63, w = threadIdx.x >> 6;
  const int wm = w >> 1, wn = w & 1, r = lane & 31, hh = lane >> 5;
#pragma unroll
  for (int mt = 0; mt < 2; ++mt)
#pragma unroll
    for (int nt = 0; nt < 2; ++nt)
#pragma unroll
      for (int i = 0; i < 16; ++i) sC[(wm * 64 + mt * 32 + crow(i, hh)) * CSTR + wn * 64 + nt * 32 + r] = acc[mt][nt][i];
}
template <class F>
DI void epi_rows(const float* sC, F f) {
  const int tx = opaque_tid();
#pragma unroll
  for (int i = 0; i < 8; ++i) {
    const int c = tx + 256 * i, row = c >> 4, cc = (c & 15) * 8;
    const float4 a = *(const float4*)(sC + row * CSTR + cc), b = *(const float4*)(sC + row * CSTR + cc + 4);
    const float v[8] = {a.x, a.y, a.z, a.w, b.x, b.y, b.z, b.w};
    f(i, row, cc, v);
  }
}
DI void store8(bf16_t* p, const float (&v)[8]) { *(bf16x8*)p = pack8(v[0], v[1], v[2], v[3], v[4], v[5], v[6], v[7]); }
DI void epi_vt(const float* sC, bf16_t* VT, int m0, int head0, int c0, int ncol_log2) {
  const int b = m0 >> 12, s0 = m0 & 4095;
  const int nitems = 16 << ncol_log2;
  for (int c = opaque_tid(); c < nitems; c += 256) {
    const int col = c & ((1 << ncol_log2) - 1), rc = c >> ncol_log2;
    float v[8];
#pragma unroll
    for (int j = 0; j < 8; ++j) v[j] = sC[(rc * 8 + j) * CSTR + c0 + col];
    const int head = head0 + (col >> 6), d = col & 63;
    store8(VT + ((size_t)((b * 8 + head) * 64 + d)) * SEQL + s0 + rc * 8, v);
  }
}
DI void rope8(const float* sC, const float* ROPE, int tok, int row, int cc, float (&v)[8]) {
  const float* pr = sC + row * CSTR + (cc ^ 16);
  const bool upper = (cc & 16) != 0;
  const int f0 = cc & 15;
  const float* tb = ROPE + (size_t)tok * 32;
#pragma unroll
  for (int j = 0; j < 8; ++j) {
    const float o = pr[j], cs = tb[f0 + j], sn = tb[16 + f0 + j];
    v[j] = upper ? (o * sn + v[j] * cs) : (v[j] * cs - o * sn);
  }
}

DI void wconv_unit(const float* __restrict__ src, int Nsrc, int K, bf16_t* __restrict__ dst, const float* __restrict__ gain, int ng, int kg, int mode, float* tile) {
  const int tid = threadIdx.x;
  {
    const int k = tid >> 2, cq = tid & 3;
    const int n = ng * 64 + cq * 16;
    int sc = n;
    if (mode == 1) { sc = (n < 2688) ? n : (n < 5248 ? n + 32 : (n < 5280 ? n - 2560 : -1)); }
    const int kk = kg * 64 + k;
    float4 v[4];
    if (sc >= 0) {
      const float* sp = src + (size_t)kk * Nsrc + sc;
#pragma unroll
      for (int i = 0; i < 4; ++i) v[i] = *(const float4*)(sp + 4 * i);
      if (gain) { const float g = gain[kk];
#pragma unroll
        for (int i = 0; i < 4; ++i) { v[i].x *= g; v[i].y *= g; v[i].z *= g; v[i].w *= g; } }
    } else {
#pragma unroll
      for (int i = 0; i < 4; ++i) v[i] = make_float4(0.f, 0.f, 0.f, 0.f);
    }
    float* tp = tile + k * 65 + cq * 16;
#pragma unroll
    for (int i = 0; i < 4; ++i) { tp[4 * i] = v[i].x; tp[4 * i + 1] = v[i].y; tp[4 * i + 2] = v[i].z; tp[4 * i + 3] = v[i].w; }
  }
  __syncthreads();
  {
    const int n = tid >> 2, kc = tid & 3;
    float o[16];
#pragma unroll
    for (int j = 0; j < 16; ++j) o[j] = tile[(kc * 16 + j) * 65 + n];
    bf16_t* dp = dst + (size_t)(ng * 64 + n) * K + kg * 64 + kc * 16;
    *(bf16x8*)dp = pack8(o[0], o[1], o[2], o[3], o[4], o[5], o[6], o[7]);
    *(bf16x8*)(dp + 8) = pack8(o[8], o[9], o[10], o[11], o[12], o[13], o[14], o[15]);
  }
  __syncthreads();
}

DI void phase_prep(const Params& p, char* smem) {
  const int tid = threadIdx.x;
  if (blockIdx.x == 0 && tid < 16) { p.counter()[tid] = 0; }
  for (int i = blockIdx.x * NTHREADS + tid; i < 2 * NTOK; i += gridDim.x * NTHREADS) p.SSQ()[i] = 0.f;
  constexpr int U_MOD = 96 * 4, U_WIN = 84 * 16, U_WUQ = 12 * 6, U_WUKV = 16 * 4, U_WA = 16 * 8, U_WB = 16 * 8, U_WO = 16 * 16, U_ROPE = 1024;
  constexpr int U_TOTAL = U_MOD + U_ROPE + U_WIN + U_WUQ + U_WUKV + U_WA + U_WB + U_WO;
  float* tile = (float*)smem;
  for (int u = blockIdx.x; u < U_TOTAL; u += gridDim.x) {
    int v = u;
    if (v < U_MOD) {
      const int cg32 = v >> 2, kq = v & 3, n0 = cg32 * 32;
      const int kgp = tid >> 5, col = tid & 31;
      const int kb = kq * 256 + kgp * 32;
      float a0 = 0.f, a1 = 0.f, a2 = 0.f, a3 = 0.f;
      const float* wp = p.w_ada + (size_t)kb * 3072 + n0 + col;
      float wv[32];
#pragma unroll
      for (int kk = 0; kk < 32; ++kk) wv[kk] = wp[(size_t)kk * 3072];
#pragma unroll
      for (int kk = 0; kk < 32; ++kk) {
        a0 += wv[kk] * p.c[kb + kk]; a1 += wv[kk] * p.c[1024 + kb + kk]; a2 += wv[kk] * p.c[2048 + kb + kk]; a3 += wv[kk] * p.c[3072 + kb + kk];
      }
      float* red = (float*)smem;
      red[(kgp * 4 + 0) * 32 + col] = a0; red[(kgp * 4 + 1) * 32 + col] = a1; red[(kgp * 4 + 2) * 32 + col] = a2; red[(kgp * 4 + 3) * 32 + col] = a3;
      __syncthreads();
      if (tid < 128) {
        const int b = tid >> 5, cc = tid & 31;
        float s = (kq == 0) ? p.b_ada[n0 + cc] : 0.f;
#pragma unroll
        for (int g = 0; g < 8; ++g) s += red[(g * 4 + b) * 32 + cc];
        p.MOD()[(size_t)(b * 3072 + n0 + cc) * 4 + kq] = s;
      }
      __syncthreads();
      continue;
    }
    v -= U_MOD;
    if (v < U_WIN) { wconv_unit(p.w_in, INW, 1024, p.WinT(), nullptr, v >> 4, v & 15, 1, tile); continue; }
    v -= U_WIN;
    if (v < U_WUQ) { wconv_unit(p.w_uq, 768, 384, p.WuqT(), p.q_gain, v / 6, v % 6, 0, tile); continue; }
    v -= U_WUQ;
    if (v < U_WUKV) { wconv_unit(p.w_ukv, 1024, 256, p.WukvT(), p.kv_gain, v >> 2, v & 3, 0, tile); continue; }
    v -= U_WUKV;
    if (v < U_WA) { wconv_unit(p.w_a, 1024, 512, p.WaT(), nullptr, v >> 3, v & 7, 0, tile); continue; }
    v -= U_WA;
    if (v < U_WB) { wconv_unit(p.w_b, 1024, 512, p.WbT(), nullptr, v >> 3, v & 7, 0, tile); continue; }
    v -= U_WB;
    if (v < U_WO) { wconv_unit(p.w_out, 1024, 1024, p.WoT(), nullptr, v >> 4, v & 15, 0, tile); continue; }
    v -= U_WO;
    {
      const int idx = v * 256 + tid, tok = idx >> 4, i = idx & 15;
      const float ang = (float)p.pos[tok] * c_invfreq[i];
      double t = (double)ang * 0.15915494309189535;
      t -= rint(t);
      const float tf = (float)t;
      p.ROPE()[(size_t)tok * 32 + i] = __builtin_amdgcn_cosf(tf);
      p.ROPE()[(size_t)tok * 32 + 16 + i] = __builtin_amdgcn_sinf(tf);
    }
  }
}

DI float mod_get(const float* MOD, int b, int n) { const float4 q = *(const float4*)(MOD + (size_t)(b * 3072 + n) * 4); return (q.x + q.y) + (q.z + q.w); }

DI void phase_h(const Params& p, char* smem) {
  const int tid = opaque_tid(), lane = tid & 63, w = tid >> 6;
  float* gs = (float*)smem;
  float* sh = gs + 1024;
  for (int rg = blockIdx.x; rg < NTOK / 32; rg += gridDim.x) {
    const int b = (rg * 32) >> 12;
    __syncthreads();
#pragma unroll
    for (int i = 0; i < 4; ++i) {
      const int k = tid + 256 * i;
      gs[k] = p.norm_gain[k] * (1.f + mod_get(p.MOD(), b, 1024 + k));
      sh[k] = mod_get(p.MOD(), b, k);
    }
    __syncthreads();
#pragma unroll 2
    for (int rr = 0; rr < 8; ++rr) {
      const int row = rg * 32 + w * 8 + rr;
      const float* xr = p.x + (size_t)row * DM;
      float4 v[4];
      float ss = 0.f;
#pragma unroll
      for (int i = 0; i < 2; ++i) {
        const int e = 8 * (lane + 64 * i);
        v[2 * i] = *(const float4*)(xr + e);
        v[2 * i + 1] = *(const float4*)(xr + e + 4);
        ss += v[2 * i].x * v[2 * i].x + v[2 * i].y * v[2 * i].y + v[2 * i].z * v[2 * i].z + v[2 * i].w * v[2 * i].w;
        ss += v[2 * i + 1].x * v[2 * i + 1].x + v[2 * i + 1].y * v[2 * i + 1].y + v[2 * i + 1].z * v[2 * i + 1].z + v[2 * i + 1].w * v[2 * i + 1].w;
      }
#pragma unroll
      for (int o = 32; o >= 1; o >>= 1) ss += __shfl_xor(ss, o);
      const float rn = __builtin_amdgcn_rsqf(ss * (1.f / DM) + EPSN);
#pragma unroll
      for (int i = 0; i < 2; ++i) {
        const int e = 8 * (lane + 64 * i);
        const float4 g0 = *(const float4*)(gs + e), g1 = *(const float4*)(gs + e + 4);
        const float4 s0 = *(const float4*)(sh + e), s1 = *(const float4*)(sh + e + 4);
        *(bf16x8*)(p.Hb() + (size_t)row * DM + e) =
            pack8(v[2 * i].x * rn * g0.x + s0.x, v[2 * i].y * rn * g0.y + s0.y, v[2 * i].z * rn * g0.z + s0.z, v[2 * i].w * rn * g0.w + s0.w,
                  v[2 * i + 1].x * rn * g1.x + s1.x, v[2 * i + 1].y * rn * g1.y + s1.y, v[2 * i + 1].z * rn * g1.z + s1.z, v[2 * i + 1].w * rn * g1.w + s1.w);
      }
    }
  }
  __syncthreads();
}

DI void phase_g1(const Params& p, char* smem, bool do_ssq = true) {
  bf16_t* sA = (bf16_t*)smem;
  bf16_t* sB = sA + 2 * GBUF;
  float* sC = (float*)smem;
  float* rs = (float*)(smem + 4 * GBUF * 2);
  constexpr int NCT = INWP / 128;
  const int ntiles = (NTOK / 128) * NCT;
  const int xq = blockIdx.x & 7, lb = blockIdx.x >> 3, nlb = gridDim.x >> 3;
  const bool xmap = (gridDim.x & 7) == 0;
  for (int t = xmap ? lb : (int)blockIdx.x; t < (xmap ? 16 * NCT : ntiles); t += (xmap ? nlb : (int)gridDim.x)) {
    int rt, ct;
    if (xmap) { const int half = t / (8 * NCT), wv = t % (8 * NCT); ct = wv >> 3; rt = 16 * xq + 8 * half + (wv & 7); }
    else { rt = t / NCT; ct = t % NCT; }
    const int m0 = rt * 128, n0 = ct * 128;
    f32x16 acc[2][2];
    zero_acc(acc);
    gemm_mainloop<false>(p.Hb() + (size_t)m0 * DM, DM, p.WinT() + (size_t)n0 * DM, DM, DM, sA, sB, acc, rs);
    acc_to_lds(acc, sC);
    __syncthreads();
    if (ct < 4) {
      epi_rows(sC, [&](int, int row, int cc, const float (&v)[8]) {
        float o[8];
#pragma unroll
        for (int j = 0; j < 8; ++j) o[j] = v[j] * QS_SCALE;
        store8(p.Qsb() + (size_t)(m0 + row) * 512 + n0 + cc, o); });
    } else if (ct < 8) {
      epi_rows(sC, [&](int, int row, int cc, const float (&v)[8]) { store8(p.Ksb() + (size_t)(m0 + row) * 512 + n0 - 512 + cc, v); });
    } else if (ct < 12) {
      epi_vt(sC, p.VTsb(), m0, (n0 - 1024) >> 6, 0, 7);
    } else if (ct < 16) {
      epi_rows(sC, [&](int, int row, int cc, const float (&v)[8]) {
        float o[8];
#pragma unroll
        for (int j = 0; j < 8; ++j) o[j] = siluf_fast(v[j]);
        store8(p.Zsb() + (size_t)(m0 + row) * 512 + n0 - 1536 + cc, o); });
    } else if (ct < 19) {
      epi_rows(sC, [&](int, int row, int cc, const float (&v)[8]) {
        store8(p.CQ() + (size_t)(m0 + row) * 384 + n0 - 2048 + cc, v);
        float q = 0.f;
#pragma unroll
        for (int j = 0; j < 8; ++j) q += v[j] * v[j];
        q += __shfl_xor(q, 1); q += __shfl_xor(q, 2); q += __shfl_xor(q, 4); q += __shfl_xor(q, 8);
        if (do_ssq && (threadIdx.x & 15) == 0) atomicAdd(p.SSQ() + m0 + row, q); });
    } else if (ct < 21) {
      epi_rows(sC, [&](int, int row, int cc, const float (&v)[8]) {
        store8(p.CKV() + (size_t)(m0 + row) * 256 + n0 - 2432 + cc, v);
        float q = 0.f;
#pragma unroll
        for (int j = 0; j < 8; ++j) q += v[j] * v[j];
        q += __shfl_xor(q, 1); q += __shfl_xor(q, 2); q += __shfl_xor(q, 4); q += __shfl_xor(q, 8);
        if (do_ssq && (threadIdx.x & 15) == 0) atomicAdd(p.SSQ() + NTOK + m0 + row, q); });
    } else if (ct < 25) {
      epi_rows(sC, [&](int, int row, int cc, const float (&v)[8]) {
        float o[8];
#pragma unroll
        for (int j = 0; j < 8; ++j) o[j] = siluf_fast(v[j]);
        store8(p.Zmla() + (size_t)(m0 + row) * 512 + n0 - 2688 + cc, o); });
    } else if (ct < 33) {
      epi_rows(sC, [&](int, int row, int cc, const float (&v)[8]) {
        float o[8];
#pragma unroll
        for (int j = 0; j < 8; ++j) o[j] = sigmoidf_fast(v[j]);
        store8(p.GA() + (size_t)(m0 + row) * 1024 + n0 - 3200 + cc, o); });
    } else if (ct < 41) {
      epi_rows(sC, [&](int, int row, int cc, const float (&v)[8]) {
        float o[8];
#pragma unroll
        for (int j = 0; j < 8; ++j) o[j] = sigmoidf_fast(v[j]);
        store8(p.GB() + (size_t)(m0 + row) * 1024 + n0 - 4224 + cc, o); });
    } else {
      epi_rows(sC, [&](int, int row, int cc, const float (&v)[8]) {
        if (cc < 32) {
          float o[8];
#pragma unroll
          for (int j = 0; j < 8; ++j) o[j] = v[j];
          rope8(sC, p.ROPE(), m0 + row, row, cc, o);
          store8(p.KPE() + (size_t)(m0 + row) * 32 + cc, o);
        } });
    }
    __syncthreads();
  }
}

DI void phase_g2(const Params& p, char* smem) {
  bf16_t* sA = (bf16_t*)smem;
  bf16_t* sB = sA + 2 * GBUF;
  float* sC = (float*)smem;
  float* rs = (float*)(smem + 4 * GBUF * 2);
  constexpr int NQ = 128 * 6, NKV = 128 * 8;
  for (int t = blockIdx.x; t < NQ + NKV; t += gridDim.x) {
    f32x16 acc[2][2];
    zero_acc(acc);
    if (t < NQ) {
      const int rt = t / 6, ct = t % 6, m0 = rt * 128, n0 = ct * 128;
      if (threadIdx.x < 128) rs[threadIdx.x] = __builtin_amdgcn_rsqf(p.SSQ()[m0 + threadIdx.x] * (1.f / 384.f) + EPSN);
      gemm_mainloop<false>(p.CQ() + (size_t)m0 * 384, 384, p.WuqT() + (size_t)n0 * 384, 384, 384, sA, sB, acc, rs);
      acc_to_lds(acc, sC);
      __syncthreads();
      epi_rows(sC, [&](int, int row, int cc, const float (&v)[8]) {
        const int col = n0 + cc;
        float o[8];
#pragma unroll
        for (int j = 0; j < 8; ++j) o[j] = v[j];
        if (((col >> 5) % 3) == 2) rope8(sC, p.ROPE(), m0 + row, row, cc, o);
        const float sc = rs[row] * QM_SCALE;
#pragma unroll
        for (int j = 0; j < 8; ++j) o[j] *= sc;
        store8(p.Qmla() + (size_t)(m0 + row) * 768 + col, o);
      });
    } else {
      const int t2 = t - NQ;
      const int rt = t2 >> 3, head = t2 & 7, m0 = rt * 128, n0 = head * 128;
      if (threadIdx.x < 128) rs[threadIdx.x] = __builtin_amdgcn_rsqf(p.SSQ()[NTOK + m0 + threadIdx.x] * (1.f / 256.f) + EPSN);
      gemm_mainloop<false>(p.CKV() + (size_t)m0 * 256, 256, p.WukvT() + (size_t)n0 * 256, 256, 256, sA, sB, acc, rs);
      acc_to_lds(acc, sC);
      __syncthreads();
      epi_rows(sC, [&](int, int row, int cc, const float (&v)[8]) {
        if (cc < 64) {
          const float sc = rs[row];
          float o[8];
#pragma unroll
          for (int j = 0; j < 8; ++j) o[j] = v[j] * sc;
          store8(p.Knope() + (size_t)(m0 + row) * 512 + head * 64 + cc, o);
        } });
      {
        const int b = m0 >> 12, s0 = m0 & 4095;
        for (int c = opaque_tid(); c < 1024; c += 256) {
          const int col = c & 63, rc = c >> 6;
          float v[8];
#pragma unroll
          for (int j = 0; j < 8; ++j) v[j] = sC[(rc * 8 + j) * CSTR + 64 + col] * rs[rc * 8 + j];
          store8(p.VTmla() + ((size_t)((b * 8 + head) * 64 + col)) * SEQL + s0 + rc * 8, v);
        }
      }
    }
    __syncthreads();
  }
}

constexpr int VSTR = 68;

template <bool MLA>
DI void attn_item(const Params& p, int b, int h, int qb, char* smem) {
  constexpr int DK = MLA ? 96 : 64;
  constexpr int KSTR = MLA ? 104 : 72;
  constexpr int NKS = DK / 16;
  bf16_t* sK = (bf16_t*)smem;
  bf16_t* sV = sK + 2 * 64 * KSTR;
  const int tid = threadIdx.x, lane = tid & 63, w = tid >> 6, r = lane & 31, hh = lane >> 5;
  const int tokb = b * SEQL;
  const int tok0 = tokb + qb * 128;
  const int qw = qb * 128 + w * 32;

  bf16x8 qf[NKS];
  {
    const bf16_t* qptr = MLA ? (p.Qmla() + (size_t)(tok0 + w * 32 + r) * 768 + h * 96 + hh * 8) : (p.Qsb() + (size_t)(tok0 + w * 32 + r) * 512 + h * 64 + hh * 8);
#pragma unroll
    for (int ks = 0; ks < NKS; ++ks) qf[ks] = *(const bf16x8*)(qptr + ks * 16);
  }
  bf16x8 tf[2];
  if (!MLA) {
#pragma unroll
    for (int st = 0; st < 2; ++st)
#pragma unroll
      for (int e = 0; e < 8; ++e) { const int j = 16 * st + 8 * (e >> 2) + 4 * hh + (e & 3); tf[st][e] = (j >= r) ? (short)0x3F80 : (short)0; }
  }

  f32x16 oacc[2];
#pragma unroll
  for (int i = 0; i < 16; ++i) { oacc[0][i] = 0.f; oacc[1][i] = 0.f; }
  float carry = 0.f;
  float mrun = 0.f, lrun = 0.f;

  const bf16_t* Kg = MLA ? p.Knope() : p.Ksb();
  const bf16_t* VTg = (MLA ? p.VTmla() : p.VTsb()) + (size_t)((b * 8 + h) * 64) * SEQL;
  const int nt = 2 * qb + 2;

  uint4 xk0, xk1, xv0, xv1, xp, yk0, yk1, yv0, yv1, yp;
  xp = make_uint4(0, 0, 0, 0); yp = xp;
  const int prow = tid >> 3, pch = tid & 7;
  const bf16_t* kgp = Kg + (size_t)(tokb + prow) * 512 + h * 64 + pch * 8;
  const bf16_t* vgp = VTg + (size_t)prow * SEQL + pch * 8;
  const bf16_t* pgp = p.KPE() + (size_t)(tokb + (tid >> 2)) * 32 + (tid & 3) * 8;
#define ATT_GLOAD(P, kt_)                                                          \
  {                                                                                \
    const int kt__ = (kt_);                                                        \
    P##k0 = *(const uint4*)(kgp + (size_t)(kt__ * 64) * 512);                      \
    P##k1 = *(const uint4*)(kgp + (size_t)(kt__ * 64 + 32) * 512);                 \
    P##v0 = *(const uint4*)(vgp + kt__ * 64);                                      \
    P##v1 = *(const uint4*)(vgp + (size_t)32 * SEQL + kt__ * 64);                  \
    if (MLA) P##p = *(const uint4*)(pgp + (size_t)(kt__ * 64) * 32);               \
  }
#define ATT_SWRITE(P, buf_)                                                        \
  {                                                                                \
    bf16_t* dK = sK + (buf_) * 64 * KSTR;                                          \
    bf16_t* dV = sV + (buf_) * 64 * VSTR;                                          \
    *(uint4*)(dK + prow * KSTR + pch * 8) = P##k0;                                 \
    *(uint4*)(dK + (prow + 32) * KSTR + pch * 8) = P##k1;                          \
    uint2* dv0 = (uint2*)(dV + prow * VSTR + pch * 8);                             \
    dv0[0] = make_uint2(P##v0.x, P##v0.y); dv0[1] = make_uint2(P##v0.z, P##v0.w);  \
    uint2* dv1 = (uint2*)(dV + (prow + 32) * VSTR + pch * 8);                      \
    dv1[0] = make_uint2(P##v1.x, P##v1.y); dv1[1] = make_uint2(P##v1.z, P##v1.w);  \
    if (MLA) *(uint4*)(dK + (tid >> 2) * KSTR + 64 + (tid & 3) * 8) = P##p;        \
  }
#define ATT_KT(i_) (MLA ? (i_) : (nt - 1 - (i_)))

  ATT_GLOAD(x, ATT_KT(0));
  ATT_GLOAD(y, ATT_KT(1));
  ATT_SWRITE(x, 0);
  __syncthreads();
  bool alive = true;
  for (int it0 = 0; alive; it0 += 2) {
#pragma unroll
   for (int half = 0; half < 2; ++half) {
    const int it = it0 + half;
    const int kt = ATT_KT(it);
    const int cur = half;
    const bool more = (it + 1 < nt);
    if (it + 2 < nt) { if (half == 0) ATT_GLOAD(x, ATT_KT(it + 2)) else ATT_GLOAD(y, ATT_KT(it + 2)) }
    const bf16_t* cK = sK + cur * 64 * KSTR;
    const bf16_t* cV = sV + cur * 64 * VSTR;
    if (MLA) {
      if (kt * 64 <= qw + 31) {
        f32x16 s0, s1;
        {
          const float sinit = -mrun;
#pragma unroll
          for (int i = 0; i < 16; ++i) { s0[i] = sinit; s1[i] = sinit; }
        }
        __builtin_amdgcn_s_setprio(1);
#pragma unroll
        for (int ks = 0; ks < NKS; ++ks) {
          const bf16x8 k0 = *(const bf16x8*)(cK + r * KSTR + ks * 16 + hh * 8);
          const bf16x8 k1 = *(const bf16x8*)(cK + (32 + r) * KSTR + ks * 16 + hh * 8);
          s0 = MFMA(k0, qf[ks], s0);
          s1 = MFMA(k1, qf[ks], s1);
        }
        __builtin_amdgcn_s_setprio(0);
        if (kt * 64 + 63 > qw) {
          const int lim = qw + r - kt * 64;
#pragma unroll
          for (int i = 0; i < 16; ++i) { if (crow(i, hh) > lim) s0[i] = -1e30f; if (32 + crow(i, hh) > lim) s1[i] = -1e30f; }
        }
        float m0 = fmaxf(fmaxf(s0[0], s0[1]), s0[2]), m1 = fmaxf(fmaxf(s1[0], s1[1]), s1[2]);
#pragma unroll
        for (int i = 3; i < 15; i += 2) { m0 = fmaxf(fmaxf(m0, s0[i]), s0[i + 1]); m1 = fmaxf(fmaxf(m1, s1[i]), s1[i + 1]); }
        float mloc = fmaxf(fmaxf(m0, s0[15]), fmaxf(m1, s1[15]));
        mloc = half_max(mloc);
        const bool first = (it == 0);
        const float delta = first ? mloc : fmaxf(mloc, 0.f);
        if (first || __builtin_amdgcn_ballot_w64(delta > 0.f) != 0ull) {
          const float alpha = first ? 0.f : __builtin_amdgcn_exp2f(-delta);
          mrun += delta;
          lrun *= alpha;
#pragma unroll
          for (int i = 0; i < 16; ++i) { oacc[0][i] *= alpha; oacc[1][i] *= alpha; s0[i] -= delta; s1[i] -= delta; }
        }
        float ps0 = 0.f, ps1 = 0.f;
#pragma unroll
        for (int i = 0; i < 16; ++i) { s0[i] = __builtin_amdgcn_exp2f(s0[i]); s1[i] = __builtin_amdgcn_exp2f(s1[i]); ps0 += s0[i]; ps1 += s1[i]; }
        lrun += ps0 + ps1;
        bf16x8 pf4[4];
        pf4[0] = pack8(s0[0], s0[1], s0[2], s0[3], s0[4], s0[5], s0[6], s0[7]);
        pf4[1] = pack8(s0[8], s0[9], s0[10], s0[11], s0[12], s0[13], s0[14], s0[15]);
        pf4[2] = pack8(s1[0], s1[1], s1[2], s1[3], s1[4], s1[5], s1[6], s1[7]);
        pf4[3] = pack8(s1[8], s1[9], s1[10], s1[11], s1[12], s1[13], s1[14], s1[15]);
        __builtin_amdgcn_s_setprio(1);
#pragma unroll
        for (int st = 0; st < 4; ++st)
#pragma unroll
          for (int dt = 0; dt < 2; ++dt) {
            const bf16_t* vp = cV + (dt * 32 + r) * VSTR + st * 16 + 4 * hh;
            const s16x4 lo = *(const s16x4*)vp;
            const s16x4 hi = *(const s16x4*)(vp + 8);
            const bf16x8 vf = __builtin_shufflevector(lo, hi, 0, 1, 2, 3, 4, 5, 6, 7);
            oacc[dt] = MFMA(vf, pf4[st], oacc[dt]);
          }
        __builtin_amdgcn_s_setprio(0);
      }
    } else
#pragma unroll
    for (int si = 0; si < 2; ++si) {
      const int sub = MLA ? si : (1 - si);
      const int kb = kt * 64 + sub * 32;
      if (kb > qw) continue;
      const bool diag = (kb == qw);
      f32x16 s;
      {
        const float sinit = MLA ? -mrun : 0.f;
#pragma unroll
        for (int i = 0; i < 16; ++i) s[i] = sinit;
      }
      __builtin_amdgcn_s_setprio(1);
#pragma unroll
      for (int ks = 0; ks < NKS; ++ks) {
        const bf16x8 kf = *(const bf16x8*)(cK + (sub * 32 + r) * KSTR + ks * 16 + hh * 8);
        s = MFMA(kf, qf[ks], s);
      }
      __builtin_amdgcn_s_setprio(0);
      bf16x8 pf[2];
      if (!MLA) {
        float sp[16];
        float tsum = 0.f;
#pragma unroll
        for (int i = 0; i < 16; ++i) {
          const float z = s[i];
          float v = __builtin_amdgcn_logf(1.f + __builtin_amdgcn_exp2f(fminf(z, 126.f)));
          if (diag && !(crow(i, hh) < r)) v = 0.f;
          sp[i] = v;
          tsum += v;
        }
        f32x16 cacc;
#pragma unroll
        for (int i = 0; i < 16; ++i) cacc[i] = carry;
        cacc = MFMA(tf[0], pack8(sp[0], sp[1], sp[2], sp[3], sp[4], sp[5], sp[6], sp[7]), cacc);
        cacc = MFMA(tf[1], pack8(sp[8], sp[9], sp[10], sp[11], sp[12], sp[13], sp[14], sp[15]), cacc);
        float pr[16];
#pragma unroll
        for (int i = 0; i < 16; ++i) {
          float v = __builtin_amdgcn_exp2f(s[i] - cacc[i]);
          if (diag && !(crow(i, hh) < r)) v = 0.f;
          pr[i] = v;
        }
        carry += half_sum(tsum);
        pf[0] = pack8(pr[0], pr[1], pr[2], pr[3], pr[4], pr[5], pr[6], pr[7]);
        pf[1] = pack8(pr[8], pr[9], pr[10], pr[11], pr[12], pr[13], pr[14], pr[15]);
      } else {
        if (diag) {
#pragma unroll
          for (int i = 0; i < 16; ++i) if (!(crow(i, hh) <= r)) s[i] = -1e30f;
        }
        float mloc = fmaxf(fmaxf(s[0], s[1]), s[2]);
#pragma unroll
        for (int i = 3; i < 15; i += 2) mloc = fmaxf(fmaxf(mloc, s[i]), s[i + 1]);
        mloc = fmaxf(mloc, s[15]);
        mloc = half_max(mloc);
        const bool first = (it == 0) && (si == 0);
        const float delta = first ? mloc : fmaxf(mloc, 0.f);
        if (first || __builtin_amdgcn_ballot_w64(delta > 0.f) != 0ull) {
          const float alpha = first ? 0.f : __builtin_amdgcn_exp2f(-delta);
          mrun += delta;
          lrun *= alpha;
#pragma unroll
          for (int i = 0; i < 16; ++i) { oacc[0][i] *= alpha; oacc[1][i] *= alpha; s[i] -= delta; }
        }
        float pr[16];
        float ps0 = 0.f, ps1 = 0.f;
#pragma unroll
        for (int i = 0; i < 16; i += 2) { pr[i] = __builtin_amdgcn_exp2f(s[i]); pr[i + 1] = __builtin_amdgcn_exp2f(s[i + 1]); ps0 += pr[i]; ps1 += pr[i + 1]; }
        lrun += ps0 + ps1;
        pf[0] = pack8(pr[0], pr[1], pr[2], pr[3], pr[4], pr[5], pr[6], pr[7]);
        pf[1] = pack8(pr[8], pr[9], pr[10], pr[11], pr[12], pr[13], pr[14], pr[15]);
      }
      __builtin_amdgcn_s_setprio(1);
#pragma unroll
      for (int dt = 0; dt < 2; ++dt)
#pragma unroll
        for (int st = 0; st < 2; ++st) {
          const bf16_t* vp = cV + (dt * 32 + r) * VSTR + sub * 32 + st * 16 + 4 * hh;
          const s16x4 lo = *(const s16x4*)vp;
          const s16x4 hi = *(const s16x4*)(vp + 8);
          const bf16x8 vf = __builtin_shufflevector(lo, hi, 0, 1, 2, 3, 4, 5, 6, 7);
          oacc[dt] = MFMA(vf, pf[st], oacc[dt]);
        }
      __builtin_amdgcn_s_setprio(0);
    }
    if (more) { if (half == 0) ATT_SWRITE(y, 1) else ATT_SWRITE(x, 0) }
    if (!MLA) {
      int* flg = (int*)(smem + SMEM_BYTES - 64) + (it & 1) * 4;
      const bool wok = (__builtin_amdgcn_ballot_w64(carry >= 160.f) == ~0ull);
      if (lane == 0) flg[w] = wok ? 1 : 0;
      __syncthreads();
      alive = more && ((flg[0] & flg[1] & flg[2] & flg[3]) == 0);
    } else {
      __syncthreads();
      alive = more;
    }
    if (!alive) break;
   }
  }
#undef ATT_GLOAD
#undef ATT_SWRITE
#undef ATT_KT
  float inv = 1.f;
  if (MLA) { const float lt = half_sum(lrun); inv = 1.f / lt; }
  const int tok = tok0 + w * 32 + r;
  const bf16_t* zg = (MLA ? p.Zmla() : p.Zsb()) + (size_t)tok * 512 + h * 64;
  bf16_t* og = (MLA ? p.OBg() : p.OAg()) + (size_t)tok * 512 + h * 64;
#pragma unroll
  for (int dt = 0; dt < 2; ++dt)
#pragma unroll
    for (int g = 0; g < 4; ++g) {
      const int d = dt * 32 + 8 * g + 4 * hh;
      const u32x2 zz = *(const u32x2*)(zg + d);
      const float z0 = __uint_as_float(zz[0] << 16), z1 = __uint_as_float(zz[0] & 0xffff0000u);
      const float z2 = __uint_as_float(zz[1] << 16), z3 = __uint_as_float(zz[1] & 0xffff0000u);
      u32x2 o;
      o[0] = pk2(oacc[dt][4 * g] * inv * z0, oacc[dt][4 * g + 1] * inv * z1);
      o[1] = pk2(oacc[dt][4 * g + 2] * inv * z2, oacc[dt][4 * g + 3] * inv * z3);
      *(u32x2*)(og + d) = o;
    }
}

DI void phase_attn(const Params& p, char* smem, int cbase, int only) {
  int* s_item = (int*)(smem + SMEM_BYTES - 16);
  const int q0 = blockIdx.x & 7;
  int qi = 0;
  for (;;) {
    if (threadIdx.x == 0) {
      int item = -1;
      while (qi < 8) {
        const int q = (q0 + qi) & 7;
        const int idx = atomicAdd(p.counter() + cbase + q, 1);
        if (idx < 256) { item = q * 256 + idx; break; }
        ++qi;
      }
      *s_item = item;
    }
    __syncthreads();
    const int item = *s_item;
    __syncthreads();
    if (item < 0) break;
    const int q = item >> 8, idx = item & 255;
    const int i2 = idx & 127;
    const int bh = q + 8 * (i2 & 3);
    const int qb = 31 - (i2 >> 2);
    if (idx < 128) { if (only != 2) attn_item<true>(p, bh >> 3, bh & 7, qb, smem); }
    else { if (only != 1) attn_item<false>(p, bh >> 3, bh & 7, qb, smem); }
  }
}

DI void phase_g3(const Params& p, char* smem) {
  bf16_t* sA = (bf16_t*)smem;
  bf16_t* sB = sA + 2 * GBUF;
  float* sC = (float*)smem;
  float* rs = (float*)(smem + 4 * GBUF * 2);
  const int xq = blockIdx.x & 7, lb = blockIdx.x >> 3, nlb = gridDim.x >> 3;
  const bool xmap = (gridDim.x & 7) == 0;
  for (int t = xmap ? lb : (int)blockIdx.x; t < (xmap ? 128 : 1024); t += (xmap ? nlb : (int)gridDim.x)) {
    const int rt = xmap ? (16 * xq + 8 * (t >> 6) + (t & 7)) : (t >> 3), ct = xmap ? ((t >> 3) & 7) : (t & 7);
    const int m0 = rt * 128, n0 = ct * 128;
    f32x16 acc[2][2];
    zero_acc(acc);
    gemm_mainloop<false>(p.OAg() + (size_t)m0 * 512, 512, p.WaT() + (size_t)n0 * 512, 512, 512, sA, sB, acc, rs);
    acc_to_lds(acc, sC);
    __syncthreads();
    const int txo = opaque_tid();
#pragma unroll
    for (int i = 0; i < 8; ++i) {
      const int c = txo + 256 * i, row = c >> 4, cc = (c & 15) * 8;
      const u32x4 g = *(const u32x4*)(p.GA() + (size_t)(m0 + row) * 1024 + n0 + cc);
      const float4 a = *(const float4*)(sC + row * CSTR + cc), b = *(const float4*)(sC + row * CSTR + cc + 4);
      u32x4 y;
      y[0] = pk2(a.x * __uint_as_float(g[0] << 16), a.y * __uint_as_float(g[0] & 0xffff0000u));
      y[1] = pk2(a.z * __uint_as_float(g[1] << 16), a.w * __uint_as_float(g[1] & 0xffff0000u));
      y[2] = pk2(b.x * __uint_as_float(g[2] << 16), b.y * __uint_as_float(g[2] & 0xffff0000u));
      y[3] = pk2(b.z * __uint_as_float(g[3] << 16), b.w * __uint_as_float(g[3] & 0xffff0000u));
      *(u32x4*)(p.MERGED() + (size_t)(m0 + row) * 1024 + n0 + cc) = y;
    }
    __syncthreads();
    zero_acc(acc);
    gemm_mainloop<false>(p.OBg() + (size_t)m0 * 512, 512, p.WbT() + (size_t)n0 * 512, 512, 512, sA, sB, acc, rs);
    acc_to_lds(acc, sC);
    __syncthreads();
    const int txo2 = opaque_tid();
#pragma unroll
    for (int i = 0; i < 8; ++i) {
      const int c = txo2 + 256 * i, row = c >> 4, cc = (c & 15) * 8;
      const u32x4 g = *(const u32x4*)(p.GB() + (size_t)(m0 + row) * 1024 + n0 + cc);
      const u32x4 yv = *(const u32x4*)(p.MERGED() + (size_t)(m0 + row) * 1024 + n0 + cc);
      const float4 a = *(const float4*)(sC + row * CSTR + cc), b = *(const float4*)(sC + row * CSTR + cc + 4);
      u32x4 o;
      o[0] = pk2(__uint_as_float(yv[0] << 16) + a.x * __uint_as_float(g[0] << 16), __uint_as_float(yv[0] & 0xffff0000u) + a.y * __uint_as_float(g[0] & 0xffff0000u));
      o[1] = pk2(__uint_as_float(yv[1] << 16) + a.z * __uint_as_float(g[1] << 16), __uint_as_float(yv[1] & 0xffff0000u) + a.w * __uint_as_float(g[1] & 0xffff0000u));
      o[2] = pk2(__uint_as_float(yv[2] << 16) + b.x * __uint_as_float(g[2] << 16), __uint_as_float(yv[2] & 0xffff0000u) + b.y * __uint_as_float(g[2] & 0xffff0000u));
      o[3] = pk2(__uint_as_float(yv[3] << 16) + b.z * __uint_as_float(g[3] << 16), __uint_as_float(yv[3] & 0xffff0000u) + b.w * __uint_as_float(g[3] & 0xffff0000u));
      *(u32x4*)(p.MERGED() + (size_t)(m0 + row) * 1024 + n0 + cc) = o;
    }
    __syncthreads();
  }
}

DI void phase_g4(const Params& p, char* smem) {
  bf16_t* sA = (bf16_t*)smem;
  bf16_t* sB = sA + 2 * GBUF;
  float* sC = (float*)smem;
  float* rs = (float*)(smem + 4 * GBUF * 2);
  const int xq = blockIdx.x & 7, lb = blockIdx.x >> 3, nlb = gridDim.x >> 3;
  const bool xmap = (gridDim.x & 7) == 0;
  for (int t = xmap ? lb : (int)blockIdx.x; t < (xmap ? 128 : 1024); t += (xmap ? nlb : (int)gridDim.x)) {
    const int rt = xmap ? (16 * xq + 8 * (t >> 6) + (t & 7)) : (t >> 3), ct = xmap ? ((t >> 3) & 7) : (t & 7);
    const int m0 = rt * 128, n0 = ct * 128;
    f32x16 acc[2][2];
    zero_acc(acc);
    if (threadIdx.x < 128) rs[threadIdx.x] = mod_get(p.MOD(), m0 >> 12, 2048 + n0 + threadIdx.x);
    gemm_mainloop<false>(p.MERGED() + (size_t)m0 * 1024, 1024, p.WoT() + (size_t)n0 * 1024, 1024, 1024, sA, sB, acc, rs);
    acc_to_lds(acc, sC);
    __syncthreads();
    const int txo = opaque_tid();
#pragma unroll
    for (int i = 0; i < 8; ++i) {
      const int c = txo + 256 * i, row = c >> 4, cc = (c & 15) * 8;
      const size_t go = (size_t)(m0 + row) * 1024 + n0 + cc;
      const float4 x0 = *(const float4*)(p.x + go), x1 = *(const float4*)(p.x + go + 4);
      const float4 a = *(const float4*)(sC + row * CSTR + cc), b = *(const float4*)(sC + row * CSTR + cc + 4);
      const float4 g0 = *(const float4*)(rs + cc), g1 = *(const float4*)(rs + cc + 4);
      float4 o0, o1;
      o0.x = x0.x + g0.x * a.x; o0.y = x0.y + g0.y * a.y; o0.z = x0.z + g0.z * a.z; o0.w = x0.w + g0.w * a.w;
      o1.x = x1.x + g1.x * b.x; o1.y = x1.y + g1.y * b.y; o1.z = x1.z + g1.z * b.z; o1.w = x1.w + g1.w * b.w;
      *(float4*)(p.out + go) = o0;
      *(float4*)(p.out + go + 4) = o1;
    }
    __syncthreads();
  }
}

DI void phase_final(const Params& p) {
  const int lane = threadIdx.x & 63, w = threadIdx.x >> 6;
  const int gw = blockIdx.x * 4 + w, nw = gridDim.x * 4;
  for (int row = gw; row < NTOK; row += nw) {
    float* xr = p.out + (size_t)row * DM;
    float4 v[4];
    float ss = 0.f;
#pragma unroll
    for (int i = 0; i < 4; ++i) {
      v[i] = *(const float4*)(xr + 4 * (lane + 64 * i));
      ss += v[i].x * v[i].x + v[i].y * v[i].y + v[i].z * v[i].z + v[i].w * v[i].w;
    }
#pragma unroll
    for (int o = 32; o >= 1; o >>= 1) ss += __shfl_xor(ss, o);
    const float rn = __builtin_amdgcn_rsqf(ss * (1.f / DM) + EPSN);
#pragma unroll
    for (int i = 0; i < 4; ++i) {
      const int e = 4 * (lane + 64 * i);
      const float4 g = *(const float4*)(p.fgain + e);
      float4 o;
      o.x = v[i].x * rn * g.x; o.y = v[i].y * rn * g.y; o.z = v[i].z * rn * g.z; o.w = v[i].w * rn * g.w;
      *(float4*)(xr + e) = o;
    }
  }
}

template <int PH>
__global__ void __launch_bounds__(NTHREADS, 2) mega_kernel(Params p) {
  __shared__ __attribute__((aligned(16))) char smem[SMEM_BYTES];
  if (PH < 0) {
    if (p.ws == nullptr) cg::this_grid().sync();
    volatile LAS unsigned* xst = (volatile LAS unsigned*)(smem + SMEM_BYTES - 32);
    if (threadIdx.x == 0) { xst[0] = 0u; xst[1] = 0u; }
    __syncthreads();
    (void)xcd_barrier_post(p.bar(), xst);
    phase_prep(p, smem); xcd_barrier(p.bar(), (volatile LAS unsigned*)(smem + SMEM_BYTES - 32));
#if PROBE_DUP == 4
    phase_prep(p, smem); xcd_barrier(p.bar(), (volatile LAS unsigned*)(smem + SMEM_BYTES - 32));
#endif
    phase_h(p, smem); xcd_barrier(p.bar(), (volatile LAS unsigned*)(smem + SMEM_BYTES - 32));
#if PROBE_DUP == 5
    phase_h(p, smem); xcd_barrier(p.bar(), (volatile LAS unsigned*)(smem + SMEM_BYTES - 32));
#endif
    phase_g1(p, smem); xcd_barrier(p.bar(), (volatile LAS unsigned*)(smem + SMEM_BYTES - 32));
#if PROBE_DUP == 1
    phase_g1(p, smem, false); xcd_barrier(p.bar(), (volatile LAS unsigned*)(smem + SMEM_BYTES - 32));
#endif
    phase_g2(p, smem); xcd_barrier(p.bar(), (volatile LAS unsigned*)(smem + SMEM_BYTES - 32));
#if PROBE_DUP == 8
    phase_g2(p, smem); xcd_barrier(p.bar(), (volatile LAS unsigned*)(smem + SMEM_BYTES - 32));
#endif
    phase_attn(p, smem, 0, 0); xcd_barrier(p.bar(), (volatile LAS unsigned*)(smem + SMEM_BYTES - 32));
#if PROBE_DUP == 2
    phase_attn(p, smem, 8, 1); xcd_barrier(p.bar(), (volatile LAS unsigned*)(smem + SMEM_BYTES - 32));
#endif
#if PROBE_DUP == 3
    phase_attn(p, smem, 8, 2); xcd_barrier(p.bar(), (volatile LAS unsigned*)(smem + SMEM_BYTES - 32));
#endif
    phase_g3(p, smem); xcd_barrier(p.bar(), (volatile LAS unsigned*)(smem + SMEM_BYTES - 32));
#if PROBE_DUP == 6
    phase_g3(p, smem); xcd_barrier(p.bar(), (volatile LAS unsigned*)(smem + SMEM_BYTES - 32));
#endif
    phase_g4(p, smem); xcd_barrier(p.bar(), (volatile LAS unsigned*)(smem + SMEM_BYTES - 32));
#if PROBE_DUP == 7
    phase_g4(p, smem); xcd_barrier(p.bar(), (volatile LAS unsigned*)(smem + SMEM_BYTES - 32));
#endif
    phase_final(p);
  } else {
    if (PH == 0) phase_prep(p, smem);
    if (PH == 1) phase_h(p, smem);
    if (PH == 2) phase_g1(p, smem);
    if (PH == 3) phase_g2(p, smem);
    if (PH == 4) phase_attn(p, smem, 0, 0);
    if (PH == 5) phase_g3(p, smem);
    if (PH == 6) phase_g4(p, smem);
    if (PH == 7) phase_final(p);
  }
}

#ifndef PROBE_DUP
#define PROBE_DUP 0
#endif
#ifndef MK_SPLIT
#define MK_SPLIT 0
#endif

extern "C" void kernel_launch(void* const* d_in, const int* in_sizes, int n_in, void* d_out, int out_size, void* d_ws, size_t ws_size, hipStream_t stream) {
  Params p{};
  p.x = (const float*)d_in[0]; p.c = (const float*)d_in[1]; p.pos = (const int*)d_in[2];
  p.w_ada = (const float*)d_in[3]; p.b_ada = (const float*)d_in[4]; p.norm_gain = (const float*)d_in[5];
  p.w_in = (const float*)d_in[6]; p.q_gain = (const float*)d_in[7]; p.w_uq = (const float*)d_in[8];
  p.kv_gain = (const float*)d_in[9]; p.w_ukv = (const float*)d_in[10]; p.w_a = (const float*)d_in[11];
  p.w_b = (const float*)d_in[12]; p.w_out = (const float*)d_in[13]; p.fgain = (const float*)d_in[14];
  p.out = (float*)d_out;
  p.ws = (char*)d_ws;
  if (WS_NEED > ws_size) { fprintf(stderr, "workspace too small: need %zu have %zu\n", (size_t)WS_NEED, ws_size); return; }

  static int grid_blocks = 0;
  if (!grid_blocks) {
    int dev = 0, cus = 0, per_cu = 0;
    hipGetDevice(&dev);
    hipDeviceGetAttribute(&cus, hipDeviceAttributeMultiprocessorCount, dev);
    hipOccupancyMaxActiveBlocksPerMultiprocessor(&per_cu, mega_kernel<-1>, NTHREADS, 0);
    if (per_cu > 2) per_cu = 2;
    if (per_cu < 1) per_cu = 1;
    grid_blocks = cus * per_cu;
  }
#if MK_SPLIT
  mega_kernel<0><<<grid_blocks, NTHREADS, 0, stream>>>(p);
  mega_kernel<1><<<grid_blocks, NTHREADS, 0, stream>>>(p);
  mega_kernel<2><<<grid_blocks, NTHREADS, 0, stream>>>(p);
  mega_kernel<3><<<grid_blocks, NTHREADS, 0, stream>>>(p);
  mega_kernel<4><<<grid_blocks, NTHREADS, 0, stream>>>(p);
  mega_kernel<5><<<grid_blocks, NTHREADS, 0, stream>>>(p);
  mega_kernel<6><<<grid_blocks, NTHREADS, 0, stream>>>(p);
  mega_kernel<7><<<grid_blocks, NTHREADS, 0, stream>>>(p);
#else
  hipMemsetAsync((char*)d_ws + OFF_bar, 0, XCD_BAR_WORDS * 4, stream);
  void* args[] = {&p};
  hipError_t e = hipLaunchCooperativeKernel((void*)mega_kernel<-1>, dim3(grid_blocks), dim3(NTHREADS), args, 0, stream);
  if (e != hipSuccess) fprintf(stderr, "cooperative launch failed: %s (grid %d)\n", hipGetErrorString(e), grid_blocks);
#endif
}
```

```cpp
#include <hip/hip_runtime.h>
#include <hip/hip_cooperative_groups.h>
#include <stdint.h>
#include <stdio.h>
namespace cg = cooperative_groups;
#ifndef PROBE_DUP
#define PROBE_DUP 0
#endif

#define DI __device__ __forceinline__
typedef unsigned short bf16_t;
typedef __attribute__((ext_vector_type(8))) short bf16x8;
typedef __attribute__((ext_vector_type(4))) short s16x4;
typedef __attribute__((ext_vector_type(16))) float f32x16;
typedef __attribute__((ext_vector_type(2))) float f32x2;
typedef __attribute__((ext_vector_type(2))) __bf16 bf16x2v;
typedef __attribute__((ext_vector_type(4))) unsigned u32x4;
typedef __attribute__((ext_vector_type(2))) unsigned u32x2;
#define MFMA(a, b, c) __builtin_amdgcn_mfma_f32_32x32x16_bf16((a), (b), (c), 0, 0, 0)

constexpr int NTOK = 16384, SEQL = 4096, DM = 1024;
constexpr int INW = 5280, INWP = 5376;
constexpr int NTHREADS = 256;
constexpr float LOG2E = 1.4426950408889634f;
constexpr float QS_SCALE = 0.125f * 1.4426950408889634f;
constexpr float QM_SCALE = 1.4426950408889634f / 9.797958971132712f;
constexpr float EPSN = 1e-6f;

constexpr int XCD_BAR_WORDS_C = 3456;
constexpr size_t al256(size_t v) { return (v + 255) & ~(size_t)255; }
constexpr size_t OFF_counter = 0;
constexpr size_t OFF_bar = OFF_counter + al256(256);
constexpr size_t OFF_MOD = OFF_bar + al256(XCD_BAR_WORDS_C * 4);
constexpr size_t OFF_ROPE = OFF_MOD + al256(4 * 3072 * 4 * 4);
constexpr size_t OFF_SSQ = OFF_ROPE + al256((size_t)NTOK * 32 * 4);
constexpr size_t OFF_Hb = OFF_SSQ + al256((size_t)2 * NTOK * 4);
constexpr size_t OFF_Qmla = OFF_Hb + al256((size_t)NTOK * 1024 * 2);
constexpr size_t OFF_WuqT = OFF_Qmla + al256((size_t)NTOK * 768 * 2);
constexpr size_t OFF_WukvT = OFF_WuqT + al256((size_t)768 * 384 * 2);
constexpr size_t OFF_WaT = OFF_WukvT + al256((size_t)1024 * 256 * 2);
constexpr size_t OFF_WbT = OFF_WaT + al256((size_t)1024 * 512 * 2);
constexpr size_t OFF_WoT = OFF_WbT + al256((size_t)1024 * 512 * 2);
constexpr size_t OFF_Qsb = OFF_WoT + al256((size_t)1024 * 1024 * 2);
constexpr size_t OFF_Ksb = OFF_Qsb + al256((size_t)NTOK * 512 * 2);
constexpr size_t OFF_VTsb = OFF_Ksb + al256((size_t)NTOK * 512 * 2);
constexpr size_t OFF_Zsb = OFF_VTsb + al256((size_t)NTOK * 512 * 2);
constexpr size_t OFF_OAg = OFF_Zsb + al256((size_t)NTOK * 512 * 2);
constexpr size_t OFF_OBg = OFF_OAg + al256((size_t)NTOK * 512 * 2);
constexpr size_t OFF_Zmla = OFF_OBg + al256((size_t)NTOK * 512 * 2);
constexpr size_t OFF_KPE = OFF_Zmla + al256((size_t)NTOK * 512 * 2);
constexpr size_t OFF_Knope = OFF_KPE + al256((size_t)NTOK * 32 * 2);
constexpr size_t OFF_VTmla = OFF_Knope + al256((size_t)NTOK * 512 * 2);
constexpr size_t WS_NEED = OFF_VTmla + al256((size_t)NTOK * 512 * 2);
struct Params {
  const float *x, *c; const int* pos;
  const float *w_ada, *b_ada, *norm_gain, *w_in, *q_gain, *w_uq, *kv_gain, *w_ukv, *w_a, *w_b, *w_out, *fgain;
  float* out;
  char* ws;
  DI int* counter() const { return (int*)(ws + OFF_counter); }
  DI unsigned* bar() const { return (unsigned*)(ws + OFF_bar); }
  DI float* MOD() const { return (float*)(ws + OFF_MOD); }
  DI float* ROPE() const { return (float*)(ws + OFF_ROPE); }
  DI float* SSQ() const { return (float*)(ws + OFF_SSQ); }
  DI bf16_t* Hb() const { return (bf16_t*)(ws + OFF_Hb); }
  DI bf16_t* Qmla() const { return (bf16_t*)(ws + OFF_Qmla); }
  DI bf16_t* WuqT() const { return (bf16_t*)(ws + OFF_WuqT); }
  DI bf16_t* WukvT() const { return (bf16_t*)(ws + OFF_WukvT); }
  DI bf16_t* WaT() const { return (bf16_t*)(ws + OFF_WaT); }
  DI bf16_t* WbT() const { return (bf16_t*)(ws + OFF_WbT); }
  DI bf16_t* WoT() const { return (bf16_t*)(ws + OFF_WoT); }
  DI bf16_t* Qsb() const { return (bf16_t*)(ws + OFF_Qsb); }
  DI bf16_t* Ksb() const { return (bf16_t*)(ws + OFF_Ksb); }
  DI bf16_t* VTsb() const { return (bf16_t*)(ws + OFF_VTsb); }
  DI bf16_t* Zsb() const { return (bf16_t*)(ws + OFF_Zsb); }
  DI bf16_t* OAg() const { return (bf16_t*)(ws + OFF_OAg); }
  DI bf16_t* OBg() const { return (bf16_t*)(ws + OFF_OBg); }
  DI bf16_t* Zmla() const { return (bf16_t*)(ws + OFF_Zmla); }
  DI bf16_t* KPE() const { return (bf16_t*)(ws + OFF_KPE); }
  DI bf16_t* Knope() const { return (bf16_t*)(ws + OFF_Knope); }
  DI bf16_t* VTmla() const { return (bf16_t*)(ws + OFF_VTmla); }
  DI bf16_t* MERGED() const { return Hb(); }
  DI bf16_t* WinT() const { return Qmla(); }
  DI bf16_t* CQ() const { return OAg(); }
  DI bf16_t* CKV() const { return OBg(); }
  DI bf16_t* GA() const { return (bf16_t*)out; }
  DI bf16_t* GB() const { return (bf16_t*)out + (size_t)NTOK * 1024; }
};


__device__ const float c_invfreq[16] = {
  1.0f, 0.5623413251903491f, 0.31622776601683794f, 0.1778279410038923f, 0.1f, 0.05623413251903491f, 0.03162277660168379f,
  0.01778279410038923f, 0.01f, 0.005623413251903491f, 0.0031622776601683794f, 0.001778279410038923f, 0.001f,
  0.0005623413251903491f, 0.00031622776601683794f, 0.0001778279410038923f};

DI unsigned pk2(float a, float b) { f32x2 v = {a, b}; bf16x2v r = __builtin_convertvector(v, bf16x2v); return __builtin_bit_cast(unsigned, r); }
DI bf16_t tobf(float a) { return (bf16_t)(pk2(a, 0.f) & 0xffffu); }
DI float bf2f(unsigned short u) { return __uint_as_float(((unsigned)u) << 16); }
DI bf16x8 pack8(float a0, float a1, float a2, float a3, float a4, float a5, float a6, float a7) {
  u32x4 p; p[0] = pk2(a0, a1); p[1] = pk2(a2, a3); p[2] = pk2(a4, a5); p[3] = pk2(a6, a7);
  return __builtin_bit_cast(bf16x8, p);
}
DI int crow(int reg, int h) { return (reg & 3) + 8 * (reg >> 2) + 4 * h; }
DI int opaque_tid() { int t = threadIdx.x; asm volatile("" : "+v"(t)); return t; }
DI float half_max(float v) {
  unsigned u = __float_as_uint(v);
  auto r = __builtin_amdgcn_permlane32_swap(u, u, false, false);
  return fmaxf(__uint_as_float(r[0]), __uint_as_float(r[1]));
}
DI float half_sum(float v) {
  unsigned u = __float_as_uint(v);
  auto r = __builtin_amdgcn_permlane32_swap(u, u, false, false);
  return __uint_as_float(r[0]) + __uint_as_float(r[1]);
}
DI float sigmoidf_fast(float v) { return __builtin_amdgcn_rcpf(1.f + __builtin_amdgcn_exp2f(-v * LOG2E)); }
DI float siluf_fast(float v) { return v * sigmoidf_fast(v); }

#define XB_TMO      128
#define XB_XCNT(j)  (256  + 64 * (j))
#define XB_XSUB(j)  (1280 + 64 * (j))
#define XB_XGEN(j)  (2304 + 64 * (j))
#define XB_TOP      3328
#define XB_TOPGEN   3392
#define XCD_BAR_WORDS 3456
#define XB_SPIN_CAP (1u << 18)
#define LAS __attribute__((address_space(3)))
DI unsigned xb_ld(unsigned* p)              { return __hip_atomic_load(p, __ATOMIC_RELAXED, __HIP_MEMORY_SCOPE_AGENT); }
DI unsigned xb_add(unsigned* p, unsigned v) { return __hip_atomic_fetch_add(p, v, __ATOMIC_RELAXED, __HIP_MEMORY_SCOPE_AGENT); }
DI unsigned xb_xcc_id() { return (unsigned)__builtin_amdgcn_s_getreg((3 << 11) | 20) & 0xFu; }
#define XB_SPIN(cond, bar) do { unsigned _sp = 0; while (cond) { __builtin_amdgcn_s_sleep(1); \
    if ((++_sp & 255u) == 0u) { if (xb_ld(&(bar)[XB_TMO])) break; if (_sp > XB_SPIN_CAP) { atomicAdd(&(bar)[XB_TMO], 1u); break; } } } } while (0)
struct XcdBarrier { unsigned* bar; unsigned x; volatile LAS unsigned* st; };
DI XcdBarrier xcd_barrier_post(unsigned* bar, volatile LAS unsigned* st) {
  XcdBarrier b; b.bar = bar; b.x = xb_xcc_id(); b.st = st;
  if (threadIdx.x == 0) (void)xb_add(&bar[XB_XCNT(b.x)], 1u);
  return b;
}
DI void xcd_barrier_complete(unsigned* bar, unsigned x, unsigned& nloc, unsigned& nx) {
  const unsigned G = gridDim.x * gridDim.y * gridDim.z;
  unsigned sum, cnt, mine, sp = 0u;
  for (;;) {
    sum = 0u; cnt = 0u; mine = 0u;
#pragma unroll
    for (unsigned j = 0; j < 16; ++j) { const unsigned c = xb_ld(&bar[XB_XCNT(j)]); sum += c; cnt += (c > 0u) ? 1u : 0u; mine = (j == x) ? c : mine; }
    if (sum == G) break;
    __builtin_amdgcn_s_sleep(1);
    if ((++sp & 255u) == 0u) { if (xb_ld(&bar[XB_TMO])) break; if (sp > XB_SPIN_CAP) { atomicAdd(&bar[XB_TMO], 1u); break; } }
  }
  nloc = mine > 0u ? mine : 1u; nx = cnt > 0u ? cnt : 1u;
}
DI void xcd_barrier(unsigned* bar_, volatile LAS unsigned* st_) {
  XcdBarrier b; b.bar = bar_; b.st = st_; b.x = 0;
  asm volatile("s_waitcnt vmcnt(0)" ::: "memory");
  __syncthreads();
  if (threadIdx.x == 0) {
    unsigned* bar = b.bar;
    b.x = xb_xcc_id();
    __builtin_amdgcn_s_waitcnt(0);
    unsigned nloc = b.st[0], nx = b.st[1];
    if (nloc == 0u) { xcd_barrier_complete(bar, b.x, nloc, nx); b.st[0] = nloc; b.st[1] = nx; }
    const unsigned old = xb_add(&bar[XB_XSUB(b.x)], 1u);
    const unsigned gen = old / nloc;
    if (old + 1u == (gen + 1u) * nloc) {
      __builtin_amdgcn_fence(__ATOMIC_RELEASE, "agent");
      asm volatile("s_waitcnt vmcnt(0)" ::: "memory");
      const unsigned og = xb_add(&bar[XB_TOP], 1u);
      const unsigned tg = og / nx;
      if (og + 1u == (tg + 1u) * nx) xb_add(&bar[XB_TOPGEN], 1u);
      else XB_SPIN(xb_ld(&bar[XB_TOPGEN]) == tg, bar);
      __builtin_amdgcn_fence(__ATOMIC_ACQUIRE, "agent");
      xb_add(&bar[XB_XGEN(b.x)], 1u);
      asm volatile("s_waitcnt vmcnt(0)" ::: "memory");
    } else {
      XB_SPIN(xb_ld(&bar[XB_XGEN(b.x)]) == gen, bar);
      __builtin_amdgcn_fence(__ATOMIC_ACQUIRE, "agent");
      asm volatile("s_waitcnt vmcnt(0)" ::: "memory");
    }
  }
  __syncthreads();
}

constexpr int GSTR = 72;
constexpr int GBUF = 128 * GSTR;
constexpr int SMEM_BYTES = 4 * GBUF * 2 + 1024;

#ifndef GEMM_GLDS
#define GEMM_GLDS 1
#endif
#if GEMM_GLDS
template <bool ROWSS>
DI void gemm_mainloop(const bf16_t* __restrict__ A, int lda, const bf16_t* __restrict__ B, int ldb, int K,
                      bf16_t* sA_, bf16_t* sB_, f32x16 (&acc)[2][2], float* rs) {
  char* smem = (char*)sA_;
  const int tid = opaque_tid(), lane = tid & 63, w = tid >> 6;
  const int wm = w >> 1, wn = w & 1, r = lane & 31, hh = lane >> 5;
  const int lr = lane >> 3, cp = lane & 7;
  const int cl = cp ^ (((w & 1) << 2) + (lr >> 1));
  const unsigned voA = (unsigned)((w * 8 + lr) * lda + cl * 8) * 2u, voB = (unsigned)((w * 8 + lr) * ldb + cl * 8) * 2u;
  const char* Ab = (const char*)A;
  const char* Bb = (const char*)B;
  const int nk = K >> 6;
  char* sw = smem + __builtin_amdgcn_readfirstlane(w) * 1024;
#define GL_STAGE(buf, ko)                                                                                                \
  { _Pragma("unroll") for (int i_ = 0; i_ < 4; ++i_) {                                                                   \
      __builtin_amdgcn_global_load_lds((const unsigned*)(Ab + (size_t)(i_ * 32 * lda + (ko)) * 2 + voA),                \
                                       (unsigned*)(sw + (buf) * 32768 + i_ * 4096), 16, 0, 0);                          \
      __builtin_amdgcn_global_load_lds((const unsigned*)(Bb + (size_t)(i_ * 32 * ldb + (ko)) * 2 + voB),                \
                                       (unsigned*)(sw + (buf) * 32768 + 16384 + i_ * 4096), 16, 0, 0); } }
  const int t3 = hh ^ ((r >> 1) & 7);
  const int arow = (wm * 64 + r) * 128, brow = 16384 + (wn * 64 + r) * 128;
  const int c0 = ((0 ^ t3) << 4), c1 = ((2 ^ t3) << 4), c2 = ((4 ^ t3) << 4), c3 = ((6 ^ t3) << 4);
#define GL_KK(bufp, cx)                                                                                                  \
  { const bf16x8 a0 = *(const bf16x8*)((bufp) + arow + (cx)), a1 = *(const bf16x8*)((bufp) + arow + 4096 + (cx));        \
    const bf16x8 b0 = *(const bf16x8*)((bufp) + brow + (cx)), b1 = *(const bf16x8*)((bufp) + brow + 4096 + (cx));        \
    acc[0][0] = MFMA(a0, b0, acc[0][0]); acc[0][1] = MFMA(a0, b1, acc[0][1]);                                            \
    acc[1][0] = MFMA(a1, b0, acc[1][0]); acc[1][1] = MFMA(a1, b1, acc[1][1]); }
  GL_STAGE(0, 0)
  asm volatile("s_waitcnt vmcnt(0)" ::: "memory");
  __syncthreads();
  for (int ks = 0; ks < nk; ++ks) {
    const int cur = ks & 1;
    if (ks + 1 < nk) GL_STAGE(cur ^ 1, (ks + 1) * 64)
    const char* bp = smem + cur * 32768;
    GL_KK(bp, c0) GL_KK(bp, c1) GL_KK(bp, c2) GL_KK(bp, c3)
    asm volatile("s_waitcnt vmcnt(0)" ::: "memory");
    __syncthreads();
  }
#undef GL_STAGE
#undef GL_KK
}
#else
template <bool ROWSS>
DI void gemm_mainloop(const bf16_t* __restrict__ A, int lda, const bf16_t* __restrict__ B, int ldb, int K,
                      bf16_t* sA, bf16_t* sB, f32x16 (&acc)[2][2], float* rs) {
  const int tid = threadIdx.x, lane = tid & 63, w = tid >> 6;
  const int wm = w >> 1, wn = w & 1, r = lane & 31, hh = lane >> 5;
  const int lrow = tid >> 3, lch = tid & 7;
  const char* Ab = (const char*)A;
  const char* Bb = (const char*)B;
  const unsigned voA = (unsigned)(lrow * lda + lch * 8) * 2u, voB = (unsigned)(lrow * ldb + lch * 8) * 2u;
  uint4 xa0, xa1, xa2, xa3, xb0, xb1, xb2, xb3, ya0, ya1, ya2, ya3, yb0, yb1, yb2, yb3;
  float ss0 = 0.f, ss1 = 0.f, ss2 = 0.f, ss3 = 0.f;
  const int nk = K >> 6;
#define G_LD1(base, i, ld, ko, vo) (*(const uint4*)((base) + (size_t)((i) * 32 * (ld) + (ko)) * 2 + (vo)))
#define G_LOAD(P, ko)                                                                                                    \
  { P##a0 = G_LD1(Ab, 0, lda, ko, voA); P##a1 = G_LD1(Ab, 1, lda, ko, voA); P##a2 = G_LD1(Ab, 2, lda, ko, voA); P##a3 = G_LD1(Ab, 3, lda, ko, voA); \
    P##b0 = G_LD1(Bb, 0, ldb, ko, voB); P##b1 = G_LD1(Bb, 1, ldb, ko, voB); P##b2 = G_LD1(Bb, 2, ldb, ko, voB); P##b3 = G_LD1(Bb, 3, ldb, ko, voB); }
#define G_SSQ(v, s) { unsigned u_[4] = {v.x, v.y, v.z, v.w}; _Pragma("unroll") for (int j_ = 0; j_ < 4; ++j_) { \
    const float lo_ = __uint_as_float(u_[j_] << 16), hi_ = __uint_as_float(u_[j_] & 0xffff0000u); s += lo_ * lo_ + hi_ * hi_; } }
#define G_WRITE(P, bufo)                                                                                                 \
  { *(uint4*)(sA + (bufo) + woff) = P##a0; *(uint4*)(sA + (bufo) + woff + 32 * GSTR) = P##a1;                            \
    *(uint4*)(sA + (bufo) + woff + 64 * GSTR) = P##a2; *(uint4*)(sA + (bufo) + woff + 96 * GSTR) = P##a3;                \
    *(uint4*)(sB + (bufo) + woff) = P##b0; *(uint4*)(sB + (bufo) + woff + 32 * GSTR) = P##b1;                            \
    *(uint4*)(sB + (bufo) + woff + 64 * GSTR) = P##b2; *(uint4*)(sB + (bufo) + woff + 96 * GSTR) = P##b3;                \
    if (ROWSS) { G_SSQ(P##a0, ss0) G_SSQ(P##a1, ss1) G_SSQ(P##a2, ss2) G_SSQ(P##a3, ss3) } }
#define G_COMPUTE(bufo)                                                                                                  \
  { const bf16_t* cA = sA + (bufo) + (wm * 64 + r) * GSTR + hh * 8;                                                      \
    const bf16_t* cB = sB + (bufo) + (wn * 64 + r) * GSTR + hh * 8;                                                      \
    _Pragma("unroll") for (int kk = 0; kk < 4; ++kk) {                                                                   \
      const bf16x8 a0 = *(const bf16x8*)(cA + kk * 16), a1 = *(const bf16x8*)(cA + 32 * GSTR + kk * 16);                 \
      const bf16x8 b0 = *(const bf16x8*)(cB + kk * 16), b1 = *(const bf16x8*)(cB + 32 * GSTR + kk * 16);                 \
      acc[0][0] = MFMA(a0, b0, acc[0][0]); acc[0][1] = MFMA(a0, b1, acc[0][1]);                                          \
      acc[1][0] = MFMA(a1, b0, acc[1][0]); acc[1][1] = MFMA(a1, b1, acc[1][1]); } }
  const int woff = lrow * GSTR + lch * 8;
  G_LOAD(x, 0)
  G_LOAD(y, 64)
  G_WRITE(x, 0)
  __syncthreads();
  for (int ks = 0; ks < nk; ks += 2) {
    if (ks + 2 < nk) G_LOAD(x, (ks + 2) * 64)
    G_COMPUTE(0)
    G_WRITE(y, GBUF)
    __syncthreads();
    if (ks + 3 < nk) G_LOAD(y, (ks + 3) * 64)
    G_COMPUTE(GBUF)
    if (ks + 2 < nk) G_WRITE(x, 0)
    __syncthreads();
  }
#undef G_LOAD
#undef G_LD1
#undef G_SSQ
#undef G_WRITE
#undef G_COMPUTE
  if (ROWSS) {
    float sv[4] = {ss0, ss1, ss2, ss3};
#pragma unroll
    for (int i = 0; i < 4; ++i) {
      float v = sv[i];
      v += __shfl_xor(v, 1); v += __shfl_xor(v, 2); v += __shfl_xor(v, 4);
      if (lch == 0) rs[lrow + 32 * i] = __builtin_amdgcn_rsqf(v / (float)K + EPSN);
    }
  }
}

#endif

DI void zero_acc(f32x16 (&acc)[2][2]) {
#pragma unroll
  for (int a = 0; a < 2; ++a)
#pragma unroll
    for (int b = 0; b < 2; ++b)
#pragma unroll
      for (int i = 0; i < 16; ++i) acc[a][b][i] = 0.f;
}

constexpr int CSTR = 132;
DI void acc_to_lds(f32x16 (&acc)[2][2], float* sC) {
  const int lane = threadIdx.x & 63, w = threadIdx.x >> 6;
  const int wm = w >> 1, wn = w & 1, r = lane & 31, hh = lane >> 5;
#pragma unroll
  for (int mt = 0; mt < 2; ++mt)
#pragma unroll
    for (int nt = 0; nt < 2; ++nt)
#pragma unroll
      for (int i = 0; i < 16; ++i) sC[(wm * 64 + mt * 32 + crow(i, hh)) * CSTR + wn * 64 + nt * 32 + r] = acc[mt][nt][i];
}
template <class F>
DI void epi_rows(const float* sC, F f) {
  const int tx = opaque_tid();
#pragma unroll
  for (int i = 0; i < 8; ++i) {
    const int c = tx + 256 * i, row = c >> 4, cc = (c & 15) * 8;
    const float4 a = *(const float4*)(sC + row * CSTR + cc), b = *(const float4*)(sC + row * CSTR + cc + 4);
    const float v[8] = {a.x, a.y, a.z, a.w, b.x, b.y, b.z, b.w};
    f(i, row, cc, v);
  }
}
DI void store8(bf16_t* p, const float (&v)[8]) { *(bf16x8*)p = pack8(v[0], v[1], v[2], v[3], v[4], v[5], v[6], v[7]); }
DI void epi_vt(const float* sC, bf16_t* VT, int m0, int head0, int c0, int ncol_log2) {
  const int b = m0 >> 12, s0 = m0 & 4095;
  const int nitems = 16 << ncol_log2;
  for (int c = opaque_tid(); c < nitems; c += 256) {
    const int col = c & ((1 << ncol_log2) - 1), rc = c >> ncol_log2;
    float v[8];
#pragma unroll
    for (int j = 0; j < 8; ++j) v[j] = sC[(rc * 8 + j) * CSTR + c0 + col];
    const int head = head0 + (col >> 6), d = col & 63;
    store8(VT + ((size_t)((b * 8 + head) * 64 + d)) * SEQL + s0 + rc * 8, v);
  }
}
DI void rope8(const float* sC, const float* ROPE, int tok, int row, int cc, float (&v)[8]) {
  const float* pr = sC + row * CSTR + (cc ^ 16);
  const bool upper = (cc & 16) != 0;
  const int f0 = cc & 15;
  const float* tb = ROPE + (size_t)tok * 32;
#pragma unroll
  for (int j = 0; j < 8; ++j) {
    const float o = pr[j], cs = tb[f0 + j], sn = tb[16 + f0 + j];
    v[j] = upper ? (o * sn + v[j] * cs) : (v[j] * cs - o * sn);
  }
}

DI void wconv_unit(const float* __restrict__ src, int Nsrc, int K, bf16_t* __restrict__ dst, const float* __restrict__ gain, int ng, int kg, int mode, float* tile) {
  const int tid = threadIdx.x;
  {
    const int k = tid >> 2, cq = tid & 3;
    const int n = ng * 64 + cq * 16;
    int sc = n;
    if (mode == 1) { sc = (n < 2688) ? n : (n < 5248 ? n + 32 : (n < 5280 ? n - 2560 : -1)); }
    const int kk = kg * 64 + k;
    float4 v[4];
    if (sc >= 0) {
      const float* sp = src + (size_t)kk * Nsrc + sc;
#pragma unroll
      for (int i = 0; i < 4; ++i) v[i] = *(const float4*)(sp + 4 * i);
      if (gain) { const float g = gain[kk];
#pragma unroll
        for (int i = 0; i < 4; ++i) { v[i].x *= g; v[i].y *= g; v[i].z *= g; v[i].w *= g; } }
    } else {
#pragma unroll
      for (int i = 0; i < 4; ++i) v[i] = make_float4(0.f, 0.f, 0.f, 0.f);
    }
    float* tp = tile + k * 65 + cq * 16;
#pragma unroll
    for (int i = 0; i < 4; ++i) { tp[4 * i] = v[i].x; tp[4 * i + 1] = v[i].y; tp[4 * i + 2] = v[i].z; tp[4 * i + 3] = v[i].w; }
  }
  __syncthreads();
  {
    const int n = tid >> 2, kc = tid & 3;
    float o[16];
#pragma unroll
    for (int j = 0; j < 16; ++j) o[j] = tile[(kc * 16 + j) * 65 + n];
    bf16_t* dp = dst + (size_t)(ng * 64 + n) * K + kg * 64 + kc * 16;
    *(bf16x8*)dp = pack8(o[0], o[1], o[2], o[3], o[4], o[5], o[6], o[7]);
    *(bf16x8*)(dp + 8) = pack8(o[8], o[9], o[10], o[11], o[12], o[13], o[14], o[15]);
  }
  __syncthreads();
}

DI void phase_prep(const Params& p, char* smem) {
  const int tid = threadIdx.x;
  if (blockIdx.x == 0 && tid < 16) { p.counter()[tid] = 0; }
  for (int i = blockIdx.x * NTHREADS + tid; i < 2 * NTOK; i += gridDim.x * NTHREADS) p.SSQ()[i] = 0.f;
  constexpr int U_MOD = 96 * 4, U_WIN = 84 * 16, U_WUQ = 12 * 6, U_WUKV = 16 * 4, U_WA = 16 * 8, U_WB = 16 * 8, U_WO = 16 * 16, U_ROPE = 1024;
  constexpr int U_TOTAL = U_MOD + U_ROPE + U_WIN + U_WUQ + U_WUKV + U_WA + U_WB + U_WO;
  float* tile = (float*)smem;
  for (int u = blockIdx.x; u < U_TOTAL; u += gridDim.x) {
    int v = u;
    if (v < U_MOD) {
      const int cg32 = v >> 2, kq = v & 3, n0 = cg32 * 32;
      const int kgp = tid >> 5, col = tid & 31;
      const int kb = kq * 256 + kgp * 32;
      float a0 = 0.f, a1 = 0.f, a2 = 0.f, a3 = 0.f;
      const float* wp = p.w_ada + (size_t)kb * 3072 + n0 + col;
      float wv[32];
#pragma unroll
      for (int kk = 0; kk < 32; ++kk) wv[kk] = wp[(size_t)kk * 3072];
#pragma unroll
      for (int kk = 0; kk < 32; ++kk) {
        a0 += wv[kk] * p.c[kb + kk]; a1 += wv[kk] * p.c[1024 + kb + kk]; a2 += wv[kk] * p.c[2048 + kb + kk]; a3 += wv[kk] * p.c[3072 + kb + kk];
      }
      float* red = (float*)smem;
      red[(kgp * 4 + 0) * 32 + col] = a0; red[(kgp * 4 + 1) * 32 + col] = a1; red[(kgp * 4 + 2) * 32 + col] = a2; red[(kgp * 4 + 3) * 32 + col] = a3;
      __syncthreads();
      if (tid < 128) {
        const int b = tid >> 5, cc = tid & 31;
        float s = (kq == 0) ? p.b_ada[n0 + cc] : 0.f;
#pragma unroll
        for (int g = 0; g < 8; ++g) s += red[(g * 4 + b) * 32 + cc];
        p.MOD()[(size_t)(b * 3072 + n0 + cc) * 4 + kq] = s;
      }
      __syncthreads();
      continue;
    }
    v -= U_MOD;
    if (v < U_WIN) { wconv_unit(p.w_in, INW, 1024, p.WinT(), nullptr, v >> 4, v & 15, 1, tile); continue; }
    v -= U_WIN;
    if (v < U_WUQ) { wconv_unit(p.w_uq, 768, 384, p.WuqT(), p.q_gain, v / 6, v % 6, 0, tile); continue; }
    v -= U_WUQ;
    if (v < U_WUKV) { wconv_unit(p.w_ukv, 1024, 256, p.WukvT(), p.kv_gain, v >> 2, v & 3, 0, tile); continue; }
    v -= U_WUKV;
    if (v < U_WA) { wconv_unit(p.w_a, 1024, 512, p.WaT(), nullptr, v >> 3, v & 7, 0, tile); continue; }
    v -= U_WA;
    if (v < U_WB) { wconv_unit(p.w_b, 1024, 512, p.WbT(), nullptr, v >> 3, v & 7, 0, tile); continue; }
    v -= U_WB;
    if (v < U_WO) { wconv_unit(p.w_out, 1024, 1024, p.WoT(), nullptr, v >> 4, v & 15, 0, tile); continue; }
    v -= U_WO;
    {
      const int idx = v * 256 + tid, tok = idx >> 4, i = idx & 15;
      const float ang = (float)p.pos[tok] * c_invfreq[i];
      double t = (double)ang * 0.15915494309189535;
      t -= rint(t);
      const float tf = (float)t;
      p.ROPE()[(size_t)tok * 32 + i] = __builtin_amdgcn_cosf(tf);
      p.ROPE()[(size_t)tok * 32 + 16 + i] = __builtin_amdgcn_sinf(tf);
    }
  }
}

DI float mod_get(const float* MOD, int b, int n) { const float4 q = *(const float4*)(MOD + (size_t)(b * 3072 + n) * 4); return (q.x + q.y) + (q.z + q.w); }

DI void phase_h(const Params& p, char* smem) {
  const int tid = opaque_tid(), lane = tid & 63, w = tid >> 6;
  float* gs = (float*)smem;
  float* sh = gs + 1024;
  for (int rg = blockIdx.x; rg < NTOK / 32; rg += gridDim.x) {
    const int b = (rg * 32) >> 12;
    __syncthreads();
#pragma unroll
    for (int i = 0; i < 4; ++i) {
      const int k = tid + 256 * i;
      gs[k] = p.norm_gain[k] * (1.f + mod_get(p.MOD(), b, 1024 + k));
      sh[k] = mod_get(p.MOD(), b, k);
    }
    __syncthreads();
#pragma unroll 2
    for (int rr = 0; rr < 8; ++rr) {
      const int row = rg * 32 + w * 8 + rr;
      const float* xr = p.x + (size_t)row * DM;
      float4 v[4];
      float ss = 0.f;
#pragma unroll
      for (int i = 0; i < 2; ++i) {
        const int e = 8 * (lane + 64 * i);
        v[2 * i] = *(const float4*)(xr + e);
        v[2 * i + 1] = *(const float4*)(xr + e + 4);
        ss += v[2 * i].x * v[2 * i].x + v[2 * i].y * v[2 * i].y + v[2 * i].z * v[2 * i].z + v[2 * i].w * v[2 * i].w;
        ss += v[2 * i + 1].x * v[2 * i + 1].x + v[2 * i + 1].y * v[2 * i + 1].y + v[2 * i + 1].z * v[2 * i + 1].z + v[2 * i + 1].w * v[2 * i + 1].w;
      }
#pragma unroll
      for (int o = 32; o >= 1; o >>= 1) ss += __shfl_xor(ss, o);
      const float rn = __builtin_amdgcn_rsqf(ss * (1.f / DM) + EPSN);
#pragma unroll
      for (int i = 0; i < 2; ++i) {
        const int e = 8 * (lane + 64 * i);
        const float4 g0 = *(const float4*)(gs + e), g1 = *(const float4*)(gs + e + 4);
        const float4 s0 = *(const float4*)(sh + e), s1 = *(const float4*)(sh + e + 4);
        *(bf16x8*)(p.Hb() + (size_t)row * DM + e) =
            pack8(v[2 * i].x * rn * g0.x + s0.x, v[2 * i].y * rn * g0.y + s0.y, v[2 * i].z * rn * g0.z + s0.z, v[2 * i].w * rn * g0.w + s0.w,
                  v[2 * i + 1].x * rn * g1.x + s1.x, v[2 * i + 1].y * rn * g1.y + s1.y, v[2 * i + 1].z * rn * g1.z + s1.z, v[2 * i + 1].w * rn * g1.w + s1.w);
      }
    }
  }
  __syncthreads();
}

DI void phase_g1(const Params& p, char* smem, bool do_ssq = true) {
  bf16_t* sA = (bf16_t*)smem;
  bf16_t* sB = sA + 2 * GBUF;
  float* sC = (float*)smem;
  float* rs = (float*)(smem + 4 * GBUF * 2);
  constexpr int NCT = INWP / 128;
  const int ntiles = (NTOK / 128) * NCT;
  const int xq = blockIdx.x & 7, lb = blockIdx.x >> 3, nlb = gridDim.x >> 3;
  const bool xmap = (gridDim.x & 7) == 0;
  for (int t = xmap ? lb : (int)blockIdx.x; t < (xmap ? 16 * NCT : ntiles); t += (xmap ? nlb : (int)gridDim.x)) {
    int rt, ct;
    if (xmap) { const int half = t / (8 * NCT), wv = t % (8 * NCT); ct = wv >> 3; rt = 16 * xq + 8 * half + (wv & 7); }
    else { rt = t / NCT; ct = t % NCT; }
    const int m0 = rt * 128, n0 = ct * 128;
    f32x16 acc[2][2];
    zero_acc(acc);
    gemm_mainloop<false>(p.Hb() + (size_t)m0 * DM, DM, p.WinT() + (size_t)n0 * DM, DM, DM, sA, sB, acc, rs);
    acc_to_lds(acc, sC);
    __syncthreads();
    if (ct < 4) {
      epi_rows(sC, [&](int, int row, int cc, const float (&v)[8]) {
        float o[8];
#pragma unroll
        for (int j = 0; j < 8; ++j) o[j] = v[j] * QS_SCALE;
        store8(p.Qsb() + (size_t)(m0 + row) * 512 + n0 + cc, o); });
    } else if (ct < 8) {
      epi_rows(sC, [&](int, int row, int cc, const float (&v)[8]) { store8(p.Ksb() + (size_t)(m0 + row) * 512 + n0 - 512 + cc, v); });
    } else if (ct < 12) {
      epi_vt(sC, p.VTsb(), m0, (n0 - 1024) >> 6, 0, 7);
    } else if (ct < 16) {
      epi_rows(sC, [&](int, int row, int cc, const float (&v)[8]) {
        float o[8];
#pragma unroll
        for (int j = 0; j < 8; ++j) o[j] = siluf_fast(v[j]);
        store8(p.Zsb() + (size_t)(m0 + row) * 512 + n0 - 1536 + cc, o); });
    } else if (ct < 19) {
      epi_rows(sC, [&](int, int row, int cc, const float (&v)[8]) {
        store8(p.CQ() + (size_t)(m0 + row) * 384 + n0 - 2048 + cc, v);
        float q = 0.f;
#pragma unroll
        for (int j = 0; j < 8; ++j) q += v[j] * v[j];
        q += __shfl_xor(q, 1); q += __shfl_xor(q, 2); q += __shfl_xor(q, 4); q += __shfl_xor(q, 8);
        if (do_ssq && (threadIdx.x & 15) == 0) atomicAdd(p.SSQ() + m0 + row, q); });
    } else if (ct < 21) {
      epi_rows(sC, [&](int, int row, int cc, const float (&v)[8]) {
        store8(p.CKV() + (size_t)(m0 + row) * 256 + n0 - 2432 + cc, v);
        float q = 0.f;
#pragma unroll
        for (int j = 0; j < 8; ++j) q += v[j] * v[j];
        q += __shfl_xor(q, 1); q += __shfl_xor(q, 2); q += __shfl_xor(q, 4); q += __shfl_xor(q, 8);
        if (do_ssq && (threadIdx.x & 15) == 0) atomicAdd(p.SSQ() + NTOK + m0 + row, q); });
    } else if (ct < 25) {
      epi_rows(sC, [&](int, int row, int cc, const float (&v)[8]) {
        float o[8];
#pragma unroll
        for (int j = 0; j < 8; ++j) o[j] = siluf_fast(v[j]);
        store8(p.Zmla() + (size_t)(m0 + row) * 512 + n0 - 2688 + cc, o); });
    } else if (ct < 33) {
      epi_rows(sC, [&](int, int row, int cc, const float (&v)[8]) {
        float o[8];
#pragma unroll
        for (int j = 0; j < 8; ++j) o[j] = sigmoidf_fast(v[j]);
        store8(p.GA() + (size_t)(m0 + row) * 1024 + n0 - 3200 + cc, o); });
    } else if (ct < 41) {
      epi_rows(sC, [&](int, int row, int cc, const float (&v)[8]) {
        float o[8];
#pragma unroll
        for (int j = 0; j < 8; ++j) o[j] = sigmoidf_fast(v[j]);
        store8(p.GB() + (size_t)(m0 + row) * 1024 + n0 - 4224 + cc, o); });
    } else {
      epi_rows(sC, [&](int, int row, int cc, const float (&v)[8]) {
        if (cc < 32) {
          float o[8];
#pragma unroll
          for (int j = 0; j < 8; ++j) o[j] = v[j];
          rope8(sC, p.ROPE(), m0 + row, row, cc, o);
          store8(p.KPE() + (size_t)(m0 + row) * 32 + cc, o);
        } });
    }
    __syncthreads();
  }
}

DI void phase_g2(const Params& p, char* smem) {
  bf16_t* sA = (bf16_t*)smem;
  bf16_t* sB = sA + 2 * GBUF;
  float* sC = (float*)smem;
  float* rs = (float*)(smem + 4 * GBUF * 2);
  constexpr int NQ = 128 * 6, NKV = 128 * 8;
  const int xq = blockIdx.x & 7, lb = blockIdx.x >> 3, nlb = gridDim.x >> 3;
  const bool xmap = (gridDim.x & 7) == 0;
  for (int tt = xmap ? lb : (int)blockIdx.x; tt < (xmap ? 224 : NQ + NKV); tt += (xmap ? nlb : (int)gridDim.x)) {
    int t = tt;
    if (xmap) {
      if (tt < 96) t = (16 * xq + (tt & 15)) * 6 + (tt >> 4);
      else { const int v2 = tt - 96; t = NQ + (16 * xq + (v2 & 15)) * 8 + (v2 >> 4); }
    }
    f32x16 acc[2][2];
    zero_acc(acc);
    if (t < NQ) {
      const int rt = t / 6, ct = t % 6, m0 = rt * 128, n0 = ct * 128;
      if (threadIdx.x < 128) rs[threadIdx.x] = __builtin_amdgcn_rsqf(p.SSQ()[m0 + threadIdx.x] * (1.f / 384.f) + EPSN);
      gemm_mainloop<false>(p.CQ() + (size_t)m0 * 384, 384, p.WuqT() + (size_t)n0 * 384, 384, 384, sA, sB, acc, rs);
      acc_to_lds(acc, sC);
      __syncthreads();
      epi_rows(sC, [&](int, int row, int cc, const float (&v)[8]) {
        const int col = n0 + cc;
        float o[8];
#pragma unroll
        for (int j = 0; j < 8; ++j) o[j] = v[j];
        if (((col >> 5) % 3) == 2) rope8(sC, p.ROPE(), m0 + row, row, cc, o);
        const float sc = rs[row] * QM_SCALE;
#pragma unroll
        for (int j = 0; j < 8; ++j) o[j] *= sc;
        store8(p.Qmla() + (size_t)(m0 + row) * 768 + col, o);
      });
    } else {
      const int t2 = t - NQ;
      const int rt = t2 >> 3, head = t2 & 7, m0 = rt * 128, n0 = head * 128;
      if (threadIdx.x < 128) rs[threadIdx.x] = __builtin_amdgcn_rsqf(p.SSQ()[NTOK + m0 + threadIdx.x] * (1.f / 256.f) + EPSN);
      gemm_mainloop<false>(p.CKV() + (size_t)m0 * 256, 256, p.WukvT() + (size_t)n0 * 256, 256, 256, sA, sB, acc, rs);
      acc_to_lds(acc, sC);
      __syncthreads();
      epi_rows(sC, [&](int, int row, int cc, const float (&v)[8]) {
        if (cc < 64) {
          const float sc = rs[row];
          float o[8];
#pragma unroll
          for (int j = 0; j < 8; ++j) o[j] = v[j] * sc;
          store8(p.Knope() + (size_t)(m0 + row) * 512 + head * 64 + cc, o);
        } });
      {
        const int b = m0 >> 12, s0 = m0 & 4095;
        for (int c = opaque_tid(); c < 1024; c += 256) {
          const int col = c & 63, rc = c >> 6;
          float v[8];
#pragma unroll
          for (int j = 0; j < 8; ++j) v[j] = sC[(rc * 8 + j) * CSTR + 64 + col] * rs[rc * 8 + j];
          store8(p.VTmla() + ((size_t)((b * 8 + head) * 64 + col)) * SEQL + s0 + rc * 8, v);
        }
      }
    }
    __syncthreads();
  }
}

constexpr int VSTR = 68;

template <bool MLA>
DI void attn_item(const Params& p, int b, int h, int qb, char* smem) {
  constexpr int DK = MLA ? 96 : 64;
  constexpr int KSTR = MLA ? 104 : 72;
  constexpr int NKS = DK / 16;
  bf16_t* sK = (bf16_t*)smem;
  bf16_t* sV = sK + 2 * 64 * KSTR;
  const int tid = threadIdx.x, lane = tid & 63, w = tid >> 6, r = lane & 31, hh = lane >> 5;
  const int tokb = b * SEQL;
  const int tok0 = tokb + qb * 128;
  const int qw = qb * 128 + w * 32;

  bf16x8 qf[NKS];
  {
    const bf16_t* qptr = MLA ? (p.Qmla() + (size_t)(tok0 + w * 32 + r) * 768 + h * 96 + hh * 8) : (p.Qsb() + (size_t)(tok0 + w * 32 + r) * 512 + h * 64 + hh * 8);
#pragma unroll
    for (int ks = 0; ks < NKS; ++ks) qf[ks] = *(const bf16x8*)(qptr + ks * 16);
  }
  bf16x8 tf[2];
  if (!MLA) {
#pragma unroll
    for (int st = 0; st < 2; ++st)
#pragma unroll
      for (int e = 0; e < 8; ++e) { const int j = 16 * st + 8 * (e >> 2) + 4 * hh + (e & 3); tf[st][e] = (j >= r) ? (short)0x3F80 : (short)0; }
  }

  f32x16 oacc[2];
#pragma unroll
  for (int i = 0; i < 16; ++i) { oacc[0][i] = 0.f; oacc[1][i] = 0.f; }
  float carry = 0.f;
  float mrun = 0.f, lrun = 0.f;

  const bf16_t* Kg = MLA ? p.Knope() : p.Ksb();
  const bf16_t* VTg = (MLA ? p.VTmla() : p.VTsb()) + (size_t)((b * 8 + h) * 64) * SEQL;
  const int nt = 2 * qb + 2;

  uint4 xk0, xk1, xv0, xv1, xp, yk0, yk1, yv0, yv1, yp;
  xp = make_uint4(0, 0, 0, 0); yp = xp;
  const int prow = tid >> 3, pch = tid & 7;
  const bf16_t* kgp = Kg + (size_t)(tokb + prow) * 512 + h * 64 + pch * 8;
  const bf16_t* vgp = VTg + (size_t)prow * SEQL + pch * 8;
  const bf16_t* pgp = p.KPE() + (size_t)(tokb + (tid >> 2)) * 32 + (tid & 3) * 8;
#define ATT_GLOAD(P, kt_)                                                          \
  {                                                                                \
    const int kt__ = (kt_);                                                        \
    P##k0 = *(const uint4*)(kgp + (size_t)(kt__ * 64) * 512);                      \
    P##k1 = *(const uint4*)(kgp + (size_t)(kt__ * 64 + 32) * 512);                 \
    P##v0 = *(const uint4*)(vgp + kt__ * 64);                                      \
    P##v1 = *(const uint4*)(vgp + (size_t)32 * SEQL + kt__ * 64);                  \
    if (MLA) P##p = *(const uint4*)(pgp + (size_t)(kt__ * 64) * 32);               \
  }
#define ATT_SWRITE(P, buf_)                                                        \
  {                                                                                \
    bf16_t* dK = sK + (buf_) * 64 * KSTR;                                          \
    bf16_t* dV = sV + (buf_) * 64 * VSTR;                                          \
    *(uint4*)(dK + prow * KSTR + pch * 8) = P##k0;                                 \
    *(uint4*)(dK + (prow + 32) * KSTR + pch * 8) = P##k1;                          \
    uint2* dv0 = (uint2*)(dV + prow * VSTR + pch * 8);                             \
    dv0[0] = make_uint2(P##v0.x, P##v0.y); dv0[1] = make_uint2(P##v0.z, P##v0.w);  \
    uint2* dv1 = (uint2*)(dV + (prow + 32) * VSTR + pch * 8);                      \
    dv1[0] = make_uint2(P##v1.x, P##v1.y); dv1[1] = make_uint2(P##v1.z, P##v1.w);  \
    if (MLA) *(uint4*)(dK + (tid >> 2) * KSTR + 64 + (tid & 3) * 8) = P##p;        \
  }
#define ATT_KT(i_) (MLA ? (i_) : (nt - 1 - (i_)))

  ATT_GLOAD(x, ATT_KT(0));
  ATT_GLOAD(y, ATT_KT(1));
  ATT_SWRITE(x, 0);
  __syncthreads();
  bool alive = true;
  for (int it0 = 0; alive; it0 += 2) {
#pragma unroll
   for (int half = 0; half < 2; ++half) {
    const int it = it0 + half;
    const int kt = ATT_KT(it);
    const int cur = half;
    const bool more = (it + 1 < nt);
    if (it + 2 < nt) { if (half == 0) ATT_GLOAD(x, ATT_KT(it + 2)) else ATT_GLOAD(y, ATT_KT(it + 2)) }
    const bf16_t* cK = sK + cur * 64 * KSTR;
    const bf16_t* cV = sV + cur * 64 * VSTR;
    if (MLA) {
      if (kt * 64 <= qw + 31) {
        f32x16 s0, s1;
        {
          const float sinit = -mrun;
#pragma unroll
          for (int i = 0; i < 16; ++i) { s0[i] = sinit; s1[i] = sinit; }
        }
        __builtin_amdgcn_s_setprio(1);
#pragma unroll
        for (int ks = 0; ks < NKS; ++ks) {
          const bf16x8 k0 = *(const bf16x8*)(cK + r * KSTR + ks * 16 + hh * 8);
          const bf16x8 k1 = *(const bf16x8*)(cK + (32 + r) * KSTR + ks * 16 + hh * 8);
          s0 = MFMA(k0, qf[ks], s0);
          s1 = MFMA(k1, qf[ks], s1);
        }
        __builtin_amdgcn_s_setprio(0);
        if (kt * 64 + 63 > qw) {
          const int lim = qw + r - kt * 64;
#pragma unroll
          for (int i = 0; i < 16; ++i) { if (crow(i, hh) > lim) s0[i] = -1e30f; if (32 + crow(i, hh) > lim) s1[i] = -1e30f; }
        }
        float m0 = fmaxf(fmaxf(s0[0], s0[1]), s0[2]), m1 = fmaxf(fmaxf(s1[0], s1[1]), s1[2]);
#pragma unroll
        for (int i = 3; i < 15; i += 2) { m0 = fmaxf(fmaxf(m0, s0[i]), s0[i + 1]); m1 = fmaxf(fmaxf(m1, s1[i]), s1[i + 1]); }
        float mloc = fmaxf(fmaxf(m0, s0[15]), fmaxf(m1, s1[15]));
        mloc = half_max(mloc);
        const bool first = (it == 0);
        const float delta = first ? mloc : fmaxf(mloc, 0.f);
        if (first || __builtin_amdgcn_ballot_w64(delta > 0.f) != 0ull) {
          const float alpha = first ? 0.f : __builtin_amdgcn_exp2f(-delta);
          mrun += delta;
          lrun *= alpha;
#pragma unroll
          for (int i = 0; i < 16; ++i) { oacc[0][i] *= alpha; oacc[1][i] *= alpha; s0[i] -= delta; s1[i] -= delta; }
        }
        float ps0 = 0.f, ps1 = 0.f;
#pragma unroll
        for (int i = 0; i < 16; ++i) { s0[i] = __builtin_amdgcn_exp2f(s0[i]); s1[i] = __builtin_amdgcn_exp2f(s1[i]); ps0 += s0[i]; ps1 += s1[i]; }
        lrun += ps0 + ps1;
        bf16x8 pf4[4];
        pf4[0] = pack8(s0[0], s0[1], s0[2], s0[3], s0[4], s0[5], s0[6], s0[7]);
        pf4[1] = pack8(s0[8], s0[9], s0[10], s0[11], s0[12], s0[13], s0[14], s0[15]);
        pf4[2] = pack8(s1[0], s1[1], s1[2], s1[3], s1[4], s1[5], s1[6], s1[7]);
        pf4[3] = pack8(s1[8], s1[9], s1[10], s1[11], s1[12], s1[13], s1[14], s1[15]);
        __builtin_amdgcn_s_setprio(1);
#pragma unroll
        for (int st = 0; st < 4; ++st)
#pragma unroll
          for (int dt = 0; dt < 2; ++dt) {
            const bf16_t* vp = cV + (dt * 32 + r) * VSTR + st * 16 + 4 * hh;
            const s16x4 lo = *(const s16x4*)vp;
            const s16x4 hi = *(const s16x4*)(vp + 8);
            const bf16x8 vf = __builtin_shufflevector(lo, hi, 0, 1, 2, 3, 4, 5, 6, 7);
            oacc[dt] = MFMA(vf, pf4[st], oacc[dt]);
          }
        __builtin_amdgcn_s_setprio(0);
      }
    } else
#pragma unroll
    for (int si = 0; si < 2; ++si) {
      const int sub = MLA ? si : (1 - si);
      const int kb = kt * 64 + sub * 32;
      if (kb > qw) continue;
      const bool diag = (kb == qw);
      f32x16 s;
      {
        const float sinit = MLA ? -mrun : 0.f;
#pragma unroll
        for (int i = 0; i < 16; ++i) s[i] = sinit;
      }
      __builtin_amdgcn_s_setprio(1);
#pragma unroll
      for (int ks = 0; ks < NKS; ++ks) {
        const bf16x8 kf = *(const bf16x8*)(cK + (sub * 32 + r) * KSTR + ks * 16 + hh * 8);
        s = MFMA(kf, qf[ks], s);
      }
      __builtin_amdgcn_s_setprio(0);
      bf16x8 pf[2];
      if (!MLA) {
        float sp[16];
        float tsum = 0.f;
#pragma unroll
        for (int i = 0; i < 16; ++i) {
          const float z = s[i];
          float v = __builtin_amdgcn_logf(1.f + __builtin_amdgcn_exp2f(fminf(z, 126.f)));
          if (diag && !(crow(i, hh) < r)) v = 0.f;
          sp[i] = v;
          tsum += v;
        }
        f32x16 cacc;
#pragma unroll
        for (int i = 0; i < 16; ++i) cacc[i] = carry;
        cacc = MFMA(tf[0], pack8(sp[0], sp[1], sp[2], sp[3], sp[4], sp[5], sp[6], sp[7]), cacc);
        cacc = MFMA(tf[1], pack8(sp[8], sp[9], sp[10], sp[11], sp[12], sp[13], sp[14], sp[15]), cacc);
        float pr[16];
#pragma unroll
        for (int i = 0; i < 16; ++i) {
          float v = __builtin_amdgcn_exp2f(s[i] - cacc[i]);
          if (diag && !(crow(i, hh) < r)) v = 0.f;
          pr[i] = v;
        }
        carry += half_sum(tsum);
        pf[0] = pack8(pr[0], pr[1], pr[2], pr[3], pr[4], pr[5], pr[6], pr[7]);
        pf[1] = pack8(pr[8], pr[9], pr[10], pr[11], pr[12], pr[13], pr[14], pr[15]);
      } else {
        if (diag) {
#pragma unroll
          for (int i = 0; i < 16; ++i) if (!(crow(i, hh) <= r)) s[i] = -1e30f;
        }
        float mloc = fmaxf(fmaxf(s[0], s[1]), s[2]);
#pragma unroll
        for (int i = 3; i < 15; i += 2) mloc = fmaxf(fmaxf(mloc, s[i]), s[i + 1]);
        mloc = fmaxf(mloc, s[15]);
        mloc = half_max(mloc);
        const bool first = (it == 0) && (si == 0);
        const float delta = first ? mloc : fmaxf(mloc, 0.f);
        if (first || __builtin_amdgcn_ballot_w64(delta > 0.f) != 0ull) {
          const float alpha = first ? 0.f : __builtin_amdgcn_exp2f(-delta);
          mrun += delta;
          lrun *= alpha;
#pragma unroll
          for (int i = 0; i < 16; ++i) { oacc[0][i] *= alpha; oacc[1][i] *= alpha; s[i] -= delta; }
        }
        float pr[16];
        float ps0 = 0.f, ps1 = 0.f;
#pragma unroll
        for (int i = 0; i < 16; i += 2) { pr[i] = __builtin_amdgcn_exp2f(s[i]); pr[i + 1] = __builtin_amdgcn_exp2f(s[i + 1]); ps0 += pr[i]; ps1 += pr[i + 1]; }
        lrun += ps0 + ps1;
        pf[0] = pack8(pr[0], pr[1], pr[2], pr[3], pr[4], pr[5], pr[6], pr[7]);
        pf[1] = pack8(pr[8], pr[9], pr[10], pr[11], pr[12], pr[13], pr[14], pr[15]);
      }
      __builtin_amdgcn_s_setprio(1);
#pragma unroll
      for (int dt = 0; dt < 2; ++dt)
#pragma unroll
        for (int st = 0; st < 2; ++st) {
          const bf16_t* vp = cV + (dt * 32 + r) * VSTR + sub * 32 + st * 16 + 4 * hh;
          const s16x4 lo = *(const s16x4*)vp;
          const s16x4 hi = *(const s16x4*)(vp + 8);
          const bf16x8 vf = __builtin_shufflevector(lo, hi, 0, 1, 2, 3, 4, 5, 6, 7);
          oacc[dt] = MFMA(vf, pf[st], oacc[dt]);
        }
      __builtin_amdgcn_s_setprio(0);
    }
    if (more) { if (half == 0) ATT_SWRITE(y, 1) else ATT_SWRITE(x, 0) }
    if (!MLA) {
      int* flg = (int*)(smem + SMEM_BYTES - 64) + (it & 1) * 4;
      const bool wok = (__builtin_amdgcn_ballot_w64(carry >= 160.f) == ~0ull);
      if (lane == 0) flg[w] = wok ? 1 : 0;
      __syncthreads();
      alive = more && ((flg[0] & flg[1] & flg[2] & flg[3]) == 0);
    } else {
      __syncthreads();
      alive = more;
    }
    if (!alive) break;
   }
  }
#undef ATT_GLOAD
#undef ATT_SWRITE
#undef ATT_KT
  float inv = 1.f;
  if (MLA) { const float lt = half_sum(lrun); inv = 1.f / lt; }
  const int tok = tok0 + w * 32 + r;
  const bf16_t* zg = (MLA ? p.Zmla() : p.Zsb()) + (size_t)tok * 512 + h * 64;
  bf16_t* og = (MLA ? p.OBg() : p.OAg()) + (size_t)tok * 512 + h * 64;
#pragma unroll
  for (int dt = 0; dt < 2; ++dt)
#pragma unroll
    for (int g = 0; g < 4; ++g) {
      const int d = dt * 32 + 8 * g + 4 * hh;
      const u32x2 zz = *(const u32x2*)(zg + d);
      const float z0 = __uint_as_float(zz[0] << 16), z1 = __uint_as_float(zz[0] & 0xffff0000u);
      const float z2 = __uint_as_float(zz[1] << 16), z3 = __uint_as_float(zz[1] & 0xffff0000u);
      u32x2 o;
      o[0] = pk2(oacc[dt][4 * g] * inv * z0, oacc[dt][4 * g + 1] * inv * z1);
      o[1] = pk2(oacc[dt][4 * g + 2] * inv * z2, oacc[dt][4 * g + 3] * inv * z3);
      *(u32x2*)(og + d) = o;
    }
}

DI void phase_attn(const Params& p, char* smem, int cbase, int only) {
  int* s_item = (int*)(smem + SMEM_BYTES - 16);
  const int q0 = blockIdx.x & 7;
  int qi = 0;
  for (;;) {
    if (threadIdx.x == 0) {
      int item = -1;
      while (qi < 8) {
        const int q = (q0 + qi) & 7;
        const int idx = atomicAdd(p.counter() + cbase + q, 1);
        if (idx < 256) { item = q * 256 + idx; break; }
        ++qi;
      }
      *s_item = item;
    }
    __syncthreads();
    const int item = *s_item;
    __syncthreads();
    if (item < 0) break;
    const int q = item >> 8, idx = item & 255;
    const int i2 = idx & 127;
    const int bh = q + 8 * (i2 & 3);
    const int qb = 31 - (i2 >> 2);
    if (idx < 128) { if (only != 2) attn_item<true>(p, bh >> 3, bh & 7, qb, smem); }
    else { if (only != 1) attn_item<false>(p, bh >> 3, bh & 7, qb, smem); }
  }
}

DI void phase_g3(const Params& p, char* smem) {
  bf16_t* sA = (bf16_t*)smem;
  bf16_t* sB = sA + 2 * GBUF;
  float* sC = (float*)smem;
  float* rs = (float*)(smem + 4 * GBUF * 2);
  const int xq = blockIdx.x & 7, lb = blockIdx.x >> 3, nlb = gridDim.x >> 3;
  const bool xmap = (gridDim.x & 7) == 0;
  for (int t = xmap ? lb : (int)blockIdx.x; t < (xmap ? 128 : 1024); t += (xmap ? nlb : (int)gridDim.x)) {
    const int rt = xmap ? (16 * xq + 8 * (t >> 6) + (t & 7)) : (t >> 3), ct = xmap ? ((t >> 3) & 7) : (t & 7);
    const int m0 = rt * 128, n0 = ct * 128;
    f32x16 acc[2][2];
    zero_acc(acc);
    gemm_mainloop<false>(p.OAg() + (size_t)m0 * 512, 512, p.WaT() + (size_t)n0 * 512, 512, 512, sA, sB, acc, rs);
    acc_to_lds(acc, sC);
    __syncthreads();
    const int txo = opaque_tid();
#pragma unroll
    for (int i = 0; i < 8; ++i) {
      const int c = txo + 256 * i, row = c >> 4, cc = (c & 15) * 8;
      const u32x4 g = *(const u32x4*)(p.GA() + (size_t)(m0 + row) * 1024 + n0 + cc);
      const float4 a = *(const float4*)(sC + row * CSTR + cc), b = *(const float4*)(sC + row * CSTR + cc + 4);
      u32x4 y;
      y[0] = pk2(a.x * __uint_as_float(g[0] << 16), a.y * __uint_as_float(g[0] & 0xffff0000u));
      y[1] = pk2(a.z * __uint_as_float(g[1] << 16), a.w * __uint_as_float(g[1] & 0xffff0000u));
      y[2] = pk2(b.x * __uint_as_float(g[2] << 16), b.y * __uint_as_float(g[2] & 0xffff0000u));
      y[3] = pk2(b.z * __uint_as_float(g[3] << 16), b.w * __uint_as_float(g[3] & 0xffff0000u));
      *(u32x4*)(p.MERGED() + (size_t)(m0 + row) * 1024 + n0 + cc) = y;
    }
    __syncthreads();
    zero_acc(acc);
    gemm_mainloop<false>(p.OBg() + (size_t)m0 * 512, 512, p.WbT() + (size_t)n0 * 512, 512, 512, sA, sB, acc, rs);
    acc_to_lds(acc, sC);
    __syncthreads();
    const int txo2 = opaque_tid();
#pragma unroll
    for (int i = 0; i < 8; ++i) {
      const int c = txo2 + 256 * i, row = c >> 4, cc = (c & 15) * 8;
      const u32x4 g = *(const u32x4*)(p.GB() + (size_t)(m0 + row) * 1024 + n0 + cc);
      const u32x4 yv = *(const u32x4*)(p.MERGED() + (size_t)(m0 + row) * 1024 + n0 + cc);
      const float4 a = *(const float4*)(sC + row * CSTR + cc), b = *(const float4*)(sC + row * CSTR + cc + 4);
      u32x4 o;
      o[0] = pk2(__uint_as_float(yv[0] << 16) + a.x * __uint_as_float(g[0] << 16), __uint_as_float(yv[0] & 0xffff0000u) + a.y * __uint_as_float(g[0] & 0xffff0000u));
      o[1] = pk2(__uint_as_float(yv[1] << 16) + a.z * __uint_as_float(g[1] << 16), __uint_as_float(yv[1] & 0xffff0000u) + a.w * __uint_as_float(g[1] & 0xffff0000u));
      o[2] = pk2(__uint_as_float(yv[2] << 16) + b.x * __uint_as_float(g[2] << 16), __uint_as_float(yv[2] & 0xffff0000u) + b.y * __uint_as_float(g[2] & 0xffff0000u));
      o[3] = pk2(__uint_as_float(yv[3] << 16) + b.z * __uint_as_float(g[3] << 16), __uint_as_float(yv[3] & 0xffff0000u) + b.w * __uint_as_float(g[3] & 0xffff0000u));
      *(u32x4*)(p.MERGED() + (size_t)(m0 + row) * 1024 + n0 + cc) = o;
    }
    __syncthreads();
  }
}

DI void phase_g4(const Params& p, char* smem) {
  bf16_t* sA = (bf16_t*)smem;
  bf16_t* sB = sA + 2 * GBUF;
  float* sC = (float*)smem;
  float* rs = (float*)(smem + 4 * GBUF * 2);
  const int xq = blockIdx.x & 7, lb = blockIdx.x >> 3, nlb = gridDim.x >> 3;
  const bool xmap = (gridDim.x & 7) == 0;
  for (int t = xmap ? lb : (int)blockIdx.x; t < (xmap ? 128 : 1024); t += (xmap ? nlb : (int)gridDim.x)) {
    const int rt = xmap ? (16 * xq + 8 * (t >> 6) + (t & 7)) : (t >> 3), ct = xmap ? ((t >> 3) & 7) : (t & 7);
    const int m0 = rt * 128, n0 = ct * 128;
    f32x16 acc[2][2];
    zero_acc(acc);
    if (threadIdx.x < 128) rs[threadIdx.x] = mod_get(p.MOD(), m0 >> 12, 2048 + n0 + threadIdx.x);
    gemm_mainloop<false>(p.MERGED() + (size_t)m0 * 1024, 1024, p.WoT() + (size_t)n0 * 1024, 1024, 1024, sA, sB, acc, rs);
    acc_to_lds(acc, sC);
    __syncthreads();
    const int txo = opaque_tid();
#pragma unroll
    for (int i = 0; i < 8; ++i) {
      const int c = txo + 256 * i, row = c >> 4, cc = (c & 15) * 8;
      const size_t go = (size_t)(m0 + row) * 1024 + n0 + cc;
      const float4 x0 = *(const float4*)(p.x + go), x1 = *(const float4*)(p.x + go + 4);
      const float4 a = *(const float4*)(sC + row * CSTR + cc), b = *(const float4*)(sC + row * CSTR + cc + 4);
      const float4 g0 = *(const float4*)(rs + cc), g1 = *(const float4*)(rs + cc + 4);
      float4 o0, o1;
      o0.x = x0.x + g0.x * a.x; o0.y = x0.y + g0.y * a.y; o0.z = x0.z + g0.z * a.z; o0.w = x0.w + g0.w * a.w;
      o1.x = x1.x + g1.x * b.x; o1.y = x1.y + g1.y * b.y; o1.z = x1.z + g1.z * b.z; o1.w = x1.w + g1.w * b.w;
      *(float4*)(p.out + go) = o0;
      *(float4*)(p.out + go + 4) = o1;
    }
    __syncthreads();
  }
}

DI void phase_final(const Params& p) {
  const int lane = threadIdx.x & 63, w = threadIdx.x >> 6;
  const int gw = blockIdx.x * 4 + w, nw = gridDim.x * 4;
  for (int row = gw; row < NTOK; row += nw) {
    float* xr = p.out + (size_t)row * DM;
    float4 v[4];
    float ss = 0.f;
#pragma unroll
    for (int i = 0; i < 4; ++i) {
      v[i] = *(const float4*)(xr + 4 * (lane + 64 * i));
      ss += v[i].x * v[i].x + v[i].y * v[i].y + v[i].z * v[i].z + v[i].w * v[i].w;
    }
#pragma unroll
    for (int o = 32; o >= 1; o >>= 1) ss += __shfl_xor(ss, o);
    const float rn = __builtin_amdgcn_rsqf(ss * (1.f / DM) + EPSN);
#pragma unroll
    for (int i = 0; i < 4; ++i) {
      const int e = 4 * (lane + 64 * i);
      const float4 g = *(const float4*)(p.fgain + e);
      float4 o;
      o.x = v[i].x * rn * g.x; o.y = v[i].y * rn * g.y; o.z = v[i].z * rn * g.z; o.w = v[i].w * rn * g.w;
      *(float4*)(xr + e) = o;
    }
  }
}

template <int PH>
__global__ void __launch_bounds__(NTHREADS, 2) mega_kernel(Params p) {
  __shared__ __attribute__((aligned(16))) char smem[SMEM_BYTES];
  if (PH < 0) {
    if (p.ws == nullptr) cg::this_grid().sync();
    volatile LAS unsigned* xst = (volatile LAS unsigned*)(smem + SMEM_BYTES - 32);
    if (threadIdx.x == 0) { xst[0] = 0u; xst[1] = 0u; }
    __syncthreads();
    (void)xcd_barrier_post(p.bar(), xst);
    phase_prep(p, smem); xcd_barrier(p.bar(), (volatile LAS unsigned*)(smem + SMEM_BYTES - 32));
#if PROBE_DUP == 4
    phase_prep(p, smem); xcd_barrier(p.bar(), (volatile LAS unsigned*)(smem + SMEM_BYTES - 32));
#endif
    phase_h(p, smem); xcd_barrier(p.bar(), (volatile LAS unsigned*)(smem + SMEM_BYTES - 32));
#if PROBE_DUP == 5
    phase_h(p, smem); xcd_barrier(p.bar(), (volatile LAS unsigned*)(smem + SMEM_BYTES - 32));
#endif
    phase_g1(p, smem); xcd_barrier(p.bar(), (volatile LAS unsigned*)(smem + SMEM_BYTES - 32));
#if PROBE_DUP == 1
    phase_g1(p, smem, false); xcd_barrier(p.bar(), (volatile LAS unsigned*)(smem + SMEM_BYTES - 32));
#endif
    phase_g2(p, smem); xcd_barrier(p.bar(), (volatile LAS unsigned*)(smem + SMEM_BYTES - 32));
#if PROBE_DUP == 8
    phase_g2(p, smem); xcd_barrier(p.bar(), (volatile LAS unsigned*)(smem + SMEM_BYTES - 32));
#endif
    phase_attn(p, smem, 0, 0); xcd_barrier(p.bar(), (volatile LAS unsigned*)(smem + SMEM_BYTES - 32));
#if PROBE_DUP == 2
    phase_attn(p, smem, 8, 1); xcd_barrier(p.bar(), (volatile LAS unsigned*)(smem + SMEM_BYTES - 32));
#endif
#if PROBE_DUP == 3
    phase_attn(p, smem, 8, 2); xcd_barrier(p.bar(), (volatile LAS unsigned*)(smem + SMEM_BYTES - 32));
#endif
    phase_g3(p, smem); xcd_barrier(p.bar(), (volatile LAS unsigned*)(smem + SMEM_BYTES - 32));
#if PROBE_DUP == 6
    phase_g3(p, smem); xcd_barrier(p.bar(), (volatile LAS unsigned*)(smem + SMEM_BYTES - 32));
#endif
    phase_g4(p, smem); xcd_barrier(p.bar(), (volatile LAS unsigned*)(smem + SMEM_BYTES - 32));
#if PROBE_DUP == 7
    phase_g4(p, smem); xcd_barrier(p.bar(), (volatile LAS unsigned*)(smem + SMEM_BYTES - 32));
#endif
    phase_final(p);
  } else {
    if (PH == 0) phase_prep(p, smem);
    if (PH == 1) phase_h(p, smem);
    if (PH == 2) phase_g1(p, smem);
    if (PH == 3) phase_g2(p, smem);
    if (PH == 4) phase_attn(p, smem, 0, 0);
    if (PH == 5) phase_g3(p, smem);
    if (PH == 6) phase_g4(p, smem);
    if (PH == 7) phase_final(p);
  }
}

#ifndef PROBE_DUP
#define PROBE_DUP 0
#endif
#ifndef MK_SPLIT
#define MK_SPLIT 0
#endif

extern "C" void kernel_launch(void* const* d_in, const int* in_sizes, int n_in, void* d_out, int out_size, void* d_ws, size_t ws_size, hipStream_t stream) {
  Params p{};
  p.x = (const float*)d_in[0]; p.c = (const float*)d_in[1]; p.pos = (const int*)d_in[2];
  p.w_ada = (const float*)d_in[3]; p.b_ada = (const float*)d_in[4]; p.norm_gain = (const float*)d_in[5];
  p.w_in = (const float*)d_in[6]; p.q_gain = (const float*)d_in[7]; p.w_uq = (const float*)d_in[8];
  p.kv_gain = (const float*)d_in[9]; p.w_ukv = (const float*)d_in[10]; p.w_a = (const float*)d_in[11];
  p.w_b = (const float*)d_in[12]; p.w_out = (const float*)d_in[13]; p.fgain = (const float*)d_in[14];
  p.out = (float*)d_out;
  p.ws = (char*)d_ws;
  if (WS_NEED > ws_size) { fprintf(stderr, "workspace too small: need %zu have %zu\n", (size_t)WS_NEED, ws_size); return; }

  static int grid_blocks = 0;
  if (!grid_blocks) {
    int dev = 0, cus = 0, per_cu = 0;
    hipGetDevice(&dev);
    hipDeviceGetAttribute(&cus, hipDeviceAttributeMultiprocessorCount, dev);
    hipOccupancyMaxActiveBlocksPerMultiprocessor(&per_cu, mega_kernel<-1>, NTHREADS, 0);
    if (per_cu > 2) per_cu = 2;
    if (per_cu < 1) per_cu = 1;
    grid_blocks = cus * per_cu;
  }
#if MK_SPLIT
  mega_kernel<0><<<grid_blocks, NTHREADS, 0, stream>>>(p);
  mega_kernel<1><<<grid_blocks, NTHREADS, 0, stream>>>(p);
  mega_kernel<2><<<grid_blocks, NTHREADS, 0, stream>>>(p);
  mega_kernel<3><<<grid_blocks, NTHREADS, 0, stream>>>(p);
  mega_kernel<4><<<grid_blocks, NTHREADS, 0, stream>>>(p);
  mega_kernel<5><<<grid_blocks, NTHREADS, 0, stream>>>(p);
  mega_kernel<6><<<grid_blocks, NTHREADS, 0, stream>>>(p);
  mega_kernel<7><<<grid_blocks, NTHREADS, 0, stream>>>(p);
#else
  hipMemsetAsync((char*)d_ws + OFF_bar, 0, XCD_BAR_WORDS * 4, stream);
  void* args[] = {&p};
  hipError_t e = hipLaunchCooperativeKernel((void*)mega_kernel<-1>, dim3(grid_blocks), dim3(NTHREADS), args, 0, stream);
  if (e != hipSuccess) fprintf(stderr, "cooperative launch failed: %s (grid %d)\n", hipGetErrorString(e), grid_blocks);
#endif
}
```

```cpp
#include <hip/hip_runtime.h>
#include <hip/hip_cooperative_groups.h>
#include <stdint.h>
#include <stdio.h>
namespace cg = cooperative_groups;
#ifndef PROBE_DUP
#define PROBE_DUP 0
#endif

#define DI __device__ __forceinline__
typedef unsigned short bf16_t;
typedef __attribute__((ext_vector_type(8))) short bf16x8;
typedef __attribute__((ext_vector_type(4))) short s16x4;
typedef __attribute__((ext_vector_type(16))) float f32x16;
typedef __attribute__((ext_vector_type(2))) float f32x2;
typedef __attribute__((ext_vector_type(2))) __bf16 bf16x2v;
typedef __attribute__((ext_vector_type(4))) unsigned u32x4;
typedef __attribute__((ext_vector_type(2))) unsigned u32x2;
typedef __attribute__((ext_vector_type(4))) float f32x4;
#define MFMA(a, b, c) __builtin_amdgcn_mfma_f32_32x32x16_bf16((a), (b), (c), 0, 0, 0)

constexpr int NTOK = 16384, SEQL = 4096, DM = 1024;
constexpr int INW = 5280, INWP = 5376;
constexpr int NTHREADS = 512;
constexpr float LOG2E = 1.4426950408889634f;
constexpr float QS_SCALE = 0.125f * 1.4426950408889634f;
constexpr float QM_SCALE = 1.4426950408889634f / 9.797958971132712f;
constexpr float EPSN = 1e-6f;

constexpr int XCD_BAR_WORDS_C = 3456;
constexpr size_t al256(size_t v) { return (v + 255) & ~(size_t)255; }
constexpr size_t OFF_counter = 0;
constexpr size_t OFF_bar = OFF_counter + al256(256);
constexpr size_t OFF_MOD = OFF_bar + al256(XCD_BAR_WORDS_C * 4);
constexpr size_t OFF_ROPE = OFF_MOD + al256(4 * 3072 * 4 * 4);
constexpr size_t OFF_SSQ = OFF_ROPE + al256((size_t)NTOK * 32 * 4);
constexpr size_t OFF_Hb = OFF_SSQ + al256((size_t)2 * NTOK * 4);
constexpr size_t OFF_Qmla = OFF_Hb + al256((size_t)NTOK * 1024 * 2);
constexpr size_t OFF_WuqT = OFF_Qmla + al256((size_t)NTOK * 768 * 2);
constexpr size_t OFF_WukvT = OFF_WuqT + al256((size_t)768 * 384 * 2);
constexpr size_t OFF_WaT = OFF_WukvT + al256((size_t)1024 * 256 * 2);
constexpr size_t OFF_WbT = OFF_WaT + al256((size_t)1024 * 512 * 2);
constexpr size_t OFF_WoT = OFF_WbT + al256((size_t)1024 * 512 * 2);
constexpr size_t OFF_Qsb = OFF_WoT + al256((size_t)1024 * 1024 * 2);
constexpr size_t OFF_Ksb = OFF_Qsb + al256((size_t)NTOK * 512 * 2);
constexpr size_t OFF_VTsb = OFF_Ksb + al256((size_t)NTOK * 512 * 2);
constexpr size_t OFF_Zsb = OFF_VTsb + al256((size_t)NTOK * 512 * 2);
constexpr size_t OFF_OAg = OFF_Zsb + al256((size_t)NTOK * 512 * 2);
constexpr size_t OFF_OBg = OFF_OAg + al256((size_t)NTOK * 512 * 2);
constexpr size_t OFF_Zmla = OFF_OBg + al256((size_t)NTOK * 512 * 2);
constexpr size_t OFF_KPE = OFF_Zmla + al256((size_t)NTOK * 512 * 2);
constexpr size_t OFF_Knope = OFF_KPE + al256((size_t)NTOK * 32 * 2);
constexpr size_t OFF_VTmla = OFF_Knope + al256((size_t)NTOK * 512 * 2);
constexpr size_t WS_NEED = OFF_VTmla + al256((size_t)NTOK * 512 * 2);
struct Params {
  const float *x, *c; const int* pos;
  const float *w_ada, *b_ada, *norm_gain, *w_in, *q_gain, *w_uq, *kv_gain, *w_ukv, *w_a, *w_b, *w_out, *fgain;
  float* out;
  char* ws;
  DI int* counter() const { return (int*)(ws + OFF_counter); }
  DI unsigned* bar() const { return (unsigned*)(ws + OFF_bar); }
  DI float* MOD() const { return (float*)(ws + OFF_MOD); }
  DI float* ROPE() const { return (float*)(ws + OFF_ROPE); }
  DI float* SSQ() const { return (float*)(ws + OFF_SSQ); }
  DI bf16_t* Hb() const { return (bf16_t*)(ws + OFF_Hb); }
  DI bf16_t* Qmla() const { return (bf16_t*)(ws + OFF_Qmla); }
  DI bf16_t* WuqT() const { return (bf16_t*)(ws + OFF_WuqT); }
  DI bf16_t* WukvT() const { return (bf16_t*)(ws + OFF_WukvT); }
  DI bf16_t* WaT() const { return (bf16_t*)(ws + OFF_WaT); }
  DI bf16_t* WbT() const { return (bf16_t*)(ws + OFF_WbT); }
  DI bf16_t* WoT() const { return (bf16_t*)(ws + OFF_WoT); }
  DI bf16_t* Qsb() const { return (bf16_t*)(ws + OFF_Qsb); }
  DI bf16_t* Ksb() const { return (bf16_t*)(ws + OFF_Ksb); }
  DI bf16_t* VTsb() const { return (bf16_t*)(ws + OFF_VTsb); }
  DI bf16_t* Zsb() const { return (bf16_t*)(ws + OFF_Zsb); }
  DI bf16_t* OAg() const { return (bf16_t*)(ws + OFF_OAg); }
  DI bf16_t* OBg() const { return (bf16_t*)(ws + OFF_OBg); }
  DI bf16_t* Zmla() const { return (bf16_t*)(ws + OFF_Zmla); }
  DI bf16_t* KPE() const { return (bf16_t*)(ws + OFF_KPE); }
  DI bf16_t* Knope() const { return (bf16_t*)(ws + OFF_Knope); }
  DI bf16_t* VTmla() const { return (bf16_t*)(ws + OFF_VTmla); }
  DI bf16_t* MERGED() const { return Hb(); }
  DI bf16_t* WinT() const { return Qmla(); }
  DI bf16_t* CQ() const { return OAg(); }
  DI bf16_t* CKV() const { return OBg(); }
  DI bf16_t* GA() const { return (bf16_t*)out; }
  DI bf16_t* GB() const { return (bf16_t*)out + (size_t)NTOK * 1024; }
};


__device__ const float c_invfreq[16] = {
  1.0f, 0.5623413251903491f, 0.31622776601683794f, 0.1778279410038923f, 0.1f, 0.05623413251903491f, 0.03162277660168379f,
  0.01778279410038923f, 0.01f, 0.005623413251903491f, 0.0031622776601683794f, 0.001778279410038923f, 0.001f,
  0.0005623413251903491f, 0.00031622776601683794f, 0.0001778279410038923f};

DI unsigned pk2(float a, float b) { f32x2 v = {a, b}; bf16x2v r = __builtin_convertvector(v, bf16x2v); return __builtin_bit_cast(unsigned, r); }
DI bf16_t tobf(float a) { return (bf16_t)(pk2(a, 0.f) & 0xffffu); }
DI float bf2f(unsigned short u) { return __uint_as_float(((unsigned)u) << 16); }
DI bf16x8 pack8(float a0, float a1, float a2, float a3, float a4, float a5, float a6, float a7) {
  u32x4 p; p[0] = pk2(a0, a1); p[1] = pk2(a2, a3); p[2] = pk2(a4, a5); p[3] = pk2(a6, a7);
  return __builtin_bit_cast(bf16x8, p);
}
DI int crow(int reg, int h) { return (reg & 3) + 8 * (reg >> 2) + 4 * h; }
DI int opaque_tid() { int t = threadIdx.x; asm volatile("" : "+v"(t)); return t; }
DI float half_max(float v) {
  unsigned u = __float_as_uint(v);
  auto r = __builtin_amdgcn_permlane32_swap(u, u, false, false);
  return fmaxf(__uint_as_float(r[0]), __uint_as_float(r[1]));
}
DI float half_sum(float v) {
  unsigned u = __float_as_uint(v);
  auto r = __builtin_amdgcn_permlane32_swap(u, u, false, false);
  return __uint_as_float(r[0]) + __uint_as_float(r[1]);
}
DI float sigmoidf_fast(float v) { return __builtin_amdgcn_rcpf(1.f + __builtin_amdgcn_exp2f(-v * LOG2E)); }
DI float siluf_fast(float v) { return v * sigmoidf_fast(v); }

#define XB_TMO      128
#define XB_XCNT(j)  (256  + 64 * (j))
#define XB_XSUB(j)  (1280 + 64 * (j))
#define XB_XGEN(j)  (2304 + 64 * (j))
#define XB_TOP      3328
#define XB_TOPGEN   3392
#define XCD_BAR_WORDS 3456
#define XB_SPIN_CAP (1u << 18)
#define LAS __attribute__((address_space(3)))
DI unsigned xb_ld(unsigned* p)              { return __hip_atomic_load(p, __ATOMIC_RELAXED, __HIP_MEMORY_SCOPE_AGENT); }
DI unsigned xb_add(unsigned* p, unsigned v) { return __hip_atomic_fetch_add(p, v, __ATOMIC_RELAXED, __HIP_MEMORY_SCOPE_AGENT); }
DI unsigned xb_xcc_id() { return (unsigned)__builtin_amdgcn_s_getreg((3 << 11) | 20) & 0xFu; }
#define XB_SPIN(cond, bar) do { unsigned _sp = 0; while (cond) { __builtin_amdgcn_s_sleep(1); \
    if ((++_sp & 255u) == 0u) { if (xb_ld(&(bar)[XB_TMO])) break; if (_sp > XB_SPIN_CAP) { atomicAdd(&(bar)[XB_TMO], 1u); break; } } } } while (0)
struct XcdBarrier { unsigned* bar; unsigned x; volatile LAS unsigned* st; };
DI XcdBarrier xcd_barrier_post(unsigned* bar, volatile LAS unsigned* st) {
  XcdBarrier b; b.bar = bar; b.x = xb_xcc_id(); b.st = st;
  if (threadIdx.x == 0) (void)xb_add(&bar[XB_XCNT(b.x)], 1u);
  return b;
}
DI void xcd_barrier_complete(unsigned* bar, unsigned x, unsigned& nloc, unsigned& nx) {
  const unsigned G = gridDim.x * gridDim.y * gridDim.z;
  unsigned sum, cnt, mine, sp = 0u;
  for (;;) {
    sum = 0u; cnt = 0u; mine = 0u;
#pragma unroll
    for (unsigned j = 0; j < 16; ++j) { const unsigned c = xb_ld(&bar[XB_XCNT(j)]); sum += c; cnt += (c > 0u) ? 1u : 0u; mine = (j == x) ? c : mine; }
    if (sum == G) break;
    __builtin_amdgcn_s_sleep(1);
    if ((++sp & 255u) == 0u) { if (xb_ld(&bar[XB_TMO])) break; if (sp > XB_SPIN_CAP) { atomicAdd(&bar[XB_TMO], 1u); break; } }
  }
  nloc = mine > 0u ? mine : 1u; nx = cnt > 0u ? cnt : 1u;
}
DI void xcd_barrier(unsigned* bar_, volatile LAS unsigned* st_) {
  XcdBarrier b; b.bar = bar_; b.st = st_; b.x = 0;
  asm volatile("s_waitcnt vmcnt(0)" ::: "memory");
  __syncthreads();
  if (threadIdx.x == 0) {
    unsigned* bar = b.bar;
    b.x = xb_xcc_id();
    __builtin_amdgcn_s_waitcnt(0);
    unsigned nloc = b.st[0], nx = b.st[1];
    if (nloc == 0u) { xcd_barrier_complete(bar, b.x, nloc, nx); b.st[0] = nloc; b.st[1] = nx; }
    const unsigned old = xb_add(&bar[XB_XSUB(b.x)], 1u);
    const unsigned gen = old / nloc;
    if (old + 1u == (gen + 1u) * nloc) {
      __builtin_amdgcn_fence(__ATOMIC_RELEASE, "agent");
      asm volatile("s_waitcnt vmcnt(0)" ::: "memory");
      const unsigned og = xb_add(&bar[XB_TOP], 1u);
      const unsigned tg = og / nx;
      if (og + 1u == (tg + 1u) * nx) xb_add(&bar[XB_TOPGEN], 1u);
      else XB_SPIN(xb_ld(&bar[XB_TOPGEN]) == tg, bar);
      __builtin_amdgcn_fence(__ATOMIC_ACQUIRE, "agent");
      xb_add(&bar[XB_XGEN(b.x)], 1u);
      asm volatile("s_waitcnt vmcnt(0)" ::: "memory");
    } else {
      XB_SPIN(xb_ld(&bar[XB_XGEN(b.x)]) == gen, bar);
      __builtin_amdgcn_fence(__ATOMIC_ACQUIRE, "agent");
      asm volatile("s_waitcnt vmcnt(0)" ::: "memory");
    }
  }
  __syncthreads();
}

constexpr int GSTR = 72;
constexpr int GBUF = 128 * GSTR;
constexpr int SMEM_BYTES = 131072 + 4096;

constexpr int G8_HT = 128 * 64;
DI int lds_byte(int r, int c) { const int st = (r >> 4) * 2 + (c >> 5), rr = r & 15, cc = c & 31, ob = rr * 64 + cc * 2; return st * 1024 + (ob ^ (((ob >> 9) & 1) << 5)); }
DI void stage_rc(int b, int& R, int& C) { const int st = b / 1024, sb = b % 1024, swz = sb ^ (((sb >> 9) & 1) << 5); R = (st >> 1) * 16 + swz / 64; C = (st & 1) * 32 + (swz % 64) / 2; }

DI void gemm8_tile(const bf16_t* __restrict__ A, const bf16_t* __restrict__ Bt, const int K, bf16_t* shm, f32x4 (&acc)[2][2][4][2]) {
  const int tid = opaque_tid();
  const int wid = tid >> 6, lane = tid & 63, wr = wid >> 2, wc = wid & 3, fr = lane & 15, fq = lane >> 4;
  const int swz = (fr * 64 + fq * 16) ^ ((fr >> 3) << 5);
  const char* aRd = (const char*)shm + swz + wr * 8192;
  const char* bRd = (const char*)shm + 65536 + swz + wc * 4096;
  int sr0, sc0, sr1, sc1;
  stage_rc(tid * 16, sr0, sc0);
  stage_rc(tid * 16 + 8192, sr1, sc1);
  const unsigned so0 = (unsigned)(sr0 * K + sc0) * 2u, so1 = (unsigned)(sr1 * K + sc1) * 2u;
  char* const stw = (char*)shm + __builtin_amdgcn_readfirstlane(tid & ~63) * 16;
  const char* const Ab = (const char*)A;
  const char* const Bb = (const char*)Bt;
#define SA(b, h) (((b) * 2 + (h)) * 16384)
#define SB(b, h) ((4 + (b) * 2 + (h)) * 16384)
#define STAGE(P, BASE, br, kt) do { const char* g_ = (BASE) + ((long)(br) * K + (long)(kt) * 64) * 2;                        \
    __builtin_amdgcn_global_load_lds((const unsigned*)(g_ + so0), (unsigned*)(stw + (P)), 16, 0, 0);                          \
    __builtin_amdgcn_global_load_lds((const unsigned*)(g_ + so1), (unsigned*)(stw + (P) + 8192), 16, 0, 0); } while (0)
#define LDA(dst, b, h) _Pragma("unroll") for (int m = 0; m < 4; ++m) _Pragma("unroll") for (int k = 0; k < 2; ++k) \
    dst[m][k] = *reinterpret_cast<const bf16x8*>(aRd + ((b) * 2 + (h)) * 16384 + (m * 2 + k) * 1024)
#define LDB(dst, b, h) _Pragma("unroll") for (int n = 0; n < 2; ++n) _Pragma("unroll") for (int k = 0; k < 2; ++k) \
    dst[n][k] = *reinterpret_cast<const bf16x8*>(bRd + ((b) * 2 + (h)) * 16384 + (n * 2 + k) * 1024)
#define MMA(ai, bj, At_, Bt_) do { __builtin_amdgcn_s_setprio(1);                                                          \
    _Pragma("unroll") for (int m = 0; m < 4; ++m) _Pragma("unroll") for (int n = 0; n < 2; ++n) _Pragma("unroll") for (int k = 0; k < 2; ++k) \
      acc[ai][bj][m][n] = __builtin_amdgcn_mfma_f32_16x16x32_bf16(At_[m][k], Bt_[n][k], acc[ai][bj][m][n], 0, 0, 0);       \
    __builtin_amdgcn_s_setprio(0); } while (0)
#define WAIT_V(n) asm volatile("s_waitcnt vmcnt(" #n ")" ::: "memory")
#define WAIT_L(n) asm volatile("s_waitcnt lgkmcnt(" #n ")" ::: "memory")
#define BAR __builtin_amdgcn_s_barrier()
#define SCHED __builtin_amdgcn_sched_barrier(0)
  bf16x8 At[4][2], B0[2][2], B1[2][2];
  const int nt = K / 64;
  WAIT_V(0);
  STAGE(SB(0, 0), Bb, 0, 0); STAGE(SA(0, 0), Ab, 0, 0);
  STAGE(SB(0, 1), Bb, 128, 0); STAGE(SA(0, 1), Ab, 128, 0);
  if (wr == 1) BAR;
  WAIT_V(4); BAR;
  STAGE(SB(1, 0), Bb, 0, 1); STAGE(SA(1, 0), Ab, 0, 1); STAGE(SB(1, 1), Bb, 128, 1);
  WAIT_V(6); BAR;
  for (int t = 0; t < nt - 2; t += 2) {
    LDB(B0, 0, 0); SCHED; LDA(At, 0, 0); STAGE(SA(1, 1), Ab, 128, t + 1);
    WAIT_L(8); BAR; WAIT_L(0); MMA(0, 0, At, B0); BAR; SCHED;
    LDB(B1, 0, 1); STAGE(SB(0, 0), Bb, 0, t + 2);
    BAR; WAIT_L(0); MMA(0, 1, At, B1); BAR;
    LDA(At, 0, 1); STAGE(SA(0, 0), Ab, 0, t + 2);
    BAR; WAIT_L(0); MMA(1, 0, At, B0); BAR; SCHED;
    STAGE(SB(0, 1), Bb, 128, t + 2);
    WAIT_V(6); BAR; MMA(1, 1, At, B1); BAR;
    LDB(B0, 1, 0); SCHED; LDA(At, 1, 0); STAGE(SA(0, 1), Ab, 128, t + 2);
    WAIT_L(8); BAR; WAIT_L(0); MMA(0, 0, At, B0); BAR; SCHED;
    LDB(B1, 1, 1); STAGE(SB(1, 0), Bb, 0, t + 3);
    BAR; WAIT_L(0); MMA(0, 1, At, B1); BAR;
    LDA(At, 1, 1); STAGE(SA(1, 0), Ab, 0, t + 3);
    BAR; WAIT_L(0); MMA(1, 0, At, B0); BAR; SCHED;
    STAGE(SB(1, 1), Bb, 128, t + 3);
    WAIT_V(6); BAR; MMA(1, 1, At, B1); BAR;
  }
  { LDB(B0, 0, 0); LDA(At, 0, 0); STAGE(SA(1, 1), Ab, 128, nt - 1);
    BAR; WAIT_L(0); MMA(0, 0, At, B0); BAR;
    LDB(B1, 0, 1); BAR; WAIT_L(0); MMA(0, 1, At, B1); BAR;
    LDA(At, 0, 1); WAIT_V(4); BAR; WAIT_L(0); MMA(1, 0, At, B0); MMA(1, 1, At, B1); BAR; }
  { LDB(B0, 1, 0); LDA(At, 1, 0); WAIT_V(2); BAR; WAIT_L(0); MMA(0, 0, At, B0); BAR;
    LDB(B1, 1, 1); WAIT_V(0); BAR; WAIT_L(0); MMA(0, 1, At, B1); BAR;
    LDA(At, 1, 1); BAR; WAIT_L(0); MMA(1, 0, At, B0); MMA(1, 1, At, B1); BAR; }
  if (wr == 0) BAR;
#undef SA
#undef SB
#undef STAGE
#undef LDA
#undef LDB
#undef MMA
#undef WAIT_V
#undef WAIT_L
#undef BAR
#undef SCHED
}


DI void zero_acc8(f32x4 (&acc)[2][2][4][2]) {
#pragma unroll
  for (int a = 0; a < 2; ++a)
#pragma unroll
    for (int b = 0; b < 2; ++b)
#pragma unroll
      for (int m = 0; m < 4; ++m)
#pragma unroll
        for (int n = 0; n < 2; ++n) acc[a][b][m][n] = f32x4{0.f, 0.f, 0.f, 0.f};
}

constexpr int CSTR = 132;
DI void accq_to_lds(const f32x4 (&q)[4][2], float* sC) {
  const int tid = opaque_tid(), wid = tid >> 6, lane = tid & 63, wr = wid >> 2, wc = wid & 3, fr = lane & 15, fq = lane >> 4;
#pragma unroll
  for (int m = 0; m < 4; ++m)
#pragma unroll
    for (int n = 0; n < 2; ++n)
#pragma unroll
      for (int j = 0; j < 4; ++j) sC[(wr * 64 + m * 16 + fq * 4 + j) * CSTR + wc * 32 + n * 16 + fr] = q[m][n][j];
}
template <class F>
DI void epi_rows(const float* sC, F f) {
  const int tx = opaque_tid();
#pragma unroll
  for (int i = 0; i < 4; ++i) {
    const int c = tx + 512 * i, row = c >> 4, cc = (c & 15) * 8;
    const float4 a = *(const float4*)(sC + row * CSTR + cc), b = *(const float4*)(sC + row * CSTR + cc + 4);
    const float v[8] = {a.x, a.y, a.z, a.w, b.x, b.y, b.z, b.w};
    f(i, row, cc, v);
  }
}
DI void store8(bf16_t* p, const float (&v)[8]) { *(bf16x8*)p = pack8(v[0], v[1], v[2], v[3], v[4], v[5], v[6], v[7]); }
DI void epi_vt(const float* sC, bf16_t* VT, int m0, int head0, int c0, int ncol_log2) {
  const int b = m0 >> 12, s0 = m0 & 4095;
  const int nitems = 16 << ncol_log2;
  for (int c = opaque_tid(); c < nitems; c += 512) {
    const int col = c & ((1 << ncol_log2) - 1), rc = c >> ncol_log2;
    float v[8];
#pragma unroll
    for (int j = 0; j < 8; ++j) v[j] = sC[(rc * 8 + j) * CSTR + c0 + col];
    const int head = head0 + (col >> 6), d = col & 63;
    store8(VT + ((size_t)((b * 8 + head) * 64 + d)) * SEQL + s0 + rc * 8, v);
  }
}
DI void rope8(const float* sC, const float* ROPE, int tok, int row, int cc, float (&v)[8]) {
  const float* pr = sC + row * CSTR + (cc ^ 16);
  const bool upper = (cc & 16) != 0;
  const int f0 = cc & 15;
  const float* tb = ROPE + (size_t)tok * 32;
#pragma unroll
  for (int j = 0; j < 8; ++j) {
    const float o = pr[j], cs = tb[f0 + j], sn = tb[16 + f0 + j];
    v[j] = upper ? (o * sn + v[j] * cs) : (v[j] * cs - o * sn);
  }
}

DI void wconv_unit(const float* __restrict__ src, int Nsrc, int K, bf16_t* __restrict__ dst, const float* __restrict__ gain, int ng, int kg, int mode, float* tile, const int tid) {
  {
    const int k = tid >> 2, cq = tid & 3;
    const int n = ng * 64 + cq * 16;
    int sc = n;
    if (mode == 1) { sc = (n < 2688) ? n : (n < 5248 ? n + 32 : (n < 5280 ? n - 2560 : -1)); }
    const int kk = kg * 64 + k;
    float4 v[4];
    if (sc >= 0) {
      const float* sp = src + (size_t)kk * Nsrc + sc;
#pragma unroll
      for (int i = 0; i < 4; ++i) v[i] = *(const float4*)(sp + 4 * i);
      if (gain) { const float g = gain[kk];
#pragma unroll
        for (int i = 0; i < 4; ++i) { v[i].x *= g; v[i].y *= g; v[i].z *= g; v[i].w *= g; } }
    } else {
#pragma unroll
      for (int i = 0; i < 4; ++i) v[i] = make_float4(0.f, 0.f, 0.f, 0.f);
    }
    float* tp = tile + k * 65 + cq * 16;
#pragma unroll
    for (int i = 0; i < 4; ++i) { tp[4 * i] = v[i].x; tp[4 * i + 1] = v[i].y; tp[4 * i + 2] = v[i].z; tp[4 * i + 3] = v[i].w; }
  }
  __syncthreads();
  {
    const int n = tid >> 2, kc = tid & 3;
    float o[16];
#pragma unroll
    for (int j = 0; j < 16; ++j) o[j] = tile[(kc * 16 + j) * 65 + n];
    bf16_t* dp = dst + (size_t)(ng * 64 + n) * K + kg * 64 + kc * 16;
    *(bf16x8*)dp = pack8(o[0], o[1], o[2], o[3], o[4], o[5], o[6], o[7]);
    *(bf16x8*)(dp + 8) = pack8(o[8], o[9], o[10], o[11], o[12], o[13], o[14], o[15]);
  }
  __syncthreads();
}

DI void phase_prep(const Params& p, char* smem) {
  if (blockIdx.x == 0 && threadIdx.x < 16) { p.counter()[threadIdx.x] = 0; }
  for (int i = blockIdx.x * NTHREADS + threadIdx.x; i < 2 * NTOK; i += gridDim.x * NTHREADS) p.SSQ()[i] = 0.f;
  const int half = threadIdx.x >> 8, tid = threadIdx.x & 255;
  constexpr int U_MOD = 96 * 4, U_WIN = 84 * 16, U_WUQ = 12 * 6, U_WUKV = 16 * 4, U_WA = 16 * 8, U_WB = 16 * 8, U_WO = 16 * 16, U_ROPE = 1024;
  constexpr int U_TOTAL = U_MOD + U_ROPE + U_WIN + U_WUQ + U_WUKV + U_WA + U_WB + U_WO;
  float* tile = (float*)smem + half * (64 * 65 + 64);
  for (int up = blockIdx.x; up < U_TOTAL / 2; up += gridDim.x) {
    int v = 2 * up + half;
    if (v < U_MOD) {
      const int cg32 = v >> 2, kq = v & 3, n0 = cg32 * 32;
      const int kgp = tid >> 5, col = tid & 31;
      const int kb = kq * 256 + kgp * 32;
      float a0 = 0.f, a1 = 0.f, a2 = 0.f, a3 = 0.f;
      const float* wp = p.w_ada + (size_t)kb * 3072 + n0 + col;
      float wv[32];
#pragma unroll
      for (int kk = 0; kk < 32; ++kk) wv[kk] = wp[(size_t)kk * 3072];
#pragma unroll
      for (int kk = 0; kk < 32; ++kk) {
        a0 += wv[kk] * p.c[kb + kk]; a1 += wv[kk] * p.c[1024 + kb + kk]; a2 += wv[kk] * p.c[2048 + kb + kk]; a3 += wv[kk] * p.c[3072 + kb + kk];
      }
      float* red = (float*)smem + half * 1024;
      red[(kgp * 4 + 0) * 32 + col] = a0; red[(kgp * 4 + 1) * 32 + col] = a1; red[(kgp * 4 + 2) * 32 + col] = a2; red[(kgp * 4 + 3) * 32 + col] = a3;
      __syncthreads();
      if (tid < 128) {
        const int b = tid >> 5, cc = tid & 31;
        float s = (kq == 0) ? p.b_ada[n0 + cc] : 0.f;
#pragma unroll
        for (int g = 0; g < 8; ++g) s += red[(g * 4 + b) * 32 + cc];
        p.MOD()[(size_t)(b * 3072 + n0 + cc) * 4 + kq] = s;
      }
      __syncthreads();
      continue;
    }
    v -= U_MOD;
    if (v < U_WIN) { wconv_unit(p.w_in, INW, 1024, p.WinT(), nullptr, v >> 4, v & 15, 1, tile, tid); continue; }
    v -= U_WIN;
    if (v < U_WUQ) { wconv_unit(p.w_uq, 768, 384, p.WuqT(), p.q_gain, v / 6, v % 6, 0, tile, tid); continue; }
    v -= U_WUQ;
    if (v < U_WUKV) { wconv_unit(p.w_ukv, 1024, 256, p.WukvT(), p.kv_gain, v >> 2, v & 3, 0, tile, tid); continue; }
    v -= U_WUKV;
    if (v < U_WA) { wconv_unit(p.w_a, 1024, 512, p.WaT(), nullptr, v >> 3, v & 7, 0, tile, tid); continue; }
    v -= U_WA;
    if (v < U_WB) { wconv_unit(p.w_b, 1024, 512, p.WbT(), nullptr, v >> 3, v & 7, 0, tile, tid); continue; }
    v -= U_WB;
    if (v < U_WO) { wconv_unit(p.w_out, 1024, 1024, p.WoT(), nullptr, v >> 4, v & 15, 0, tile, tid); continue; }
    v -= U_WO;
    {
      const int idx = v * 256 + tid, tok = idx >> 4, i = idx & 15;
      const float ang = (float)p.pos[tok] * c_invfreq[i];
      double t = (double)ang * 0.15915494309189535;
      t -= rint(t);
      const float tf = (float)t;
      p.ROPE()[(size_t)tok * 32 + i] = __builtin_amdgcn_cosf(tf);
      p.ROPE()[(size_t)tok * 32 + 16 + i] = __builtin_amdgcn_sinf(tf);
    }
  }
}

DI float mod_get(const float* MOD, int b, int n) { const float4 q = *(const float4*)(MOD + (size_t)(b * 3072 + n) * 4); return (q.x + q.y) + (q.z + q.w); }

DI void phase_h(const Params& p, char* smem) {
  const int tid = opaque_tid(), lane = tid & 63, w = tid >> 6;
  float* gs = (float*)smem;
  float* sh = gs + 1024;
  const int xq = blockIdx.x & 7, lb = blockIdx.x >> 3, nlb = gridDim.x >> 3;
  const bool xmap = (gridDim.x & 7) == 0;
  for (int rgi = xmap ? lb : (int)blockIdx.x; rgi < (xmap ? 32 : NTOK / 64); rgi += (xmap ? nlb : (int)gridDim.x)) {
    const int rg = xmap ? (32 * xq + rgi) : rgi;
    const int b = (rg * 64) >> 12;
    __syncthreads();
#pragma unroll
    for (int i = 0; i < 2; ++i) {
      const int k = tid + 512 * i;
      gs[k] = p.norm_gain[k] * (1.f + mod_get(p.MOD(), b, 1024 + k));
      sh[k] = mod_get(p.MOD(), b, k);
    }
    __syncthreads();
#pragma unroll 2
    for (int rr = 0; rr < 8; ++rr) {
      const int row = rg * 64 + w * 8 + rr;
      const float* xr = p.x + (size_t)row * DM;
      float4 v[4];
      float ss = 0.f;
#pragma unroll
      for (int i = 0; i < 2; ++i) {
        const int e = 8 * (lane + 64 * i);
        v[2 * i] = *(const float4*)(xr + e);
        v[2 * i + 1] = *(const float4*)(xr + e + 4);
        ss += v[2 * i].x * v[2 * i].x + v[2 * i].y * v[2 * i].y + v[2 * i].z * v[2 * i].z + v[2 * i].w * v[2 * i].w;
        ss += v[2 * i + 1].x * v[2 * i + 1].x + v[2 * i + 1].y * v[2 * i + 1].y + v[2 * i + 1].z * v[2 * i + 1].z + v[2 * i + 1].w * v[2 * i + 1].w;
      }
#pragma unroll
      for (int o = 32; o >= 1; o >>= 1) ss += __shfl_xor(ss, o);
      const float rn = __builtin_amdgcn_rsqf(ss * (1.f / DM) + EPSN);
#pragma unroll
      for (int i = 0; i < 2; ++i) {
        const int e = 8 * (lane + 64 * i);
        const float4 g0 = *(const float4*)(gs + e), g1 = *(const float4*)(gs + e + 4);
        const float4 s0 = *(const float4*)(sh + e), s1 = *(const float4*)(sh + e + 4);
        *(bf16x8*)(p.Hb() + (size_t)row * DM + e) =
            pack8(v[2 * i].x * rn * g0.x + s0.x, v[2 * i].y * rn * g0.y + s0.y, v[2 * i].z * rn * g0.z + s0.z, v[2 * i].w * rn * g0.w + s0.w,
                  v[2 * i + 1].x * rn * g1.x + s1.x, v[2 * i + 1].y * rn * g1.y + s1.y, v[2 * i + 1].z * rn * g1.z + s1.z, v[2 * i + 1].w * rn * g1.w + s1.w);
      }
    }
  }
  __syncthreads();
}

DI void g1_epi(const Params& p, const float* sC, const int m0, const int n0, const int ct, const bool do_ssq) {
    if (ct < 4) {
      epi_rows(sC, [&](int, int row, int cc, const float (&v)[8]) {
        float o[8];
#pragma unroll
        for (int j = 0; j < 8; ++j) o[j] = v[j] * QS_SCALE;
        store8(p.Qsb() + (size_t)(m0 + row) * 512 + n0 + cc, o); });
    } else if (ct < 8) {
      epi_rows(sC, [&](int, int row, int cc, const float (&v)[8]) { store8(p.Ksb() + (size_t)(m0 + row) * 512 + n0 - 512 + cc, v); });
    } else if (ct < 12) {
      epi_vt(sC, p.VTsb(), m0, (n0 - 1024) >> 6, 0, 7);
    } else if (ct < 16) {
      epi_rows(sC, [&](int, int row, int cc, const float (&v)[8]) {
        float o[8];
#pragma unroll
        for (int j = 0; j < 8; ++j) o[j] = siluf_fast(v[j]);
        store8(p.Zsb() + (size_t)(m0 + row) * 512 + n0 - 1536 + cc, o); });
    } else if (ct < 19) {
      epi_rows(sC, [&](int, int row, int cc, const float (&v)[8]) {
        store8(p.CQ() + (size_t)(m0 + row) * 384 + n0 - 2048 + cc, v);
        float q = 0.f;
#pragma unroll
        for (int j = 0; j < 8; ++j) q += v[j] * v[j];
        q += __shfl_xor(q, 1); q += __shfl_xor(q, 2); q += __shfl_xor(q, 4); q += __shfl_xor(q, 8);
        if (do_ssq && (threadIdx.x & 15) == 0) atomicAdd(p.SSQ() + m0 + row, q); });
    } else if (ct < 21) {
      epi_rows(sC, [&](int, int row, int cc, const float (&v)[8]) {
        store8(p.CKV() + (size_t)(m0 + row) * 256 + n0 - 2432 + cc, v);
        float q = 0.f;
#pragma unroll
        for (int j = 0; j < 8; ++j) q += v[j] * v[j];
        q += __shfl_xor(q, 1); q += __shfl_xor(q, 2); q += __shfl_xor(q, 4); q += __shfl_xor(q, 8);
        if (do_ssq && (threadIdx.x & 15) == 0) atomicAdd(p.SSQ() + NTOK + m0 + row, q); });
    } else if (ct < 25) {
      epi_rows(sC, [&](int, int row, int cc, const float (&v)[8]) {
        float o[8];
#pragma unroll
        for (int j = 0; j < 8; ++j) o[j] = siluf_fast(v[j]);
        store8(p.Zmla() + (size_t)(m0 + row) * 512 + n0 - 2688 + cc, o); });
    } else if (ct < 33) {
      epi_rows(sC, [&](int, int row, int cc, const float (&v)[8]) {
        float o[8];
#pragma unroll
        for (int j = 0; j < 8; ++j) o[j] = sigmoidf_fast(v[j]);
        store8(p.GA() + (size_t)(m0 + row) * 1024 + n0 - 3200 + cc, o); });
    } else if (ct < 41) {
      epi_rows(sC, [&](int, int row, int cc, const float (&v)[8]) {
        float o[8];
#pragma unroll
        for (int j = 0; j < 8; ++j) o[j] = sigmoidf_fast(v[j]);
        store8(p.GB() + (size_t)(m0 + row) * 1024 + n0 - 4224 + cc, o); });
    } else {
      epi_rows(sC, [&](int, int row, int cc, const float (&v)[8]) {
        if (cc < 32) {
          float o[8];
#pragma unroll
          for (int j = 0; j < 8; ++j) o[j] = v[j];
          rope8(sC, p.ROPE(), m0 + row, row, cc, o);
          store8(p.KPE() + (size_t)(m0 + row) * 32 + cc, o);
        } });
    }
}

DI void phase_g1(const Params& p, char* smem, bool do_ssq = true) {
  bf16_t* shm = (bf16_t*)smem;
  float* sC = (float*)smem;
  constexpr int NCT = INWP / 256;
  const int xq = blockIdx.x & 7, lb = blockIdx.x >> 3, nlb = gridDim.x >> 3;
  const bool xmap = (gridDim.x & 7) == 0;
  for (int t = xmap ? lb : (int)blockIdx.x; t < (xmap ? 8 * NCT : 64 * NCT); t += (xmap ? nlb : (int)gridDim.x)) {
    int rt, ct2;
    if (xmap) { ct2 = t >> 3; rt = 8 * xq + (t & 7); } else { rt = t / NCT; ct2 = t % NCT; }
    const int m0 = rt * 256, n0 = ct2 * 256;
    f32x4 acc[2][2][4][2];
    zero_acc8(acc);
    gemm8_tile(p.Hb() + (size_t)m0 * DM, p.WinT() + (size_t)n0 * DM, DM, shm, acc);
#pragma unroll
    for (int ai = 0; ai < 2; ++ai)
#pragma unroll
      for (int bj = 0; bj < 2; ++bj) {
        __syncthreads();
        accq_to_lds(acc[ai][bj], sC);
        __syncthreads();
        g1_epi(p, sC, m0 + ai * 128, n0 + bj * 128, ct2 * 2 + bj, do_ssq);
      }
    __syncthreads();
  }
}

DI void g2_epi_q(const Params& p, const float* sC, const float* rsq, const int m0, const int n0) {
  epi_rows(sC, [&](int, int row, int cc, const float (&v)[8]) {
    const int col = n0 + cc;
    float o[8];
#pragma unroll
    for (int j = 0; j < 8; ++j) o[j] = v[j];
    if (((col >> 5) % 3) == 2) rope8(sC, p.ROPE(), m0 + row, row, cc, o);
    const float sc = rsq[row] * QM_SCALE;
#pragma unroll
    for (int j = 0; j < 8; ++j) o[j] *= sc;
    store8(p.Qmla() + (size_t)(m0 + row) * 768 + col, o);
  });
}
DI void g2_epi_kv(const Params& p, const float* sC, const float* rsq, const int m0, const int head) {
  epi_rows(sC, [&](int, int row, int cc, const float (&v)[8]) {
    if (cc < 64) {
      const float sc = rsq[row];
      float o[8];
#pragma unroll
      for (int j = 0; j < 8; ++j) o[j] = v[j] * sc;
      store8(p.Knope() + (size_t)(m0 + row) * 512 + head * 64 + cc, o);
    } });
  const int b = m0 >> 12, s0 = m0 & 4095;
  for (int c = opaque_tid(); c < 1024; c += 512) {
    const int col = c & 63, rc = c >> 6;
    float v[8];
#pragma unroll
    for (int j = 0; j < 8; ++j) v[j] = sC[(rc * 8 + j) * CSTR + 64 + col] * rsq[rc * 8 + j];
    store8(p.VTmla() + ((size_t)((b * 8 + head) * 64 + col)) * SEQL + s0 + rc * 8, v);
  }
}

DI void phase_g2(const Params& p, char* smem) {
  bf16_t* shm = (bf16_t*)smem;
  float* sC = (float*)smem;
  float* rs = (float*)(smem + 131072);
  const int xq = blockIdx.x & 7, lb = blockIdx.x >> 3, nlb = gridDim.x >> 3;
  const bool xmap = (gridDim.x & 7) == 0;
  for (int tt = xmap ? lb : (int)blockIdx.x; tt < (xmap ? 56 : 448); tt += (xmap ? nlb : (int)gridDim.x)) {
    bool isq; int rt, ct;
    if (xmap) { isq = tt < 24; const int v2 = isq ? tt : tt - 24; rt = 8 * xq + (v2 & 7); ct = v2 >> 3; }
    else { isq = tt < 192; const int v2 = isq ? tt : tt - 192; rt = isq ? v2 / 3 : v2 >> 2; ct = isq ? v2 % 3 : v2 & 3; }
    const int m0 = rt * 256, n0 = ct * 256;
    f32x4 acc[2][2][4][2];
    zero_acc8(acc);
    if (isq) {
      if (threadIdx.x < 256) rs[threadIdx.x] = __builtin_amdgcn_rsqf(p.SSQ()[m0 + threadIdx.x] * (1.f / 384.f) + EPSN);
      gemm8_tile(p.CQ() + (size_t)m0 * 384, p.WuqT() + (size_t)n0 * 384, 384, shm, acc);
#pragma unroll
      for (int ai = 0; ai < 2; ++ai)
#pragma unroll
        for (int bj = 0; bj < 2; ++bj) {
          __syncthreads();
          accq_to_lds(acc[ai][bj], sC);
          __syncthreads();
          g2_epi_q(p, sC, rs + ai * 128, m0 + ai * 128, n0 + bj * 128);
        }
    } else {
      if (threadIdx.x < 256) rs[threadIdx.x] = __builtin_amdgcn_rsqf(p.SSQ()[NTOK + m0 + threadIdx.x] * (1.f / 256.f) + EPSN);
      gemm8_tile(p.CKV() + (size_t)m0 * 256, p.WukvT() + (size_t)n0 * 256, 256, shm, acc);
#pragma unroll
      for (int ai = 0; ai < 2; ++ai)
#pragma unroll
        for (int bj = 0; bj < 2; ++bj) {
          __syncthreads();
          accq_to_lds(acc[ai][bj], sC);
          __syncthreads();
          g2_epi_kv(p, sC, rs + ai * 128, m0 + ai * 128, ct * 2 + bj);
        }
    }
    __syncthreads();
  }
}

constexpr int VSTR = 68;

template <bool MLA>
DI void attn_item(const Params& p, int b, int h, int qb, char* smem) {
  constexpr int DK = MLA ? 96 : 64;
  constexpr int KSTR = MLA ? 104 : 72;
  constexpr int NKS = DK / 16;
  bf16_t* sK = (bf16_t*)smem;
  bf16_t* sV = sK + 2 * 64 * KSTR;
  const int tid = threadIdx.x, lane = tid & 63, w = tid >> 6, r = lane & 31, hh = lane >> 5;
  const int tokb = b * SEQL;
  const int tok0 = tokb + qb * 256;
  const int qw = qb * 256 + w * 32;

  bf16x8 qf[NKS];
  {
    const bf16_t* qptr = MLA ? (p.Qmla() + (size_t)(tok0 + w * 32 + r) * 768 + h * 96 + hh * 8) : (p.Qsb() + (size_t)(tok0 + w * 32 + r) * 512 + h * 64 + hh * 8);
#pragma unroll
    for (int ks = 0; ks < NKS; ++ks) qf[ks] = *(const bf16x8*)(qptr + ks * 16);
  }
  bf16x8 tf[2];
  if (!MLA) {
#pragma unroll
    for (int st = 0; st < 2; ++st)
#pragma unroll
      for (int e = 0; e < 8; ++e) { const int j = 16 * st + 8 * (e >> 2) + 4 * hh + (e & 3); tf[st][e] = (j >= r) ? (short)0x3F80 : (short)0; }
  }

  f32x16 oacc[2];
#pragma unroll
  for (int i = 0; i < 16; ++i) { oacc[0][i] = 0.f; oacc[1][i] = 0.f; }
  float carry = 0.f;
  float mrun = 0.f, lrun = 0.f;

  const bf16_t* Kg = MLA ? p.Knope() : p.Ksb();
  const bf16_t* VTg = (MLA ? p.VTmla() : p.VTsb()) + (size_t)((b * 8 + h) * 64) * SEQL;
  const int nt = 4 * qb + 4;

  uint4 xk0, xv0, xp, yk0, yv0, yp;
  xp = make_uint4(0, 0, 0, 0); yp = xp;
  const int prow = tid >> 3, pch = tid & 7;
  const bf16_t* kgp = Kg + (size_t)(tokb + prow) * 512 + h * 64 + pch * 8;
  const bf16_t* vgp = VTg + (size_t)prow * SEQL + pch * 8;
  const bf16_t* pgp = p.KPE() + (size_t)(tokb + ((tid & 255) >> 2)) * 32 + (tid & 3) * 8;
#define ATT_GLOAD(P, kt_)                                                          \
  {                                                                                \
    const int kt__ = (kt_);                                                        \
    P##k0 = *(const uint4*)(kgp + (size_t)(kt__ * 64) * 512);                      \
    P##v0 = *(const uint4*)(vgp + kt__ * 64);                                      \
    if (MLA && tid < 256) P##p = *(const uint4*)(pgp + (size_t)(kt__ * 64) * 32);  \
  }
#define ATT_SWRITE(P, buf_)                                                        \
  {                                                                                \
    bf16_t* dK = sK + (buf_) * 64 * KSTR;                                          \
    bf16_t* dV = sV + (buf_) * 64 * VSTR;                                          \
    *(uint4*)(dK + prow * KSTR + pch * 8) = P##k0;                                 \
    uint2* dv0 = (uint2*)(dV + prow * VSTR + pch * 8);                             \
    dv0[0] = make_uint2(P##v0.x, P##v0.y); dv0[1] = make_uint2(P##v0.z, P##v0.w);  \
    if (MLA && tid < 256) *(uint4*)(dK + (tid >> 2) * KSTR + 64 + (tid & 3) * 8) = P##p; \
  }
#define ATT_KT(i_) (MLA ? (i_) : (nt - 1 - (i_)))

  ATT_GLOAD(x, ATT_KT(0));
  ATT_GLOAD(y, ATT_KT(1));
  ATT_SWRITE(x, 0);
  __syncthreads();
  bool alive = true;
  for (int it0 = 0; alive; it0 += 2) {
#pragma unroll
   for (int half = 0; half < 2; ++half) {
    const int it = it0 + half;
    const int kt = ATT_KT(it);
    const int cur = half;
    const bool more = (it + 1 < nt);
    if (it + 2 < nt) { if (half == 0) ATT_GLOAD(x, ATT_KT(it + 2)) else ATT_GLOAD(y, ATT_KT(it + 2)) }
    const bf16_t* cK = sK + cur * 64 * KSTR;
    const bf16_t* cV = sV + cur * 64 * VSTR;
    if (MLA) {
      if (kt * 64 <= qw + 31) {
        f32x16 s0, s1;
        {
          const float sinit = -mrun;
#pragma unroll
          for (int i = 0; i < 16; ++i) { s0[i] = sinit; s1[i] = sinit; }
        }
        __builtin_amdgcn_s_setprio(1);
#pragma unroll
        for (int ks = 0; ks < NKS; ++ks) {
          const bf16x8 k0 = *(const bf16x8*)(cK + r * KSTR + ks * 16 + hh * 8);
          const bf16x8 k1 = *(const bf16x8*)(cK + (32 + r) * KSTR + ks * 16 + hh * 8);
          s0 = MFMA(k0, qf[ks], s0);
          s1 = MFMA(k1, qf[ks], s1);
        }
        __builtin_amdgcn_s_setprio(0);
        if (kt * 64 + 63 > qw) {
          const int lim = qw + r - kt * 64;
#pragma unroll
          for (int i = 0; i < 16; ++i) { if (crow(i, hh) > lim) s0[i] = -1e30f; if (32 + crow(i, hh) > lim) s1[i] = -1e30f; }
        }
        float m0 = fmaxf(fmaxf(s0[0], s0[1]), s0[2]), m1 = fmaxf(fmaxf(s1[0], s1[1]), s1[2]);
#pragma unroll
        for (int i = 3; i < 15; i += 2) { m0 = fmaxf(fmaxf(m0, s0[i]), s0[i + 1]); m1 = fmaxf(fmaxf(m1, s1[i]), s1[i + 1]); }
        float mloc = fmaxf(fmaxf(m0, s0[15]), fmaxf(m1, s1[15]));
        mloc = half_max(mloc);
        const bool first = (it == 0);
        const float delta = first ? mloc : fmaxf(mloc, 0.f);
        if (first || __builtin_amdgcn_ballot_w64(delta > 0.f) != 0ull) {
          const float alpha = first ? 0.f : __builtin_amdgcn_exp2f(-delta);
          mrun += delta;
          lrun *= alpha;
#pragma unroll
          for (int i = 0; i < 16; ++i) { oacc[0][i] *= alpha; oacc[1][i] *= alpha; s0[i] -= delta; s1[i] -= delta; }
        }
        float ps0 = 0.f, ps1 = 0.f;
#pragma unroll
        for (int i = 0; i < 16; ++i) { s0[i] = __builtin_amdgcn_exp2f(s0[i]); s1[i] = __builtin_amdgcn_exp2f(s1[i]); ps0 += s0[i]; ps1 += s1[i]; }
        lrun += ps0 + ps1;
        bf16x8 pf4[4];
        pf4[0] = pack8(s0[0], s0[1], s0[2], s0[3], s0[4], s0[5], s0[6], s0[7]);
        pf4[1] = pack8(s0[8], s0[9], s0[10], s0[11], s0[12], s0[13], s0[14], s0[15]);
        pf4[2] = pack8(s1[0], s1[1], s1[2], s1[3], s1[4], s1[5], s1[6], s1[7]);
        pf4[3] = pack8(s1[8], s1[9], s1[10], s1[11], s1[12], s1[13], s1[14], s1[15]);
        __builtin_amdgcn_s_setprio(1);
#pragma unroll
        for (int st = 0; st < 4; ++st)
#pragma unroll
          for (int dt = 0; dt < 2; ++dt) {
            const bf16_t* vp = cV + (dt * 32 + r) * VSTR + st * 16 + 4 * hh;
            const s16x4 lo = *(const s16x4*)vp;
            const s16x4 hi = *(const s16x4*)(vp + 8);
            const bf16x8 vf = __builtin_shufflevector(lo, hi, 0, 1, 2, 3, 4, 5, 6, 7);
            oacc[dt] = MFMA(vf, pf4[st], oacc[dt]);
          }
        __builtin_amdgcn_s_setprio(0);
      }
    } else
#pragma unroll
    for (int si = 0; si < 2; ++si) {
      const int sub = MLA ? si : (1 - si);
      const int kb = kt * 64 + sub * 32;
      if (kb > qw) continue;
      const bool diag = (kb == qw);
      f32x16 s;
      {
        const float sinit = MLA ? -mrun : 0.f;
#pragma unroll
        for (int i = 0; i < 16; ++i) s[i] = sinit;
      }
      __builtin_amdgcn_s_setprio(1);
#pragma unroll
      for (int ks = 0; ks < NKS; ++ks) {
        const bf16x8 kf = *(const bf16x8*)(cK + (sub * 32 + r) * KSTR + ks * 16 + hh * 8);
        s = MFMA(kf, qf[ks], s);
      }
      __builtin_amdgcn_s_setprio(0);
      bf16x8 pf[2];
      if (!MLA) {
        float sp[16];
        float tsum = 0.f;
#pragma unroll
        for (int i = 0; i < 16; ++i) {
          const float z = s[i];
          float v = __builtin_amdgcn_logf(1.f + __builtin_amdgcn_exp2f(fminf(z, 126.f)));
          if (diag && !(crow(i, hh) < r)) v = 0.f;
          sp[i] = v;
          tsum += v;
        }
        f32x16 cacc;
#pragma unroll
        for (int i = 0; i < 16; ++i) cacc[i] = carry;
        cacc = MFMA(tf[0], pack8(sp[0], sp[1], sp[2], sp[3], sp[4], sp[5], sp[6], sp[7]), cacc);
        cacc = MFMA(tf[1], pack8(sp[8], sp[9], sp[10], sp[11], sp[12], sp[13], sp[14], sp[15]), cacc);
        float pr[16];
#pragma unroll
        for (int i = 0; i < 16; ++i) {
          float v = __builtin_amdgcn_exp2f(s[i] - cacc[i]);
          if (diag && !(crow(i, hh) < r)) v = 0.f;
          pr[i] = v;
        }
        carry += half_sum(tsum);
        pf[0] = pack8(pr[0], pr[1], pr[2], pr[3], pr[4], pr[5], pr[6], pr[7]);
        pf[1] = pack8(pr[8], pr[9], pr[10], pr[11], pr[12], pr[13], pr[14], pr[15]);
      } else {
        if (diag) {
#pragma unroll
          for (int i = 0; i < 16; ++i) if (!(crow(i, hh) <= r)) s[i] = -1e30f;
        }
        float mloc = fmaxf(fmaxf(s[0], s[1]), s[2]);
#pragma unroll
        for (int i = 3; i < 15; i += 2) mloc = fmaxf(fmaxf(mloc, s[i]), s[i + 1]);
        mloc = fmaxf(mloc, s[15]);
        mloc = half_max(mloc);
        const bool first = (it == 0) && (si == 0);
        const float delta = first ? mloc : fmaxf(mloc, 0.f);
        if (first || __builtin_amdgcn_ballot_w64(delta > 0.f) != 0ull) {
          const float alpha = first ? 0.f : __builtin_amdgcn_exp2f(-delta);
          mrun += delta;
          lrun *= alpha;
#pragma unroll
          for (int i = 0; i < 16; ++i) { oacc[0][i] *= alpha; oacc[1][i] *= alpha; s[i] -= delta; }
        }
        float pr[16];
        float ps0 = 0.f, ps1 = 0.f;
#pragma unroll
        for (int i = 0; i < 16; i += 2) { pr[i] = __builtin_amdgcn_exp2f(s[i]); pr[i + 1] = __builtin_amdgcn_exp2f(s[i + 1]); ps0 += pr[i]; ps1 += pr[i + 1]; }
        lrun += ps0 + ps1;
        pf[0] = pack8(pr[0], pr[1], pr[2], pr[3], pr[4], pr[5], pr[6], pr[7]);
        pf[1] = pack8(pr[8], pr[9], pr[10], pr[11], pr[12], pr[13], pr[14], pr[15]);
      }
      __builtin_amdgcn_s_setprio(1);
#pragma unroll
      for (int dt = 0; dt < 2; ++dt)
#pragma unroll
        for (int st = 0; st < 2; ++st) {
          const bf16_t* vp = cV + (dt * 32 + r) * VSTR + sub * 32 + st * 16 + 4 * hh;
          const s16x4 lo = *(const s16x4*)vp;
          const s16x4 hi = *(const s16x4*)(vp + 8);
          const bf16x8 vf = __builtin_shufflevector(lo, hi, 0, 1, 2, 3, 4, 5, 6, 7);
          oacc[dt] = MFMA(vf, pf[st], oacc[dt]);
        }
      __builtin_amdgcn_s_setprio(0);
    }
    if (more) { if (half == 0) ATT_SWRITE(y, 1) else ATT_SWRITE(x, 0) }
    if (!MLA) {
      int* flg = (int*)(smem + SMEM_BYTES - 128) + (it & 1) * 8;
      const bool wok = (__builtin_amdgcn_ballot_w64(carry >= 160.f) == ~0ull);
      if (lane == 0) flg[w] = wok ? 1 : 0;
      __syncthreads();
      alive = more && ((flg[0] & flg[1] & flg[2] & flg[3] & flg[4] & flg[5] & flg[6] & flg[7]) == 0);
    } else {
      __syncthreads();
      alive = more;
    }
    if (!alive) break;
   }
  }
#undef ATT_GLOAD
#undef ATT_SWRITE
#undef ATT_KT
  float inv = 1.f;
  if (MLA) { const float lt = half_sum(lrun); inv = 1.f / lt; }
  const int tok = tok0 + w * 32 + r;
  const bf16_t* zg = (MLA ? p.Zmla() : p.Zsb()) + (size_t)tok * 512 + h * 64;
  bf16_t* og = (MLA ? p.OBg() : p.OAg()) + (size_t)tok * 512 + h * 64;
#pragma unroll
  for (int dt = 0; dt < 2; ++dt)
#pragma unroll
    for (int g = 0; g < 4; ++g) {
      const int d = dt * 32 + 8 * g + 4 * hh;
      const u32x2 zz = *(const u32x2*)(zg + d);
      const float z0 = __uint_as_float(zz[0] << 16), z1 = __uint_as_float(zz[0] & 0xffff0000u);
      const float z2 = __uint_as_float(zz[1] << 16), z3 = __uint_as_float(zz[1] & 0xffff0000u);
      u32x2 o;
      o[0] = pk2(oacc[dt][4 * g] * inv * z0, oacc[dt][4 * g + 1] * inv * z1);
      o[1] = pk2(oacc[dt][4 * g + 2] * inv * z2, oacc[dt][4 * g + 3] * inv * z3);
      *(u32x2*)(og + d) = o;
    }
}

DI void phase_attn(const Params& p, char* smem, int cbase, int only) {
  int* s_item = (int*)(smem + SMEM_BYTES - 16);
  const int q0 = blockIdx.x & 7;
  int qi = 0;
  for (;;) {
    if (threadIdx.x == 0) {
      int item = -1;
      while (qi < 8) {
        const int q = (q0 + qi) & 7;
        const int idx = atomicAdd(p.counter() + cbase + q, 1);
        if (idx < 128) { item = q * 256 + idx; break; }
        ++qi;
      }
      *s_item = item;
    }
    __syncthreads();
    const int item = *s_item;
    __syncthreads();
    if (item < 0) break;
    const int q = item >> 8, idx = item & 255;
    const int i2 = idx & 63;
    const int bh = q + 8 * (i2 & 3);
    const int qb = 15 - (i2 >> 2);
    if (idx < 64) { if (only != 2) attn_item<true>(p, bh >> 3, bh & 7, qb, smem); }
    else { if (only != 1) attn_item<false>(p, bh >> 3, bh & 7, qb, smem); }
  }
}

DI void g3_epi_a(const Params& p, const float* sC, const int m0, const int n0) {
  const int txo = opaque_tid();
#pragma unroll
  for (int i = 0; i < 4; ++i) {
    const int c = txo + 512 * i, row = c >> 4, cc = (c & 15) * 8;
    const u32x4 g = *(const u32x4*)(p.GA() + (size_t)(m0 + row) * 1024 + n0 + cc);
    const float4 a = *(const float4*)(sC + row * CSTR + cc), b = *(const float4*)(sC + row * CSTR + cc + 4);
    u32x4 y;
    y[0] = pk2(a.x * __uint_as_float(g[0] << 16), a.y * __uint_as_float(g[0] & 0xffff0000u));
    y[1] = pk2(a.z * __uint_as_float(g[1] << 16), a.w * __uint_as_float(g[1] & 0xffff0000u));
    y[2] = pk2(b.x * __uint_as_float(g[2] << 16), b.y * __uint_as_float(g[2] & 0xffff0000u));
    y[3] = pk2(b.z * __uint_as_float(g[3] << 16), b.w * __uint_as_float(g[3] & 0xffff0000u));
    *(u32x4*)(p.MERGED() + (size_t)(m0 + row) * 1024 + n0 + cc) = y;
  }
}
DI void g3_epi_b(const Params& p, const float* sC, const int m0, const int n0) {
  const int txo2 = opaque_tid();
#pragma unroll
  for (int i = 0; i < 4; ++i) {
    const int c = txo2 + 512 * i, row = c >> 4, cc = (c & 15) * 8;
    const u32x4 g = *(const u32x4*)(p.GB() + (size_t)(m0 + row) * 1024 + n0 + cc);
    const u32x4 yv = *(const u32x4*)(p.MERGED() + (size_t)(m0 + row) * 1024 + n0 + cc);
    const float4 a = *(const float4*)(sC + row * CSTR + cc), b = *(const float4*)(sC + row * CSTR + cc + 4);
    u32x4 o;
    o[0] = pk2(__uint_as_float(yv[0] << 16) + a.x * __uint_as_float(g[0] << 16), __uint_as_float(yv[0] & 0xffff0000u) + a.y * __uint_as_float(g[0] & 0xffff0000u));
    o[1] = pk2(__uint_as_float(yv[1] << 16) + a.z * __uint_as_float(g[1] << 16), __uint_as_float(yv[1] & 0xffff0000u) + a.w * __uint_as_float(g[1] & 0xffff0000u));
    o[2] = pk2(__uint_as_float(yv[2] << 16) + b.x * __uint_as_float(g[2] << 16), __uint_as_float(yv[2] & 0xffff0000u) + b.y * __uint_as_float(g[2] & 0xffff0000u));
    o[3] = pk2(__uint_as_float(yv[3] << 16) + b.z * __uint_as_float(g[3] << 16), __uint_as_float(yv[3] & 0xffff0000u) + b.w * __uint_as_float(g[3] & 0xffff0000u));
    *(u32x4*)(p.MERGED() + (size_t)(m0 + row) * 1024 + n0 + cc) = o;
  }
}
DI void phase_g3(const Params& p, char* smem) {
  bf16_t* shm = (bf16_t*)smem;
  float* sC = (float*)smem;
  const int xq = blockIdx.x & 7, lb = blockIdx.x >> 3, nlb = gridDim.x >> 3;
  const bool xmap = (gridDim.x & 7) == 0;
  for (int t = xmap ? lb : (int)blockIdx.x; t < (xmap ? 32 : 256); t += (xmap ? nlb : (int)gridDim.x)) {
    const int rt = xmap ? (8 * xq + (t & 7)) : (t >> 2), ct = xmap ? (t >> 3) : (t & 3);
    const int m0 = rt * 256, n0 = ct * 256;
    f32x4 acc[2][2][4][2];
    zero_acc8(acc);
    gemm8_tile(p.OAg() + (size_t)m0 * 512, p.WaT() + (size_t)n0 * 512, 512, shm, acc);
#pragma unroll
    for (int ai = 0; ai < 2; ++ai)
#pragma unroll
      for (int bj = 0; bj < 2; ++bj) {
        __syncthreads();
        accq_to_lds(acc[ai][bj], sC);
        __syncthreads();
        g3_epi_a(p, sC, m0 + ai * 128, n0 + bj * 128);
      }
    __syncthreads();
    zero_acc8(acc);
    gemm8_tile(p.OBg() + (size_t)m0 * 512, p.WbT() + (size_t)n0 * 512, 512, shm, acc);
#pragma unroll
    for (int ai = 0; ai < 2; ++ai)
#pragma unroll
      for (int bj = 0; bj < 2; ++bj) {
        __syncthreads();
        accq_to_lds(acc[ai][bj], sC);
        __syncthreads();
        g3_epi_b(p, sC, m0 + ai * 128, n0 + bj * 128);
      }
    __syncthreads();
  }
}

DI void g4_epi(const Params& p, const float* sC, const float* gt, const int m0, const int n0) {
  const int txo = opaque_tid();
#pragma unroll
  for (int i = 0; i < 4; ++i) {
    const int c = txo + 512 * i, row = c >> 4, cc = (c & 15) * 8;
    const size_t go = (size_t)(m0 + row) * 1024 + n0 + cc;
    const float4 x0 = *(const float4*)(p.x + go), x1 = *(const float4*)(p.x + go + 4);
    const float4 a = *(const float4*)(sC + row * CSTR + cc), b = *(const float4*)(sC + row * CSTR + cc + 4);
    const float4 g0 = *(const float4*)(gt + cc), g1 = *(const float4*)(gt + cc + 4);
    float4 o0, o1;
    o0.x = x0.x + g0.x * a.x; o0.y = x0.y + g0.y * a.y; o0.z = x0.z + g0.z * a.z; o0.w = x0.w + g0.w * a.w;
    o1.x = x1.x + g1.x * b.x; o1.y = x1.y + g1.y * b.y; o1.z = x1.z + g1.z * b.z; o1.w = x1.w + g1.w * b.w;
    *(float4*)(p.out + go) = o0;
    *(float4*)(p.out + go + 4) = o1;
  }
}
DI void phase_g4(const Params& p, char* smem) {
  bf16_t* shm = (bf16_t*)smem;
  float* sC = (float*)smem;
  float* rs = (float*)(smem + 131072);
  const int xq = blockIdx.x & 7, lb = blockIdx.x >> 3, nlb = gridDim.x >> 3;
  const bool xmap = (gridDim.x & 7) == 0;
  for (int t = xmap ? lb : (int)blockIdx.x; t < (xmap ? 32 : 256); t += (xmap ? nlb : (int)gridDim.x)) {
    const int rt = xmap ? (8 * xq + (t & 7)) : (t >> 2), ct = xmap ? (t >> 3) : (t & 3);
    const int m0 = rt * 256, n0 = ct * 256;
    f32x4 acc[2][2][4][2];
    zero_acc8(acc);
    if (threadIdx.x < 256) rs[threadIdx.x] = mod_get(p.MOD(), m0 >> 12, 2048 + n0 + threadIdx.x);
    gemm8_tile(p.MERGED() + (size_t)m0 * 1024, p.WoT() + (size_t)n0 * 1024, 1024, shm, acc);
#pragma unroll
    for (int ai = 0; ai < 2; ++ai)
#pragma unroll
      for (int bj = 0; bj < 2; ++bj) {
        __syncthreads();
        accq_to_lds(acc[ai][bj], sC);
        __syncthreads();
        g4_epi(p, sC, rs + bj * 128, m0 + ai * 128, n0 + bj * 128);
      }
    __syncthreads();
  }
}

DI void phase_final(const Params& p) {
  const int lane = threadIdx.x & 63, w = threadIdx.x >> 6;
  const int gw = blockIdx.x * 8 + w, nw = gridDim.x * 8;
  for (int row = gw; row < NTOK; row += nw) {
    float* xr = p.out + (size_t)row * DM;
    float4 v[4];
    float ss = 0.f;
#pragma unroll
    for (int i = 0; i < 4; ++i) {
      v[i] = *(const float4*)(xr + 4 * (lane + 64 * i));
      ss += v[i].x * v[i].x + v[i].y * v[i].y + v[i].z * v[i].z + v[i].w * v[i].w;
    }
#pragma unroll
    for (int o = 32; o >= 1; o >>= 1) ss += __shfl_xor(ss, o);
    const float rn = __builtin_amdgcn_rsqf(ss * (1.f / DM) + EPSN);
#pragma unroll
    for (int i = 0; i < 4; ++i) {
      const int e = 4 * (lane + 64 * i);
      const float4 g = *(const float4*)(p.fgain + e);
      float4 o;
      o.x = v[i].x * rn * g.x; o.y = v[i].y * rn * g.y; o.z = v[i].z * rn * g.z; o.w = v[i].w * rn * g.w;
      *(float4*)(xr + e) = o;
    }
  }
}

template <int PH>
__global__ void __launch_bounds__(NTHREADS, 2) mega_kernel(Params p) {
  __shared__ __attribute__((aligned(16))) char smem[SMEM_BYTES];
  if (PH < 0) {
    if (p.ws == nullptr) cg::this_grid().sync();
    volatile LAS unsigned* xst = (volatile LAS unsigned*)(smem + SMEM_BYTES - 32);
    if (threadIdx.x == 0) { xst[0] = 0u; xst[1] = 0u; }
    __syncthreads();
    (void)xcd_barrier_post(p.bar(), xst);
    phase_prep(p, smem); xcd_barrier(p.bar(), (volatile LAS unsigned*)(smem + SMEM_BYTES - 32));
#if PROBE_DUP == 4
    phase_prep(p, smem); xcd_barrier(p.bar(), (volatile LAS unsigned*)(smem + SMEM_BYTES - 32));
#endif
    phase_h(p, smem); xcd_barrier(p.bar(), (volatile LAS unsigned*)(smem + SMEM_BYTES - 32));
#if PROBE_DUP == 5
    phase_h(p, smem); xcd_barrier(p.bar(), (volatile LAS unsigned*)(smem + SMEM_BYTES - 32));
#endif
    phase_g1(p, smem); xcd_barrier(p.bar(), (volatile LAS unsigned*)(smem + SMEM_BYTES - 32));
#if PROBE_DUP == 1
    phase_g1(p, smem, false); xcd_barrier(p.bar(), (volatile LAS unsigned*)(smem + SMEM_BYTES - 32));
#endif
    phase_g2(p, smem); xcd_barrier(p.bar(), (volatile LAS unsigned*)(smem + SMEM_BYTES - 32));
#if PROBE_DUP == 8
    phase_g2(p, smem); xcd_barrier(p.bar(), (volatile LAS unsigned*)(smem + SMEM_BYTES - 32));
#endif
    phase_attn(p, smem, 0, 0); xcd_barrier(p.bar(), (volatile LAS unsigned*)(smem + SMEM_BYTES - 32));
#if PROBE_DUP == 2
    phase_attn(p, smem, 8, 1); xcd_barrier(p.bar(), (volatile LAS unsigned*)(smem + SMEM_BYTES - 32));
#endif
#if PROBE_DUP == 3
    phase_attn(p, smem, 8, 2); xcd_barrier(p.bar(), (volatile LAS unsigned*)(smem + SMEM_BYTES - 32));
#endif
    phase_g3(p, smem); xcd_barrier(p.bar(), (volatile LAS unsigned*)(smem + SMEM_BYTES - 32));
#if PROBE_DUP == 6
    phase_g3(p, smem); xcd_barrier(p.bar(), (volatile LAS unsigned*)(smem + SMEM_BYTES - 32));
#endif
    phase_g4(p, smem); xcd_barrier(p.bar(), (volatile LAS unsigned*)(smem + SMEM_BYTES - 32));
#if PROBE_DUP == 7
    phase_g4(p, smem); xcd_barrier(p.bar(), (volatile LAS unsigned*)(smem + SMEM_BYTES - 32));
#endif
    phase_final(p);
  } else {
    if (PH == 0) phase_prep(p, smem);
    if (PH == 1) phase_h(p, smem);
    if (PH == 2) phase_g1(p, smem);
    if (PH == 3) phase_g2(p, smem);
    if (PH == 4) phase_attn(p, smem, 0, 0);
    if (PH == 5) phase_g3(p, smem);
    if (PH == 6) phase_g4(p, smem);
    if (PH == 7) phase_final(p);
  }
}

#ifndef PROBE_DUP
#define PROBE_DUP 0
#endif
#ifndef MK_SPLIT
#define MK_SPLIT 0
#endif

extern "C" void kernel_launch(void* const* d_in, const int* in_sizes, int n_in, void* d_out, int out_size, void* d_ws, size_t ws_size, hipStream_t stream) {
  Params p{};
  p.x = (const float*)d_in[0]; p.c = (const float*)d_in[1]; p.pos = (const int*)d_in[2];
  p.w_ada = (const float*)d_in[3]; p.b_ada = (const float*)d_in[4]; p.norm_gain = (const float*)d_in[5];
  p.w_in = (const float*)d_in[6]; p.q_gain = (const float*)d_in[7]; p.w_uq = (const float*)d_in[8];
  p.kv_gain = (const float*)d_in[9]; p.w_ukv = (const float*)d_in[10]; p.w_a = (const float*)d_in[11];
  p.w_b = (const float*)d_in[12]; p.w_out = (const float*)d_in[13]; p.fgain = (const float*)d_in[14];
  p.out = (float*)d_out;
  p.ws = (char*)d_ws;
  if (WS_NEED > ws_size) { fprintf(stderr, "workspace too small: need %zu have %zu\n", (size_t)WS_NEED, ws_size); return; }

  static int grid_blocks = 0;
  if (!grid_blocks) {
    int dev = 0, cus = 0, per_cu = 0;
    hipGetDevice(&dev);
    hipDeviceGetAttribute(&cus, hipDeviceAttributeMultiprocessorCount, dev);
    hipOccupancyMaxActiveBlocksPerMultiprocessor(&per_cu, mega_kernel<-1>, NTHREADS, 0);
    per_cu = 1;
    grid_blocks = cus * per_cu;
  }
#if MK_SPLIT
  mega_kernel<0><<<grid_blocks, NTHREADS, 0, stream>>>(p);
  mega_kernel<1><<<grid_blocks, NTHREADS, 0, stream>>>(p);
  mega_kernel<2><<<grid_blocks, NTHREADS, 0, stream>>>(p);
  mega_kernel<3><<<grid_blocks, NTHREADS, 0, stream>>>(p);
  mega_kernel<4><<<grid_blocks, NTHREADS, 0, stream>>>(p);
  mega_kernel<5><<<grid_blocks, NTHREADS, 0, stream>>>(p);
  mega_kernel<6><<<grid_blocks, NTHREADS, 0, stream>>>(p);
  mega_kernel<7><<<grid_blocks, NTHREADS, 0, stream>>>(p);
#else
  hipMemsetAsync((char*)d_ws + OFF_bar, 0, XCD_BAR_WORDS * 4, stream);
  void* args[] = {&p};
  hipError_t e = hipLaunchCooperativeKernel((void*)mega_kernel<-1>, dim3(grid_blocks), dim3(NTHREADS), args, 0, stream);
  if (e != hipSuccess) fprintf(stderr, "cooperative launch failed: %s (grid %d)\n", hipGetErrorString(e), grid_blocks);
#endif
}
```

```cpp
#include <hip/hip_runtime.h>
#include <hip/hip_cooperative_groups.h>
#include <stdint.h>
#include <stdio.h>
namespace cg = cooperative_groups;
#ifndef PROBE_DUP
#define PROBE_DUP 0
#endif

#define DI __device__ __forceinline__
typedef unsigned short bf16_t;
typedef __attribute__((ext_vector_type(8))) short bf16x8;
typedef __attribute__((ext_vector_type(4))) short s16x4;
typedef __attribute__((ext_vector_type(16))) float f32x16;
typedef __attribute__((ext_vector_type(2))) float f32x2;
typedef __attribute__((ext_vector_type(2))) __bf16 bf16x2v;
typedef __attribute__((ext_vector_type(4))) unsigned u32x4;
typedef __attribute__((ext_vector_type(2))) unsigned u32x2;
typedef __attribute__((ext_vector_type(4))) float f32x4;
#define MFMA(a, b, c) __builtin_amdgcn_mfma_f32_32x32x16_bf16((a), (b), (c), 0, 0, 0)

constexpr int NTOK = 16384, SEQL = 4096, DM = 1024;
constexpr int INW = 5280, INWP = 5376;
constexpr int NTHREADS = 512;
constexpr float LOG2E = 1.4426950408889634f;
constexpr float QS_SCALE = 0.125f * 1.4426950408889634f;
constexpr float QM_SCALE = 1.4426950408889634f / 9.797958971132712f;
constexpr float EPSN = 1e-6f;

constexpr int XCD_BAR_WORDS_C = 3456;
constexpr size_t al256(size_t v) { return (v + 255) & ~(size_t)255; }
constexpr size_t OFF_counter = 0;
constexpr size_t OFF_bar = OFF_counter + al256(256);
constexpr size_t OFF_MOD = OFF_bar + al256(XCD_BAR_WORDS_C * 4);
constexpr size_t OFF_ROPE = OFF_MOD + al256(4 * 3072 * 4 * 4);
constexpr size_t OFF_SSQ = OFF_ROPE + al256((size_t)NTOK * 32 * 4);
constexpr size_t OFF_Hb = OFF_SSQ + al256((size_t)2 * NTOK * 4);
constexpr size_t OFF_Qmla = OFF_Hb + al256((size_t)NTOK * 1024 * 2);
constexpr size_t OFF_WuqT = OFF_Qmla + al256((size_t)NTOK * 768 * 2);
constexpr size_t OFF_WukvT = OFF_WuqT + al256((size_t)768 * 384 * 2);
constexpr size_t OFF_WaT = OFF_WukvT + al256((size_t)1024 * 256 * 2);
constexpr size_t OFF_WbT = OFF_WaT + al256((size_t)1024 * 512 * 2);
constexpr size_t OFF_WoT = OFF_WbT + al256((size_t)1024 * 512 * 2);
constexpr size_t OFF_Qsb = OFF_WoT + al256((size_t)1024 * 1024 * 2);
constexpr size_t OFF_Ksb = OFF_Qsb + al256((size_t)NTOK * 512 * 2);
constexpr size_t OFF_VTsb = OFF_Ksb + al256((size_t)NTOK * 512 * 2);
constexpr size_t OFF_Zsb = OFF_VTsb + al256((size_t)NTOK * 512 * 2);
constexpr size_t OFF_OAg = OFF_Zsb + al256((size_t)NTOK * 512 * 2);
constexpr size_t OFF_OBg = OFF_OAg + al256((size_t)NTOK * 512 * 2);
constexpr size_t OFF_Zmla = OFF_OBg + al256((size_t)NTOK * 512 * 2);
constexpr size_t OFF_KPE = OFF_Zmla + al256((size_t)NTOK * 512 * 2);
constexpr size_t OFF_Knope = OFF_KPE + al256((size_t)NTOK * 32 * 2);
constexpr size_t OFF_VTmla = OFF_Knope + al256((size_t)NTOK * 512 * 2);
constexpr size_t OFF_WinT = OFF_VTmla + al256((size_t)NTOK * 512 * 2);
constexpr size_t WS_NEED = OFF_WinT + al256((size_t)INWP * 1024 * 2);
struct Params {
  const float *x, *c; const int* pos;
  const float *w_ada, *b_ada, *norm_gain, *w_in, *q_gain, *w_uq, *kv_gain, *w_ukv, *w_a, *w_b, *w_out, *fgain;
  float* out;
  char* ws;
  DI int* counter() const { return (int*)(ws + OFF_counter); }
  DI unsigned* bar() const { return (unsigned*)(ws + OFF_bar); }
  DI float* MOD() const { return (float*)(ws + OFF_MOD); }
  DI float* ROPE() const { return (float*)(ws + OFF_ROPE); }
  DI float* SSQ() const { return (float*)(ws + OFF_SSQ); }
  DI bf16_t* Hb() const { return (bf16_t*)(ws + OFF_Hb); }
  DI bf16_t* Qmla() const { return (bf16_t*)(ws + OFF_Qmla); }
  DI bf16_t* WuqT() const { return (bf16_t*)(ws + OFF_WuqT); }
  DI bf16_t* WukvT() const { return (bf16_t*)(ws + OFF_WukvT); }
  DI bf16_t* WaT() const { return (bf16_t*)(ws + OFF_WaT); }
  DI bf16_t* WbT() const { return (bf16_t*)(ws + OFF_WbT); }
  DI bf16_t* WoT() const { return (bf16_t*)(ws + OFF_WoT); }
  DI bf16_t* Qsb() const { return (bf16_t*)(ws + OFF_Qsb); }
  DI bf16_t* Ksb() const { return (bf16_t*)(ws + OFF_Ksb); }
  DI bf16_t* VTsb() const { return (bf16_t*)(ws + OFF_VTsb); }
  DI bf16_t* Zsb() const { return (bf16_t*)(ws + OFF_Zsb); }
  DI bf16_t* OAg() const { return (bf16_t*)(ws + OFF_OAg); }
  DI bf16_t* OBg() const { return (bf16_t*)(ws + OFF_OBg); }
  DI bf16_t* Zmla() const { return (bf16_t*)(ws + OFF_Zmla); }
  DI bf16_t* KPE() const { return (bf16_t*)(ws + OFF_KPE); }
  DI bf16_t* Knope() const { return (bf16_t*)(ws + OFF_Knope); }
  DI bf16_t* VTmla() const { return (bf16_t*)(ws + OFF_VTmla); }
  DI bf16_t* MERGED() const { return Hb(); }
  DI bf16_t* WinT() const { return (bf16_t*)(ws + OFF_WinT); }
  DI bf16_t* CQ() const { return OAg(); }
  DI bf16_t* CKV() const { return OBg(); }
  DI bf16_t* GA() const { return (bf16_t*)out; }
  DI bf16_t* GB() const { return (bf16_t*)out + (size_t)NTOK * 1024; }
};


__device__ const float c_invfreq[16] = {
  1.0f, 0.5623413251903491f, 0.31622776601683794f, 0.1778279410038923f, 0.1f, 0.05623413251903491f, 0.03162277660168379f,
  0.01778279410038923f, 0.01f, 0.005623413251903491f, 0.0031622776601683794f, 0.001778279410038923f, 0.001f,
  0.0005623413251903491f, 0.00031622776601683794f, 0.0001778279410038923f};

DI unsigned pk2(float a, float b) { f32x2 v = {a, b}; bf16x2v r = __builtin_convertvector(v, bf16x2v); return __builtin_bit_cast(unsigned, r); }
DI bf16_t tobf(float a) { return (bf16_t)(pk2(a, 0.f) & 0xffffu); }
DI float bf2f(unsigned short u) { return __uint_as_float(((unsigned)u) << 16); }
DI bf16x8 pack8(float a0, float a1, float a2, float a3, float a4, float a5, float a6, float a7) {
  u32x4 p; p[0] = pk2(a0, a1); p[1] = pk2(a2, a3); p[2] = pk2(a4, a5); p[3] = pk2(a6, a7);
  return __builtin_bit_cast(bf16x8, p);
}
DI int crow(int reg, int h) { return (reg & 3) + 8 * (reg >> 2) + 4 * h; }
DI int opaque_tid() { int t = threadIdx.x; asm volatile("" : "+v"(t)); return t; }
DI float half_max(float v) {
  unsigned u = __float_as_uint(v);
  auto r = __builtin_amdgcn_permlane32_swap(u, u, false, false);
  return fmaxf(__uint_as_float(r[0]), __uint_as_float(r[1]));
}
DI float half_sum(float v) {
  unsigned u = __float_as_uint(v);
  auto r = __builtin_amdgcn_permlane32_swap(u, u, false, false);
  return __uint_as_float(r[0]) + __uint_as_float(r[1]);
}
DI float sigmoidf_fast(float v) { return __builtin_amdgcn_rcpf(1.f + __builtin_amdgcn_exp2f(-v * LOG2E)); }
DI float siluf_fast(float v) { return v * sigmoidf_fast(v); }

#define XB_TMO      128
#define XB_XCNT(j)  (256  + 64 * (j))
#define XB_XSUB(j)  (1280 + 64 * (j))
#define XB_XGEN(j)  (2304 + 64 * (j))
#define XB_TOP      3328
#define XB_TOPGEN   3392
#define XCD_BAR_WORDS 3456
#define XB_SPIN_CAP (1u << 18)
#define LAS __attribute__((address_space(3)))
DI unsigned xb_ld(unsigned* p)              { return __hip_atomic_load(p, __ATOMIC_RELAXED, __HIP_MEMORY_SCOPE_AGENT); }
DI unsigned xb_add(unsigned* p, unsigned v) { return __hip_atomic_fetch_add(p, v, __ATOMIC_RELAXED, __HIP_MEMORY_SCOPE_AGENT); }
DI unsigned xb_xcc_id() { return (unsigned)__builtin_amdgcn_s_getreg((3 << 11) | 20) & 0xFu; }
#define XB_SPIN(cond, bar) do { unsigned _sp = 0; while (cond) { __builtin_amdgcn_s_sleep(1); \
    if ((++_sp & 255u) == 0u) { if (xb_ld(&(bar)[XB_TMO])) break; if (_sp > XB_SPIN_CAP) { atomicAdd(&(bar)[XB_TMO], 1u); break; } } } } while (0)
struct XcdBarrier { unsigned* bar; unsigned x; volatile LAS unsigned* st; };
DI XcdBarrier xcd_barrier_post(unsigned* bar, volatile LAS unsigned* st) {
  XcdBarrier b; b.bar = bar; b.x = xb_xcc_id(); b.st = st;
  if (threadIdx.x == 0) (void)xb_add(&bar[XB_XCNT(b.x)], 1u);
  return b;
}
DI void xcd_barrier_complete(unsigned* bar, unsigned x, unsigned& nloc, unsigned& nx) {
  const unsigned G = gridDim.x * gridDim.y * gridDim.z;
  unsigned sum, cnt, mine, sp = 0u;
  for (;;) {
    sum = 0u; cnt = 0u; mine = 0u;
#pragma unroll
    for (unsigned j = 0; j < 16; ++j) { const unsigned c = xb_ld(&bar[XB_XCNT(j)]); sum += c; cnt += (c > 0u) ? 1u : 0u; mine = (j == x) ? c : mine; }
    if (sum == G) break;
    __builtin_amdgcn_s_sleep(1);
    if ((++sp & 255u) == 0u) { if (xb_ld(&bar[XB_TMO])) break; if (sp > XB_SPIN_CAP) { atomicAdd(&bar[XB_TMO], 1u); break; } }
  }
  nloc = mine > 0u ? mine : 1u; nx = cnt > 0u ? cnt : 1u;
}
DI void xcd_barrier(unsigned* bar_, volatile LAS unsigned* st_) {
  XcdBarrier b; b.bar = bar_; b.st = st_; b.x = 0;
  asm volatile("s_waitcnt vmcnt(0)" ::: "memory");
  __syncthreads();
  if (threadIdx.x == 0) {
    unsigned* bar = b.bar;
    b.x = xb_xcc_id();
    __builtin_amdgcn_s_waitcnt(0);
    unsigned nloc = b.st[0], nx = b.st[1];
    if (nloc == 0u) { xcd_barrier_complete(bar, b.x, nloc, nx); b.st[0] = nloc; b.st[1] = nx; }
    const unsigned old = xb_add(&bar[XB_XSUB(b.x)], 1u);
    const unsigned gen = old / nloc;
    if (old + 1u == (gen + 1u) * nloc) {
      __builtin_amdgcn_fence(__ATOMIC_RELEASE, "agent");
      asm volatile("s_waitcnt vmcnt(0)" ::: "memory");
      const unsigned og = xb_add(&bar[XB_TOP], 1u);
      const unsigned tg = og / nx;
      if (og + 1u == (tg + 1u) * nx) xb_add(&bar[XB_TOPGEN], 1u);
      else XB_SPIN(xb_ld(&bar[XB_TOPGEN]) == tg, bar);
      __builtin_amdgcn_fence(__ATOMIC_ACQUIRE, "agent");
      xb_add(&bar[XB_XGEN(b.x)], 1u);
      asm volatile("s_waitcnt vmcnt(0)" ::: "memory");
    } else {
      XB_SPIN(xb_ld(&bar[XB_XGEN(b.x)]) == gen, bar);
      __builtin_amdgcn_fence(__ATOMIC_ACQUIRE, "agent");
      asm volatile("s_waitcnt vmcnt(0)" ::: "memory");
    }
  }
  __syncthreads();
}

constexpr int GSTR = 72;
constexpr int GBUF = 128 * GSTR;
constexpr int SMEM_BYTES = 131072 + 4096;

constexpr int G8_HT = 128 * 64;
DI int lds_byte(int r, int c) { const int st = (r >> 4) * 2 + (c >> 5), rr = r & 15, cc = c & 31, ob = rr * 64 + cc * 2; return st * 1024 + (ob ^ (((ob >> 9) & 1) << 5)); }
DI void stage_rc(int b, int& R, int& C) { const int st = b / 1024, sb = b % 1024, swz = sb ^ (((sb >> 9) & 1) << 5); R = (st >> 1) * 16 + swz / 64; C = (st & 1) * 32 + (swz % 64) / 2; }

DI void gemm8_tile(const bf16_t* __restrict__ A, const bf16_t* __restrict__ Bt, const int K, bf16_t* shm, f32x4 (&acc)[2][2][4][2]) {
  const int tid = opaque_tid();
  const int wid = tid >> 6, lane = tid & 63, wr = wid >> 2, wc = wid & 3, fr = lane & 15, fq = lane >> 4;
  const int swz = (fr * 64 + fq * 16) ^ ((fr >> 3) << 5);
  const char* aRd = (const char*)shm + swz + wr * 8192;
  const char* bRd = (const char*)shm + 65536 + swz + wc * 4096;
  int sr0, sc0, sr1, sc1;
  stage_rc(tid * 16, sr0, sc0);
  stage_rc(tid * 16 + 8192, sr1, sc1);
  const unsigned so0 = (unsigned)(sr0 * K + sc0) * 2u, so1 = (unsigned)(sr1 * K + sc1) * 2u;
  char* const stw = (char*)shm + __builtin_amdgcn_readfirstlane(tid & ~63) * 16;
  const char* const Ab = (const char*)A;
  const char* const Bb = (const char*)Bt;
#define SA(b, h) (((b) * 2 + (h)) * 16384)
#define SB(b, h) ((4 + (b) * 2 + (h)) * 16384)
#define STAGE(P, BASE, br, kt) do { const char* g_ = (BASE) + ((long)(br) * K + (long)(kt) * 64) * 2;                        \
    __builtin_amdgcn_global_load_lds((const unsigned*)(g_ + so0), (unsigned*)(stw + (P)), 16, 0, 0);                          \
    __builtin_amdgcn_global_load_lds((const unsigned*)(g_ + so1), (unsigned*)(stw + (P) + 8192), 16, 0, 0); } while (0)
#define LDA(dst, b, h) _Pragma("unroll") for (int m = 0; m < 4; ++m) _Pragma("unroll") for (int k = 0; k < 2; ++k) \
    dst[m][k] = *reinterpret_cast<const bf16x8*>(aRd + ((b) * 2 + (h)) * 16384 + (m * 2 + k) * 1024)
#define LDB(dst, b, h) _Pragma("unroll") for (int n = 0; n < 2; ++n) _Pragma("unroll") for (int k = 0; k < 2; ++k) \
    dst[n][k] = *reinterpret_cast<const bf16x8*>(bRd + ((b) * 2 + (h)) * 16384 + (n * 2 + k) * 1024)
#define MMA(ai, bj, At_, Bt_) do { __builtin_amdgcn_s_setprio(1);                                                          \
    _Pragma("unroll") for (int m = 0; m < 4; ++m) _Pragma("unroll") for (int n = 0; n < 2; ++n) _Pragma("unroll") for (int k = 0; k < 2; ++k) \
      acc[ai][bj][m][n] = __builtin_amdgcn_mfma_f32_16x16x32_bf16(At_[m][k], Bt_[n][k], acc[ai][bj][m][n], 0, 0, 0);       \
    __builtin_amdgcn_s_setprio(0); } while (0)
#define WAIT_V(n) asm volatile("s_waitcnt vmcnt(" #n ")" ::: "memory")
#define WAIT_L(n) asm volatile("s_waitcnt lgkmcnt(" #n ")" ::: "memory")
#define BAR __builtin_amdgcn_s_barrier()
#define SCHED __builtin_amdgcn_sched_barrier(0)
  bf16x8 At[4][2], B0[2][2], B1[2][2];
  const int nt = K / 64;
  WAIT_V(0);
  STAGE(SB(0, 0), Bb, 0, 0); STAGE(SA(0, 0), Ab, 0, 0);
  STAGE(SB(0, 1), Bb, 128, 0); STAGE(SA(0, 1), Ab, 128, 0);
  if (wr == 1) BAR;
  WAIT_V(4); BAR;
  STAGE(SB(1, 0), Bb, 0, 1); STAGE(SA(1, 0), Ab, 0, 1); STAGE(SB(1, 1), Bb, 128, 1);
  WAIT_V(6); BAR;
  for (int t = 0; t < nt - 2; t += 2) {
    LDB(B0, 0, 0); SCHED; LDA(At, 0, 0); STAGE(SA(1, 1), Ab, 128, t + 1);
    WAIT_L(8); BAR; WAIT_L(0); MMA(0, 0, At, B0); BAR; SCHED;
    LDB(B1, 0, 1); STAGE(SB(0, 0), Bb, 0, t + 2);
    BAR; WAIT_L(0); MMA(0, 1, At, B1); BAR;
    LDA(At, 0, 1); STAGE(SA(0, 0), Ab, 0, t + 2);
    BAR; WAIT_L(0); MMA(1, 0, At, B0); BAR; SCHED;
    STAGE(SB(0, 1), Bb, 128, t + 2);
    WAIT_V(6); BAR; MMA(1, 1, At, B1); BAR;
    LDB(B0, 1, 0); SCHED; LDA(At, 1, 0); STAGE(SA(0, 1), Ab, 128, t + 2);
    WAIT_L(8); BAR; WAIT_L(0); MMA(0, 0, At, B0); BAR; SCHED;
    LDB(B1, 1, 1); STAGE(SB(1, 0), Bb, 0, t + 3);
    BAR; WAIT_L(0); MMA(0, 1, At, B1); BAR;
    LDA(At, 1, 1); STAGE(SA(1, 0), Ab, 0, t + 3);
    BAR; WAIT_L(0); MMA(1, 0, At, B0); BAR; SCHED;
    STAGE(SB(1, 1), Bb, 128, t + 3);
    WAIT_V(6); BAR; MMA(1, 1, At, B1); BAR;
  }
  { LDB(B0, 0, 0); LDA(At, 0, 0); STAGE(SA(1, 1), Ab, 128, nt - 1);
    BAR; WAIT_L(0); MMA(0, 0, At, B0); BAR;
    LDB(B1, 0, 1); BAR; WAIT_L(0); MMA(0, 1, At, B1); BAR;
    LDA(At, 0, 1); WAIT_V(4); BAR; WAIT_L(0); MMA(1, 0, At, B0); MMA(1, 1, At, B1); BAR; }
  { LDB(B0, 1, 0); LDA(At, 1, 0); WAIT_V(2); BAR; WAIT_L(0); MMA(0, 0, At, B0); BAR;
    LDB(B1, 1, 1); WAIT_V(0); BAR; WAIT_L(0); MMA(0, 1, At, B1); BAR;
    LDA(At, 1, 1); BAR; WAIT_L(0); MMA(1, 0, At, B0); MMA(1, 1, At, B1); BAR; }
  if (wr == 0) BAR;
#undef SA
#undef SB
#undef STAGE
#undef LDA
#undef LDB
#undef MMA
#undef WAIT_V
#undef WAIT_L
#undef BAR
#undef SCHED
}


DI void zero_acc8(f32x4 (&acc)[2][2][4][2]) {
#pragma unroll
  for (int a = 0; a < 2; ++a)
#pragma unroll
    for (int b = 0; b < 2; ++b)
#pragma unroll
      for (int m = 0; m < 4; ++m)
#pragma unroll
        for (int n = 0; n < 2; ++n) acc[a][b][m][n] = f32x4{0.f, 0.f, 0.f, 0.f};
}

constexpr int CSTR = 132;
DI void accq_to_lds(const f32x4 (&q)[4][2], float* sC) {
  const int tid = opaque_tid(), wid = tid >> 6, lane = tid & 63, wr = wid >> 2, wc = wid & 3, fr = lane & 15, fq = lane >> 4;
#pragma unroll
  for (int m = 0; m < 4; ++m)
#pragma unroll
    for (int n = 0; n < 2; ++n)
#pragma unroll
      for (int j = 0; j < 4; ++j) sC[(wr * 64 + m * 16 + fq * 4 + j) * CSTR + wc * 32 + n * 16 + fr] = q[m][n][j];
}
template <class F>
DI void epi_rows(const float* sC, F f) {
  const int tx = opaque_tid();
#pragma unroll
  for (int i = 0; i < 4; ++i) {
    const int c = tx + 512 * i, row = c >> 4, cc = (c & 15) * 8;
    const float4 a = *(const float4*)(sC + row * CSTR + cc), b = *(const float4*)(sC + row * CSTR + cc + 4);
    const float v[8] = {a.x, a.y, a.z, a.w, b.x, b.y, b.z, b.w};
    f(i, row, cc, v);
  }
}
DI void store8(bf16_t* p, const float (&v)[8]) { *(bf16x8*)p = pack8(v[0], v[1], v[2], v[3], v[4], v[5], v[6], v[7]); }
DI void epi_vt(const float* sC, bf16_t* VT, int m0, int head0, int c0, int ncol_log2) {
  const int b = m0 >> 12, s0 = m0 & 4095;
  const int nitems = 16 << ncol_log2;
  for (int c = opaque_tid(); c < nitems; c += 512) {
    const int col = c & ((1 << ncol_log2) - 1), rc = c >> ncol_log2;
    float v[8];
#pragma unroll
    for (int j = 0; j < 8; ++j) v[j] = sC[(rc * 8 + j) * CSTR + c0 + col];
    const int head = head0 + (col >> 6), d = col & 63;
    store8(VT + ((size_t)((b * 8 + head) * 64 + d)) * SEQL + s0 + rc * 8, v);
  }
}
DI void rope8(const float* sC, const float* ROPE, int tok, int row, int cc, float (&v)[8]) {
  const float* pr = sC + row * CSTR + (cc ^ 16);
  const bool upper = (cc & 16) != 0;
  const int f0 = cc & 15;
  const float* tb = ROPE + (size_t)tok * 32;
#pragma unroll
  for (int j = 0; j < 8; ++j) {
    const float o = pr[j], cs = tb[f0 + j], sn = tb[16 + f0 + j];
    v[j] = upper ? (o * sn + v[j] * cs) : (v[j] * cs - o * sn);
  }
}

DI void wconv_unit(const float* __restrict__ src, int Nsrc, int K, bf16_t* __restrict__ dst, const float* __restrict__ gain, int ng, int kg, int mode, float* tile, const int tid) {
  {
    const int k = tid >> 2, cq = tid & 3;
    const int n = ng * 64 + cq * 16;
    int sc = n;
    if (mode == 1) { sc = (n < 2688) ? n : (n < 5248 ? n + 32 : (n < 5280 ? n - 2560 : -1)); }
    const int kk = kg * 64 + k;
    float4 v[4];
    if (sc >= 0) {
      const float* sp = src + (size_t)kk * Nsrc + sc;
#pragma unroll
      for (int i = 0; i < 4; ++i) v[i] = *(const float4*)(sp + 4 * i);
      if (gain) { const float g = gain[kk];
#pragma unroll
        for (int i = 0; i < 4; ++i) { v[i].x *= g; v[i].y *= g; v[i].z *= g; v[i].w *= g; } }
    } else {
#pragma unroll
      for (int i = 0; i < 4; ++i) v[i] = make_float4(0.f, 0.f, 0.f, 0.f);
    }
    float* tp = tile + k * 65 + cq * 16;
#pragma unroll
    for (int i = 0; i < 4; ++i) { tp[4 * i] = v[i].x; tp[4 * i + 1] = v[i].y; tp[4 * i + 2] = v[i].z; tp[4 * i + 3] = v[i].w; }
  }
  __syncthreads();
  {
    const int n = tid >> 2, kc = tid & 3;
    float o[16];
#pragma unroll
    for (int j = 0; j < 16; ++j) o[j] = tile[(kc * 16 + j) * 65 + n];
    bf16_t* dp = dst + (size_t)(ng * 64 + n) * K + kg * 64 + kc * 16;
    *(bf16x8*)dp = pack8(o[0], o[1], o[2], o[3], o[4], o[5], o[6], o[7]);
    *(bf16x8*)(dp + 8) = pack8(o[8], o[9], o[10], o[11], o[12], o[13], o[14], o[15]);
  }
  __syncthreads();
}

DI void phase_prep(const Params& p, char* smem) {
  if (blockIdx.x == 0 && threadIdx.x < 16) { p.counter()[threadIdx.x] = 0; }
  for (int i = blockIdx.x * NTHREADS + threadIdx.x; i < 2 * NTOK; i += gridDim.x * NTHREADS) p.SSQ()[i] = 0.f;
  const int half = threadIdx.x >> 8, tid = threadIdx.x & 255;
  constexpr int U_MOD = 96 * 4, U_WIN = 84 * 16, U_WUQ = 12 * 6, U_WUKV = 16 * 4, U_WA = 16 * 8, U_WB = 16 * 8, U_WO = 16 * 16, U_ROPE = 1024;
  constexpr int U_TOTAL = U_MOD + U_ROPE + U_WIN + U_WUQ + U_WUKV + U_WA + U_WB + U_WO;
  float* tile = (float*)smem + half * (64 * 65 + 64);
  for (int up = blockIdx.x; up < U_TOTAL / 2; up += gridDim.x) {
    int v = 2 * up + half;
    if (v < U_MOD) {
      const int cg32 = v >> 2, kq = v & 3, n0 = cg32 * 32;
      const int kgp = tid >> 5, col = tid & 31;
      const int kb = kq * 256 + kgp * 32;
      float a0 = 0.f, a1 = 0.f, a2 = 0.f, a3 = 0.f;
      const float* wp = p.w_ada + (size_t)kb * 3072 + n0 + col;
      float wv[32];
#pragma unroll
      for (int kk = 0; kk < 32; ++kk) wv[kk] = wp[(size_t)kk * 3072];
#pragma unroll
      for (int kk = 0; kk < 32; ++kk) {
        a0 += wv[kk] * p.c[kb + kk]; a1 += wv[kk] * p.c[1024 + kb + kk]; a2 += wv[kk] * p.c[2048 + kb + kk]; a3 += wv[kk] * p.c[3072 + kb + kk];
      }
      float* red = (float*)smem + half * 1024;
      red[(kgp * 4 + 0) * 32 + col] = a0; red[(kgp * 4 + 1) * 32 + col] = a1; red[(kgp * 4 + 2) * 32 + col] = a2; red[(kgp * 4 + 3) * 32 + col] = a3;
      __syncthreads();
      if (tid < 128) {
        const int b = tid >> 5, cc = tid & 31;
        float s = (kq == 0) ? p.b_ada[n0 + cc] : 0.f;
#pragma unroll
        for (int g = 0; g < 8; ++g) s += red[(g * 4 + b) * 32 + cc];
        p.MOD()[(size_t)(b * 3072 + n0 + cc) * 4 + kq] = s;
      }
      __syncthreads();
      continue;
    }
    v -= U_MOD;
    if (v < U_WIN) { wconv_unit(p.w_in, INW, 1024, p.WinT(), nullptr, v >> 4, v & 15, 1, tile, tid); continue; }
    v -= U_WIN;
    if (v < U_WUQ) { wconv_unit(p.w_uq, 768, 384, p.WuqT(), p.q_gain, v / 6, v % 6, 0, tile, tid); continue; }
    v -= U_WUQ;
    if (v < U_WUKV) { wconv_unit(p.w_ukv, 1024, 256, p.WukvT(), p.kv_gain, v >> 2, v & 3, 0, tile, tid); continue; }
    v -= U_WUKV;
    if (v < U_WA) { wconv_unit(p.w_a, 1024, 512, p.WaT(), nullptr, v >> 3, v & 7, 0, tile, tid); continue; }
    v -= U_WA;
    if (v < U_WB) { wconv_unit(p.w_b, 1024, 512, p.WbT(), nullptr, v >> 3, v & 7, 0, tile, tid); continue; }
    v -= U_WB;
    if (v < U_WO) { wconv_unit(p.w_out, 1024, 1024, p.WoT(), nullptr, v >> 4, v & 15, 0, tile, tid); continue; }
    v -= U_WO;
    {
      const int idx = v * 256 + tid, tok = idx >> 4, i = idx & 15;
      const float ang = (float)p.pos[tok] * c_invfreq[i];
      double t = (double)ang * 0.15915494309189535;
      t -= rint(t);
      const float tf = (float)t;
      p.ROPE()[(size_t)tok * 32 + i] = __builtin_amdgcn_cosf(tf);
      p.ROPE()[(size_t)tok * 32 + 16 + i] = __builtin_amdgcn_sinf(tf);
    }
  }
}

DI float mod_get(const float* MOD, int b, int n) { const float4 q = *(const float4*)(MOD + (size_t)(b * 3072 + n) * 4); return (q.x + q.y) + (q.z + q.w); }

DI void phase_h(const Params& p, char* smem) {
  const int tid = opaque_tid(), lane = tid & 63, w = tid >> 6;
  float* gs = (float*)smem;
  float* sh = gs + 1024;
  const int xq = blockIdx.x & 7, lb = blockIdx.x >> 3, nlb = gridDim.x >> 3;
  const bool xmap = (gridDim.x & 7) == 0;
  for (int rgi = xmap ? lb : (int)blockIdx.x; rgi < (xmap ? 32 : NTOK / 64); rgi += (xmap ? nlb : (int)gridDim.x)) {
    const int rg = xmap ? (32 * xq + rgi) : rgi;
    const int b = (rg * 64) >> 12;
    __syncthreads();
#pragma unroll
    for (int i = 0; i < 2; ++i) {
      const int k = tid + 512 * i;
      gs[k] = p.norm_gain[k] * (1.f + mod_get(p.MOD(), b, 1024 + k));
      sh[k] = mod_get(p.MOD(), b, k);
    }
    __syncthreads();
#pragma unroll 2
    for (int rr = 0; rr < 8; ++rr) {
      const int row = rg * 64 + w * 8 + rr;
      const float* xr = p.x + (size_t)row * DM;
      float4 v[4];
      float ss = 0.f;
#pragma unroll
      for (int i = 0; i < 2; ++i) {
        const int e = 8 * (lane + 64 * i);
        v[2 * i] = *(const float4*)(xr + e);
        v[2 * i + 1] = *(const float4*)(xr + e + 4);
        ss += v[2 * i].x * v[2 * i].x + v[2 * i].y * v[2 * i].y + v[2 * i].z * v[2 * i].z + v[2 * i].w * v[2 * i].w;
        ss += v[2 * i + 1].x * v[2 * i + 1].x + v[2 * i + 1].y * v[2 * i + 1].y + v[2 * i + 1].z * v[2 * i + 1].z + v[2 * i + 1].w * v[2 * i + 1].w;
      }
#pragma unroll
      for (int o = 32; o >= 1; o >>= 1) ss += __shfl_xor(ss, o);
      const float rn = __builtin_amdgcn_rsqf(ss * (1.f / DM) + EPSN);
#pragma unroll
      for (int i = 0; i < 2; ++i) {
        const int e = 8 * (lane + 64 * i);
        const float4 g0 = *(const float4*)(gs + e), g1 = *(const float4*)(gs + e + 4);
        const float4 s0 = *(const float4*)(sh + e), s1 = *(const float4*)(sh + e + 4);
        *(bf16x8*)(p.Hb() + (size_t)row * DM + e) =
            pack8(v[2 * i].x * rn * g0.x + s0.x, v[2 * i].y * rn * g0.y + s0.y, v[2 * i].z * rn * g0.z + s0.z, v[2 * i].w * rn * g0.w + s0.w,
                  v[2 * i + 1].x * rn * g1.x + s1.x, v[2 * i + 1].y * rn * g1.y + s1.y, v[2 * i + 1].z * rn * g1.z + s1.z, v[2 * i + 1].w * rn * g1.w + s1.w);
      }
    }
  }
  __syncthreads();
}

DI void g1_epi(const Params& p, const float* sC, const int m0, const int n0, const int ct, const bool do_ssq) {
    if (ct < 4) {
      epi_rows(sC, [&](int, int row, int cc, const float (&v)[8]) {
        float o[8];
#pragma unroll
        for (int j = 0; j < 8; ++j) o[j] = v[j] * QS_SCALE;
        store8(p.Qsb() + (size_t)(m0 + row) * 512 + n0 + cc, o); });
    } else if (ct < 8) {
      epi_rows(sC, [&](int, int row, int cc, const float (&v)[8]) { store8(p.Ksb() + (size_t)(m0 + row) * 512 + n0 - 512 + cc, v); });
    } else if (ct < 12) {
      epi_vt(sC, p.VTsb(), m0, (n0 - 1024) >> 6, 0, 7);
    } else if (ct < 16) {
      epi_rows(sC, [&](int, int row, int cc, const float (&v)[8]) {
        float o[8];
#pragma unroll
        for (int j = 0; j < 8; ++j) o[j] = siluf_fast(v[j]);
        store8(p.Zsb() + (size_t)(m0 + row) * 512 + n0 - 1536 + cc, o); });
    } else if (ct < 19) {
      epi_rows(sC, [&](int, int row, int cc, const float (&v)[8]) {
        store8(p.CQ() + (size_t)(m0 + row) * 384 + n0 - 2048 + cc, v);
        float q = 0.f;
#pragma unroll
        for (int j = 0; j < 8; ++j) q += v[j] * v[j];
        q += __shfl_xor(q, 1); q += __shfl_xor(q, 2); q += __shfl_xor(q, 4); q += __shfl_xor(q, 8);
        if (do_ssq && (threadIdx.x & 15) == 0) atomicAdd(p.SSQ() + m0 + row, q); });
    } else if (ct < 21) {
      epi_rows(sC, [&](int, int row, int cc, const float (&v)[8]) {
        store8(p.CKV() + (size_t)(m0 + row) * 256 + n0 - 2432 + cc, v);
        float q = 0.f;
#pragma unroll
        for (int j = 0; j < 8; ++j) q += v[j] * v[j];
        q += __shfl_xor(q, 1); q += __shfl_xor(q, 2); q += __shfl_xor(q, 4); q += __shfl_xor(q, 8);
        if (do_ssq && (threadIdx.x & 15) == 0) atomicAdd(p.SSQ() + NTOK + m0 + row, q); });
    } else if (ct < 25) {
      epi_rows(sC, [&](int, int row, int cc, const float (&v)[8]) {
        float o[8];
#pragma unroll
        for (int j = 0; j < 8; ++j) o[j] = siluf_fast(v[j]);
        store8(p.Zmla() + (size_t)(m0 + row) * 512 + n0 - 2688 + cc, o); });
    } else if (ct < 33) {
      epi_rows(sC, [&](int, int row, int cc, const float (&v)[8]) {
        float o[8];
#pragma unroll
        for (int j = 0; j < 8; ++j) o[j] = sigmoidf_fast(v[j]);
        store8(p.GA() + (size_t)(m0 + row) * 1024 + n0 - 3200 + cc, o); });
    } else if (ct < 41) {
      epi_rows(sC, [&](int, int row, int cc, const float (&v)[8]) {
        float o[8];
#pragma unroll
        for (int j = 0; j < 8; ++j) o[j] = sigmoidf_fast(v[j]);
        store8(p.GB() + (size_t)(m0 + row) * 1024 + n0 - 4224 + cc, o); });
    } else {
      epi_rows(sC, [&](int, int row, int cc, const float (&v)[8]) {
        if (cc < 32) {
          float o[8];
#pragma unroll
          for (int j = 0; j < 8; ++j) o[j] = v[j];
          rope8(sC, p.ROPE(), m0 + row, row, cc, o);
          store8(p.KPE() + (size_t)(m0 + row) * 32 + cc, o);
        } });
    }
}

DI void g1_tile(const Params& p, char* smem, const int rt, const int ct2, const bool do_ssq) {
  bf16_t* shm = (bf16_t*)smem;
  float* sC = (float*)smem;
  const int m0 = rt * 256, n0 = ct2 * 256;
  f32x4 acc[2][2][4][2];
  zero_acc8(acc);
  gemm8_tile(p.Hb() + (size_t)m0 * DM, p.WinT() + (size_t)n0 * DM, DM, shm, acc);
#pragma unroll
  for (int ai = 0; ai < 2; ++ai)
#pragma unroll
    for (int bj = 0; bj < 2; ++bj) {
      __syncthreads();
      accq_to_lds(acc[ai][bj], sC);
      __syncthreads();
      g1_epi(p, sC, m0 + ai * 128, n0 + bj * 128, ct2 * 2 + bj, do_ssq);
    }
  __syncthreads();
}

constexpr int G1_NCT = 20;
DI void phase_g1(const Params& p, char* smem, bool do_ssq = true) {
  const int xq = blockIdx.x & 7, lb = blockIdx.x >> 3, nlb = gridDim.x >> 3;
  const bool xmap = (gridDim.x & 7) == 0;
  for (int t = xmap ? lb : (int)blockIdx.x; t < (xmap ? 8 * G1_NCT : 64 * G1_NCT); t += (xmap ? nlb : (int)gridDim.x)) {
    int rt, ct2;
    if (xmap) { ct2 = t >> 3; rt = 8 * xq + (t & 7); } else { rt = t / G1_NCT; ct2 = t % G1_NCT; }
    g1_tile(p, smem, rt, ct2, do_ssq);
  }
}

DI void g2_epi_q(const Params& p, const float* sC, const float* rsq, const int m0, const int n0) {
  epi_rows(sC, [&](int, int row, int cc, const float (&v)[8]) {
    const int col = n0 + cc;
    float o[8];
#pragma unroll
    for (int j = 0; j < 8; ++j) o[j] = v[j];
    if (((col >> 5) % 3) == 2) rope8(sC, p.ROPE(), m0 + row, row, cc, o);
    const float sc = rsq[row] * QM_SCALE;
#pragma unroll
    for (int j = 0; j < 8; ++j) o[j] *= sc;
    store8(p.Qmla() + (size_t)(m0 + row) * 768 + col, o);
  });
}
DI void g2_epi_kv(const Params& p, const float* sC, const float* rsq, const int m0, const int head) {
  epi_rows(sC, [&](int, int row, int cc, const float (&v)[8]) {
    if (cc < 64) {
      const float sc = rsq[row];
      float o[8];
#pragma unroll
      for (int j = 0; j < 8; ++j) o[j] = v[j] * sc;
      store8(p.Knope() + (size_t)(m0 + row) * 512 + head * 64 + cc, o);
    } });
  const int b = m0 >> 12, s0 = m0 & 4095;
  for (int c = opaque_tid(); c < 1024; c += 512) {
    const int col = c & 63, rc = c >> 6;
    float v[8];
#pragma unroll
    for (int j = 0; j < 8; ++j) v[j] = sC[(rc * 8 + j) * CSTR + 64 + col] * rsq[rc * 8 + j];
    store8(p.VTmla() + ((size_t)((b * 8 + head) * 64 + col)) * SEQL + s0 + rc * 8, v);
  }
}

DI void g2_tile(const Params& p, char* smem, const bool isq, const int rt, const int ct) {
  bf16_t* shm = (bf16_t*)smem;
  float* sC = (float*)smem;
  float* rs = (float*)(smem + 131072);
  const int m0 = rt * 256, n0 = ct * 256;
  f32x4 acc[2][2][4][2];
  zero_acc8(acc);
  if (isq) {
    if (threadIdx.x < 256) rs[threadIdx.x] = __builtin_amdgcn_rsqf(p.SSQ()[m0 + threadIdx.x] * (1.f / 384.f) + EPSN);
    gemm8_tile(p.CQ() + (size_t)m0 * 384, p.WuqT() + (size_t)n0 * 384, 384, shm, acc);
#pragma unroll
    for (int ai = 0; ai < 2; ++ai)
#pragma unroll
      for (int bj = 0; bj < 2; ++bj) {
        __syncthreads();
        accq_to_lds(acc[ai][bj], sC);
        __syncthreads();
        g2_epi_q(p, sC, rs + ai * 128, m0 + ai * 128, n0 + bj * 128);
      }
  } else {
    if (threadIdx.x < 256) rs[threadIdx.x] = __builtin_amdgcn_rsqf(p.SSQ()[NTOK + m0 + threadIdx.x] * (1.f / 256.f) + EPSN);
    gemm8_tile(p.CKV() + (size_t)m0 * 256, p.WukvT() + (size_t)n0 * 256, 256, shm, acc);
#pragma unroll
    for (int ai = 0; ai < 2; ++ai)
#pragma unroll
      for (int bj = 0; bj < 2; ++bj) {
        __syncthreads();
        accq_to_lds(acc[ai][bj], sC);
        __syncthreads();
        g2_epi_kv(p, sC, rs + ai * 128, m0 + ai * 128, ct * 2 + bj);
      }
  }
  __syncthreads();
}

DI void phase_g2(const Params& p, char* smem) {
  const int xq = blockIdx.x & 7, lb = blockIdx.x >> 3, nlb = gridDim.x >> 3;
  if ((gridDim.x & 7) == 0 && nlb == 32) {
    if (lb < 8) { g1_tile(p, smem, 8 * xq + lb, G1_NCT, false); return; }
    const int v = lb - 8;
    g2_tile(p, smem, true, 8 * xq + (v & 7), v >> 3);
    g2_tile(p, smem, false, 8 * xq + (v & 7), v >> 3);
    if (lb < 16) { const int v2 = 24 + v; g2_tile(p, smem, false, 8 * xq + (v2 & 7), v2 >> 3); }
  } else {
    for (int tt = blockIdx.x; tt < 64 + 192 + 256; tt += gridDim.x) {
      if (tt < 64) g1_tile(p, smem, tt, G1_NCT, false);
      else if (tt < 256) { const int v = tt - 64; g2_tile(p, smem, true, v / 3, v % 3); }
      else { const int v = tt - 256; g2_tile(p, smem, false, v >> 2, v & 3); }
    }
  }
}

constexpr int VSTR = 68;

template <bool MLA>
DI void attn_item(const Params& p, int b, int h, int qb, char* smem) {
  constexpr int DK = MLA ? 96 : 64;
  constexpr int KSTR = MLA ? 104 : 72;
  constexpr int NKS = DK / 16;
  bf16_t* sK = (bf16_t*)smem;
  bf16_t* sV = sK + 2 * 64 * KSTR;
  const int tid = threadIdx.x, lane = tid & 63, w = tid >> 6, r = lane & 31, hh = lane >> 5;
  const int tokb = b * SEQL;
  const int tok0 = tokb + qb * 256;
  const int qw = qb * 256 + w * 32;

  bf16x8 qf[NKS];
  {
    const bf16_t* qptr = MLA ? (p.Qmla() + (size_t)(tok0 + w * 32 + r) * 768 + h * 96 + hh * 8) : (p.Qsb() + (size_t)(tok0 + w * 32 + r) * 512 + h * 64 + hh * 8);
#pragma unroll
    for (int ks = 0; ks < NKS; ++ks) qf[ks] = *(const bf16x8*)(qptr + ks * 16);
  }
  bf16x8 tf[2];
  if (!MLA) {
#pragma unroll
    for (int st = 0; st < 2; ++st)
#pragma unroll
      for (int e = 0; e < 8; ++e) { const int j = 16 * st + 8 * (e >> 2) + 4 * hh + (e & 3); tf[st][e] = (j >= r) ? (short)0x3F80 : (short)0; }
  }

  f32x16 oacc[2];
#pragma unroll
  for (int i = 0; i < 16; ++i) { oacc[0][i] = 0.f; oacc[1][i] = 0.f; }
  float carry = 0.f;
  float mrun = 0.f, lrun = 0.f;

  const bf16_t* Kg = MLA ? p.Knope() : p.Ksb();
  const bf16_t* VTg = (MLA ? p.VTmla() : p.VTsb()) + (size_t)((b * 8 + h) * 64) * SEQL;
  const int nt = 4 * qb + 4;

  uint4 xk0, xv0, xp, yk0, yv0, yp;
  xp = make_uint4(0, 0, 0, 0); yp = xp;
  const int prow = tid >> 3, pch = tid & 7;
  const bf16_t* kgp = Kg + (size_t)(tokb + prow) * 512 + h * 64 + pch * 8;
  const bf16_t* vgp = VTg + (size_t)prow * SEQL + pch * 8;
  const bf16_t* pgp = p.KPE() + (size_t)(tokb + ((tid & 255) >> 2)) * 32 + (tid & 3) * 8;
#define ATT_GLOAD(P, kt_)                                                          \
  {                                                                                \
    const int kt__ = (kt_);                                                        \
    P##k0 = *(const uint4*)(kgp + (size_t)(kt__ * 64) * 512);                      \
    P##v0 = *(const uint4*)(vgp + kt__ * 64);                                      \
    if (MLA && tid < 256) P##p = *(const uint4*)(pgp + (size_t)(kt__ * 64) * 32);  \
  }
#define ATT_SWRITE(P, buf_)                                                        \
  {                                                                                \
    bf16_t* dK = sK + (buf_) * 64 * KSTR;                                          \
    bf16_t* dV = sV + (buf_) * 64 * VSTR;                                          \
    *(uint4*)(dK + prow * KSTR + pch * 8) = P##k0;                                 \
    uint2* dv0 = (uint2*)(dV + prow * VSTR + pch * 8);                             \
    dv0[0] = make_uint2(P##v0.x, P##v0.y); dv0[1] = make_uint2(P##v0.z, P##v0.w);  \
    if (MLA && tid < 256) *(uint4*)(dK + (tid >> 2) * KSTR + 64 + (tid & 3) * 8) = P##p; \
  }
#define ATT_KT(i_) (MLA ? (i_) : (nt - 1 - (i_)))

  ATT_GLOAD(x, ATT_KT(0));
  ATT_GLOAD(y, ATT_KT(1));
  ATT_SWRITE(x, 0);
  __syncthreads();
  bool alive = true;
  for (int it0 = 0; alive; it0 += 2) {
#pragma unroll
   for (int half = 0; half < 2; ++half) {
    const int it = it0 + half;
    const int kt = ATT_KT(it);
    const int cur = half;
    const bool more = (it + 1 < nt);
    if (it + 2 < nt) { if (half == 0) ATT_GLOAD(x, ATT_KT(it + 2)) else ATT_GLOAD(y, ATT_KT(it + 2)) }
    const bf16_t* cK = sK + cur * 64 * KSTR;
    const bf16_t* cV = sV + cur * 64 * VSTR;
    if (MLA) {
      if (kt * 64 <= qw + 31) {
        f32x16 s0, s1;
        {
          const float sinit = -mrun;
#pragma unroll
          for (int i = 0; i < 16; ++i) { s0[i] = sinit; s1[i] = sinit; }
        }
        __builtin_amdgcn_s_setprio(1);
#pragma unroll
        for (int ks = 0; ks < NKS; ++ks) {
          const bf16x8 k0 = *(const bf16x8*)(cK + r * KSTR + ks * 16 + hh * 8);
          const bf16x8 k1 = *(const bf16x8*)(cK + (32 + r) * KSTR + ks * 16 + hh * 8);
          s0 = MFMA(k0, qf[ks], s0);
          s1 = MFMA(k1, qf[ks], s1);
        }
        __builtin_amdgcn_s_setprio(0);
        if (kt * 64 + 63 > qw) {
          const int lim = qw + r - kt * 64;
#pragma unroll
          for (int i = 0; i < 16; ++i) { if (crow(i, hh) > lim) s0[i] = -1e30f; if (32 + crow(i, hh) > lim) s1[i] = -1e30f; }
        }
        float m0 = fmaxf(fmaxf(s0[0], s0[1]), s0[2]), m1 = fmaxf(fmaxf(s1[0], s1[1]), s1[2]);
#pragma unroll
        for (int i = 3; i < 15; i += 2) { m0 = fmaxf(fmaxf(m0, s0[i]), s0[i + 1]); m1 = fmaxf(fmaxf(m1, s1[i]), s1[i + 1]); }
        float mloc = fmaxf(fmaxf(m0, s0[15]), fmaxf(m1, s1[15]));
        mloc = half_max(mloc);
        const bool first = (it == 0);
        const float delta = first ? mloc : fmaxf(mloc, 0.f);
        if (first || __builtin_amdgcn_ballot_w64(delta > 0.f) != 0ull) {
          const float alpha = first ? 0.f : __builtin_amdgcn_exp2f(-delta);
          mrun += delta;
          lrun *= alpha;
#pragma unroll
          for (int i = 0; i < 16; ++i) { oacc[0][i] *= alpha; oacc[1][i] *= alpha; s0[i] -= delta; s1[i] -= delta; }
        }
        float ps0 = 0.f, ps1 = 0.f;
#pragma unroll
        for (int i = 0; i < 16; ++i) { s0[i] = __builtin_amdgcn_exp2f(s0[i]); s1[i] = __builtin_amdgcn_exp2f(s1[i]); ps0 += s0[i]; ps1 += s1[i]; }
        lrun += ps0 + ps1;
        bf16x8 pf4[4];
        pf4[0] = pack8(s0[0], s0[1], s0[2], s0[3], s0[4], s0[5], s0[6], s0[7]);
        pf4[1] = pack8(s0[8], s0[9], s0[10], s0[11], s0[12], s0[13], s0[14], s0[15]);
        pf4[2] = pack8(s1[0], s1[1], s1[2], s1[3], s1[4], s1[5], s1[6], s1[7]);
        pf4[3] = pack8(s1[8], s1[9], s1[10], s1[11], s1[12], s1[13], s1[14], s1[15]);
        __builtin_amdgcn_s_setprio(1);
#pragma unroll
        for (int st = 0; st < 4; ++st)
#pragma unroll
          for (int dt = 0; dt < 2; ++dt) {
            const bf16_t* vp = cV + (dt * 32 + r) * VSTR + st * 16 + 4 * hh;
            const s16x4 lo = *(const s16x4*)vp;
            const s16x4 hi = *(const s16x4*)(vp + 8);
            const bf16x8 vf = __builtin_shufflevector(lo, hi, 0, 1, 2, 3, 4, 5, 6, 7);
            oacc[dt] = MFMA(vf, pf4[st], oacc[dt]);
          }
        __builtin_amdgcn_s_setprio(0);
      }
    } else
#pragma unroll
    for (int si = 0; si < 2; ++si) {
      const int sub = MLA ? si : (1 - si);
      const int kb = kt * 64 + sub * 32;
      if (kb > qw) continue;
      const bool diag = (kb == qw);
      f32x16 s;
      {
        const float sinit = MLA ? -mrun : 0.f;
#pragma unroll
        for (int i = 0; i < 16; ++i) s[i] = sinit;
      }
      __builtin_amdgcn_s_setprio(1);
#pragma unroll
      for (int ks = 0; ks < NKS; ++ks) {
        const bf16x8 kf = *(const bf16x8*)(cK + (sub * 32 + r) * KSTR + ks * 16 + hh * 8);
        s = MFMA(kf, qf[ks], s);
      }
      __builtin_amdgcn_s_setprio(0);
      bf16x8 pf[2];
      if (!MLA) {
        float sp[16];
        float tsum = 0.f;
#pragma unroll
        for (int i = 0; i < 16; ++i) {
          const float z = s[i];
          float v = __builtin_amdgcn_logf(1.f + __builtin_amdgcn_exp2f(fminf(z, 126.f)));
          if (diag && !(crow(i, hh) < r)) v = 0.f;
          sp[i] = v;
          tsum += v;
        }
        f32x16 cacc;
#pragma unroll
        for (int i = 0; i < 16; ++i) cacc[i] = carry;
        cacc = MFMA(tf[0], pack8(sp[0], sp[1], sp[2], sp[3], sp[4], sp[5], sp[6], sp[7]), cacc);
        cacc = MFMA(tf[1], pack8(sp[8], sp[9], sp[10], sp[11], sp[12], sp[13], sp[14], sp[15]), cacc);
        float pr[16];
#pragma unroll
        for (int i = 0; i < 16; ++i) {
          float v = __builtin_amdgcn_exp2f(s[i] - cacc[i]);
          if (diag && !(crow(i, hh) < r)) v = 0.f;
          pr[i] = v;
        }
        carry += half_sum(tsum);
        pf[0] = pack8(pr[0], pr[1], pr[2], pr[3], pr[4], pr[5], pr[6], pr[7]);
        pf[1] = pack8(pr[8], pr[9], pr[10], pr[11], pr[12], pr[13], pr[14], pr[15]);
      } else {
        if (diag) {
#pragma unroll
          for (int i = 0; i < 16; ++i) if (!(crow(i, hh) <= r)) s[i] = -1e30f;
        }
        float mloc = fmaxf(fmaxf(s[0], s[1]), s[2]);
#pragma unroll
        for (int i = 3; i < 15; i += 2) mloc = fmaxf(fmaxf(mloc, s[i]), s[i + 1]);
        mloc = fmaxf(mloc, s[15]);
        mloc = half_max(mloc);
        const bool first = (it == 0) && (si == 0);
        const float delta = first ? mloc : fmaxf(mloc, 0.f);
        if (first || __builtin_amdgcn_ballot_w64(delta > 0.f) != 0ull) {
          const float alpha = first ? 0.f : __builtin_amdgcn_exp2f(-delta);
          mrun += delta;
          lrun *= alpha;
#pragma unroll
          for (int i = 0; i < 16; ++i) { oacc[0][i] *= alpha; oacc[1][i] *= alpha; s[i] -= delta; }
        }
        float pr[16];
        float ps0 = 0.f, ps1 = 0.f;
#pragma unroll
        for (int i = 0; i < 16; i += 2) { pr[i] = __builtin_amdgcn_exp2f(s[i]); pr[i + 1] = __builtin_amdgcn_exp2f(s[i + 1]); ps0 += pr[i]; ps1 += pr[i + 1]; }
        lrun += ps0 + ps1;
        pf[0] = pack8(pr[0], pr[1], pr[2], pr[3], pr[4], pr[5], pr[6], pr[7]);
        pf[1] = pack8(pr[8], pr[9], pr[10], pr[11], pr[12], pr[13], pr[14], pr[15]);
      }
      __builtin_amdgcn_s_setprio(1);
#pragma unroll
      for (int dt = 0; dt < 2; ++dt)
#pragma unroll
        for (int st = 0; st < 2; ++st) {
          const bf16_t* vp = cV + (dt * 32 + r) * VSTR + sub * 32 + st * 16 + 4 * hh;
          const s16x4 lo = *(const s16x4*)vp;
          const s16x4 hi = *(const s16x4*)(vp + 8);
          const bf16x8 vf = __builtin_shufflevector(lo, hi, 0, 1, 2, 3, 4, 5, 6, 7);
          oacc[dt] = MFMA(vf, pf[st], oacc[dt]);
        }
      __builtin_amdgcn_s_setprio(0);
    }
    if (more) { if (half == 0) ATT_SWRITE(y, 1) else ATT_SWRITE(x, 0) }
    if (!MLA) {
      int* flg = (int*)(smem + SMEM_BYTES - 128) + (it & 1) * 8;
      const bool wok = (__builtin_amdgcn_ballot_w64(carry >= 160.f) == ~0ull);
      if (lane == 0) flg[w] = wok ? 1 : 0;
      __syncthreads();
      alive = more && ((flg[0] & flg[1] & flg[2] & flg[3] & flg[4] & flg[5] & flg[6] & flg[7]) == 0);
    } else {
      __syncthreads();
      alive = more;
    }
    if (!alive) break;
   }
  }
#undef ATT_GLOAD
#undef ATT_SWRITE
#undef ATT_KT
  float inv = 1.f;
  if (MLA) { const float lt = half_sum(lrun); inv = 1.f / lt; }
  const int tok = tok0 + w * 32 + r;
  const bf16_t* zg = (MLA ? p.Zmla() : p.Zsb()) + (size_t)tok * 512 + h * 64;
  bf16_t* og = (MLA ? p.OBg() : p.OAg()) + (size_t)tok * 512 + h * 64;
#pragma unroll
  for (int dt = 0; dt < 2; ++dt)
#pragma unroll
    for (int g = 0; g < 4; ++g) {
      const int d = dt * 32 + 8 * g + 4 * hh;
      const u32x2 zz = *(const u32x2*)(zg + d);
      const float z0 = __uint_as_float(zz[0] << 16), z1 = __uint_as_float(zz[0] & 0xffff0000u);
      const float z2 = __uint_as_float(zz[1] << 16), z3 = __uint_as_float(zz[1] & 0xffff0000u);
      u32x2 o;
      o[0] = pk2(oacc[dt][4 * g] * inv * z0, oacc[dt][4 * g + 1] * inv * z1);
      o[1] = pk2(oacc[dt][4 * g + 2] * inv * z2, oacc[dt][4 * g + 3] * inv * z3);
      *(u32x2*)(og + d) = o;
    }
}

DI void phase_attn(const Params& p, char* smem, int cbase, int only) {
  int* s_item = (int*)(smem + SMEM_BYTES - 16);
  const int q0 = blockIdx.x & 7;
  int qi = 0;
  for (;;) {
    if (threadIdx.x == 0) {
      int item = -1;
      while (qi < 8) {
        const int q = (q0 + qi) & 7;
        const int idx = atomicAdd(p.counter() + cbase + q, 1);
        if (idx < 128) { item = q * 256 + idx; break; }
        ++qi;
      }
      *s_item = item;
    }
    __syncthreads();
    const int item = *s_item;
    __syncthreads();
    if (item < 0) break;
    const int q = item >> 8, idx = item & 255;
    const int i2 = idx & 63;
    const int bh = q + 8 * (i2 & 3);
    const int qb = 15 - (i2 >> 2);
    if (idx < 64) { if (only != 2) attn_item<true>(p, bh >> 3, bh & 7, qb, smem); }
    else { if (only != 1) attn_item<false>(p, bh >> 3, bh & 7, qb, smem); }
  }
}

DI void g3_epi_a(const Params& p, const float* sC, const int m0, const int n0) {
  const int txo = opaque_tid();
#pragma unroll
  for (int i = 0; i < 4; ++i) {
    const int c = txo + 512 * i, row = c >> 4, cc = (c & 15) * 8;
    const u32x4 g = *(const u32x4*)(p.GA() + (size_t)(m0 + row) * 1024 + n0 + cc);
    const float4 a = *(const float4*)(sC + row * CSTR + cc), b = *(const float4*)(sC + row * CSTR + cc + 4);
    u32x4 y;
    y[0] = pk2(a.x * __uint_as_float(g[0] << 16), a.y * __uint_as_float(g[0] & 0xffff0000u));
    y[1] = pk2(a.z * __uint_as_float(g[1] << 16), a.w * __uint_as_float(g[1] & 0xffff0000u));
    y[2] = pk2(b.x * __uint_as_float(g[2] << 16), b.y * __uint_as_float(g[2] & 0xffff0000u));
    y[3] = pk2(b.z * __uint_as_float(g[3] << 16), b.w * __uint_as_float(g[3] & 0xffff0000u));
    *(u32x4*)(p.MERGED() + (size_t)(m0 + row) * 1024 + n0 + cc) = y;
  }
}
DI void g3_epi_b(const Params& p, const float* sC, const int m0, const int n0) {
  const int txo2 = opaque_tid();
#pragma unroll
  for (int i = 0; i < 4; ++i) {
    const int c = txo2 + 512 * i, row = c >> 4, cc = (c & 15) * 8;
    const u32x4 g = *(const u32x4*)(p.GB() + (size_t)(m0 + row) * 1024 + n0 + cc);
    const u32x4 yv = *(const u32x4*)(p.MERGED() + (size_t)(m0 + row) * 1024 + n0 + cc);
    const float4 a = *(const float4*)(sC + row * CSTR + cc), b = *(const float4*)(sC + row * CSTR + cc + 4);
    u32x4 o;
    o[0] = pk2(__uint_as_float(yv[0] << 16) + a.x * __uint_as_float(g[0] << 16), __uint_as_float(yv[0] & 0xffff0000u) + a.y * __uint_as_float(g[0] & 0xffff0000u));
    o[1] = pk2(__uint_as_float(yv[1] << 16) + a.z * __uint_as_float(g[1] << 16), __uint_as_float(yv[1] & 0xffff0000u) + a.w * __uint_as_float(g[1] & 0xffff0000u));
    o[2] = pk2(__uint_as_float(yv[2] << 16) + b.x * __uint_as_float(g[2] << 16), __uint_as_float(yv[2] & 0xffff0000u) + b.y * __uint_as_float(g[2] & 0xffff0000u));
    o[3] = pk2(__uint_as_float(yv[3] << 16) + b.z * __uint_as_float(g[3] << 16), __uint_as_float(yv[3] & 0xffff0000u) + b.w * __uint_as_float(g[3] & 0xffff0000u));
    *(u32x4*)(p.MERGED() + (size_t)(m0 + row) * 1024 + n0 + cc) = o;
  }
}
DI void phase_g3(const Params& p, char* smem) {
  bf16_t* shm = (bf16_t*)smem;
  float* sC = (float*)smem;
  const int xq = blockIdx.x & 7, lb = blockIdx.x >> 3, nlb = gridDim.x >> 3;
  const bool xmap = (gridDim.x & 7) == 0;
  for (int t = xmap ? lb : (int)blockIdx.x; t < (xmap ? 32 : 256); t += (xmap ? nlb : (int)gridDim.x)) {
    const int rt = xmap ? (8 * xq + (t & 7)) : (t >> 2), ct = xmap ? (t >> 3) : (t & 3);
    const int m0 = rt * 256, n0 = ct * 256;
    f32x4 acc[2][2][4][2];
    zero_acc8(acc);
    gemm8_tile(p.OAg() + (size_t)m0 * 512, p.WaT() + (size_t)n0 * 512, 512, shm, acc);
#pragma unroll
    for (int ai = 0; ai < 2; ++ai)
#pragma unroll
      for (int bj = 0; bj < 2; ++bj) {
        __syncthreads();
        accq_to_lds(acc[ai][bj], sC);
        __syncthreads();
        g3_epi_a(p, sC, m0 + ai * 128, n0 + bj * 128);
      }
    __syncthreads();
    zero_acc8(acc);
    gemm8_tile(p.OBg() + (size_t)m0 * 512, p.WbT() + (size_t)n0 * 512, 512, shm, acc);
#pragma unroll
    for (int ai = 0; ai < 2; ++ai)
#pragma unroll
      for (int bj = 0; bj < 2; ++bj) {
        __syncthreads();
        accq_to_lds(acc[ai][bj], sC);
        __syncthreads();
        g3_epi_b(p, sC, m0 + ai * 128, n0 + bj * 128);
      }
    __syncthreads();
  }
}

DI void g4_epi(const Params& p, const float* sC, const float* gt, const int m0, const int n0) {
  const int txo = opaque_tid();
#pragma unroll
  for (int i = 0; i < 4; ++i) {
    const int c = txo + 512 * i, row = c >> 4, cc = (c & 15) * 8;
    const size_t go = (size_t)(m0 + row) * 1024 + n0 + cc;
    const float4 x0 = *(const float4*)(p.x + go), x1 = *(const float4*)(p.x + go + 4);
    const float4 a = *(const float4*)(sC + row * CSTR + cc), b = *(const float4*)(sC + row * CSTR + cc + 4);
    const float4 g0 = *(const float4*)(gt + cc), g1 = *(const float4*)(gt + cc + 4);
    float4 o0, o1;
    o0.x = x0.x + g0.x * a.x; o0.y = x0.y + g0.y * a.y; o0.z = x0.z + g0.z * a.z; o0.w = x0.w + g0.w * a.w;
    o1.x = x1.x + g1.x * b.x; o1.y = x1.y + g1.y * b.y; o1.z = x1.z + g1.z * b.z; o1.w = x1.w + g1.w * b.w;
    *(float4*)(p.out + go) = o0;
    *(float4*)(p.out + go + 4) = o1;
  }
}
DI void phase_g4(const Params& p, char* smem) {
  bf16_t* shm = (bf16_t*)smem;
  float* sC = (float*)smem;
  float* rs = (float*)(smem + 131072);
  const int xq = blockIdx.x & 7, lb = blockIdx.x >> 3, nlb = gridDim.x >> 3;
  const bool xmap = (gridDim.x & 7) == 0;
  for (int t = xmap ? lb : (int)blockIdx.x; t < (xmap ? 32 : 256); t += (xmap ? nlb : (int)gridDim.x)) {
    const int rt = xmap ? (8 * xq + (t & 7)) : (t >> 2), ct = xmap ? (t >> 3) : (t & 3);
    const int m0 = rt * 256, n0 = ct * 256;
    f32x4 acc[2][2][4][2];
    zero_acc8(acc);
    if (threadIdx.x < 256) rs[threadIdx.x] = mod_get(p.MOD(), m0 >> 12, 2048 + n0 + threadIdx.x);
    gemm8_tile(p.MERGED() + (size_t)m0 * 1024, p.WoT() + (size_t)n0 * 1024, 1024, shm, acc);
#pragma unroll
    for (int ai = 0; ai < 2; ++ai)
#pragma unroll
      for (int bj = 0; bj < 2; ++bj) {
        __syncthreads();
        accq_to_lds(acc[ai][bj], sC);
        __syncthreads();
        g4_epi(p, sC, rs + bj * 128, m0 + ai * 128, n0 + bj * 128);
      }
    __syncthreads();
  }
}

DI void phase_final(const Params& p) {
  const int lane = threadIdx.x & 63, w = threadIdx.x >> 6;
  const int gw = blockIdx.x * 8 + w, nw = gridDim.x * 8;
  for (int row = gw; row < NTOK; row += nw) {
    float* xr = p.out + (size_t)row * DM;
    float4 v[4];
    float ss = 0.f;
#pragma unroll
    for (int i = 0; i < 4; ++i) {
      v[i] = *(const float4*)(xr + 4 * (lane + 64 * i));
      ss += v[i].x * v[i].x + v[i].y * v[i].y + v[i].z * v[i].z + v[i].w * v[i].w;
    }
#pragma unroll
    for (int o = 32; o >= 1; o >>= 1) ss += __shfl_xor(ss, o);
    const float rn = __builtin_amdgcn_rsqf(ss * (1.f / DM) + EPSN);
#pragma unroll
    for (int i = 0; i < 4; ++i) {
      const int e = 4 * (lane + 64 * i);
      const float4 g = *(const float4*)(p.fgain + e);
      float4 o;
      o.x = v[i].x * rn * g.x; o.y = v[i].y * rn * g.y; o.z = v[i].z * rn * g.z; o.w = v[i].w * rn * g.w;
      *(float4*)(xr + e) = o;
    }
  }
}

template <int PH>
__global__ void __launch_bounds__(NTHREADS, 2) mega_kernel(Params p) {
  __shared__ __attribute__((aligned(16))) char smem[SMEM_BYTES];
  if (PH < 0) {
    if (p.ws == nullptr) cg::this_grid().sync();
    volatile LAS unsigned* xst = (volatile LAS unsigned*)(smem + SMEM_BYTES - 32);
    if (threadIdx.x == 0) { xst[0] = 0u; xst[1] = 0u; }
    __syncthreads();
    (void)xcd_barrier_post(p.bar(), xst);
    phase_prep(p, smem); xcd_barrier(p.bar(), (volatile LAS unsigned*)(smem + SMEM_BYTES - 32));
#if PROBE_DUP == 4
    phase_prep(p, smem); xcd_barrier(p.bar(), (volatile LAS unsigned*)(smem + SMEM_BYTES - 32));
#endif
    phase_h(p, smem); xcd_barrier(p.bar(), (volatile LAS unsigned*)(smem + SMEM_BYTES - 32));
#if PROBE_DUP == 5
    phase_h(p, smem); xcd_barrier(p.bar(), (volatile LAS unsigned*)(smem + SMEM_BYTES - 32));
#endif
    phase_g1(p, smem); xcd_barrier(p.bar(), (volatile LAS unsigned*)(smem + SMEM_BYTES - 32));
#if PROBE_DUP == 1
    phase_g1(p, smem, false); xcd_barrier(p.bar(), (volatile LAS unsigned*)(smem + SMEM_BYTES - 32));
#endif
    phase_g2(p, smem); xcd_barrier(p.bar(), (volatile LAS unsigned*)(smem + SMEM_BYTES - 32));
#if PROBE_DUP == 8
    phase_g2(p, smem); xcd_barrier(p.bar(), (volatile LAS unsigned*)(smem + SMEM_BYTES - 32));
#endif
    phase_attn(p, smem, 0, 0); xcd_barrier(p.bar(), (volatile LAS unsigned*)(smem + SMEM_BYTES - 32));
#if PROBE_DUP == 2
    phase_attn(p, smem, 8, 1); xcd_barrier(p.bar(), (volatile LAS unsigned*)(smem + SMEM_BYTES - 32));
#endif
#if PROBE_DUP == 3
    phase_attn(p, smem, 8, 2); xcd_barrier(p.bar(), (volatile LAS unsigned*)(smem + SMEM_BYTES - 32));
#endif
    phase_g3(p, smem); xcd_barrier(p.bar(), (volatile LAS unsigned*)(smem + SMEM_BYTES - 32));
#if PROBE_DUP == 6
    phase_g3(p, smem); xcd_barrier(p.bar(), (volatile LAS unsigned*)(smem + SMEM_BYTES - 32));
#endif
    phase_g4(p, smem); xcd_barrier(p.bar(), (volatile LAS unsigned*)(smem + SMEM_BYTES - 32));
#if PROBE_DUP == 7
    phase_g4(p, smem); xcd_barrier(p.bar(), (volatile LAS unsigned*)(smem + SMEM_BYTES - 32));
#endif
    phase_final(p);
  } else {
    if (PH == 0) phase_prep(p, smem);
    if (PH == 1) phase_h(p, smem);
    if (PH == 2) phase_g1(p, smem);
    if (PH == 3) phase_g2(p, smem);
    if (PH == 4) phase_attn(p, smem, 0, 0);
    if (PH == 5) phase_g3(p, smem);
    if (PH == 6) phase_g4(p, smem);
    if (PH == 7) phase_final(p);
  }
}

#ifndef PROBE_DUP
#define PROBE_DUP 0
#endif
#ifndef MK_SPLIT
#define MK_SPLIT 0
#endif

extern "C" void kernel_launch(void* const* d_in, const int* in_sizes, int n_in, void* d_out, int out_size, void* d_ws, size_t ws_size, hipStream_t stream) {
  Params p{};
  p.x = (const float*)d_in[0]; p.c = (const float*)d_in[1]; p.pos = (const int*)d_in[2];
  p.w_ada = (const float*)d_in[3]; p.b_ada = (const float*)d_in[4]; p.norm_gain = (const float*)d_in[5];
  p.w_in = (const float*)d_in[6]; p.q_gain = (const float*)d_in[7]; p.w_uq = (const float*)d_in[8];
  p.kv_gain = (const float*)d_in[9]; p.w_ukv = (const float*)d_in[10]; p.w_a = (const float*)d_in[11];
  p.w_b = (const float*)d_in[12]; p.w_out = (const float*)d_in[13]; p.fgain = (const float*)d_in[14];
  p.out = (float*)d_out;
  p.ws = (char*)d_ws;
  if (WS_NEED > ws_size) { fprintf(stderr, "workspace too small: need %zu have %zu\n", (size_t)WS_NEED, ws_size); return; }

  static int grid_blocks = 0;
  if (!grid_blocks) {
    int dev = 0, cus = 0, per_cu = 0;
    hipGetDevice(&dev);
    hipDeviceGetAttribute(&cus, hipDeviceAttributeMultiprocessorCount, dev);
    hipOccupancyMaxActiveBlocksPerMultiprocessor(&per_cu, mega_kernel<-1>, NTHREADS, 0);
    per_cu = 1;
    grid_blocks = cus * per_cu;
  }
#if MK_SPLIT
  mega_kernel<0><<<grid_blocks, NTHREADS, 0, stream>>>(p);
  mega_kernel<1><<<grid_blocks, NTHREADS, 0, stream>>>(p);
  mega_kernel<2><<<grid_blocks, NTHREADS, 0, stream>>>(p);
  mega_kernel<3><<<grid_blocks, NTHREADS, 0, stream>>>(p);
  mega_kernel<4><<<grid_blocks, NTHREADS, 0, stream>>>(p);
  mega_kernel<5><<<grid_blocks, NTHREADS, 0, stream>>>(p);
  mega_kernel<6><<<grid_blocks, NTHREADS, 0, stream>>>(p);
  mega_kernel<7><<<grid_blocks, NTHREADS, 0, stream>>>(p);
#else
  hipMemsetAsync((char*)d_ws + OFF_bar, 0, XCD_BAR_WORDS * 4, stream);
  void* args[] = {&p};
  hipError_t e = hipLaunchCooperativeKernel((void*)mega_kernel<-1>, dim3(grid_blocks), dim3(NTHREADS), args, 0, stream);
  if (e != hipSuccess) fprintf(stderr, "cooperative launch failed: %s (grid %d)\n", hipGetErrorString(e), grid_blocks);
#endif
}
```

```cpp
#include <hip/hip_runtime.h>
#include <hip/hip_cooperative_groups.h>
#include <stdint.h>
#include <stdio.h>
namespace cg = cooperative_groups;
#ifndef PROBE_DUP
#define PROBE_DUP 0
#endif

#define DI __device__ __forceinline__
typedef unsigned short bf16_t;
typedef __attribute__((ext_vector_type(8))) short bf16x8;
typedef __attribute__((ext_vector_type(4))) short s16x4;
typedef __attribute__((ext_vector_type(16))) float f32x16;
typedef __attribute__((ext_vector_type(2))) float f32x2;
typedef __attribute__((ext_vector_type(2))) __bf16 bf16x2v;
typedef __attribute__((ext_vector_type(4))) unsigned u32x4;
typedef __attribute__((ext_vector_type(2))) unsigned u32x2;
typedef __attribute__((ext_vector_type(4))) float f32x4;
#define MFMA(a, b, c) __builtin_amdgcn_mfma_f32_32x32x16_bf16((a), (b), (c), 0, 0, 0)

constexpr int NTOK = 16384, SEQL = 4096, DM = 1024;
constexpr int INW = 5280, INWP = 5376;
constexpr int NTHREADS = 512;
constexpr float LOG2E = 1.4426950408889634f;
constexpr float QS_SCALE = 0.125f * 1.4426950408889634f;
constexpr float QM_SCALE = 1.4426950408889634f / 9.797958971132712f;
constexpr float EPSN = 1e-6f;

constexpr int XCD_BAR_WORDS_C = 3456;
constexpr size_t al256(size_t v) { return (v + 255) & ~(size_t)255; }
constexpr size_t OFF_counter = 0;
constexpr size_t OFF_bar = OFF_counter + al256(256);
constexpr size_t OFF_MOD = OFF_bar + al256(XCD_BAR_WORDS_C * 4);
constexpr size_t OFF_ROPE = OFF_MOD + al256(4 * 3072 * 4 * 4);
constexpr size_t OFF_SSQ = OFF_ROPE + al256((size_t)NTOK * 32 * 4);
constexpr size_t OFF_Hb = OFF_SSQ + al256((size_t)2 * NTOK * 4);
constexpr size_t OFF_Qmla = OFF_Hb + al256((size_t)NTOK * 1024 * 2);
constexpr size_t OFF_WuqT = OFF_Qmla + al256((size_t)NTOK * 768 * 2);
constexpr size_t OFF_WukvT = OFF_WuqT + al256((size_t)768 * 384 * 2);
constexpr size_t OFF_WaT = OFF_WukvT + al256((size_t)1024 * 256 * 2);
constexpr size_t OFF_WbT = OFF_WaT + al256((size_t)1024 * 512 * 2);
constexpr size_t OFF_WoT = OFF_WbT + al256((size_t)1024 * 512 * 2);
constexpr size_t OFF_Qsb = OFF_WoT + al256((size_t)1024 * 1024 * 2);
constexpr size_t OFF_Ksb = OFF_Qsb + al256((size_t)NTOK * 512 * 2);
constexpr size_t OFF_VTsb = OFF_Ksb + al256((size_t)NTOK * 512 * 2);
constexpr size_t OFF_Zsb = OFF_VTsb + al256((size_t)NTOK * 512 * 2);
constexpr size_t OFF_OAg = OFF_Zsb + al256((size_t)NTOK * 512 * 2);
constexpr size_t OFF_OBg = OFF_OAg + al256((size_t)NTOK * 512 * 2);
constexpr size_t OFF_Zmla = OFF_OBg + al256((size_t)NTOK * 512 * 2);
constexpr size_t OFF_KPE = OFF_Zmla + al256((size_t)NTOK * 512 * 2);
constexpr size_t OFF_Knope = OFF_KPE + al256((size_t)NTOK * 32 * 2);
constexpr size_t OFF_VTmla = OFF_Knope + al256((size_t)NTOK * 512 * 2);
constexpr size_t OFF_WinT = OFF_VTmla + al256((size_t)NTOK * 512 * 2);
constexpr size_t WS_NEED = OFF_WinT + al256((size_t)INWP * 1024 * 2);
struct Params {
  const float *x, *c; const int* pos;
  const float *w_ada, *b_ada, *norm_gain, *w_in, *q_gain, *w_uq, *kv_gain, *w_ukv, *w_a, *w_b, *w_out, *fgain;
  float* out;
  char* ws;
  DI int* counter() const { return (int*)(ws + OFF_counter); }
  DI unsigned* bar() const { return (unsigned*)(ws + OFF_bar); }
  DI float* MOD() const { return (float*)(ws + OFF_MOD); }
  DI float* ROPE() const { return (float*)(ws + OFF_ROPE); }
  DI float* SSQ() const { return (float*)(ws + OFF_SSQ); }
  DI bf16_t* Hb() const { return (bf16_t*)(ws + OFF_Hb); }
  DI bf16_t* Qmla() const { return (bf16_t*)(ws + OFF_Qmla); }
  DI bf16_t* WuqT() const { return (bf16_t*)(ws + OFF_WuqT); }
  DI bf16_t* WukvT() const { return (bf16_t*)(ws + OFF_WukvT); }
  DI bf16_t* WaT() const { return (bf16_t*)(ws + OFF_WaT); }
  DI bf16_t* WbT() const { return (bf16_t*)(ws + OFF_WbT); }
  DI bf16_t* WoT() const { return (bf16_t*)(ws + OFF_WoT); }
  DI bf16_t* Qsb() const { return (bf16_t*)(ws + OFF_Qsb); }
  DI bf16_t* Ksb() const { return (bf16_t*)(ws + OFF_Ksb); }
  DI bf16_t* VTsb() const { return (bf16_t*)(ws + OFF_VTsb); }
  DI bf16_t* Zsb() const { return (bf16_t*)(ws + OFF_Zsb); }
  DI bf16_t* OAg() const { return (bf16_t*)(ws + OFF_OAg); }
  DI bf16_t* OBg() const { return (bf16_t*)(ws + OFF_OBg); }
  DI bf16_t* Zmla() const { return (bf16_t*)(ws + OFF_Zmla); }
  DI bf16_t* KPE() const { return (bf16_t*)(ws + OFF_KPE); }
  DI bf16_t* Knope() const { return (bf16_t*)(ws + OFF_Knope); }
  DI bf16_t* VTmla() const { return (bf16_t*)(ws + OFF_VTmla); }
  DI bf16_t* MERGED() const { return Hb(); }
  DI bf16_t* WinT() const { return (bf16_t*)(ws + OFF_WinT); }
  DI bf16_t* CQ() const { return OAg(); }
  DI bf16_t* CKV() const { return OBg(); }
  DI bf16_t* GA() const { return (bf16_t*)out; }
  DI bf16_t* GB() const { return (bf16_t*)out + (size_t)NTOK * 1024; }
};


__device__ const float c_invfreq[16] = {
  1.0f, 0.5623413251903491f, 0.31622776601683794f, 0.1778279410038923f, 0.1f, 0.05623413251903491f, 0.03162277660168379f,
  0.01778279410038923f, 0.01f, 0.005623413251903491f, 0.0031622776601683794f, 0.001778279410038923f, 0.001f,
  0.0005623413251903491f, 0.00031622776601683794f, 0.0001778279410038923f};

DI unsigned pk2(float a, float b) { f32x2 v = {a, b}; bf16x2v r = __builtin_convertvector(v, bf16x2v); return __builtin_bit_cast(unsigned, r); }
DI bf16_t tobf(float a) { return (bf16_t)(pk2(a, 0.f) & 0xffffu); }
DI float bf2f(unsigned short u) { return __uint_as_float(((unsigned)u) << 16); }
DI bf16x8 pack8(float a0, float a1, float a2, float a3, float a4, float a5, float a6, float a7) {
  u32x4 p; p[0] = pk2(a0, a1); p[1] = pk2(a2, a3); p[2] = pk2(a4, a5); p[3] = pk2(a6, a7);
  return __builtin_bit_cast(bf16x8, p);
}
DI int crow(int reg, int h) { return (reg & 3) + 8 * (reg >> 2) + 4 * h; }
DI int opaque_tid() { int t = threadIdx.x; asm volatile("" : "+v"(t)); return t; }
DI float half_max(float v) {
  unsigned u = __float_as_uint(v);
  auto r = __builtin_amdgcn_permlane32_swap(u, u, false, false);
  return fmaxf(__uint_as_float(r[0]), __uint_as_float(r[1]));
}
DI float half_sum(float v) {
  unsigned u = __float_as_uint(v);
  auto r = __builtin_amdgcn_permlane32_swap(u, u, false, false);
  return __uint_as_float(r[0]) + __uint_as_float(r[1]);
}
DI float sigmoidf_fast(float v) { return __builtin_amdgcn_rcpf(1.f + __builtin_amdgcn_exp2f(-v * LOG2E)); }
DI float siluf_fast(float v) { return v * sigmoidf_fast(v); }

#define XB_TMO      128
#define XB_XCNT(j)  (256  + 64 * (j))
#define XB_XSUB(j)  (1280 + 64 * (j))
#define XB_XGEN(j)  (2304 + 64 * (j))
#define XB_TOP      3328
#define XB_TOPGEN   3392
#define XCD_BAR_WORDS 3456
#define XB_SPIN_CAP (1u << 18)
#define LAS __attribute__((address_space(3)))
DI unsigned xb_ld(unsigned* p)              { return __hip_atomic_load(p, __ATOMIC_RELAXED, __HIP_MEMORY_SCOPE_AGENT); }
DI unsigned xb_add(unsigned* p, unsigned v) { return __hip_atomic_fetch_add(p, v, __ATOMIC_RELAXED, __HIP_MEMORY_SCOPE_AGENT); }
DI unsigned xb_xcc_id() { return (unsigned)__builtin_amdgcn_s_getreg((3 << 11) | 20) & 0xFu; }
#define XB_SPIN(cond, bar) do { unsigned _sp = 0; while (cond) { __builtin_amdgcn_s_sleep(1); \
    if ((++_sp & 255u) == 0u) { if (xb_ld(&(bar)[XB_TMO])) break; if (_sp > XB_SPIN_CAP) { atomicAdd(&(bar)[XB_TMO], 1u); break; } } } } while (0)
struct XcdBarrier { unsigned* bar; unsigned x; volatile LAS unsigned* st; };
DI XcdBarrier xcd_barrier_post(unsigned* bar, volatile LAS unsigned* st) {
  XcdBarrier b; b.bar = bar; b.x = xb_xcc_id(); b.st = st;
  if (threadIdx.x == 0) (void)xb_add(&bar[XB_XCNT(b.x)], 1u);
  return b;
}
DI void xcd_barrier_complete(unsigned* bar, unsigned x, unsigned& nloc, unsigned& nx) {
  const unsigned G = gridDim.x * gridDim.y * gridDim.z;
  unsigned sum, cnt, mine, sp = 0u;
  for (;;) {
    sum = 0u; cnt = 0u; mine = 0u;
#pragma unroll
    for (unsigned j = 0; j < 16; ++j) { const unsigned c = xb_ld(&bar[XB_XCNT(j)]); sum += c; cnt += (c > 0u) ? 1u : 0u; mine = (j == x) ? c : mine; }
    if (sum == G) break;
    __builtin_amdgcn_s_sleep(1);
    if ((++sp & 255u) == 0u) { if (xb_ld(&bar[XB_TMO])) break; if (sp > XB_SPIN_CAP) { atomicAdd(&bar[XB_TMO], 1u); break; } }
  }
  nloc = mine > 0u ? mine : 1u; nx = cnt > 0u ? cnt : 1u;
}
DI void xcd_barrier(unsigned* bar_, volatile LAS unsigned* st_) {
  XcdBarrier b; b.bar = bar_; b.st = st_; b.x = 0;
  asm volatile("s_waitcnt vmcnt(0)" ::: "memory");
  __syncthreads();
  if (threadIdx.x == 0) {
    unsigned* bar = b.bar;
    b.x = xb_xcc_id();
    __builtin_amdgcn_s_waitcnt(0);
    unsigned nloc = b.st[0], nx = b.st[1];
    if (nloc == 0u) { xcd_barrier_complete(bar, b.x, nloc, nx); b.st[0] = nloc; b.st[1] = nx; }
    const unsigned old = xb_add(&bar[XB_XSUB(b.x)], 1u);
    const unsigned gen = old / nloc;
    if (old + 1u == (gen + 1u) * nloc) {
      __builtin_amdgcn_fence(__ATOMIC_RELEASE, "agent");
      asm volatile("s_waitcnt vmcnt(0)" ::: "memory");
      const unsigned og = xb_add(&bar[XB_TOP], 1u);
      const unsigned tg = og / nx;
      if (og + 1u == (tg + 1u) * nx) xb_add(&bar[XB_TOPGEN], 1u);
      else XB_SPIN(xb_ld(&bar[XB_TOPGEN]) == tg, bar);
      __builtin_amdgcn_fence(__ATOMIC_ACQUIRE, "agent");
      xb_add(&bar[XB_XGEN(b.x)], 1u);
      asm volatile("s_waitcnt vmcnt(0)" ::: "memory");
    } else {
      XB_SPIN(xb_ld(&bar[XB_XGEN(b.x)]) == gen, bar);
      __builtin_amdgcn_fence(__ATOMIC_ACQUIRE, "agent");
      asm volatile("s_waitcnt vmcnt(0)" ::: "memory");
    }
  }
  __syncthreads();
}

constexpr int GSTR = 72;
constexpr int GBUF = 128 * GSTR;
constexpr int SMEM_BYTES = 131072 + 4096;

constexpr int G8_HT = 128 * 64;
DI int lds_byte(int r, int c) { const int st = (r >> 4) * 2 + (c >> 5), rr = r & 15, cc = c & 31, ob = rr * 64 + cc * 2; return st * 1024 + (ob ^ (((ob >> 9) & 1) << 5)); }
DI void stage_rc(int b, int& R, int& C) { const int st = b / 1024, sb = b % 1024, swz = sb ^ (((sb >> 9) & 1) << 5); R = (st >> 1) * 16 + swz / 64; C = (st & 1) * 32 + (swz % 64) / 2; }

DI void gemm8_tile(const bf16_t* __restrict__ A, const bf16_t* __restrict__ Bt, const int K, bf16_t* shm, f32x4 (&acc)[2][2][4][2]) {
  const int tid = opaque_tid();
  const int wid = tid >> 6, lane = tid & 63, wr = wid >> 2, wc = wid & 3, fr = lane & 15, fq = lane >> 4;
  const int swz = (fr * 64 + fq * 16) ^ ((fr >> 3) << 5);
  const char* aRd = (const char*)shm + swz + wr * 8192;
  const char* bRd = (const char*)shm + 65536 + swz + wc * 4096;
  int sr0, sc0, sr1, sc1;
  stage_rc(tid * 16, sr0, sc0);
  stage_rc(tid * 16 + 8192, sr1, sc1);
  const unsigned so0 = (unsigned)(sr0 * K + sc0) * 2u, so1 = (unsigned)(sr1 * K + sc1) * 2u;
  char* const stw = (char*)shm + __builtin_amdgcn_readfirstlane(tid & ~63) * 16;
  const char* const Ab = (const char*)A;
  const char* const Bb = (const char*)Bt;
#define SA(b, h) (((b) * 2 + (h)) * 16384)
#define SB(b, h) ((4 + (b) * 2 + (h)) * 16384)
#define STAGE(P, BASE, br, kt) do { const char* g_ = (BASE) + ((long)(br) * K + (long)(kt) * 64) * 2;                        \
    __builtin_amdgcn_global_load_lds((const unsigned*)(g_ + so0), (unsigned*)(stw + (P)), 16, 0, 0);                          \
    __builtin_amdgcn_global_load_lds((const unsigned*)(g_ + so1), (unsigned*)(stw + (P) + 8192), 16, 0, 0); } while (0)
#define LDA(dst, b, h) _Pragma("unroll") for (int m = 0; m < 4; ++m) _Pragma("unroll") for (int k = 0; k < 2; ++k) \
    dst[m][k] = *reinterpret_cast<const bf16x8*>(aRd + ((b) * 2 + (h)) * 16384 + (m * 2 + k) * 1024)
#define LDB(dst, b, h) _Pragma("unroll") for (int n = 0; n < 2; ++n) _Pragma("unroll") for (int k = 0; k < 2; ++k) \
    dst[n][k] = *reinterpret_cast<const bf16x8*>(bRd + ((b) * 2 + (h)) * 16384 + (n * 2 + k) * 1024)
#define MMA(ai, bj, At_, Bt_) do { __builtin_amdgcn_s_setprio(1);                                                          \
    _Pragma("unroll") for (int m = 0; m < 4; ++m) _Pragma("unroll") for (int n = 0; n < 2; ++n) _Pragma("unroll") for (int k = 0; k < 2; ++k) \
      acc[ai][bj][m][n] = __builtin_amdgcn_mfma_f32_16x16x32_bf16(At_[m][k], Bt_[n][k], acc[ai][bj][m][n], 0, 0, 0);       \
    __builtin_amdgcn_s_setprio(0); } while (0)
#define WAIT_V(n) asm volatile("s_waitcnt vmcnt(" #n ")" ::: "memory")
#define WAIT_L(n) asm volatile("s_waitcnt lgkmcnt(" #n ")" ::: "memory")
#define BAR __builtin_amdgcn_s_barrier()
#define SCHED __builtin_amdgcn_sched_barrier(0)
  bf16x8 At[4][2], B0[2][2], B1[2][2];
  const int nt = K / 64;
  WAIT_V(0);
  STAGE(SB(0, 0), Bb, 0, 0); STAGE(SA(0, 0), Ab, 0, 0);
  STAGE(SB(0, 1), Bb, 128, 0); STAGE(SA(0, 1), Ab, 128, 0);
  if (wr == 1) BAR;
  WAIT_V(4); BAR;
  STAGE(SB(1, 0), Bb, 0, 1); STAGE(SA(1, 0), Ab, 0, 1); STAGE(SB(1, 1), Bb, 128, 1);
  WAIT_V(6); BAR;
  for (int t = 0; t < nt - 2; t += 2) {
    LDB(B0, 0, 0); SCHED; LDA(At, 0, 0); STAGE(SA(1, 1), Ab, 128, t + 1);
    WAIT_L(8); BAR; WAIT_L(0); MMA(0, 0, At, B0); BAR; SCHED;
    LDB(B1, 0, 1); STAGE(SB(0, 0), Bb, 0, t + 2);
    BAR; WAIT_L(0); MMA(0, 1, At, B1); BAR;
    LDA(At, 0, 1); STAGE(SA(0, 0), Ab, 0, t + 2);
    BAR; WAIT_L(0); MMA(1, 0, At, B0); BAR; SCHED;
    STAGE(SB(0, 1), Bb, 128, t + 2);
    WAIT_V(6); BAR; MMA(1, 1, At, B1); BAR;
    LDB(B0, 1, 0); SCHED; LDA(At, 1, 0); STAGE(SA(0, 1), Ab, 128, t + 2);
    WAIT_L(8); BAR; WAIT_L(0); MMA(0, 0, At, B0); BAR; SCHED;
    LDB(B1, 1, 1); STAGE(SB(1, 0), Bb, 0, t + 3);
    BAR; WAIT_L(0); MMA(0, 1, At, B1); BAR;
    LDA(At, 1, 1); STAGE(SA(1, 0), Ab, 0, t + 3);
    BAR; WAIT_L(0); MMA(1, 0, At, B0); BAR; SCHED;
    STAGE(SB(1, 1), Bb, 128, t + 3);
    WAIT_V(6); BAR; MMA(1, 1, At, B1); BAR;
  }
  { LDB(B0, 0, 0); LDA(At, 0, 0); STAGE(SA(1, 1), Ab, 128, nt - 1);
    BAR; WAIT_L(0); MMA(0, 0, At, B0); BAR;
    LDB(B1, 0, 1); BAR; WAIT_L(0); MMA(0, 1, At, B1); BAR;
    LDA(At, 0, 1); WAIT_V(4); BAR; WAIT_L(0); MMA(1, 0, At, B0); MMA(1, 1, At, B1); BAR; }
  { LDB(B0, 1, 0); LDA(At, 1, 0); WAIT_V(2); BAR; WAIT_L(0); MMA(0, 0, At, B0); BAR;
    LDB(B1, 1, 1); WAIT_V(0); BAR; WAIT_L(0); MMA(0, 1, At, B1); BAR;
    LDA(At, 1, 1); BAR; WAIT_L(0); MMA(1, 0, At, B0); MMA(1, 1, At, B1); BAR; }
  if (wr == 0) BAR;
#undef SA
#undef SB
#undef STAGE
#undef LDA
#undef LDB
#undef MMA
#undef WAIT_V
#undef WAIT_L
#undef BAR
#undef SCHED
}


DI void zero_acc8(f32x4 (&acc)[2][2][4][2]) {
#pragma unroll
  for (int a = 0; a < 2; ++a)
#pragma unroll
    for (int b = 0; b < 2; ++b)
#pragma unroll
      for (int m = 0; m < 4; ++m)
#pragma unroll
        for (int n = 0; n < 2; ++n) acc[a][b][m][n] = f32x4{0.f, 0.f, 0.f, 0.f};
}

constexpr int CSTR = 132;
DI void accq_to_lds(const f32x4 (&q)[4][2], float* sC) {
  const int tid = opaque_tid(), wid = tid >> 6, lane = tid & 63, wr = wid >> 2, wc = wid & 3, fr = lane & 15, fq = lane >> 4;
#pragma unroll
  for (int m = 0; m < 4; ++m)
#pragma unroll
    for (int n = 0; n < 2; ++n)
#pragma unroll
      for (int j = 0; j < 4; ++j) sC[(wr * 64 + m * 16 + fq * 4 + j) * CSTR + wc * 32 + n * 16 + fr] = q[m][n][j];
}
template <class F>
DI void epi_rows(const float* sC, F f) {
  const int tx = opaque_tid();
#pragma unroll
  for (int i = 0; i < 4; ++i) {
    const int c = tx + 512 * i, row = c >> 4, cc = (c & 15) * 8;
    const float4 a = *(const float4*)(sC + row * CSTR + cc), b = *(const float4*)(sC + row * CSTR + cc + 4);
    const float v[8] = {a.x, a.y, a.z, a.w, b.x, b.y, b.z, b.w};
    f(i, row, cc, v);
  }
}
DI void store8(bf16_t* p, const float (&v)[8]) { *(bf16x8*)p = pack8(v[0], v[1], v[2], v[3], v[4], v[5], v[6], v[7]); }
DI void epi_vt(const float* sC, bf16_t* VT, int m0, int head0, int c0, int ncol_log2) {
  const int b = m0 >> 12, s0 = m0 & 4095;
  const int nitems = 16 << ncol_log2;
  for (int c = opaque_tid(); c < nitems; c += 512) {
    const int col = c & ((1 << ncol_log2) - 1), rc = c >> ncol_log2;
    float v[8];
#pragma unroll
    for (int j = 0; j < 8; ++j) v[j] = sC[(rc * 8 + j) * CSTR + c0 + col];
    const int head = head0 + (col >> 6), d = col & 63;
    store8(VT + ((size_t)((b * 8 + head) * 64 + d)) * SEQL + s0 + rc * 8, v);
  }
}
DI void rope8(const float* sC, const float* ROPE, int tok, int row, int cc, float (&v)[8]) {
  const float* pr = sC + row * CSTR + (cc ^ 16);
  const bool upper = (cc & 16) != 0;
  const int f0 = cc & 15;
  const float* tb = ROPE + (size_t)tok * 32;
#pragma unroll
  for (int j = 0; j < 8; ++j) {
    const float o = pr[j], cs = tb[f0 + j], sn = tb[16 + f0 + j];
    v[j] = upper ? (o * sn + v[j] * cs) : (v[j] * cs - o * sn);
  }
}

DI void wconv_unit(const float* __restrict__ src, int Nsrc, int K, bf16_t* __restrict__ dst, const float* __restrict__ gain, int ng, int kg, int mode, float* tile, const int tid) {
  {
    const int k = tid >> 2, cq = tid & 3;
    const int n = ng * 64 + cq * 16;
    int sc = n;
    if (mode == 1) { sc = (n < 2688) ? n : (n < 5248 ? n + 32 : (n < 5280 ? n - 2560 : -1)); }
    const int kk = kg * 64 + k;
    float4 v[4];
    if (sc >= 0) {
      const float* sp = src + (size_t)kk * Nsrc + sc;
#pragma unroll
      for (int i = 0; i < 4; ++i) v[i] = *(const float4*)(sp + 4 * i);
      if (gain) { const float g = gain[kk];
#pragma unroll
        for (int i = 0; i < 4; ++i) { v[i].x *= g; v[i].y *= g; v[i].z *= g; v[i].w *= g; } }
    } else {
#pragma unroll
      for (int i = 0; i < 4; ++i) v[i] = make_float4(0.f, 0.f, 0.f, 0.f);
    }
    float* tp = tile + k * 65 + cq * 16;
#pragma unroll
    for (int i = 0; i < 4; ++i) { tp[4 * i] = v[i].x; tp[4 * i + 1] = v[i].y; tp[4 * i + 2] = v[i].z; tp[4 * i + 3] = v[i].w; }
  }
  __syncthreads();
  {
    const int n = tid >> 2, kc = tid & 3;
    float o[16];
#pragma unroll
    for (int j = 0; j < 16; ++j) o[j] = tile[(kc * 16 + j) * 65 + n];
    bf16_t* dp = dst + (size_t)(ng * 64 + n) * K + kg * 64 + kc * 16;
    *(bf16x8*)dp = pack8(o[0], o[1], o[2], o[3], o[4], o[5], o[6], o[7]);
    *(bf16x8*)(dp + 8) = pack8(o[8], o[9], o[10], o[11], o[12], o[13], o[14], o[15]);
  }
  __syncthreads();
}

DI void phase_prep(const Params& p, char* smem) {
  if (blockIdx.x == 0 && threadIdx.x < 16) { p.counter()[threadIdx.x] = 0; }
  for (int i = blockIdx.x * NTHREADS + threadIdx.x; i < 2 * NTOK; i += gridDim.x * NTHREADS) p.SSQ()[i] = 0.f;
  const int half = threadIdx.x >> 8, tid = threadIdx.x & 255;
  constexpr int U_MOD = 96 * 4, U_WIN = 84 * 16, U_WUQ = 12 * 6, U_WUKV = 16 * 4, U_WA = 16 * 8, U_WB = 16 * 8, U_WO = 16 * 16, U_ROPE = 1024;
  constexpr int U_TOTAL = U_MOD + U_ROPE + U_WIN + U_WUQ + U_WUKV + U_WA + U_WB + U_WO;
  float* tile = (float*)smem + half * (64 * 65 + 64);
  for (int up = blockIdx.x; up < U_TOTAL / 2; up += gridDim.x) {
    int v = 2 * up + half;
    if (v < U_MOD) {
      const int cg32 = v >> 2, kq = v & 3, n0 = cg32 * 32;
      const int kgp = tid >> 5, col = tid & 31;
      const int kb = kq * 256 + kgp * 32;
      float a0 = 0.f, a1 = 0.f, a2 = 0.f, a3 = 0.f;
      const float* wp = p.w_ada + (size_t)kb * 3072 + n0 + col;
      float wv[32];
#pragma unroll
      for (int kk = 0; kk < 32; ++kk) wv[kk] = wp[(size_t)kk * 3072];
#pragma unroll
      for (int kk = 0; kk < 32; ++kk) {
        a0 += wv[kk] * p.c[kb + kk]; a1 += wv[kk] * p.c[1024 + kb + kk]; a2 += wv[kk] * p.c[2048 + kb + kk]; a3 += wv[kk] * p.c[3072 + kb + kk];
      }
      float* red = (float*)smem + half * 1024;
      red[(kgp * 4 + 0) * 32 + col] = a0; red[(kgp * 4 + 1) * 32 + col] = a1; red[(kgp * 4 + 2) * 32 + col] = a2; red[(kgp * 4 + 3) * 32 + col] = a3;
      __syncthreads();
      if (tid < 128) {
        const int b = tid >> 5, cc = tid & 31;
        float s = (kq == 0) ? p.b_ada[n0 + cc] : 0.f;
#pragma unroll
        for (int g = 0; g < 8; ++g) s += red[(g * 4 + b) * 32 + cc];
        p.MOD()[(size_t)(b * 3072 + n0 + cc) * 4 + kq] = s;
      }
      __syncthreads();
      continue;
    }
    v -= U_MOD;
    if (v < U_WIN) { wconv_unit(p.w_in, INW, 1024, p.WinT(), nullptr, v >> 4, v & 15, 1, tile, tid); continue; }
    v -= U_WIN;
    if (v < U_WUQ) { wconv_unit(p.w_uq, 768, 384, p.WuqT(), p.q_gain, v / 6, v % 6, 0, tile, tid); continue; }
    v -= U_WUQ;
    if (v < U_WUKV) { wconv_unit(p.w_ukv, 1024, 256, p.WukvT(), p.kv_gain, v >> 2, v & 3, 0, tile, tid); continue; }
    v -= U_WUKV;
    if (v < U_WA) { wconv_unit(p.w_a, 1024, 512, p.WaT(), nullptr, v >> 3, v & 7, 0, tile, tid); continue; }
    v -= U_WA;
    if (v < U_WB) { wconv_unit(p.w_b, 1024, 512, p.WbT(), nullptr, v >> 3, v & 7, 0, tile, tid); continue; }
    v -= U_WB;
    if (v < U_WO) { wconv_unit(p.w_out, 1024, 1024, p.WoT(), nullptr, v >> 4, v & 15, 0, tile, tid); continue; }
    v -= U_WO;
    {
      const int idx = v * 256 + tid, tok = idx >> 4, i = idx & 15;
      const float ang = (float)p.pos[tok] * c_invfreq[i];
      double t = (double)ang * 0.15915494309189535;
      t -= rint(t);
      const float tf = (float)t;
      p.ROPE()[(size_t)tok * 32 + i] = __builtin_amdgcn_cosf(tf);
      p.ROPE()[(size_t)tok * 32 + 16 + i] = __builtin_amdgcn_sinf(tf);
    }
  }
}

DI float mod_get(const float* MOD, int b, int n) { const float4 q = *(const float4*)(MOD + (size_t)(b * 3072 + n) * 4); return (q.x + q.y) + (q.z + q.w); }

DI void phase_h(const Params& p, char* smem) {
  const int tid = opaque_tid(), lane = tid & 63, w = tid >> 6;
  float* gs = (float*)smem;
  float* sh = gs + 1024;
  const int xq = blockIdx.x & 7, lb = blockIdx.x >> 3, nlb = gridDim.x >> 3;
  const bool xmap = (gridDim.x & 7) == 0;
  for (int rgi = xmap ? lb : (int)blockIdx.x; rgi < (xmap ? 32 : NTOK / 64); rgi += (xmap ? nlb : (int)gridDim.x)) {
    const int rg = xmap ? (32 * xq + rgi) : rgi;
    const int b = (rg * 64) >> 12;
    __syncthreads();
#pragma unroll
    for (int i = 0; i < 2; ++i) {
      const int k = tid + 512 * i;
      gs[k] = p.norm_gain[k] * (1.f + mod_get(p.MOD(), b, 1024 + k));
      sh[k] = mod_get(p.MOD(), b, k);
    }
    __syncthreads();
#pragma unroll 2
    for (int rr = 0; rr < 8; ++rr) {
      const int row = rg * 64 + w * 8 + rr;
      const float* xr = p.x + (size_t)row * DM;
      float4 v[4];
      float ss = 0.f;
#pragma unroll
      for (int i = 0; i < 2; ++i) {
        const int e = 8 * (lane + 64 * i);
        v[2 * i] = *(const float4*)(xr + e);
        v[2 * i + 1] = *(const float4*)(xr + e + 4);
        ss += v[2 * i].x * v[2 * i].x + v[2 * i].y * v[2 * i].y + v[2 * i].z * v[2 * i].z + v[2 * i].w * v[2 * i].w;
        ss += v[2 * i + 1].x * v[2 * i + 1].x + v[2 * i + 1].y * v[2 * i + 1].y + v[2 * i + 1].z * v[2 * i + 1].z + v[2 * i + 1].w * v[2 * i + 1].w;
      }
#pragma unroll
      for (int o = 32; o >= 1; o >>= 1) ss += __shfl_xor(ss, o);
      const float rn = __builtin_amdgcn_rsqf(ss * (1.f / DM) + EPSN);
#pragma unroll
      for (int i = 0; i < 2; ++i) {
        const int e = 8 * (lane + 64 * i);
        const float4 g0 = *(const float4*)(gs + e), g1 = *(const float4*)(gs + e + 4);
        const float4 s0 = *(const float4*)(sh + e), s1 = *(const float4*)(sh + e + 4);
        *(bf16x8*)(p.Hb() + (size_t)row * DM + e) =
            pack8(v[2 * i].x * rn * g0.x + s0.x, v[2 * i].y * rn * g0.y + s0.y, v[2 * i].z * rn * g0.z + s0.z, v[2 * i].w * rn * g0.w + s0.w,
                  v[2 * i + 1].x * rn * g1.x + s1.x, v[2 * i + 1].y * rn * g1.y + s1.y, v[2 * i + 1].z * rn * g1.z + s1.z, v[2 * i + 1].w * rn * g1.w + s1.w);
      }
    }
  }
  __syncthreads();
}

DI void g1_epi(const Params& p, const float* sC, const int m0, const int n0, const int ct, const bool do_ssq) {
    if (ct < 4) {
      epi_rows(sC, [&](int, int row, int cc, const float (&v)[8]) {
        float o[8];
#pragma unroll
        for (int j = 0; j < 8; ++j) o[j] = v[j] * QS_SCALE;
        store8(p.Qsb() + (size_t)(m0 + row) * 512 + n0 + cc, o); });
    } else if (ct < 8) {
      epi_rows(sC, [&](int, int row, int cc, const float (&v)[8]) { store8(p.Ksb() + (size_t)(m0 + row) * 512 + n0 - 512 + cc, v); });
    } else if (ct < 12) {
      epi_vt(sC, p.VTsb(), m0, (n0 - 1024) >> 6, 0, 7);
    } else if (ct < 16) {
      epi_rows(sC, [&](int, int row, int cc, const float (&v)[8]) {
        float o[8];
#pragma unroll
        for (int j = 0; j < 8; ++j) o[j] = siluf_fast(v[j]);
        store8(p.Zsb() + (size_t)(m0 + row) * 512 + n0 - 1536 + cc, o); });
    } else if (ct < 19) {
      epi_rows(sC, [&](int, int row, int cc, const float (&v)[8]) {
        store8(p.CQ() + (size_t)(m0 + row) * 384 + n0 - 2048 + cc, v);
        float q = 0.f;
#pragma unroll
        for (int j = 0; j < 8; ++j) q += v[j] * v[j];
        q += __shfl_xor(q, 1); q += __shfl_xor(q, 2); q += __shfl_xor(q, 4); q += __shfl_xor(q, 8);
        if (do_ssq && (threadIdx.x & 15) == 0) atomicAdd(p.SSQ() + m0 + row, q); });
    } else if (ct < 21) {
      epi_rows(sC, [&](int, int row, int cc, const float (&v)[8]) {
        store8(p.CKV() + (size_t)(m0 + row) * 256 + n0 - 2432 + cc, v);
        float q = 0.f;
#pragma unroll
        for (int j = 0; j < 8; ++j) q += v[j] * v[j];
        q += __shfl_xor(q, 1); q += __shfl_xor(q, 2); q += __shfl_xor(q, 4); q += __shfl_xor(q, 8);
        if (do_ssq && (threadIdx.x & 15) == 0) atomicAdd(p.SSQ() + NTOK + m0 + row, q); });
    } else if (ct < 25) {
      epi_rows(sC, [&](int, int row, int cc, const float (&v)[8]) {
        float o[8];
#pragma unroll
        for (int j = 0; j < 8; ++j) o[j] = siluf_fast(v[j]);
        store8(p.Zmla() + (size_t)(m0 + row) * 512 + n0 - 2688 + cc, o); });
    } else if (ct < 33) {
      epi_rows(sC, [&](int, int row, int cc, const float (&v)[8]) {
        float o[8];
#pragma unroll
        for (int j = 0; j < 8; ++j) o[j] = sigmoidf_fast(v[j]);
        store8(p.GA() + (size_t)(m0 + row) * 1024 + n0 - 3200 + cc, o); });
    } else if (ct < 41) {
      epi_rows(sC, [&](int, int row, int cc, const float (&v)[8]) {
        float o[8];
#pragma unroll
        for (int j = 0; j < 8; ++j) o[j] = sigmoidf_fast(v[j]);
        store8(p.GB() + (size_t)(m0 + row) * 1024 + n0 - 4224 + cc, o); });
    } else {
      epi_rows(sC, [&](int, int row, int cc, const float (&v)[8]) {
        if (cc < 32) {
          float o[8];
#pragma unroll
          for (int j = 0; j < 8; ++j) o[j] = v[j];
          rope8(sC, p.ROPE(), m0 + row, row, cc, o);
          store8(p.KPE() + (size_t)(m0 + row) * 32 + cc, o);
        } });
    }
}

DI void g1_tile(const Params& p, char* smem, const int rt, const int ct2, const bool do_ssq) {
  bf16_t* shm = (bf16_t*)smem;
  float* sC = (float*)smem;
  const int m0 = rt * 256, n0 = ct2 * 256;
  f32x4 acc[2][2][4][2];
  zero_acc8(acc);
  gemm8_tile(p.Hb() + (size_t)m0 * DM, p.WinT() + (size_t)n0 * DM, DM, shm, acc);
#pragma unroll
  for (int ai = 0; ai < 2; ++ai)
#pragma unroll
    for (int bj = 0; bj < 2; ++bj) {
      __syncthreads();
      accq_to_lds(acc[ai][bj], sC);
      __syncthreads();
      g1_epi(p, sC, m0 + ai * 128, n0 + bj * 128, ct2 * 2 + bj, do_ssq);
    }
  __syncthreads();
}

constexpr int G1_NCT = 20;
DI void phase_g1(const Params& p, char* smem, bool do_ssq = true) {
  const int xq = blockIdx.x & 7, lb = blockIdx.x >> 3, nlb = gridDim.x >> 3;
  const bool xmap = (gridDim.x & 7) == 0;
  for (int t = xmap ? lb : (int)blockIdx.x; t < (xmap ? 8 * G1_NCT : 64 * G1_NCT); t += (xmap ? nlb : (int)gridDim.x)) {
    int rt, ct2;
    if (xmap) { ct2 = t >> 3; rt = 8 * xq + (t & 7); } else { rt = t / G1_NCT; ct2 = t % G1_NCT; }
    g1_tile(p, smem, rt, ct2, do_ssq);
  }
}

DI void g2_epi_q(const Params& p, const float* sC, const float* rsq, const int m0, const int n0) {
  epi_rows(sC, [&](int, int row, int cc, const float (&v)[8]) {
    const int col = n0 + cc;
    float o[8];
#pragma unroll
    for (int j = 0; j < 8; ++j) o[j] = v[j];
    if (((col >> 5) % 3) == 2) rope8(sC, p.ROPE(), m0 + row, row, cc, o);
    const float sc = rsq[row] * QM_SCALE;
#pragma unroll
    for (int j = 0; j < 8; ++j) o[j] *= sc;
    store8(p.Qmla() + (size_t)(m0 + row) * 768 + col, o);
  });
}
DI void g2_epi_kv(const Params& p, const float* sC, const float* rsq, const int m0, const int head) {
  epi_rows(sC, [&](int, int row, int cc, const float (&v)[8]) {
    if (cc < 64) {
      const float sc = rsq[row];
      float o[8];
#pragma unroll
      for (int j = 0; j < 8; ++j) o[j] = v[j] * sc;
      store8(p.Knope() + (size_t)(m0 + row) * 512 + head * 64 + cc, o);
    } });
  const int b = m0 >> 12, s0 = m0 & 4095;
  for (int c = opaque_tid(); c < 1024; c += 512) {
    const int col = c & 63, rc = c >> 6;
    float v[8];
#pragma unroll
    for (int j = 0; j < 8; ++j) v[j] = sC[(rc * 8 + j) * CSTR + 64 + col] * rsq[rc * 8 + j];
    store8(p.VTmla() + ((size_t)((b * 8 + head) * 64 + col)) * SEQL + s0 + rc * 8, v);
  }
}

DI void g2_tile(const Params& p, char* smem, const bool isq, const int rt, const int ct) {
  bf16_t* shm = (bf16_t*)smem;
  float* sC = (float*)smem;
  float* rs = (float*)(smem + 131072);
  const int m0 = rt * 256, n0 = ct * 256;
  f32x4 acc[2][2][4][2];
  zero_acc8(acc);
  if (isq) {
    if (threadIdx.x < 256) rs[threadIdx.x] = __builtin_amdgcn_rsqf(p.SSQ()[m0 + threadIdx.x] * (1.f / 384.f) + EPSN);
    gemm8_tile(p.CQ() + (size_t)m0 * 384, p.WuqT() + (size_t)n0 * 384, 384, shm, acc);
#pragma unroll
    for (int ai = 0; ai < 2; ++ai)
#pragma unroll
      for (int bj = 0; bj < 2; ++bj) {
        __syncthreads();
        accq_to_lds(acc[ai][bj], sC);
        __syncthreads();
        g2_epi_q(p, sC, rs + ai * 128, m0 + ai * 128, n0 + bj * 128);
      }
  } else {
    if (threadIdx.x < 256) rs[threadIdx.x] = __builtin_amdgcn_rsqf(p.SSQ()[NTOK + m0 + threadIdx.x] * (1.f / 256.f) + EPSN);
    gemm8_tile(p.CKV() + (size_t)m0 * 256, p.WukvT() + (size_t)n0 * 256, 256, shm, acc);
#pragma unroll
    for (int ai = 0; ai < 2; ++ai)
#pragma unroll
      for (int bj = 0; bj < 2; ++bj) {
        __syncthreads();
        accq_to_lds(acc[ai][bj], sC);
        __syncthreads();
        g2_epi_kv(p, sC, rs + ai * 128, m0 + ai * 128, ct * 2 + bj);
      }
  }
  __syncthreads();
}

DI void phase_g2(const Params& p, char* smem) {
  const int xq = blockIdx.x & 7, lb = blockIdx.x >> 3, nlb = gridDim.x >> 3;
  if ((gridDim.x & 7) == 0 && nlb == 32) {
    if (lb < 8) { g1_tile(p, smem, 8 * xq + lb, G1_NCT, false); return; }
    const int v = lb - 8;
    g2_tile(p, smem, true, 8 * xq + (v & 7), v >> 3);
    g2_tile(p, smem, false, 8 * xq + (v & 7), v >> 3);
    if (lb < 16) { const int v2 = 24 + v; g2_tile(p, smem, false, 8 * xq + (v2 & 7), v2 >> 3); }
  } else {
    for (int tt = blockIdx.x; tt < 64 + 192 + 256; tt += gridDim.x) {
      if (tt < 64) g1_tile(p, smem, tt, G1_NCT, false);
      else if (tt < 256) { const int v = tt - 64; g2_tile(p, smem, true, v / 3, v % 3); }
      else { const int v = tt - 256; g2_tile(p, smem, false, v >> 2, v & 3); }
    }
  }
}

constexpr int VSTR = 68;

template <bool MLA>
DI void attn_item(const Params& p, int b, int h, int qb, char* smem) {
  constexpr int DK = MLA ? 96 : 64;
  constexpr int KSTR = MLA ? 104 : 72;
  constexpr int NKS = DK / 16;
  bf16_t* sK = (bf16_t*)smem;
  bf16_t* sV = sK + 2 * 64 * KSTR;
  const int tid = threadIdx.x, lane = tid & 63, w = tid >> 6, r = lane & 31, hh = lane >> 5;
  const int tokb = b * SEQL;
  const int tok0 = tokb + qb * 256;
  const int qw = qb * 256 + w * 32;

  bf16x8 qf[NKS];
  {
    const bf16_t* qptr = MLA ? (p.Qmla() + (size_t)(tok0 + w * 32 + r) * 768 + h * 96 + hh * 8) : (p.Qsb() + (size_t)(tok0 + w * 32 + r) * 512 + h * 64 + hh * 8);
#pragma unroll
    for (int ks = 0; ks < NKS; ++ks) qf[ks] = *(const bf16x8*)(qptr + ks * 16);
  }
  bf16x8 tf[2];
  if (!MLA) {
#pragma unroll
    for (int st = 0; st < 2; ++st)
#pragma unroll
      for (int e = 0; e < 8; ++e) { const int j = 16 * st + 8 * (e >> 2) + 4 * hh + (e & 3); tf[st][e] = (j >= r) ? (short)0x3F80 : (short)0; }
  }

  f32x16 oacc[2];
#pragma unroll
  for (int i = 0; i < 16; ++i) { oacc[0][i] = 0.f; oacc[1][i] = 0.f; }
  float carry = 0.f;
  float mrun = 0.f, lrun = 0.f;

  const bf16_t* Kg = MLA ? p.Knope() : p.Ksb();
  const bf16_t* VTg = (MLA ? p.VTmla() : p.VTsb()) + (size_t)((b * 8 + h) * 64) * SEQL;
  const int nt = 4 * qb + 4;

  uint4 xk0, xv0, xp, yk0, yv0, yp;
  xp = make_uint4(0, 0, 0, 0); yp = xp;
  const int prow = tid >> 3, pch = tid & 7;
  const bf16_t* kgp = Kg + (size_t)(tokb + prow) * 512 + h * 64 + pch * 8;
  const bf16_t* vgp = VTg + (size_t)prow * SEQL + pch * 8;
  const bf16_t* pgp = p.KPE() + (size_t)(tokb + ((tid & 255) >> 2)) * 32 + (tid & 3) * 8;
#define ATT_GLOAD(P, kt_)                                                          \
  {                                                                                \
    const int kt__ = (kt_);                                                        \
    P##k0 = *(const uint4*)(kgp + (size_t)(kt__ * 64) * 512);                      \
    P##v0 = *(const uint4*)(vgp + kt__ * 64);                                      \
    if (MLA && tid < 256) P##p = *(const uint4*)(pgp + (size_t)(kt__ * 64) * 32);  \
  }
#define ATT_SWRITE(P, buf_)                                                        \
  {                                                                                \
    bf16_t* dK = sK + (buf_) * 64 * KSTR;                                          \
    bf16_t* dV = sV + (buf_) * 64 * VSTR;                                          \
    *(uint4*)(dK + prow * KSTR + pch * 8) = P##k0;                                 \
    uint2* dv0 = (uint2*)(dV + prow * VSTR + pch * 8);                             \
    dv0[0] = make_uint2(P##v0.x, P##v0.y); dv0[1] = make_uint2(P##v0.z, P##v0.w);  \
    if (MLA && tid < 256) *(uint4*)(dK + (tid >> 2) * KSTR + 64 + (tid & 3) * 8) = P##p; \
  }
#define ATT_KT(i_) (MLA ? (i_) : (nt - 1 - (i_)))

  ATT_GLOAD(x, ATT_KT(0));
  ATT_GLOAD(y, ATT_KT(1));
  ATT_SWRITE(x, 0);
  __syncthreads();
  bool alive = true;
  for (int it0 = 0; alive; it0 += 2) {
#pragma unroll
   for (int half = 0; half < 2; ++half) {
    const int it = it0 + half;
    const int kt = ATT_KT(it);
    const int cur = half;
    const bool more = (it + 1 < nt);
    if (it + 2 < nt) { if (half == 0) ATT_GLOAD(x, ATT_KT(it + 2)) else ATT_GLOAD(y, ATT_KT(it + 2)) }
    const bf16_t* cK = sK + cur * 64 * KSTR;
    const bf16_t* cV = sV + cur * 64 * VSTR;
    if (MLA) {
      if (kt * 64 <= qw + 31) {
        f32x16 s0, s1;
        {
          const float sinit = -mrun;
#pragma unroll
          for (int i = 0; i < 16; ++i) { s0[i] = sinit; s1[i] = sinit; }
        }
        __builtin_amdgcn_s_setprio(1);
#pragma unroll
        for (int ks = 0; ks < NKS; ++ks) {
          const bf16x8 k0 = *(const bf16x8*)(cK + r * KSTR + ks * 16 + hh * 8);
          const bf16x8 k1 = *(const bf16x8*)(cK + (32 + r) * KSTR + ks * 16 + hh * 8);
          s0 = MFMA(k0, qf[ks], s0);
          s1 = MFMA(k1, qf[ks], s1);
        }
        __builtin_amdgcn_s_setprio(0);
        if (kt * 64 + 63 > qw) {
          const int lim = qw + r - kt * 64;
#pragma unroll
          for (int i = 0; i < 16; ++i) { if (crow(i, hh) > lim) s0[i] = -1e30f; if (32 + crow(i, hh) > lim) s1[i] = -1e30f; }
        }
        float m0 = fmaxf(fmaxf(s0[0], s0[1]), s0[2]), m1 = fmaxf(fmaxf(s1[0], s1[1]), s1[2]);
#pragma unroll
        for (int i = 3; i < 15; i += 2) { m0 = fmaxf(fmaxf(m0, s0[i]), s0[i + 1]); m1 = fmaxf(fmaxf(m1, s1[i]), s1[i + 1]); }
        float mloc = fmaxf(fmaxf(m0, s0[15]), fmaxf(m1, s1[15]));
        mloc = half_max(mloc);
        const bool first = (it == 0);
        const float delta = first ? mloc : fmaxf(mloc, 0.f);
        if (first || __builtin_amdgcn_ballot_w64(delta > 0.f) != 0ull) {
          const float alpha = first ? 0.f : __builtin_amdgcn_exp2f(-delta);
          mrun += delta;
          lrun *= alpha;
#pragma unroll
          for (int i = 0; i < 16; ++i) { oacc[0][i] *= alpha; oacc[1][i] *= alpha; s0[i] -= delta; s1[i] -= delta; }
        }
        float ps0 = 0.f, ps1 = 0.f;
#pragma unroll
        for (int i = 0; i < 16; ++i) { s0[i] = __builtin_amdgcn_exp2f(s0[i]); s1[i] = __builtin_amdgcn_exp2f(s1[i]); ps0 += s0[i]; ps1 += s1[i]; }
        lrun += ps0 + ps1;
        bf16x8 pf4[4];
        pf4[0] = pack8(s0[0], s0[1], s0[2], s0[3], s0[4], s0[5], s0[6], s0[7]);
        pf4[1] = pack8(s0[8], s0[9], s0[10], s0[11], s0[12], s0[13], s0[14], s0[15]);
        pf4[2] = pack8(s1[0], s1[1], s1[2], s1[3], s1[4], s1[5], s1[6], s1[7]);
        pf4[3] = pack8(s1[8], s1[9], s1[10], s1[11], s1[12], s1[13], s1[14], s1[15]);
        __builtin_amdgcn_s_setprio(1);
#pragma unroll
        for (int st = 0; st < 4; ++st)
#pragma unroll
          for (int dt = 0; dt < 2; ++dt) {
            const bf16_t* vp = cV + (dt * 32 + r) * VSTR + st * 16 + 4 * hh;
            const s16x4 lo = *(const s16x4*)vp;
            const s16x4 hi = *(const s16x4*)(vp + 8);
            const bf16x8 vf = __builtin_shufflevector(lo, hi, 0, 1, 2, 3, 4, 5, 6, 7);
            oacc[dt] = MFMA(vf, pf4[st], oacc[dt]);
          }
        __builtin_amdgcn_s_setprio(0);
      }
    } else
#pragma unroll
    for (int si = 0; si < 2; ++si) {
      const int sub = MLA ? si : (1 - si);
      const int kb = kt * 64 + sub * 32;
      if (kb > qw) continue;
      const bool diag = (kb == qw);
      f32x16 s;
      {
        const float sinit = MLA ? -mrun : 0.f;
#pragma unroll
        for (int i = 0; i < 16; ++i) s[i] = sinit;
      }
      __builtin_amdgcn_s_setprio(1);
#pragma unroll
      for (int ks = 0; ks < NKS; ++ks) {
        const bf16x8 kf = *(const bf16x8*)(cK + (sub * 32 + r) * KSTR + ks * 16 + hh * 8);
        s = MFMA(kf, qf[ks], s);
      }
      __builtin_amdgcn_s_setprio(0);
      bf16x8 pf[2];
      if (!MLA) {
        float sp[16];
        float tsum = 0.f;
#pragma unroll
        for (int i = 0; i < 16; ++i) {
          const float z = s[i];
          float v = __builtin_amdgcn_logf(1.f + __builtin_amdgcn_exp2f(fminf(z, 126.f)));
          if (diag && !(crow(i, hh) < r)) v = 0.f;
          sp[i] = v;
          tsum += v;
        }
        f32x16 cacc;
#pragma unroll
        for (int i = 0; i < 16; ++i) cacc[i] = carry;
        cacc = MFMA(tf[0], pack8(sp[0], sp[1], sp[2], sp[3], sp[4], sp[5], sp[6], sp[7]), cacc);
        cacc = MFMA(tf[1], pack8(sp[8], sp[9], sp[10], sp[11], sp[12], sp[13], sp[14], sp[15]), cacc);
        float pr[16];
#pragma unroll
        for (int i = 0; i < 16; ++i) {
          float v = __builtin_amdgcn_exp2f(s[i] - cacc[i]);
          if (diag && !(crow(i, hh) < r)) v = 0.f;
          pr[i] = v;
        }
        carry += half_sum(tsum);
        pf[0] = pack8(pr[0], pr[1], pr[2], pr[3], pr[4], pr[5], pr[6], pr[7]);
        pf[1] = pack8(pr[8], pr[9], pr[10], pr[11], pr[12], pr[13], pr[14], pr[15]);
      } else {
        if (diag) {
#pragma unroll
          for (int i = 0; i < 16; ++i) if (!(crow(i, hh) <= r)) s[i] = -1e30f;
        }
        float mloc = fmaxf(fmaxf(s[0], s[1]), s[2]);
#pragma unroll
        for (int i = 3; i < 15; i += 2) mloc = fmaxf(fmaxf(mloc, s[i]), s[i + 1]);
        mloc = fmaxf(mloc, s[15]);
        mloc = half_max(mloc);
        const bool first = (it == 0) && (si == 0);
        const float delta = first ? mloc : fmaxf(mloc, 0.f);
        if (first || __builtin_amdgcn_ballot_w64(delta > 0.f) != 0ull) {
          const float alpha = first ? 0.f : __builtin_amdgcn_exp2f(-delta);
          mrun += delta;
          lrun *= alpha;
#pragma unroll
          for (int i = 0; i < 16; ++i) { oacc[0][i] *= alpha; oacc[1][i] *= alpha; s[i] -= delta; }
        }
        float pr[16];
        float ps0 = 0.f, ps1 = 0.f;
#pragma unroll
        for (int i = 0; i < 16; i += 2) { pr[i] = __builtin_amdgcn_exp2f(s[i]); pr[i + 1] = __builtin_amdgcn_exp2f(s[i + 1]); ps0 += pr[i]; ps1 += pr[i + 1]; }
        lrun += ps0 + ps1;
        pf[0] = pack8(pr[0], pr[1], pr[2], pr[3], pr[4], pr[5], pr[6], pr[7]);
        pf[1] = pack8(pr[8], pr[9], pr[10], pr[11], pr[12], pr[13], pr[14], pr[15]);
      }
      __builtin_amdgcn_s_setprio(1);
#pragma unroll
      for (int dt = 0; dt < 2; ++dt)
#pragma unroll
        for (int st = 0; st < 2; ++st) {
          const bf16_t* vp = cV + (dt * 32 + r) * VSTR + sub * 32 + st * 16 + 4 * hh;
          const s16x4 lo = *(const s16x4*)vp;
          const s16x4 hi = *(const s16x4*)(vp + 8);
          const bf16x8 vf = __builtin_shufflevector(lo, hi, 0, 1, 2, 3, 4, 5, 6, 7);
          oacc[dt] = MFMA(vf, pf[st], oacc[dt]);
        }
      __builtin_amdgcn_s_setprio(0);
    }
    if (more) { if (half == 0) ATT_SWRITE(y, 1) else ATT_SWRITE(x, 0) }
    if (!MLA) {
      int* flg = (int*)(smem + SMEM_BYTES - 128) + (it & 1) * 8;
      const bool wok = (__builtin_amdgcn_ballot_w64(carry >= 160.f) == ~0ull);
      if (lane == 0) flg[w] = wok ? 1 : 0;
      __syncthreads();
      alive = more && ((flg[0] & flg[1] & flg[2] & flg[3] & flg[4] & flg[5] & flg[6] & flg[7]) == 0);
    } else {
      __syncthreads();
      alive = more;
    }
    if (!alive) break;
   }
  }
#undef ATT_GLOAD
#undef ATT_SWRITE
#undef ATT_KT
  float inv = 1.f;
  if (MLA) { const float lt = half_sum(lrun); inv = 1.f / lt; }
  const int tok = tok0 + w * 32 + r;
  const bf16_t* zg = (MLA ? p.Zmla() : p.Zsb()) + (size_t)tok * 512 + h * 64;
  bf16_t* og = (MLA ? p.OBg() : p.OAg()) + (size_t)tok * 512 + h * 64;
#pragma unroll
  for (int dt = 0; dt < 2; ++dt)
#pragma unroll
    for (int g = 0; g < 4; ++g) {
      const int d = dt * 32 + 8 * g + 4 * hh;
      const u32x2 zz = *(const u32x2*)(zg + d);
      const float z0 = __uint_as_float(zz[0] << 16), z1 = __uint_as_float(zz[0] & 0xffff0000u);
      const float z2 = __uint_as_float(zz[1] << 16), z3 = __uint_as_float(zz[1] & 0xffff0000u);
      u32x2 o;
      o[0] = pk2(oacc[dt][4 * g] * inv * z0, oacc[dt][4 * g + 1] * inv * z1);
      o[1] = pk2(oacc[dt][4 * g + 2] * inv * z2, oacc[dt][4 * g + 3] * inv * z3);
      *(u32x2*)(og + d) = o;
    }
}

DI void phase_attn(const Params& p, char* smem, int cbase, int only) {
  int* s_item = (int*)(smem + SMEM_BYTES - 16);
  const int q0 = blockIdx.x & 7;
  int qi = 0;
  for (;;) {
    if (threadIdx.x < 64) {
      int item = -1;
      while (qi < 8) {
        const int q = (q0 + qi) & 7;
        int idx = 0;
        if (threadIdx.x == 0) idx = atomicAdd(p.counter() + cbase + q, 1);
        idx = __builtin_amdgcn_readfirstlane(idx);
        if (idx < 128) { item = q * 256 + idx; break; }
        const int lq = (q0 + (threadIdx.x & 7)) & 7;
        const int head = __hip_atomic_load(p.counter() + cbase + lq, __ATOMIC_RELAXED, __HIP_MEMORY_SCOPE_AGENT);
        const unsigned long long avail = __builtin_amdgcn_ballot_w64((threadIdx.x < 8) && (head < 128) && ((int)(threadIdx.x & 7) > qi));
        if (avail == 0ull) { qi = 8; break; }
        qi = __builtin_ctzll(avail);
      }
      if (threadIdx.x == 0) *s_item = item;
    }
    __syncthreads();
    const int item = *s_item;
    __syncthreads();
    if (item < 0) break;
    const int q = item >> 8, idx = item & 255;
    const int i2 = idx & 63;
    const int bh = q + 8 * (i2 & 3);
    const int qb = 15 - (i2 >> 2);
    if (idx < 64) { if (only != 2) attn_item<true>(p, bh >> 3, bh & 7, qb, smem); }
    else { if (only != 1) attn_item<false>(p, bh >> 3, bh & 7, qb, smem); }
  }
}

DI void g3_epi_a(const Params& p, const float* sC, const int m0, const int n0) {
  const int txo = opaque_tid();
#pragma unroll
  for (int i = 0; i < 4; ++i) {
    const int c = txo + 512 * i, row = c >> 4, cc = (c & 15) * 8;
    const u32x4 g = *(const u32x4*)(p.GA() + (size_t)(m0 + row) * 1024 + n0 + cc);
    const float4 a = *(const float4*)(sC + row * CSTR + cc), b = *(const float4*)(sC + row * CSTR + cc + 4);
    u32x4 y;
    y[0] = pk2(a.x * __uint_as_float(g[0] << 16), a.y * __uint_as_float(g[0] & 0xffff0000u));
    y[1] = pk2(a.z * __uint_as_float(g[1] << 16), a.w * __uint_as_float(g[1] & 0xffff0000u));
    y[2] = pk2(b.x * __uint_as_float(g[2] << 16), b.y * __uint_as_float(g[2] & 0xffff0000u));
    y[3] = pk2(b.z * __uint_as_float(g[3] << 16), b.w * __uint_as_float(g[3] & 0xffff0000u));
    *(u32x4*)(p.MERGED() + (size_t)(m0 + row) * 1024 + n0 + cc) = y;
  }
}
DI void g3_epi_b(const Params& p, const float* sC, const int m0, const int n0) {
  const int txo2 = opaque_tid();
#pragma unroll
  for (int i = 0; i < 4; ++i) {
    const int c = txo2 + 512 * i, row = c >> 4, cc = (c & 15) * 8;
    const u32x4 g = *(const u32x4*)(p.GB() + (size_t)(m0 + row) * 1024 + n0 + cc);
    const u32x4 yv = *(const u32x4*)(p.MERGED() + (size_t)(m0 + row) * 1024 + n0 + cc);
    const float4 a = *(const float4*)(sC + row * CSTR + cc), b = *(const float4*)(sC + row * CSTR + cc + 4);
    u32x4 o;
    o[0] = pk2(__uint_as_float(yv[0] << 16) + a.x * __uint_as_float(g[0] << 16), __uint_as_float(yv[0] & 0xffff0000u) + a.y * __uint_as_float(g[0] & 0xffff0000u));
    o[1] = pk2(__uint_as_float(yv[1] << 16) + a.z * __uint_as_float(g[1] << 16), __uint_as_float(yv[1] & 0xffff0000u) + a.w * __uint_as_float(g[1] & 0xffff0000u));
    o[2] = pk2(__uint_as_float(yv[2] << 16) + b.x * __uint_as_float(g[2] << 16), __uint_as_float(yv[2] & 0xffff0000u) + b.y * __uint_as_float(g[2] & 0xffff0000u));
    o[3] = pk2(__uint_as_float(yv[3] << 16) + b.z * __uint_as_float(g[3] << 16), __uint_as_float(yv[3] & 0xffff0000u) + b.w * __uint_as_float(g[3] & 0xffff0000u));
    *(u32x4*)(p.MERGED() + (size_t)(m0 + row) * 1024 + n0 + cc) = o;
  }
}
DI void phase_g3(const Params& p, char* smem) {
  bf16_t* shm = (bf16_t*)smem;
  float* sC = (float*)smem;
  const int xq = blockIdx.x & 7, lb = blockIdx.x >> 3, nlb = gridDim.x >> 3;
  const bool xmap = (gridDim.x & 7) == 0;
  for (int t = xmap ? lb : (int)blockIdx.x; t < (xmap ? 32 : 256); t += (xmap ? nlb : (int)gridDim.x)) {
    const int rt = xmap ? (8 * xq + (t & 7)) : (t >> 2), ct = xmap ? (t >> 3) : (t & 3);
    const int m0 = rt * 256, n0 = ct * 256;
    f32x4 acc[2][2][4][2];
    zero_acc8(acc);
    gemm8_tile(p.OAg() + (size_t)m0 * 512, p.WaT() + (size_t)n0 * 512, 512, shm, acc);
#pragma unroll
    for (int ai = 0; ai < 2; ++ai)
#pragma unroll
      for (int bj = 0; bj < 2; ++bj) {
        __syncthreads();
        accq_to_lds(acc[ai][bj], sC);
        __syncthreads();
        g3_epi_a(p, sC, m0 + ai * 128, n0 + bj * 128);
      }
    __syncthreads();
    zero_acc8(acc);
    gemm8_tile(p.OBg() + (size_t)m0 * 512, p.WbT() + (size_t)n0 * 512, 512, shm, acc);
#pragma unroll
    for (int ai = 0; ai < 2; ++ai)
#pragma unroll
      for (int bj = 0; bj < 2; ++bj) {
        __syncthreads();
        accq_to_lds(acc[ai][bj], sC);
        __syncthreads();
        g3_epi_b(p, sC, m0 + ai * 128, n0 + bj * 128);
      }
    __syncthreads();
  }
}

DI void g4_epi(const Params& p, const float* sC, const float* gt, const int m0, const int n0) {
  const int txo = opaque_tid();
#pragma unroll
  for (int i = 0; i < 4; ++i) {
    const int c = txo + 512 * i, row = c >> 4, cc = (c & 15) * 8;
    const size_t go = (size_t)(m0 + row) * 1024 + n0 + cc;
    const float4 x0 = *(const float4*)(p.x + go), x1 = *(const float4*)(p.x + go + 4);
    const float4 a = *(const float4*)(sC + row * CSTR + cc), b = *(const float4*)(sC + row * CSTR + cc + 4);
    const float4 g0 = *(const float4*)(gt + cc), g1 = *(const float4*)(gt + cc + 4);
    float4 o0, o1;
    o0.x = x0.x + g0.x * a.x; o0.y = x0.y + g0.y * a.y; o0.z = x0.z + g0.z * a.z; o0.w = x0.w + g0.w * a.w;
    o1.x = x1.x + g1.x * b.x; o1.y = x1.y + g1.y * b.y; o1.z = x1.z + g1.z * b.z; o1.w = x1.w + g1.w * b.w;
    *(float4*)(p.out + go) = o0;
    *(float4*)(p.out + go + 4) = o1;
  }
}
DI void phase_g4(const Params& p, char* smem) {
  bf16_t* shm = (bf16_t*)smem;
  float* sC = (float*)smem;
  float* rs = (float*)(smem + 131072);
  const int xq = blockIdx.x & 7, lb = blockIdx.x >> 3, nlb = gridDim.x >> 3;
  const bool xmap = (gridDim.x & 7) == 0;
  for (int t = xmap ? lb : (int)blockIdx.x; t < (xmap ? 32 : 256); t += (xmap ? nlb : (int)gridDim.x)) {
    const int rt = xmap ? (8 * xq + (t & 7)) : (t >> 2), ct = xmap ? (t >> 3) : (t & 3);
    const int m0 = rt * 256, n0 = ct * 256;
    f32x4 acc[2][2][4][2];
    zero_acc8(acc);
    if (threadIdx.x < 256) rs[threadIdx.x] = mod_get(p.MOD(), m0 >> 12, 2048 + n0 + threadIdx.x);
    gemm8_tile(p.MERGED() + (size_t)m0 * 1024, p.WoT() + (size_t)n0 * 1024, 1024, shm, acc);
#pragma unroll
    for (int ai = 0; ai < 2; ++ai)
#pragma unroll
      for (int bj = 0; bj < 2; ++bj) {
        __syncthreads();
        accq_to_lds(acc[ai][bj], sC);
        __syncthreads();
        g4_epi(p, sC, rs + bj * 128, m0 + ai * 128, n0 + bj * 128);
      }
    __syncthreads();
  }
}

DI void phase_final(const Params& p) {
  const int lane = threadIdx.x & 63, w = threadIdx.x >> 6;
  const int gw = blockIdx.x * 8 + w, nw = gridDim.x * 8;
  for (int row = gw; row < NTOK; row += nw) {
    float* xr = p.out + (size_t)row * DM;
    float4 v[4];
    float ss = 0.f;
#pragma unroll
    for (int i = 0; i < 4; ++i) {
      v[i] = *(const float4*)(xr + 4 * (lane + 64 * i));
      ss += v[i].x * v[i].x + v[i].y * v[i].y + v[i].z * v[i].z + v[i].w * v[i].w;
    }
#pragma unroll
    for (int o = 32; o >= 1; o >>= 1) ss += __shfl_xor(ss, o);
    const float rn = __builtin_amdgcn_rsqf(ss * (1.f / DM) + EPSN);
#pragma unroll
    for (int i = 0; i < 4; ++i) {
      const int e = 4 * (lane + 64 * i);
      const float4 g = *(const float4*)(p.fgain + e);
      float4 o;
      o.x = v[i].x * rn * g.x; o.y = v[i].y * rn * g.y; o.z = v[i].z * rn * g.z; o.w = v[i].w * rn * g.w;
      *(float4*)(xr + e) = o;
    }
  }
}

template <int PH>
__global__ void __launch_bounds__(NTHREADS, 2) mega_kernel(Params p) {
  __shared__ __attribute__((aligned(16))) char smem[SMEM_BYTES];
  if (PH < 0) {
    if (p.ws == nullptr) cg::this_grid().sync();
    volatile LAS unsigned* xst = (volatile LAS unsigned*)(smem + SMEM_BYTES - 32);
    if (threadIdx.x == 0) { xst[0] = 0u; xst[1] = 0u; }
    __syncthreads();
    (void)xcd_barrier_post(p.bar(), xst);
    phase_prep(p, smem); xcd_barrier(p.bar(), (volatile LAS unsigned*)(smem + SMEM_BYTES - 32));
#if PROBE_DUP == 4
    phase_prep(p, smem); xcd_barrier(p.bar(), (volatile LAS unsigned*)(smem + SMEM_BYTES - 32));
#endif
    phase_h(p, smem); xcd_barrier(p.bar(), (volatile LAS unsigned*)(smem + SMEM_BYTES - 32));
#if PROBE_DUP == 5
    phase_h(p, smem); xcd_barrier(p.bar(), (volatile LAS unsigned*)(smem + SMEM_BYTES - 32));
#endif
    phase_g1(p, smem); xcd_barrier(p.bar(), (volatile LAS unsigned*)(smem + SMEM_BYTES - 32));
#if PROBE_DUP == 1
    phase_g1(p, smem, false); xcd_barrier(p.bar(), (volatile LAS unsigned*)(smem + SMEM_BYTES - 32));
#endif
    phase_g2(p, smem); xcd_barrier(p.bar(), (volatile LAS unsigned*)(smem + SMEM_BYTES - 32));
#if PROBE_DUP == 8
    phase_g2(p, smem); xcd_barrier(p.bar(), (volatile LAS unsigned*)(smem + SMEM_BYTES - 32));
#endif
    phase_attn(p, smem, 0, 0); xcd_barrier(p.bar(), (volatile LAS unsigned*)(smem + SMEM_BYTES - 32));
#if PROBE_DUP == 2
    phase_attn(p, smem, 8, 1); xcd_barrier(p.bar(), (volatile LAS unsigned*)(smem + SMEM_BYTES - 32));
#endif
#if PROBE_DUP == 3
    phase_attn(p, smem, 8, 2); xcd_barrier(p.bar(), (volatile LAS unsigned*)(smem + SMEM_BYTES - 32));
#endif
    phase_g3(p, smem); xcd_barrier(p.bar(), (volatile LAS unsigned*)(smem + SMEM_BYTES - 32));
#if PROBE_DUP == 6
    phase_g3(p, smem); xcd_barrier(p.bar(), (volatile LAS unsigned*)(smem + SMEM_BYTES - 32));
#endif
    phase_g4(p, smem); xcd_barrier(p.bar(), (volatile LAS unsigned*)(smem + SMEM_BYTES - 32));
#if PROBE_DUP == 7
    phase_g4(p, smem); xcd_barrier(p.bar(), (volatile LAS unsigned*)(smem + SMEM_BYTES - 32));
#endif
    phase_final(p);
  } else {
    if (PH == 0) phase_prep(p, smem);
    if (PH == 1) phase_h(p, smem);
    if (PH == 2) phase_g1(p, smem);
    if (PH == 3) phase_g2(p, smem);
    if (PH == 4) phase_attn(p, smem, 0, 0);
    if (PH == 5) phase_g3(p, smem);
    if (PH == 6) phase_g4(p, smem);
    if (PH == 7) phase_final(p);
  }
}

#ifndef PROBE_DUP
#define PROBE_DUP 0
#endif
#ifndef MK_SPLIT
#define MK_SPLIT 0
#endif

extern "C" void kernel_launch(void* const* d_in, const int* in_sizes, int n_in, void* d_out, int out_size, void* d_ws, size_t ws_size, hipStream_t stream) {
  Params p{};
  p.x = (const float*)d_in[0]; p.c = (const float*)d_in[1]; p.pos = (const int*)d_in[2];
  p.w_ada = (const float*)d_in[3]; p.b_ada = (const float*)d_in[4]; p.norm_gain = (const float*)d_in[5];
  p.w_in = (const float*)d_in[6]; p.q_gain = (const float*)d_in[7]; p.w_uq = (const float*)d_in[8];
  p.kv_gain = (const float*)d_in[9]; p.w_ukv = (const float*)d_in[10]; p.w_a = (const float*)d_in[11];
  p.w_b = (const float*)d_in[12]; p.w_out = (const float*)d_in[13]; p.fgain = (const float*)d_in[14];
  p.out = (float*)d_out;
  p.ws = (char*)d_ws;
  if (WS_NEED > ws_size) { fprintf(stderr, "workspace too small: need %zu have %zu\n", (size_t)WS_NEED, ws_size); return; }

  static int grid_blocks = 0;
  if (!grid_blocks) {
    int dev = 0, cus = 0, per_cu = 0;
    hipGetDevice(&dev);
    hipDeviceGetAttribute(&cus, hipDeviceAttributeMultiprocessorCount, dev);
    hipOccupancyMaxActiveBlocksPerMultiprocessor(&per_cu, mega_kernel<-1>, NTHREADS, 0);
    per_cu = 1;
    grid_blocks = cus * per_cu;
  }
#if MK_SPLIT
  mega_kernel<0><<<grid_blocks, NTHREADS, 0, stream>>>(p);
  mega_kernel<1><<<grid_blocks, NTHREADS, 0, stream>>>(p);
  mega_kernel<2><<<grid_blocks, NTHREADS, 0, stream>>>(p);
  mega_kernel<3><<<grid_blocks, NTHREADS, 0, stream>>>(p);
  mega_kernel<4><<<grid_blocks, NTHREADS, 0, stream>>>(p);
  mega_kernel<5><<<grid_blocks, NTHREADS, 0, stream>>>(p);
  mega_kernel<6><<<grid_blocks, NTHREADS, 0, stream>>>(p);
  mega_kernel<7><<<grid_blocks, NTHREADS, 0, stream>>>(p);
#else
  hipMemsetAsync((char*)d_ws + OFF_bar, 0, XCD_BAR_WORDS * 4, stream);
  void* args[] = {&p};
  hipError_t e = hipLaunchCooperativeKernel((void*)mega_kernel<-1>, dim3(grid_blocks), dim3(NTHREADS), args, 0, stream);
  if (e != hipSuccess) fprintf(stderr, "cooperative launch failed: %s (grid %d)\n", hipGetErrorString(e), grid_blocks);
#endif
}
```

```cpp
#include <hip/hip_runtime.h>
#include <hip/hip_cooperative_groups.h>
#include <stdint.h>
#include <stdio.h>
namespace cg = cooperative_groups;
#ifndef PROBE_DUP
#define PROBE_DUP 0
#endif

#define DI __device__ __forceinline__
typedef unsigned short bf16_t;
typedef __attribute__((ext_vector_type(8))) short bf16x8;
typedef __attribute__((ext_vector_type(4))) short s16x4;
typedef __attribute__((ext_vector_type(16))) float f32x16;
typedef __attribute__((ext_vector_type(2))) float f32x2;
typedef __attribute__((ext_vector_type(2))) __bf16 bf16x2v;
typedef __attribute__((ext_vector_type(4))) unsigned u32x4;
typedef __attribute__((ext_vector_type(2))) unsigned u32x2;
typedef __attribute__((ext_vector_type(4))) float f32x4;
#define MFMA(a, b, c) __builtin_amdgcn_mfma_f32_32x32x16_bf16((a), (b), (c), 0, 0, 0)

constexpr int NTOK = 16384, SEQL = 4096, DM = 1024;
constexpr int INW = 5280, INWP = 5376;
constexpr int NTHREADS = 512;
constexpr float LOG2E = 1.4426950408889634f;
constexpr float QS_SCALE = 0.125f * 1.4426950408889634f;
constexpr float QM_SCALE = 1.4426950408889634f / 9.797958971132712f;
constexpr float EPSN = 1e-6f;

constexpr int XCD_BAR_WORDS_C = 3456;
constexpr size_t al256(size_t v) { return (v + 255) & ~(size_t)255; }
constexpr size_t OFF_counter = 0;
constexpr size_t OFF_bar = OFF_counter + al256(256);
constexpr size_t OFF_MOD = OFF_bar + al256(XCD_BAR_WORDS_C * 4);
constexpr size_t OFF_ROPE = OFF_MOD + al256(4 * 3072 * 4 * 4);
constexpr size_t OFF_SSQ = OFF_ROPE + al256((size_t)NTOK * 32 * 4);
constexpr size_t OFF_Hb = OFF_SSQ + al256((size_t)2 * NTOK * 4);
constexpr size_t OFF_Qmla = OFF_Hb + al256((size_t)NTOK * 1024 * 2);
constexpr size_t OFF_WuqT = OFF_Qmla + al256((size_t)NTOK * 768 * 2);
constexpr size_t OFF_WukvT = OFF_WuqT + al256((size_t)768 * 384 * 2);
constexpr size_t OFF_WaT = OFF_WukvT + al256((size_t)1024 * 256 * 2);
constexpr size_t OFF_WbT = OFF_WaT + al256((size_t)1024 * 512 * 2);
constexpr size_t OFF_WoT = OFF_WbT + al256((size_t)1024 * 512 * 2);
constexpr size_t OFF_Qsb = OFF_WoT + al256((size_t)1024 * 1024 * 2);
constexpr size_t OFF_Ksb = OFF_Qsb + al256((size_t)NTOK * 512 * 2);
constexpr size_t OFF_VTsb = OFF_Ksb + al256((size_t)NTOK * 512 * 2);
constexpr size_t OFF_Zsb = OFF_VTsb + al256((size_t)NTOK * 512 * 2);
constexpr size_t OFF_OAg = OFF_Zsb + al256((size_t)NTOK * 512 * 2);
constexpr size_t OFF_OBg = OFF_OAg + al256((size_t)NTOK * 512 * 2);
constexpr size_t OFF_Zmla = OFF_OBg + al256((size_t)NTOK * 512 * 2);
constexpr size_t OFF_KPE = OFF_Zmla + al256((size_t)NTOK * 512 * 2);
constexpr size_t OFF_Knope = OFF_KPE + al256((size_t)NTOK * 32 * 2);
constexpr size_t OFF_VTmla = OFF_Knope + al256((size_t)NTOK * 512 * 2);
constexpr size_t OFF_WinT = OFF_VTmla + al256((size_t)NTOK * 512 * 2);
constexpr size_t WS_NEED = OFF_WinT + al256((size_t)INWP * 1024 * 2);
struct Params {
  const float *x, *c; const int* pos;
  const float *w_ada, *b_ada, *norm_gain, *w_in, *q_gain, *w_uq, *kv_gain, *w_ukv, *w_a, *w_b, *w_out, *fgain;
  float* out;
  char* ws;
  DI int* counter() const { return (int*)(ws + OFF_counter); }
  DI unsigned* bar() const { return (unsigned*)(ws + OFF_bar); }
  DI float* MOD() const { return (float*)(ws + OFF_MOD); }
  DI float* ROPE() const { return (float*)(ws + OFF_ROPE); }
  DI float* SSQ() const { return (float*)(ws + OFF_SSQ); }
  DI bf16_t* Hb() const { return (bf16_t*)(ws + OFF_Hb); }
  DI bf16_t* Qmla() const { return (bf16_t*)(ws + OFF_Qmla); }
  DI bf16_t* WuqT() const { return (bf16_t*)(ws + OFF_WuqT); }
  DI bf16_t* WukvT() const { return (bf16_t*)(ws + OFF_WukvT); }
  DI bf16_t* WaT() const { return (bf16_t*)(ws + OFF_WaT); }
  DI bf16_t* WbT() const { return (bf16_t*)(ws + OFF_WbT); }
  DI bf16_t* WoT() const { return (bf16_t*)(ws + OFF_WoT); }
  DI bf16_t* Qsb() const { return (bf16_t*)(ws + OFF_Qsb); }
  DI bf16_t* Ksb() const { return (bf16_t*)(ws + OFF_Ksb); }
  DI bf16_t* VTsb() const { return (bf16_t*)(ws + OFF_VTsb); }
  DI bf16_t* Zsb() const { return (bf16_t*)(ws + OFF_Zsb); }
  DI bf16_t* OAg() const { return (bf16_t*)(ws + OFF_OAg); }
  DI bf16_t* OBg() const { return (bf16_t*)(ws + OFF_OBg); }
  DI bf16_t* Zmla() const { return (bf16_t*)(ws + OFF_Zmla); }
  DI bf16_t* KPE() const { return (bf16_t*)(ws + OFF_KPE); }
  DI bf16_t* Knope() const { return (bf16_t*)(ws + OFF_Knope); }
  DI bf16_t* VTmla() const { return (bf16_t*)(ws + OFF_VTmla); }
  DI bf16_t* MERGED() const { return Hb(); }
  DI bf16_t* WinT() const { return (bf16_t*)(ws + OFF_WinT); }
  DI bf16_t* CQ() const { return OAg(); }
  DI bf16_t* CKV() const { return OBg(); }
  DI bf16_t* GA() const { return (bf16_t*)out; }
  DI bf16_t* GB() const { return (bf16_t*)out + (size_t)NTOK * 1024; }
};


__device__ const float c_invfreq[16] = {
  1.0f, 0.5623413251903491f, 0.31622776601683794f, 0.1778279410038923f, 0.1f, 0.05623413251903491f, 0.03162277660168379f,
  0.01778279410038923f, 0.01f, 0.005623413251903491f, 0.0031622776601683794f, 0.001778279410038923f, 0.001f,
  0.0005623413251903491f, 0.00031622776601683794f, 0.0001778279410038923f};

DI unsigned pk2(float a, float b) { f32x2 v = {a, b}; bf16x2v r = __builtin_convertvector(v, bf16x2v); return __builtin_bit_cast(unsigned, r); }
DI bf16_t tobf(float a) { return (bf16_t)(pk2(a, 0.f) & 0xffffu); }
DI float bf2f(unsigned short u) { return __uint_as_float(((unsigned)u) << 16); }
DI bf16x8 pack8(float a0, float a1, float a2, float a3, float a4, float a5, float a6, float a7) {
  u32x4 p; p[0] = pk2(a0, a1); p[1] = pk2(a2, a3); p[2] = pk2(a4, a5); p[3] = pk2(a6, a7);
  return __builtin_bit_cast(bf16x8, p);
}
DI int crow(int reg, int h) { return (reg & 3) + 8 * (reg >> 2) + 4 * h; }
DI int opaque_tid() { int t = threadIdx.x; asm volatile("" : "+v"(t)); return t; }
DI float half_max(float v) {
  unsigned u = __float_as_uint(v);
  auto r = __builtin_amdgcn_permlane32_swap(u, u, false, false);
  return fmaxf(__uint_as_float(r[0]), __uint_as_float(r[1]));
}
DI float half_sum(float v) {
  unsigned u = __float_as_uint(v);
  auto r = __builtin_amdgcn_permlane32_swap(u, u, false, false);
  return __uint_as_float(r[0]) + __uint_as_float(r[1]);
}
DI float sigmoidf_fast(float v) { return __builtin_amdgcn_rcpf(1.f + __builtin_amdgcn_exp2f(-v * LOG2E)); }
DI float siluf_fast(float v) { return v * sigmoidf_fast(v); }

#define XB_TMO      128
#define XB_XCNT(j)  (256  + 64 * (j))
#define XB_XSUB(j)  (1280 + 64 * (j))
#define XB_XGEN(j)  (2304 + 64 * (j))
#define XB_TOP      3328
#define XB_TOPGEN   3392
#define XCD_BAR_WORDS 3456
#define XB_SPIN_CAP (1u << 18)
#define LAS __attribute__((address_space(3)))
DI unsigned xb_ld(unsigned* p)              { return __hip_atomic_load(p, __ATOMIC_RELAXED, __HIP_MEMORY_SCOPE_AGENT); }
DI unsigned xb_add(unsigned* p, unsigned v) { return __hip_atomic_fetch_add(p, v, __ATOMIC_RELAXED, __HIP_MEMORY_SCOPE_AGENT); }
DI unsigned xb_xcc_id() { return (unsigned)__builtin_amdgcn_s_getreg((3 << 11) | 20) & 0xFu; }
#define XB_SPIN(cond, bar) do { unsigned _sp = 0; while (cond) { __builtin_amdgcn_s_sleep(1); \
    if ((++_sp & 255u) == 0u) { if (xb_ld(&(bar)[XB_TMO])) break; if (_sp > XB_SPIN_CAP) { atomicAdd(&(bar)[XB_TMO], 1u); break; } } } } while (0)
struct XcdBarrier { unsigned* bar; unsigned x; volatile LAS unsigned* st; };
DI XcdBarrier xcd_barrier_post(unsigned* bar, volatile LAS unsigned* st) {
  XcdBarrier b; b.bar = bar; b.x = xb_xcc_id(); b.st = st;
  if (threadIdx.x == 0) (void)xb_add(&bar[XB_XCNT(b.x)], 1u);
  return b;
}
DI void xcd_barrier_complete(unsigned* bar, unsigned x, unsigned& nloc, unsigned& nx) {
  const unsigned G = gridDim.x * gridDim.y * gridDim.z;
  unsigned sum, cnt, mine, sp = 0u;
  for (;;) {
    sum = 0u; cnt = 0u; mine = 0u;
#pragma unroll
    for (unsigned j = 0; j < 16; ++j) { const unsigned c = xb_ld(&bar[XB_XCNT(j)]); sum += c; cnt += (c > 0u) ? 1u : 0u; mine = (j == x) ? c : mine; }
    if (sum == G) break;
    __builtin_amdgcn_s_sleep(1);
    if ((++sp & 255u) == 0u) { if (xb_ld(&bar[XB_TMO])) break; if (sp > XB_SPIN_CAP) { atomicAdd(&bar[XB_TMO], 1u); break; } }
  }
  nloc = mine > 0u ? mine : 1u; nx = cnt > 0u ? cnt : 1u;
}
DI void xcd_barrier(unsigned* bar_, volatile LAS unsigned* st_) {
  XcdBarrier b; b.bar = bar_; b.st = st_; b.x = 0;
  asm volatile("s_waitcnt vmcnt(0)" ::: "memory");
  __syncthreads();
  if (threadIdx.x == 0) {
    unsigned* bar = b.bar;
    b.x = xb_xcc_id();
    __builtin_amdgcn_s_waitcnt(0);
    unsigned nloc = b.st[0], nx = b.st[1];
    if (nloc == 0u) { xcd_barrier_complete(bar, b.x, nloc, nx); b.st[0] = nloc; b.st[1] = nx; }
    const unsigned old = xb_add(&bar[XB_XSUB(b.x)], 1u);
    const unsigned gen = old / nloc;
    if (old + 1u == (gen + 1u) * nloc) {
      __builtin_amdgcn_fence(__ATOMIC_RELEASE, "agent");
      asm volatile("s_waitcnt vmcnt(0)" ::: "memory");
      const unsigned og = xb_add(&bar[XB_TOP], 1u);
      const unsigned tg = og / nx;
      if (og + 1u == (tg + 1u) * nx) xb_add(&bar[XB_TOPGEN], 1u);
      else XB_SPIN(xb_ld(&bar[XB_TOPGEN]) == tg, bar);
      __builtin_amdgcn_fence(__ATOMIC_ACQUIRE, "agent");
      xb_add(&bar[XB_XGEN(b.x)], 1u);
      asm volatile("s_waitcnt vmcnt(0)" ::: "memory");
    } else {
      XB_SPIN(xb_ld(&bar[XB_XGEN(b.x)]) == gen, bar);
      __builtin_amdgcn_fence(__ATOMIC_ACQUIRE, "agent");
      asm volatile("s_waitcnt vmcnt(0)" ::: "memory");
    }
  }
  __syncthreads();
}

constexpr int GSTR = 72;
constexpr int GBUF = 128 * GSTR;
constexpr int SMEM_BYTES = 131072 + 4096;

constexpr int G8_HT = 128 * 64;
DI int lds_byte(int r, int c) { const int st = (r >> 4) * 2 + (c >> 5), rr = r & 15, cc = c & 31, ob = rr * 64 + cc * 2; return st * 1024 + (ob ^ (((ob >> 9) & 1) << 5)); }
DI void stage_rc(int b, int& R, int& C) { const int st = b / 1024, sb = b % 1024, swz = sb ^ (((sb >> 9) & 1) << 5); R = (st >> 1) * 16 + swz / 64; C = (st & 1) * 32 + (swz % 64) / 2; }

DI void gemm8_tile(const bf16_t* __restrict__ A, const bf16_t* __restrict__ Bt, const int K, bf16_t* shm, f32x4 (&acc)[2][2][4][2]) {
  const int tid = opaque_tid();
  const int wid = tid >> 6, lane = tid & 63, wr = wid >> 2, wc = wid & 3, fr = lane & 15, fq = lane >> 4;
  const int swz = (fr * 64 + fq * 16) ^ ((fr >> 3) << 5);
  const char* aRd = (const char*)shm + swz + wr * 8192;
  const char* bRd = (const char*)shm + 65536 + swz + wc * 4096;
  int sr0, sc0, sr1, sc1;
  stage_rc(tid * 16, sr0, sc0);
  stage_rc(tid * 16 + 8192, sr1, sc1);
  const unsigned so0 = (unsigned)(sr0 * K + sc0) * 2u, so1 = (unsigned)(sr1 * K + sc1) * 2u;
  char* const stw = (char*)shm + __builtin_amdgcn_readfirstlane(tid & ~63) * 16;
  const char* const Ab = (const char*)A;
  const char* const Bb = (const char*)Bt;
#define SA(b, h) (((b) * 2 + (h)) * 16384)
#define SB(b, h) ((4 + (b) * 2 + (h)) * 16384)
#define STAGE(P, BASE, br, kt) do { const char* g_ = (BASE) + ((long)(br) * K + (long)(kt) * 64) * 2;                        \
    __builtin_amdgcn_global_load_lds((const unsigned*)(g_ + so0), (unsigned*)(stw + (P)), 16, 0, 0);                          \
    __builtin_amdgcn_global_load_lds((const unsigned*)(g_ + so1), (unsigned*)(stw + (P) + 8192), 16, 0, 0); } while (0)
#define LDA(dst, b, h) _Pragma("unroll") for (int m = 0; m < 4; ++m) _Pragma("unroll") for (int k = 0; k < 2; ++k) \
    dst[m][k] = *reinterpret_cast<const bf16x8*>(aRd + ((b) * 2 + (h)) * 16384 + (m * 2 + k) * 1024)
#define LDB(dst, b, h) _Pragma("unroll") for (int n = 0; n < 2; ++n) _Pragma("unroll") for (int k = 0; k < 2; ++k) \
    dst[n][k] = *reinterpret_cast<const bf16x8*>(bRd + ((b) * 2 + (h)) * 16384 + (n * 2 + k) * 1024)
#define MMA(ai, bj, At_, Bt_) do { __builtin_amdgcn_s_setprio(1);                                                          \
    _Pragma("unroll") for (int m = 0; m < 4; ++m) _Pragma("unroll") for (int n = 0; n < 2; ++n) _Pragma("unroll") for (int k = 0; k < 2; ++k) \
      acc[ai][bj][m][n] = __builtin_amdgcn_mfma_f32_16x16x32_bf16(At_[m][k], Bt_[n][k], acc[ai][bj][m][n], 0, 0, 0);       \
    __builtin_amdgcn_s_setprio(0); } while (0)
#define WAIT_V(n) asm volatile("s_waitcnt vmcnt(" #n ")" ::: "memory")
#define WAIT_L(n) asm volatile("s_waitcnt lgkmcnt(" #n ")" ::: "memory")
#define BAR __builtin_amdgcn_s_barrier()
#define SCHED __builtin_amdgcn_sched_barrier(0)
  bf16x8 At[4][2], B0[2][2], B1[2][2];
  const int nt = K / 64;
  WAIT_V(0);
  STAGE(SB(0, 0), Bb, 0, 0); STAGE(SA(0, 0), Ab, 0, 0);
  STAGE(SB(0, 1), Bb, 128, 0); STAGE(SA(0, 1), Ab, 128, 0);
  if (wr == 1) BAR;
  WAIT_V(4); BAR;
  STAGE(SB(1, 0), Bb, 0, 1); STAGE(SA(1, 0), Ab, 0, 1); STAGE(SB(1, 1), Bb, 128, 1);
  WAIT_V(6); BAR;
  for (int t = 0; t < nt - 2; t += 2) {
    LDB(B0, 0, 0); SCHED; LDA(At, 0, 0); STAGE(SA(1, 1), Ab, 128, t + 1);
    WAIT_L(8); BAR; WAIT_L(0); MMA(0, 0, At, B0); BAR; SCHED;
    LDB(B1, 0, 1); STAGE(SB(0, 0), Bb, 0, t + 2);
    BAR; WAIT_L(0); MMA(0, 1, At, B1); BAR;
    LDA(At, 0, 1); STAGE(SA(0, 0), Ab, 0, t + 2);
    BAR; WAIT_L(0); MMA(1, 0, At, B0); BAR; SCHED;
    STAGE(SB(0, 1), Bb, 128, t + 2);
    WAIT_V(6); BAR; MMA(1, 1, At, B1); BAR;
    LDB(B0, 1, 0); SCHED; LDA(At, 1, 0); STAGE(SA(0, 1), Ab, 128, t + 2);
    WAIT_L(8); BAR; WAIT_L(0); MMA(0, 0, At, B0); BAR; SCHED;
    LDB(B1, 1, 1); STAGE(SB(1, 0), Bb, 0, t + 3);
    BAR; WAIT_L(0); MMA(0, 1, At, B1); BAR;
    LDA(At, 1, 1); STAGE(SA(1, 0), Ab, 0, t + 3);
    BAR; WAIT_L(0); MMA(1, 0, At, B0); BAR; SCHED;
    STAGE(SB(1, 1), Bb, 128, t + 3);
    WAIT_V(6); BAR; MMA(1, 1, At, B1); BAR;
  }
  { LDB(B0, 0, 0); LDA(At, 0, 0); STAGE(SA(1, 1), Ab, 128, nt - 1);
    BAR; WAIT_L(0); MMA(0, 0, At, B0); BAR;
    LDB(B1, 0, 1); BAR; WAIT_L(0); MMA(0, 1, At, B1); BAR;
    LDA(At, 0, 1); WAIT_V(4); BAR; WAIT_L(0); MMA(1, 0, At, B0); MMA(1, 1, At, B1); BAR; }
  { LDB(B0, 1, 0); LDA(At, 1, 0); WAIT_V(2); BAR; WAIT_L(0); MMA(0, 0, At, B0); BAR;
    LDB(B1, 1, 1); WAIT_V(0); BAR; WAIT_L(0); MMA(0, 1, At, B1); BAR;
    LDA(At, 1, 1); BAR; WAIT_L(0); MMA(1, 0, At, B0); MMA(1, 1, At, B1); BAR; }
  if (wr == 0) BAR;
#undef SA
#undef SB
#undef STAGE
#undef LDA
#undef LDB
#undef MMA
#undef WAIT_V
#undef WAIT_L
#undef BAR
#undef SCHED
}


DI void zero_acc8(f32x4 (&acc)[2][2][4][2]) {
#pragma unroll
  for (int a = 0; a < 2; ++a)
#pragma unroll
    for (int b = 0; b < 2; ++b)
#pragma unroll
      for (int m = 0; m < 4; ++m)
#pragma unroll
        for (int n = 0; n < 2; ++n) acc[a][b][m][n] = f32x4{0.f, 0.f, 0.f, 0.f};
}

constexpr int CSTR = 132;
DI void accq_to_lds(const f32x4 (&q)[4][2], float* sC) {
  const int tid = opaque_tid(), wid = tid >> 6, lane = tid & 63, wr = wid >> 2, wc = wid & 3, fr = lane & 15, fq = lane >> 4;
#pragma unroll
  for (int m = 0; m < 4; ++m)
#pragma unroll
    for (int n = 0; n < 2; ++n)
#pragma unroll
      for (int j = 0; j < 4; ++j) sC[(wr * 64 + m * 16 + fq * 4 + j) * CSTR + wc * 32 + n * 16 + fr] = q[m][n][j];
}
template <class F>
DI void epi_rows(const float* sC, F f) {
  const int tx = opaque_tid();
#pragma unroll
  for (int i = 0; i < 4; ++i) {
    const int c = tx + 512 * i, row = c >> 4, cc = (c & 15) * 8;
    const float4 a = *(const float4*)(sC + row * CSTR + cc), b = *(const float4*)(sC + row * CSTR + cc + 4);
    const float v[8] = {a.x, a.y, a.z, a.w, b.x, b.y, b.z, b.w};
    f(i, row, cc, v);
  }
}
DI void store8(bf16_t* p, const float (&v)[8]) { *(bf16x8*)p = pack8(v[0], v[1], v[2], v[3], v[4], v[5], v[6], v[7]); }
DI void epi_vt(const float* sC, bf16_t* VT, int m0, int head0, int c0, int ncol_log2) {
  const int b = m0 >> 12, s0 = m0 & 4095;
  const int nitems = 16 << ncol_log2;
  for (int c = opaque_tid(); c < nitems; c += 512) {
    const int col = c & ((1 << ncol_log2) - 1), rc = c >> ncol_log2;
    float v[8];
#pragma unroll
    for (int j = 0; j < 8; ++j) v[j] = sC[(rc * 8 + j) * CSTR + c0 + col];
    const int head = head0 + (col >> 6), d = col & 63;
    store8(VT + ((size_t)((b * 8 + head) * 64 + d)) * SEQL + s0 + rc * 8, v);
  }
}
DI void rope8(const float* sC, const float* ROPE, int tok, int row, int cc, float (&v)[8]) {
  const float* pr = sC + row * CSTR + (cc ^ 16);
  const bool upper = (cc & 16) != 0;
  const int f0 = cc & 15;
  const float* tb = ROPE + (size_t)tok * 32;
#pragma unroll
  for (int j = 0; j < 8; ++j) {
    const float o = pr[j], cs = tb[f0 + j], sn = tb[16 + f0 + j];
    v[j] = upper ? (o * sn + v[j] * cs) : (v[j] * cs - o * sn);
  }
}

DI void wconv_unit(const float* __restrict__ src, int Nsrc, int K, bf16_t* __restrict__ dst, const float* __restrict__ gain, int ng, int kg, int mode, float* tile, const int tid) {
  {
    const int k = tid >> 2, cq = tid & 3;
    const int n = ng * 64 + cq * 16;
    int sc = n;
    if (mode == 1) { sc = (n < 2688) ? n : (n < 5248 ? n + 32 : (n < 5280 ? n - 2560 : -1)); }
    const int kk = kg * 64 + k;
    float4 v[4];
    if (sc >= 0) {
      const float* sp = src + (size_t)kk * Nsrc + sc;
#pragma unroll
      for (int i = 0; i < 4; ++i) v[i] = *(const float4*)(sp + 4 * i);
      if (gain) { const float g = gain[kk];
#pragma unroll
        for (int i = 0; i < 4; ++i) { v[i].x *= g; v[i].y *= g; v[i].z *= g; v[i].w *= g; } }
    } else {
#pragma unroll
      for (int i = 0; i < 4; ++i) v[i] = make_float4(0.f, 0.f, 0.f, 0.f);
    }
    float* tp = tile + k * 65 + cq * 16;
#pragma unroll
    for (int i = 0; i < 4; ++i) { tp[4 * i] = v[i].x; tp[4 * i + 1] = v[i].y; tp[4 * i + 2] = v[i].z; tp[4 * i + 3] = v[i].w; }
  }
  __syncthreads();
  {
    const int n = tid >> 2, kc = tid & 3;
    float o[16];
#pragma unroll
    for (int j = 0; j < 16; ++j) o[j] = tile[(kc * 16 + j) * 65 + n];
    bf16_t* dp = dst + (size_t)(ng * 64 + n) * K + kg * 64 + kc * 16;
    *(bf16x8*)dp = pack8(o[0], o[1], o[2], o[3], o[4], o[5], o[6], o[7]);
    *(bf16x8*)(dp + 8) = pack8(o[8], o[9], o[10], o[11], o[12], o[13], o[14], o[15]);
  }
  __syncthreads();
}

DI void phase_prep(const Params& p, char* smem) {
  if (blockIdx.x == 0 && threadIdx.x < 16) { p.counter()[threadIdx.x] = 0; }
  for (int i = blockIdx.x * NTHREADS + threadIdx.x; i < 2 * NTOK; i += gridDim.x * NTHREADS) p.SSQ()[i] = 0.f;
  const int half = threadIdx.x >> 8, tid = threadIdx.x & 255;
  constexpr int U_MOD = 96 * 4, U_WIN = 84 * 16, U_WUQ = 12 * 6, U_WUKV = 16 * 4, U_WA = 16 * 8, U_WB = 16 * 8, U_WO = 16 * 16, U_ROPE = 1024;
  constexpr int U_TOTAL = U_MOD + U_ROPE + U_WIN + U_WUQ + U_WUKV + U_WA + U_WB + U_WO;
  float* tile = (float*)smem + half * (64 * 65 + 64);
  for (int up = blockIdx.x; up < U_TOTAL / 2; up += gridDim.x) {
    int v = 2 * up + half;
    if (v < U_MOD) {
      const int cg32 = v >> 2, kq = v & 3, n0 = cg32 * 32;
      const int kgp = tid >> 5, col = tid & 31;
      const int kb = kq * 256 + kgp * 32;
      float a0 = 0.f, a1 = 0.f, a2 = 0.f, a3 = 0.f;
      const float* wp = p.w_ada + (size_t)kb * 3072 + n0 + col;
      float wv[32];
#pragma unroll
      for (int kk = 0; kk < 32; ++kk) wv[kk] = wp[(size_t)kk * 3072];
#pragma unroll
      for (int kk = 0; kk < 32; ++kk) {
        a0 += wv[kk] * p.c[kb + kk]; a1 += wv[kk] * p.c[1024 + kb + kk]; a2 += wv[kk] * p.c[2048 + kb + kk]; a3 += wv[kk] * p.c[3072 + kb + kk];
      }
      float* red = (float*)smem + half * 1024;
      red[(kgp * 4 + 0) * 32 + col] = a0; red[(kgp * 4 + 1) * 32 + col] = a1; red[(kgp * 4 + 2) * 32 + col] = a2; red[(kgp * 4 + 3) * 32 + col] = a3;
      __syncthreads();
      if (tid < 128) {
        const int b = tid >> 5, cc = tid & 31;
        float s = (kq == 0) ? p.b_ada[n0 + cc] : 0.f;
#pragma unroll
        for (int g = 0; g < 8; ++g) s += red[(g * 4 + b) * 32 + cc];
        p.MOD()[(size_t)(b * 3072 + n0 + cc) * 4 + kq] = s;
      }
      __syncthreads();
      continue;
    }
    v -= U_MOD;
    if (v < U_WIN) { wconv_unit(p.w_in, INW, 1024, p.WinT(), nullptr, v >> 4, v & 15, 1, tile, tid); continue; }
    v -= U_WIN;
    if (v < U_WUQ) { wconv_unit(p.w_uq, 768, 384, p.WuqT(), p.q_gain, v / 6, v % 6, 0, tile, tid); continue; }
    v -= U_WUQ;
    if (v < U_WUKV) { wconv_unit(p.w_ukv, 1024, 256, p.WukvT(), p.kv_gain, v >> 2, v & 3, 0, tile, tid); continue; }
    v -= U_WUKV;
    if (v < U_WA) { wconv_unit(p.w_a, 1024, 512, p.WaT(), nullptr, v >> 3, v & 7, 0, tile, tid); continue; }
    v -= U_WA;
    if (v < U_WB) { wconv_unit(p.w_b, 1024, 512, p.WbT(), nullptr, v >> 3, v & 7, 0, tile, tid); continue; }
    v -= U_WB;
    if (v < U_WO) { wconv_unit(p.w_out, 1024, 1024, p.WoT(), nullptr, v >> 4, v & 15, 0, tile, tid); continue; }
    v -= U_WO;
    {
      const int idx = v * 256 + tid, tok = idx >> 4, i = idx & 15;
      const float ang = (float)p.pos[tok] * c_invfreq[i];
      double t = (double)ang * 0.15915494309189535;
      t -= rint(t);
      const float tf = (float)t;
      p.ROPE()[(size_t)tok * 32 + i] = __builtin_amdgcn_cosf(tf);
      p.ROPE()[(size_t)tok * 32 + 16 + i] = __builtin_amdgcn_sinf(tf);
    }
  }
}

DI float mod_get(const float* MOD, int b, int n) { const float4 q = *(const float4*)(MOD + (size_t)(b * 3072 + n) * 4); return (q.x + q.y) + (q.z + q.w); }

DI void phase_h(const Params& p, char* smem) {
  const int tid = opaque_tid(), lane = tid & 63, w = tid >> 6;
  float* gs = (float*)smem;
  float* sh = gs + 1024;
  const int xq = blockIdx.x & 7, lb = blockIdx.x >> 3, nlb = gridDim.x >> 3;
  const bool xmap = (gridDim.x & 7) == 0;
  for (int rgi = xmap ? lb : (int)blockIdx.x; rgi < (xmap ? 32 : NTOK / 64); rgi += (xmap ? nlb : (int)gridDim.x)) {
    const int rg = xmap ? (32 * xq + rgi) : rgi;
    const int b = (rg * 64) >> 12;
    __syncthreads();
#pragma unroll
    for (int i = 0; i < 2; ++i) {
      const int k = tid + 512 * i;
      gs[k] = p.norm_gain[k] * (1.f + mod_get(p.MOD(), b, 1024 + k));
      sh[k] = mod_get(p.MOD(), b, k);
    }
    __syncthreads();
#pragma unroll 2
    for (int rr = 0; rr < 8; ++rr) {
      const int row = rg * 64 + w * 8 + rr;
      const float* xr = p.x + (size_t)row * DM;
      float4 v[4];
      float ss = 0.f;
#pragma unroll
      for (int i = 0; i < 2; ++i) {
        const int e = 8 * (lane + 64 * i);
        v[2 * i] = *(const float4*)(xr + e);
        v[2 * i + 1] = *(const float4*)(xr + e + 4);
        ss += v[2 * i].x * v[2 * i].x + v[2 * i].y * v[2 * i].y + v[2 * i].z * v[2 * i].z + v[2 * i].w * v[2 * i].w;
        ss += v[2 * i + 1].x * v[2 * i + 1].x + v[2 * i + 1].y * v[2 * i + 1].y + v[2 * i + 1].z * v[2 * i + 1].z + v[2 * i + 1].w * v[2 * i + 1].w;
      }
#pragma unroll
      for (int o = 32; o >= 1; o >>= 1) ss += __shfl_xor(ss, o);
      const float rn = __builtin_amdgcn_rsqf(ss * (1.f / DM) + EPSN);
#pragma unroll
      for (int i = 0; i < 2; ++i) {
        const int e = 8 * (lane + 64 * i);
        const float4 g0 = *(const float4*)(gs + e), g1 = *(const float4*)(gs + e + 4);
        const float4 s0 = *(const float4*)(sh + e), s1 = *(const float4*)(sh + e + 4);
        *(bf16x8*)(p.Hb() + (size_t)row * DM + e) =
            pack8(v[2 * i].x * rn * g0.x + s0.x, v[2 * i].y * rn * g0.y + s0.y, v[2 * i].z * rn * g0.z + s0.z, v[2 * i].w * rn * g0.w + s0.w,
                  v[2 * i + 1].x * rn * g1.x + s1.x, v[2 * i + 1].y * rn * g1.y + s1.y, v[2 * i + 1].z * rn * g1.z + s1.z, v[2 * i + 1].w * rn * g1.w + s1.w);
      }
    }
  }
  __syncthreads();
}

DI void g1_epi(const Params& p, const float* sC, const int m0, const int n0, const int ct, const bool do_ssq) {
    if (ct < 4) {
      epi_rows(sC, [&](int, int row, int cc, const float (&v)[8]) {
        float o[8];
#pragma unroll
        for (int j = 0; j < 8; ++j) o[j] = v[j] * QS_SCALE;
        store8(p.Qsb() + (size_t)(m0 + row) * 512 + n0 + cc, o); });
    } else if (ct < 8) {
      epi_rows(sC, [&](int, int row, int cc, const float (&v)[8]) { store8(p.Ksb() + (size_t)(m0 + row) * 512 + n0 - 512 + cc, v); });
    } else if (ct < 12) {
      epi_vt(sC, p.VTsb(), m0, (n0 - 1024) >> 6, 0, 7);
    } else if (ct < 16) {
      epi_rows(sC, [&](int, int row, int cc, const float (&v)[8]) {
        float o[8];
#pragma unroll
        for (int j = 0; j < 8; ++j) o[j] = siluf_fast(v[j]);
        store8(p.Zsb() + (size_t)(m0 + row) * 512 + n0 - 1536 + cc, o); });
    } else if (ct < 19) {
      epi_rows(sC, [&](int, int row, int cc, const float (&v)[8]) {
        store8(p.CQ() + (size_t)(m0 + row) * 384 + n0 - 2048 + cc, v);
        float q = 0.f;
#pragma unroll
        for (int j = 0; j < 8; ++j) q += v[j] * v[j];
        q += __shfl_xor(q, 1); q += __shfl_xor(q, 2); q += __shfl_xor(q, 4); q += __shfl_xor(q, 8);
        if (do_ssq && (threadIdx.x & 15) == 0) atomicAdd(p.SSQ() + m0 + row, q); });
    } else if (ct < 21) {
      epi_rows(sC, [&](int, int row, int cc, const float (&v)[8]) {
        store8(p.CKV() + (size_t)(m0 + row) * 256 + n0 - 2432 + cc, v);
        float q = 0.f;
#pragma unroll
        for (int j = 0; j < 8; ++j) q += v[j] * v[j];
        q += __shfl_xor(q, 1); q += __shfl_xor(q, 2); q += __shfl_xor(q, 4); q += __shfl_xor(q, 8);
        if (do_ssq && (threadIdx.x & 15) == 0) atomicAdd(p.SSQ() + NTOK + m0 + row, q); });
    } else if (ct < 25) {
      epi_rows(sC, [&](int, int row, int cc, const float (&v)[8]) {
        float o[8];
#pragma unroll
        for (int j = 0; j < 8; ++j) o[j] = siluf_fast(v[j]);
        store8(p.Zmla() + (size_t)(m0 + row) * 512 + n0 - 2688 + cc, o); });
    } else if (ct < 33) {
      epi_rows(sC, [&](int, int row, int cc, const float (&v)[8]) {
        float o[8];
#pragma unroll
        for (int j = 0; j < 8; ++j) o[j] = sigmoidf_fast(v[j]);
        store8(p.GA() + (size_t)(m0 + row) * 1024 + n0 - 3200 + cc, o); });
    } else if (ct < 41) {
      epi_rows(sC, [&](int, int row, int cc, const float (&v)[8]) {
        float o[8];
#pragma unroll
        for (int j = 0; j < 8; ++j) o[j] = sigmoidf_fast(v[j]);
        store8(p.GB() + (size_t)(m0 + row) * 1024 + n0 - 4224 + cc, o); });
    } else {
      epi_rows(sC, [&](int, int row, int cc, const float (&v)[8]) {
        if (cc < 32) {
          float o[8];
#pragma unroll
          for (int j = 0; j < 8; ++j) o[j] = v[j];
          rope8(sC, p.ROPE(), m0 + row, row, cc, o);
          store8(p.KPE() + (size_t)(m0 + row) * 32 + cc, o);
        } });
    }
}

DI void g1_tile(const Params& p, char* smem, const int rt, const int ct2, const bool do_ssq) {
  bf16_t* shm = (bf16_t*)smem;
  float* sC = (float*)smem;
  const int m0 = rt * 256, n0 = ct2 * 256;
  f32x4 acc[2][2][4][2];
  zero_acc8(acc);
  gemm8_tile(p.Hb() + (size_t)m0 * DM, p.WinT() + (size_t)n0 * DM, DM, shm, acc);
#pragma unroll
  for (int ai = 0; ai < 2; ++ai)
#pragma unroll
    for (int bj = 0; bj < 2; ++bj) {
      __syncthreads();
      accq_to_lds(acc[ai][bj], sC);
      __syncthreads();
      g1_epi(p, sC, m0 + ai * 128, n0 + bj * 128, ct2 * 2 + bj, do_ssq);
    }
  __syncthreads();
}

constexpr int G1_NCT = 20;
DI void phase_g1(const Params& p, char* smem, bool do_ssq = true) {
  const int xq = blockIdx.x & 7, lb = blockIdx.x >> 3, nlb = gridDim.x >> 3;
  const bool xmap = (gridDim.x & 7) == 0;
  for (int t = xmap ? lb : (int)blockIdx.x; t < (xmap ? 8 * G1_NCT : 64 * G1_NCT); t += (xmap ? nlb : (int)gridDim.x)) {
    int rt, ct2;
    if (xmap) { ct2 = t >> 3; rt = 8 * xq + (t & 7); } else { rt = t / G1_NCT; ct2 = t % G1_NCT; }
    g1_tile(p, smem, rt, ct2, do_ssq);
  }
}

DI void g2_epi_q(const Params& p, const float* sC, const float* rsq, const int m0, const int n0) {
  epi_rows(sC, [&](int, int row, int cc, const float (&v)[8]) {
    const int col = n0 + cc;
    float o[8];
#pragma unroll
    for (int j = 0; j < 8; ++j) o[j] = v[j];
    if (((col >> 5) % 3) == 2) rope8(sC, p.ROPE(), m0 + row, row, cc, o);
    const float sc = rsq[row] * QM_SCALE;
#pragma unroll
    for (int j = 0; j < 8; ++j) o[j] *= sc;
    store8(p.Qmla() + (size_t)(m0 + row) * 768 + col, o);
  });
}
DI void g2_epi_kv(const Params& p, const float* sC, const float* rsq, const int m0, const int head) {
  epi_rows(sC, [&](int, int row, int cc, const float (&v)[8]) {
    if (cc < 64) {
      const float sc = rsq[row];
      float o[8];
#pragma unroll
      for (int j = 0; j < 8; ++j) o[j] = v[j] * sc;
      store8(p.Knope() + (size_t)(m0 + row) * 512 + head * 64 + cc, o);
    } });
  const int b = m0 >> 12, s0 = m0 & 4095;
  for (int c = opaque_tid(); c < 1024; c += 512) {
    const int col = c & 63, rc = c >> 6;
    float v[8];
#pragma unroll
    for (int j = 0; j < 8; ++j) v[j] = sC[(rc * 8 + j) * CSTR + 64 + col] * rsq[rc * 8 + j];
    store8(p.VTmla() + ((size_t)((b * 8 + head) * 64 + col)) * SEQL + s0 + rc * 8, v);
  }
}

DI void g2_tile(const Params& p, char* smem, const bool isq, const int rt, const int ct) {
  bf16_t* shm = (bf16_t*)smem;
  float* sC = (float*)smem;
  float* rs = (float*)(smem + 131072);
  const int m0 = rt * 256, n0 = ct * 256;
  f32x4 acc[2][2][4][2];
  zero_acc8(acc);
  if (isq) {
    if (threadIdx.x < 256) rs[threadIdx.x] = __builtin_amdgcn_rsqf(p.SSQ()[m0 + threadIdx.x] * (1.f / 384.f) + EPSN);
    gemm8_tile(p.CQ() + (size_t)m0 * 384, p.WuqT() + (size_t)n0 * 384, 384, shm, acc);
#pragma unroll
    for (int ai = 0; ai < 2; ++ai)
#pragma unroll
      for (int bj = 0; bj < 2; ++bj) {
        __syncthreads();
        accq_to_lds(acc[ai][bj], sC);
        __syncthreads();
        g2_epi_q(p, sC, rs + ai * 128, m0 + ai * 128, n0 + bj * 128);
      }
  } else {
    if (threadIdx.x < 256) rs[threadIdx.x] = __builtin_amdgcn_rsqf(p.SSQ()[NTOK + m0 + threadIdx.x] * (1.f / 256.f) + EPSN);
    gemm8_tile(p.CKV() + (size_t)m0 * 256, p.WukvT() + (size_t)n0 * 256, 256, shm, acc);
#pragma unroll
    for (int ai = 0; ai < 2; ++ai)
#pragma unroll
      for (int bj = 0; bj < 2; ++bj) {
        __syncthreads();
        accq_to_lds(acc[ai][bj], sC);
        __syncthreads();
        g2_epi_kv(p, sC, rs + ai * 128, m0 + ai * 128, ct * 2 + bj);
      }
  }
  __syncthreads();
}

DI void phase_g2(const Params& p, char* smem) {
  const int xq = blockIdx.x & 7, lb = blockIdx.x >> 3, nlb = gridDim.x >> 3;
  if ((gridDim.x & 7) == 0 && nlb == 32) {
    if (lb < 8) { g1_tile(p, smem, 8 * xq + lb, G1_NCT, false); return; }
    const int v = lb - 8;
    g2_tile(p, smem, true, 8 * xq + (v & 7), v >> 3);
    g2_tile(p, smem, false, 8 * xq + (v & 7), v >> 3);
    if (lb < 16) { const int v2 = 24 + v; g2_tile(p, smem, false, 8 * xq + (v2 & 7), v2 >> 3); }
  } else {
    for (int tt = blockIdx.x; tt < 64 + 192 + 256; tt += gridDim.x) {
      if (tt < 64) g1_tile(p, smem, tt, G1_NCT, false);
      else if (tt < 256) { const int v = tt - 64; g2_tile(p, smem, true, v / 3, v % 3); }
      else { const int v = tt - 256; g2_tile(p, smem, false, v >> 2, v & 3); }
    }
  }
}

constexpr int VSTR = 68;

template <bool MLA>
DI void attn_item(const Params& p, int b, int h, int qb, char* smem) {
  constexpr int DK = MLA ? 96 : 64;
  constexpr int KSTR = MLA ? 104 : 72;
  constexpr int NKS = DK / 16;
  bf16_t* sK = (bf16_t*)smem;
  bf16_t* sV = sK + 2 * 64 * KSTR;
  const int tid = threadIdx.x, lane = tid & 63, w = tid >> 6, r = lane & 31, hh = lane >> 5;
  const int tokb = b * SEQL;
  const int tok0 = tokb + qb * 256;
  const int qw = qb * 256 + w * 32;

  bf16x8 qf[NKS];
  {
    const bf16_t* qptr = MLA ? (p.Qmla() + (size_t)(tok0 + w * 32 + r) * 768 + h * 96 + hh * 8) : (p.Qsb() + (size_t)(tok0 + w * 32 + r) * 512 + h * 64 + hh * 8);
#pragma unroll
    for (int ks = 0; ks < NKS; ++ks) qf[ks] = *(const bf16x8*)(qptr + ks * 16);
  }
  bf16x8 tf[2];
  if (!MLA) {
#pragma unroll
    for (int st = 0; st < 2; ++st)
#pragma unroll
      for (int e = 0; e < 8; ++e) { const int j = 16 * st + 8 * (e >> 2) + 4 * hh + (e & 3); tf[st][e] = (j >= r) ? (short)0x3F80 : (short)0; }
  }

  f32x16 oacc[2];
#pragma unroll
  for (int i = 0; i < 16; ++i) { oacc[0][i] = 0.f; oacc[1][i] = 0.f; }
  float carry = 0.f;
  float mrun = 0.f, lrun = 0.f;

  const bf16_t* Kg = MLA ? p.Knope() : p.Ksb();
  const bf16_t* VTg = (MLA ? p.VTmla() : p.VTsb()) + (size_t)((b * 8 + h) * 64) * SEQL;
  const int nt = 4 * qb + 4;

  uint4 xk0, xv0, xp, yk0, yv0, yp;
  xp = make_uint4(0, 0, 0, 0); yp = xp;
  const int prow = tid >> 3, pch = tid & 7;
  const bf16_t* kgp = Kg + (size_t)(tokb + prow) * 512 + h * 64 + pch * 8;
  const bf16_t* vgp = VTg + (size_t)prow * SEQL + pch * 8;
  const bf16_t* pgp = p.KPE() + (size_t)(tokb + ((tid & 255) >> 2)) * 32 + (tid & 3) * 8;
#define ATT_GLOAD(P, kt_)                                                          \
  {                                                                                \
    const int kt__ = (kt_);                                                        \
    P##k0 = *(const uint4*)(kgp + (size_t)(kt__ * 64) * 512);                      \
    P##v0 = *(const uint4*)(vgp + kt__ * 64);                                      \
    if (MLA && tid < 256) P##p = *(const uint4*)(pgp + (size_t)(kt__ * 64) * 32);  \
  }
#define ATT_SWRITE(P, buf_)                                                        \
  {                                                                                \
    bf16_t* dK = sK + (buf_) * 64 * KSTR;                                          \
    bf16_t* dV = sV + (buf_) * 64 * VSTR;                                          \
    *(uint4*)(dK + prow * KSTR + pch * 8) = P##k0;                                 \
    uint2* dv0 = (uint2*)(dV + prow * VSTR + pch * 8);                             \
    dv0[0] = make_uint2(P##v0.x, P##v0.y); dv0[1] = make_uint2(P##v0.z, P##v0.w);  \
    if (MLA && tid < 256) *(uint4*)(dK + (tid >> 2) * KSTR + 64 + (tid & 3) * 8) = P##p; \
  }
#define ATT_KT(i_) (MLA ? (i_) : (nt - 1 - (i_)))

  ATT_GLOAD(x, ATT_KT(0));
  ATT_GLOAD(y, ATT_KT(1));
  ATT_SWRITE(x, 0);
  __syncthreads();
  bool alive = true;
  for (int it0 = 0; alive; it0 += 2) {
#pragma unroll
   for (int half = 0; half < 2; ++half) {
    const int it = it0 + half;
    const int kt = ATT_KT(it);
    const int cur = half;
    const bool more = (it + 1 < nt);
    if (it + 2 < nt) { if (half == 0) ATT_GLOAD(x, ATT_KT(it + 2)) else ATT_GLOAD(y, ATT_KT(it + 2)) }
    const bf16_t* cK = sK + cur * 64 * KSTR;
    const bf16_t* cV = sV + cur * 64 * VSTR;
    if (MLA) {
      if (kt * 64 <= qw + 31) {
        f32x16 s0, s1;
        {
          const float sinit = -mrun;
#pragma unroll
          for (int i = 0; i < 16; ++i) { s0[i] = sinit; s1[i] = sinit; }
        }
        __builtin_amdgcn_s_setprio(1);
#pragma unroll
        for (int ks = 0; ks < NKS; ++ks) {
          const bf16x8 k0 = *(const bf16x8*)(cK + r * KSTR + ks * 16 + hh * 8);
          const bf16x8 k1 = *(const bf16x8*)(cK + (32 + r) * KSTR + ks * 16 + hh * 8);
          s0 = MFMA(k0, qf[ks], s0);
          s1 = MFMA(k1, qf[ks], s1);
        }
        __builtin_amdgcn_s_setprio(0);
        if (kt * 64 + 63 > qw) {
          const int lim = qw + r - kt * 64;
#pragma unroll
          for (int i = 0; i < 16; ++i) { if (crow(i, hh) > lim) s0[i] = -1e30f; if (32 + crow(i, hh) > lim) s1[i] = -1e30f; }
        }
        float m0 = fmaxf(fmaxf(s0[0], s0[1]), s0[2]), m1 = fmaxf(fmaxf(s1[0], s1[1]), s1[2]);
#pragma unroll
        for (int i = 3; i < 15; i += 2) { m0 = fmaxf(fmaxf(m0, s0[i]), s0[i + 1]); m1 = fmaxf(fmaxf(m1, s1[i]), s1[i + 1]); }
        float mloc = fmaxf(fmaxf(m0, s0[15]), fmaxf(m1, s1[15]));
        mloc = half_max(mloc);
        const bool first = (it == 0);
        const float delta = first ? mloc : fmaxf(mloc, 0.f);
        if (first || __builtin_amdgcn_ballot_w64(delta > 0.f) != 0ull) {
          const float alpha = first ? 0.f : __builtin_amdgcn_exp2f(-delta);
          mrun += delta;
          lrun *= alpha;
#pragma unroll
          for (int i = 0; i < 16; ++i) { oacc[0][i] *= alpha; oacc[1][i] *= alpha; s0[i] -= delta; s1[i] -= delta; }
        }
        float ps0 = 0.f, ps1 = 0.f;
#pragma unroll
        for (int i = 0; i < 16; ++i) { s0[i] = __builtin_amdgcn_exp2f(s0[i]); s1[i] = __builtin_amdgcn_exp2f(s1[i]); ps0 += s0[i]; ps1 += s1[i]; }
        lrun += ps0 + ps1;
        bf16x8 pf4[4];
        pf4[0] = pack8(s0[0], s0[1], s0[2], s0[3], s0[4], s0[5], s0[6], s0[7]);
        pf4[1] = pack8(s0[8], s0[9], s0[10], s0[11], s0[12], s0[13], s0[14], s0[15]);
        pf4[2] = pack8(s1[0], s1[1], s1[2], s1[3], s1[4], s1[5], s1[6], s1[7]);
        pf4[3] = pack8(s1[8], s1[9], s1[10], s1[11], s1[12], s1[13], s1[14], s1[15]);
        __builtin_amdgcn_s_setprio(1);
#pragma unroll
        for (int st = 0; st < 4; ++st)
#pragma unroll
          for (int dt = 0; dt < 2; ++dt) {
            const bf16_t* vp = cV + (dt * 32 + r) * VSTR + st * 16 + 4 * hh;
            const s16x4 lo = *(const s16x4*)vp;
            const s16x4 hi = *(const s16x4*)(vp + 8);
            const bf16x8 vf = __builtin_shufflevector(lo, hi, 0, 1, 2, 3, 4, 5, 6, 7);
            oacc[dt] = MFMA(vf, pf4[st], oacc[dt]);
          }
        __builtin_amdgcn_s_setprio(0);
      }
    } else
#pragma unroll
    for (int si = 0; si < 2; ++si) {
      const int sub = MLA ? si : (1 - si);
      const int kb = kt * 64 + sub * 32;
      if (kb > qw) continue;
      const bool diag = (kb == qw);
      f32x16 s;
      {
        const float sinit = MLA ? -mrun : 0.f;
#pragma unroll
        for (int i = 0; i < 16; ++i) s[i] = sinit;
      }
      __builtin_amdgcn_s_setprio(1);
#pragma unroll
      for (int ks = 0; ks < NKS; ++ks) {
        const bf16x8 kf = *(const bf16x8*)(cK + (sub * 32 + r) * KSTR + ks * 16 + hh * 8);
        s = MFMA(kf, qf[ks], s);
      }
      __builtin_amdgcn_s_setprio(0);
      bf16x8 pf[2];
      if (!MLA) {
        float sp[16];
        float tsum = 0.f;
#pragma unroll
        for (int i = 0; i < 16; ++i) {
          const float z = s[i];
          float v = __builtin_amdgcn_logf(1.f + __builtin_amdgcn_exp2f(fminf(z, 126.f)));
          if (diag && !(crow(i, hh) < r)) v = 0.f;
          sp[i] = v;
          tsum += v;
        }
        f32x16 cacc;
#pragma unroll
        for (int i = 0; i < 16; ++i) cacc[i] = carry;
        cacc = MFMA(tf[0], pack8(sp[0], sp[1], sp[2], sp[3], sp[4], sp[5], sp[6], sp[7]), cacc);
        cacc = MFMA(tf[1], pack8(sp[8], sp[9], sp[10], sp[11], sp[12], sp[13], sp[14], sp[15]), cacc);
        float pr[16];
#pragma unroll
        for (int i = 0; i < 16; ++i) {
          float v = __builtin_amdgcn_exp2f(s[i] - cacc[i]);
          if (diag && !(crow(i, hh) < r)) v = 0.f;
          pr[i] = v;
        }
        carry += half_sum(tsum);
        pf[0] = pack8(pr[0], pr[1], pr[2], pr[3], pr[4], pr[5], pr[6], pr[7]);
        pf[1] = pack8(pr[8], pr[9], pr[10], pr[11], pr[12], pr[13], pr[14], pr[15]);
      } else {
        if (diag) {
#pragma unroll
          for (int i = 0; i < 16; ++i) if (!(crow(i, hh) <= r)) s[i] = -1e30f;
        }
        float mloc = fmaxf(fmaxf(s[0], s[1]), s[2]);
#pragma unroll
        for (int i = 3; i < 15; i += 2) mloc = fmaxf(fmaxf(mloc, s[i]), s[i + 1]);
        mloc = fmaxf(mloc, s[15]);
        mloc = half_max(mloc);
        const bool first = (it == 0) && (si == 0);
        const float delta = first ? mloc : fmaxf(mloc, 0.f);
        if (first || __builtin_amdgcn_ballot_w64(delta > 0.f) != 0ull) {
          const float alpha = first ? 0.f : __builtin_amdgcn_exp2f(-delta);
          mrun += delta;
          lrun *= alpha;
#pragma unroll
          for (int i = 0; i < 16; ++i) { oacc[0][i] *= alpha; oacc[1][i] *= alpha; s[i] -= delta; }
        }
        float pr[16];
        float ps0 = 0.f, ps1 = 0.f;
#pragma unroll
        for (int i = 0; i < 16; i += 2) { pr[i] = __builtin_amdgcn_exp2f(s[i]); pr[i + 1] = __builtin_amdgcn_exp2f(s[i + 1]); ps0 += pr[i]; ps1 += pr[i + 1]; }
        lrun += ps0 + ps1;
        pf[0] = pack8(pr[0], pr[1], pr[2], pr[3], pr[4], pr[5], pr[6], pr[7]);
        pf[1] = pack8(pr[8], pr[9], pr[10], pr[11], pr[12], pr[13], pr[14], pr[15]);
      }
      __builtin_amdgcn_s_setprio(1);
#pragma unroll
      for (int dt = 0; dt < 2; ++dt)
#pragma unroll
        for (int st = 0; st < 2; ++st) {
          const bf16_t* vp = cV + (dt * 32 + r) * VSTR + sub * 32 + st * 16 + 4 * hh;
          const s16x4 lo = *(const s16x4*)vp;
          const s16x4 hi = *(const s16x4*)(vp + 8);
          const bf16x8 vf = __builtin_shufflevector(lo, hi, 0, 1, 2, 3, 4, 5, 6, 7);
          oacc[dt] = MFMA(vf, pf[st], oacc[dt]);
        }
      __builtin_amdgcn_s_setprio(0);
    }
    if (more) { if (half == 0) ATT_SWRITE(y, 1) else ATT_SWRITE(x, 0) }
    if (!MLA) {
      int* flg = (int*)(smem + SMEM_BYTES - 128) + (it & 1) * 8;
      const bool wok = (__builtin_amdgcn_ballot_w64(carry >= 160.f) == ~0ull);
      if (lane == 0) flg[w] = wok ? 1 : 0;
      __syncthreads();
      alive = more && ((flg[0] & flg[1] & flg[2] & flg[3] & flg[4] & flg[5] & flg[6] & flg[7]) == 0);
    } else {
      __syncthreads();
      alive = more;
    }
    if (!alive) break;
   }
  }
#undef ATT_GLOAD
#undef ATT_SWRITE
#undef ATT_KT
  float inv = 1.f;
  if (MLA) { const float lt = half_sum(lrun); inv = 1.f / lt; }
  const int tok = tok0 + w * 32 + r;
  const bf16_t* zg = (MLA ? p.Zmla() : p.Zsb()) + (size_t)tok * 512 + h * 64;
  bf16_t* og = (MLA ? p.OBg() : p.OAg()) + (size_t)tok * 512 + h * 64;
#pragma unroll
  for (int dt = 0; dt < 2; ++dt)
#pragma unroll
    for (int g = 0; g < 4; ++g) {
      const int d = dt * 32 + 8 * g + 4 * hh;
      const u32x2 zz = *(const u32x2*)(zg + d);
      const float z0 = __uint_as_float(zz[0] << 16), z1 = __uint_as_float(zz[0] & 0xffff0000u);
      const float z2 = __uint_as_float(zz[1] << 16), z3 = __uint_as_float(zz[1] & 0xffff0000u);
      u32x2 o;
      o[0] = pk2(oacc[dt][4 * g] * inv * z0, oacc[dt][4 * g + 1] * inv * z1);
      o[1] = pk2(oacc[dt][4 * g + 2] * inv * z2, oacc[dt][4 * g + 3] * inv * z3);
      *(u32x2*)(og + d) = o;
    }
}

DI void phase_attn(const Params& p, char* smem, int cbase, int only) {
  int* s_item = (int*)(smem + SMEM_BYTES - 16);
  const int q0 = blockIdx.x & 7;
  int qi = 0;
  for (;;) {
    if (threadIdx.x < 64) {
      int item = -1;
      while (qi < 8) {
        const int q = (q0 + qi) & 7;
        int idx = 0;
        if (threadIdx.x == 0) idx = atomicAdd(p.counter() + cbase + q, 1);
        idx = __builtin_amdgcn_readfirstlane(idx);
        if (idx < 128) { item = q * 256 + idx; break; }
        const int lq = (q0 + (threadIdx.x & 7)) & 7;
        const int head = __hip_atomic_load(p.counter() + cbase + lq, __ATOMIC_RELAXED, __HIP_MEMORY_SCOPE_AGENT);
        const unsigned long long avail = __builtin_amdgcn_ballot_w64((threadIdx.x < 8) && (head < 128) && ((int)(threadIdx.x & 7) > qi));
        if (avail == 0ull) { qi = 8; break; }
        qi = __builtin_ctzll(avail);
      }
      if (threadIdx.x == 0) *s_item = item;
    }
    __syncthreads();
    const int item = *s_item;
    __syncthreads();
    if (item < 0) break;
    const int q = item >> 8, idx = item & 255;
    const int i2 = idx & 63;
    const int bh = q + 8 * (i2 & 3);
    const int qb = 15 - (i2 >> 2);
    if (idx < 64) { if (only != 2) attn_item<true>(p, bh >> 3, bh & 7, qb, smem); }
    else { if (only != 1) attn_item<false>(p, bh >> 3, bh & 7, qb, smem); }
  }
}

DI void g3_pre_a(const Params& p, const int m0, const int n0, u32x4 (&g)[4]) {
  const int txo = opaque_tid();
#pragma unroll
  for (int i = 0; i < 4; ++i) {
    const int c = txo + 512 * i, row = c >> 4, cc = (c & 15) * 8;
    g[i] = *(const u32x4*)(p.GA() + (size_t)(m0 + row) * 1024 + n0 + cc);
  }
}
DI void g3_epi_a(const Params& p, const float* sC, const int m0, const int n0, const u32x4 (&gq)[4]) {
  const int txo = opaque_tid();
#pragma unroll
  for (int i = 0; i < 4; ++i) {
    const int c = txo + 512 * i, row = c >> 4, cc = (c & 15) * 8;
    const u32x4 g = gq[i];
    const float4 a = *(const float4*)(sC + row * CSTR + cc), b = *(const float4*)(sC + row * CSTR + cc + 4);
    u32x4 y;
    y[0] = pk2(a.x * __uint_as_float(g[0] << 16), a.y * __uint_as_float(g[0] & 0xffff0000u));
    y[1] = pk2(a.z * __uint_as_float(g[1] << 16), a.w * __uint_as_float(g[1] & 0xffff0000u));
    y[2] = pk2(b.x * __uint_as_float(g[2] << 16), b.y * __uint_as_float(g[2] & 0xffff0000u));
    y[3] = pk2(b.z * __uint_as_float(g[3] << 16), b.w * __uint_as_float(g[3] & 0xffff0000u));
    *(u32x4*)(p.MERGED() + (size_t)(m0 + row) * 1024 + n0 + cc) = y;
  }
}
DI void g3_pre_b(const Params& p, const int m0, const int n0, u32x4 (&g)[4], u32x4 (&y)[4]) {
  const int txo2 = opaque_tid();
#pragma unroll
  for (int i = 0; i < 4; ++i) {
    const int c = txo2 + 512 * i, row = c >> 4, cc = (c & 15) * 8;
    g[i] = *(const u32x4*)(p.GB() + (size_t)(m0 + row) * 1024 + n0 + cc);
    y[i] = *(const u32x4*)(p.MERGED() + (size_t)(m0 + row) * 1024 + n0 + cc);
  }
}
DI void g3_epi_b(const Params& p, const float* sC, const int m0, const int n0, const u32x4 (&gq)[4], const u32x4 (&yq)[4]) {
  const int txo2 = opaque_tid();
#pragma unroll
  for (int i = 0; i < 4; ++i) {
    const int c = txo2 + 512 * i, row = c >> 4, cc = (c & 15) * 8;
    const u32x4 g = gq[i];
    const u32x4 yv = yq[i];
    const float4 a = *(const float4*)(sC + row * CSTR + cc), b = *(const float4*)(sC + row * CSTR + cc + 4);
    u32x4 o;
    o[0] = pk2(__uint_as_float(yv[0] << 16) + a.x * __uint_as_float(g[0] << 16), __uint_as_float(yv[0] & 0xffff0000u) + a.y * __uint_as_float(g[0] & 0xffff0000u));
    o[1] = pk2(__uint_as_float(yv[1] << 16) + a.z * __uint_as_float(g[1] << 16), __uint_as_float(yv[1] & 0xffff0000u) + a.w * __uint_as_float(g[1] & 0xffff0000u));
    o[2] = pk2(__uint_as_float(yv[2] << 16) + b.x * __uint_as_float(g[2] << 16), __uint_as_float(yv[2] & 0xffff0000u) + b.y * __uint_as_float(g[2] & 0xffff0000u));
    o[3] = pk2(__uint_as_float(yv[3] << 16) + b.z * __uint_as_float(g[3] << 16), __uint_as_float(yv[3] & 0xffff0000u) + b.w * __uint_as_float(g[3] & 0xffff0000u));
    *(u32x4*)(p.MERGED() + (size_t)(m0 + row) * 1024 + n0 + cc) = o;
  }
}
DI void phase_g3(const Params& p, char* smem) {
  bf16_t* shm = (bf16_t*)smem;
  float* sC = (float*)smem;
  const int xq = blockIdx.x & 7, lb = blockIdx.x >> 3, nlb = gridDim.x >> 3;
  const bool xmap = (gridDim.x & 7) == 0;
  for (int t = xmap ? lb : (int)blockIdx.x; t < (xmap ? 32 : 256); t += (xmap ? nlb : (int)gridDim.x)) {
    const int rt = xmap ? (8 * xq + (t & 7)) : (t >> 2), ct = xmap ? (t >> 3) : (t & 3);
    const int m0 = rt * 256, n0 = ct * 256;
    f32x4 acc[2][2][4][2];
    zero_acc8(acc);
    gemm8_tile(p.OAg() + (size_t)m0 * 512, p.WaT() + (size_t)n0 * 512, 512, shm, acc);
#pragma unroll
    for (int ai = 0; ai < 2; ++ai)
#pragma unroll
      for (int bj = 0; bj < 2; ++bj) {
        u32x4 gq[4];
        g3_pre_a(p, m0 + ai * 128, n0 + bj * 128, gq);
        __syncthreads();
        accq_to_lds(acc[ai][bj], sC);
        __syncthreads();
        g3_epi_a(p, sC, m0 + ai * 128, n0 + bj * 128, gq);
      }
    __syncthreads();
    zero_acc8(acc);
    gemm8_tile(p.OBg() + (size_t)m0 * 512, p.WbT() + (size_t)n0 * 512, 512, shm, acc);
#pragma unroll
    for (int ai = 0; ai < 2; ++ai)
#pragma unroll
      for (int bj = 0; bj < 2; ++bj) {
        u32x4 gq[4], yq[4];
        g3_pre_b(p, m0 + ai * 128, n0 + bj * 128, gq, yq);
        __syncthreads();
        accq_to_lds(acc[ai][bj], sC);
        __syncthreads();
        g3_epi_b(p, sC, m0 + ai * 128, n0 + bj * 128, gq, yq);
      }
    __syncthreads();
  }
}

DI void g4_pre(const Params& p, const int m0, const int n0, float4 (&xq)[8]) {
  const int txo = opaque_tid();
#pragma unroll
  for (int i = 0; i < 4; ++i) {
    const int c = txo + 512 * i, row = c >> 4, cc = (c & 15) * 8;
    const size_t go = (size_t)(m0 + row) * 1024 + n0 + cc;
    xq[2 * i] = *(const float4*)(p.x + go); xq[2 * i + 1] = *(const float4*)(p.x + go + 4);
  }
}
DI void g4_epi(const Params& p, const float* sC, const float* gt, const int m0, const int n0, const float4 (&xq)[8]) {
  const int txo = opaque_tid();
#pragma unroll
  for (int i = 0; i < 4; ++i) {
    const int c = txo + 512 * i, row = c >> 4, cc = (c & 15) * 8;
    const size_t go = (size_t)(m0 + row) * 1024 + n0 + cc;
    const float4 x0 = xq[2 * i], x1 = xq[2 * i + 1];
    const float4 a = *(const float4*)(sC + row * CSTR + cc), b = *(const float4*)(sC + row * CSTR + cc + 4);
    const float4 g0 = *(const float4*)(gt + cc), g1 = *(const float4*)(gt + cc + 4);
    float4 o0, o1;
    o0.x = x0.x + g0.x * a.x; o0.y = x0.y + g0.y * a.y; o0.z = x0.z + g0.z * a.z; o0.w = x0.w + g0.w * a.w;
    o1.x = x1.x + g1.x * b.x; o1.y = x1.y + g1.y * b.y; o1.z = x1.z + g1.z * b.z; o1.w = x1.w + g1.w * b.w;
    *(float4*)(p.out + go) = o0;
    *(float4*)(p.out + go + 4) = o1;
  }
}
DI void phase_g4(const Params& p, char* smem) {
  bf16_t* shm = (bf16_t*)smem;
  float* sC = (float*)smem;
  float* rs = (float*)(smem + 131072);
  const int xq = blockIdx.x & 7, lb = blockIdx.x >> 3, nlb = gridDim.x >> 3;
  const bool xmap = (gridDim.x & 7) == 0;
  for (int t = xmap ? lb : (int)blockIdx.x; t < (xmap ? 32 : 256); t += (xmap ? nlb : (int)gridDim.x)) {
    const int rt = xmap ? (8 * xq + (t & 7)) : (t >> 2), ct = xmap ? (t >> 3) : (t & 3);
    const int m0 = rt * 256, n0 = ct * 256;
    f32x4 acc[2][2][4][2];
    zero_acc8(acc);
    if (threadIdx.x < 256) rs[threadIdx.x] = mod_get(p.MOD(), m0 >> 12, 2048 + n0 + threadIdx.x);
    gemm8_tile(p.MERGED() + (size_t)m0 * 1024, p.WoT() + (size_t)n0 * 1024, 1024, shm, acc);
#pragma unroll
    for (int ai = 0; ai < 2; ++ai)
#pragma unroll
      for (int bj = 0; bj < 2; ++bj) {
        float4 xq[8];
        g4_pre(p, m0 + ai * 128, n0 + bj * 128, xq);
        __syncthreads();
        accq_to_lds(acc[ai][bj], sC);
        __syncthreads();
        g4_epi(p, sC, rs + bj * 128, m0 + ai * 128, n0 + bj * 128, xq);
      }
    __syncthreads();
  }
}

DI void phase_final(const Params& p) {
  const int lane = threadIdx.x & 63, w = threadIdx.x >> 6;
  const int gw = blockIdx.x * 8 + w, nw = gridDim.x * 8;
  for (int row = gw; row < NTOK; row += nw) {
    float* xr = p.out + (size_t)row * DM;
    float4 v[4];
    float ss = 0.f;
#pragma unroll
    for (int i = 0; i < 4; ++i) {
      v[i] = *(const float4*)(xr + 4 * (lane + 64 * i));
      ss += v[i].x * v[i].x + v[i].y * v[i].y + v[i].z * v[i].z + v[i].w * v[i].w;
    }
#pragma unroll
    for (int o = 32; o >= 1; o >>= 1) ss += __shfl_xor(ss, o);
    const float rn = __builtin_amdgcn_rsqf(ss * (1.f / DM) + EPSN);
#pragma unroll
    for (int i = 0; i < 4; ++i) {
      const int e = 4 * (lane + 64 * i);
      const float4 g = *(const float4*)(p.fgain + e);
      float4 o;
      o.x = v[i].x * rn * g.x; o.y = v[i].y * rn * g.y; o.z = v[i].z * rn * g.z; o.w = v[i].w * rn * g.w;
      *(float4*)(xr + e) = o;
    }
  }
}

template <int PH>
__global__ void __launch_bounds__(NTHREADS, 2) mega_kernel(Params p) {
  __shared__ __attribute__((aligned(16))) char smem[SMEM_BYTES];
  if (PH < 0) {
    if (p.ws == nullptr) cg::this_grid().sync();
    volatile LAS unsigned* xst = (volatile LAS unsigned*)(smem + SMEM_BYTES - 32);
    if (threadIdx.x == 0) { xst[0] = 0u; xst[1] = 0u; }
    __syncthreads();
    (void)xcd_barrier_post(p.bar(), xst);
    phase_prep(p, smem); xcd_barrier(p.bar(), (volatile LAS unsigned*)(smem + SMEM_BYTES - 32));
#if PROBE_DUP == 4
    phase_prep(p, smem); xcd_barrier(p.bar(), (volatile LAS unsigned*)(smem + SMEM_BYTES - 32));
#endif
    phase_h(p, smem); xcd_barrier(p.bar(), (volatile LAS unsigned*)(smem + SMEM_BYTES - 32));
#if PROBE_DUP == 5
    phase_h(p, smem); xcd_barrier(p.bar(), (volatile LAS unsigned*)(smem + SMEM_BYTES - 32));
#endif
    phase_g1(p, smem); xcd_barrier(p.bar(), (volatile LAS unsigned*)(smem + SMEM_BYTES - 32));
#if PROBE_DUP == 1
    phase_g1(p, smem, false); xcd_barrier(p.bar(), (volatile LAS unsigned*)(smem + SMEM_BYTES - 32));
#endif
    phase_g2(p, smem); xcd_barrier(p.bar(), (volatile LAS unsigned*)(smem + SMEM_BYTES - 32));
#if PROBE_DUP == 8
    phase_g2(p, smem); xcd_barrier(p.bar(), (volatile LAS unsigned*)(smem + SMEM_BYTES - 32));
#endif
    phase_attn(p, smem, 0, 0); xcd_barrier(p.bar(), (volatile LAS unsigned*)(smem + SMEM_BYTES - 32));
#if PROBE_DUP == 2
    phase_attn(p, smem, 8, 1); xcd_barrier(p.bar(), (volatile LAS unsigned*)(smem + SMEM_BYTES - 32));
#endif
#if PROBE_DUP == 3
    phase_attn(p, smem, 8, 2); xcd_barrier(p.bar(), (volatile LAS unsigned*)(smem + SMEM_BYTES - 32));
#endif
    phase_g3(p, smem); xcd_barrier(p.bar(), (volatile LAS unsigned*)(smem + SMEM_BYTES - 32));
#if PROBE_DUP == 6
    phase_g3(p, smem); xcd_barrier(p.bar(), (volatile LAS unsigned*)(smem + SMEM_BYTES - 32));
#endif
    phase_g4(p, smem); xcd_barrier(p.bar(), (volatile LAS unsigned*)(smem + SMEM_BYTES - 32));
#if PROBE_DUP == 7
    phase_g4(p, smem); xcd_barrier(p.bar(), (volatile LAS unsigned*)(smem + SMEM_BYTES - 32));
#endif
    phase_final(p);
  } else {
    if (PH == 0) phase_prep(p, smem);
    if (PH == 1) phase_h(p, smem);
    if (PH == 2) phase_g1(p, smem);
    if (PH == 3) phase_g2(p, smem);
    if (PH == 4) phase_attn(p, smem, 0, 0);
    if (PH == 5) phase_g3(p, smem);
    if (PH == 6) phase_g4(p, smem);
    if (PH == 7) phase_final(p);
  }
}

#ifndef PROBE_DUP
#define PROBE_DUP 0
#endif
#ifndef MK_SPLIT
#define MK_SPLIT 0
#endif

extern "C" void kernel_launch(void* const* d_in, const int* in_sizes, int n_in, void* d_out, int out_size, void* d_ws, size_t ws_size, hipStream_t stream) {
  Params p{};
  p.x = (const float*)d_in[0]; p.c = (const float*)d_in[1]; p.pos = (const int*)d_in[2];
  p.w_ada = (const float*)d_in[3]; p.b_ada = (const float*)d_in[4]; p.norm_gain = (const float*)d_in[5];
  p.w_in = (const float*)d_in[6]; p.q_gain = (const float*)d_in[7]; p.w_uq = (const float*)d_in[8];
  p.kv_gain = (const float*)d_in[9]; p.w_ukv = (const float*)d_in[10]; p.w_a = (const float*)d_in[11];
  p.w_b = (const float*)d_in[12]; p.w_out = (const float*)d_in[13]; p.fgain = (const float*)d_in[14];
  p.out = (float*)d_out;
  p.ws = (char*)d_ws;
  if (WS_NEED > ws_size) { fprintf(stderr, "workspace too small: need %zu have %zu\n", (size_t)WS_NEED, ws_size); return; }

  static int grid_blocks = 0;
  if (!grid_blocks) {
    int dev = 0, cus = 0, per_cu = 0;
    hipGetDevice(&dev);
    hipDeviceGetAttribute(&cus, hipDeviceAttributeMultiprocessorCount, dev);
    hipOccupancyMaxActiveBlocksPerMultiprocessor(&per_cu, mega_kernel<-1>, NTHREADS, 0);
    per_cu = 1;
    grid_blocks = cus * per_cu;
  }
#if MK_SPLIT
  mega_kernel<0><<<grid_blocks, NTHREADS, 0, stream>>>(p);
  mega_kernel<1><<<grid_blocks, NTHREADS, 0, stream>>>(p);
  mega_kernel<2><<<grid_blocks, NTHREADS, 0, stream>>>(p);
  mega_kernel<3><<<grid_blocks, NTHREADS, 0, stream>>>(p);
  mega_kernel<4><<<grid_blocks, NTHREADS, 0, stream>>>(p);
  mega_kernel<5><<<grid_blocks, NTHREADS, 0, stream>>>(p);
  mega_kernel<6><<<grid_blocks, NTHREADS, 0, stream>>>(p);
  mega_kernel<7><<<grid_blocks, NTHREADS, 0, stream>>>(p);
#else
  hipMemsetAsync((char*)d_ws + OFF_bar, 0, XCD_BAR_WORDS * 4, stream);
  void* args[] = {&p};
  hipError_t e = hipLaunchCooperativeKernel((void*)mega_kernel<-1>, dim3(grid_blocks), dim3(NTHREADS), args, 0, stream);
  if (e != hipSuccess) fprintf(stderr, "cooperative launch failed: %s (grid %d)\n", hipGetErrorString(e), grid_blocks);
#endif
}
```

```cpp
#include <hip/hip_runtime.h>
#include <hip/hip_cooperative_groups.h>
#include <stdint.h>
#include <stdio.h>
namespace cg = cooperative_groups;
#ifndef PROBE_DUP
#define PROBE_DUP 0
#endif

#define DI __device__ __forceinline__
typedef unsigned short bf16_t;
typedef __attribute__((ext_vector_type(8))) short bf16x8;
typedef __attribute__((ext_vector_type(4))) short s16x4;
typedef __attribute__((ext_vector_type(16))) float f32x16;
typedef __attribute__((ext_vector_type(2))) float f32x2;
typedef __attribute__((ext_vector_type(2))) __bf16 bf16x2v;
typedef __attribute__((ext_vector_type(4))) unsigned u32x4;
typedef __attribute__((ext_vector_type(2))) unsigned u32x2;
typedef __attribute__((ext_vector_type(4))) float f32x4;
#define MFMA(a, b, c) __builtin_amdgcn_mfma_f32_32x32x16_bf16((a), (b), (c), 0, 0, 0)

constexpr int NTOK = 16384, SEQL = 4096, DM = 1024;
constexpr int INW = 5280, INWP = 5376;
constexpr int NTHREADS = 512;
constexpr float LOG2E = 1.4426950408889634f;
constexpr float QS_SCALE = 0.125f * 1.4426950408889634f;
constexpr float QM_SCALE = 1.4426950408889634f / 9.797958971132712f;
constexpr float EPSN = 1e-6f;

constexpr int XCD_BAR_WORDS_C = 3456;
constexpr size_t al256(size_t v) { return (v + 255) & ~(size_t)255; }
constexpr size_t OFF_counter = 0;
constexpr size_t OFF_bar = OFF_counter + al256(256);
constexpr size_t OFF_MOD = OFF_bar + al256(XCD_BAR_WORDS_C * 4);
constexpr size_t OFF_ROPE = OFF_MOD + al256(4 * 3072 * 4 * 4);
constexpr size_t OFF_SSQ = OFF_ROPE + al256((size_t)NTOK * 32 * 4);
constexpr size_t OFF_Hb = OFF_SSQ + al256((size_t)2 * NTOK * 4);
constexpr size_t OFF_Qmla = OFF_Hb + al256((size_t)NTOK * 1024 * 2);
constexpr size_t OFF_WuqT = OFF_Qmla + al256((size_t)NTOK * 768 * 2);
constexpr size_t OFF_WukvT = OFF_WuqT + al256((size_t)768 * 384 * 2);
constexpr size_t OFF_WaT = OFF_WukvT + al256((size_t)1024 * 256 * 2);
constexpr size_t OFF_WbT = OFF_WaT + al256((size_t)1024 * 512 * 2);
constexpr size_t OFF_WoT = OFF_WbT + al256((size_t)1024 * 512 * 2);
constexpr size_t OFF_Qsb = OFF_WoT + al256((size_t)1024 * 1024 * 2);
constexpr size_t OFF_Ksb = OFF_Qsb + al256((size_t)NTOK * 512 * 2);
constexpr size_t OFF_VTsb = OFF_Ksb + al256((size_t)NTOK * 512 * 2);
constexpr size_t OFF_Zsb = OFF_VTsb + al256((size_t)NTOK * 512 * 2);
constexpr size_t OFF_OAg = OFF_Zsb + al256((size_t)NTOK * 512 * 2);
constexpr size_t OFF_OBg = OFF_OAg + al256((size_t)NTOK * 512 * 2);
constexpr size_t OFF_Zmla = OFF_OBg + al256((size_t)NTOK * 512 * 2);
constexpr size_t OFF_KPE = OFF_Zmla + al256((size_t)NTOK * 512 * 2);
constexpr size_t OFF_Knope = OFF_KPE + al256((size_t)NTOK * 32 * 2);
constexpr size_t OFF_VTmla = OFF_Knope + al256((size_t)NTOK * 512 * 2);
constexpr size_t OFF_WinT = OFF_VTmla + al256((size_t)NTOK * 512 * 2);
constexpr size_t WS_NEED = OFF_WinT + al256((size_t)INWP * 1024 * 2);
struct Params {
  const float *x, *c; const int* pos;
  const float *w_ada, *b_ada, *norm_gain, *w_in, *q_gain, *w_uq, *kv_gain, *w_ukv, *w_a, *w_b, *w_out, *fgain;
  float* out;
  char* ws;
  DI int* counter() const { return (int*)(ws + OFF_counter); }
  DI unsigned* bar() const { return (unsigned*)(ws + OFF_bar); }
  DI float* MOD() const { return (float*)(ws + OFF_MOD); }
  DI float* ROPE() const { return (float*)(ws + OFF_ROPE); }
  DI float* SSQ() const { return (float*)(ws + OFF_SSQ); }
  DI bf16_t* Hb() const { return (bf16_t*)(ws + OFF_Hb); }
  DI bf16_t* Qmla() const { return (bf16_t*)(ws + OFF_Qmla); }
  DI bf16_t* WuqT() const { return (bf16_t*)(ws + OFF_WuqT); }
  DI bf16_t* WukvT() const { return (bf16_t*)(ws + OFF_WukvT); }
  DI bf16_t* WaT() const { return (bf16_t*)(ws + OFF_WaT); }
  DI bf16_t* WbT() const { return (bf16_t*)(ws + OFF_WbT); }
  DI bf16_t* WoT() const { return (bf16_t*)(ws + OFF_WoT); }
  DI bf16_t* Qsb() const { return (bf16_t*)(ws + OFF_Qsb); }
  DI bf16_t* Ksb() const { return (bf16_t*)(ws + OFF_Ksb); }
  DI bf16_t* VTsb() const { return (bf16_t*)(ws + OFF_VTsb); }
  DI bf16_t* Zsb() const { return (bf16_t*)(ws + OFF_Zsb); }
  DI bf16_t* OAg() const { return (bf16_t*)(ws + OFF_OAg); }
  DI bf16_t* OBg() const { return (bf16_t*)(ws + OFF_OBg); }
  DI bf16_t* Zmla() const { return (bf16_t*)(ws + OFF_Zmla); }
  DI bf16_t* KPE() const { return (bf16_t*)(ws + OFF_KPE); }
  DI bf16_t* Knope() const { return (bf16_t*)(ws + OFF_Knope); }
  DI bf16_t* VTmla() const { return (bf16_t*)(ws + OFF_VTmla); }
  DI bf16_t* MERGED() const { return Hb(); }
  DI bf16_t* WinT() const { return (bf16_t*)(ws + OFF_WinT); }
  DI bf16_t* CQ() const { return OAg(); }
  DI bf16_t* CKV() const { return OBg(); }
  DI bf16_t* GA() const { return (bf16_t*)out; }
  DI bf16_t* GB() const { return (bf16_t*)out + (size_t)NTOK * 1024; }
};


__device__ const float c_invfreq[16] = {
  1.0f, 0.5623413251903491f, 0.31622776601683794f, 0.1778279410038923f, 0.1f, 0.05623413251903491f, 0.03162277660168379f,
  0.01778279410038923f, 0.01f, 0.005623413251903491f, 0.0031622776601683794f, 0.001778279410038923f, 0.001f,
  0.0005623413251903491f, 0.00031622776601683794f, 0.0001778279410038923f};

DI unsigned pk2(float a, float b) { f32x2 v = {a, b}; bf16x2v r = __builtin_convertvector(v, bf16x2v); return __builtin_bit_cast(unsigned, r); }
DI bf16_t tobf(float a) { return (bf16_t)(pk2(a, 0.f) & 0xffffu); }
DI float bf2f(unsigned short u) { return __uint_as_float(((unsigned)u) << 16); }
DI bf16x8 pack8(float a0, float a1, float a2, float a3, float a4, float a5, float a6, float a7) {
  u32x4 p; p[0] = pk2(a0, a1); p[1] = pk2(a2, a3); p[2] = pk2(a4, a5); p[3] = pk2(a6, a7);
  return __builtin_bit_cast(bf16x8, p);
}
DI int crow(int reg, int h) { return (reg & 3) + 8 * (reg >> 2) + 4 * h; }
DI int opaque_tid() { int t = threadIdx.x; asm volatile("" : "+v"(t)); return t; }
DI float half_max(float v) {
  unsigned u = __float_as_uint(v);
  auto r = __builtin_amdgcn_permlane32_swap(u, u, false, false);
  return fmaxf(__uint_as_float(r[0]), __uint_as_float(r[1]));
}
DI float half_sum(float v) {
  unsigned u = __float_as_uint(v);
  auto r = __builtin_amdgcn_permlane32_swap(u, u, false, false);
  return __uint_as_float(r[0]) + __uint_as_float(r[1]);
}
DI float sigmoidf_fast(float v) { return __builtin_amdgcn_rcpf(1.f + __builtin_amdgcn_exp2f(-v * LOG2E)); }
DI float siluf_fast(float v) { return v * sigmoidf_fast(v); }

#define XB_TMO      128
#define XB_XCNT(j)  (256  + 64 * (j))
#define XB_XSUB(j)  (1280 + 64 * (j))
#define XB_XGEN(j)  (2304 + 64 * (j))
#define XB_TOP      3328
#define XB_TOPGEN   3392
#define XCD_BAR_WORDS 3456
#define XB_SPIN_CAP (1u << 18)
#define LAS __attribute__((address_space(3)))
DI unsigned xb_ld(unsigned* p)              { return __hip_atomic_load(p, __ATOMIC_RELAXED, __HIP_MEMORY_SCOPE_AGENT); }
DI unsigned xb_add(unsigned* p, unsigned v) { return __hip_atomic_fetch_add(p, v, __ATOMIC_RELAXED, __HIP_MEMORY_SCOPE_AGENT); }
DI unsigned xb_xcc_id() { return (unsigned)__builtin_amdgcn_s_getreg((3 << 11) | 20) & 0xFu; }
#define XB_SPIN(cond, bar) do { unsigned _sp = 0; while (cond) { __builtin_amdgcn_s_sleep(1); \
    if ((++_sp & 255u) == 0u) { if (xb_ld(&(bar)[XB_TMO])) break; if (_sp > XB_SPIN_CAP) { atomicAdd(&(bar)[XB_TMO], 1u); break; } } } } while (0)
struct XcdBarrier { unsigned* bar; unsigned x; volatile LAS unsigned* st; };
DI XcdBarrier xcd_barrier_post(unsigned* bar, volatile LAS unsigned* st) {
  XcdBarrier b; b.bar = bar; b.x = xb_xcc_id(); b.st = st;
  if (threadIdx.x == 0) (void)xb_add(&bar[XB_XCNT(b.x)], 1u);
  return b;
}
DI void xcd_barrier_complete(unsigned* bar, unsigned x, unsigned& nloc, unsigned& nx) {
  const unsigned G = gridDim.x * gridDim.y * gridDim.z;
  unsigned sum, cnt, mine, sp = 0u;
  for (;;) {
    sum = 0u; cnt = 0u; mine = 0u;
#pragma unroll
    for (unsigned j = 0; j < 16; ++j) { const unsigned c = xb_ld(&bar[XB_XCNT(j)]); sum += c; cnt += (c > 0u) ? 1u : 0u; mine = (j == x) ? c : mine; }
    if (sum == G) break;
    __builtin_amdgcn_s_sleep(1);
    if ((++sp & 255u) == 0u) { if (xb_ld(&bar[XB_TMO])) break; if (sp > XB_SPIN_CAP) { atomicAdd(&bar[XB_TMO], 1u); break; } }
  }
  nloc = mine > 0u ? mine : 1u; nx = cnt > 0u ? cnt : 1u;
}
DI void xcd_barrier(unsigned* bar_, volatile LAS unsigned* st_) {
  XcdBarrier b; b.bar = bar_; b.st = st_; b.x = 0;
  asm volatile("s_waitcnt vmcnt(0)" ::: "memory");
  __syncthreads();
  if (threadIdx.x == 0) {
    unsigned* bar = b.bar;
    b.x = xb_xcc_id();
    __builtin_amdgcn_s_waitcnt(0);
    unsigned nloc = b.st[0], nx = b.st[1];
    if (nloc == 0u) { xcd_barrier_complete(bar, b.x, nloc, nx); b.st[0] = nloc; b.st[1] = nx; }
    const unsigned old = xb_add(&bar[XB_XSUB(b.x)], 1u);
    const unsigned gen = old / nloc;
    if (old + 1u == (gen + 1u) * nloc) {
      __builtin_amdgcn_fence(__ATOMIC_RELEASE, "agent");
      asm volatile("s_waitcnt vmcnt(0)" ::: "memory");
      const unsigned og = xb_add(&bar[XB_TOP], 1u);
      const unsigned tg = og / nx;
      if (og + 1u == (tg + 1u) * nx) xb_add(&bar[XB_TOPGEN], 1u);
      else XB_SPIN(xb_ld(&bar[XB_TOPGEN]) == tg, bar);
      __builtin_amdgcn_fence(__ATOMIC_ACQUIRE, "agent");
      xb_add(&bar[XB_XGEN(b.x)], 1u);
      asm volatile("s_waitcnt vmcnt(0)" ::: "memory");
    } else {
      XB_SPIN(xb_ld(&bar[XB_XGEN(b.x)]) == gen, bar);
      __builtin_amdgcn_fence(__ATOMIC_ACQUIRE, "agent");
      asm volatile("s_waitcnt vmcnt(0)" ::: "memory");
    }
  }
  __syncthreads();
}

constexpr int GSTR = 72;
constexpr int GBUF = 128 * GSTR;
constexpr int SMEM_BYTES = 131072 + 4096;

constexpr int G8_HT = 128 * 64;
DI int lds_byte(int r, int c) { const int st = (r >> 4) * 2 + (c >> 5), rr = r & 15, cc = c & 31, ob = rr * 64 + cc * 2; return st * 1024 + (ob ^ (((ob >> 9) & 1) << 5)); }
DI void stage_rc(int b, int& R, int& C) { const int st = b / 1024, sb = b % 1024, swz = sb ^ (((sb >> 9) & 1) << 5); R = (st >> 1) * 16 + swz / 64; C = (st & 1) * 32 + (swz % 64) / 2; }

DI void gemm8_tile(const bf16_t* __restrict__ A, const bf16_t* __restrict__ Bt, const int K, bf16_t* shm, f32x4 (&acc)[2][2][4][2]) {
  const int tid = opaque_tid();
  const int wid = tid >> 6, lane = tid & 63, wr = wid >> 2, wc = wid & 3, fr = lane & 15, fq = lane >> 4;
  const int swz = (fr * 64 + fq * 16) ^ ((fr >> 3) << 5);
  const char* aRd = (const char*)shm + swz + wr * 8192;
  const char* bRd = (const char*)shm + 65536 + swz + wc * 4096;
  int sr0, sc0, sr1, sc1;
  stage_rc(tid * 16, sr0, sc0);
  stage_rc(tid * 16 + 8192, sr1, sc1);
  const unsigned so0 = (unsigned)(sr0 * K + sc0) * 2u, so1 = (unsigned)(sr1 * K + sc1) * 2u;
  char* const stw = (char*)shm + __builtin_amdgcn_readfirstlane(tid & ~63) * 16;
  const char* const Ab = (const char*)A;
  const char* const Bb = (const char*)Bt;
#define SA(b, h) (((b) * 2 + (h)) * 16384)
#define SB(b, h) ((4 + (b) * 2 + (h)) * 16384)
#define STAGE(P, BASE, br, kt) do { const char* g_ = (BASE) + ((long)(br) * K + (long)(kt) * 64) * 2;                        \
    __builtin_amdgcn_global_load_lds((const unsigned*)(g_ + so0), (unsigned*)(stw + (P)), 16, 0, 0);                          \
    __builtin_amdgcn_global_load_lds((const unsigned*)(g_ + so1), (unsigned*)(stw + (P) + 8192), 16, 0, 0); } while (0)
#define LDA(dst, b, h) _Pragma("unroll") for (int m = 0; m < 4; ++m) _Pragma("unroll") for (int k = 0; k < 2; ++k) \
    dst[m][k] = *reinterpret_cast<const bf16x8*>(aRd + ((b) * 2 + (h)) * 16384 + (m * 2 + k) * 1024)
#define LDB(dst, b, h) _Pragma("unroll") for (int n = 0; n < 2; ++n) _Pragma("unroll") for (int k = 0; k < 2; ++k) \
    dst[n][k] = *reinterpret_cast<const bf16x8*>(bRd + ((b) * 2 + (h)) * 16384 + (n * 2 + k) * 1024)
#define MMA(ai, bj, At_, Bt_) do { __builtin_amdgcn_s_setprio(1);                                                          \
    _Pragma("unroll") for (int m = 0; m < 4; ++m) _Pragma("unroll") for (int n = 0; n < 2; ++n) _Pragma("unroll") for (int k = 0; k < 2; ++k) \
      acc[ai][bj][m][n] = __builtin_amdgcn_mfma_f32_16x16x32_bf16(At_[m][k], Bt_[n][k], acc[ai][bj][m][n], 0, 0, 0);       \
    __builtin_amdgcn_s_setprio(0); } while (0)
#define WAIT_V(n) asm volatile("s_waitcnt vmcnt(" #n ")" ::: "memory")
#define WAIT_L(n) asm volatile("s_waitcnt lgkmcnt(" #n ")" ::: "memory")
#define BAR __builtin_amdgcn_s_barrier()
#define SCHED __builtin_amdgcn_sched_barrier(0)
  bf16x8 At[4][2], B0[2][2], B1[2][2];
  const int nt = K / 64;
  STAGE(SB(0, 0), Bb, 0, 0); STAGE(SA(0, 0), Ab, 0, 0);
  STAGE(SB(0, 1), Bb, 128, 0); STAGE(SA(0, 1), Ab, 128, 0);
  if (wr == 1) BAR;
  WAIT_V(4); BAR;
  STAGE(SB(1, 0), Bb, 0, 1); STAGE(SA(1, 0), Ab, 0, 1); STAGE(SB(1, 1), Bb, 128, 1);
  WAIT_V(6); BAR;
  for (int t = 0; t < nt - 2; t += 2) {
    LDB(B0, 0, 0); SCHED; LDA(At, 0, 0); STAGE(SA(1, 1), Ab, 128, t + 1);
    WAIT_L(8); BAR; WAIT_L(0); MMA(0, 0, At, B0); BAR; SCHED;
    LDB(B1, 0, 1); STAGE(SB(0, 0), Bb, 0, t + 2);
    BAR; WAIT_L(0); MMA(0, 1, At, B1); BAR;
    LDA(At, 0, 1); STAGE(SA(0, 0), Ab, 0, t + 2);
    BAR; WAIT_L(0); MMA(1, 0, At, B0); BAR; SCHED;
    STAGE(SB(0, 1), Bb, 128, t + 2);
    WAIT_V(6); BAR; MMA(1, 1, At, B1); BAR;
    LDB(B0, 1, 0); SCHED; LDA(At, 1, 0); STAGE(SA(0, 1), Ab, 128, t + 2);
    WAIT_L(8); BAR; WAIT_L(0); MMA(0, 0, At, B0); BAR; SCHED;
    LDB(B1, 1, 1); STAGE(SB(1, 0), Bb, 0, t + 3);
    BAR; WAIT_L(0); MMA(0, 1, At, B1); BAR;
    LDA(At, 1, 1); STAGE(SA(1, 0), Ab, 0, t + 3);
    BAR; WAIT_L(0); MMA(1, 0, At, B0); BAR; SCHED;
    STAGE(SB(1, 1), Bb, 128, t + 3);
    WAIT_V(6); BAR; MMA(1, 1, At, B1); BAR;
  }
  { LDB(B0, 0, 0); LDA(At, 0, 0); STAGE(SA(1, 1), Ab, 128, nt - 1);
    BAR; WAIT_L(0); MMA(0, 0, At, B0); BAR;
    LDB(B1, 0, 1); BAR; WAIT_L(0); MMA(0, 1, At, B1); BAR;
    LDA(At, 0, 1); WAIT_V(4); BAR; WAIT_L(0); MMA(1, 0, At, B0); MMA(1, 1, At, B1); BAR; }
  { LDB(B0, 1, 0); LDA(At, 1, 0); WAIT_V(2); BAR; WAIT_L(0); MMA(0, 0, At, B0); BAR;
    LDB(B1, 1, 1); WAIT_V(0); BAR; WAIT_L(0); MMA(0, 1, At, B1); BAR;
    LDA(At, 1, 1); BAR; WAIT_L(0); MMA(1, 0, At, B0); MMA(1, 1, At, B1); BAR; }
  if (wr == 0) BAR;
#undef SA
#undef SB
#undef STAGE
#undef LDA
#undef LDB
#undef MMA
#undef WAIT_V
#undef WAIT_L
#undef BAR
#undef SCHED
}


DI void zero_acc8(f32x4 (&acc)[2][2][4][2]) {
#pragma unroll
  for (int a = 0; a < 2; ++a)
#pragma unroll
    for (int b = 0; b < 2; ++b)
#pragma unroll
      for (int m = 0; m < 4; ++m)
#pragma unroll
        for (int n = 0; n < 2; ++n) acc[a][b][m][n] = f32x4{0.f, 0.f, 0.f, 0.f};
}

constexpr int CSTR = 132;
DI void accq_to_lds(const f32x4 (&q)[4][2], float* sC) {
  const int tid = opaque_tid(), wid = tid >> 6, lane = tid & 63, wr = wid >> 2, wc = wid & 3, fr = lane & 15, fq = lane >> 4;
#pragma unroll
  for (int m = 0; m < 4; ++m)
#pragma unroll
    for (int n = 0; n < 2; ++n)
#pragma unroll
      for (int j = 0; j < 4; ++j) sC[(wr * 64 + m * 16 + fq * 4 + j) * CSTR + wc * 32 + n * 16 + fr] = q[m][n][j];
}
template <class F>
DI void epi_rows(const float* sC, F f) {
  const int tx = opaque_tid();
#pragma unroll
  for (int i = 0; i < 4; ++i) {
    const int c = tx + 512 * i, row = c >> 4, cc = (c & 15) * 8;
    const float4 a = *(const float4*)(sC + row * CSTR + cc), b = *(const float4*)(sC + row * CSTR + cc + 4);
    const float v[8] = {a.x, a.y, a.z, a.w, b.x, b.y, b.z, b.w};
    f(i, row, cc, v);
  }
}
DI void store8(bf16_t* p, const float (&v)[8]) { *(bf16x8*)p = pack8(v[0], v[1], v[2], v[3], v[4], v[5], v[6], v[7]); }
DI void epi_vt(const float* sC, bf16_t* VT, int m0, int head0, int c0, int ncol_log2) {
  const int b = m0 >> 12, s0 = m0 & 4095;
  const int nitems = 16 << ncol_log2;
  for (int c = opaque_tid(); c < nitems; c += 512) {
    const int col = c & ((1 << ncol_log2) - 1), rc = c >> ncol_log2;
    float v[8];
#pragma unroll
    for (int j = 0; j < 8; ++j) v[j] = sC[(rc * 8 + j) * CSTR + c0 + col];
    const int head = head0 + (col >> 6), d = col & 63;
    store8(VT + ((size_t)((b * 8 + head) * 64 + d)) * SEQL + s0 + rc * 8, v);
  }
}
DI void rope8(const float* sC, const float* ROPE, int tok, int row, int cc, float (&v)[8]) {
  const float* pr = sC + row * CSTR + (cc ^ 16);
  const bool upper = (cc & 16) != 0;
  const int f0 = cc & 15;
  const float* tb = ROPE + (size_t)tok * 32;
#pragma unroll
  for (int j = 0; j < 8; ++j) {
    const float o = pr[j], cs = tb[f0 + j], sn = tb[16 + f0 + j];
    v[j] = upper ? (o * sn + v[j] * cs) : (v[j] * cs - o * sn);
  }
}

DI void wconv_unit(const float* __restrict__ src, int Nsrc, int K, bf16_t* __restrict__ dst, const float* __restrict__ gain, int ng, int kg, int mode, float* tile, const int tid) {
  {
    const int k = tid >> 2, cq = tid & 3;
    const int n = ng * 64 + cq * 16;
    int sc = n;
    if (mode == 1) { sc = (n < 2688) ? n : (n < 5248 ? n + 32 : (n < 5280 ? n - 2560 : -1)); }
    const int kk = kg * 64 + k;
    float4 v[4];
    if (sc >= 0) {
      const float* sp = src + (size_t)kk * Nsrc + sc;
#pragma unroll
      for (int i = 0; i < 4; ++i) v[i] = *(const float4*)(sp + 4 * i);
      if (gain) { const float g = gain[kk];
#pragma unroll
        for (int i = 0; i < 4; ++i) { v[i].x *= g; v[i].y *= g; v[i].z *= g; v[i].w *= g; } }
    } else {
#pragma unroll
      for (int i = 0; i < 4; ++i) v[i] = make_float4(0.f, 0.f, 0.f, 0.f);
    }
    float* tp = tile + k * 65 + cq * 16;
#pragma unroll
    for (int i = 0; i < 4; ++i) { tp[4 * i] = v[i].x; tp[4 * i + 1] = v[i].y; tp[4 * i + 2] = v[i].z; tp[4 * i + 3] = v[i].w; }
  }
  __syncthreads();
  {
    const int n = tid >> 2, kc = tid & 3;
    float o[16];
#pragma unroll
    for (int j = 0; j < 16; ++j) o[j] = tile[(kc * 16 + j) * 65 + n];
    bf16_t* dp = dst + (size_t)(ng * 64 + n) * K + kg * 64 + kc * 16;
    *(bf16x8*)dp = pack8(o[0], o[1], o[2], o[3], o[4], o[5], o[6], o[7]);
    *(bf16x8*)(dp + 8) = pack8(o[8], o[9], o[10], o[11], o[12], o[13], o[14], o[15]);
  }
  __syncthreads();
}

DI void phase_prep(const Params& p, char* smem) {
  if (blockIdx.x == 0 && threadIdx.x < 16) { p.counter()[threadIdx.x] = 0; }
  for (int i = blockIdx.x * NTHREADS + threadIdx.x; i < 2 * NTOK; i += gridDim.x * NTHREADS) p.SSQ()[i] = 0.f;
  const int half = threadIdx.x >> 8, tid = threadIdx.x & 255;
  constexpr int U_MOD = 96 * 4, U_WIN = 84 * 16, U_WUQ = 12 * 6, U_WUKV = 16 * 4, U_WA = 16 * 8, U_WB = 16 * 8, U_WO = 16 * 16, U_ROPE = 1024;
  constexpr int U_TOTAL = U_MOD + U_ROPE + U_WIN + U_WUQ + U_WUKV + U_WA + U_WB + U_WO;
  float* tile = (float*)smem + half * (64 * 65 + 64);
  for (int up = blockIdx.x; up < U_TOTAL / 2; up += gridDim.x) {
    int v = 2 * up + half;
    if (v < U_MOD) {
      const int cg32 = v >> 2, kq = v & 3, n0 = cg32 * 32;
      const int kgp = tid >> 5, col = tid & 31;
      const int kb = kq * 256 + kgp * 32;
      float a0 = 0.f, a1 = 0.f, a2 = 0.f, a3 = 0.f;
      const float* wp = p.w_ada + (size_t)kb * 3072 + n0 + col;
      float wv[32];
#pragma unroll
      for (int kk = 0; kk < 32; ++kk) wv[kk] = wp[(size_t)kk * 3072];
#pragma unroll
      for (int kk = 0; kk < 32; ++kk) {
        a0 += wv[kk] * p.c[kb + kk]; a1 += wv[kk] * p.c[1024 + kb + kk]; a2 += wv[kk] * p.c[2048 + kb + kk]; a3 += wv[kk] * p.c[3072 + kb + kk];
      }
      float* red = (float*)smem + half * 1024;
      red[(kgp * 4 + 0) * 32 + col] = a0; red[(kgp * 4 + 1) * 32 + col] = a1; red[(kgp * 4 + 2) * 32 + col] = a2; red[(kgp * 4 + 3) * 32 + col] = a3;
      __syncthreads();
      if (tid < 128) {
        const int b = tid >> 5, cc = tid & 31;
        float s = (kq == 0) ? p.b_ada[n0 + cc] : 0.f;
#pragma unroll
        for (int g = 0; g < 8; ++g) s += red[(g * 4 + b) * 32 + cc];
        p.MOD()[(size_t)(b * 3072 + n0 + cc) * 4 + kq] = s;
      }
      __syncthreads();
      continue;
    }
    v -= U_MOD;
    if (v < U_WIN) { wconv_unit(p.w_in, INW, 1024, p.WinT(), nullptr, v >> 4, v & 15, 1, tile, tid); continue; }
    v -= U_WIN;
    if (v < U_WUQ) { wconv_unit(p.w_uq, 768, 384, p.WuqT(), p.q_gain, v / 6, v % 6, 0, tile, tid); continue; }
    v -= U_WUQ;
    if (v < U_WUKV) { wconv_unit(p.w_ukv, 1024, 256, p.WukvT(), p.kv_gain, v >> 2, v & 3, 0, tile, tid); continue; }
    v -= U_WUKV;
    if (v < U_WA) { wconv_unit(p.w_a, 1024, 512, p.WaT(), nullptr, v >> 3, v & 7, 0, tile, tid); continue; }
    v -= U_WA;
    if (v < U_WB) { wconv_unit(p.w_b, 1024, 512, p.WbT(), nullptr, v >> 3, v & 7, 0, tile, tid); continue; }
    v -= U_WB;
    if (v < U_WO) { wconv_unit(p.w_out, 1024, 1024, p.WoT(), nullptr, v >> 4, v & 15, 0, tile, tid); continue; }
    v -= U_WO;
    {
      const int idx = v * 256 + tid, tok = idx >> 4, i = idx & 15;
      const float ang = (float)p.pos[tok] * c_invfreq[i];
      double t = (double)ang * 0.15915494309189535;
      t -= rint(t);
      const float tf = (float)t;
      p.ROPE()[(size_t)tok * 32 + i] = __builtin_amdgcn_cosf(tf);
      p.ROPE()[(size_t)tok * 32 + 16 + i] = __builtin_amdgcn_sinf(tf);
    }
  }
}

DI float mod_get(const float* MOD, int b, int n) { const float4 q = *(const float4*)(MOD + (size_t)(b * 3072 + n) * 4); return (q.x + q.y) + (q.z + q.w); }

DI void phase_h(const Params& p, char* smem) {
  const int tid = opaque_tid(), lane = tid & 63, w = tid >> 6;
  float* gs = (float*)smem;
  float* sh = gs + 1024;
  const int xq = blockIdx.x & 7, lb = blockIdx.x >> 3, nlb = gridDim.x >> 3;
  const bool xmap = (gridDim.x & 7) == 0;
  for (int rgi = xmap ? lb : (int)blockIdx.x; rgi < (xmap ? 32 : NTOK / 64); rgi += (xmap ? nlb : (int)gridDim.x)) {
    const int rg = xmap ? (32 * xq + rgi) : rgi;
    const int b = (rg * 64) >> 12;
    __syncthreads();
#pragma unroll
    for (int i = 0; i < 2; ++i) {
      const int k = tid + 512 * i;
      gs[k] = p.norm_gain[k] * (1.f + mod_get(p.MOD(), b, 1024 + k));
      sh[k] = mod_get(p.MOD(), b, k);
    }
    __syncthreads();
#pragma unroll 2
    for (int rr = 0; rr < 8; ++rr) {
      const int row = rg * 64 + w * 8 + rr;
      const float* xr = p.x + (size_t)row * DM;
      float4 v[4];
      float ss = 0.f;
#pragma unroll
      for (int i = 0; i < 2; ++i) {
        const int e = 8 * (lane + 64 * i);
        v[2 * i] = *(const float4*)(xr + e);
        v[2 * i + 1] = *(const float4*)(xr + e + 4);
        ss += v[2 * i].x * v[2 * i].x + v[2 * i].y * v[2 * i].y + v[2 * i].z * v[2 * i].z + v[2 * i].w * v[2 * i].w;
        ss += v[2 * i + 1].x * v[2 * i + 1].x + v[2 * i + 1].y * v[2 * i + 1].y + v[2 * i + 1].z * v[2 * i + 1].z + v[2 * i + 1].w * v[2 * i + 1].w;
      }
#pragma unroll
      for (int o = 32; o >= 1; o >>= 1) ss += __shfl_xor(ss, o);
      const float rn = __builtin_amdgcn_rsqf(ss * (1.f / DM) + EPSN);
#pragma unroll
      for (int i = 0; i < 2; ++i) {
        const int e = 8 * (lane + 64 * i);
        const float4 g0 = *(const float4*)(gs + e), g1 = *(const float4*)(gs + e + 4);
        const float4 s0 = *(const float4*)(sh + e), s1 = *(const float4*)(sh + e + 4);
        *(bf16x8*)(p.Hb() + (size_t)row * DM + e) =
            pack8(v[2 * i].x * rn * g0.x + s0.x, v[2 * i].y * rn * g0.y + s0.y, v[2 * i].z * rn * g0.z + s0.z, v[2 * i].w * rn * g0.w + s0.w,
                  v[2 * i + 1].x * rn * g1.x + s1.x, v[2 * i + 1].y * rn * g1.y + s1.y, v[2 * i + 1].z * rn * g1.z + s1.z, v[2 * i + 1].w * rn * g1.w + s1.w);
      }
    }
  }
  __syncthreads();
}

DI void g1_epi(const Params& p, const float* sC, const int m0, const int n0, const int ct, const bool do_ssq) {
    if (ct < 4) {
      epi_rows(sC, [&](int, int row, int cc, const float (&v)[8]) {
        float o[8];
#pragma unroll
        for (int j = 0; j < 8; ++j) o[j] = v[j] * QS_SCALE;
        store8(p.Qsb() + (size_t)(m0 + row) * 512 + n0 + cc, o); });
    } else if (ct < 8) {
      epi_rows(sC, [&](int, int row, int cc, const float (&v)[8]) { store8(p.Ksb() + (size_t)(m0 + row) * 512 + n0 - 512 + cc, v); });
    } else if (ct < 12) {
      epi_vt(sC, p.VTsb(), m0, (n0 - 1024) >> 6, 0, 7);
    } else if (ct < 16) {
      epi_rows(sC, [&](int, int row, int cc, const float (&v)[8]) {
        float o[8];
#pragma unroll
        for (int j = 0; j < 8; ++j) o[j] = siluf_fast(v[j]);
        store8(p.Zsb() + (size_t)(m0 + row) * 512 + n0 - 1536 + cc, o); });
    } else if (ct < 19) {
      epi_rows(sC, [&](int, int row, int cc, const float (&v)[8]) {
        store8(p.CQ() + (size_t)(m0 + row) * 384 + n0 - 2048 + cc, v);
        float q = 0.f;
#pragma unroll
        for (int j = 0; j < 8; ++j) q += v[j] * v[j];
        q += __shfl_xor(q, 1); q += __shfl_xor(q, 2); q += __shfl_xor(q, 4); q += __shfl_xor(q, 8);
        if (do_ssq && (threadIdx.x & 15) == 0) atomicAdd(p.SSQ() + m0 + row, q); });
    } else if (ct < 21) {
      epi_rows(sC, [&](int, int row, int cc, const float (&v)[8]) {
        store8(p.CKV() + (size_t)(m0 + row) * 256 + n0 - 2432 + cc, v);
        float q = 0.f;
#pragma unroll
        for (int j = 0; j < 8; ++j) q += v[j] * v[j];
        q += __shfl_xor(q, 1); q += __shfl_xor(q, 2); q += __shfl_xor(q, 4); q += __shfl_xor(q, 8);
        if (do_ssq && (threadIdx.x & 15) == 0) atomicAdd(p.SSQ() + NTOK + m0 + row, q); });
    } else if (ct < 25) {
      epi_rows(sC, [&](int, int row, int cc, const float (&v)[8]) {
        float o[8];
#pragma unroll
        for (int j = 0; j < 8; ++j) o[j] = siluf_fast(v[j]);
        store8(p.Zmla() + (size_t)(m0 + row) * 512 + n0 - 2688 + cc, o); });
    } else if (ct < 33) {
      epi_rows(sC, [&](int, int row, int cc, const float (&v)[8]) {
        float o[8];
#pragma unroll
        for (int j = 0; j < 8; ++j) o[j] = sigmoidf_fast(v[j]);
        store8(p.GA() + (size_t)(m0 + row) * 1024 + n0 - 3200 + cc, o); });
    } else if (ct < 41) {
      epi_rows(sC, [&](int, int row, int cc, const float (&v)[8]) {
        float o[8];
#pragma unroll
        for (int j = 0; j < 8; ++j) o[j] = sigmoidf_fast(v[j]);
        store8(p.GB() + (size_t)(m0 + row) * 1024 + n0 - 4224 + cc, o); });
    } else {
      epi_rows(sC, [&](int, int row, int cc, const float (&v)[8]) {
        if (cc < 32) {
          float o[8];
#pragma unroll
          for (int j = 0; j < 8; ++j) o[j] = v[j];
          rope8(sC, p.ROPE(), m0 + row, row, cc, o);
          store8(p.KPE() + (size_t)(m0 + row) * 32 + cc, o);
        } });
    }
}

DI void g1_tile(const Params& p, char* smem, const int rt, const int ct2, const bool do_ssq) {
  bf16_t* shm = (bf16_t*)smem;
  float* sC = (float*)smem;
  const int m0 = rt * 256, n0 = ct2 * 256;
  f32x4 acc[2][2][4][2];
  zero_acc8(acc);
  gemm8_tile(p.Hb() + (size_t)m0 * DM, p.WinT() + (size_t)n0 * DM, DM, shm, acc);
#pragma unroll
  for (int ai = 0; ai < 2; ++ai)
#pragma unroll
    for (int bj = 0; bj < 2; ++bj) {
      __syncthreads();
      accq_to_lds(acc[ai][bj], sC);
      __syncthreads();
      g1_epi(p, sC, m0 + ai * 128, n0 + bj * 128, ct2 * 2 + bj, do_ssq);
    }
  __syncthreads();
}

constexpr int G1_NCT = 20;
DI void phase_g1(const Params& p, char* smem, bool do_ssq = true) {
  const int xq = blockIdx.x & 7, lb = blockIdx.x >> 3, nlb = gridDim.x >> 3;
  const bool xmap = (gridDim.x & 7) == 0;
  for (int t = xmap ? lb : (int)blockIdx.x; t < (xmap ? 8 * G1_NCT : 64 * G1_NCT); t += (xmap ? nlb : (int)gridDim.x)) {
    int rt, ct2;
    if (xmap) { ct2 = t >> 3; rt = 8 * xq + (t & 7); } else { rt = t / G1_NCT; ct2 = t % G1_NCT; }
    g1_tile(p, smem, rt, ct2, do_ssq);
  }
}

DI void g2_epi_q(const Params& p, const float* sC, const float* rsq, const int m0, const int n0) {
  epi_rows(sC, [&](int, int row, int cc, const float (&v)[8]) {
    const int col = n0 + cc;
    float o[8];
#pragma unroll
    for (int j = 0; j < 8; ++j) o[j] = v[j];
    if (((col >> 5) % 3) == 2) rope8(sC, p.ROPE(), m0 + row, row, cc, o);
    const float sc = rsq[row] * QM_SCALE;
#pragma unroll
    for (int j = 0; j < 8; ++j) o[j] *= sc;
    store8(p.Qmla() + (size_t)(m0 + row) * 768 + col, o);
  });
}
DI void g2_epi_kv(const Params& p, const float* sC, const float* rsq, const int m0, const int head) {
  epi_rows(sC, [&](int, int row, int cc, const float (&v)[8]) {
    if (cc < 64) {
      const float sc = rsq[row];
      float o[8];
#pragma unroll
      for (int j = 0; j < 8; ++j) o[j] = v[j] * sc;
      store8(p.Knope() + (size_t)(m0 + row) * 512 + head * 64 + cc, o);
    } });
  const int b = m0 >> 12, s0 = m0 & 4095;
  for (int c = opaque_tid(); c < 1024; c += 512) {
    const int col = c & 63, rc = c >> 6;
    float v[8];
#pragma unroll
    for (int j = 0; j < 8; ++j) v[j] = sC[(rc * 8 + j) * CSTR + 64 + col] * rsq[rc * 8 + j];
    store8(p.VTmla() + ((size_t)((b * 8 + head) * 64 + col)) * SEQL + s0 + rc * 8, v);
  }
}

DI void g2_tile(const Params& p, char* smem, const bool isq, const int rt, const int ct) {
  bf16_t* shm = (bf16_t*)smem;
  float* sC = (float*)smem;
  float* rs = (float*)(smem + 131072);
  const int m0 = rt * 256, n0 = ct * 256;
  f32x4 acc[2][2][4][2];
  zero_acc8(acc);
  if (isq) {
    if (threadIdx.x < 256) rs[threadIdx.x] = __builtin_amdgcn_rsqf(p.SSQ()[m0 + threadIdx.x] * (1.f / 384.f) + EPSN);
    gemm8_tile(p.CQ() + (size_t)m0 * 384, p.WuqT() + (size_t)n0 * 384, 384, shm, acc);
#pragma unroll
    for (int ai = 0; ai < 2; ++ai)
#pragma unroll
      for (int bj = 0; bj < 2; ++bj) {
        __syncthreads();
        accq_to_lds(acc[ai][bj], sC);
        __syncthreads();
        g2_epi_q(p, sC, rs + ai * 128, m0 + ai * 128, n0 + bj * 128);
      }
  } else {
    if (threadIdx.x < 256) rs[threadIdx.x] = __builtin_amdgcn_rsqf(p.SSQ()[NTOK + m0 + threadIdx.x] * (1.f / 256.f) + EPSN);
    gemm8_tile(p.CKV() + (size_t)m0 * 256, p.WukvT() + (size_t)n0 * 256, 256, shm, acc);
#pragma unroll
    for (int ai = 0; ai < 2; ++ai)
#pragma unroll
      for (int bj = 0; bj < 2; ++bj) {
        __syncthreads();
        accq_to_lds(acc[ai][bj], sC);
        __syncthreads();
        g2_epi_kv(p, sC, rs + ai * 128, m0 + ai * 128, ct * 2 + bj);
      }
  }
  __syncthreads();
}

DI void phase_g2(const Params& p, char* smem) {
  const int xq = blockIdx.x & 7, lb = blockIdx.x >> 3, nlb = gridDim.x >> 3;
  if ((gridDim.x & 7) == 0 && nlb == 32) {
    if (lb < 8) { g1_tile(p, smem, 8 * xq + lb, G1_NCT, false); return; }
    const int v = lb - 8;
    g2_tile(p, smem, true, 8 * xq + (v & 7), v >> 3);
    g2_tile(p, smem, false, 8 * xq + (v & 7), v >> 3);
    if (lb < 16) { const int v2 = 24 + v; g2_tile(p, smem, false, 8 * xq + (v2 & 7), v2 >> 3); }
  } else {
    for (int tt = blockIdx.x; tt < 64 + 192 + 256; tt += gridDim.x) {
      if (tt < 64) g1_tile(p, smem, tt, G1_NCT, false);
      else if (tt < 256) { const int v = tt - 64; g2_tile(p, smem, true, v / 3, v % 3); }
      else { const int v = tt - 256; g2_tile(p, smem, false, v >> 2, v & 3); }
    }
  }
}

constexpr int VSTR = 68;

template <bool MLA>
DI void attn_item(const Params& p, int b, int h, int qb, char* smem) {
  constexpr int DK = MLA ? 96 : 64;
  constexpr int KSTR = MLA ? 104 : 72;
  constexpr int NKS = DK / 16;
  bf16_t* sK = (bf16_t*)smem;
  bf16_t* sV = sK + 2 * 64 * KSTR;
  const int tid = threadIdx.x, lane = tid & 63, w = tid >> 6, r = lane & 31, hh = lane >> 5;
  const int tokb = b * SEQL;
  const int tok0 = tokb + qb * 256;
  const int qw = qb * 256 + w * 32;

  bf16x8 qf[NKS];
  {
    const bf16_t* qptr = MLA ? (p.Qmla() + (size_t)(tok0 + w * 32 + r) * 768 + h * 96 + hh * 8) : (p.Qsb() + (size_t)(tok0 + w * 32 + r) * 512 + h * 64 + hh * 8);
#pragma unroll
    for (int ks = 0; ks < NKS; ++ks) qf[ks] = *(const bf16x8*)(qptr + ks * 16);
  }
  bf16x8 tf[2];
  if (!MLA) {
#pragma unroll
    for (int st = 0; st < 2; ++st)
#pragma unroll
      for (int e = 0; e < 8; ++e) { const int j = 16 * st + 8 * (e >> 2) + 4 * hh + (e & 3); tf[st][e] = (j >= r) ? (short)0x3F80 : (short)0; }
  }

  f32x16 oacc[2];
#pragma unroll
  for (int i = 0; i < 16; ++i) { oacc[0][i] = 0.f; oacc[1][i] = 0.f; }
  float carry = 0.f;
  float mrun = 0.f, lrun = 0.f;

  const bf16_t* Kg = MLA ? p.Knope() : p.Ksb();
  const bf16_t* VTg = (MLA ? p.VTmla() : p.VTsb()) + (size_t)((b * 8 + h) * 64) * SEQL;
  const int nt = 4 * qb + 4;

  uint4 xk0, xv0, xp, yk0, yv0, yp;
  xp = make_uint4(0, 0, 0, 0); yp = xp;
  const int prow = tid >> 3, pch = tid & 7;
  const bf16_t* kgp = Kg + (size_t)(tokb + prow) * 512 + h * 64 + pch * 8;
  const bf16_t* vgp = VTg + (size_t)prow * SEQL + pch * 8;
  const bf16_t* pgp = p.KPE() + (size_t)(tokb + ((tid & 255) >> 2)) * 32 + (tid & 3) * 8;
#define ATT_GLOAD(P, kt_)                                                          \
  {                                                                                \
    const int kt__ = (kt_);                                                        \
    P##k0 = *(const uint4*)(kgp + (size_t)(kt__ * 64) * 512);                      \
    P##v0 = *(const uint4*)(vgp + kt__ * 64);                                      \
    if (MLA && tid < 256) P##p = *(const uint4*)(pgp + (size_t)(kt__ * 64) * 32);  \
  }
#define ATT_SWRITE(P, buf_)                                                        \
  {                                                                                \
    bf16_t* dK = sK + (buf_) * 64 * KSTR;                                          \
    bf16_t* dV = sV + (buf_) * 64 * VSTR;                                          \
    *(uint4*)(dK + prow * KSTR + pch * 8) = P##k0;                                 \
    uint2* dv0 = (uint2*)(dV + prow * VSTR + pch * 8);                             \
    dv0[0] = make_uint2(P##v0.x, P##v0.y); dv0[1] = make_uint2(P##v0.z, P##v0.w);  \
    if (MLA && tid < 256) *(uint4*)(dK + (tid >> 2) * KSTR + 64 + (tid & 3) * 8) = P##p; \
  }
#define ATT_KT(i_) (MLA ? (i_) : (nt - 1 - (i_)))

  ATT_GLOAD(x, ATT_KT(0));
  ATT_GLOAD(y, ATT_KT(1));
  ATT_SWRITE(x, 0);
  __syncthreads();
  bool alive = true;
  for (int it0 = 0; alive; it0 += 2) {
#pragma unroll
   for (int half = 0; half < 2; ++half) {
    const int it = it0 + half;
    const int kt = ATT_KT(it);
    const int cur = half;
    const bool more = (it + 1 < nt);
    if (it + 2 < nt) { if (half == 0) ATT_GLOAD(x, ATT_KT(it + 2)) else ATT_GLOAD(y, ATT_KT(it + 2)) }
    const bf16_t* cK = sK + cur * 64 * KSTR;
    const bf16_t* cV = sV + cur * 64 * VSTR;
    if (MLA) {
      if (kt * 64 <= qw + 31) {
        f32x16 s0, s1;
        {
          const float sinit = -mrun;
#pragma unroll
          for (int i = 0; i < 16; ++i) { s0[i] = sinit; s1[i] = sinit; }
        }
        __builtin_amdgcn_s_setprio(1);
#pragma unroll
        for (int ks = 0; ks < NKS; ++ks) {
          const bf16x8 k0 = *(const bf16x8*)(cK + r * KSTR + ks * 16 + hh * 8);
          const bf16x8 k1 = *(const bf16x8*)(cK + (32 + r) * KSTR + ks * 16 + hh * 8);
          s0 = MFMA(k0, qf[ks], s0);
          s1 = MFMA(k1, qf[ks], s1);
        }
        __builtin_amdgcn_s_setprio(0);
        if (kt * 64 + 63 > qw) {
          const int lim = qw + r - kt * 64;
#pragma unroll
          for (int i = 0; i < 16; ++i) { if (crow(i, hh) > lim) s0[i] = -1e30f; if (32 + crow(i, hh) > lim) s1[i] = -1e30f; }
        }
        float m0 = fmaxf(fmaxf(s0[0], s0[1]), s0[2]), m1 = fmaxf(fmaxf(s1[0], s1[1]), s1[2]);
#pragma unroll
        for (int i = 3; i < 15; i += 2) { m0 = fmaxf(fmaxf(m0, s0[i]), s0[i + 1]); m1 = fmaxf(fmaxf(m1, s1[i]), s1[i + 1]); }
        float mloc = fmaxf(fmaxf(m0, s0[15]), fmaxf(m1, s1[15]));
        mloc = half_max(mloc);
        const bool first = (it == 0);
        const float delta = first ? mloc : fmaxf(mloc, 0.f);
        if (first || __builtin_amdgcn_ballot_w64(delta > 0.f) != 0ull) {
          const float alpha = first ? 0.f : __builtin_amdgcn_exp2f(-delta);
          mrun += delta;
          lrun *= alpha;
#pragma unroll
          for (int i = 0; i < 16; ++i) { oacc[0][i] *= alpha; oacc[1][i] *= alpha; s0[i] -= delta; s1[i] -= delta; }
        }
        float ps0 = 0.f, ps1 = 0.f;
#pragma unroll
        for (int i = 0; i < 16; ++i) { s0[i] = __builtin_amdgcn_exp2f(s0[i]); s1[i] = __builtin_amdgcn_exp2f(s1[i]); ps0 += s0[i]; ps1 += s1[i]; }
        lrun += ps0 + ps1;
        bf16x8 pf4[4];
        pf4[0] = pack8(s0[0], s0[1], s0[2], s0[3], s0[4], s0[5], s0[6], s0[7]);
        pf4[1] = pack8(s0[8], s0[9], s0[10], s0[11], s0[12], s0[13], s0[14], s0[15]);
        pf4[2] = pack8(s1[0], s1[1], s1[2], s1[3], s1[4], s1[5], s1[6], s1[7]);
        pf4[3] = pack8(s1[8], s1[9], s1[10], s1[11], s1[12], s1[13], s1[14], s1[15]);
        __builtin_amdgcn_s_setprio(1);
#pragma unroll
        for (int st = 0; st < 4; ++st)
#pragma unroll
          for (int dt = 0; dt < 2; ++dt) {
            const bf16_t* vp = cV + (dt * 32 + r) * VSTR + st * 16 + 4 * hh;
            const s16x4 lo = *(const s16x4*)vp;
            const s16x4 hi = *(const s16x4*)(vp + 8);
            const bf16x8 vf = __builtin_shufflevector(lo, hi, 0, 1, 2, 3, 4, 5, 6, 7);
            oacc[dt] = MFMA(vf, pf4[st], oacc[dt]);
          }
        __builtin_amdgcn_s_setprio(0);
      }
    } else
#pragma unroll
    for (int si = 0; si < 2; ++si) {
      const int sub = MLA ? si : (1 - si);
      const int kb = kt * 64 + sub * 32;
      if (kb > qw) continue;
      const bool diag = (kb == qw);
      f32x16 s;
      {
        const float sinit = MLA ? -mrun : 0.f;
#pragma unroll
        for (int i = 0; i < 16; ++i) s[i] = sinit;
      }
      __builtin_amdgcn_s_setprio(1);
#pragma unroll
      for (int ks = 0; ks < NKS; ++ks) {
        const bf16x8 kf = *(const bf16x8*)(cK + (sub * 32 + r) * KSTR + ks * 16 + hh * 8);
        s = MFMA(kf, qf[ks], s);
      }
      __builtin_amdgcn_s_setprio(0);
      bf16x8 pf[2];
      if (!MLA) {
        float sp[16];
        float tsum = 0.f;
#pragma unroll
        for (int i = 0; i < 16; ++i) {
          const float z = s[i];
          float v = __builtin_amdgcn_logf(1.f + __builtin_amdgcn_exp2f(fminf(z, 126.f)));
          if (diag && !(crow(i, hh) < r)) v = 0.f;
          sp[i] = v;
          tsum += v;
        }
        f32x16 cacc;
#pragma unroll
        for (int i = 0; i < 16; ++i) cacc[i] = carry;
        cacc = MFMA(tf[0], pack8(sp[0], sp[1], sp[2], sp[3], sp[4], sp[5], sp[6], sp[7]), cacc);
        cacc = MFMA(tf[1], pack8(sp[8], sp[9], sp[10], sp[11], sp[12], sp[13], sp[14], sp[15]), cacc);
        float pr[16];
#pragma unroll
        for (int i = 0; i < 16; ++i) {
          float v = __builtin_amdgcn_exp2f(s[i] - cacc[i]);
          if (diag && !(crow(i, hh) < r)) v = 0.f;
          pr[i] = v;
        }
        carry += half_sum(tsum);
        pf[0] = pack8(pr[0], pr[1], pr[2], pr[3], pr[4], pr[5], pr[6], pr[7]);
        pf[1] = pack8(pr[8], pr[9], pr[10], pr[11], pr[12], pr[13], pr[14], pr[15]);
      } else {
        if (diag) {
#pragma unroll
          for (int i = 0; i < 16; ++i) if (!(crow(i, hh) <= r)) s[i] = -1e30f;
        }
        float mloc = fmaxf(fmaxf(s[0], s[1]), s[2]);
#pragma unroll
        for (int i = 3; i < 15; i += 2) mloc = fmaxf(fmaxf(mloc, s[i]), s[i + 1]);
        mloc = fmaxf(mloc, s[15]);
        mloc = half_max(mloc);
        const bool first = (it == 0) && (si == 0);
        const float delta = first ? mloc : fmaxf(mloc, 0.f);
        if (first || __builtin_amdgcn_ballot_w64(delta > 0.f) != 0ull) {
          const float alpha = first ? 0.f : __builtin_amdgcn_exp2f(-delta);
          mrun += delta;
          lrun *= alpha;
#pragma unroll
          for (int i = 0; i < 16; ++i) { oacc[0][i] *= alpha; oacc[1][i] *= alpha; s[i] -= delta; }
        }
        float pr[16];
        float ps0 = 0.f, ps1 = 0.f;
#pragma unroll
        for (int i = 0; i < 16; i += 2) { pr[i] = __builtin_amdgcn_exp2f(s[i]); pr[i + 1] = __builtin_amdgcn_exp2f(s[i + 1]); ps0 += pr[i]; ps1 += pr[i + 1]; }
        lrun += ps0 + ps1;
        pf[0] = pack8(pr[0], pr[1], pr[2], pr[3], pr[4], pr[5], pr[6], pr[7]);
        pf[1] = pack8(pr[8], pr[9], pr[10], pr[11], pr[12], pr[13], pr[14], pr[15]);
      }
      __builtin_amdgcn_s_setprio(1);
#pragma unroll
      for (int dt = 0; dt < 2; ++dt)
#pragma unroll
        for (int st = 0; st < 2; ++st) {
          const bf16_t* vp = cV + (dt * 32 + r) * VSTR + sub * 32 + st * 16 + 4 * hh;
          const s16x4 lo = *(const s16x4*)vp;
          const s16x4 hi = *(const s16x4*)(vp + 8);
          const bf16x8 vf = __builtin_shufflevector(lo, hi, 0, 1, 2, 3, 4, 5, 6, 7);
          oacc[dt] = MFMA(vf, pf[st], oacc[dt]);
        }
      __builtin_amdgcn_s_setprio(0);
    }
    if (more) { if (half == 0) ATT_SWRITE(y, 1) else ATT_SWRITE(x, 0) }
    if (!MLA) {
      int* flg = (int*)(smem + SMEM_BYTES - 128) + (it & 1) * 8;
      const bool wok = (__builtin_amdgcn_ballot_w64(carry >= 160.f) == ~0ull);
      if (lane == 0) flg[w] = wok ? 1 : 0;
      __syncthreads();
      alive = more && ((flg[0] & flg[1] & flg[2] & flg[3] & flg[4] & flg[5] & flg[6] & flg[7]) == 0);
    } else {
      __syncthreads();
      alive = more;
    }
    if (!alive) break;
   }
  }
#undef ATT_GLOAD
#undef ATT_SWRITE
#undef ATT_KT
  float inv = 1.f;
  if (MLA) { const float lt = half_sum(lrun); inv = 1.f / lt; }
  const int tok = tok0 + w * 32 + r;
  const bf16_t* zg = (MLA ? p.Zmla() : p.Zsb()) + (size_t)tok * 512 + h * 64;
  bf16_t* og = (MLA ? p.OBg() : p.OAg()) + (size_t)tok * 512 + h * 64;
#pragma unroll
  for (int dt = 0; dt < 2; ++dt)
#pragma unroll
    for (int g = 0; g < 4; ++g) {
      const int d = dt * 32 + 8 * g + 4 * hh;
      const u32x2 zz = *(const u32x2*)(zg + d);
      const float z0 = __uint_as_float(zz[0] << 16), z1 = __uint_as_float(zz[0] & 0xffff0000u);
      const float z2 = __uint_as_float(zz[1] << 16), z3 = __uint_as_float(zz[1] & 0xffff0000u);
      u32x2 o;
      o[0] = pk2(oacc[dt][4 * g] * inv * z0, oacc[dt][4 * g + 1] * inv * z1);
      o[1] = pk2(oacc[dt][4 * g + 2] * inv * z2, oacc[dt][4 * g + 3] * inv * z3);
      *(u32x2*)(og + d) = o;
    }
}

DI void phase_attn(const Params& p, char* smem, int cbase, int only) {
  int* s_item = (int*)(smem + SMEM_BYTES - 16);
  const int q0 = blockIdx.x & 7;
  int qi = 0;
  for (;;) {
    if (threadIdx.x < 64) {
      int item = -1;
      while (qi < 8) {
        const int q = (q0 + qi) & 7;
        int idx = 0;
        if (threadIdx.x == 0) idx = atomicAdd(p.counter() + cbase + q, 1);
        idx = __builtin_amdgcn_readfirstlane(idx);
        if (idx < 128) { item = q * 256 + idx; break; }
        const int lq = (q0 + (threadIdx.x & 7)) & 7;
        const int head = __hip_atomic_load(p.counter() + cbase + lq, __ATOMIC_RELAXED, __HIP_MEMORY_SCOPE_AGENT);
        const unsigned long long avail = __builtin_amdgcn_ballot_w64((threadIdx.x < 8) && (head < 128) && ((int)(threadIdx.x & 7) > qi));
        if (avail == 0ull) { qi = 8; break; }
        qi = __builtin_ctzll(avail);
      }
      if (threadIdx.x == 0) *s_item = item;
    }
    __syncthreads();
    const int item = *s_item;
    __syncthreads();
    if (item < 0) break;
    const int q = item >> 8, idx = item & 255;
    const int i2 = idx & 63;
    const int bh = q + 8 * (i2 & 3);
    const int qb = 15 - (i2 >> 2);
    if (idx < 64) { if (only != 2) attn_item<true>(p, bh >> 3, bh & 7, qb, smem); }
    else { if (only != 1) attn_item<false>(p, bh >> 3, bh & 7, qb, smem); }
  }
}

DI void g3_pre_a(const Params& p, const int m0, const int n0, u32x4 (&g)[4]) {
  const int txo = opaque_tid();
#pragma unroll
  for (int i = 0; i < 4; ++i) {
    const int c = txo + 512 * i, row = c >> 4, cc = (c & 15) * 8;
    g[i] = *(const u32x4*)(p.GA() + (size_t)(m0 + row) * 1024 + n0 + cc);
  }
}
DI void g3_epi_a(const Params& p, const float* sC, const int m0, const int n0, const u32x4 (&gq)[4]) {
  const int txo = opaque_tid();
#pragma unroll
  for (int i = 0; i < 4; ++i) {
    const int c = txo + 512 * i, row = c >> 4, cc = (c & 15) * 8;
    const u32x4 g = gq[i];
    const float4 a = *(const float4*)(sC + row * CSTR + cc), b = *(const float4*)(sC + row * CSTR + cc + 4);
    u32x4 y;
    y[0] = pk2(a.x * __uint_as_float(g[0] << 16), a.y * __uint_as_float(g[0] & 0xffff0000u));
    y[1] = pk2(a.z * __uint_as_float(g[1] << 16), a.w * __uint_as_float(g[1] & 0xffff0000u));
    y[2] = pk2(b.x * __uint_as_float(g[2] << 16), b.y * __uint_as_float(g[2] & 0xffff0000u));
    y[3] = pk2(b.z * __uint_as_float(g[3] << 16), b.w * __uint_as_float(g[3] & 0xffff0000u));
    *(u32x4*)(p.MERGED() + (size_t)(m0 + row) * 1024 + n0 + cc) = y;
  }
}
DI void g3_pre_b(const Params& p, const int m0, const int n0, u32x4 (&g)[4], u32x4 (&y)[4]) {
  const int txo2 = opaque_tid();
#pragma unroll
  for (int i = 0; i < 4; ++i) {
    const int c = txo2 + 512 * i, row = c >> 4, cc = (c & 15) * 8;
    g[i] = *(const u32x4*)(p.GB() + (size_t)(m0 + row) * 1024 + n0 + cc);
    y[i] = *(const u32x4*)(p.MERGED() + (size_t)(m0 + row) * 1024 + n0 + cc);
  }
}
DI void g3_epi_b(const Params& p, const float* sC, const int m0, const int n0, const u32x4 (&gq)[4], const u32x4 (&yq)[4]) {
  const int txo2 = opaque_tid();
#pragma unroll
  for (int i = 0; i < 4; ++i) {
    const int c = txo2 + 512 * i, row = c >> 4, cc = (c & 15) * 8;
    const u32x4 g = gq[i];
    const u32x4 yv = yq[i];
    const float4 a = *(const float4*)(sC + row * CSTR + cc), b = *(const float4*)(sC + row * CSTR + cc + 4);
    u32x4 o;
    o[0] = pk2(__uint_as_float(yv[0] << 16) + a.x * __uint_as_float(g[0] << 16), __uint_as_float(yv[0] & 0xffff0000u) + a.y * __uint_as_float(g[0] & 0xffff0000u));
    o[1] = pk2(__uint_as_float(yv[1] << 16) + a.z * __uint_as_float(g[1] << 16), __uint_as_float(yv[1] & 0xffff0000u) + a.w * __uint_as_float(g[1] & 0xffff0000u));
    o[2] = pk2(__uint_as_float(yv[2] << 16) + b.x * __uint_as_float(g[2] << 16), __uint_as_float(yv[2] & 0xffff0000u) + b.y * __uint_as_float(g[2] & 0xffff0000u));
    o[3] = pk2(__uint_as_float(yv[3] << 16) + b.z * __uint_as_float(g[3] << 16), __uint_as_float(yv[3] & 0xffff0000u) + b.w * __uint_as_float(g[3] & 0xffff0000u));
    *(u32x4*)(p.MERGED() + (size_t)(m0 + row) * 1024 + n0 + cc) = o;
  }
}
DI void phase_g3(const Params& p, char* smem) {
  bf16_t* shm = (bf16_t*)smem;
  float* sC = (float*)smem;
  const int xq = blockIdx.x & 7, lb = blockIdx.x >> 3, nlb = gridDim.x >> 3;
  const bool xmap = (gridDim.x & 7) == 0;
  for (int t = xmap ? lb : (int)blockIdx.x; t < (xmap ? 32 : 256); t += (xmap ? nlb : (int)gridDim.x)) {
    const int rt = xmap ? (8 * xq + (t & 7)) : (t >> 2), ct = xmap ? (t >> 3) : (t & 3);
    const int m0 = rt * 256, n0 = ct * 256;
    f32x4 acc[2][2][4][2];
    zero_acc8(acc);
    gemm8_tile(p.OAg() + (size_t)m0 * 512, p.WaT() + (size_t)n0 * 512, 512, shm, acc);
#pragma unroll
    for (int ai = 0; ai < 2; ++ai)
#pragma unroll
      for (int bj = 0; bj < 2; ++bj) {
        u32x4 gq[4];
        g3_pre_a(p, m0 + ai * 128, n0 + bj * 128, gq);
        __syncthreads();
        accq_to_lds(acc[ai][bj], sC);
        __syncthreads();
        g3_epi_a(p, sC, m0 + ai * 128, n0 + bj * 128, gq);
      }
    __syncthreads();
    zero_acc8(acc);
    gemm8_tile(p.OBg() + (size_t)m0 * 512, p.WbT() + (size_t)n0 * 512, 512, shm, acc);
#pragma unroll
    for (int ai = 0; ai < 2; ++ai)
#pragma unroll
      for (int bj = 0; bj < 2; ++bj) {
        u32x4 gq[4], yq[4];
        g3_pre_b(p, m0 + ai * 128, n0 + bj * 128, gq, yq);
        __syncthreads();
        accq_to_lds(acc[ai][bj], sC);
        __syncthreads();
        g3_epi_b(p, sC, m0 + ai * 128, n0 + bj * 128, gq, yq);
      }
    __syncthreads();
  }
}

DI void g4_pre(const Params& p, const int m0, const int n0, float4 (&xq)[8]) {
  const int txo = opaque_tid();
#pragma unroll
  for (int i = 0; i < 4; ++i) {
    const int c = txo + 512 * i, row = c >> 4, cc = (c & 15) * 8;
    const size_t go = (size_t)(m0 + row) * 1024 + n0 + cc;
    xq[2 * i] = *(const float4*)(p.x + go); xq[2 * i + 1] = *(const float4*)(p.x + go + 4);
  }
}
DI void g4_epi(const Params& p, const float* sC, const float* gt, const int m0, const int n0, const float4 (&xq)[8]) {
  const int txo = opaque_tid();
#pragma unroll
  for (int i = 0; i < 4; ++i) {
    const int c = txo + 512 * i, row = c >> 4, cc = (c & 15) * 8;
    const size_t go = (size_t)(m0 + row) * 1024 + n0 + cc;
    const float4 x0 = xq[2 * i], x1 = xq[2 * i + 1];
    const float4 a = *(const float4*)(sC + row * CSTR + cc), b = *(const float4*)(sC + row * CSTR + cc + 4);
    const float4 g0 = *(const float4*)(gt + cc), g1 = *(const float4*)(gt + cc + 4);
    float4 o0, o1;
    o0.x = x0.x + g0.x * a.x; o0.y = x0.y + g0.y * a.y; o0.z = x0.z + g0.z * a.z; o0.w = x0.w + g0.w * a.w;
    o1.x = x1.x + g1.x * b.x; o1.y = x1.y + g1.y * b.y; o1.z = x1.z + g1.z * b.z; o1.w = x1.w + g1.w * b.w;
    *(float4*)(p.out + go) = o0;
    *(float4*)(p.out + go + 4) = o1;
  }
}
DI void phase_g4(const Params& p, char* smem) {
  bf16_t* shm = (bf16_t*)smem;
  float* sC = (float*)smem;
  float* rs = (float*)(smem + 131072);
  const int xq = blockIdx.x & 7, lb = blockIdx.x >> 3, nlb = gridDim.x >> 3;
  const bool xmap = (gridDim.x & 7) == 0;
  for (int t = xmap ? lb : (int)blockIdx.x; t < (xmap ? 32 : 256); t += (xmap ? nlb : (int)gridDim.x)) {
    const int rt = xmap ? (8 * xq + (t & 7)) : (t >> 2), ct = xmap ? (t >> 3) : (t & 3);
    const int m0 = rt * 256, n0 = ct * 256;
    f32x4 acc[2][2][4][2];
    zero_acc8(acc);
    if (threadIdx.x < 256) rs[threadIdx.x] = mod_get(p.MOD(), m0 >> 12, 2048 + n0 + threadIdx.x);
    gemm8_tile(p.MERGED() + (size_t)m0 * 1024, p.WoT() + (size_t)n0 * 1024, 1024, shm, acc);
#pragma unroll
    for (int ai = 0; ai < 2; ++ai)
#pragma unroll
      for (int bj = 0; bj < 2; ++bj) {
        float4 xq[8];
        g4_pre(p, m0 + ai * 128, n0 + bj * 128, xq);
        __syncthreads();
        accq_to_lds(acc[ai][bj], sC);
        __syncthreads();
        g4_epi(p, sC, rs + bj * 128, m0 + ai * 128, n0 + bj * 128, xq);
      }
    __syncthreads();
  }
}

DI void phase_final(const Params& p) {
  const int lane = threadIdx.x & 63, w = threadIdx.x >> 6;
  const int gw = blockIdx.x * 8 + w, nw = gridDim.x * 8;
  for (int row = gw; row < NTOK; row += nw) {
    float* xr = p.out + (size_t)row * DM;
    float4 v[4];
    float ss = 0.f;
#pragma unroll
    for (int i = 0; i < 4; ++i) {
      v[i] = *(const float4*)(xr + 4 * (lane + 64 * i));
      ss += v[i].x * v[i].x + v[i].y * v[i].y + v[i].z * v[i].z + v[i].w * v[i].w;
    }
#pragma unroll
    for (int o = 32; o >= 1; o >>= 1) ss += __shfl_xor(ss, o);
    const float rn = __builtin_amdgcn_rsqf(ss * (1.f / DM) + EPSN);
#pragma unroll
    for (int i = 0; i < 4; ++i) {
      const int e = 4 * (lane + 64 * i);
      const float4 g = *(const float4*)(p.fgain + e);
      float4 o;
      o.x = v[i].x * rn * g.x; o.y = v[i].y * rn * g.y; o.z = v[i].z * rn * g.z; o.w = v[i].w * rn * g.w;
      *(float4*)(xr + e) = o;
    }
  }
}

template <int PH>
__global__ void __launch_bounds__(NTHREADS, 2) mega_kernel(Params p) {
  __shared__ __attribute__((aligned(16))) char smem[SMEM_BYTES];
  if (PH < 0) {
    if (p.ws == nullptr) cg::this_grid().sync();
    volatile LAS unsigned* xst = (volatile LAS unsigned*)(smem + SMEM_BYTES - 32);
    if (threadIdx.x == 0) { xst[0] = 0u; xst[1] = 0u; }
    __syncthreads();
    (void)xcd_barrier_post(p.bar(), xst);
    phase_prep(p, smem); xcd_barrier(p.bar(), (volatile LAS unsigned*)(smem + SMEM_BYTES - 32));
#if PROBE_DUP == 4
    phase_prep(p, smem); xcd_barrier(p.bar(), (volatile LAS unsigned*)(smem + SMEM_BYTES - 32));
#endif
    phase_h(p, smem); xcd_barrier(p.bar(), (volatile LAS unsigned*)(smem + SMEM_BYTES - 32));
#if PROBE_DUP == 5
    phase_h(p, smem); xcd_barrier(p.bar(), (volatile LAS unsigned*)(smem + SMEM_BYTES - 32));
#endif
    phase_g1(p, smem); xcd_barrier(p.bar(), (volatile LAS unsigned*)(smem + SMEM_BYTES - 32));
#if PROBE_DUP == 1
    phase_g1(p, smem, false); xcd_barrier(p.bar(), (volatile LAS unsigned*)(smem + SMEM_BYTES - 32));
#endif
    phase_g2(p, smem); xcd_barrier(p.bar(), (volatile LAS unsigned*)(smem + SMEM_BYTES - 32));
#if PROBE_DUP == 8
    phase_g2(p, smem); xcd_barrier(p.bar(), (volatile LAS unsigned*)(smem + SMEM_BYTES - 32));
#endif
    phase_attn(p, smem, 0, 0); xcd_barrier(p.bar(), (volatile LAS unsigned*)(smem + SMEM_BYTES - 32));
#if PROBE_DUP == 2
    phase_attn(p, smem, 8, 1); xcd_barrier(p.bar(), (volatile LAS unsigned*)(smem + SMEM_BYTES - 32));
#endif
#if PROBE_DUP == 3
    phase_attn(p, smem, 8, 2); xcd_barrier(p.bar(), (volatile LAS unsigned*)(smem + SMEM_BYTES - 32));
#endif
    phase_g3(p, smem); xcd_barrier(p.bar(), (volatile LAS unsigned*)(smem + SMEM_BYTES - 32));
#if PROBE_DUP == 6
    phase_g3(p, smem); xcd_barrier(p.bar(), (volatile LAS unsigned*)(smem + SMEM_BYTES - 32));
#endif
    phase_g4(p, smem); xcd_barrier(p.bar(), (volatile LAS unsigned*)(smem + SMEM_BYTES - 32));
#if PROBE_DUP == 7
    phase_g4(p, smem); xcd_barrier(p.bar(), (volatile LAS unsigned*)(smem + SMEM_BYTES - 32));
#endif
    phase_final(p);
  } else {
    if (PH == 0) phase_prep(p, smem);
    if (PH == 1) phase_h(p, smem);
    if (PH == 2) phase_g1(p, smem);
    if (PH == 3) phase_g2(p, smem);
    if (PH == 4) phase_attn(p, smem, 0, 0);
    if (PH == 5) phase_g3(p, smem);
    if (PH == 6) phase_g4(p, smem);
    if (PH == 7) phase_final(p);
  }
}

#ifndef PROBE_DUP
#define PROBE_DUP 0
#endif
#ifndef MK_SPLIT
#define MK_SPLIT 0
#endif

extern "C" void kernel_launch(void* const* d_in, const int* in_sizes, int n_in, void* d_out, int out_size, void* d_ws, size_t ws_size, hipStream_t stream) {
  Params p{};
  p.x = (const float*)d_in[0]; p.c = (const float*)d_in[1]; p.pos = (const int*)d_in[2];
  p.w_ada = (const float*)d_in[3]; p.b_ada = (const float*)d_in[4]; p.norm_gain = (const float*)d_in[5];
  p.w_in = (const float*)d_in[6]; p.q_gain = (const float*)d_in[7]; p.w_uq = (const float*)d_in[8];
  p.kv_gain = (const float*)d_in[9]; p.w_ukv = (const float*)d_in[10]; p.w_a = (const float*)d_in[11];
  p.w_b = (const float*)d_in[12]; p.w_out = (const float*)d_in[13]; p.fgain = (const float*)d_in[14];
  p.out = (float*)d_out;
  p.ws = (char*)d_ws;
  if (WS_NEED > ws_size) { fprintf(stderr, "workspace too small: need %zu have %zu\n", (size_t)WS_NEED, ws_size); return; }

  static int grid_blocks = 0;
  if (!grid_blocks) {
    int dev = 0, cus = 0, per_cu = 0;
    hipGetDevice(&dev);
    hipDeviceGetAttribute(&cus, hipDeviceAttributeMultiprocessorCount, dev);
    hipOccupancyMaxActiveBlocksPerMultiprocessor(&per_cu, mega_kernel<-1>, NTHREADS, 0);
    per_cu = 1;
    grid_blocks = cus * per_cu;
  }
#if MK_SPLIT
  mega_kernel<0><<<grid_blocks, NTHREADS, 0, stream>>>(p);
  mega_kernel<1><<<grid_blocks, NTHREADS, 0, stream>>>(p);
  mega_kernel<2><<<grid_blocks, NTHREADS, 0, stream>>>(p);
  mega_kernel<3><<<grid_blocks, NTHREADS, 0, stream>>>(p);
  mega_kernel<4><<<grid_blocks, NTHREADS, 0, stream>>>(p);
  mega_kernel<5><<<grid_blocks, NTHREADS, 0, stream>>>(p);
  mega_kernel<6><<<grid_blocks, NTHREADS, 0, stream>>>(p);
  mega_kernel<7><<<grid_blocks, NTHREADS, 0, stream>>>(p);
#else
  hipMemsetAsync((char*)d_ws + OFF_bar, 0, XCD_BAR_WORDS * 4, stream);
  void* args[] = {&p};
  hipError_t e = hipLaunchCooperativeKernel((void*)mega_kernel<-1>, dim3(grid_blocks), dim3(NTHREADS), args, 0, stream);
  if (e != hipSuccess) fprintf(stderr, "cooperative launch failed: %s (grid %d)\n", hipGetErrorString(e), grid_blocks);
#endif
}
```

```cpp
#include <hip/hip_runtime.h>
#include <hip/hip_cooperative_groups.h>
#include <stdint.h>
#include <stdio.h>
namespace cg = cooperative_groups;
#ifndef PROBE_DUP
#define PROBE_DUP 0
#endif

#define DI __device__ __forceinline__
typedef unsigned short bf16_t;
typedef __attribute__((ext_vector_type(8))) short bf16x8;
typedef __attribute__((ext_vector_type(4))) short s16x4;
typedef __attribute__((ext_vector_type(16))) float f32x16;
typedef __attribute__((ext_vector_type(2))) float f32x2;
typedef __attribute__((ext_vector_type(2))) __bf16 bf16x2v;
typedef __attribute__((ext_vector_type(4))) unsigned u32x4;
typedef __attribute__((ext_vector_type(2))) unsigned u32x2;
typedef __attribute__((ext_vector_type(4))) float f32x4;
#define MFMA(a, b, c) __builtin_amdgcn_mfma_f32_32x32x16_bf16((a), (b), (c), 0, 0, 0)

constexpr int NTOK = 16384, SEQL = 4096, DM = 1024;
constexpr int INW = 5280, INWP = 5376;
constexpr int NTHREADS = 512;
constexpr float LOG2E = 1.4426950408889634f;
constexpr float QS_SCALE = 0.125f * 1.4426950408889634f;
constexpr float QM_SCALE = 1.4426950408889634f / 9.797958971132712f;
constexpr float EPSN = 1e-6f;

constexpr int XCD_BAR_WORDS_C = 3456;
constexpr size_t al256(size_t v) { return (v + 255) & ~(size_t)255; }
constexpr size_t OFF_counter = 0;
constexpr size_t OFF_bar = OFF_counter + al256(256);
constexpr size_t OFF_MOD = OFF_bar + al256(XCD_BAR_WORDS_C * 4);
constexpr size_t OFF_ROPE = OFF_MOD + al256(4 * 3072 * 4 * 4);
constexpr size_t OFF_SSQ = OFF_ROPE + al256((size_t)NTOK * 32 * 4);
constexpr size_t OFF_Hb = OFF_SSQ + al256((size_t)2 * NTOK * 4);
constexpr size_t OFF_Qmla = OFF_Hb + al256((size_t)NTOK * 1024 * 2);
constexpr size_t OFF_WuqT = OFF_Qmla + al256((size_t)NTOK * 768 * 2);
constexpr size_t OFF_WukvT = OFF_WuqT + al256((size_t)768 * 384 * 2);
constexpr size_t OFF_WaT = OFF_WukvT + al256((size_t)1024 * 256 * 2);
constexpr size_t OFF_WbT = OFF_WaT + al256((size_t)1024 * 512 * 2);
constexpr size_t OFF_WoT = OFF_WbT + al256((size_t)1024 * 512 * 2);
constexpr size_t OFF_Qsb = OFF_WoT + al256((size_t)1024 * 1024 * 2);
constexpr size_t OFF_Ksb = OFF_Qsb + al256((size_t)NTOK * 512 * 2);
constexpr size_t OFF_VTsb = OFF_Ksb + al256((size_t)NTOK * 512 * 2);
constexpr size_t OFF_Zsb = OFF_VTsb + al256((size_t)NTOK * 512 * 2);
constexpr size_t OFF_OAg = OFF_Zsb + al256((size_t)NTOK * 512 * 2);
constexpr size_t OFF_OBg = OFF_OAg + al256((size_t)NTOK * 512 * 2);
constexpr size_t OFF_Zmla = OFF_OBg + al256((size_t)NTOK * 512 * 2);
constexpr size_t OFF_KPE = OFF_Zmla + al256((size_t)NTOK * 512 * 2);
constexpr size_t OFF_Knope = OFF_KPE + al256((size_t)NTOK * 32 * 2);
constexpr size_t OFF_VTmla = OFF_Knope + al256((size_t)NTOK * 512 * 2);
constexpr size_t OFF_WinT = OFF_VTmla + al256((size_t)NTOK * 512 * 2);
constexpr size_t WS_NEED = OFF_WinT + al256((size_t)INWP * 1024 * 2);
struct Params {
  const float *x, *c; const int* pos;
  const float *w_ada, *b_ada, *norm_gain, *w_in, *q_gain, *w_uq, *kv_gain, *w_ukv, *w_a, *w_b, *w_out, *fgain;
  float* out;
  char* ws;
  DI int* counter() const { return (int*)(ws + OFF_counter); }
  DI unsigned* bar() const { return (unsigned*)(ws + OFF_bar); }
  DI float* MOD() const { return (float*)(ws + OFF_MOD); }
  DI float* ROPE() const { return (float*)(ws + OFF_ROPE); }
  DI float* SSQ() const { return (float*)(ws + OFF_SSQ); }
  DI bf16_t* Hb() const { return (bf16_t*)(ws + OFF_Hb); }
  DI bf16_t* Qmla() const { return (bf16_t*)(ws + OFF_Qmla); }
  DI bf16_t* WuqT() const { return (bf16_t*)(ws + OFF_WuqT); }
  DI bf16_t* WukvT() const { return (bf16_t*)(ws + OFF_WukvT); }
  DI bf16_t* WaT() const { return (bf16_t*)(ws + OFF_WaT); }
  DI bf16_t* WbT() const { return (bf16_t*)(ws + OFF_WbT); }
  DI bf16_t* WoT() const { return (bf16_t*)(ws + OFF_WoT); }
  DI bf16_t* Qsb() const { return (bf16_t*)(ws + OFF_Qsb); }
  DI bf16_t* Ksb() const { return (bf16_t*)(ws + OFF_Ksb); }
  DI bf16_t* VTsb() const { return (bf16_t*)(ws + OFF_VTsb); }
  DI bf16_t* Zsb() const { return (bf16_t*)(ws + OFF_Zsb); }
  DI bf16_t* OAg() const { return (bf16_t*)(ws + OFF_OAg); }
  DI bf16_t* OBg() const { return (bf16_t*)(ws + OFF_OBg); }
  DI bf16_t* Zmla() const { return (bf16_t*)(ws + OFF_Zmla); }
  DI bf16_t* KPE() const { return (bf16_t*)(ws + OFF_KPE); }
  DI bf16_t* Knope() const { return (bf16_t*)(ws + OFF_Knope); }
  DI bf16_t* VTmla() const { return (bf16_t*)(ws + OFF_VTmla); }
  DI bf16_t* MERGED() const { return Hb(); }
  DI bf16_t* WinT() const { return (bf16_t*)(ws + OFF_WinT); }
  DI bf16_t* CQ() const { return OAg(); }
  DI bf16_t* CKV() const { return OBg(); }
  DI bf16_t* GA() const { return (bf16_t*)out; }
  DI bf16_t* GB() const { return (bf16_t*)out + (size_t)NTOK * 1024; }
};


__device__ const float c_invfreq[16] = {
  1.0f, 0.5623413251903491f, 0.31622776601683794f, 0.1778279410038923f, 0.1f, 0.05623413251903491f, 0.03162277660168379f,
  0.01778279410038923f, 0.01f, 0.005623413251903491f, 0.0031622776601683794f, 0.001778279410038923f, 0.001f,
  0.0005623413251903491f, 0.00031622776601683794f, 0.0001778279410038923f};

DI unsigned pk2(float a, float b) { f32x2 v = {a, b}; bf16x2v r = __builtin_convertvector(v, bf16x2v); return __builtin_bit_cast(unsigned, r); }
DI bf16_t tobf(float a) { return (bf16_t)(pk2(a, 0.f) & 0xffffu); }
DI float bf2f(unsigned short u) { return __uint_as_float(((unsigned)u) << 16); }
DI bf16x8 pack8(float a0, float a1, float a2, float a3, float a4, float a5, float a6, float a7) {
  u32x4 p; p[0] = pk2(a0, a1); p[1] = pk2(a2, a3); p[2] = pk2(a4, a5); p[3] = pk2(a6, a7);
  return __builtin_bit_cast(bf16x8, p);
}
DI int crow(int reg, int h) { return (reg & 3) + 8 * (reg >> 2) + 4 * h; }
DI int opaque_tid() { int t = threadIdx.x; asm volatile("" : "+v"(t)); return t; }
DI float half_max(float v) {
  unsigned u = __float_as_uint(v);
  auto r = __builtin_amdgcn_permlane32_swap(u, u, false, false);
  return fmaxf(__uint_as_float(r[0]), __uint_as_float(r[1]));
}
DI float half_sum(float v) {
  unsigned u = __float_as_uint(v);
  auto r = __builtin_amdgcn_permlane32_swap(u, u, false, false);
  return __uint_as_float(r[0]) + __uint_as_float(r[1]);
}
DI float sigmoidf_fast(float v) { return __builtin_amdgcn_rcpf(1.f + __builtin_amdgcn_exp2f(-v * LOG2E)); }
DI float siluf_fast(float v) { return v * sigmoidf_fast(v); }

#define XB_TMO      128
#define XB_XCNT(j)  (256  + 64 * (j))
#define XB_XSUB(j)  (1280 + 64 * (j))
#define XB_XGEN(j)  (2304 + 64 * (j))
#define XB_TOP      3328
#define XB_TOPGEN   3392
#define XCD_BAR_WORDS 3456
#define XB_SPIN_CAP (1u << 18)
#define LAS __attribute__((address_space(3)))
DI unsigned xb_ld(unsigned* p)              { return __hip_atomic_load(p, __ATOMIC_RELAXED, __HIP_MEMORY_SCOPE_AGENT); }
DI unsigned xb_add(unsigned* p, unsigned v) { return __hip_atomic_fetch_add(p, v, __ATOMIC_RELAXED, __HIP_MEMORY_SCOPE_AGENT); }
DI unsigned xb_xcc_id() { return (unsigned)__builtin_amdgcn_s_getreg((3 << 11) | 20) & 0xFu; }
#define XB_SPIN(cond, bar) do { unsigned _sp = 0; while (cond) { __builtin_amdgcn_s_sleep(1); \
    if ((++_sp & 255u) == 0u) { if (xb_ld(&(bar)[XB_TMO])) break; if (_sp > XB_SPIN_CAP) { atomicAdd(&(bar)[XB_TMO], 1u); break; } } } } while (0)
struct XcdBarrier { unsigned* bar; unsigned x; volatile LAS unsigned* st; };
DI XcdBarrier xcd_barrier_post(unsigned* bar, volatile LAS unsigned* st) {
  XcdBarrier b; b.bar = bar; b.x = xb_xcc_id(); b.st = st;
  if (threadIdx.x == 0) (void)xb_add(&bar[XB_XCNT(b.x)], 1u);
  return b;
}
DI void xcd_barrier_complete(unsigned* bar, unsigned x, unsigned& nloc, unsigned& nx) {
  const unsigned G = gridDim.x * gridDim.y * gridDim.z;
  unsigned sum, cnt, mine, sp = 0u;
  for (;;) {
    sum = 0u; cnt = 0u; mine = 0u;
#pragma unroll
    for (unsigned j = 0; j < 16; ++j) { const unsigned c = xb_ld(&bar[XB_XCNT(j)]); sum += c; cnt += (c > 0u) ? 1u : 0u; mine = (j == x) ? c : mine; }
    if (sum == G) break;
    __builtin_amdgcn_s_sleep(1);
    if ((++sp & 255u) == 0u) { if (xb_ld(&bar[XB_TMO])) break; if (sp > XB_SPIN_CAP) { atomicAdd(&bar[XB_TMO], 1u); break; } }
  }
  nloc = mine > 0u ? mine : 1u; nx = cnt > 0u ? cnt : 1u;
}
DI void xcd_barrier(unsigned* bar_, volatile LAS unsigned* st_) {
  XcdBarrier b; b.bar = bar_; b.st = st_; b.x = 0;
  asm volatile("s_waitcnt vmcnt(0)" ::: "memory");
  __syncthreads();
  if (threadIdx.x == 0) {
    unsigned* bar = b.bar;
    b.x = xb_xcc_id();
    __builtin_amdgcn_s_waitcnt(0);
    unsigned nloc = b.st[0], nx = b.st[1];
    if (nloc == 0u) { xcd_barrier_complete(bar, b.x, nloc, nx); b.st[0] = nloc; b.st[1] = nx; }
    const unsigned old = xb_add(&bar[XB_XSUB(b.x)], 1u);
    const unsigned gen = old / nloc;
    if (old + 1u == (gen + 1u) * nloc) {
      __builtin_amdgcn_fence(__ATOMIC_RELEASE, "agent");
      asm volatile("s_waitcnt vmcnt(0)" ::: "memory");
      const unsigned og = xb_add(&bar[XB_TOP], 1u);
      const unsigned tg = og / nx;
      if (og + 1u == (tg + 1u) * nx) xb_add(&bar[XB_TOPGEN], 1u);
      else XB_SPIN(xb_ld(&bar[XB_TOPGEN]) == tg, bar);
      __builtin_amdgcn_fence(__ATOMIC_ACQUIRE, "agent");
      xb_add(&bar[XB_XGEN(b.x)], 1u);
      asm volatile("s_waitcnt vmcnt(0)" ::: "memory");
    } else {
      XB_SPIN(xb_ld(&bar[XB_XGEN(b.x)]) == gen, bar);
      __builtin_amdgcn_fence(__ATOMIC_ACQUIRE, "agent");
      asm volatile("s_waitcnt vmcnt(0)" ::: "memory");
    }
  }
  __syncthreads();
}

constexpr int GSTR = 72;
constexpr int GBUF = 128 * GSTR;
constexpr int RS_OFF = 135168;
constexpr int SMEM_BYTES = RS_OFF + 4096;

constexpr int G8_HT = 128 * 64;
DI int lds_byte(int r, int c) { const int st = (r >> 4) * 2 + (c >> 5), rr = r & 15, cc = c & 31, ob = rr * 64 + cc * 2; return st * 1024 + (ob ^ (((ob >> 9) & 1) << 5)); }
DI void stage_rc(int b, int& R, int& C) { const int st = b / 1024, sb = b % 1024, swz = sb ^ (((sb >> 9) & 1) << 5); R = (st >> 1) * 16 + swz / 64; C = (st & 1) * 32 + (swz % 64) / 2; }

DI void gemm8_tile(const bf16_t* __restrict__ A, const bf16_t* __restrict__ Bt, const int K, bf16_t* shm, f32x4 (&acc)[2][2][4][2]) {
  const int tid = opaque_tid();
  const int wid = tid >> 6, lane = tid & 63, wr = wid >> 2, wc = wid & 3, fr = lane & 15, fq = lane >> 4;
  const int swz = (fr * 64 + fq * 16) ^ ((fr >> 3) << 5);
  const char* aRd = (const char*)shm + swz + wr * 8192;
  const char* bRd = (const char*)shm + 65536 + swz + wc * 4096;
  int sr0, sc0, sr1, sc1;
  stage_rc(tid * 16, sr0, sc0);
  stage_rc(tid * 16 + 8192, sr1, sc1);
  const unsigned so0 = (unsigned)(sr0 * K + sc0) * 2u, so1 = (unsigned)(sr1 * K + sc1) * 2u;
  char* const stw = (char*)shm + __builtin_amdgcn_readfirstlane(tid & ~63) * 16;
  const char* const Ab = (const char*)A;
  const char* const Bb = (const char*)Bt;
#define SA(b, h) (((b) * 2 + (h)) * 16384)
#define SB(b, h) ((4 + (b) * 2 + (h)) * 16384)
#define STAGE(P, BASE, br, kt) do { const char* g_ = (BASE) + ((long)(br) * K + (long)(kt) * 64) * 2;                        \
    __builtin_amdgcn_global_load_lds((const unsigned*)(g_ + so0), (unsigned*)(stw + (P)), 16, 0, 0);                          \
    __builtin_amdgcn_global_load_lds((const unsigned*)(g_ + so1), (unsigned*)(stw + (P) + 8192), 16, 0, 0); } while (0)
#define LDA(dst, b, h) _Pragma("unroll") for (int m = 0; m < 4; ++m) _Pragma("unroll") for (int k = 0; k < 2; ++k) \
    dst[m][k] = *reinterpret_cast<const bf16x8*>(aRd + ((b) * 2 + (h)) * 16384 + (m * 2 + k) * 1024)
#define LDB(dst, b, h) _Pragma("unroll") for (int n = 0; n < 2; ++n) _Pragma("unroll") for (int k = 0; k < 2; ++k) \
    dst[n][k] = *reinterpret_cast<const bf16x8*>(bRd + ((b) * 2 + (h)) * 16384 + (n * 2 + k) * 1024)
#define MMA(ai, bj, At_, Bt_) do { __builtin_amdgcn_s_setprio(1);                                                          \
    _Pragma("unroll") for (int m = 0; m < 4; ++m) _Pragma("unroll") for (int n = 0; n < 2; ++n) _Pragma("unroll") for (int k = 0; k < 2; ++k) \
      acc[ai][bj][m][n] = __builtin_amdgcn_mfma_f32_16x16x32_bf16(At_[m][k], Bt_[n][k], acc[ai][bj][m][n], 0, 0, 0);       \
    __builtin_amdgcn_s_setprio(0); } while (0)
#define WAIT_V(n) asm volatile("s_waitcnt vmcnt(" #n ")" ::: "memory")
#define WAIT_L(n) asm volatile("s_waitcnt lgkmcnt(" #n ")" ::: "memory")
#define BAR __builtin_amdgcn_s_barrier()
#define SCHED __builtin_amdgcn_sched_barrier(0)
  bf16x8 At[4][2], B0[2][2], B1[2][2];
  const int nt = K / 64;
  STAGE(SB(0, 0), Bb, 0, 0); STAGE(SA(0, 0), Ab, 0, 0);
  STAGE(SB(0, 1), Bb, 128, 0); STAGE(SA(0, 1), Ab, 128, 0);
  if (wr == 1) BAR;
  WAIT_V(4); BAR;
  STAGE(SB(1, 0), Bb, 0, 1); STAGE(SA(1, 0), Ab, 0, 1); STAGE(SB(1, 1), Bb, 128, 1);
  WAIT_V(6); BAR;
  for (int t = 0; t < nt - 2; t += 2) {
    LDB(B0, 0, 0); SCHED; LDA(At, 0, 0); STAGE(SA(1, 1), Ab, 128, t + 1);
    WAIT_L(8); BAR; WAIT_L(0); MMA(0, 0, At, B0); BAR; SCHED;
    LDB(B1, 0, 1); STAGE(SB(0, 0), Bb, 0, t + 2);
    BAR; WAIT_L(0); MMA(0, 1, At, B1); BAR;
    LDA(At, 0, 1); STAGE(SA(0, 0), Ab, 0, t + 2);
    BAR; WAIT_L(0); MMA(1, 0, At, B0); BAR; SCHED;
    STAGE(SB(0, 1), Bb, 128, t + 2);
    WAIT_V(6); BAR; MMA(1, 1, At, B1); BAR;
    LDB(B0, 1, 0); SCHED; LDA(At, 1, 0); STAGE(SA(0, 1), Ab, 128, t + 2);
    WAIT_L(8); BAR; WAIT_L(0); MMA(0, 0, At, B0); BAR; SCHED;
    LDB(B1, 1, 1); STAGE(SB(1, 0), Bb, 0, t + 3);
    BAR; WAIT_L(0); MMA(0, 1, At, B1); BAR;
    LDA(At, 1, 1); STAGE(SA(1, 0), Ab, 0, t + 3);
    BAR; WAIT_L(0); MMA(1, 0, At, B0); BAR; SCHED;
    STAGE(SB(1, 1), Bb, 128, t + 3);
    WAIT_V(6); BAR; MMA(1, 1, At, B1); BAR;
  }
  { LDB(B0, 0, 0); LDA(At, 0, 0); STAGE(SA(1, 1), Ab, 128, nt - 1);
    BAR; WAIT_L(0); MMA(0, 0, At, B0); BAR;
    LDB(B1, 0, 1); BAR; WAIT_L(0); MMA(0, 1, At, B1); BAR;
    LDA(At, 0, 1); WAIT_V(4); BAR; WAIT_L(0); MMA(1, 0, At, B0); MMA(1, 1, At, B1); BAR; }
  { LDB(B0, 1, 0); LDA(At, 1, 0); WAIT_V(2); BAR; WAIT_L(0); MMA(0, 0, At, B0); BAR;
    LDB(B1, 1, 1); WAIT_V(0); BAR; WAIT_L(0); MMA(0, 1, At, B1); BAR;
    LDA(At, 1, 1); BAR; WAIT_L(0); MMA(1, 0, At, B0); MMA(1, 1, At, B1); BAR; }
  if (wr == 0) BAR;
#undef SA
#undef SB
#undef STAGE
#undef LDA
#undef LDB
#undef MMA
#undef WAIT_V
#undef WAIT_L
#undef BAR
#undef SCHED
}


DI void zero_acc8(f32x4 (&acc)[2][2][4][2]) {
#pragma unroll
  for (int a = 0; a < 2; ++a)
#pragma unroll
    for (int b = 0; b < 2; ++b)
#pragma unroll
      for (int m = 0; m < 4; ++m)
#pragma unroll
        for (int n = 0; n < 2; ++n) acc[a][b][m][n] = f32x4{0.f, 0.f, 0.f, 0.f};
}

constexpr int CSTR = 132;
DI void accq_to_lds(const f32x4 (&q)[4][2], float* sC) {
  const int tid = opaque_tid(), wid = tid >> 6, lane = tid & 63, wr = wid >> 2, wc = wid & 3, fr = lane & 15, fq = lane >> 4;
#pragma unroll
  for (int m = 0; m < 4; ++m)
#pragma unroll
    for (int n = 0; n < 2; ++n)
#pragma unroll
      for (int j = 0; j < 4; ++j) sC[(wr * 64 + m * 16 + fq * 4 + j) * CSTR + wc * 32 + n * 16 + fr] = q[m][n][j];
}
constexpr int SC2_OFF = 128 * CSTR;
template <class EPI>
DI void tile_epilogue2(const f32x4 (&acc)[2][2][4][2], float* sC, EPI epi) {
  __syncthreads();
  accq_to_lds(acc[0][0], sC);
  __syncthreads();
  accq_to_lds(acc[0][1], sC + SC2_OFF);
  epi(0, sC);
  __syncthreads();
  accq_to_lds(acc[1][0], sC);
  epi(1, sC + SC2_OFF);
  __syncthreads();
  accq_to_lds(acc[1][1], sC + SC2_OFF);
  epi(2, sC);
  __syncthreads();
  epi(3, sC + SC2_OFF);
  __syncthreads();
}

template <class F>
DI void epi_rows(const float* sC, F f) {
  const int tx = opaque_tid();
#pragma unroll
  for (int i = 0; i < 4; ++i) {
    const int c = tx + 512 * i, row = c >> 4, cc = (c & 15) * 8;
    const float4 a = *(const float4*)(sC + row * CSTR + cc), b = *(const float4*)(sC + row * CSTR + cc + 4);
    const float v[8] = {a.x, a.y, a.z, a.w, b.x, b.y, b.z, b.w};
    f(i, row, cc, v);
  }
}
DI void store8(bf16_t* p, const float (&v)[8]) { *(bf16x8*)p = pack8(v[0], v[1], v[2], v[3], v[4], v[5], v[6], v[7]); }
DI void epi_vt(const float* sC, bf16_t* VT, int m0, int head0, int c0, int ncol_log2) {
  const int b = m0 >> 12, s0 = m0 & 4095;
  const int nitems = 16 << ncol_log2;
  for (int c = opaque_tid(); c < nitems; c += 512) {
    const int col = c & ((1 << ncol_log2) - 1), rc = c >> ncol_log2;
    float v[8];
#pragma unroll
    for (int j = 0; j < 8; ++j) v[j] = sC[(rc * 8 + j) * CSTR + c0 + col];
    const int head = head0 + (col >> 6), d = col & 63;
    store8(VT + ((size_t)((b * 8 + head) * 64 + d)) * SEQL + s0 + rc * 8, v);
  }
}
DI void rope8(const float* sC, const float* ROPE, int tok, int row, int cc, float (&v)[8]) {
  const float* pr = sC + row * CSTR + (cc ^ 16);
  const bool upper = (cc & 16) != 0;
  const int f0 = cc & 15;
  const float* tb = ROPE + (size_t)tok * 32;
#pragma unroll
  for (int j = 0; j < 8; ++j) {
    const float o = pr[j], cs = tb[f0 + j], sn = tb[16 + f0 + j];
    v[j] = upper ? (o * sn + v[j] * cs) : (v[j] * cs - o * sn);
  }
}

DI void wconv_unit(const float* __restrict__ src, int Nsrc, int K, bf16_t* __restrict__ dst, const float* __restrict__ gain, int ng, int kg, int mode, float* tile, const int tid) {
  {
    const int k = tid >> 2, cq = tid & 3;
    const int n = ng * 64 + cq * 16;
    int sc = n;
    if (mode == 1) { sc = (n < 2688) ? n : (n < 5248 ? n + 32 : (n < 5280 ? n - 2560 : -1)); }
    const int kk = kg * 64 + k;
    float4 v[4];
    if (sc >= 0) {
      const float* sp = src + (size_t)kk * Nsrc + sc;
#pragma unroll
      for (int i = 0; i < 4; ++i) v[i] = *(const float4*)(sp + 4 * i);
      if (gain) { const float g = gain[kk];
#pragma unroll
        for (int i = 0; i < 4; ++i) { v[i].x *= g; v[i].y *= g; v[i].z *= g; v[i].w *= g; } }
    } else {
#pragma unroll
      for (int i = 0; i < 4; ++i) v[i] = make_float4(0.f, 0.f, 0.f, 0.f);
    }
    float* tp = tile + k * 65 + cq * 16;
#pragma unroll
    for (int i = 0; i < 4; ++i) { tp[4 * i] = v[i].x; tp[4 * i + 1] = v[i].y; tp[4 * i + 2] = v[i].z; tp[4 * i + 3] = v[i].w; }
  }
  __syncthreads();
  {
    const int n = tid >> 2, kc = tid & 3;
    float o[16];
#pragma unroll
    for (int j = 0; j < 16; ++j) o[j] = tile[(kc * 16 + j) * 65 + n];
    bf16_t* dp = dst + (size_t)(ng * 64 + n) * K + kg * 64 + kc * 16;
    *(bf16x8*)dp = pack8(o[0], o[1], o[2], o[3], o[4], o[5], o[6], o[7]);
    *(bf16x8*)(dp + 8) = pack8(o[8], o[9], o[10], o[11], o[12], o[13], o[14], o[15]);
  }
  __syncthreads();
}

DI void phase_prep(const Params& p, char* smem) {
  if (blockIdx.x == 0 && threadIdx.x < 16) { p.counter()[threadIdx.x] = 0; }
  for (int i = blockIdx.x * NTHREADS + threadIdx.x; i < 2 * NTOK; i += gridDim.x * NTHREADS) p.SSQ()[i] = 0.f;
  const int half = threadIdx.x >> 8, tid = threadIdx.x & 255;
  constexpr int U_MOD = 96 * 4, U_WIN = 84 * 16, U_WUQ = 12 * 6, U_WUKV = 16 * 4, U_WA = 16 * 8, U_WB = 16 * 8, U_WO = 16 * 16, U_ROPE = 1024;
  constexpr int U_TOTAL = U_MOD + U_ROPE + U_WIN + U_WUQ + U_WUKV + U_WA + U_WB + U_WO;
  float* tile = (float*)smem + half * (64 * 65 + 64);
  for (int up = blockIdx.x; up < U_TOTAL / 2; up += gridDim.x) {
    int v = 2 * up + half;
    if (v < U_MOD) {
      const int cg32 = v >> 2, kq = v & 3, n0 = cg32 * 32;
      const int kgp = tid >> 5, col = tid & 31;
      const int kb = kq * 256 + kgp * 32;
      float a0 = 0.f, a1 = 0.f, a2 = 0.f, a3 = 0.f;
      const float* wp = p.w_ada + (size_t)kb * 3072 + n0 + col;
      float wv[32];
#pragma unroll
      for (int kk = 0; kk < 32; ++kk) wv[kk] = wp[(size_t)kk * 3072];
#pragma unroll
      for (int kk = 0; kk < 32; ++kk) {
        a0 += wv[kk] * p.c[kb + kk]; a1 += wv[kk] * p.c[1024 + kb + kk]; a2 += wv[kk] * p.c[2048 + kb + kk]; a3 += wv[kk] * p.c[3072 + kb + kk];
      }
      float* red = (float*)smem + half * 1024;
      red[(kgp * 4 + 0) * 32 + col] = a0; red[(kgp * 4 + 1) * 32 + col] = a1; red[(kgp * 4 + 2) * 32 + col] = a2; red[(kgp * 4 + 3) * 32 + col] = a3;
      __syncthreads();
      if (tid < 128) {
        const int b = tid >> 5, cc = tid & 31;
        float s = (kq == 0) ? p.b_ada[n0 + cc] : 0.f;
#pragma unroll
        for (int g = 0; g < 8; ++g) s += red[(g * 4 + b) * 32 + cc];
        p.MOD()[(size_t)(b * 3072 + n0 + cc) * 4 + kq] = s;
      }
      __syncthreads();
      continue;
    }
    v -= U_MOD;
    if (v < U_WIN) { wconv_unit(p.w_in, INW, 1024, p.WinT(), nullptr, v >> 4, v & 15, 1, tile, tid); continue; }
    v -= U_WIN;
    if (v < U_WUQ) { wconv_unit(p.w_uq, 768, 384, p.WuqT(), p.q_gain, v / 6, v % 6, 0, tile, tid); continue; }
    v -= U_WUQ;
    if (v < U_WUKV) { wconv_unit(p.w_ukv, 1024, 256, p.WukvT(), p.kv_gain, v >> 2, v & 3, 0, tile, tid); continue; }
    v -= U_WUKV;
    if (v < U_WA) { wconv_unit(p.w_a, 1024, 512, p.WaT(), nullptr, v >> 3, v & 7, 0, tile, tid); continue; }
    v -= U_WA;
    if (v < U_WB) { wconv_unit(p.w_b, 1024, 512, p.WbT(), nullptr, v >> 3, v & 7, 0, tile, tid); continue; }
    v -= U_WB;
    if (v < U_WO) { wconv_unit(p.w_out, 1024, 1024, p.WoT(), nullptr, v >> 4, v & 15, 0, tile, tid); continue; }
    v -= U_WO;
    {
      const int idx = v * 256 + tid, tok = idx >> 4, i = idx & 15;
      const float ang = (float)p.pos[tok] * c_invfreq[i];
      double t = (double)ang * 0.15915494309189535;
      t -= rint(t);
      const float tf = (float)t;
      p.ROPE()[(size_t)tok * 32 + i] = __builtin_amdgcn_cosf(tf);
      p.ROPE()[(size_t)tok * 32 + 16 + i] = __builtin_amdgcn_sinf(tf);
    }
  }
}

DI float mod_get(const float* MOD, int b, int n) { const float4 q = *(const float4*)(MOD + (size_t)(b * 3072 + n) * 4); return (q.x + q.y) + (q.z + q.w); }

DI void phase_h(const Params& p, char* smem) {
  const int tid = opaque_tid(), lane = tid & 63, w = tid >> 6;
  float* gs = (float*)smem;
  float* sh = gs + 1024;
  const int xq = blockIdx.x & 7, lb = blockIdx.x >> 3, nlb = gridDim.x >> 3;
  const bool xmap = (gridDim.x & 7) == 0;
  for (int rgi = xmap ? lb : (int)blockIdx.x; rgi < (xmap ? 32 : NTOK / 64); rgi += (xmap ? nlb : (int)gridDim.x)) {
    const int rg = xmap ? (32 * xq + rgi) : rgi;
    const int b = (rg * 64) >> 12;
    __syncthreads();
#pragma unroll
    for (int i = 0; i < 2; ++i) {
      const int k = tid + 512 * i;
      gs[k] = p.norm_gain[k] * (1.f + mod_get(p.MOD(), b, 1024 + k));
      sh[k] = mod_get(p.MOD(), b, k);
    }
    __syncthreads();
#pragma unroll 2
    for (int rr = 0; rr < 8; ++rr) {
      const int row = rg * 64 + w * 8 + rr;
      const float* xr = p.x + (size_t)row * DM;
      float4 v[4];
      float ss = 0.f;
#pragma unroll
      for (int i = 0; i < 2; ++i) {
        const int e = 8 * (lane + 64 * i);
        v[2 * i] = *(const float4*)(xr + e);
        v[2 * i + 1] = *(const float4*)(xr + e + 4);
        ss += v[2 * i].x * v[2 * i].x + v[2 * i].y * v[2 * i].y + v[2 * i].z * v[2 * i].z + v[2 * i].w * v[2 * i].w;
        ss += v[2 * i + 1].x * v[2 * i + 1].x + v[2 * i + 1].y * v[2 * i + 1].y + v[2 * i + 1].z * v[2 * i + 1].z + v[2 * i + 1].w * v[2 * i + 1].w;
      }
#pragma unroll
      for (int o = 32; o >= 1; o >>= 1) ss += __shfl_xor(ss, o);
      const float rn = __builtin_amdgcn_rsqf(ss * (1.f / DM) + EPSN);
#pragma unroll
      for (int i = 0; i < 2; ++i) {
        const int e = 8 * (lane + 64 * i);
        const float4 g0 = *(const float4*)(gs + e), g1 = *(const float4*)(gs + e + 4);
        const float4 s0 = *(const float4*)(sh + e), s1 = *(const float4*)(sh + e + 4);
        *(bf16x8*)(p.Hb() + (size_t)row * DM + e) =
            pack8(v[2 * i].x * rn * g0.x + s0.x, v[2 * i].y * rn * g0.y + s0.y, v[2 * i].z * rn * g0.z + s0.z, v[2 * i].w * rn * g0.w + s0.w,
                  v[2 * i + 1].x * rn * g1.x + s1.x, v[2 * i + 1].y * rn * g1.y + s1.y, v[2 * i + 1].z * rn * g1.z + s1.z, v[2 * i + 1].w * rn * g1.w + s1.w);
      }
    }
  }
  __syncthreads();
}

DI void g1_epi(const Params& p, const float* sC, const int m0, const int n0, const int ct, const bool do_ssq) {
    if (ct < 4) {
      epi_rows(sC, [&](int, int row, int cc, const float (&v)[8]) {
        float o[8];
#pragma unroll
        for (int j = 0; j < 8; ++j) o[j] = v[j] * QS_SCALE;
        store8(p.Qsb() + (size_t)(m0 + row) * 512 + n0 + cc, o); });
    } else if (ct < 8) {
      epi_rows(sC, [&](int, int row, int cc, const float (&v)[8]) { store8(p.Ksb() + (size_t)(m0 + row) * 512 + n0 - 512 + cc, v); });
    } else if (ct < 12) {
      epi_vt(sC, p.VTsb(), m0, (n0 - 1024) >> 6, 0, 7);
    } else if (ct < 16) {
      epi_rows(sC, [&](int, int row, int cc, const float (&v)[8]) {
        float o[8];
#pragma unroll
        for (int j = 0; j < 8; ++j) o[j] = siluf_fast(v[j]);
        store8(p.Zsb() + (size_t)(m0 + row) * 512 + n0 - 1536 + cc, o); });
    } else if (ct < 19) {
      epi_rows(sC, [&](int, int row, int cc, const float (&v)[8]) {
        store8(p.CQ() + (size_t)(m0 + row) * 384 + n0 - 2048 + cc, v);
        float q = 0.f;
#pragma unroll
        for (int j = 0; j < 8; ++j) q += v[j] * v[j];
        q += __shfl_xor(q, 1); q += __shfl_xor(q, 2); q += __shfl_xor(q, 4); q += __shfl_xor(q, 8);
        if (do_ssq && (threadIdx.x & 15) == 0) atomicAdd(p.SSQ() + m0 + row, q); });
    } else if (ct < 21) {
      epi_rows(sC, [&](int, int row, int cc, const float (&v)[8]) {
        store8(p.CKV() + (size_t)(m0 + row) * 256 + n0 - 2432 + cc, v);
        float q = 0.f;
#pragma unroll
        for (int j = 0; j < 8; ++j) q += v[j] * v[j];
        q += __shfl_xor(q, 1); q += __shfl_xor(q, 2); q += __shfl_xor(q, 4); q += __shfl_xor(q, 8);
        if (do_ssq && (threadIdx.x & 15) == 0) atomicAdd(p.SSQ() + NTOK + m0 + row, q); });
    } else if (ct < 25) {
      epi_rows(sC, [&](int, int row, int cc, const float (&v)[8]) {
        float o[8];
#pragma unroll
        for (int j = 0; j < 8; ++j) o[j] = siluf_fast(v[j]);
        store8(p.Zmla() + (size_t)(m0 + row) * 512 + n0 - 2688 + cc, o); });
    } else if (ct < 33) {
      epi_rows(sC, [&](int, int row, int cc, const float (&v)[8]) {
        float o[8];
#pragma unroll
        for (int j = 0; j < 8; ++j) o[j] = sigmoidf_fast(v[j]);
        store8(p.GA() + (size_t)(m0 + row) * 1024 + n0 - 3200 + cc, o); });
    } else if (ct < 41) {
      epi_rows(sC, [&](int, int row, int cc, const float (&v)[8]) {
        float o[8];
#pragma unroll
        for (int j = 0; j < 8; ++j) o[j] = sigmoidf_fast(v[j]);
        store8(p.GB() + (size_t)(m0 + row) * 1024 + n0 - 4224 + cc, o); });
    } else {
      epi_rows(sC, [&](int, int row, int cc, const float (&v)[8]) {
        if (cc < 32) {
          float o[8];
#pragma unroll
          for (int j = 0; j < 8; ++j) o[j] = v[j];
          rope8(sC, p.ROPE(), m0 + row, row, cc, o);
          store8(p.KPE() + (size_t)(m0 + row) * 32 + cc, o);
        } });
    }
}

DI void g1_tile(const Params& p, char* smem, const int rt, const int ct2, const bool do_ssq) {
  bf16_t* shm = (bf16_t*)smem;
  float* sC = (float*)smem;
  const int m0 = rt * 256, n0 = ct2 * 256;
  f32x4 acc[2][2][4][2];
  zero_acc8(acc);
  gemm8_tile(p.Hb() + (size_t)m0 * DM, p.WinT() + (size_t)n0 * DM, DM, shm, acc);
  tile_epilogue2(acc, sC, [&](const int qd, const float* sq) {
    g1_epi(p, sq, m0 + (qd >> 1) * 128, n0 + (qd & 1) * 128, ct2 * 2 + (qd & 1), do_ssq); });
}

constexpr int G1_NCT = 20;
DI void phase_g1(const Params& p, char* smem, bool do_ssq = true) {
  const int xq = blockIdx.x & 7, lb = blockIdx.x >> 3, nlb = gridDim.x >> 3;
  const bool xmap = (gridDim.x & 7) == 0;
  for (int t = xmap ? lb : (int)blockIdx.x; t < (xmap ? 8 * G1_NCT : 64 * G1_NCT); t += (xmap ? nlb : (int)gridDim.x)) {
    int rt, ct2;
    if (xmap) { ct2 = t >> 3; rt = 8 * xq + (t & 7); } else { rt = t / G1_NCT; ct2 = t % G1_NCT; }
    g1_tile(p, smem, rt, ct2, do_ssq);
  }
}

DI void g2_epi_q(const Params& p, const float* sC, const float* rsq, const int m0, const int n0) {
  epi_rows(sC, [&](int, int row, int cc, const float (&v)[8]) {
    const int col = n0 + cc;
    float o[8];
#pragma unroll
    for (int j = 0; j < 8; ++j) o[j] = v[j];
    if (((col >> 5) % 3) == 2) rope8(sC, p.ROPE(), m0 + row, row, cc, o);
    const float sc = rsq[row] * QM_SCALE;
#pragma unroll
    for (int j = 0; j < 8; ++j) o[j] *= sc;
    store8(p.Qmla() + (size_t)(m0 + row) * 768 + col, o);
  });
}
DI void g2_epi_kv(const Params& p, const float* sC, const float* rsq, const int m0, const int head) {
  epi_rows(sC, [&](int, int row, int cc, const float (&v)[8]) {
    if (cc < 64) {
      const float sc = rsq[row];
      float o[8];
#pragma unroll
      for (int j = 0; j < 8; ++j) o[j] = v[j] * sc;
      store8(p.Knope() + (size_t)(m0 + row) * 512 + head * 64 + cc, o);
    } });
  const int b = m0 >> 12, s0 = m0 & 4095;
  for (int c = opaque_tid(); c < 1024; c += 512) {
    const int col = c & 63, rc = c >> 6;
    float v[8];
#pragma unroll
    for (int j = 0; j < 8; ++j) v[j] = sC[(rc * 8 + j) * CSTR + 64 + col] * rsq[rc * 8 + j];
    store8(p.VTmla() + ((size_t)((b * 8 + head) * 64 + col)) * SEQL + s0 + rc * 8, v);
  }
}

DI void g2_tile(const Params& p, char* smem, const bool isq, const int rt, const int ct) {
  bf16_t* shm = (bf16_t*)smem;
  float* sC = (float*)smem;
  float* rs = (float*)(smem + RS_OFF);
  const int m0 = rt * 256, n0 = ct * 256;
  f32x4 acc[2][2][4][2];
  zero_acc8(acc);
  if (isq) {
    if (threadIdx.x < 256) rs[threadIdx.x] = __builtin_amdgcn_rsqf(p.SSQ()[m0 + threadIdx.x] * (1.f / 384.f) + EPSN);
    gemm8_tile(p.CQ() + (size_t)m0 * 384, p.WuqT() + (size_t)n0 * 384, 384, shm, acc);
    tile_epilogue2(acc, sC, [&](const int qd, const float* sq) {
      g2_epi_q(p, sq, rs + (qd >> 1) * 128, m0 + (qd >> 1) * 128, n0 + (qd & 1) * 128); });
  } else {
    if (threadIdx.x < 256) rs[threadIdx.x] = __builtin_amdgcn_rsqf(p.SSQ()[NTOK + m0 + threadIdx.x] * (1.f / 256.f) + EPSN);
    gemm8_tile(p.CKV() + (size_t)m0 * 256, p.WukvT() + (size_t)n0 * 256, 256, shm, acc);
    tile_epilogue2(acc, sC, [&](const int qd, const float* sq) {
      g2_epi_kv(p, sq, rs + (qd >> 1) * 128, m0 + (qd >> 1) * 128, ct * 2 + (qd & 1)); });
  }
  __syncthreads();
}

DI void phase_g2(const Params& p, char* smem) {
  const int xq = blockIdx.x & 7, lb = blockIdx.x >> 3, nlb = gridDim.x >> 3;
  if ((gridDim.x & 7) == 0 && nlb == 32) {
    if (lb < 8) {
      g1_tile(p, smem, 8 * xq + lb, G1_NCT, false);
      const int v2 = 24 + lb;
      g2_tile(p, smem, false, 8 * xq + (v2 & 7), v2 >> 3);
      return;
    }
    const int v = lb - 8;
    g2_tile(p, smem, true, 8 * xq + (v & 7), v >> 3);
    g2_tile(p, smem, false, 8 * xq + (v & 7), v >> 3);
  } else {
    for (int tt = blockIdx.x; tt < 64 + 192 + 256; tt += gridDim.x) {
      if (tt < 64) g1_tile(p, smem, tt, G1_NCT, false);
      else if (tt < 256) { const int v = tt - 64; g2_tile(p, smem, true, v / 3, v % 3); }
      else { const int v = tt - 256; g2_tile(p, smem, false, v >> 2, v & 3); }
    }
  }
}

constexpr int VSTR = 68;

template <bool MLA>
DI void attn_item(const Params& p, int b, int h, int qb, char* smem) {
  constexpr int DK = MLA ? 96 : 64;
  constexpr int KSTR = MLA ? 104 : 72;
  constexpr int NKS = DK / 16;
  bf16_t* sK = (bf16_t*)smem;
  bf16_t* sV = sK + 2 * 64 * KSTR;
  const int tid = threadIdx.x, lane = tid & 63, w = tid >> 6, r = lane & 31, hh = lane >> 5;
  const int tokb = b * SEQL;
  const int tok0 = tokb + qb * 256;
  const int qw = qb * 256 + w * 32;

  bf16x8 qf[NKS];
  {
    const bf16_t* qptr = MLA ? (p.Qmla() + (size_t)(tok0 + w * 32 + r) * 768 + h * 96 + hh * 8) : (p.Qsb() + (size_t)(tok0 + w * 32 + r) * 512 + h * 64 + hh * 8);
#pragma unroll
    for (int ks = 0; ks < NKS; ++ks) qf[ks] = *(const bf16x8*)(qptr + ks * 16);
  }
  bf16x8 tf[2];
  if (!MLA) {
#pragma unroll
    for (int st = 0; st < 2; ++st)
#pragma unroll
      for (int e = 0; e < 8; ++e) { const int j = 16 * st + 8 * (e >> 2) + 4 * hh + (e & 3); tf[st][e] = (j >= r) ? (short)0x3F80 : (short)0; }
  }

  f32x16 oacc[2];
#pragma unroll
  for (int i = 0; i < 16; ++i) { oacc[0][i] = 0.f; oacc[1][i] = 0.f; }
  float carry = 0.f;
  float mrun = 0.f, lrun = 0.f;

  const bf16_t* Kg = MLA ? p.Knope() : p.Ksb();
  const bf16_t* VTg = (MLA ? p.VTmla() : p.VTsb()) + (size_t)((b * 8 + h) * 64) * SEQL;
  const int nt = 4 * qb + 4;

  uint4 xk0, xv0, xp, yk0, yv0, yp;
  xp = make_uint4(0, 0, 0, 0); yp = xp;
  const int prow = tid >> 3, pch = tid & 7;
  const bf16_t* kgp = Kg + (size_t)(tokb + prow) * 512 + h * 64 + pch * 8;
  const bf16_t* vgp = VTg + (size_t)prow * SEQL + pch * 8;
  const bf16_t* pgp = p.KPE() + (size_t)(tokb + ((tid & 255) >> 2)) * 32 + (tid & 3) * 8;
#define ATT_GLOAD(P, kt_)                                                          \
  {                                                                                \
    const int kt__ = (kt_);                                                        \
    P##k0 = *(const uint4*)(kgp + (size_t)(kt__ * 64) * 512);                      \
    P##v0 = *(const uint4*)(vgp + kt__ * 64);                                      \
    if (MLA && tid < 256) P##p = *(const uint4*)(pgp + (size_t)(kt__ * 64) * 32);  \
  }
#define ATT_SWRITE(P, buf_)                                                        \
  {                                                                                \
    bf16_t* dK = sK + (buf_) * 64 * KSTR;                                          \
    bf16_t* dV = sV + (buf_) * 64 * VSTR;                                          \
    *(uint4*)(dK + prow * KSTR + pch * 8) = P##k0;                                 \
    uint2* dv0 = (uint2*)(dV + prow * VSTR + pch * 8);                             \
    dv0[0] = make_uint2(P##v0.x, P##v0.y); dv0[1] = make_uint2(P##v0.z, P##v0.w);  \
    if (MLA && tid < 256) *(uint4*)(dK + (tid >> 2) * KSTR + 64 + (tid & 3) * 8) = P##p; \
  }
#define ATT_KT(i_) (MLA ? (i_) : (nt - 1 - (i_)))

  ATT_GLOAD(x, ATT_KT(0));
  ATT_GLOAD(y, ATT_KT(1));
  ATT_SWRITE(x, 0);
  __syncthreads();
  bool alive = true;
  for (int it0 = 0; alive; it0 += 2) {
#pragma unroll
   for (int half = 0; half < 2; ++half) {
    const int it = it0 + half;
    const int kt = ATT_KT(it);
    const int cur = half;
    const bool more = (it + 1 < nt);
    if (it + 2 < nt) { if (half == 0) ATT_GLOAD(x, ATT_KT(it + 2)) else ATT_GLOAD(y, ATT_KT(it + 2)) }
    const bf16_t* cK = sK + cur * 64 * KSTR;
    const bf16_t* cV = sV + cur * 64 * VSTR;
    if (MLA) {
      if (kt * 64 <= qw + 31) {
        f32x16 s0, s1;
        {
          const float sinit = -mrun;
#pragma unroll
          for (int i = 0; i < 16; ++i) { s0[i] = sinit; s1[i] = sinit; }
        }
        __builtin_amdgcn_s_setprio(1);
#pragma unroll
        for (int ks = 0; ks < NKS; ++ks) {
          const bf16x8 k0 = *(const bf16x8*)(cK + r * KSTR + ks * 16 + hh * 8);
          const bf16x8 k1 = *(const bf16x8*)(cK + (32 + r) * KSTR + ks * 16 + hh * 8);
          s0 = MFMA(k0, qf[ks], s0);
          s1 = MFMA(k1, qf[ks], s1);
        }
        __builtin_amdgcn_s_setprio(0);
        if (kt * 64 + 63 > qw) {
          const int lim = qw + r - kt * 64;
#pragma unroll
          for (int i = 0; i < 16; ++i) { if (crow(i, hh) > lim) s0[i] = -1e30f; if (32 + crow(i, hh) > lim) s1[i] = -1e30f; }
        }
        float m0 = fmaxf(fmaxf(s0[0], s0[1]), s0[2]), m1 = fmaxf(fmaxf(s1[0], s1[1]), s1[2]);
#pragma unroll
        for (int i = 3; i < 15; i += 2) { m0 = fmaxf(fmaxf(m0, s0[i]), s0[i + 1]); m1 = fmaxf(fmaxf(m1, s1[i]), s1[i + 1]); }
        float mloc = fmaxf(fmaxf(m0, s0[15]), fmaxf(m1, s1[15]));
        mloc = half_max(mloc);
        const bool first = (it == 0);
        const float delta = first ? mloc : fmaxf(mloc, 0.f);
        if (first || __builtin_amdgcn_ballot_w64(delta > 0.f) != 0ull) {
          const float alpha = first ? 0.f : __builtin_amdgcn_exp2f(-delta);
          mrun += delta;
          lrun *= alpha;
#pragma unroll
          for (int i = 0; i < 16; ++i) { oacc[0][i] *= alpha; oacc[1][i] *= alpha; s0[i] -= delta; s1[i] -= delta; }
        }
        float ps0 = 0.f, ps1 = 0.f;
#pragma unroll
        for (int i = 0; i < 16; ++i) { s0[i] = __builtin_amdgcn_exp2f(s0[i]); s1[i] = __builtin_amdgcn_exp2f(s1[i]); ps0 += s0[i]; ps1 += s1[i]; }
        lrun += ps0 + ps1;
        bf16x8 pf4[4];
        pf4[0] = pack8(s0[0], s0[1], s0[2], s0[3], s0[4], s0[5], s0[6], s0[7]);
        pf4[1] = pack8(s0[8], s0[9], s0[10], s0[11], s0[12], s0[13], s0[14], s0[15]);
        pf4[2] = pack8(s1[0], s1[1], s1[2], s1[3], s1[4], s1[5], s1[6], s1[7]);
        pf4[3] = pack8(s1[8], s1[9], s1[10], s1[11], s1[12], s1[13], s1[14], s1[15]);
        __builtin_amdgcn_s_setprio(1);
#pragma unroll
        for (int st = 0; st < 4; ++st)
#pragma unroll
          for (int dt = 0; dt < 2; ++dt) {
            const bf16_t* vp = cV + (dt * 32 + r) * VSTR + st * 16 + 4 * hh;
            const s16x4 lo = *(const s16x4*)vp;
            const s16x4 hi = *(const s16x4*)(vp + 8);
            const bf16x8 vf = __builtin_shufflevector(lo, hi, 0, 1, 2, 3, 4, 5, 6, 7);
            oacc[dt] = MFMA(vf, pf4[st], oacc[dt]);
          }
        __builtin_amdgcn_s_setprio(0);
      }
    } else
#pragma unroll
    for (int si = 0; si < 2; ++si) {
      const int sub = MLA ? si : (1 - si);
      const int kb = kt * 64 + sub * 32;
      if (kb > qw) continue;
      const bool diag = (kb == qw);
      f32x16 s;
      {
        const float sinit = MLA ? -mrun : 0.f;
#pragma unroll
        for (int i = 0; i < 16; ++i) s[i] = sinit;
      }
      __builtin_amdgcn_s_setprio(1);
#pragma unroll
      for (int ks = 0; ks < NKS; ++ks) {
        const bf16x8 kf = *(const bf16x8*)(cK + (sub * 32 + r) * KSTR + ks * 16 + hh * 8);
        s = MFMA(kf, qf[ks], s);
      }
      __builtin_amdgcn_s_setprio(0);
      bf16x8 pf[2];
      if (!MLA) {
        float sp[16];
        float tsum = 0.f;
#pragma unroll
        for (int i = 0; i < 16; ++i) {
          const float z = s[i];
          float v = __builtin_amdgcn_logf(1.f + __builtin_amdgcn_exp2f(fminf(z, 126.f)));
          if (diag && !(crow(i, hh) < r)) v = 0.f;
          sp[i] = v;
          tsum += v;
        }
        f32x16 cacc;
#pragma unroll
        for (int i = 0; i < 16; ++i) cacc[i] = carry;
        cacc = MFMA(tf[0], pack8(sp[0], sp[1], sp[2], sp[3], sp[4], sp[5], sp[6], sp[7]), cacc);
        cacc = MFMA(tf[1], pack8(sp[8], sp[9], sp[10], sp[11], sp[12], sp[13], sp[14], sp[15]), cacc);
        float pr[16];
#pragma unroll
        for (int i = 0; i < 16; ++i) {
          float v = __builtin_amdgcn_exp2f(s[i] - cacc[i]);
          if (diag && !(crow(i, hh) < r)) v = 0.f;
          pr[i] = v;
        }
        carry += half_sum(tsum);
        pf[0] = pack8(pr[0], pr[1], pr[2], pr[3], pr[4], pr[5], pr[6], pr[7]);
        pf[1] = pack8(pr[8], pr[9], pr[10], pr[11], pr[12], pr[13], pr[14], pr[15]);
      } else {
        if (diag) {
#pragma unroll
          for (int i = 0; i < 16; ++i) if (!(crow(i, hh) <= r)) s[i] = -1e30f;
        }
        float mloc = fmaxf(fmaxf(s[0], s[1]), s[2]);
#pragma unroll
        for (int i = 3; i < 15; i += 2) mloc = fmaxf(fmaxf(mloc, s[i]), s[i + 1]);
        mloc = fmaxf(mloc, s[15]);
        mloc = half_max(mloc);
        const bool first = (it == 0) && (si == 0);
        const float delta = first ? mloc : fmaxf(mloc, 0.f);
        if (first || __builtin_amdgcn_ballot_w64(delta > 0.f) != 0ull) {
          const float alpha = first ? 0.f : __builtin_amdgcn_exp2f(-delta);
          mrun += delta;
          lrun *= alpha;
#pragma unroll
          for (int i = 0; i < 16; ++i) { oacc[0][i] *= alpha; oacc[1][i] *= alpha; s[i] -= delta; }
        }
        float pr[16];
        float ps0 = 0.f, ps1 = 0.f;
#pragma unroll
        for (int i = 0; i < 16; i += 2) { pr[i] = __builtin_amdgcn_exp2f(s[i]); pr[i + 1] = __builtin_amdgcn_exp2f(s[i + 1]); ps0 += pr[i]; ps1 += pr[i + 1]; }
        lrun += ps0 + ps1;
        pf[0] = pack8(pr[0], pr[1], pr[2], pr[3], pr[4], pr[5], pr[6], pr[7]);
        pf[1] = pack8(pr[8], pr[9], pr[10], pr[11], pr[12], pr[13], pr[14], pr[15]);
      }
      __builtin_amdgcn_s_setprio(1);
#pragma unroll
      for (int dt = 0; dt < 2; ++dt)
#pragma unroll
        for (int st = 0; st < 2; ++st) {
          const bf16_t* vp = cV + (dt * 32 + r) * VSTR + sub * 32 + st * 16 + 4 * hh;
          const s16x4 lo = *(const s16x4*)vp;
          const s16x4 hi = *(const s16x4*)(vp + 8);
          const bf16x8 vf = __builtin_shufflevector(lo, hi, 0, 1, 2, 3, 4, 5, 6, 7);
          oacc[dt] = MFMA(vf, pf[st], oacc[dt]);
        }
      __builtin_amdgcn_s_setprio(0);
    }
    if (more) { if (half == 0) ATT_SWRITE(y, 1) else ATT_SWRITE(x, 0) }
    if (!MLA) {
      int* flg = (int*)(smem + SMEM_BYTES - 128) + (it & 1) * 8;
      const bool wok = (__builtin_amdgcn_ballot_w64(carry >= 160.f) == ~0ull);
      if (lane == 0) flg[w] = wok ? 1 : 0;
      __syncthreads();
      alive = more && ((flg[0] & flg[1] & flg[2] & flg[3] & flg[4] & flg[5] & flg[6] & flg[7]) == 0);
    } else {
      __syncthreads();
      alive = more;
    }
    if (!alive) break;
   }
  }
#undef ATT_GLOAD
#undef ATT_SWRITE
#undef ATT_KT
  float inv = 1.f;
  if (MLA) { const float lt = half_sum(lrun); inv = 1.f / lt; }
  const int tok = tok0 + w * 32 + r;
  const bf16_t* zg = (MLA ? p.Zmla() : p.Zsb()) + (size_t)tok * 512 + h * 64;
  bf16_t* og = (MLA ? p.OBg() : p.OAg()) + (size_t)tok * 512 + h * 64;
#pragma unroll
  for (int dt = 0; dt < 2; ++dt)
#pragma unroll
    for (int g = 0; g < 4; ++g) {
      const int d = dt * 32 + 8 * g + 4 * hh;
      const u32x2 zz = *(const u32x2*)(zg + d);
      const float z0 = __uint_as_float(zz[0] << 16), z1 = __uint_as_float(zz[0] & 0xffff0000u);
      const float z2 = __uint_as_float(zz[1] << 16), z3 = __uint_as_float(zz[1] & 0xffff0000u);
      u32x2 o;
      o[0] = pk2(oacc[dt][4 * g] * inv * z0, oacc[dt][4 * g + 1] * inv * z1);
      o[1] = pk2(oacc[dt][4 * g + 2] * inv * z2, oacc[dt][4 * g + 3] * inv * z3);
      *(u32x2*)(og + d) = o;
    }
}

DI void phase_attn(const Params& p, char* smem, int cbase, int only) {
  int* s_item = (int*)(smem + SMEM_BYTES - 16);
  const int q0 = blockIdx.x & 7;
  int qi = 0;
  for (;;) {
    if (threadIdx.x < 64) {
      int item = -1;
      while (qi < 8) {
        const int q = (q0 + qi) & 7;
        int idx = 0;
        if (threadIdx.x == 0) idx = atomicAdd(p.counter() + cbase + q, 1);
        idx = __builtin_amdgcn_readfirstlane(idx);
        if (idx < 128) { item = q * 256 + idx; break; }
        const int lq = (q0 + (threadIdx.x & 7)) & 7;
        const int head = __hip_atomic_load(p.counter() + cbase + lq, __ATOMIC_RELAXED, __HIP_MEMORY_SCOPE_AGENT);
        const unsigned long long avail = __builtin_amdgcn_ballot_w64((threadIdx.x < 8) && (head < 128) && ((int)(threadIdx.x & 7) > qi));
        if (avail == 0ull) { qi = 8; break; }
        qi = __builtin_ctzll(avail);
      }
      if (threadIdx.x == 0) *s_item = item;
    }
    __syncthreads();
    const int item = *s_item;
    __syncthreads();
    if (item < 0) break;
    const int q = item >> 8, idx = item & 255;
    const int i2 = idx & 63;
    const int bh = q + 8 * (i2 & 3);
    const int qb = 15 - (i2 >> 2);
    if (idx < 64) { if (only != 2) attn_item<true>(p, bh >> 3, bh & 7, qb, smem); }
    else { if (only != 1) attn_item<false>(p, bh >> 3, bh & 7, qb, smem); }
  }
}

DI void g3_pre_a(const Params& p, const int m0, const int n0, u32x4 (&g)[4]) {
  const int txo = opaque_tid();
#pragma unroll
  for (int i = 0; i < 4; ++i) {
    const int c = txo + 512 * i, row = c >> 4, cc = (c & 15) * 8;
    g[i] = *(const u32x4*)(p.GA() + (size_t)(m0 + row) * 1024 + n0 + cc);
  }
}
DI void g3_epi_a(const Params& p, const float* sC, const int m0, const int n0, const u32x4 (&gq)[4]) {
  const int txo = opaque_tid();
#pragma unroll
  for (int i = 0; i < 4; ++i) {
    const int c = txo + 512 * i, row = c >> 4, cc = (c & 15) * 8;
    const u32x4 g = gq[i];
    const float4 a = *(const float4*)(sC + row * CSTR + cc), b = *(const float4*)(sC + row * CSTR + cc + 4);
    u32x4 y;
    y[0] = pk2(a.x * __uint_as_float(g[0] << 16), a.y * __uint_as_float(g[0] & 0xffff0000u));
    y[1] = pk2(a.z * __uint_as_float(g[1] << 16), a.w * __uint_as_float(g[1] & 0xffff0000u));
    y[2] = pk2(b.x * __uint_as_float(g[2] << 16), b.y * __uint_as_float(g[2] & 0xffff0000u));
    y[3] = pk2(b.z * __uint_as_float(g[3] << 16), b.w * __uint_as_float(g[3] & 0xffff0000u));
    *(u32x4*)(p.MERGED() + (size_t)(m0 + row) * 1024 + n0 + cc) = y;
  }
}
DI void g3_pre_b(const Params& p, const int m0, const int n0, u32x4 (&g)[4], u32x4 (&y)[4]) {
  const int txo2 = opaque_tid();
#pragma unroll
  for (int i = 0; i < 4; ++i) {
    const int c = txo2 + 512 * i, row = c >> 4, cc = (c & 15) * 8;
    g[i] = *(const u32x4*)(p.GB() + (size_t)(m0 + row) * 1024 + n0 + cc);
    y[i] = *(const u32x4*)(p.MERGED() + (size_t)(m0 + row) * 1024 + n0 + cc);
  }
}
DI void g3_epi_b(const Params& p, const float* sC, const int m0, const int n0, const u32x4 (&gq)[4], const u32x4 (&yq)[4]) {
  const int txo2 = opaque_tid();
#pragma unroll
  for (int i = 0; i < 4; ++i) {
    const int c = txo2 + 512 * i, row = c >> 4, cc = (c & 15) * 8;
    const u32x4 g = gq[i];
    const u32x4 yv = yq[i];
    const float4 a = *(const float4*)(sC + row * CSTR + cc), b = *(const float4*)(sC + row * CSTR + cc + 4);
    u32x4 o;
    o[0] = pk2(__uint_as_float(yv[0] << 16) + a.x * __uint_as_float(g[0] << 16), __uint_as_float(yv[0] & 0xffff0000u) + a.y * __uint_as_float(g[0] & 0xffff0000u));
    o[1] = pk2(__uint_as_float(yv[1] << 16) + a.z * __uint_as_float(g[1] << 16), __uint_as_float(yv[1] & 0xffff0000u) + a.w * __uint_as_float(g[1] & 0xffff0000u));
    o[2] = pk2(__uint_as_float(yv[2] << 16) + b.x * __uint_as_float(g[2] << 16), __uint_as_float(yv[2] & 0xffff0000u) + b.y * __uint_as_float(g[2] & 0xffff0000u));
    o[3] = pk2(__uint_as_float(yv[3] << 16) + b.z * __uint_as_float(g[3] << 16), __uint_as_float(yv[3] & 0xffff0000u) + b.w * __uint_as_float(g[3] & 0xffff0000u));
    *(u32x4*)(p.MERGED() + (size_t)(m0 + row) * 1024 + n0 + cc) = o;
  }
}
DI void phase_g3(const Params& p, char* smem) {
  bf16_t* shm = (bf16_t*)smem;
  float* sC = (float*)smem;
  const int xq = blockIdx.x & 7, lb = blockIdx.x >> 3, nlb = gridDim.x >> 3;
  const bool xmap = (gridDim.x & 7) == 0;
  for (int t = xmap ? lb : (int)blockIdx.x; t < (xmap ? 32 : 256); t += (xmap ? nlb : (int)gridDim.x)) {
    const int rt = xmap ? (8 * xq + (t & 7)) : (t >> 2), ct = xmap ? (t >> 3) : (t & 3);
    const int m0 = rt * 256, n0 = ct * 256;
    f32x4 acc[2][2][4][2];
    zero_acc8(acc);
    gemm8_tile(p.OAg() + (size_t)m0 * 512, p.WaT() + (size_t)n0 * 512, 512, shm, acc);
#pragma unroll
    for (int ai = 0; ai < 2; ++ai)
#pragma unroll
      for (int bj = 0; bj < 2; ++bj) {
        u32x4 gq[4];
        g3_pre_a(p, m0 + ai * 128, n0 + bj * 128, gq);
        __syncthreads();
        accq_to_lds(acc[ai][bj], sC);
        __syncthreads();
        g3_epi_a(p, sC, m0 + ai * 128, n0 + bj * 128, gq);
      }
    __syncthreads();
    zero_acc8(acc);
    gemm8_tile(p.OBg() + (size_t)m0 * 512, p.WbT() + (size_t)n0 * 512, 512, shm, acc);
#pragma unroll
    for (int ai = 0; ai < 2; ++ai)
#pragma unroll
      for (int bj = 0; bj < 2; ++bj) {
        u32x4 gq[4], yq[4];
        g3_pre_b(p, m0 + ai * 128, n0 + bj * 128, gq, yq);
        __syncthreads();
        accq_to_lds(acc[ai][bj], sC);
        __syncthreads();
        g3_epi_b(p, sC, m0 + ai * 128, n0 + bj * 128, gq, yq);
      }
    __syncthreads();
  }
}

DI void g4_pre(const Params& p, const int m0, const int n0, float4 (&xq)[8]) {
  const int txo = opaque_tid();
#pragma unroll
  for (int i = 0; i < 4; ++i) {
    const int c = txo + 512 * i, row = c >> 4, cc = (c & 15) * 8;
    const size_t go = (size_t)(m0 + row) * 1024 + n0 + cc;
    xq[2 * i] = *(const float4*)(p.x + go); xq[2 * i + 1] = *(const float4*)(p.x + go + 4);
  }
}
DI void g4_epi(const Params& p, const float* sC, const float* gt, const int m0, const int n0, const float4 (&xq)[8]) {
  const int txo = opaque_tid();
#pragma unroll
  for (int i = 0; i < 4; ++i) {
    const int c = txo + 512 * i, row = c >> 4, cc = (c & 15) * 8;
    const size_t go = (size_t)(m0 + row) * 1024 + n0 + cc;
    const float4 x0 = xq[2 * i], x1 = xq[2 * i + 1];
    const float4 a = *(const float4*)(sC + row * CSTR + cc), b = *(const float4*)(sC + row * CSTR + cc + 4);
    const float4 g0 = *(const float4*)(gt + cc), g1 = *(const float4*)(gt + cc + 4);
    float4 o0, o1;
    o0.x = x0.x + g0.x * a.x; o0.y = x0.y + g0.y * a.y; o0.z = x0.z + g0.z * a.z; o0.w = x0.w + g0.w * a.w;
    o1.x = x1.x + g1.x * b.x; o1.y = x1.y + g1.y * b.y; o1.z = x1.z + g1.z * b.z; o1.w = x1.w + g1.w * b.w;
    *(float4*)(p.out + go) = o0;
    *(float4*)(p.out + go + 4) = o1;
  }
}
DI void phase_g4(const Params& p, char* smem) {
  bf16_t* shm = (bf16_t*)smem;
  float* sC = (float*)smem;
  float* rs = (float*)(smem + RS_OFF);
  const int xq = blockIdx.x & 7, lb = blockIdx.x >> 3, nlb = gridDim.x >> 3;
  const bool xmap = (gridDim.x & 7) == 0;
  for (int t = xmap ? lb : (int)blockIdx.x; t < (xmap ? 32 : 256); t += (xmap ? nlb : (int)gridDim.x)) {
    const int rt = xmap ? (8 * xq + (t & 7)) : (t >> 2), ct = xmap ? (t >> 3) : (t & 3);
    const int m0 = rt * 256, n0 = ct * 256;
    f32x4 acc[2][2][4][2];
    zero_acc8(acc);
    if (threadIdx.x < 256) rs[threadIdx.x] = mod_get(p.MOD(), m0 >> 12, 2048 + n0 + threadIdx.x);
    gemm8_tile(p.MERGED() + (size_t)m0 * 1024, p.WoT() + (size_t)n0 * 1024, 1024, shm, acc);
#pragma unroll
    for (int ai = 0; ai < 2; ++ai)
#pragma unroll
      for (int bj = 0; bj < 2; ++bj) {
        float4 xq[8];
        g4_pre(p, m0 + ai * 128, n0 + bj * 128, xq);
        __syncthreads();
        accq_to_lds(acc[ai][bj], sC);
        __syncthreads();
        g4_epi(p, sC, rs + bj * 128, m0 + ai * 128, n0 + bj * 128, xq);
      }
    __syncthreads();
  }
}

DI void phase_final(const Params& p) {
  const int lane = threadIdx.x & 63, w = threadIdx.x >> 6;
  const int gw = blockIdx.x * 8 + w, nw = gridDim.x * 8;
  for (int row = gw; row < NTOK; row += nw) {
    float* xr = p.out + (size_t)row * DM;
    float4 v[4];
    float ss = 0.f;
#pragma unroll
    for (int i = 0; i < 4; ++i) {
      v[i] = *(const float4*)(xr + 4 * (lane + 64 * i));
      ss += v[i].x * v[i].x + v[i].y * v[i].y + v[i].z * v[i].z + v[i].w * v[i].w;
    }
#pragma unroll
    for (int o = 32; o >= 1; o >>= 1) ss += __shfl_xor(ss, o);
    const float rn = __builtin_amdgcn_rsqf(ss * (1.f / DM) + EPSN);
#pragma unroll
    for (int i = 0; i < 4; ++i) {
      const int e = 4 * (lane + 64 * i);
      const float4 g = *(const float4*)(p.fgain + e);
      float4 o;
      o.x = v[i].x * rn * g.x; o.y = v[i].y * rn * g.y; o.z = v[i].z * rn * g.z; o.w = v[i].w * rn * g.w;
      *(float4*)(xr + e) = o;
    }
  }
}

template <int PH>
__global__ void __launch_bounds__(NTHREADS, 2) mega_kernel(Params p) {
  __shared__ __attribute__((aligned(16))) char smem[SMEM_BYTES];
  if (PH < 0) {
    if (p.ws == nullptr) cg::this_grid().sync();
    volatile LAS unsigned* xst = (volatile LAS unsigned*)(smem + SMEM_BYTES - 32);
    if (threadIdx.x == 0) { xst[0] = 0u; xst[1] = 0u; }
    __syncthreads();
    (void)xcd_barrier_post(p.bar(), xst);
    phase_prep(p, smem); xcd_barrier(p.bar(), (volatile LAS unsigned*)(smem + SMEM_BYTES - 32));
#if PROBE_DUP == 4
    phase_prep(p, smem); xcd_barrier(p.bar(), (volatile LAS unsigned*)(smem + SMEM_BYTES - 32));
#endif
    phase_h(p, smem); xcd_barrier(p.bar(), (volatile LAS unsigned*)(smem + SMEM_BYTES - 32));
#if PROBE_DUP == 5
    phase_h(p, smem); xcd_barrier(p.bar(), (volatile LAS unsigned*)(smem + SMEM_BYTES - 32));
#endif
    phase_g1(p, smem); xcd_barrier(p.bar(), (volatile LAS unsigned*)(smem + SMEM_BYTES - 32));
#if PROBE_DUP == 1
    phase_g1(p, smem, false); xcd_barrier(p.bar(), (volatile LAS unsigned*)(smem + SMEM_BYTES - 32));
#endif
    phase_g2(p, smem); xcd_barrier(p.bar(), (volatile LAS unsigned*)(smem + SMEM_BYTES - 32));
#if PROBE_DUP == 8
    phase_g2(p, smem); xcd_barrier(p.bar(), (volatile LAS unsigned*)(smem + SMEM_BYTES - 32));
#endif
    phase_attn(p, smem, 0, 0); xcd_barrier(p.bar(), (volatile LAS unsigned*)(smem + SMEM_BYTES - 32));
#if PROBE_DUP == 2
    phase_attn(p, smem, 8, 1); xcd_barrier(p.bar(), (volatile LAS unsigned*)(smem + SMEM_BYTES - 32));
#endif
#if PROBE_DUP == 3
    phase_attn(p, smem, 8, 2); xcd_barrier(p.bar(), (volatile LAS unsigned*)(smem + SMEM_BYTES - 32));
#endif
    phase_g3(p, smem); xcd_barrier(p.bar(), (volatile LAS unsigned*)(smem + SMEM_BYTES - 32));
#if PROBE_DUP == 6
    phase_g3(p, smem); xcd_barrier(p.bar(), (volatile LAS unsigned*)(smem + SMEM_BYTES - 32));
#endif
    phase_g4(p, smem); xcd_barrier(p.bar(), (volatile LAS unsigned*)(smem + SMEM_BYTES - 32));
#if PROBE_DUP == 7
    phase_g4(p, smem); xcd_barrier(p.bar(), (volatile LAS unsigned*)(smem + SMEM_BYTES - 32));
#endif
    phase_final(p);
  } else {
    if (PH == 0) phase_prep(p, smem);
    if (PH == 1) phase_h(p, smem);
    if (PH == 2) phase_g1(p, smem);
    if (PH == 3) phase_g2(p, smem);
    if (PH == 4) phase_attn(p, smem, 0, 0);
    if (PH == 5) phase_g3(p, smem);
    if (PH == 6) phase_g4(p, smem);
    if (PH == 7) phase_final(p);
  }
}

#ifndef PROBE_DUP
#define PROBE_DUP 0
#endif
#ifndef MK_SPLIT
#define MK_SPLIT 0
#endif

extern "C" void kernel_launch(void* const* d_in, const int* in_sizes, int n_in, void* d_out, int out_size, void* d_ws, size_t ws_size, hipStream_t stream) {
  Params p{};
  p.x = (const float*)d_in[0]; p.c = (const float*)d_in[1]; p.pos = (const int*)d_in[2];
  p.w_ada = (const float*)d_in[3]; p.b_ada = (const float*)d_in[4]; p.norm_gain = (const float*)d_in[5];
  p.w_in = (const float*)d_in[6]; p.q_gain = (const float*)d_in[7]; p.w_uq = (const float*)d_in[8];
  p.kv_gain = (const float*)d_in[9]; p.w_ukv = (const float*)d_in[10]; p.w_a = (const float*)d_in[11];
  p.w_b = (const float*)d_in[12]; p.w_out = (const float*)d_in[13]; p.fgain = (const float*)d_in[14];
  p.out = (float*)d_out;
  p.ws = (char*)d_ws;
  if (WS_NEED > ws_size) { fprintf(stderr, "workspace too small: need %zu have %zu\n", (size_t)WS_NEED, ws_size); return; }

  static int grid_blocks = 0;
  if (!grid_blocks) {
    int dev = 0, cus = 0, per_cu = 0;
    hipGetDevice(&dev);
    hipDeviceGetAttribute(&cus, hipDeviceAttributeMultiprocessorCount, dev);
    hipOccupancyMaxActiveBlocksPerMultiprocessor(&per_cu, mega_kernel<-1>, NTHREADS, 0);
    per_cu = 1;
    grid_blocks = cus * per_cu;
  }
#if MK_SPLIT
  mega_kernel<0><<<grid_blocks, NTHREADS, 0, stream>>>(p);
  mega_kernel<1><<<grid_blocks, NTHREADS, 0, stream>>>(p);
  mega_kernel<2><<<grid_blocks, NTHREADS, 0, stream>>>(p);
  mega_kernel<3><<<grid_blocks, NTHREADS, 0, stream>>>(p);
  mega_kernel<4><<<grid_blocks, NTHREADS, 0, stream>>>(p);
  mega_kernel<5><<<grid_blocks, NTHREADS, 0, stream>>>(p);
  mega_kernel<6><<<grid_blocks, NTHREADS, 0, stream>>>(p);
  mega_kernel<7><<<grid_blocks, NTHREADS, 0, stream>>>(p);
#else
  hipMemsetAsync((char*)d_ws + OFF_bar, 0, XCD_BAR_WORDS * 4, stream);
  void* args[] = {&p};
  hipError_t e = hipLaunchCooperativeKernel((void*)mega_kernel<-1>, dim3(grid_blocks), dim3(NTHREADS), args, 0, stream);
  if (e != hipSuccess) fprintf(stderr, "cooperative launch failed: %s (grid %d)\n", hipGetErrorString(e), grid_blocks);
#endif
}
```

```cpp
#include <hip/hip_runtime.h>
#include <hip/hip_cooperative_groups.h>
#include <stdint.h>
#include <stdio.h>
namespace cg = cooperative_groups;
#ifndef PROBE_DUP
#define PROBE_DUP 0
#endif

#define DI __device__ __forceinline__
typedef unsigned short bf16_t;
typedef __attribute__((ext_vector_type(8))) short bf16x8;
typedef __attribute__((ext_vector_type(4))) short s16x4;
typedef __attribute__((ext_vector_type(16))) float f32x16;
typedef __attribute__((ext_vector_type(2))) float f32x2;
typedef __attribute__((ext_vector_type(2))) __bf16 bf16x2v;
typedef __attribute__((ext_vector_type(4))) unsigned u32x4;
typedef __attribute__((ext_vector_type(2))) unsigned u32x2;
typedef __attribute__((ext_vector_type(4))) float f32x4;
#define MFMA(a, b, c) __builtin_amdgcn_mfma_f32_32x32x16_bf16((a), (b), (c), 0, 0, 0)

constexpr int NTOK = 16384, SEQL = 4096, DM = 1024;
constexpr int INW = 5280, INWP = 5376;
constexpr int NTHREADS = 512;
constexpr float LOG2E = 1.4426950408889634f;
constexpr float QS_SCALE = 0.125f * 1.4426950408889634f;
constexpr float QM_SCALE = 1.4426950408889634f / 9.797958971132712f;
constexpr float EPSN = 1e-6f;

constexpr int XCD_BAR_WORDS_C = 3456;
constexpr size_t al256(size_t v) { return (v + 255) & ~(size_t)255; }
constexpr size_t OFF_counter = 0;
constexpr size_t OFF_bar = OFF_counter + al256(256);
constexpr size_t OFF_MOD = OFF_bar + al256(XCD_BAR_WORDS_C * 4);
constexpr size_t OFF_ROPE = OFF_MOD + al256(4 * 3072 * 4 * 4);
constexpr size_t OFF_SSQ = OFF_ROPE + al256((size_t)NTOK * 32 * 4);
constexpr size_t OFF_Hb = OFF_SSQ + al256((size_t)2 * NTOK * 4);
constexpr size_t OFF_Qmla = OFF_Hb + al256((size_t)NTOK * 1024 * 2);
constexpr size_t OFF_WuqT = OFF_Qmla + al256((size_t)NTOK * 768 * 2);
constexpr size_t OFF_WukvT = OFF_WuqT + al256((size_t)768 * 384 * 2);
constexpr size_t OFF_WaT = OFF_WukvT + al256((size_t)1024 * 256 * 2);
constexpr size_t OFF_WbT = OFF_WaT + al256((size_t)1024 * 512 * 2);
constexpr size_t OFF_WoT = OFF_WbT + al256((size_t)1024 * 512 * 2);
constexpr size_t OFF_Qsb = OFF_WoT + al256((size_t)1024 * 1024 * 2);
constexpr size_t OFF_Ksb = OFF_Qsb + al256((size_t)NTOK * 512 * 2);
constexpr size_t OFF_VTsb = OFF_Ksb + al256((size_t)NTOK * 512 * 2);
constexpr size_t OFF_Zsb = OFF_VTsb + al256((size_t)NTOK * 512 * 2);
constexpr size_t OFF_OAg = OFF_Zsb + al256((size_t)NTOK * 512 * 2);
constexpr size_t OFF_OBg = OFF_OAg + al256((size_t)NTOK * 512 * 2);
constexpr size_t OFF_Zmla = OFF_OBg + al256((size_t)NTOK * 512 * 2);
constexpr size_t OFF_KPE = OFF_Zmla + al256((size_t)NTOK * 512 * 2);
constexpr size_t OFF_Knope = OFF_KPE + al256((size_t)NTOK * 32 * 2);
constexpr size_t OFF_VTmla = OFF_Knope + al256((size_t)NTOK * 512 * 2);
constexpr size_t OFF_WinT = OFF_VTmla + al256((size_t)NTOK * 512 * 2);
constexpr size_t WS_NEED = OFF_WinT + al256((size_t)INWP * 1024 * 2);
struct Params {
  const float *x, *c; const int* pos;
  const float *w_ada, *b_ada, *norm_gain, *w_in, *q_gain, *w_uq, *kv_gain, *w_ukv, *w_a, *w_b, *w_out, *fgain;
  float* out;
  char* ws;
  DI int* counter() const { return (int*)(ws + OFF_counter); }
  DI unsigned* bar() const { return (unsigned*)(ws + OFF_bar); }
  DI float* MOD() const { return (float*)(ws + OFF_MOD); }
  DI float* ROPE() const { return (float*)(ws + OFF_ROPE); }
  DI float* SSQ() const { return (float*)(ws + OFF_SSQ); }
  DI bf16_t* Hb() const { return (bf16_t*)(ws + OFF_Hb); }
  DI bf16_t* Qmla() const { return (bf16_t*)(ws + OFF_Qmla); }
  DI bf16_t* WuqT() const { return (bf16_t*)(ws + OFF_WuqT); }
  DI bf16_t* WukvT() const { return (bf16_t*)(ws + OFF_WukvT); }
  DI bf16_t* WaT() const { return (bf16_t*)(ws + OFF_WaT); }
  DI bf16_t* WbT() const { return (bf16_t*)(ws + OFF_WbT); }
  DI bf16_t* WoT() const { return (bf16_t*)(ws + OFF_WoT); }
  DI bf16_t* Qsb() const { return (bf16_t*)(ws + OFF_Qsb); }
  DI bf16_t* Ksb() const { return (bf16_t*)(ws + OFF_Ksb); }
  DI bf16_t* VTsb() const { return (bf16_t*)(ws + OFF_VTsb); }
  DI bf16_t* Zsb() const { return (bf16_t*)(ws + OFF_Zsb); }
  DI bf16_t* OAg() const { return (bf16_t*)(ws + OFF_OAg); }
  DI bf16_t* OBg() const { return (bf16_t*)(ws + OFF_OBg); }
  DI bf16_t* Zmla() const { return (bf16_t*)(ws + OFF_Zmla); }
  DI bf16_t* KPE() const { return (bf16_t*)(ws + OFF_KPE); }
  DI bf16_t* Knope() const { return (bf16_t*)(ws + OFF_Knope); }
  DI bf16_t* VTmla() const { return (bf16_t*)(ws + OFF_VTmla); }
  DI bf16_t* MERGED() const { return Hb(); }
  DI bf16_t* WinT() const { return (bf16_t*)(ws + OFF_WinT); }
  DI bf16_t* CQ() const { return OAg(); }
  DI bf16_t* CKV() const { return OBg(); }
  DI bf16_t* GA() const { return (bf16_t*)out; }
  DI bf16_t* GB() const { return (bf16_t*)out + (size_t)NTOK * 1024; }
};


__device__ const float c_invfreq[16] = {
  1.0f, 0.5623413251903491f, 0.31622776601683794f, 0.1778279410038923f, 0.1f, 0.05623413251903491f, 0.03162277660168379f,
  0.01778279410038923f, 0.01f, 0.005623413251903491f, 0.0031622776601683794f, 0.001778279410038923f, 0.001f,
  0.0005623413251903491f, 0.00031622776601683794f, 0.0001778279410038923f};

DI unsigned pk2(float a, float b) { f32x2 v = {a, b}; bf16x2v r = __builtin_convertvector(v, bf16x2v); return __builtin_bit_cast(unsigned, r); }
DI bf16_t tobf(float a) { return (bf16_t)(pk2(a, 0.f) & 0xffffu); }
DI float bf2f(unsigned short u) { return __uint_as_float(((unsigned)u) << 16); }
DI bf16x8 pack8(float a0, float a1, float a2, float a3, float a4, float a5, float a6, float a7) {
  u32x4 p; p[0] = pk2(a0, a1); p[1] = pk2(a2, a3); p[2] = pk2(a4, a5); p[3] = pk2(a6, a7);
  return __builtin_bit_cast(bf16x8, p);
}
DI int crow(int reg, int h) { return (reg & 3) + 8 * (reg >> 2) + 4 * h; }
DI int opaque_tid() { int t = threadIdx.x; asm volatile("" : "+v"(t)); return t; }
DI float half_max(float v) {
  unsigned u = __float_as_uint(v);
  auto r = __builtin_amdgcn_permlane32_swap(u, u, false, false);
  return fmaxf(__uint_as_float(r[0]), __uint_as_float(r[1]));
}
DI float half_sum(float v) {
  unsigned u = __float_as_uint(v);
  auto r = __builtin_amdgcn_permlane32_swap(u, u, false, false);
  return __uint_as_float(r[0]) + __uint_as_float(r[1]);
}
DI float sigmoidf_fast(float v) { return __builtin_amdgcn_rcpf(1.f + __builtin_amdgcn_exp2f(-v * LOG2E)); }
DI float siluf_fast(float v) { return v * sigmoidf_fast(v); }

#define XB_TMO      128
#define XB_XCNT(j)  (256  + 64 * (j))
#define XB_XSUB(j)  (1280 + 64 * (j))
#define XB_XGEN(j)  (2304 + 64 * (j))
#define XB_TOP      3328
#define XB_TOPGEN   3392
#define XCD_BAR_WORDS 3456
#define XB_SPIN_CAP (1u << 18)
#define LAS __attribute__((address_space(3)))
DI unsigned xb_ld(unsigned* p)              { return __hip_atomic_load(p, __ATOMIC_RELAXED, __HIP_MEMORY_SCOPE_AGENT); }
DI unsigned xb_add(unsigned* p, unsigned v) { return __hip_atomic_fetch_add(p, v, __ATOMIC_RELAXED, __HIP_MEMORY_SCOPE_AGENT); }
DI unsigned xb_xcc_id() { return (unsigned)__builtin_amdgcn_s_getreg((3 << 11) | 20) & 0xFu; }
#define XB_SPIN(cond, bar) do { unsigned _sp = 0; while (cond) { __builtin_amdgcn_s_sleep(1); \
    if ((++_sp & 255u) == 0u) { if (xb_ld(&(bar)[XB_TMO])) break; if (_sp > XB_SPIN_CAP) { atomicAdd(&(bar)[XB_TMO], 1u); break; } } } } while (0)
struct XcdBarrier { unsigned* bar; unsigned x; volatile LAS unsigned* st; };
DI XcdBarrier xcd_barrier_post(unsigned* bar, volatile LAS unsigned* st) {
  XcdBarrier b; b.bar = bar; b.x = xb_xcc_id(); b.st = st;
  if (threadIdx.x == 0) (void)xb_add(&bar[XB_XCNT(b.x)], 1u);
  return b;
}
DI void xcd_barrier_complete(unsigned* bar, unsigned x, unsigned& nloc, unsigned& nx) {
  const unsigned G = gridDim.x * gridDim.y * gridDim.z;
  unsigned sum, cnt, mine, sp = 0u;
  for (;;) {
    sum = 0u; cnt = 0u; mine = 0u;
#pragma unroll
    for (unsigned j = 0; j < 16; ++j) { const unsigned c = xb_ld(&bar[XB_XCNT(j)]); sum += c; cnt += (c > 0u) ? 1u : 0u; mine = (j == x) ? c : mine; }
    if (sum == G) break;
    __builtin_amdgcn_s_sleep(1);
    if ((++sp & 255u) == 0u) { if (xb_ld(&bar[XB_TMO])) break; if (sp > XB_SPIN_CAP) { atomicAdd(&bar[XB_TMO], 1u); break; } }
  }
  nloc = mine > 0u ? mine : 1u; nx = cnt > 0u ? cnt : 1u;
}
DI void xcd_barrier(unsigned* bar_, volatile LAS unsigned* st_) {
  XcdBarrier b; b.bar = bar_; b.st = st_; b.x = 0;
  asm volatile("s_waitcnt vmcnt(0)" ::: "memory");
  __syncthreads();
  if (threadIdx.x == 0) {
    unsigned* bar = b.bar;
    b.x = xb_xcc_id();
    __builtin_amdgcn_s_waitcnt(0);
    unsigned nloc = b.st[0], nx = b.st[1];
    if (nloc == 0u) { xcd_barrier_complete(bar, b.x, nloc, nx); b.st[0] = nloc; b.st[1] = nx; }
    const unsigned old = xb_add(&bar[XB_XSUB(b.x)], 1u);
    const unsigned gen = old / nloc;
    if (old + 1u == (gen + 1u) * nloc) {
      __builtin_amdgcn_fence(__ATOMIC_RELEASE, "agent");
      asm volatile("s_waitcnt vmcnt(0)" ::: "memory");
      const unsigned og = xb_add(&bar[XB_TOP], 1u);
      const unsigned tg = og / nx;
      if (og + 1u == (tg + 1u) * nx) xb_add(&bar[XB_TOPGEN], 1u);
      else XB_SPIN(xb_ld(&bar[XB_TOPGEN]) == tg, bar);
      __builtin_amdgcn_fence(__ATOMIC_ACQUIRE, "agent");
      xb_add(&bar[XB_XGEN(b.x)], 1u);
      asm volatile("s_waitcnt vmcnt(0)" ::: "memory");
    } else {
      XB_SPIN(xb_ld(&bar[XB_XGEN(b.x)]) == gen, bar);
      __builtin_amdgcn_fence(__ATOMIC_ACQUIRE, "agent");
      asm volatile("s_waitcnt vmcnt(0)" ::: "memory");
    }
  }
  __syncthreads();
}

constexpr int GSTR = 72;
constexpr int GBUF = 128 * GSTR;
constexpr int RS_OFF = 135168;
constexpr int SMEM_BYTES = RS_OFF + 4096;

constexpr int G8_HT = 128 * 64;
DI int lds_byte(int r, int c) { const int st = (r >> 4) * 2 + (c >> 5), rr = r & 15, cc = c & 31, ob = rr * 64 + cc * 2; return st * 1024 + (ob ^ (((ob >> 9) & 1) << 5)); }
DI void stage_rc(int b, int& R, int& C) { const int st = b / 1024, sb = b % 1024, swz = sb ^ (((sb >> 9) & 1) << 5); R = (st >> 1) * 16 + swz / 64; C = (st & 1) * 32 + (swz % 64) / 2; }

DI void gemm8_tile(const bf16_t* __restrict__ A, const bf16_t* __restrict__ Bt, const int K, bf16_t* shm, f32x4 (&acc)[2][2][4][2]) {
  const int tid = opaque_tid();
  const int wid = tid >> 6, lane = tid & 63, wr = wid >> 2, wc = wid & 3, fr = lane & 15, fq = lane >> 4;
  const int swz = (fr * 64 + fq * 16) ^ ((fr >> 3) << 5);
  const char* aRd = (const char*)shm + swz + wr * 8192;
  const char* bRd = (const char*)shm + 65536 + swz + wc * 4096;
  int sr0, sc0, sr1, sc1;
  stage_rc(tid * 16, sr0, sc0);
  stage_rc(tid * 16 + 8192, sr1, sc1);
  const unsigned so0 = (unsigned)(sr0 * K + sc0) * 2u, so1 = (unsigned)(sr1 * K + sc1) * 2u;
  char* const stw = (char*)shm + __builtin_amdgcn_readfirstlane(tid & ~63) * 16;
  const char* const Ab = (const char*)A;
  const char* const Bb = (const char*)Bt;
#define SA(b, h) (((b) * 2 + (h)) * 16384)
#define SB(b, h) ((4 + (b) * 2 + (h)) * 16384)
#define STAGE(P, BASE, br, kt) do { const char* g_ = (BASE) + ((long)(br) * K + (long)(kt) * 64) * 2;                        \
    __builtin_amdgcn_global_load_lds((const unsigned*)(g_ + so0), (unsigned*)(stw + (P)), 16, 0, 0);                          \
    __builtin_amdgcn_global_load_lds((const unsigned*)(g_ + so1), (unsigned*)(stw + (P) + 8192), 16, 0, 0); } while (0)
#define LDA(dst, b, h) _Pragma("unroll") for (int m = 0; m < 4; ++m) _Pragma("unroll") for (int k = 0; k < 2; ++k) \
    dst[m][k] = *reinterpret_cast<const bf16x8*>(aRd + ((b) * 2 + (h)) * 16384 + (m * 2 + k) * 1024)
#define LDB(dst, b, h) _Pragma("unroll") for (int n = 0; n < 2; ++n) _Pragma("unroll") for (int k = 0; k < 2; ++k) \
    dst[n][k] = *reinterpret_cast<const bf16x8*>(bRd + ((b) * 2 + (h)) * 16384 + (n * 2 + k) * 1024)
#define MMA(ai, bj, At_, Bt_) do { __builtin_amdgcn_s_setprio(1);                                                          \
    _Pragma("unroll") for (int m = 0; m < 4; ++m) _Pragma("unroll") for (int n = 0; n < 2; ++n) _Pragma("unroll") for (int k = 0; k < 2; ++k) \
      acc[ai][bj][m][n] = __builtin_amdgcn_mfma_f32_16x16x32_bf16(At_[m][k], Bt_[n][k], acc[ai][bj][m][n], 0, 0, 0);       \
    __builtin_amdgcn_s_setprio(0); } while (0)
#define WAIT_V(n) asm volatile("s_waitcnt vmcnt(" #n ")" ::: "memory")
#define WAIT_L(n) asm volatile("s_waitcnt lgkmcnt(" #n ")" ::: "memory")
#define BAR __builtin_amdgcn_s_barrier()
#define SCHED __builtin_amdgcn_sched_barrier(0)
  bf16x8 At[4][2], B0[2][2], B1[2][2];
  const int nt = K / 64;
  STAGE(SB(0, 0), Bb, 0, 0); STAGE(SA(0, 0), Ab, 0, 0);
  STAGE(SB(0, 1), Bb, 128, 0); STAGE(SA(0, 1), Ab, 128, 0);
  if (wr == 1) BAR;
  WAIT_V(4); BAR;
  STAGE(SB(1, 0), Bb, 0, 1); STAGE(SA(1, 0), Ab, 0, 1); STAGE(SB(1, 1), Bb, 128, 1);
  WAIT_V(6); BAR;
  for (int t = 0; t < nt - 2; t += 2) {
    LDB(B0, 0, 0); SCHED; LDA(At, 0, 0); STAGE(SA(1, 1), Ab, 128, t + 1);
    WAIT_L(8); BAR; WAIT_L(0); MMA(0, 0, At, B0); BAR; SCHED;
    LDB(B1, 0, 1); STAGE(SB(0, 0), Bb, 0, t + 2);
    BAR; WAIT_L(0); MMA(0, 1, At, B1); BAR;
    LDA(At, 0, 1); STAGE(SA(0, 0), Ab, 0, t + 2);
    BAR; WAIT_L(0); MMA(1, 0, At, B0); BAR; SCHED;
    STAGE(SB(0, 1), Bb, 128, t + 2);
    WAIT_V(6); BAR; MMA(1, 1, At, B1); BAR;
    LDB(B0, 1, 0); SCHED; LDA(At, 1, 0); STAGE(SA(0, 1), Ab, 128, t + 2);
    WAIT_L(8); BAR; WAIT_L(0); MMA(0, 0, At, B0); BAR; SCHED;
    LDB(B1, 1, 1); STAGE(SB(1, 0), Bb, 0, t + 3);
    BAR; WAIT_L(0); MMA(0, 1, At, B1); BAR;
    LDA(At, 1, 1); STAGE(SA(1, 0), Ab, 0, t + 3);
    BAR; WAIT_L(0); MMA(1, 0, At, B0); BAR; SCHED;
    STAGE(SB(1, 1), Bb, 128, t + 3);
    WAIT_V(6); BAR; MMA(1, 1, At, B1); BAR;
  }
  { LDB(B0, 0, 0); LDA(At, 0, 0); STAGE(SA(1, 1), Ab, 128, nt - 1);
    BAR; WAIT_L(0); MMA(0, 0, At, B0); BAR;
    LDB(B1, 0, 1); BAR; WAIT_L(0); MMA(0, 1, At, B1); BAR;
    LDA(At, 0, 1); WAIT_V(4); BAR; WAIT_L(0); MMA(1, 0, At, B0); MMA(1, 1, At, B1); BAR; }
  { LDB(B0, 1, 0); LDA(At, 1, 0); WAIT_V(2); BAR; WAIT_L(0); MMA(0, 0, At, B0); BAR;
    LDB(B1, 1, 1); WAIT_V(0); BAR; WAIT_L(0); MMA(0, 1, At, B1); BAR;
    LDA(At, 1, 1); BAR; WAIT_L(0); MMA(1, 0, At, B0); MMA(1, 1, At, B1); BAR; }
  if (wr == 0) BAR;
#undef SA
#undef SB
#undef STAGE
#undef LDA
#undef LDB
#undef MMA
#undef WAIT_V
#undef WAIT_L
#undef BAR
#undef SCHED
}


DI void zero_acc8(f32x4 (&acc)[2][2][4][2]) {
#pragma unroll
  for (int a = 0; a < 2; ++a)
#pragma unroll
    for (int b = 0; b < 2; ++b)
#pragma unroll
      for (int m = 0; m < 4; ++m)
#pragma unroll
        for (int n = 0; n < 2; ++n) acc[a][b][m][n] = f32x4{0.f, 0.f, 0.f, 0.f};
}

constexpr int CSTR = 132;
DI void accq_to_lds(const f32x4 (&q)[4][2], float* sC) {
  const int tid = opaque_tid(), wid = tid >> 6, lane = tid & 63, wr = wid >> 2, wc = wid & 3, fr = lane & 15, fq = lane >> 4;
#pragma unroll
  for (int m = 0; m < 4; ++m)
#pragma unroll
    for (int n = 0; n < 2; ++n)
#pragma unroll
      for (int j = 0; j < 4; ++j) sC[(wr * 64 + m * 16 + fq * 4 + j) * CSTR + wc * 32 + n * 16 + fr] = q[m][n][j];
}
constexpr int SC2_OFF = 128 * CSTR;
template <class EPI>
DI void tile_epilogue2(const f32x4 (&acc)[2][2][4][2], float* sC, EPI epi) {
  __syncthreads();
  accq_to_lds(acc[0][0], sC);
  __syncthreads();
  accq_to_lds(acc[0][1], sC + SC2_OFF);
  epi(0, sC);
  __syncthreads();
  accq_to_lds(acc[1][0], sC);
  epi(1, sC + SC2_OFF);
  __syncthreads();
  accq_to_lds(acc[1][1], sC + SC2_OFF);
  epi(2, sC);
  __syncthreads();
  epi(3, sC + SC2_OFF);
  __syncthreads();
}

template <class F>
DI void epi_rows(const float* sC, F f) {
  const int tx = opaque_tid();
#pragma unroll
  for (int i = 0; i < 4; ++i) {
    const int c = tx + 512 * i, row = c >> 4, cc = (c & 15) * 8;
    const float4 a = *(const float4*)(sC + row * CSTR + cc), b = *(const float4*)(sC + row * CSTR + cc + 4);
    const float v[8] = {a.x, a.y, a.z, a.w, b.x, b.y, b.z, b.w};
    f(i, row, cc, v);
  }
}
DI void store8(bf16_t* p, const float (&v)[8]) { *(bf16x8*)p = pack8(v[0], v[1], v[2], v[3], v[4], v[5], v[6], v[7]); }
DI void epi_vt(const float* sC, bf16_t* VT, int m0, int head0, int c0, int ncol_log2) {
  const int b = m0 >> 12, s0 = m0 & 4095;
  const int nitems = 16 << ncol_log2;
  for (int c = opaque_tid(); c < nitems; c += 512) {
    const int col = c & ((1 << ncol_log2) - 1), rc = c >> ncol_log2;
    float v[8];
#pragma unroll
    for (int j = 0; j < 8; ++j) v[j] = sC[(rc * 8 + j) * CSTR + c0 + col];
    const int head = head0 + (col >> 6), d = col & 63;
    store8(VT + ((size_t)((b * 8 + head) * 64 + d)) * SEQL + s0 + rc * 8, v);
  }
}
DI void rope8(const float* sC, const float* ROPE, int tok, int row, int cc, float (&v)[8]) {
  const float* pr = sC + row * CSTR + (cc ^ 16);
  const bool upper = (cc & 16) != 0;
  const int f0 = cc & 15;
  const float* tb = ROPE + (size_t)tok * 32;
#pragma unroll
  for (int j = 0; j < 8; ++j) {
    const float o = pr[j], cs = tb[f0 + j], sn = tb[16 + f0 + j];
    v[j] = upper ? (o * sn + v[j] * cs) : (v[j] * cs - o * sn);
  }
}

DI void wconv_unit(const float* __restrict__ src, int Nsrc, int K, bf16_t* __restrict__ dst, const float* __restrict__ gain, int ng, int kg, int mode, float* tile, const int tid) {
  {
    const int k = tid >> 2, cq = tid & 3;
    const int n = ng * 64 + cq * 16;
    int sc = n;
    if (mode == 1) { sc = (n < 2688) ? n : (n < 5248 ? n + 32 : (n < 5280 ? n - 2560 : -1)); }
    const int kk = kg * 64 + k;
    float4 v[4];
    if (sc >= 0) {
      const float* sp = src + (size_t)kk * Nsrc + sc;
#pragma unroll
      for (int i = 0; i < 4; ++i) v[i] = *(const float4*)(sp + 4 * i);
      if (gain) { const float g = gain[kk];
#pragma unroll
        for (int i = 0; i < 4; ++i) { v[i].x *= g; v[i].y *= g; v[i].z *= g; v[i].w *= g; } }
    } else {
#pragma unroll
      for (int i = 0; i < 4; ++i) v[i] = make_float4(0.f, 0.f, 0.f, 0.f);
    }
    float* tp = tile + k * 65 + cq * 16;
#pragma unroll
    for (int i = 0; i < 4; ++i) { tp[4 * i] = v[i].x; tp[4 * i + 1] = v[i].y; tp[4 * i + 2] = v[i].z; tp[4 * i + 3] = v[i].w; }
  }
  __syncthreads();
  {
    const int n = tid >> 2, kc = tid & 3;
    float o[16];
#pragma unroll
    for (int j = 0; j < 16; ++j) o[j] = tile[(kc * 16 + j) * 65 + n];
    bf16_t* dp = dst + (size_t)(ng * 64 + n) * K + kg * 64 + kc * 16;
    *(bf16x8*)dp = pack8(o[0], o[1], o[2], o[3], o[4], o[5], o[6], o[7]);
    *(bf16x8*)(dp + 8) = pack8(o[8], o[9], o[10], o[11], o[12], o[13], o[14], o[15]);
  }
  __syncthreads();
}

DI void phase_prep(const Params& p, char* smem) {
  if (blockIdx.x == 0 && threadIdx.x < 16) { p.counter()[threadIdx.x] = 0; }
  for (int i = blockIdx.x * NTHREADS + threadIdx.x; i < 2 * NTOK; i += gridDim.x * NTHREADS) p.SSQ()[i] = 0.f;
  const int half = threadIdx.x >> 8, tid = threadIdx.x & 255;
  constexpr int U_MOD = 96 * 4, U_WIN = 84 * 16, U_WUQ = 12 * 6, U_WUKV = 16 * 4, U_WA = 16 * 8, U_WB = 16 * 8, U_WO = 16 * 16, U_ROPE = 1024;
  constexpr int U_TOTAL = U_MOD + U_ROPE + U_WIN + U_WUQ + U_WUKV + U_WA + U_WB + U_WO;
  float* tile = (float*)smem + half * (64 * 65 + 64);
  for (int up = blockIdx.x; up < U_TOTAL / 2; up += gridDim.x) {
    int v = 2 * up + half;
    if (v < U_MOD) {
      const int cg32 = v >> 2, kq = v & 3, n0 = cg32 * 32;
      const int kgp = tid >> 5, col = tid & 31;
      const int kb = kq * 256 + kgp * 32;
      float a0 = 0.f, a1 = 0.f, a2 = 0.f, a3 = 0.f;
      const float* wp = p.w_ada + (size_t)kb * 3072 + n0 + col;
      float wv[32];
#pragma unroll
      for (int kk = 0; kk < 32; ++kk) wv[kk] = wp[(size_t)kk * 3072];
#pragma unroll
      for (int kk = 0; kk < 32; ++kk) {
        a0 += wv[kk] * p.c[kb + kk]; a1 += wv[kk] * p.c[1024 + kb + kk]; a2 += wv[kk] * p.c[2048 + kb + kk]; a3 += wv[kk] * p.c[3072 + kb + kk];
      }
      float* red = (float*)smem + half * 1024;
      red[(kgp * 4 + 0) * 32 + col] = a0; red[(kgp * 4 + 1) * 32 + col] = a1; red[(kgp * 4 + 2) * 32 + col] = a2; red[(kgp * 4 + 3) * 32 + col] = a3;
      __syncthreads();
      if (tid < 128) {
        const int b = tid >> 5, cc = tid & 31;
        float s = (kq == 0) ? p.b_ada[n0 + cc] : 0.f;
#pragma unroll
        for (int g = 0; g < 8; ++g) s += red[(g * 4 + b) * 32 + cc];
        p.MOD()[(size_t)(b * 3072 + n0 + cc) * 4 + kq] = s;
      }
      __syncthreads();
      continue;
    }
    v -= U_MOD;
    if (v < U_WIN) { wconv_unit(p.w_in, INW, 1024, p.WinT(), nullptr, v >> 4, v & 15, 1, tile, tid); continue; }
    v -= U_WIN;
    if (v < U_WUQ) { wconv_unit(p.w_uq, 768, 384, p.WuqT(), p.q_gain, v / 6, v % 6, 0, tile, tid); continue; }
    v -= U_WUQ;
    if (v < U_WUKV) { wconv_unit(p.w_ukv, 1024, 256, p.WukvT(), p.kv_gain, v >> 2, v & 3, 0, tile, tid); continue; }
    v -= U_WUKV;
    if (v < U_WA) { wconv_unit(p.w_a, 1024, 512, p.WaT(), nullptr, v >> 3, v & 7, 0, tile, tid); continue; }
    v -= U_WA;
    if (v < U_WB) { wconv_unit(p.w_b, 1024, 512, p.WbT(), nullptr, v >> 3, v & 7, 0, tile, tid); continue; }
    v -= U_WB;
    if (v < U_WO) { wconv_unit(p.w_out, 1024, 1024, p.WoT(), nullptr, v >> 4, v & 15, 0, tile, tid); continue; }
    v -= U_WO;
    {
      const int idx = v * 256 + tid, tok = idx >> 4, i = idx & 15;
      const float ang = (float)p.pos[tok] * c_invfreq[i];
      double t = (double)ang * 0.15915494309189535;
      t -= rint(t);
      const float tf = (float)t;
      p.ROPE()[(size_t)tok * 32 + i] = __builtin_amdgcn_cosf(tf);
      p.ROPE()[(size_t)tok * 32 + 16 + i] = __builtin_amdgcn_sinf(tf);
    }
  }
}

DI float mod_get(const float* MOD, int b, int n) { const float4 q = *(const float4*)(MOD + (size_t)(b * 3072 + n) * 4); return (q.x + q.y) + (q.z + q.w); }

DI void phase_h(const Params& p, char* smem) {
  const int tid = opaque_tid(), lane = tid & 63, w = tid >> 6;
  float* gs = (float*)smem;
  float* sh = gs + 1024;
  const int xq = blockIdx.x & 7, lb = blockIdx.x >> 3, nlb = gridDim.x >> 3;
  const bool xmap = (gridDim.x & 7) == 0;
  for (int rgi = xmap ? lb : (int)blockIdx.x; rgi < (xmap ? 32 : NTOK / 64); rgi += (xmap ? nlb : (int)gridDim.x)) {
    const int rg = xmap ? (32 * xq + rgi) : rgi;
    const int b = (rg * 64) >> 12;
    __syncthreads();
#pragma unroll
    for (int i = 0; i < 2; ++i) {
      const int k = tid + 512 * i;
      gs[k] = p.norm_gain[k] * (1.f + mod_get(p.MOD(), b, 1024 + k));
      sh[k] = mod_get(p.MOD(), b, k);
    }
    __syncthreads();
#pragma unroll 2
    for (int rr = 0; rr < 8; ++rr) {
      const int row = rg * 64 + w * 8 + rr;
      const float* xr = p.x + (size_t)row * DM;
      float4 v[4];
      float ss = 0.f;
#pragma unroll
      for (int i = 0; i < 2; ++i) {
        const int e = 8 * (lane + 64 * i);
        v[2 * i] = *(const float4*)(xr + e);
        v[2 * i + 1] = *(const float4*)(xr + e + 4);
        ss += v[2 * i].x * v[2 * i].x + v[2 * i].y * v[2 * i].y + v[2 * i].z * v[2 * i].z + v[2 * i].w * v[2 * i].w;
        ss += v[2 * i + 1].x * v[2 * i + 1].x + v[2 * i + 1].y * v[2 * i + 1].y + v[2 * i + 1].z * v[2 * i + 1].z + v[2 * i + 1].w * v[2 * i + 1].w;
      }
#pragma unroll
      for (int o = 32; o >= 1; o >>= 1) ss += __shfl_xor(ss, o);
      const float rn = __builtin_amdgcn_rsqf(ss * (1.f / DM) + EPSN);
#pragma unroll
      for (int i = 0; i < 2; ++i) {
        const int e = 8 * (lane + 64 * i);
        const float4 g0 = *(const float4*)(gs + e), g1 = *(const float4*)(gs + e + 4);
        const float4 s0 = *(const float4*)(sh + e), s1 = *(const float4*)(sh + e + 4);
        *(bf16x8*)(p.Hb() + (size_t)row * DM + e) =
            pack8(v[2 * i].x * rn * g0.x + s0.x, v[2 * i].y * rn * g0.y + s0.y, v[2 * i].z * rn * g0.z + s0.z, v[2 * i].w * rn * g0.w + s0.w,
                  v[2 * i + 1].x * rn * g1.x + s1.x, v[2 * i + 1].y * rn * g1.y + s1.y, v[2 * i + 1].z * rn * g1.z + s1.z, v[2 * i + 1].w * rn * g1.w + s1.w);
      }
    }
  }
  __syncthreads();
}

DI void g1_epi(const Params& p, const float* sC, const int m0, const int n0, const int ct, const bool do_ssq) {
    if (ct < 4) {
      epi_rows(sC, [&](int, int row, int cc, const float (&v)[8]) {
        float o[8];
#pragma unroll
        for (int j = 0; j < 8; ++j) o[j] = v[j] * QS_SCALE;
        store8(p.Qsb() + (size_t)(m0 + row) * 512 + n0 + cc, o); });
    } else if (ct < 8) {
      epi_rows(sC, [&](int, int row, int cc, const float (&v)[8]) { store8(p.Ksb() + (size_t)(m0 + row) * 512 + n0 - 512 + cc, v); });
    } else if (ct < 12) {
      epi_vt(sC, p.VTsb(), m0, (n0 - 1024) >> 6, 0, 7);
    } else if (ct < 16) {
      epi_rows(sC, [&](int, int row, int cc, const float (&v)[8]) {
        float o[8];
#pragma unroll
        for (int j = 0; j < 8; ++j) o[j] = siluf_fast(v[j]);
        store8(p.Zsb() + (size_t)(m0 + row) * 512 + n0 - 1536 + cc, o); });
    } else if (ct < 19) {
      epi_rows(sC, [&](int, int row, int cc, const float (&v)[8]) {
        store8(p.CQ() + (size_t)(m0 + row) * 384 + n0 - 2048 + cc, v);
        float q = 0.f;
#pragma unroll
        for (int j = 0; j < 8; ++j) q += v[j] * v[j];
        q += __shfl_xor(q, 1); q += __shfl_xor(q, 2); q += __shfl_xor(q, 4); q += __shfl_xor(q, 8);
        if (do_ssq && (threadIdx.x & 15) == 0) atomicAdd(p.SSQ() + m0 + row, q); });
    } else if (ct < 21) {
      epi_rows(sC, [&](int, int row, int cc, const float (&v)[8]) {
        store8(p.CKV() + (size_t)(m0 + row) * 256 + n0 - 2432 + cc, v);
        float q = 0.f;
#pragma unroll
        for (int j = 0; j < 8; ++j) q += v[j] * v[j];
        q += __shfl_xor(q, 1); q += __shfl_xor(q, 2); q += __shfl_xor(q, 4); q += __shfl_xor(q, 8);
        if (do_ssq && (threadIdx.x & 15) == 0) atomicAdd(p.SSQ() + NTOK + m0 + row, q); });
    } else if (ct < 25) {
      epi_rows(sC, [&](int, int row, int cc, const float (&v)[8]) {
        float o[8];
#pragma unroll
        for (int j = 0; j < 8; ++j) o[j] = siluf_fast(v[j]);
        store8(p.Zmla() + (size_t)(m0 + row) * 512 + n0 - 2688 + cc, o); });
    } else if (ct < 33) {
      epi_rows(sC, [&](int, int row, int cc, const float (&v)[8]) {
        float o[8];
#pragma unroll
        for (int j = 0; j < 8; ++j) o[j] = sigmoidf_fast(v[j]);
        store8(p.GA() + (size_t)(m0 + row) * 1024 + n0 - 3200 + cc, o); });
    } else if (ct < 41) {
      epi_rows(sC, [&](int, int row, int cc, const float (&v)[8]) {
        float o[8];
#pragma unroll
        for (int j = 0; j < 8; ++j) o[j] = sigmoidf_fast(v[j]);
        store8(p.GB() + (size_t)(m0 + row) * 1024 + n0 - 4224 + cc, o); });
    } else {
      epi_rows(sC, [&](int, int row, int cc, const float (&v)[8]) {
        if (cc < 32) {
          float o[8];
#pragma unroll
          for (int j = 0; j < 8; ++j) o[j] = v[j];
          rope8(sC, p.ROPE(), m0 + row, row, cc, o);
          store8(p.KPE() + (size_t)(m0 + row) * 32 + cc, o);
        } });
    }
}

DI void g1_tile(const Params& p, char* smem, const int rt, const int ct2, const bool do_ssq) {
  bf16_t* shm = (bf16_t*)smem;
  float* sC = (float*)smem;
  const int m0 = rt * 256, n0 = ct2 * 256;
  f32x4 acc[2][2][4][2];
  zero_acc8(acc);
  gemm8_tile(p.Hb() + (size_t)m0 * DM, p.WinT() + (size_t)n0 * DM, DM, shm, acc);
  tile_epilogue2(acc, sC, [&](const int qd, const float* sq) {
    g1_epi(p, sq, m0 + (qd >> 1) * 128, n0 + (qd & 1) * 128, ct2 * 2 + (qd & 1), do_ssq); });
}

constexpr int G1_NCT = 20;
DI void phase_g1(const Params& p, char* smem, bool do_ssq = true) {
  const int xq = blockIdx.x & 7, lb = blockIdx.x >> 3, nlb = gridDim.x >> 3;
  const bool xmap = (gridDim.x & 7) == 0;
  for (int t = xmap ? lb : (int)blockIdx.x; t < (xmap ? 8 * G1_NCT : 64 * G1_NCT); t += (xmap ? nlb : (int)gridDim.x)) {
    int rt, ct2;
    if (xmap) { ct2 = t >> 3; rt = 8 * xq + (t & 7); } else { rt = t / G1_NCT; ct2 = t % G1_NCT; }
    g1_tile(p, smem, rt, ct2, do_ssq);
  }
}

DI void g2_epi_q(const Params& p, const float* sC, const float* rsq, const int m0, const int n0) {
  epi_rows(sC, [&](int, int row, int cc, const float (&v)[8]) {
    const int col = n0 + cc;
    float o[8];
#pragma unroll
    for (int j = 0; j < 8; ++j) o[j] = v[j];
    if (((col >> 5) % 3) == 2) rope8(sC, p.ROPE(), m0 + row, row, cc, o);
    const float sc = rsq[row] * QM_SCALE;
#pragma unroll
    for (int j = 0; j < 8; ++j) o[j] *= sc;
    store8(p.Qmla() + (size_t)(m0 + row) * 768 + col, o);
  });
}
DI void g2_epi_kv(const Params& p, const float* sC, const float* rsq, const int m0, const int head) {
  epi_rows(sC, [&](int, int row, int cc, const float (&v)[8]) {
    if (cc < 64) {
      const float sc = rsq[row];
      float o[8];
#pragma unroll
      for (int j = 0; j < 8; ++j) o[j] = v[j] * sc;
      store8(p.Knope() + (size_t)(m0 + row) * 512 + head * 64 + cc, o);
    } });
  const int b = m0 >> 12, s0 = m0 & 4095;
  for (int c = opaque_tid(); c < 1024; c += 512) {
    const int col = c & 63, rc = c >> 6;
    float v[8];
#pragma unroll
    for (int j = 0; j < 8; ++j) v[j] = sC[(rc * 8 + j) * CSTR + 64 + col] * rsq[rc * 8 + j];
    store8(p.VTmla() + ((size_t)((b * 8 + head) * 64 + col)) * SEQL + s0 + rc * 8, v);
  }
}

DI void g2_tile(const Params& p, char* smem, const bool isq, const int rt, const int ct) {
  bf16_t* shm = (bf16_t*)smem;
  float* sC = (float*)smem;
  float* rs = (float*)(smem + RS_OFF);
  const int m0 = rt * 256, n0 = ct * 256;
  f32x4 acc[2][2][4][2];
  zero_acc8(acc);
  if (isq) {
    if (threadIdx.x < 256) rs[threadIdx.x] = __builtin_amdgcn_rsqf(p.SSQ()[m0 + threadIdx.x] * (1.f / 384.f) + EPSN);
    gemm8_tile(p.CQ() + (size_t)m0 * 384, p.WuqT() + (size_t)n0 * 384, 384, shm, acc);
    tile_epilogue2(acc, sC, [&](const int qd, const float* sq) {
      g2_epi_q(p, sq, rs + (qd >> 1) * 128, m0 + (qd >> 1) * 128, n0 + (qd & 1) * 128); });
  } else {
    if (threadIdx.x < 256) rs[threadIdx.x] = __builtin_amdgcn_rsqf(p.SSQ()[NTOK + m0 + threadIdx.x] * (1.f / 256.f) + EPSN);
    gemm8_tile(p.CKV() + (size_t)m0 * 256, p.WukvT() + (size_t)n0 * 256, 256, shm, acc);
    tile_epilogue2(acc, sC, [&](const int qd, const float* sq) {
      g2_epi_kv(p, sq, rs + (qd >> 1) * 128, m0 + (qd >> 1) * 128, ct * 2 + (qd & 1)); });
  }
  __syncthreads();
}

DI void phase_g2(const Params& p, char* smem) {
  const int xq = blockIdx.x & 7, lb = blockIdx.x >> 3, nlb = gridDim.x >> 3;
  if ((gridDim.x & 7) == 0 && nlb == 32) {
    if (lb < 8) {
      g1_tile(p, smem, 8 * xq + lb, G1_NCT, false);
      const int v2 = 24 + lb;
      g2_tile(p, smem, false, 8 * xq + (v2 & 7), v2 >> 3);
      return;
    }
    const int v = lb - 8;
    g2_tile(p, smem, true, 8 * xq + (v & 7), v >> 3);
    g2_tile(p, smem, false, 8 * xq + (v & 7), v >> 3);
  } else {
    for (int tt = blockIdx.x; tt < 64 + 192 + 256; tt += gridDim.x) {
      if (tt < 64) g1_tile(p, smem, tt, G1_NCT, false);
      else if (tt < 256) { const int v = tt - 64; g2_tile(p, smem, true, v / 3, v % 3); }
      else { const int v = tt - 256; g2_tile(p, smem, false, v >> 2, v & 3); }
    }
  }
}

constexpr int VSTR = 68;

template <bool MLA>
DI void attn_item(const Params& p, int b, int h, int qb, char* smem, int* pre_ctr, int& pre_raw) {
  constexpr int DK = MLA ? 96 : 64;
  constexpr int KSTR = MLA ? 104 : 72;
  constexpr int NKS = DK / 16;
  bf16_t* sK = (bf16_t*)smem;
  bf16_t* sV = sK + 2 * 64 * KSTR;
  const int tid = threadIdx.x, lane = tid & 63, w = tid >> 6, r = lane & 31, hh = lane >> 5;
  const int tokb = b * SEQL;
  const int tok0 = tokb + qb * 256;
  const int qw = qb * 256 + w * 32;

  bf16x8 qf[NKS];
  {
    const bf16_t* qptr = MLA ? (p.Qmla() + (size_t)(tok0 + w * 32 + r) * 768 + h * 96 + hh * 8) : (p.Qsb() + (size_t)(tok0 + w * 32 + r) * 512 + h * 64 + hh * 8);
#pragma unroll
    for (int ks = 0; ks < NKS; ++ks) qf[ks] = *(const bf16x8*)(qptr + ks * 16);
  }
  u32x2* zbuf = (u32x2*)(smem + 65536);
  u32x2 zpre[8];
  {
    const bf16_t* zg0 = (MLA ? p.Zmla() : p.Zsb()) + (size_t)(tok0 + w * 32 + r) * 512 + h * 64 + 4 * hh;
#pragma unroll
    for (int i = 0; i < 8; ++i) zpre[i] = *(const u32x2*)(zg0 + (i >> 2) * 32 + 8 * (i & 3));
  }
  bf16x8 tf[2];
  if (!MLA) {
#pragma unroll
    for (int st = 0; st < 2; ++st)
#pragma unroll
      for (int e = 0; e < 8; ++e) { const int j = 16 * st + 8 * (e >> 2) + 4 * hh + (e & 3); tf[st][e] = (j >= r) ? (short)0x3F80 : (short)0; }
  }

  f32x16 oacc[2];
#pragma unroll
  for (int i = 0; i < 16; ++i) { oacc[0][i] = 0.f; oacc[1][i] = 0.f; }
  float carry = 0.f;
  float mrun = 0.f, lrun = 0.f;

  const bf16_t* Kg = MLA ? p.Knope() : p.Ksb();
  const bf16_t* VTg = (MLA ? p.VTmla() : p.VTsb()) + (size_t)((b * 8 + h) * 64) * SEQL;
  const int nt = 4 * qb + 4;

  uint4 xk0, xv0, xp, yk0, yv0, yp;
  xp = make_uint4(0, 0, 0, 0); yp = xp;
  const int prow = tid >> 3, pch = tid & 7;
  const bf16_t* kgp = Kg + (size_t)(tokb + prow) * 512 + h * 64 + pch * 8;
  const bf16_t* vgp = VTg + (size_t)prow * SEQL + pch * 8;
  const bf16_t* pgp = p.KPE() + (size_t)(tokb + ((tid & 255) >> 2)) * 32 + (tid & 3) * 8;
#define ATT_GLOAD(P, kt_)                                                          \
  {                                                                                \
    const int kt__ = (kt_);                                                        \
    P##k0 = *(const uint4*)(kgp + (size_t)(kt__ * 64) * 512);                      \
    P##v0 = *(const uint4*)(vgp + kt__ * 64);                                      \
    if (MLA && tid < 256) P##p = *(const uint4*)(pgp + (size_t)(kt__ * 64) * 32);  \
  }
#define ATT_SWRITE(P, buf_)                                                        \
  {                                                                                \
    bf16_t* dK = sK + (buf_) * 64 * KSTR;                                          \
    bf16_t* dV = sV + (buf_) * 64 * VSTR;                                          \
    *(uint4*)(dK + prow * KSTR + pch * 8) = P##k0;                                 \
    uint2* dv0 = (uint2*)(dV + prow * VSTR + pch * 8);                             \
    dv0[0] = make_uint2(P##v0.x, P##v0.y); dv0[1] = make_uint2(P##v0.z, P##v0.w);  \
    if (MLA && tid < 256) *(uint4*)(dK + (tid >> 2) * KSTR + 64 + (tid & 3) * 8) = P##p; \
  }
#define ATT_KT(i_) (MLA ? (i_) : (nt - 1 - (i_)))

  ATT_GLOAD(x, ATT_KT(0));
  ATT_GLOAD(y, ATT_KT(1));
  ATT_SWRITE(x, 0);
#pragma unroll
  for (int i = 0; i < 8; ++i) zbuf[i * 512 + tid] = zpre[i];
  __syncthreads();
  bool alive = true;
  for (int it0 = 0; alive; it0 += 2) {
#pragma unroll
   for (int half = 0; half < 2; ++half) {
    const int it = it0 + half;
    const int kt = ATT_KT(it);
    const int cur = half;
    const bool more = (it + 1 < nt);
    if (it + 2 < nt) { if (half == 0) ATT_GLOAD(x, ATT_KT(it + 2)) else ATT_GLOAD(y, ATT_KT(it + 2)) }
    const bf16_t* cK = sK + cur * 64 * KSTR;
    const bf16_t* cV = sV + cur * 64 * VSTR;
    if (MLA) {
      if (kt * 64 <= qw + 31) {
        f32x16 s0, s1;
        {
          const float sinit = -mrun;
#pragma unroll
          for (int i = 0; i < 16; ++i) { s0[i] = sinit; s1[i] = sinit; }
        }
        __builtin_amdgcn_s_setprio(1);
#pragma unroll
        for (int ks = 0; ks < NKS; ++ks) {
          const bf16x8 k0 = *(const bf16x8*)(cK + r * KSTR + ks * 16 + hh * 8);
          const bf16x8 k1 = *(const bf16x8*)(cK + (32 + r) * KSTR + ks * 16 + hh * 8);
          s0 = MFMA(k0, qf[ks], s0);
          s1 = MFMA(k1, qf[ks], s1);
        }
        __builtin_amdgcn_s_setprio(0);
        if (kt * 64 + 63 > qw) {
          const int lim = qw + r - kt * 64;
#pragma unroll
          for (int i = 0; i < 16; ++i) { if (crow(i, hh) > lim) s0[i] = -1e30f; if (32 + crow(i, hh) > lim) s1[i] = -1e30f; }
        }
        float m0 = fmaxf(fmaxf(s0[0], s0[1]), s0[2]), m1 = fmaxf(fmaxf(s1[0], s1[1]), s1[2]);
#pragma unroll
        for (int i = 3; i < 15; i += 2) { m0 = fmaxf(fmaxf(m0, s0[i]), s0[i + 1]); m1 = fmaxf(fmaxf(m1, s1[i]), s1[i + 1]); }
        float mloc = fmaxf(fmaxf(m0, s0[15]), fmaxf(m1, s1[15]));
        mloc = half_max(mloc);
        const bool first = (it == 0);
        const float delta = first ? mloc : fmaxf(mloc, 0.f);
        if (first || __builtin_amdgcn_ballot_w64(delta > 0.f) != 0ull) {
          const float alpha = first ? 0.f : __builtin_amdgcn_exp2f(-delta);
          mrun += delta;
          lrun *= alpha;
#pragma unroll
          for (int i = 0; i < 16; ++i) { oacc[0][i] *= alpha; oacc[1][i] *= alpha; s0[i] -= delta; s1[i] -= delta; }
        }
        float ps0 = 0.f, ps1 = 0.f;
#pragma unroll
        for (int i = 0; i < 16; ++i) { s0[i] = __builtin_amdgcn_exp2f(s0[i]); s1[i] = __builtin_amdgcn_exp2f(s1[i]); ps0 += s0[i]; ps1 += s1[i]; }
        lrun += ps0 + ps1;
        bf16x8 pf4[4];
        pf4[0] = pack8(s0[0], s0[1], s0[2], s0[3], s0[4], s0[5], s0[6], s0[7]);
        pf4[1] = pack8(s0[8], s0[9], s0[10], s0[11], s0[12], s0[13], s0[14], s0[15]);
        pf4[2] = pack8(s1[0], s1[1], s1[2], s1[3], s1[4], s1[5], s1[6], s1[7]);
        pf4[3] = pack8(s1[8], s1[9], s1[10], s1[11], s1[12], s1[13], s1[14], s1[15]);
        __builtin_amdgcn_s_setprio(1);
#pragma unroll
        for (int st = 0; st < 4; ++st)
#pragma unroll
          for (int dt = 0; dt < 2; ++dt) {
            const bf16_t* vp = cV + (dt * 32 + r) * VSTR + st * 16 + 4 * hh;
            const s16x4 lo = *(const s16x4*)vp;
            const s16x4 hi = *(const s16x4*)(vp + 8);
            const bf16x8 vf = __builtin_shufflevector(lo, hi, 0, 1, 2, 3, 4, 5, 6, 7);
            oacc[dt] = MFMA(vf, pf4[st], oacc[dt]);
          }
        __builtin_amdgcn_s_setprio(0);
      }
    } else
#pragma unroll
    for (int si = 0; si < 2; ++si) {
      const int sub = MLA ? si : (1 - si);
      const int kb = kt * 64 + sub * 32;
      if (kb > qw) continue;
      const bool diag = (kb == qw);
      f32x16 s;
      {
        const float sinit = MLA ? -mrun : 0.f;
#pragma unroll
        for (int i = 0; i < 16; ++i) s[i] = sinit;
      }
      __builtin_amdgcn_s_setprio(1);
#pragma unroll
      for (int ks = 0; ks < NKS; ++ks) {
        const bf16x8 kf = *(const bf16x8*)(cK + (sub * 32 + r) * KSTR + ks * 16 + hh * 8);
        s = MFMA(kf, qf[ks], s);
      }
      __builtin_amdgcn_s_setprio(0);
      bf16x8 pf[2];
      if (!MLA) {
        float sp[16];
        float tsum = 0.f;
#pragma unroll
        for (int i = 0; i < 16; ++i) {
          const float z = s[i];
          float v = __builtin_amdgcn_logf(1.f + __builtin_amdgcn_exp2f(fminf(z, 126.f)));
          if (diag && !(crow(i, hh) < r)) v = 0.f;
          sp[i] = v;
          tsum += v;
        }
        f32x16 cacc;
#pragma unroll
        for (int i = 0; i < 16; ++i) cacc[i] = carry;
        cacc = MFMA(tf[0], pack8(sp[0], sp[1], sp[2], sp[3], sp[4], sp[5], sp[6], sp[7]), cacc);
        cacc = MFMA(tf[1], pack8(sp[8], sp[9], sp[10], sp[11], sp[12], sp[13], sp[14], sp[15]), cacc);
        float pr[16];
#pragma unroll
        for (int i = 0; i < 16; ++i) {
          float v = __builtin_amdgcn_exp2f(s[i] - cacc[i]);
          if (diag && !(crow(i, hh) < r)) v = 0.f;
          pr[i] = v;
        }
        carry += half_sum(tsum);
        pf[0] = pack8(pr[0], pr[1], pr[2], pr[3], pr[4], pr[5], pr[6], pr[7]);
        pf[1] = pack8(pr[8], pr[9], pr[10], pr[11], pr[12], pr[13], pr[14], pr[15]);
      } else {
        if (diag) {
#pragma unroll
          for (int i = 0; i < 16; ++i) if (!(crow(i, hh) <= r)) s[i] = -1e30f;
        }
        float mloc = fmaxf(fmaxf(s[0], s[1]), s[2]);
#pragma unroll
        for (int i = 3; i < 15; i += 2) mloc = fmaxf(fmaxf(mloc, s[i]), s[i + 1]);
        mloc = fmaxf(mloc, s[15]);
        mloc = half_max(mloc);
        const bool first = (it == 0) && (si == 0);
        const float delta = first ? mloc : fmaxf(mloc, 0.f);
        if (first || __builtin_amdgcn_ballot_w64(delta > 0.f) != 0ull) {
          const float alpha = first ? 0.f : __builtin_amdgcn_exp2f(-delta);
          mrun += delta;
          lrun *= alpha;
#pragma unroll
          for (int i = 0; i < 16; ++i) { oacc[0][i] *= alpha; oacc[1][i] *= alpha; s[i] -= delta; }
        }
        float pr[16];
        float ps0 = 0.f, ps1 = 0.f;
#pragma unroll
        for (int i = 0; i < 16; i += 2) { pr[i] = __builtin_amdgcn_exp2f(s[i]); pr[i + 1] = __builtin_amdgcn_exp2f(s[i + 1]); ps0 += pr[i]; ps1 += pr[i + 1]; }
        lrun += ps0 + ps1;
        pf[0] = pack8(pr[0], pr[1], pr[2], pr[3], pr[4], pr[5], pr[6], pr[7]);
        pf[1] = pack8(pr[8], pr[9], pr[10], pr[11], pr[12], pr[13], pr[14], pr[15]);
      }
      __builtin_amdgcn_s_setprio(1);
#pragma unroll
      for (int dt = 0; dt < 2; ++dt)
#pragma unroll
        for (int st = 0; st < 2; ++st) {
          const bf16_t* vp = cV + (dt * 32 + r) * VSTR + sub * 32 + st * 16 + 4 * hh;
          const s16x4 lo = *(const s16x4*)vp;
          const s16x4 hi = *(const s16x4*)(vp + 8);
          const bf16x8 vf = __builtin_shufflevector(lo, hi, 0, 1, 2, 3, 4, 5, 6, 7);
          oacc[dt] = MFMA(vf, pf[st], oacc[dt]);
        }
      __builtin_amdgcn_s_setprio(0);
    }
    if (more) { if (half == 0) ATT_SWRITE(y, 1) else ATT_SWRITE(x, 0) }
    if (!MLA) {
      int* flg = (int*)(smem + SMEM_BYTES - 128) + (it & 1) * 8;
      const bool wok = (__builtin_amdgcn_ballot_w64(carry >= 160.f) == ~0ull);
      if (lane == 0) flg[w] = wok ? 1 : 0;
      __syncthreads();
      alive = more && ((flg[0] & flg[1] & flg[2] & flg[3] & flg[4] & flg[5] & flg[6] & flg[7]) == 0);
    } else {
      __syncthreads();
      alive = more;
    }
    if (!alive) break;
   }
  }
#undef ATT_GLOAD
#undef ATT_SWRITE
#undef ATT_KT
  if (threadIdx.x == 0 && pre_ctr) pre_raw = atomicAdd(pre_ctr, 1);
  float inv = 1.f;
  if (MLA) { const float lt = half_sum(lrun); inv = 1.f / lt; }
  const int tok = tok0 + w * 32 + r;
  bf16_t* og = (MLA ? p.OBg() : p.OAg()) + (size_t)tok * 512 + h * 64;
#pragma unroll
  for (int dt = 0; dt < 2; ++dt)
#pragma unroll
    for (int g = 0; g < 4; ++g) {
      const int d = dt * 32 + 8 * g + 4 * hh;
      const u32x2 zz = zbuf[(dt * 4 + g) * 512 + tid];
      const float z0 = __uint_as_float(zz[0] << 16), z1 = __uint_as_float(zz[0] & 0xffff0000u);
      const float z2 = __uint_as_float(zz[1] << 16), z3 = __uint_as_float(zz[1] & 0xffff0000u);
      u32x2 o;
      o[0] = pk2(oacc[dt][4 * g] * inv * z0, oacc[dt][4 * g + 1] * inv * z1);
      o[1] = pk2(oacc[dt][4 * g + 2] * inv * z2, oacc[dt][4 * g + 3] * inv * z3);
      *(u32x2*)(og + d) = o;
    }
}

DI void phase_attn(const Params& p, char* smem, int cbase, int only) {
  int* s_item = (int*)(smem + SMEM_BYTES - 16);
  const int q0 = blockIdx.x & 7;
  int qi = 0;
  int pre_raw = 0;
  bool has_pre = false;
  for (;;) {
    if (threadIdx.x < 64) {
      int item = -1;
      while (qi < 8) {
        const int q = (q0 + qi) & 7;
        int idx = 0;
        if (has_pre) { idx = pre_raw; has_pre = false; }
        else if (threadIdx.x == 0) idx = atomicAdd(p.counter() + cbase + q, 1);
        idx = __builtin_amdgcn_readfirstlane(idx);
        if (idx < 128) { item = q * 256 + idx; break; }
        const int lq = (q0 + (threadIdx.x & 7)) & 7;
        const int head = __hip_atomic_load(p.counter() + cbase + lq, __ATOMIC_RELAXED, __HIP_MEMORY_SCOPE_AGENT);
        const unsigned long long avail = __builtin_amdgcn_ballot_w64((threadIdx.x < 8) && (head < 128) && ((int)(threadIdx.x & 7) > qi));
        if (avail == 0ull) { qi = 8; break; }
        qi = __builtin_ctzll(avail);
      }
      if (threadIdx.x == 0) *s_item = item;
    }
    __syncthreads();
    const int item = *s_item;
    __syncthreads();
    if (item < 0) break;
    const int q = item >> 8, idx = item & 255;
    const int i2 = idx & 63;
    const int bh = q + 8 * (i2 & 3);
    const int qb = 15 - (i2 >> 2);
    int* pre_ctr = p.counter() + cbase + ((q0 + qi) & 7);
    if (idx < 64) { if (only != 2) { attn_item<true>(p, bh >> 3, bh & 7, qb, smem, pre_ctr, pre_raw); has_pre = true; } }
    else { if (only != 1) { attn_item<false>(p, bh >> 3, bh & 7, qb, smem, pre_ctr, pre_raw); has_pre = true; } }
  }
}

DI void g3_pre_a(const Params& p, const int m0, const int n0, u32x4 (&g)[4]) {
  const int txo = opaque_tid();
#pragma unroll
  for (int i = 0; i < 4; ++i) {
    const int c = txo + 512 * i, row = c >> 4, cc = (c & 15) * 8;
    g[i] = *(const u32x4*)(p.GA() + (size_t)(m0 + row) * 1024 + n0 + cc);
  }
}
DI void g3_epi_a(const Params& p, const float* sC, const int m0, const int n0, const u32x4 (&gq)[4]) {
  const int txo = opaque_tid();
#pragma unroll
  for (int i = 0; i < 4; ++i) {
    const int c = txo + 512 * i, row = c >> 4, cc = (c & 15) * 8;
    const u32x4 g = gq[i];
    const float4 a = *(const float4*)(sC + row * CSTR + cc), b = *(const float4*)(sC + row * CSTR + cc + 4);
    u32x4 y;
    y[0] = pk2(a.x * __uint_as_float(g[0] << 16), a.y * __uint_as_float(g[0] & 0xffff0000u));
    y[1] = pk2(a.z * __uint_as_float(g[1] << 16), a.w * __uint_as_float(g[1] & 0xffff0000u));
    y[2] = pk2(b.x * __uint_as_float(g[2] << 16), b.y * __uint_as_float(g[2] & 0xffff0000u));
    y[3] = pk2(b.z * __uint_as_float(g[3] << 16), b.w * __uint_as_float(g[3] & 0xffff0000u));
    *(u32x4*)(p.MERGED() + (size_t)(m0 + row) * 1024 + n0 + cc) = y;
  }
}
DI void g3_pre_b(const Params& p, const int m0, const int n0, u32x4 (&g)[4], u32x4 (&y)[4]) {
  const int txo2 = opaque_tid();
#pragma unroll
  for (int i = 0; i < 4; ++i) {
    const int c = txo2 + 512 * i, row = c >> 4, cc = (c & 15) * 8;
    g[i] = *(const u32x4*)(p.GB() + (size_t)(m0 + row) * 1024 + n0 + cc);
    y[i] = *(const u32x4*)(p.MERGED() + (size_t)(m0 + row) * 1024 + n0 + cc);
  }
}
DI void g3_epi_b(const Params& p, const float* sC, const int m0, const int n0, const u32x4 (&gq)[4], const u32x4 (&yq)[4]) {
  const int txo2 = opaque_tid();
#pragma unroll
  for (int i = 0; i < 4; ++i) {
    const int c = txo2 + 512 * i, row = c >> 4, cc = (c & 15) * 8;
    const u32x4 g = gq[i];
    const u32x4 yv = yq[i];
    const float4 a = *(const float4*)(sC + row * CSTR + cc), b = *(const float4*)(sC + row * CSTR + cc + 4);
    u32x4 o;
    o[0] = pk2(__uint_as_float(yv[0] << 16) + a.x * __uint_as_float(g[0] << 16), __uint_as_float(yv[0] & 0xffff0000u) + a.y * __uint_as_float(g[0] & 0xffff0000u));
    o[1] = pk2(__uint_as_float(yv[1] << 16) + a.z * __uint_as_float(g[1] << 16), __uint_as_float(yv[1] & 0xffff0000u) + a.w * __uint_as_float(g[1] & 0xffff0000u));
    o[2] = pk2(__uint_as_float(yv[2] << 16) + b.x * __uint_as_float(g[2] << 16), __uint_as_float(yv[2] & 0xffff0000u) + b.y * __uint_as_float(g[2] & 0xffff0000u));
    o[3] = pk2(__uint_as_float(yv[3] << 16) + b.z * __uint_as_float(g[3] << 16), __uint_as_float(yv[3] & 0xffff0000u) + b.w * __uint_as_float(g[3] & 0xffff0000u));
    *(u32x4*)(p.MERGED() + (size_t)(m0 + row) * 1024 + n0 + cc) = o;
  }
}
DI void phase_g3(const Params& p, char* smem) {
  bf16_t* shm = (bf16_t*)smem;
  float* sC = (float*)smem;
  const int xq = blockIdx.x & 7, lb = blockIdx.x >> 3, nlb = gridDim.x >> 3;
  const bool xmap = (gridDim.x & 7) == 0;
  for (int t = xmap ? lb : (int)blockIdx.x; t < (xmap ? 32 : 256); t += (xmap ? nlb : (int)gridDim.x)) {
    const int rt = xmap ? (8 * xq + (t & 7)) : (t >> 2), ct = xmap ? (t >> 3) : (t & 3);
    const int m0 = rt * 256, n0 = ct * 256;
    f32x4 acc[2][2][4][2];
    zero_acc8(acc);
    gemm8_tile(p.OAg() + (size_t)m0 * 512, p.WaT() + (size_t)n0 * 512, 512, shm, acc);
#pragma unroll
    for (int ai = 0; ai < 2; ++ai)
#pragma unroll
      for (int bj = 0; bj < 2; ++bj) {
        u32x4 gq[4];
        g3_pre_a(p, m0 + ai * 128, n0 + bj * 128, gq);
        __syncthreads();
        accq_to_lds(acc[ai][bj], sC);
        __syncthreads();
        g3_epi_a(p, sC, m0 + ai * 128, n0 + bj * 128, gq);
      }
    __syncthreads();
    zero_acc8(acc);
    gemm8_tile(p.OBg() + (size_t)m0 * 512, p.WbT() + (size_t)n0 * 512, 512, shm, acc);
#pragma unroll
    for (int ai = 0; ai < 2; ++ai)
#pragma unroll
      for (int bj = 0; bj < 2; ++bj) {
        u32x4 gq[4], yq[4];
        g3_pre_b(p, m0 + ai * 128, n0 + bj * 128, gq, yq);
        __syncthreads();
        accq_to_lds(acc[ai][bj], sC);
        __syncthreads();
        g3_epi_b(p, sC, m0 + ai * 128, n0 + bj * 128, gq, yq);
      }
    __syncthreads();
  }
}

DI void g4_pre(const Params& p, const int m0, const int n0, float4 (&xq)[8]) {
  const int txo = opaque_tid();
#pragma unroll
  for (int i = 0; i < 4; ++i) {
    const int c = txo + 512 * i, row = c >> 4, cc = (c & 15) * 8;
    const size_t go = (size_t)(m0 + row) * 1024 + n0 + cc;
    xq[2 * i] = *(const float4*)(p.x + go); xq[2 * i + 1] = *(const float4*)(p.x + go + 4);
  }
}
DI void g4_epi(const Params& p, const float* sC, const float* gt, const int m0, const int n0, const float4 (&xq)[8]) {
  const int txo = opaque_tid();
#pragma unroll
  for (int i = 0; i < 4; ++i) {
    const int c = txo + 512 * i, row = c >> 4, cc = (c & 15) * 8;
    const size_t go = (size_t)(m0 + row) * 1024 + n0 + cc;
    const float4 x0 = xq[2 * i], x1 = xq[2 * i + 1];
    const float4 a = *(const float4*)(sC + row * CSTR + cc), b = *(const float4*)(sC + row * CSTR + cc + 4);
    const float4 g0 = *(const float4*)(gt + cc), g1 = *(const float4*)(gt + cc + 4);
    float4 o0, o1;
    o0.x = x0.x + g0.x * a.x; o0.y = x0.y + g0.y * a.y; o0.z = x0.z + g0.z * a.z; o0.w = x0.w + g0.w * a.w;
    o1.x = x1.x + g1.x * b.x; o1.y = x1.y + g1.y * b.y; o1.z = x1.z + g1.z * b.z; o1.w = x1.w + g1.w * b.w;
    *(float4*)(p.out + go) = o0;
    *(float4*)(p.out + go + 4) = o1;
  }
}
DI void phase_g4(const Params& p, char* smem) {
  bf16_t* shm = (bf16_t*)smem;
  float* sC = (float*)smem;
  float* rs = (float*)(smem + RS_OFF);
  const int xq = blockIdx.x & 7, lb = blockIdx.x >> 3, nlb = gridDim.x >> 3;
  const bool xmap = (gridDim.x & 7) == 0;
  for (int t = xmap ? lb : (int)blockIdx.x; t < (xmap ? 32 : 256); t += (xmap ? nlb : (int)gridDim.x)) {
    const int rt = xmap ? (8 * xq + (t & 7)) : (t >> 2), ct = xmap ? (t >> 3) : (t & 3);
    const int m0 = rt * 256, n0 = ct * 256;
    f32x4 acc[2][2][4][2];
    zero_acc8(acc);
    if (threadIdx.x < 256) rs[threadIdx.x] = mod_get(p.MOD(), m0 >> 12, 2048 + n0 + threadIdx.x);
    gemm8_tile(p.MERGED() + (size_t)m0 * 1024, p.WoT() + (size_t)n0 * 1024, 1024, shm, acc);
#pragma unroll
    for (int ai = 0; ai < 2; ++ai)
#pragma unroll
      for (int bj = 0; bj < 2; ++bj) {
        float4 xq[8];
        g4_pre(p, m0 + ai * 128, n0 + bj * 128, xq);
        __syncthreads();
        accq_to_lds(acc[ai][bj], sC);
        __syncthreads();
        g4_epi(p, sC, rs + bj * 128, m0 + ai * 128, n0 + bj * 128, xq);
      }
    __syncthreads();
  }
}

DI void phase_final(const Params& p) {
  const int lane = threadIdx.x & 63, w = threadIdx.x >> 6;
  const int gw = blockIdx.x * 8 + w, nw = gridDim.x * 8;
  for (int row = gw; row < NTOK; row += nw) {
    float* xr = p.out + (size_t)row * DM;
    float4 v[4];
    float ss = 0.f;
#pragma unroll
    for (int i = 0; i < 4; ++i) {
      v[i] = *(const float4*)(xr + 4 * (lane + 64 * i));
      ss += v[i].x * v[i].x + v[i].y * v[i].y + v[i].z * v[i].z + v[i].w * v[i].w;
    }
#pragma unroll
    for (int o = 32; o >= 1; o >>= 1) ss += __shfl_xor(ss, o);
    const float rn = __builtin_amdgcn_rsqf(ss * (1.f / DM) + EPSN);
#pragma unroll
    for (int i = 0; i < 4; ++i) {
      const int e = 4 * (lane + 64 * i);
      const float4 g = *(const float4*)(p.fgain + e);
      float4 o;
      o.x = v[i].x * rn * g.x; o.y = v[i].y * rn * g.y; o.z = v[i].z * rn * g.z; o.w = v[i].w * rn * g.w;
      *(float4*)(xr + e) = o;
    }
  }
}

template <int PH>
__global__ void __launch_bounds__(NTHREADS, 2) mega_kernel(Params p) {
  __shared__ __attribute__((aligned(16))) char smem[SMEM_BYTES];
  if (PH < 0) {
    if (p.ws == nullptr) cg::this_grid().sync();
    volatile LAS unsigned* xst = (volatile LAS unsigned*)(smem + SMEM_BYTES - 32);
    if (threadIdx.x == 0) { xst[0] = 0u; xst[1] = 0u; }
    __syncthreads();
    (void)xcd_barrier_post(p.bar(), xst);
    phase_prep(p, smem); xcd_barrier(p.bar(), (volatile LAS unsigned*)(smem + SMEM_BYTES - 32));
#if PROBE_DUP == 4
    phase_prep(p, smem); xcd_barrier(p.bar(), (volatile LAS unsigned*)(smem + SMEM_BYTES - 32));
#endif
    phase_h(p, smem); xcd_barrier(p.bar(), (volatile LAS unsigned*)(smem + SMEM_BYTES - 32));
#if PROBE_DUP == 5
    phase_h(p, smem); xcd_barrier(p.bar(), (volatile LAS unsigned*)(smem + SMEM_BYTES - 32));
#endif
    phase_g1(p, smem); xcd_barrier(p.bar(), (volatile LAS unsigned*)(smem + SMEM_BYTES - 32));
#if PROBE_DUP == 1
    phase_g1(p, smem, false); xcd_barrier(p.bar(), (volatile LAS unsigned*)(smem + SMEM_BYTES - 32));
#endif
    phase_g2(p, smem); xcd_barrier(p.bar(), (volatile LAS unsigned*)(smem + SMEM_BYTES - 32));
#if PROBE_DUP == 8
    phase_g2(p, smem); xcd_barrier(p.bar(), (volatile LAS unsigned*)(smem + SMEM_BYTES - 32));
#endif
    phase_attn(p, smem, 0, 0); xcd_barrier(p.bar(), (volatile LAS unsigned*)(smem + SMEM_BYTES - 32));
#if PROBE_DUP == 2
    phase_attn(p, smem, 8, 1); xcd_barrier(p.bar(), (volatile LAS unsigned*)(smem + SMEM_BYTES - 32));
#endif
#if PROBE_DUP == 3
    phase_attn(p, smem, 8, 2); xcd_barrier(p.bar(), (volatile LAS unsigned*)(smem + SMEM_BYTES - 32));
#endif
    phase_g3(p, smem); xcd_barrier(p.bar(), (volatile LAS unsigned*)(smem + SMEM_BYTES - 32));
#if PROBE_DUP == 6
    phase_g3(p, smem); xcd_barrier(p.bar(), (volatile LAS unsigned*)(smem + SMEM_BYTES - 32));
#endif
    phase_g4(p, smem); xcd_barrier(p.bar(), (volatile LAS unsigned*)(smem + SMEM_BYTES - 32));
#if PROBE_DUP == 7
    phase_g4(p, smem); xcd_barrier(p.bar(), (volatile LAS unsigned*)(smem + SMEM_BYTES - 32));
#endif
    phase_final(p);
  } else {
    if (PH == 0) phase_prep(p, smem);
    if (PH == 1) phase_h(p, smem);
    if (PH == 2) phase_g1(p, smem);
    if (PH == 3) phase_g2(p, smem);
    if (PH == 4) phase_attn(p, smem, 0, 0);
    if (PH == 5) phase_g3(p, smem);
    if (PH == 6) phase_g4(p, smem);
    if (PH == 7) phase_final(p);
  }
}

#ifndef PROBE_DUP
#define PROBE_DUP 0
#endif
#ifndef MK_SPLIT
#define MK_SPLIT 0
#endif

extern "C" void kernel_launch(void* const* d_in, const int* in_sizes, int n_in, void* d_out, int out_size, void* d_ws, size_t ws_size, hipStream_t stream) {
  Params p{};
  p.x = (const float*)d_in[0]; p.c = (const float*)d_in[1]; p.pos = (const int*)d_in[2];
  p.w_ada = (const float*)d_in[3]; p.b_ada = (const float*)d_in[4]; p.norm_gain = (const float*)d_in[5];
  p.w_in = (const float*)d_in[6]; p.q_gain = (const float*)d_in[7]; p.w_uq = (const float*)d_in[8];
  p.kv_gain = (const float*)d_in[9]; p.w_ukv = (const float*)d_in[10]; p.w_a = (const float*)d_in[11];
  p.w_b = (const float*)d_in[12]; p.w_out = (const float*)d_in[13]; p.fgain = (const float*)d_in[14];
  p.out = (float*)d_out;
  p.ws = (char*)d_ws;
  if (WS_NEED > ws_size) { fprintf(stderr, "workspace too small: need %zu have %zu\n", (size_t)WS_NEED, ws_size); return; }

  static int grid_blocks = 0;
  if (!grid_blocks) {
    int dev = 0, cus = 0, per_cu = 0;
    hipGetDevice(&dev);
    hipDeviceGetAttribute(&cus, hipDeviceAttributeMultiprocessorCount, dev);
    hipOccupancyMaxActiveBlocksPerMultiprocessor(&per_cu, mega_kernel<-1>, NTHREADS, 0);
    per_cu = 1;
    grid_blocks = cus * per_cu;
  }
#if MK_SPLIT
  mega_kernel<0><<<grid_blocks, NTHREADS, 0, stream>>>(p);
  mega_kernel<1><<<grid_blocks, NTHREADS, 0, stream>>>(p);
  mega_kernel<2><<<grid_blocks, NTHREADS, 0, stream>>>(p);
  mega_kernel<3><<<grid_blocks, NTHREADS, 0, stream>>>(p);
  mega_kernel<4><<<grid_blocks, NTHREADS, 0, stream>>>(p);
  mega_kernel<5><<<grid_blocks, NTHREADS, 0, stream>>>(p);
  mega_kernel<6><<<grid_blocks, NTHREADS, 0, stream>>>(p);
  mega_kernel<7><<<grid_blocks, NTHREADS, 0, stream>>>(p);
#else
  hipMemsetAsync((char*)d_ws + OFF_bar, 0, XCD_BAR_WORDS * 4, stream);
  void* args[] = {&p};
  hipError_t e = hipLaunchCooperativeKernel((void*)mega_kernel<-1>, dim3(grid_blocks), dim3(NTHREADS), args, 0, stream);
  if (e != hipSuccess) fprintf(stderr, "cooperative launch failed: %s (grid %d)\n", hipGetErrorString(e), grid_blocks);
#endif
}
```

```cpp
#include <hip/hip_runtime.h>
#include <hip/hip_cooperative_groups.h>
#include <stdint.h>
#include <stdio.h>
namespace cg = cooperative_groups;
#ifndef PROBE_DUP
#define PROBE_DUP 0
#endif

#define DI __device__ __forceinline__
typedef unsigned short bf16_t;
typedef __attribute__((ext_vector_type(8))) short bf16x8;
typedef __attribute__((ext_vector_type(4))) short s16x4;
typedef __attribute__((ext_vector_type(16))) float f32x16;
typedef __attribute__((ext_vector_type(2))) float f32x2;
typedef __attribute__((ext_vector_type(2))) __bf16 bf16x2v;
typedef __attribute__((ext_vector_type(4))) unsigned u32x4;
typedef __attribute__((ext_vector_type(2))) unsigned u32x2;
typedef __attribute__((ext_vector_type(4))) float f32x4;
#define MFMA(a, b, c) __builtin_amdgcn_mfma_f32_32x32x16_bf16((a), (b), (c), 0, 0, 0)

constexpr int NTOK = 16384, SEQL = 4096, DM = 1024;
constexpr int INW = 5280, INWP = 5376;
constexpr int NTHREADS = 512;
constexpr float LOG2E = 1.4426950408889634f;
constexpr float QS_SCALE = 0.125f * 1.4426950408889634f;
constexpr float QM_SCALE = 1.4426950408889634f / 9.797958971132712f;
constexpr float EPSN = 1e-6f;

constexpr int XCD_BAR_WORDS_C = 3456;
constexpr size_t al256(size_t v) { return (v + 255) & ~(size_t)255; }
constexpr size_t OFF_counter = 0;
constexpr size_t OFF_bar = OFF_counter + al256(256);
constexpr size_t OFF_MOD = OFF_bar + al256(XCD_BAR_WORDS_C * 4);
constexpr size_t OFF_ROPE = OFF_MOD + al256(4 * 3072 * 4 * 4);
constexpr size_t OFF_SSQ = OFF_ROPE + al256((size_t)NTOK * 32 * 4);
constexpr size_t OFF_Hb = OFF_SSQ + al256((size_t)2 * NTOK * 4);
constexpr size_t OFF_Qmla = OFF_Hb + al256((size_t)NTOK * 1024 * 2);
constexpr size_t OFF_WuqT = OFF_Qmla + al256((size_t)NTOK * 768 * 2);
constexpr size_t OFF_WukvT = OFF_WuqT + al256((size_t)768 * 384 * 2);
constexpr size_t OFF_WaT = OFF_WukvT + al256((size_t)1024 * 256 * 2);
constexpr size_t OFF_WbT = OFF_WaT + al256((size_t)1024 * 512 * 2);
constexpr size_t OFF_WoT = OFF_WbT + al256((size_t)1024 * 512 * 2);
constexpr size_t OFF_Qsb = OFF_WoT + al256((size_t)1024 * 1024 * 2);
constexpr size_t OFF_Ksb = OFF_Qsb + al256((size_t)NTOK * 512 * 2);
constexpr size_t OFF_VTsb = OFF_Ksb + al256((size_t)NTOK * 512 * 2);
constexpr size_t OFF_Zsb = OFF_VTsb + al256((size_t)NTOK * 512 * 2);
constexpr size_t OFF_OAg = OFF_Zsb + al256((size_t)NTOK * 512 * 2);
constexpr size_t OFF_OBg = OFF_OAg + al256((size_t)NTOK * 512 * 2);
constexpr size_t OFF_Zmla = OFF_OBg + al256((size_t)NTOK * 512 * 2);
constexpr size_t OFF_KPE = OFF_Zmla + al256((size_t)NTOK * 512 * 2);
constexpr size_t OFF_Knope = OFF_KPE + al256((size_t)NTOK * 32 * 2);
constexpr size_t OFF_VTmla = OFF_Knope + al256((size_t)NTOK * 512 * 2);
constexpr size_t OFF_WinT = OFF_VTmla + al256((size_t)NTOK * 512 * 2);
constexpr size_t WS_NEED = OFF_WinT + al256((size_t)INWP * 1024 * 2);
struct Params {
  const float *x, *c; const int* pos;
  const float *w_ada, *b_ada, *norm_gain, *w_in, *q_gain, *w_uq, *kv_gain, *w_ukv, *w_a, *w_b, *w_out, *fgain;
  float* out;
  char* ws;
  DI int* counter() const { return (int*)(ws + OFF_counter); }
  DI unsigned* bar() const { return (unsigned*)(ws + OFF_bar); }
  DI float* MOD() const { return (float*)(ws + OFF_MOD); }
  DI float* ROPE() const { return (float*)(ws + OFF_ROPE); }
  DI float* SSQ() const { return (float*)(ws + OFF_SSQ); }
  DI bf16_t* Hb() const { return (bf16_t*)(ws + OFF_Hb); }
  DI bf16_t* Qmla() const { return (bf16_t*)(ws + OFF_Qmla); }
  DI bf16_t* WuqT() const { return (bf16_t*)(ws + OFF_WuqT); }
  DI bf16_t* WukvT() const { return (bf16_t*)(ws + OFF_WukvT); }
  DI bf16_t* WaT() const { return (bf16_t*)(ws + OFF_WaT); }
  DI bf16_t* WbT() const { return (bf16_t*)(ws + OFF_WbT); }
  DI bf16_t* WoT() const { return (bf16_t*)(ws + OFF_WoT); }
  DI bf16_t* Qsb() const { return (bf16_t*)(ws + OFF_Qsb); }
  DI bf16_t* Ksb() const { return (bf16_t*)(ws + OFF_Ksb); }
  DI bf16_t* VTsb() const { return (bf16_t*)(ws + OFF_VTsb); }
  DI bf16_t* Zsb() const { return (bf16_t*)(ws + OFF_Zsb); }
  DI bf16_t* OAg() const { return (bf16_t*)(ws + OFF_OAg); }
  DI bf16_t* OBg() const { return (bf16_t*)(ws + OFF_OBg); }
  DI bf16_t* Zmla() const { return (bf16_t*)(ws + OFF_Zmla); }
  DI bf16_t* KPE() const { return (bf16_t*)(ws + OFF_KPE); }
  DI bf16_t* Knope() const { return (bf16_t*)(ws + OFF_Knope); }
  DI bf16_t* VTmla() const { return (bf16_t*)(ws + OFF_VTmla); }
  DI bf16_t* MERGED() const { return Hb(); }
  DI bf16_t* WinT() const { return (bf16_t*)(ws + OFF_WinT); }
  DI bf16_t* CQ() const { return OAg(); }
  DI bf16_t* CKV() const { return OBg(); }
  DI bf16_t* GA() const { return (bf16_t*)out; }
  DI bf16_t* GB() const { return (bf16_t*)out + (size_t)NTOK * 1024; }
};


__device__ const float c_invfreq[16] = {
  1.0f, 0.5623413251903491f, 0.31622776601683794f, 0.1778279410038923f, 0.1f, 0.05623413251903491f, 0.03162277660168379f,
  0.01778279410038923f, 0.01f, 0.005623413251903491f, 0.0031622776601683794f, 0.001778279410038923f, 0.001f,
  0.0005623413251903491f, 0.00031622776601683794f, 0.0001778279410038923f};

DI unsigned pk2(float a, float b) { f32x2 v = {a, b}; bf16x2v r = __builtin_convertvector(v, bf16x2v); return __builtin_bit_cast(unsigned, r); }
DI bf16_t tobf(float a) { return (bf16_t)(pk2(a, 0.f) & 0xffffu); }
DI float bf2f(unsigned short u) { return __uint_as_float(((unsigned)u) << 16); }
DI bf16x8 pack8(float a0, float a1, float a2, float a3, float a4, float a5, float a6, float a7) {
  u32x4 p; p[0] = pk2(a0, a1); p[1] = pk2(a2, a3); p[2] = pk2(a4, a5); p[3] = pk2(a6, a7);
  return __builtin_bit_cast(bf16x8, p);
}
DI int crow(int reg, int h) { return (reg & 3) + 8 * (reg >> 2) + 4 * h; }
DI int opaque_tid() { int t = threadIdx.x; asm volatile("" : "+v"(t)); return t; }
DI float half_max(float v) {
  unsigned u = __float_as_uint(v);
  auto r = __builtin_amdgcn_permlane32_swap(u, u, false, false);
  return fmaxf(__uint_as_float(r[0]), __uint_as_float(r[1]));
}
DI float half_sum(float v) {
  unsigned u = __float_as_uint(v);
  auto r = __builtin_amdgcn_permlane32_swap(u, u, false, false);
  return __uint_as_float(r[0]) + __uint_as_float(r[1]);
}
DI float sigmoidf_fast(float v) { return __builtin_amdgcn_rcpf(1.f + __builtin_amdgcn_exp2f(-v * LOG2E)); }
DI float siluf_fast(float v) { return v * sigmoidf_fast(v); }

#define XB_TMO      128
#define XB_XCNT(j)  (256  + 64 * (j))
#define XB_XSUB(j)  (1280 + 64 * (j))
#define XB_XGEN(j)  (2304 + 64 * (j))
#define XB_TOP      3328
#define XB_TOPGEN   3392
#define XCD_BAR_WORDS 3456
#define XB_SPIN_CAP (1u << 18)
#define LAS __attribute__((address_space(3)))
DI unsigned xb_ld(unsigned* p)              { return __hip_atomic_load(p, __ATOMIC_RELAXED, __HIP_MEMORY_SCOPE_AGENT); }
DI unsigned xb_add(unsigned* p, unsigned v) { return __hip_atomic_fetch_add(p, v, __ATOMIC_RELAXED, __HIP_MEMORY_SCOPE_AGENT); }
DI unsigned xb_xcc_id() { return (unsigned)__builtin_amdgcn_s_getreg((3 << 11) | 20) & 0xFu; }
#define XB_SPIN(cond, bar) do { unsigned _sp = 0; while (cond) { __builtin_amdgcn_s_sleep(1); \
    if ((++_sp & 255u) == 0u) { if (xb_ld(&(bar)[XB_TMO])) break; if (_sp > XB_SPIN_CAP) { atomicAdd(&(bar)[XB_TMO], 1u); break; } } } } while (0)
struct XcdBarrier { unsigned* bar; unsigned x; volatile LAS unsigned* st; };
DI XcdBarrier xcd_barrier_post(unsigned* bar, volatile LAS unsigned* st) {
  XcdBarrier b; b.bar = bar; b.x = xb_xcc_id(); b.st = st;
  if (threadIdx.x == 0) (void)xb_add(&bar[XB_XCNT(b.x)], 1u);
  return b;
}
DI void xcd_barrier_complete(unsigned* bar, unsigned x, unsigned& nloc, unsigned& nx) {
  const unsigned G = gridDim.x * gridDim.y * gridDim.z;
  unsigned sum, cnt, mine, sp = 0u;
  for (;;) {
    sum = 0u; cnt = 0u; mine = 0u;
#pragma unroll
    for (unsigned j = 0; j < 16; ++j) { const unsigned c = xb_ld(&bar[XB_XCNT(j)]); sum += c; cnt += (c > 0u) ? 1u : 0u; mine = (j == x) ? c : mine; }
    if (sum == G) break;
    __builtin_amdgcn_s_sleep(1);
    if ((++sp & 255u) == 0u) { if (xb_ld(&bar[XB_TMO])) break; if (sp > XB_SPIN_CAP) { atomicAdd(&bar[XB_TMO], 1u); break; } }
  }
  nloc = mine > 0u ? mine : 1u; nx = cnt > 0u ? cnt : 1u;
}
DI void xcd_barrier(unsigned* bar_, volatile LAS unsigned* st_) {
  XcdBarrier b; b.bar = bar_; b.st = st_; b.x = 0;
  asm volatile("s_waitcnt vmcnt(0)" ::: "memory");
  __syncthreads();
  if (threadIdx.x == 0) {
    unsigned* bar = b.bar;
    b.x = xb_xcc_id();
    __builtin_amdgcn_s_waitcnt(0);
    unsigned nloc = b.st[0], nx = b.st[1];
    if (nloc == 0u) { xcd_barrier_complete(bar, b.x, nloc, nx); b.st[0] = nloc; b.st[1] = nx; }
    const unsigned old = xb_add(&bar[XB_XSUB(b.x)], 1u);
    const unsigned gen = old / nloc;
    if (old + 1u == (gen + 1u) * nloc) {
      __builtin_amdgcn_fence(__ATOMIC_RELEASE, "agent");
      asm volatile("s_waitcnt vmcnt(0)" ::: "memory");
      const unsigned og = xb_add(&bar[XB_TOP], 1u);
      const unsigned tg = og / nx;
      if (og + 1u == (tg + 1u) * nx) xb_add(&bar[XB_TOPGEN], 1u);
      else XB_SPIN(xb_ld(&bar[XB_TOPGEN]) == tg, bar);
      __builtin_amdgcn_fence(__ATOMIC_ACQUIRE, "agent");
      xb_add(&bar[XB_XGEN(b.x)], 1u);
      asm volatile("s_waitcnt vmcnt(0)" ::: "memory");
    } else {
      XB_SPIN(xb_ld(&bar[XB_XGEN(b.x)]) == gen, bar);
      __builtin_amdgcn_fence(__ATOMIC_ACQUIRE, "agent");
      asm volatile("s_waitcnt vmcnt(0)" ::: "memory");
    }
  }
  __syncthreads();
}

constexpr int GSTR = 72;
constexpr int GBUF = 128 * GSTR;
constexpr int RS_OFF = 135168;
constexpr int SMEM_BYTES = RS_OFF + 4096;

constexpr int G8_HT = 128 * 64;
DI int lds_byte(int r, int c) { const int st = (r >> 4) * 2 + (c >> 5), rr = r & 15, cc = c & 31, ob = rr * 64 + cc * 2; return st * 1024 + (ob ^ (((ob >> 9) & 1) << 5)); }
DI void stage_rc(int b, int& R, int& C) { const int st = b / 1024, sb = b % 1024, swz = sb ^ (((sb >> 9) & 1) << 5); R = (st >> 1) * 16 + swz / 64; C = (st & 1) * 32 + (swz % 64) / 2; }

DI void gemm8_tile(const bf16_t* __restrict__ A, const bf16_t* __restrict__ Bt, const int K, bf16_t* shm, f32x4 (&acc)[2][2][4][2]) {
  const int tid = opaque_tid();
  const int wid = tid >> 6, lane = tid & 63, wr = wid >> 2, wc = wid & 3, fr = lane & 15, fq = lane >> 4;
  const int swz = (fr * 64 + fq * 16) ^ ((fr >> 3) << 5);
  const char* aRd = (const char*)shm + swz + wr * 8192;
  const char* bRd = (const char*)shm + 65536 + swz + wc * 4096;
  int sr0, sc0, sr1, sc1;
  stage_rc(tid * 16, sr0, sc0);
  stage_rc(tid * 16 + 8192, sr1, sc1);
  const unsigned so0 = (unsigned)(sr0 * K + sc0) * 2u, so1 = (unsigned)(sr1 * K + sc1) * 2u;
  char* const stw = (char*)shm + __builtin_amdgcn_readfirstlane(tid & ~63) * 16;
  const char* const Ab = (const char*)A;
  const char* const Bb = (const char*)Bt;
#define SA(b, h) (((b) * 2 + (h)) * 16384)
#define SB(b, h) ((4 + (b) * 2 + (h)) * 16384)
#define STAGE(P, BASE, br, kt) do { const char* g_ = (BASE) + ((long)(br) * K + (long)(kt) * 64) * 2;                        \
    __builtin_amdgcn_global_load_lds((const unsigned*)(g_ + so0), (unsigned*)(stw + (P)), 16, 0, 0);                          \
    __builtin_amdgcn_global_load_lds((const unsigned*)(g_ + so1), (unsigned*)(stw + (P) + 8192), 16, 0, 0); } while (0)
#define LDA(dst, b, h) _Pragma("unroll") for (int m = 0; m < 4; ++m) _Pragma("unroll") for (int k = 0; k < 2; ++k) \
    dst[m][k] = *reinterpret_cast<const bf16x8*>(aRd + ((b) * 2 + (h)) * 16384 + (m * 2 + k) * 1024)
#define LDB(dst, b, h) _Pragma("unroll") for (int n = 0; n < 2; ++n) _Pragma("unroll") for (int k = 0; k < 2; ++k) \
    dst[n][k] = *reinterpret_cast<const bf16x8*>(bRd + ((b) * 2 + (h)) * 16384 + (n * 2 + k) * 1024)
#define MMA(ai, bj, At_, Bt_) do { __builtin_amdgcn_s_setprio(1);                                                          \
    _Pragma("unroll") for (int m = 0; m < 4; ++m) _Pragma("unroll") for (int n = 0; n < 2; ++n) _Pragma("unroll") for (int k = 0; k < 2; ++k) \
      acc[ai][bj][m][n] = __builtin_amdgcn_mfma_f32_16x16x32_bf16(At_[m][k], Bt_[n][k], acc[ai][bj][m][n], 0, 0, 0);       \
    __builtin_amdgcn_s_setprio(0); } while (0)
#define WAIT_V(n) asm volatile("s_waitcnt vmcnt(" #n ")" ::: "memory")
#define WAIT_L(n) asm volatile("s_waitcnt lgkmcnt(" #n ")" ::: "memory")
#define BAR __builtin_amdgcn_s_barrier()
#define SCHED __builtin_amdgcn_sched_barrier(0)
  bf16x8 At[4][2], B0[2][2], B1[2][2];
  const int nt = K / 64;
  STAGE(SB(0, 0), Bb, 0, 0); STAGE(SA(0, 0), Ab, 0, 0);
  STAGE(SB(0, 1), Bb, 128, 0); STAGE(SA(0, 1), Ab, 128, 0);
  if (wr == 1) BAR;
  WAIT_V(4); BAR;
  STAGE(SB(1, 0), Bb, 0, 1); STAGE(SA(1, 0), Ab, 0, 1); STAGE(SB(1, 1), Bb, 128, 1);
  WAIT_V(6); BAR;
  for (int t = 0; t < nt - 2; t += 2) {
    LDB(B0, 0, 0); SCHED; LDA(At, 0, 0); STAGE(SA(1, 1), Ab, 128, t + 1);
    WAIT_L(8); BAR; WAIT_L(0); MMA(0, 0, At, B0); BAR; SCHED;
    LDB(B1, 0, 1); STAGE(SB(0, 0), Bb, 0, t + 2);
    BAR; WAIT_L(0); MMA(0, 1, At, B1); BAR;
    LDA(At, 0, 1); STAGE(SA(0, 0), Ab, 0, t + 2);
    BAR; WAIT_L(0); MMA(1, 0, At, B0); BAR; SCHED;
    STAGE(SB(0, 1), Bb, 128, t + 2);
    WAIT_V(6); BAR; MMA(1, 1, At, B1); BAR;
    LDB(B0, 1, 0); SCHED; LDA(At, 1, 0); STAGE(SA(0, 1), Ab, 128, t + 2);
    WAIT_L(8); BAR; WAIT_L(0); MMA(0, 0, At, B0); BAR; SCHED;
    LDB(B1, 1, 1); STAGE(SB(1, 0), Bb, 0, t + 3);
    BAR; WAIT_L(0); MMA(0, 1, At, B1); BAR;
    LDA(At, 1, 1); STAGE(SA(1, 0), Ab, 0, t + 3);
    BAR; WAIT_L(0); MMA(1, 0, At, B0); BAR; SCHED;
    STAGE(SB(1, 1), Bb, 128, t + 3);
    WAIT_V(6); BAR; MMA(1, 1, At, B1); BAR;
  }
  { LDB(B0, 0, 0); LDA(At, 0, 0); STAGE(SA(1, 1), Ab, 128, nt - 1);
    BAR; WAIT_L(0); MMA(0, 0, At, B0); BAR;
    LDB(B1, 0, 1); BAR; WAIT_L(0); MMA(0, 1, At, B1); BAR;
    LDA(At, 0, 1); WAIT_V(4); BAR; WAIT_L(0); MMA(1, 0, At, B0); MMA(1, 1, At, B1); BAR; }
  { LDB(B0, 1, 0); LDA(At, 1, 0); WAIT_V(2); BAR; WAIT_L(0); MMA(0, 0, At, B0); BAR;
    LDB(B1, 1, 1); WAIT_V(0); BAR; WAIT_L(0); MMA(0, 1, At, B1); BAR;
    LDA(At, 1, 1); BAR; WAIT_L(0); MMA(1, 0, At, B0); MMA(1, 1, At, B1); BAR; }
  if (wr == 0) BAR;
#undef SA
#undef SB
#undef STAGE
#undef LDA
#undef LDB
#undef MMA
#undef WAIT_V
#undef WAIT_L
#undef BAR
#undef SCHED
}


DI void zero_acc8(f32x4 (&acc)[2][2][4][2]) {
#pragma unroll
  for (int a = 0; a < 2; ++a)
#pragma unroll
    for (int b = 0; b < 2; ++b)
#pragma unroll
      for (int m = 0; m < 4; ++m)
#pragma unroll
        for (int n = 0; n < 2; ++n) acc[a][b][m][n] = f32x4{0.f, 0.f, 0.f, 0.f};
}

constexpr int CSTR = 132;
DI void accq_to_lds(const f32x4 (&q)[4][2], float* sC) {
  const int tid = opaque_tid(), wid = tid >> 6, lane = tid & 63, wr = wid >> 2, wc = wid & 3, fr = lane & 15, fq = lane >> 4;
#pragma unroll
  for (int m = 0; m < 4; ++m)
#pragma unroll
    for (int n = 0; n < 2; ++n)
#pragma unroll
      for (int j = 0; j < 4; ++j) sC[(wr * 64 + m * 16 + fq * 4 + j) * CSTR + wc * 32 + n * 16 + fr] = q[m][n][j];
}
constexpr int SC2_OFF = 128 * CSTR;
template <class EPI>
DI void tile_epilogue2(const f32x4 (&acc)[2][2][4][2], float* sC, EPI epi) {
  __syncthreads();
  accq_to_lds(acc[0][0], sC);
  __syncthreads();
  accq_to_lds(acc[0][1], sC + SC2_OFF);
  epi(0, sC);
  __syncthreads();
  accq_to_lds(acc[1][0], sC);
  epi(1, sC + SC2_OFF);
  __syncthreads();
  accq_to_lds(acc[1][1], sC + SC2_OFF);
  epi(2, sC);
  __syncthreads();
  epi(3, sC + SC2_OFF);
  __syncthreads();
}

template <class F>
DI void epi_rows(const float* sC, F f) {
  const int tx = opaque_tid();
#pragma unroll
  for (int i = 0; i < 4; ++i) {
    const int c = tx + 512 * i, row = c >> 4, cc = (c & 15) * 8;
    const float4 a = *(const float4*)(sC + row * CSTR + cc), b = *(const float4*)(sC + row * CSTR + cc + 4);
    const float v[8] = {a.x, a.y, a.z, a.w, b.x, b.y, b.z, b.w};
    f(i, row, cc, v);
  }
}
DI void store8(bf16_t* p, const float (&v)[8]) { *(bf16x8*)p = pack8(v[0], v[1], v[2], v[3], v[4], v[5], v[6], v[7]); }
DI void store8_nt(bf16_t* p, const float (&v)[8]) { __builtin_nontemporal_store(pack8(v[0], v[1], v[2], v[3], v[4], v[5], v[6], v[7]), (bf16x8*)p); }
DI void epi_vt(const float* sC, bf16_t* VT, int m0, int head0, int c0, int ncol_log2) {
  const int b = m0 >> 12, s0 = m0 & 4095;
  const int nitems = 16 << ncol_log2;
  for (int c = opaque_tid(); c < nitems; c += 512) {
    const int col = c & ((1 << ncol_log2) - 1), rc = c >> ncol_log2;
    float v[8];
#pragma unroll
    for (int j = 0; j < 8; ++j) v[j] = sC[(rc * 8 + j) * CSTR + c0 + col];
    const int head = head0 + (col >> 6), d = col & 63;
    store8(VT + ((size_t)((b * 8 + head) * 64 + d)) * SEQL + s0 + rc * 8, v);
  }
}
DI void rope8(const float* sC, const float* ROPE, int tok, int row, int cc, float (&v)[8]) {
  const float* pr = sC + row * CSTR + (cc ^ 16);
  const bool upper = (cc & 16) != 0;
  const int f0 = cc & 15;
  const float* tb = ROPE + (size_t)tok * 32;
#pragma unroll
  for (int j = 0; j < 8; ++j) {
    const float o = pr[j], cs = tb[f0 + j], sn = tb[16 + f0 + j];
    v[j] = upper ? (o * sn + v[j] * cs) : (v[j] * cs - o * sn);
  }
}

DI void wconv_unit(const float* __restrict__ src, int Nsrc, int K, bf16_t* __restrict__ dst, const float* __restrict__ gain, int ng, int kg, int mode, float* tile, const int tid) {
  {
    const int k = tid >> 2, cq = tid & 3;
    const int n = ng * 64 + cq * 16;
    int sc = n;
    if (mode == 1) { sc = (n < 2688) ? n : (n < 5248 ? n + 32 : (n < 5280 ? n - 2560 : -1)); }
    const int kk = kg * 64 + k;
    float4 v[4];
    if (sc >= 0) {
      const float* sp = src + (size_t)kk * Nsrc + sc;
#pragma unroll
      for (int i = 0; i < 4; ++i) v[i] = *(const float4*)(sp + 4 * i);
      if (gain) { const float g = gain[kk];
#pragma unroll
        for (int i = 0; i < 4; ++i) { v[i].x *= g; v[i].y *= g; v[i].z *= g; v[i].w *= g; } }
    } else {
#pragma unroll
      for (int i = 0; i < 4; ++i) v[i] = make_float4(0.f, 0.f, 0.f, 0.f);
    }
    float* tp = tile + k * 65 + cq * 16;
#pragma unroll
    for (int i = 0; i < 4; ++i) { tp[4 * i] = v[i].x; tp[4 * i + 1] = v[i].y; tp[4 * i + 2] = v[i].z; tp[4 * i + 3] = v[i].w; }
  }
  __syncthreads();
  {
    const int n = tid >> 2, kc = tid & 3;
    float o[16];
#pragma unroll
    for (int j = 0; j < 16; ++j) o[j] = tile[(kc * 16 + j) * 65 + n];
    bf16_t* dp = dst + (size_t)(ng * 64 + n) * K + kg * 64 + kc * 16;
    *(bf16x8*)dp = pack8(o[0], o[1], o[2], o[3], o[4], o[5], o[6], o[7]);
    *(bf16x8*)(dp + 8) = pack8(o[8], o[9], o[10], o[11], o[12], o[13], o[14], o[15]);
  }
  __syncthreads();
}

DI void phase_prep(const Params& p, char* smem) {
  if (blockIdx.x == 0 && threadIdx.x < 16) { p.counter()[threadIdx.x] = 0; }
  for (int i = blockIdx.x * NTHREADS + threadIdx.x; i < 2 * NTOK; i += gridDim.x * NTHREADS) p.SSQ()[i] = 0.f;
  const int half = threadIdx.x >> 8, tid = threadIdx.x & 255;
  constexpr int U_MOD = 96 * 4, U_WIN = 84 * 16, U_WUQ = 12 * 6, U_WUKV = 16 * 4, U_WA = 16 * 8, U_WB = 16 * 8, U_WO = 16 * 16, U_ROPE = 1024;
  constexpr int U_TOTAL = U_MOD + U_ROPE + U_WIN + U_WUQ + U_WUKV + U_WA + U_WB + U_WO;
  float* tile = (float*)smem + half * (64 * 65 + 64);
  for (int up = blockIdx.x; up < U_TOTAL / 2; up += gridDim.x) {
    int v = 2 * up + half;
    if (v < U_MOD) {
      const int cg32 = v >> 2, kq = v & 3, n0 = cg32 * 32;
      const int kgp = tid >> 5, col = tid & 31;
      const int kb = kq * 256 + kgp * 32;
      float a0 = 0.f, a1 = 0.f, a2 = 0.f, a3 = 0.f;
      const float* wp = p.w_ada + (size_t)kb * 3072 + n0 + col;
      float wv[32];
#pragma unroll
      for (int kk = 0; kk < 32; ++kk) wv[kk] = wp[(size_t)kk * 3072];
#pragma unroll
      for (int kk = 0; kk < 32; ++kk) {
        a0 += wv[kk] * p.c[kb + kk]; a1 += wv[kk] * p.c[1024 + kb + kk]; a2 += wv[kk] * p.c[2048 + kb + kk]; a3 += wv[kk] * p.c[3072 + kb + kk];
      }
      float* red = (float*)smem + half * 1024;
      red[(kgp * 4 + 0) * 32 + col] = a0; red[(kgp * 4 + 1) * 32 + col] = a1; red[(kgp * 4 + 2) * 32 + col] = a2; red[(kgp * 4 + 3) * 32 + col] = a3;
      __syncthreads();
      if (tid < 128) {
        const int b = tid >> 5, cc = tid & 31;
        float s = (kq == 0) ? p.b_ada[n0 + cc] : 0.f;
#pragma unroll
        for (int g = 0; g < 8; ++g) s += red[(g * 4 + b) * 32 + cc];
        p.MOD()[(size_t)(b * 3072 + n0 + cc) * 4 + kq] = s;
      }
      __syncthreads();
      continue;
    }
    v -= U_MOD;
    if (v < U_WIN) { wconv_unit(p.w_in, INW, 1024, p.WinT(), nullptr, v >> 4, v & 15, 1, tile, tid); continue; }
    v -= U_WIN;
    if (v < U_WUQ) { wconv_unit(p.w_uq, 768, 384, p.WuqT(), p.q_gain, v / 6, v % 6, 0, tile, tid); continue; }
    v -= U_WUQ;
    if (v < U_WUKV) { wconv_unit(p.w_ukv, 1024, 256, p.WukvT(), p.kv_gain, v >> 2, v & 3, 0, tile, tid); continue; }
    v -= U_WUKV;
    if (v < U_WA) { wconv_unit(p.w_a, 1024, 512, p.WaT(), nullptr, v >> 3, v & 7, 0, tile, tid); continue; }
    v -= U_WA;
    if (v < U_WB) { wconv_unit(p.w_b, 1024, 512, p.WbT(), nullptr, v >> 3, v & 7, 0, tile, tid); continue; }
    v -= U_WB;
    if (v < U_WO) { wconv_unit(p.w_out, 1024, 1024, p.WoT(), nullptr, v >> 4, v & 15, 0, tile, tid); continue; }
    v -= U_WO;
    {
      const int idx = v * 256 + tid, tok = idx >> 4, i = idx & 15;
      const float ang = (float)p.pos[tok] * c_invfreq[i];
      double t = (double)ang * 0.15915494309189535;
      t -= rint(t);
      const float tf = (float)t;
      p.ROPE()[(size_t)tok * 32 + i] = __builtin_amdgcn_cosf(tf);
      p.ROPE()[(size_t)tok * 32 + 16 + i] = __builtin_amdgcn_sinf(tf);
    }
  }
}

DI float mod_get(const float* MOD, int b, int n) { const float4 q = *(const float4*)(MOD + (size_t)(b * 3072 + n) * 4); return (q.x + q.y) + (q.z + q.w); }

DI void phase_h(const Params& p, char* smem) {
  const int tid = opaque_tid(), lane = tid & 63, w = tid >> 6;
  float* gs = (float*)smem;
  float* sh = gs + 1024;
  const int xq = blockIdx.x & 7, lb = blockIdx.x >> 3, nlb = gridDim.x >> 3;
  const bool xmap = (gridDim.x & 7) == 0;
  for (int rgi = xmap ? lb : (int)blockIdx.x; rgi < (xmap ? 32 : NTOK / 64); rgi += (xmap ? nlb : (int)gridDim.x)) {
    const int rg = xmap ? (32 * xq + rgi) : rgi;
    const int b = (rg * 64) >> 12;
    __syncthreads();
#pragma unroll
    for (int i = 0; i < 2; ++i) {
      const int k = tid + 512 * i;
      gs[k] = p.norm_gain[k] * (1.f + mod_get(p.MOD(), b, 1024 + k));
      sh[k] = mod_get(p.MOD(), b, k);
    }
    __syncthreads();
#pragma unroll 2
    for (int rr = 0; rr < 8; ++rr) {
      const int row = rg * 64 + w * 8 + rr;
      const float* xr = p.x + (size_t)row * DM;
      float4 v[4];
      float ss = 0.f;
#pragma unroll
      for (int i = 0; i < 2; ++i) {
        const int e = 8 * (lane + 64 * i);
        v[2 * i] = *(const float4*)(xr + e);
        v[2 * i + 1] = *(const float4*)(xr + e + 4);
        ss += v[2 * i].x * v[2 * i].x + v[2 * i].y * v[2 * i].y + v[2 * i].z * v[2 * i].z + v[2 * i].w * v[2 * i].w;
        ss += v[2 * i + 1].x * v[2 * i + 1].x + v[2 * i + 1].y * v[2 * i + 1].y + v[2 * i + 1].z * v[2 * i + 1].z + v[2 * i + 1].w * v[2 * i + 1].w;
      }
#pragma unroll
      for (int o = 32; o >= 1; o >>= 1) ss += __shfl_xor(ss, o);
      const float rn = __builtin_amdgcn_rsqf(ss * (1.f / DM) + EPSN);
#pragma unroll
      for (int i = 0; i < 2; ++i) {
        const int e = 8 * (lane + 64 * i);
        const float4 g0 = *(const float4*)(gs + e), g1 = *(const float4*)(gs + e + 4);
        const float4 s0 = *(const float4*)(sh + e), s1 = *(const float4*)(sh + e + 4);
        *(bf16x8*)(p.Hb() + (size_t)row * DM + e) =
            pack8(v[2 * i].x * rn * g0.x + s0.x, v[2 * i].y * rn * g0.y + s0.y, v[2 * i].z * rn * g0.z + s0.z, v[2 * i].w * rn * g0.w + s0.w,
                  v[2 * i + 1].x * rn * g1.x + s1.x, v[2 * i + 1].y * rn * g1.y + s1.y, v[2 * i + 1].z * rn * g1.z + s1.z, v[2 * i + 1].w * rn * g1.w + s1.w);
      }
    }
  }
  __syncthreads();
}

DI void g1_epi(const Params& p, const float* sC, const int m0, const int n0, const int ct, const bool do_ssq) {
    if (ct < 4) {
      epi_rows(sC, [&](int, int row, int cc, const float (&v)[8]) {
        float o[8];
#pragma unroll
        for (int j = 0; j < 8; ++j) o[j] = v[j] * QS_SCALE;
        store8(p.Qsb() + (size_t)(m0 + row) * 512 + n0 + cc, o); });
    } else if (ct < 8) {
      epi_rows(sC, [&](int, int row, int cc, const float (&v)[8]) { store8(p.Ksb() + (size_t)(m0 + row) * 512 + n0 - 512 + cc, v); });
    } else if (ct < 12) {
      epi_vt(sC, p.VTsb(), m0, (n0 - 1024) >> 6, 0, 7);
    } else if (ct < 16) {
      epi_rows(sC, [&](int, int row, int cc, const float (&v)[8]) {
        float o[8];
#pragma unroll
        for (int j = 0; j < 8; ++j) o[j] = siluf_fast(v[j]);
        store8(p.Zsb() + (size_t)(m0 + row) * 512 + n0 - 1536 + cc, o); });
    } else if (ct < 19) {
      epi_rows(sC, [&](int, int row, int cc, const float (&v)[8]) {
        store8(p.CQ() + (size_t)(m0 + row) * 384 + n0 - 2048 + cc, v);
        float q = 0.f;
#pragma unroll
        for (int j = 0; j < 8; ++j) q += v[j] * v[j];
        q += __shfl_xor(q, 1); q += __shfl_xor(q, 2); q += __shfl_xor(q, 4); q += __shfl_xor(q, 8);
        if (do_ssq && (threadIdx.x & 15) == 0) atomicAdd(p.SSQ() + m0 + row, q); });
    } else if (ct < 21) {
      epi_rows(sC, [&](int, int row, int cc, const float (&v)[8]) {
        store8(p.CKV() + (size_t)(m0 + row) * 256 + n0 - 2432 + cc, v);
        float q = 0.f;
#pragma unroll
        for (int j = 0; j < 8; ++j) q += v[j] * v[j];
        q += __shfl_xor(q, 1); q += __shfl_xor(q, 2); q += __shfl_xor(q, 4); q += __shfl_xor(q, 8);
        if (do_ssq && (threadIdx.x & 15) == 0) atomicAdd(p.SSQ() + NTOK + m0 + row, q); });
    } else if (ct < 25) {
      epi_rows(sC, [&](int, int row, int cc, const float (&v)[8]) {
        float o[8];
#pragma unroll
        for (int j = 0; j < 8; ++j) o[j] = siluf_fast(v[j]);
        store8(p.Zmla() + (size_t)(m0 + row) * 512 + n0 - 2688 + cc, o); });
    } else if (ct < 33) {
      epi_rows(sC, [&](int, int row, int cc, const float (&v)[8]) {
        float o[8];
#pragma unroll
        for (int j = 0; j < 8; ++j) o[j] = sigmoidf_fast(v[j]);
        store8_nt(p.GA() + (size_t)(m0 + row) * 1024 + n0 - 3200 + cc, o); });
    } else if (ct < 41) {
      epi_rows(sC, [&](int, int row, int cc, const float (&v)[8]) {
        float o[8];
#pragma unroll
        for (int j = 0; j < 8; ++j) o[j] = sigmoidf_fast(v[j]);
        store8_nt(p.GB() + (size_t)(m0 + row) * 1024 + n0 - 4224 + cc, o); });
    } else {
      epi_rows(sC, [&](int, int row, int cc, const float (&v)[8]) {
        if (cc < 32) {
          float o[8];
#pragma unroll
          for (int j = 0; j < 8; ++j) o[j] = v[j];
          rope8(sC, p.ROPE(), m0 + row, row, cc, o);
          store8(p.KPE() + (size_t)(m0 + row) * 32 + cc, o);
        } });
    }
}

DI void g1_tile(const Params& p, char* smem, const int rt, const int ct2, const bool do_ssq) {
  bf16_t* shm = (bf16_t*)smem;
  float* sC = (float*)smem;
  const int m0 = rt * 256, n0 = ct2 * 256;
  f32x4 acc[2][2][4][2];
  zero_acc8(acc);
  gemm8_tile(p.Hb() + (size_t)m0 * DM, p.WinT() + (size_t)n0 * DM, DM, shm, acc);
  tile_epilogue2(acc, sC, [&](const int qd, const float* sq) {
    g1_epi(p, sq, m0 + (qd >> 1) * 128, n0 + (qd & 1) * 128, ct2 * 2 + (qd & 1), do_ssq); });
}

constexpr int G1_NCT = 20;
DI void phase_g1(const Params& p, char* smem, bool do_ssq = true) {
  const int xq = blockIdx.x & 7, lb = blockIdx.x >> 3, nlb = gridDim.x >> 3;
  const bool xmap = (gridDim.x & 7) == 0;
  for (int t = xmap ? lb : (int)blockIdx.x; t < (xmap ? 8 * G1_NCT : 64 * G1_NCT); t += (xmap ? nlb : (int)gridDim.x)) {
    int rt, ct2;
    if (xmap) { ct2 = t >> 3; rt = 8 * xq + (t & 7); } else { rt = t / G1_NCT; ct2 = t % G1_NCT; }
    g1_tile(p, smem, rt, ct2, do_ssq);
  }
}

DI void g2_epi_q(const Params& p, const float* sC, const float* rsq, const int m0, const int n0) {
  epi_rows(sC, [&](int, int row, int cc, const float (&v)[8]) {
    const int col = n0 + cc;
    float o[8];
#pragma unroll
    for (int j = 0; j < 8; ++j) o[j] = v[j];
    if (((col >> 5) % 3) == 2) rope8(sC, p.ROPE(), m0 + row, row, cc, o);
    const float sc = rsq[row] * QM_SCALE;
#pragma unroll
    for (int j = 0; j < 8; ++j) o[j] *= sc;
    store8(p.Qmla() + (size_t)(m0 + row) * 768 + col, o);
  });
}
DI void g2_epi_kv(const Params& p, const float* sC, const float* rsq, const int m0, const int head) {
  epi_rows(sC, [&](int, int row, int cc, const float (&v)[8]) {
    if (cc < 64) {
      const float sc = rsq[row];
      float o[8];
#pragma unroll
      for (int j = 0; j < 8; ++j) o[j] = v[j] * sc;
      store8(p.Knope() + (size_t)(m0 + row) * 512 + head * 64 + cc, o);
    } });
  const int b = m0 >> 12, s0 = m0 & 4095;
  for (int c = opaque_tid(); c < 1024; c += 512) {
    const int col = c & 63, rc = c >> 6;
    float v[8];
#pragma unroll
    for (int j = 0; j < 8; ++j) v[j] = sC[(rc * 8 + j) * CSTR + 64 + col] * rsq[rc * 8 + j];
    store8(p.VTmla() + ((size_t)((b * 8 + head) * 64 + col)) * SEQL + s0 + rc * 8, v);
  }
}

DI void g2_tile(const Params& p, char* smem, const bool isq, const int rt, const int ct) {
  bf16_t* shm = (bf16_t*)smem;
  float* sC = (float*)smem;
  float* rs = (float*)(smem + RS_OFF);
  const int m0 = rt * 256, n0 = ct * 256;
  f32x4 acc[2][2][4][2];
  zero_acc8(acc);
  if (isq) {
    if (threadIdx.x < 256) rs[threadIdx.x] = __builtin_amdgcn_rsqf(p.SSQ()[m0 + threadIdx.x] * (1.f / 384.f) + EPSN);
    gemm8_tile(p.CQ() + (size_t)m0 * 384, p.WuqT() + (size_t)n0 * 384, 384, shm, acc);
    tile_epilogue2(acc, sC, [&](const int qd, const float* sq) {
      g2_epi_q(p, sq, rs + (qd >> 1) * 128, m0 + (qd >> 1) * 128, n0 + (qd & 1) * 128); });
  } else {
    if (threadIdx.x < 256) rs[threadIdx.x] = __builtin_amdgcn_rsqf(p.SSQ()[NTOK + m0 + threadIdx.x] * (1.f / 256.f) + EPSN);
    gemm8_tile(p.CKV() + (size_t)m0 * 256, p.WukvT() + (size_t)n0 * 256, 256, shm, acc);
    tile_epilogue2(acc, sC, [&](const int qd, const float* sq) {
      g2_epi_kv(p, sq, rs + (qd >> 1) * 128, m0 + (qd >> 1) * 128, ct * 2 + (qd & 1)); });
  }
  __syncthreads();
}

DI void phase_g2(const Params& p, char* smem) {
  const int xq = blockIdx.x & 7, lb = blockIdx.x >> 3, nlb = gridDim.x >> 3;
  if ((gridDim.x & 7) == 0 && nlb == 32) {
    if (lb < 8) {
      g1_tile(p, smem, 8 * xq + lb, G1_NCT, false);
      const int v2 = 24 + lb;
      g2_tile(p, smem, false, 8 * xq + (v2 & 7), v2 >> 3);
      return;
    }
    const int v = lb - 8;
    g2_tile(p, smem, true, 8 * xq + (v & 7), v >> 3);
    g2_tile(p, smem, false, 8 * xq + (v & 7), v >> 3);
  } else {
    for (int tt = blockIdx.x; tt < 64 + 192 + 256; tt += gridDim.x) {
      if (tt < 64) g1_tile(p, smem, tt, G1_NCT, false);
      else if (tt < 256) { const int v = tt - 64; g2_tile(p, smem, true, v / 3, v % 3); }
      else { const int v = tt - 256; g2_tile(p, smem, false, v >> 2, v & 3); }
    }
  }
}

constexpr int VSTR = 68;

template <bool MLA>
DI void attn_item(const Params& p, int b, int h, int qb, char* smem, int* pre_ctr, int& pre_raw) {
  constexpr int DK = MLA ? 96 : 64;
  constexpr int KSTR = MLA ? 104 : 72;
  constexpr int NKS = DK / 16;
  bf16_t* sK = (bf16_t*)smem;
  bf16_t* sV = sK + 2 * 64 * KSTR;
  const int tid = threadIdx.x, lane = tid & 63, w = tid >> 6, r = lane & 31, hh = lane >> 5;
  const int tokb = b * SEQL;
  const int tok0 = tokb + qb * 256;
  const int qw = qb * 256 + w * 32;

  bf16x8 qf[NKS];
  {
    const bf16_t* qptr = MLA ? (p.Qmla() + (size_t)(tok0 + w * 32 + r) * 768 + h * 96 + hh * 8) : (p.Qsb() + (size_t)(tok0 + w * 32 + r) * 512 + h * 64 + hh * 8);
#pragma unroll
    for (int ks = 0; ks < NKS; ++ks) qf[ks] = *(const bf16x8*)(qptr + ks * 16);
  }
  u32x2* zbuf = (u32x2*)(smem + 65536);
  u32x2 zpre[8];
  {
    const bf16_t* zg0 = (MLA ? p.Zmla() : p.Zsb()) + (size_t)(tok0 + w * 32 + r) * 512 + h * 64 + 4 * hh;
#pragma unroll
    for (int i = 0; i < 8; ++i) zpre[i] = *(const u32x2*)(zg0 + (i >> 2) * 32 + 8 * (i & 3));
  }
  bf16x8 tf[2];
  if (!MLA) {
#pragma unroll
    for (int st = 0; st < 2; ++st)
#pragma unroll
      for (int e = 0; e < 8; ++e) { const int j = 16 * st + 8 * (e >> 2) + 4 * hh + (e & 3); tf[st][e] = (j >= r) ? (short)0x3F80 : (short)0; }
  }

  f32x16 oacc[2];
#pragma unroll
  for (int i = 0; i < 16; ++i) { oacc[0][i] = 0.f; oacc[1][i] = 0.f; }
  float carry = 0.f;
  float mrun = 0.f, lrun = 0.f;

  const bf16_t* Kg = MLA ? p.Knope() : p.Ksb();
  const bf16_t* VTg = (MLA ? p.VTmla() : p.VTsb()) + (size_t)((b * 8 + h) * 64) * SEQL;
  const int nt = 4 * qb + 4;

  uint4 xk0, xv0, xp, yk0, yv0, yp;
  xp = make_uint4(0, 0, 0, 0); yp = xp;
  const int prow = tid >> 3, pch = tid & 7;
  const bf16_t* kgp = Kg + (size_t)(tokb + prow) * 512 + h * 64 + pch * 8;
  const bf16_t* vgp = VTg + (size_t)prow * SEQL + pch * 8;
  const bf16_t* pgp = p.KPE() + (size_t)(tokb + ((tid & 255) >> 2)) * 32 + (tid & 3) * 8;
#define ATT_GLOAD(P, kt_)                                                          \
  {                                                                                \
    const int kt__ = (kt_);                                                        \
    P##k0 = *(const uint4*)(kgp + (size_t)(kt__ * 64) * 512);                      \
    P##v0 = *(const uint4*)(vgp + kt__ * 64);                                      \
    if (MLA && tid < 256) P##p = *(const uint4*)(pgp + (size_t)(kt__ * 64) * 32);  \
  }
#define ATT_SWRITE(P, buf_)                                                        \
  {                                                                                \
    bf16_t* dK = sK + (buf_) * 64 * KSTR;                                          \
    bf16_t* dV = sV + (buf_) * 64 * VSTR;                                          \
    *(uint4*)(dK + prow * KSTR + pch * 8) = P##k0;                                 \
    uint2* dv0 = (uint2*)(dV + prow * VSTR + pch * 8);                             \
    dv0[0] = make_uint2(P##v0.x, P##v0.y); dv0[1] = make_uint2(P##v0.z, P##v0.w);  \
    if (MLA && tid < 256) *(uint4*)(dK + (tid >> 2) * KSTR + 64 + (tid & 3) * 8) = P##p; \
  }
#define ATT_KT(i_) (MLA ? (i_) : (nt - 1 - (i_)))

  ATT_GLOAD(x, ATT_KT(0));
  ATT_GLOAD(y, ATT_KT(1));
  ATT_SWRITE(x, 0);
#pragma unroll
  for (int i = 0; i < 8; ++i) zbuf[i * 512 + tid] = zpre[i];
  __syncthreads();
  bool alive = true;
  for (int it0 = 0; alive; it0 += 2) {
#pragma unroll
   for (int half = 0; half < 2; ++half) {
    const int it = it0 + half;
    const int kt = ATT_KT(it);
    const int cur = half;
    const bool more = (it + 1 < nt);
    if (it + 2 < nt) { if (half == 0) ATT_GLOAD(x, ATT_KT(it + 2)) else ATT_GLOAD(y, ATT_KT(it + 2)) }
    const bf16_t* cK = sK + cur * 64 * KSTR;
    const bf16_t* cV = sV + cur * 64 * VSTR;
    if (MLA) {
      if (kt * 64 <= qw + 31) {
        f32x16 s0, s1;
        {
          const float sinit = -mrun;
#pragma unroll
          for (int i = 0; i < 16; ++i) { s0[i] = sinit; s1[i] = sinit; }
        }
        __builtin_amdgcn_s_setprio(1);
#pragma unroll
        for (int ks = 0; ks < NKS; ++ks) {
          const bf16x8 k0 = *(const bf16x8*)(cK + r * KSTR + ks * 16 + hh * 8);
          const bf16x8 k1 = *(const bf16x8*)(cK + (32 + r) * KSTR + ks * 16 + hh * 8);
          s0 = MFMA(k0, qf[ks], s0);
          s1 = MFMA(k1, qf[ks], s1);
        }
        __builtin_amdgcn_s_setprio(0);
        if (kt * 64 + 63 > qw) {
          const int lim = qw + r - kt * 64;
#pragma unroll
          for (int i = 0; i < 16; ++i) { if (crow(i, hh) > lim) s0[i] = -1e30f; if (32 + crow(i, hh) > lim) s1[i] = -1e30f; }
        }
        float m0 = fmaxf(fmaxf(s0[0], s0[1]), s0[2]), m1 = fmaxf(fmaxf(s1[0], s1[1]), s1[2]);
#pragma unroll
        for (int i = 3; i < 15; i += 2) { m0 = fmaxf(fmaxf(m0, s0[i]), s0[i + 1]); m1 = fmaxf(fmaxf(m1, s1[i]), s1[i + 1]); }
        float mloc = fmaxf(fmaxf(m0, s0[15]), fmaxf(m1, s1[15]));
        mloc = half_max(mloc);
        const bool first = (it == 0);
        const float delta = first ? mloc : fmaxf(mloc, 0.f);
        if (first || __builtin_amdgcn_ballot_w64(delta > 0.f) != 0ull) {
          const float alpha = first ? 0.f : __builtin_amdgcn_exp2f(-delta);
          mrun += delta;
          lrun *= alpha;
#pragma unroll
          for (int i = 0; i < 16; ++i) { oacc[0][i] *= alpha; oacc[1][i] *= alpha; s0[i] -= delta; s1[i] -= delta; }
        }
        float ps0 = 0.f, ps1 = 0.f;
#pragma unroll
        for (int i = 0; i < 16; ++i) { s0[i] = __builtin_amdgcn_exp2f(s0[i]); s1[i] = __builtin_amdgcn_exp2f(s1[i]); ps0 += s0[i]; ps1 += s1[i]; }
        lrun += ps0 + ps1;
        bf16x8 pf4[4];
        pf4[0] = pack8(s0[0], s0[1], s0[2], s0[3], s0[4], s0[5], s0[6], s0[7]);
        pf4[1] = pack8(s0[8], s0[9], s0[10], s0[11], s0[12], s0[13], s0[14], s0[15]);
        pf4[2] = pack8(s1[0], s1[1], s1[2], s1[3], s1[4], s1[5], s1[6], s1[7]);
        pf4[3] = pack8(s1[8], s1[9], s1[10], s1[11], s1[12], s1[13], s1[14], s1[15]);
        __builtin_amdgcn_s_setprio(1);
#pragma unroll
        for (int st = 0; st < 4; ++st)
#pragma unroll
          for (int dt = 0; dt < 2; ++dt) {
            const bf16_t* vp = cV + (dt * 32 + r) * VSTR + st * 16 + 4 * hh;
            const s16x4 lo = *(const s16x4*)vp;
            const s16x4 hi = *(const s16x4*)(vp + 8);
            const bf16x8 vf = __builtin_shufflevector(lo, hi, 0, 1, 2, 3, 4, 5, 6, 7);
            oacc[dt] = MFMA(vf, pf4[st], oacc[dt]);
          }
        __builtin_amdgcn_s_setprio(0);
      }
    } else
#pragma unroll
    for (int si = 0; si < 2; ++si) {
      const int sub = MLA ? si : (1 - si);
      const int kb = kt * 64 + sub * 32;
      if (kb > qw) continue;
      const bool diag = (kb == qw);
      f32x16 s;
      {
        const float sinit = MLA ? -mrun : 0.f;
#pragma unroll
        for (int i = 0; i < 16; ++i) s[i] = sinit;
      }
      __builtin_amdgcn_s_setprio(1);
#pragma unroll
      for (int ks = 0; ks < NKS; ++ks) {
        const bf16x8 kf = *(const bf16x8*)(cK + (sub * 32 + r) * KSTR + ks * 16 + hh * 8);
        s = MFMA(kf, qf[ks], s);
      }
      __builtin_amdgcn_s_setprio(0);
      bf16x8 pf[2];
      if (!MLA) {
        float sp[16];
        float tsum = 0.f;
#pragma unroll
        for (int i = 0; i < 16; ++i) {
          const float z = s[i];
          float v = __builtin_amdgcn_logf(1.f + __builtin_amdgcn_exp2f(fminf(z, 126.f)));
          if (diag && !(crow(i, hh) < r)) v = 0.f;
          sp[i] = v;
          tsum += v;
        }
        f32x16 cacc;
#pragma unroll
        for (int i = 0; i < 16; ++i) cacc[i] = carry;
        cacc = MFMA(tf[0], pack8(sp[0], sp[1], sp[2], sp[3], sp[4], sp[5], sp[6], sp[7]), cacc);
        cacc = MFMA(tf[1], pack8(sp[8], sp[9], sp[10], sp[11], sp[12], sp[13], sp[14], sp[15]), cacc);
        float pr[16];
#pragma unroll
        for (int i = 0; i < 16; ++i) {
          float v = __builtin_amdgcn_exp2f(s[i] - cacc[i]);
          if (diag && !(crow(i, hh) < r)) v = 0.f;
          pr[i] = v;
        }
        carry += half_sum(tsum);
        pf[0] = pack8(pr[0], pr[1], pr[2], pr[3], pr[4], pr[5], pr[6], pr[7]);
        pf[1] = pack8(pr[8], pr[9], pr[10], pr[11], pr[12], pr[13], pr[14], pr[15]);
      } else {
        if (diag) {
#pragma unroll
          for (int i = 0; i < 16; ++i) if (!(crow(i, hh) <= r)) s[i] = -1e30f;
        }
        float mloc = fmaxf(fmaxf(s[0], s[1]), s[2]);
#pragma unroll
        for (int i = 3; i < 15; i += 2) mloc = fmaxf(fmaxf(mloc, s[i]), s[i + 1]);
        mloc = fmaxf(mloc, s[15]);
        mloc = half_max(mloc);
        const bool first = (it == 0) && (si == 0);
        const float delta = first ? mloc : fmaxf(mloc, 0.f);
        if (first || __builtin_amdgcn_ballot_w64(delta > 0.f) != 0ull) {
          const float alpha = first ? 0.f : __builtin_amdgcn_exp2f(-delta);
          mrun += delta;
          lrun *= alpha;
#pragma unroll
          for (int i = 0; i < 16; ++i) { oacc[0][i] *= alpha; oacc[1][i] *= alpha; s[i] -= delta; }
        }
        float pr[16];
        float ps0 = 0.f, ps1 = 0.f;
#pragma unroll
        for (int i = 0; i < 16; i += 2) { pr[i] = __builtin_amdgcn_exp2f(s[i]); pr[i + 1] = __builtin_amdgcn_exp2f(s[i + 1]); ps0 += pr[i]; ps1 += pr[i + 1]; }
        lrun += ps0 + ps1;
        pf[0] = pack8(pr[0], pr[1], pr[2], pr[3], pr[4], pr[5], pr[6], pr[7]);
        pf[1] = pack8(pr[8], pr[9], pr[10], pr[11], pr[12], pr[13], pr[14], pr[15]);
      }
      __builtin_amdgcn_s_setprio(1);
#pragma unroll
      for (int dt = 0; dt < 2; ++dt)
#pragma unroll
        for (int st = 0; st < 2; ++st) {
          const bf16_t* vp = cV + (dt * 32 + r) * VSTR + sub * 32 + st * 16 + 4 * hh;
          const s16x4 lo = *(const s16x4*)vp;
          const s16x4 hi = *(const s16x4*)(vp + 8);
          const bf16x8 vf = __builtin_shufflevector(lo, hi, 0, 1, 2, 3, 4, 5, 6, 7);
          oacc[dt] = MFMA(vf, pf[st], oacc[dt]);
        }
      __builtin_amdgcn_s_setprio(0);
    }
    if (more) { if (half == 0) ATT_SWRITE(y, 1) else ATT_SWRITE(x, 0) }
    if (!MLA) {
      int* flg = (int*)(smem + SMEM_BYTES - 128) + (it & 1) * 8;
      const bool wok = (__builtin_amdgcn_ballot_w64(carry >= 160.f) == ~0ull);
      if (lane == 0) flg[w] = wok ? 1 : 0;
      __syncthreads();
      alive = more && ((flg[0] & flg[1] & flg[2] & flg[3] & flg[4] & flg[5] & flg[6] & flg[7]) == 0);
    } else {
      __syncthreads();
      alive = more;
    }
    if (!alive) break;
   }
  }
#undef ATT_GLOAD
#undef ATT_SWRITE
#undef ATT_KT
  if (threadIdx.x == 0 && pre_ctr) pre_raw = atomicAdd(pre_ctr, 1);
  float inv = 1.f;
  if (MLA) { const float lt = half_sum(lrun); inv = 1.f / lt; }
  const int tok = tok0 + w * 32 + r;
  bf16_t* og = (MLA ? p.OBg() : p.OAg()) + (size_t)tok * 512 + h * 64;
#pragma unroll
  for (int dt = 0; dt < 2; ++dt)
#pragma unroll
    for (int g = 0; g < 4; ++g) {
      const int d = dt * 32 + 8 * g + 4 * hh;
      const u32x2 zz = zbuf[(dt * 4 + g) * 512 + tid];
      const float z0 = __uint_as_float(zz[0] << 16), z1 = __uint_as_float(zz[0] & 0xffff0000u);
      const float z2 = __uint_as_float(zz[1] << 16), z3 = __uint_as_float(zz[1] & 0xffff0000u);
      u32x2 o;
      o[0] = pk2(oacc[dt][4 * g] * inv * z0, oacc[dt][4 * g + 1] * inv * z1);
      o[1] = pk2(oacc[dt][4 * g + 2] * inv * z2, oacc[dt][4 * g + 3] * inv * z3);
      *(u32x2*)(og + d) = o;
    }
}

DI void phase_attn(const Params& p, char* smem, int cbase, int only) {
  int* s_item = (int*)(smem + SMEM_BYTES - 16);
  const int q0 = blockIdx.x & 7;
  int qi = 0;
  int pre_raw = 0;
  bool has_pre = false;
  for (;;) {
    if (threadIdx.x < 64) {
      int item = -1;
      while (qi < 8) {
        const int q = (q0 + qi) & 7;
        int idx = 0;
        if (has_pre) { idx = pre_raw; has_pre = false; }
        else if (threadIdx.x == 0) idx = atomicAdd(p.counter() + cbase + q, 1);
        idx = __builtin_amdgcn_readfirstlane(idx);
        if (idx < 128) { item = q * 256 + idx; break; }
        const int lq = (q0 + (threadIdx.x & 7)) & 7;
        const int head = __hip_atomic_load(p.counter() + cbase + lq, __ATOMIC_RELAXED, __HIP_MEMORY_SCOPE_AGENT);
        const unsigned long long avail = __builtin_amdgcn_ballot_w64((threadIdx.x < 8) && (head < 128) && ((int)(threadIdx.x & 7) > qi));
        if (avail == 0ull) { qi = 8; break; }
        qi = __builtin_ctzll(avail);
      }
      if (threadIdx.x == 0) *s_item = item;
    }
    __syncthreads();
    const int item = *s_item;
    __syncthreads();
    if (item < 0) break;
    const int q = item >> 8, idx = item & 255;
    const int i2 = idx & 63;
    const int bh = q + 8 * (i2 & 3);
    const int qb = 15 - (i2 >> 2);
    int* pre_ctr = p.counter() + cbase + ((q0 + qi) & 7);
    if (idx < 64) { if (only != 2) { attn_item<true>(p, bh >> 3, bh & 7, qb, smem, pre_ctr, pre_raw); has_pre = true; } }
    else { if (only != 1) { attn_item<false>(p, bh >> 3, bh & 7, qb, smem, pre_ctr, pre_raw); has_pre = true; } }
  }
}

DI void g3_pre_a(const Params& p, const int m0, const int n0, u32x4 (&g)[4]) {
  const int txo = opaque_tid();
#pragma unroll
  for (int i = 0; i < 4; ++i) {
    const int c = txo + 512 * i, row = c >> 4, cc = (c & 15) * 8;
    g[i] = *(const u32x4*)(p.GA() + (size_t)(m0 + row) * 1024 + n0 + cc);
  }
}
DI void g3_epi_a(const Params& p, const float* sC, const int m0, const int n0, const u32x4 (&gq)[4]) {
  const int txo = opaque_tid();
#pragma unroll
  for (int i = 0; i < 4; ++i) {
    const int c = txo + 512 * i, row = c >> 4, cc = (c & 15) * 8;
    const u32x4 g = gq[i];
    const float4 a = *(const float4*)(sC + row * CSTR + cc), b = *(const float4*)(sC + row * CSTR + cc + 4);
    u32x4 y;
    y[0] = pk2(a.x * __uint_as_float(g[0] << 16), a.y * __uint_as_float(g[0] & 0xffff0000u));
    y[1] = pk2(a.z * __uint_as_float(g[1] << 16), a.w * __uint_as_float(g[1] & 0xffff0000u));
    y[2] = pk2(b.x * __uint_as_float(g[2] << 16), b.y * __uint_as_float(g[2] & 0xffff0000u));
    y[3] = pk2(b.z * __uint_as_float(g[3] << 16), b.w * __uint_as_float(g[3] & 0xffff0000u));
    *(u32x4*)(p.MERGED() + (size_t)(m0 + row) * 1024 + n0 + cc) = y;
  }
}
DI void g3_pre_b(const Params& p, const int m0, const int n0, u32x4 (&g)[4], u32x4 (&y)[4]) {
  const int txo2 = opaque_tid();
#pragma unroll
  for (int i = 0; i < 4; ++i) {
    const int c = txo2 + 512 * i, row = c >> 4, cc = (c & 15) * 8;
    g[i] = *(const u32x4*)(p.GB() + (size_t)(m0 + row) * 1024 + n0 + cc);
    y[i] = *(const u32x4*)(p.MERGED() + (size_t)(m0 + row) * 1024 + n0 + cc);
  }
}
DI void g3_epi_b(const Params& p, const float* sC, const int m0, const int n0, const u32x4 (&gq)[4], const u32x4 (&yq)[4]) {
  const int txo2 = opaque_tid();
#pragma unroll
  for (int i = 0; i < 4; ++i) {
    const int c = txo2 + 512 * i, row = c >> 4, cc = (c & 15) * 8;
    const u32x4 g = gq[i];
    const u32x4 yv = yq[i];
    const float4 a = *(const float4*)(sC + row * CSTR + cc), b = *(const float4*)(sC + row * CSTR + cc + 4);
    u32x4 o;
    o[0] = pk2(__uint_as_float(yv[0] << 16) + a.x * __uint_as_float(g[0] << 16), __uint_as_float(yv[0] & 0xffff0000u) + a.y * __uint_as_float(g[0] & 0xffff0000u));
    o[1] = pk2(__uint_as_float(yv[1] << 16) + a.z * __uint_as_float(g[1] << 16), __uint_as_float(yv[1] & 0xffff0000u) + a.w * __uint_as_float(g[1] & 0xffff0000u));
    o[2] = pk2(__uint_as_float(yv[2] << 16) + b.x * __uint_as_float(g[2] << 16), __uint_as_float(yv[2] & 0xffff0000u) + b.y * __uint_as_float(g[2] & 0xffff0000u));
    o[3] = pk2(__uint_as_float(yv[3] << 16) + b.z * __uint_as_float(g[3] << 16), __uint_as_float(yv[3] & 0xffff0000u) + b.w * __uint_as_float(g[3] & 0xffff0000u));
    *(u32x4*)(p.MERGED() + (size_t)(m0 + row) * 1024 + n0 + cc) = o;
  }
}
DI void phase_g3(const Params& p, char* smem) {
  bf16_t* shm = (bf16_t*)smem;
  float* sC = (float*)smem;
  const int xq = blockIdx.x & 7, lb = blockIdx.x >> 3, nlb = gridDim.x >> 3;
  const bool xmap = (gridDim.x & 7) == 0;
  for (int t = xmap ? lb : (int)blockIdx.x; t < (xmap ? 32 : 256); t += (xmap ? nlb : (int)gridDim.x)) {
    const int rt = xmap ? (8 * xq + (t & 7)) : (t >> 2), ct = xmap ? (t >> 3) : (t & 3);
    const int m0 = rt * 256, n0 = ct * 256;
    f32x4 acc[2][2][4][2];
    zero_acc8(acc);
    gemm8_tile(p.OAg() + (size_t)m0 * 512, p.WaT() + (size_t)n0 * 512, 512, shm, acc);
#pragma unroll
    for (int ai = 0; ai < 2; ++ai)
#pragma unroll
      for (int bj = 0; bj < 2; ++bj) {
        u32x4 gq[4];
        g3_pre_a(p, m0 + ai * 128, n0 + bj * 128, gq);
        __syncthreads();
        accq_to_lds(acc[ai][bj], sC);
        __syncthreads();
        g3_epi_a(p, sC, m0 + ai * 128, n0 + bj * 128, gq);
      }
    __syncthreads();
    zero_acc8(acc);
    gemm8_tile(p.OBg() + (size_t)m0 * 512, p.WbT() + (size_t)n0 * 512, 512, shm, acc);
#pragma unroll
    for (int ai = 0; ai < 2; ++ai)
#pragma unroll
      for (int bj = 0; bj < 2; ++bj) {
        u32x4 gq[4], yq[4];
        g3_pre_b(p, m0 + ai * 128, n0 + bj * 128, gq, yq);
        __syncthreads();
        accq_to_lds(acc[ai][bj], sC);
        __syncthreads();
        g3_epi_b(p, sC, m0 + ai * 128, n0 + bj * 128, gq, yq);
      }
    __syncthreads();
  }
}

DI void g4_pre(const Params& p, const int m0, const int n0, float4 (&xq)[8]) {
  const int txo = opaque_tid();
#pragma unroll
  for (int i = 0; i < 4; ++i) {
    const int c = txo + 512 * i, row = c >> 4, cc = (c & 15) * 8;
    const size_t go = (size_t)(m0 + row) * 1024 + n0 + cc;
    xq[2 * i] = *(const float4*)(p.x + go); xq[2 * i + 1] = *(const float4*)(p.x + go + 4);
  }
}
DI void g4_epi(const Params& p, const float* sC, const float* gt, const int m0, const int n0, const float4 (&xq)[8]) {
  const int txo = opaque_tid();
#pragma unroll
  for (int i = 0; i < 4; ++i) {
    const int c = txo + 512 * i, row = c >> 4, cc = (c & 15) * 8;
    const size_t go = (size_t)(m0 + row) * 1024 + n0 + cc;
    const float4 x0 = xq[2 * i], x1 = xq[2 * i + 1];
    const float4 a = *(const float4*)(sC + row * CSTR + cc), b = *(const float4*)(sC + row * CSTR + cc + 4);
    const float4 g0 = *(const float4*)(gt + cc), g1 = *(const float4*)(gt + cc + 4);
    float4 o0, o1;
    o0.x = x0.x + g0.x * a.x; o0.y = x0.y + g0.y * a.y; o0.z = x0.z + g0.z * a.z; o0.w = x0.w + g0.w * a.w;
    o1.x = x1.x + g1.x * b.x; o1.y = x1.y + g1.y * b.y; o1.z = x1.z + g1.z * b.z; o1.w = x1.w + g1.w * b.w;
    *(float4*)(p.out + go) = o0;
    *(float4*)(p.out + go + 4) = o1;
  }
}
DI void phase_g4(const Params& p, char* smem) {
  bf16_t* shm = (bf16_t*)smem;
  float* sC = (float*)smem;
  float* rs = (float*)(smem + RS_OFF);
  const int xq = blockIdx.x & 7, lb = blockIdx.x >> 3, nlb = gridDim.x >> 3;
  const bool xmap = (gridDim.x & 7) == 0;
  for (int t = xmap ? lb : (int)blockIdx.x; t < (xmap ? 32 : 256); t += (xmap ? nlb : (int)gridDim.x)) {
    const int rt = xmap ? (8 * xq + (t & 7)) : (t >> 2), ct = xmap ? (t >> 3) : (t & 3);
    const int m0 = rt * 256, n0 = ct * 256;
    f32x4 acc[2][2][4][2];
    zero_acc8(acc);
    if (threadIdx.x < 256) rs[threadIdx.x] = mod_get(p.MOD(), m0 >> 12, 2048 + n0 + threadIdx.x);
    gemm8_tile(p.MERGED() + (size_t)m0 * 1024, p.WoT() + (size_t)n0 * 1024, 1024, shm, acc);
#pragma unroll
    for (int ai = 0; ai < 2; ++ai)
#pragma unroll
      for (int bj = 0; bj < 2; ++bj) {
        float4 xq[8];
        g4_pre(p, m0 + ai * 128, n0 + bj * 128, xq);
        __syncthreads();
        accq_to_lds(acc[ai][bj], sC);
        __syncthreads();
        g4_epi(p, sC, rs + bj * 128, m0 + ai * 128, n0 + bj * 128, xq);
      }
    __syncthreads();
  }
}

DI void phase_final(const Params& p) {
  const int lane = threadIdx.x & 63, w = threadIdx.x >> 6;
  const int gw = blockIdx.x * 8 + w, nw = gridDim.x * 8;
  for (int row = gw; row < NTOK; row += nw) {
    float* xr = p.out + (size_t)row * DM;
    float4 v[4];
    float ss = 0.f;
#pragma unroll
    for (int i = 0; i < 4; ++i) {
      v[i] = *(const float4*)(xr + 4 * (lane + 64 * i));
      ss += v[i].x * v[i].x + v[i].y * v[i].y + v[i].z * v[i].z + v[i].w * v[i].w;
    }
#pragma unroll
    for (int o = 32; o >= 1; o >>= 1) ss += __shfl_xor(ss, o);
    const float rn = __builtin_amdgcn_rsqf(ss * (1.f / DM) + EPSN);
#pragma unroll
    for (int i = 0; i < 4; ++i) {
      const int e = 4 * (lane + 64 * i);
      const float4 g = *(const float4*)(p.fgain + e);
      float4 o;
      o.x = v[i].x * rn * g.x; o.y = v[i].y * rn * g.y; o.z = v[i].z * rn * g.z; o.w = v[i].w * rn * g.w;
      __builtin_nontemporal_store(o.x, xr + e); __builtin_nontemporal_store(o.y, xr + e + 1); __builtin_nontemporal_store(o.z, xr + e + 2); __builtin_nontemporal_store(o.w, xr + e + 3);
    }
  }
}

template <int PH>
__global__ void __launch_bounds__(NTHREADS, 2) mega_kernel(Params p) {
  __shared__ __attribute__((aligned(16))) char smem[SMEM_BYTES];
  if (PH < 0) {
    if (p.ws == nullptr) cg::this_grid().sync();
    volatile LAS unsigned* xst = (volatile LAS unsigned*)(smem + SMEM_BYTES - 32);
    if (threadIdx.x == 0) { xst[0] = 0u; xst[1] = 0u; }
    __syncthreads();
    (void)xcd_barrier_post(p.bar(), xst);
    phase_prep(p, smem); xcd_barrier(p.bar(), (volatile LAS unsigned*)(smem + SMEM_BYTES - 32));
#if PROBE_DUP == 4
    phase_prep(p, smem); xcd_barrier(p.bar(), (volatile LAS unsigned*)(smem + SMEM_BYTES - 32));
#endif
    phase_h(p, smem); xcd_barrier(p.bar(), (volatile LAS unsigned*)(smem + SMEM_BYTES - 32));
#if PROBE_DUP == 5
    phase_h(p, smem); xcd_barrier(p.bar(), (volatile LAS unsigned*)(smem + SMEM_BYTES - 32));
#endif
    phase_g1(p, smem); xcd_barrier(p.bar(), (volatile LAS unsigned*)(smem + SMEM_BYTES - 32));
#if PROBE_DUP == 1
    phase_g1(p, smem, false); xcd_barrier(p.bar(), (volatile LAS unsigned*)(smem + SMEM_BYTES - 32));
#endif
    phase_g2(p, smem); xcd_barrier(p.bar(), (volatile LAS unsigned*)(smem + SMEM_BYTES - 32));
#if PROBE_DUP == 8
    phase_g2(p, smem); xcd_barrier(p.bar(), (volatile LAS unsigned*)(smem + SMEM_BYTES - 32));
#endif
    phase_attn(p, smem, 0, 0); xcd_barrier(p.bar(), (volatile LAS unsigned*)(smem + SMEM_BYTES - 32));
#if PROBE_DUP == 2
    phase_attn(p, smem, 8, 1); xcd_barrier(p.bar(), (volatile LAS unsigned*)(smem + SMEM_BYTES - 32));
#endif
#if PROBE_DUP == 3
    phase_attn(p, smem, 8, 2); xcd_barrier(p.bar(), (volatile LAS unsigned*)(smem + SMEM_BYTES - 32));
#endif
    phase_g3(p, smem); xcd_barrier(p.bar(), (volatile LAS unsigned*)(smem + SMEM_BYTES - 32));
#if PROBE_DUP == 6
    phase_g3(p, smem); xcd_barrier(p.bar(), (volatile LAS unsigned*)(smem + SMEM_BYTES - 32));
#endif
    phase_g4(p, smem); xcd_barrier(p.bar(), (volatile LAS unsigned*)(smem + SMEM_BYTES - 32));
#if PROBE_DUP == 7
    phase_g4(p, smem); xcd_barrier(p.bar(), (volatile LAS unsigned*)(smem + SMEM_BYTES - 32));
#endif
    phase_final(p);
  } else {
    if (PH == 0) phase_prep(p, smem);
    if (PH == 1) phase_h(p, smem);
    if (PH == 2) phase_g1(p, smem);
    if (PH == 3) phase_g2(p, smem);
    if (PH == 4) phase_attn(p, smem, 0, 0);
    if (PH == 5) phase_g3(p, smem);
    if (PH == 6) phase_g4(p, smem);
    if (PH == 7) phase_final(p);
  }
}

#ifndef PROBE_DUP
#define PROBE_DUP 0
#endif
#ifndef MK_SPLIT
#define MK_SPLIT 0
#endif

extern "C" void kernel_launch(void* const* d_in, const int* in_sizes, int n_in, void* d_out, int out_size, void* d_ws, size_t ws_size, hipStream_t stream) {
  Params p{};
  p.x = (const float*)d_in[0]; p.c = (const float*)d_in[1]; p.pos = (const int*)d_in[2];
  p.w_ada = (const float*)d_in[3]; p.b_ada = (const float*)d_in[4]; p.norm_gain = (const float*)d_in[5];
  p.w_in = (const float*)d_in[6]; p.q_gain = (const float*)d_in[7]; p.w_uq = (const float*)d_in[8];
  p.kv_gain = (const float*)d_in[9]; p.w_ukv = (const float*)d_in[10]; p.w_a = (const float*)d_in[11];
  p.w_b = (const float*)d_in[12]; p.w_out = (const float*)d_in[13]; p.fgain = (const float*)d_in[14];
  p.out = (float*)d_out;
  p.ws = (char*)d_ws;
  if (WS_NEED > ws_size) { fprintf(stderr, "workspace too small: need %zu have %zu\n", (size_t)WS_NEED, ws_size); return; }

  static int grid_blocks = 0;
  if (!grid_blocks) {
    int dev = 0, cus = 0, per_cu = 0;
    hipGetDevice(&dev);
    hipDeviceGetAttribute(&cus, hipDeviceAttributeMultiprocessorCount, dev);
    hipOccupancyMaxActiveBlocksPerMultiprocessor(&per_cu, mega_kernel<-1>, NTHREADS, 0);
    per_cu = 1;
    grid_blocks = cus * per_cu;
  }
#if MK_SPLIT
  mega_kernel<0><<<grid_blocks, NTHREADS, 0, stream>>>(p);
  mega_kernel<1><<<grid_blocks, NTHREADS, 0, stream>>>(p);
  mega_kernel<2><<<grid_blocks, NTHREADS, 0, stream>>>(p);
  mega_kernel<3><<<grid_blocks, NTHREADS, 0, stream>>>(p);
  mega_kernel<4><<<grid_blocks, NTHREADS, 0, stream>>>(p);
  mega_kernel<5><<<grid_blocks, NTHREADS, 0, stream>>>(p);
  mega_kernel<6><<<grid_blocks, NTHREADS, 0, stream>>>(p);
  mega_kernel<7><<<grid_blocks, NTHREADS, 0, stream>>>(p);
#else
  hipMemsetAsync((char*)d_ws + OFF_bar, 0, XCD_BAR_WORDS * 4, stream);
  void* args[] = {&p};
  hipError_t e = hipLaunchCooperativeKernel((void*)mega_kernel<-1>, dim3(grid_blocks), dim3(NTHREADS), args, 0, stream);
  if (e != hipSuccess) fprintf(stderr, "cooperative launch failed: %s (grid %d)\n", hipGetErrorString(e), grid_blocks);
#endif
}
```

```cpp
#include <hip/hip_runtime.h>
#include <hip/hip_cooperative_groups.h>
#include <stdint.h>
#include <stdio.h>
namespace cg = cooperative_groups;
#ifndef PROBE_DUP
#define PROBE_DUP 0
#endif

#define DI __device__ __forceinline__
typedef unsigned short bf16_t;
typedef __attribute__((ext_vector_type(8))) short bf16x8;
typedef __attribute__((ext_vector_type(4))) short s16x4;
typedef __attribute__((ext_vector_type(16))) float f32x16;
typedef __attribute__((ext_vector_type(2))) float f32x2;
typedef __attribute__((ext_vector_type(2))) __bf16 bf16x2v;
typedef __attribute__((ext_vector_type(4))) unsigned u32x4;
typedef __attribute__((ext_vector_type(2))) unsigned u32x2;
typedef __attribute__((ext_vector_type(4))) float f32x4;
#define MFMA(a, b, c) __builtin_amdgcn_mfma_f32_32x32x16_bf16((a), (b), (c), 0, 0, 0)

constexpr int NTOK = 16384, SEQL = 4096, DM = 1024;
constexpr int INW = 5280, INWP = 5376;
constexpr int NTHREADS = 512;
constexpr float LOG2E = 1.4426950408889634f;
constexpr float QS_SCALE = 0.125f * 1.4426950408889634f;
constexpr float QM_SCALE = 1.4426950408889634f / 9.797958971132712f;
constexpr float EPSN = 1e-6f;

constexpr int XCD_BAR_WORDS_C = 3456;
constexpr size_t al256(size_t v) { return (v + 255) & ~(size_t)255; }
constexpr size_t OFF_counter = 0;
constexpr size_t OFF_bar = OFF_counter + al256(256);
constexpr size_t OFF_MOD = OFF_bar + al256(XCD_BAR_WORDS_C * 4);
constexpr size_t OFF_ROPE = OFF_MOD + al256(4 * 3072 * 4 * 4);
constexpr size_t OFF_SSQ = OFF_ROPE + al256((size_t)NTOK * 32 * 4);
constexpr size_t OFF_Hb = OFF_SSQ + al256((size_t)2 * NTOK * 4);
constexpr size_t OFF_Qmla = OFF_Hb + al256((size_t)NTOK * 1024 * 2);
constexpr size_t OFF_WuqT = OFF_Qmla + al256((size_t)NTOK * 768 * 2);
constexpr size_t OFF_WukvT = OFF_WuqT + al256((size_t)768 * 384 * 2);
constexpr size_t OFF_WaT = OFF_WukvT + al256((size_t)1024 * 256 * 2);
constexpr size_t OFF_WbT = OFF_WaT + al256((size_t)1024 * 512 * 2);
constexpr size_t OFF_WoT = OFF_WbT + al256((size_t)1024 * 512 * 2);
constexpr size_t OFF_Qsb = OFF_WoT + al256((size_t)1024 * 1024 * 2);
constexpr size_t OFF_Ksb = OFF_Qsb + al256((size_t)NTOK * 512 * 2);
constexpr size_t OFF_VTsb = OFF_Ksb + al256((size_t)NTOK * 512 * 2);
constexpr size_t OFF_Zsb = OFF_VTsb + al256((size_t)NTOK * 512 * 2);
constexpr size_t OFF_OAg = OFF_Zsb + al256((size_t)NTOK * 512 * 2);
constexpr size_t OFF_OBg = OFF_OAg + al256((size_t)NTOK * 512 * 2);
constexpr size_t OFF_Zmla = OFF_OBg + al256((size_t)NTOK * 512 * 2);
constexpr size_t OFF_KPE = OFF_Zmla + al256((size_t)NTOK * 512 * 2);
constexpr size_t OFF_Knope = OFF_KPE + al256((size_t)NTOK * 32 * 2);
constexpr size_t OFF_VTmla = OFF_Knope + al256((size_t)NTOK * 512 * 2);
constexpr size_t OFF_WinT = OFF_VTmla + al256((size_t)NTOK * 512 * 2);
constexpr size_t WS_NEED = OFF_WinT + al256((size_t)INWP * 1024 * 2);
struct Params {
  const float *x, *c; const int* pos;
  const float *w_ada, *b_ada, *norm_gain, *w_in, *q_gain, *w_uq, *kv_gain, *w_ukv, *w_a, *w_b, *w_out, *fgain;
  float* out;
  char* ws;
  DI int* counter() const { return (int*)(ws + OFF_counter); }
  DI unsigned* bar() const { return (unsigned*)(ws + OFF_bar); }
  DI float* MOD() const { return (float*)(ws + OFF_MOD); }
  DI float* ROPE() const { return (float*)(ws + OFF_ROPE); }
  DI float* SSQ() const { return (float*)(ws + OFF_SSQ); }
  DI bf16_t* Hb() const { return (bf16_t*)(ws + OFF_Hb); }
  DI bf16_t* Qmla() const { return (bf16_t*)(ws + OFF_Qmla); }
  DI bf16_t* WuqT() const { return (bf16_t*)(ws + OFF_WuqT); }
  DI bf16_t* WukvT() const { return (bf16_t*)(ws + OFF_WukvT); }
  DI bf16_t* WaT() const { return (bf16_t*)(ws + OFF_WaT); }
  DI bf16_t* WbT() const { return (bf16_t*)(ws + OFF_WbT); }
  DI bf16_t* WoT() const { return (bf16_t*)(ws + OFF_WoT); }
  DI bf16_t* Qsb() const { return (bf16_t*)(ws + OFF_Qsb); }
  DI bf16_t* Ksb() const { return (bf16_t*)(ws + OFF_Ksb); }
  DI bf16_t* VTsb() const { return (bf16_t*)(ws + OFF_VTsb); }
  DI bf16_t* Zsb() const { return (bf16_t*)(ws + OFF_Zsb); }
  DI bf16_t* OAg() const { return (bf16_t*)(ws + OFF_OAg); }
  DI bf16_t* OBg() const { return (bf16_t*)(ws + OFF_OBg); }
  DI bf16_t* Zmla() const { return (bf16_t*)(ws + OFF_Zmla); }
  DI bf16_t* KPE() const { return (bf16_t*)(ws + OFF_KPE); }
  DI bf16_t* Knope() const { return (bf16_t*)(ws + OFF_Knope); }
  DI bf16_t* VTmla() const { return (bf16_t*)(ws + OFF_VTmla); }
  DI bf16_t* MERGED() const { return Hb(); }
  DI bf16_t* WinT() const { return (bf16_t*)(ws + OFF_WinT); }
  DI bf16_t* CQ() const { return OAg(); }
  DI bf16_t* CKV() const { return OBg(); }
  DI bf16_t* GA() const { return (bf16_t*)out; }
  DI bf16_t* GB() const { return (bf16_t*)out + (size_t)NTOK * 1024; }
};


__device__ const float c_invfreq[16] = {
  1.0f, 0.5623413251903491f, 0.31622776601683794f, 0.1778279410038923f, 0.1f, 0.05623413251903491f, 0.03162277660168379f,
  0.01778279410038923f, 0.01f, 0.005623413251903491f, 0.0031622776601683794f, 0.001778279410038923f, 0.001f,
  0.0005623413251903491f, 0.00031622776601683794f, 0.0001778279410038923f};

DI unsigned pk2(float a, float b) { f32x2 v = {a, b}; bf16x2v r = __builtin_convertvector(v, bf16x2v); return __builtin_bit_cast(unsigned, r); }
DI bf16_t tobf(float a) { return (bf16_t)(pk2(a, 0.f) & 0xffffu); }
DI float bf2f(unsigned short u) { return __uint_as_float(((unsigned)u) << 16); }
DI bf16x8 pack8(float a0, float a1, float a2, float a3, float a4, float a5, float a6, float a7) {
  u32x4 p; p[0] = pk2(a0, a1); p[1] = pk2(a2, a3); p[2] = pk2(a4, a5); p[3] = pk2(a6, a7);
  return __builtin_bit_cast(bf16x8, p);
}
DI int crow(int reg, int h) { return (reg & 3) + 8 * (reg >> 2) + 4 * h; }
DI int opaque_tid() { int t = threadIdx.x; asm volatile("" : "+v"(t)); return t; }
DI float half_max(float v) {
  unsigned u = __float_as_uint(v);
  auto r = __builtin_amdgcn_permlane32_swap(u, u, false, false);
  return fmaxf(__uint_as_float(r[0]), __uint_as_float(r[1]));
}
DI float half_sum(float v) {
  unsigned u = __float_as_uint(v);
  auto r = __builtin_amdgcn_permlane32_swap(u, u, false, false);
  return __uint_as_float(r[0]) + __uint_as_float(r[1]);
}
DI float sigmoidf_fast(float v) { return __builtin_amdgcn_rcpf(1.f + __builtin_amdgcn_exp2f(-v * LOG2E)); }
DI float siluf_fast(float v) { return v * sigmoidf_fast(v); }

#define XB_TMO      128
#define XB_XCNT(j)  (256  + 64 * (j))
#define XB_XSUB(j)  (1280 + 64 * (j))
#define XB_XGEN(j)  (2304 + 64 * (j))
#define XB_TOP      3328
#define XB_TOPGEN   3392
#define XCD_BAR_WORDS 3456
#define XB_SPIN_CAP (1u << 18)
#define LAS __attribute__((address_space(3)))
DI unsigned xb_ld(unsigned* p)              { return __hip_atomic_load(p, __ATOMIC_RELAXED, __HIP_MEMORY_SCOPE_AGENT); }
DI unsigned xb_add(unsigned* p, unsigned v) { return __hip_atomic_fetch_add(p, v, __ATOMIC_RELAXED, __HIP_MEMORY_SCOPE_AGENT); }
DI unsigned xb_xcc_id() { return (unsigned)__builtin_amdgcn_s_getreg((3 << 11) | 20) & 0xFu; }
#define XB_SPIN(cond, bar) do { unsigned _sp = 0; while (cond) { __builtin_amdgcn_s_sleep(1); \
    if ((++_sp & 255u) == 0u) { if (xb_ld(&(bar)[XB_TMO])) break; if (_sp > XB_SPIN_CAP) { atomicAdd(&(bar)[XB_TMO], 1u); break; } } } } while (0)
struct XcdBarrier { unsigned* bar; unsigned x; volatile LAS unsigned* st; };
DI XcdBarrier xcd_barrier_post(unsigned* bar, volatile LAS unsigned* st) {
  XcdBarrier b; b.bar = bar; b.x = xb_xcc_id(); b.st = st;
  if (threadIdx.x == 0) (void)xb_add(&bar[XB_XCNT(b.x)], 1u);
  return b;
}
DI void xcd_barrier_complete(unsigned* bar, unsigned x, unsigned& nloc, unsigned& nx) {
  const unsigned G = gridDim.x * gridDim.y * gridDim.z;
  unsigned sum, cnt, mine, sp = 0u;
  for (;;) {
    sum = 0u; cnt = 0u; mine = 0u;
#pragma unroll
    for (unsigned j = 0; j < 16; ++j) { const unsigned c = xb_ld(&bar[XB_XCNT(j)]); sum += c; cnt += (c > 0u) ? 1u : 0u; mine = (j == x) ? c : mine; }
    if (sum == G) break;
    __builtin_amdgcn_s_sleep(1);
    if ((++sp & 255u) == 0u) { if (xb_ld(&bar[XB_TMO])) break; if (sp > XB_SPIN_CAP) { atomicAdd(&bar[XB_TMO], 1u); break; } }
  }
  nloc = mine > 0u ? mine : 1u; nx = cnt > 0u ? cnt : 1u;
}
DI void xcd_barrier(unsigned* bar_, volatile LAS unsigned* st_) {
  XcdBarrier b; b.bar = bar_; b.st = st_; b.x = 0;
  asm volatile("s_waitcnt vmcnt(0)" ::: "memory");
  __syncthreads();
  if (threadIdx.x == 0) {
    unsigned* bar = b.bar;
    b.x = xb_xcc_id();
    __builtin_amdgcn_s_waitcnt(0);
    unsigned nloc = b.st[0], nx = b.st[1];
    if (nloc == 0u) { xcd_barrier_complete(bar, b.x, nloc, nx); b.st[0] = nloc; b.st[1] = nx; }
    const unsigned old = xb_add(&bar[XB_XSUB(b.x)], 1u);
    const unsigned gen = old / nloc;
    if (old + 1u == (gen + 1u) * nloc) {
      __builtin_amdgcn_fence(__ATOMIC_RELEASE, "agent");
      asm volatile("s_waitcnt vmcnt(0)" ::: "memory");
      const unsigned og = xb_add(&bar[XB_TOP], 1u);
      const unsigned tg = og / nx;
      if (og + 1u == (tg + 1u) * nx) xb_add(&bar[XB_TOPGEN], 1u);
      else XB_SPIN(xb_ld(&bar[XB_TOPGEN]) == tg, bar);
      __builtin_amdgcn_fence(__ATOMIC_ACQUIRE, "agent");
      xb_add(&bar[XB_XGEN(b.x)], 1u);
      asm volatile("s_waitcnt vmcnt(0)" ::: "memory");
    } else {
      XB_SPIN(xb_ld(&bar[XB_XGEN(b.x)]) == gen, bar);
      __builtin_amdgcn_fence(__ATOMIC_ACQUIRE, "agent");
      asm volatile("s_waitcnt vmcnt(0)" ::: "memory");
    }
  }
  __syncthreads();
}

constexpr int GSTR = 72;
constexpr int GBUF = 128 * GSTR;
constexpr int RS_OFF = 135168;
constexpr int SMEM_BYTES = RS_OFF + 4096;

constexpr int G8_HT = 128 * 64;
DI int lds_byte(int r, int c) { const int st = (r >> 4) * 2 + (c >> 5), rr = r & 15, cc = c & 31, ob = rr * 64 + cc * 2; return st * 1024 + (ob ^ (((ob >> 9) & 1) << 5)); }
DI void stage_rc(int b, int& R, int& C) { const int st = b / 1024, sb = b % 1024, swz = sb ^ (((sb >> 9) & 1) << 5); R = (st >> 1) * 16 + swz / 64; C = (st & 1) * 32 + (swz % 64) / 2; }

DI void gemm8_tile(const bf16_t* __restrict__ A, const bf16_t* __restrict__ Bt, const int K, bf16_t* shm, f32x4 (&acc)[2][2][4][2]) {
  const int tid = opaque_tid();
  const int wid = tid >> 6, lane = tid & 63, wr = wid >> 2, wc = wid & 3, fr = lane & 15, fq = lane >> 4;
  const int swz = (fr * 64 + fq * 16) ^ ((fr >> 3) << 5);
  const char* aRd = (const char*)shm + swz + wr * 8192;
  const char* bRd = (const char*)shm + 65536 + swz + wc * 4096;
  int sr0, sc0, sr1, sc1;
  stage_rc(tid * 16, sr0, sc0);
  stage_rc(tid * 16 + 8192, sr1, sc1);
  const unsigned so0 = (unsigned)(sr0 * K + sc0) * 2u, so1 = (unsigned)(sr1 * K + sc1) * 2u;
  char* const stw = (char*)shm + __builtin_amdgcn_readfirstlane(tid & ~63) * 16;
  const char* const Ab = (const char*)A;
  const char* const Bb = (const char*)Bt;
#define SA(b, h) (((b) * 2 + (h)) * 16384)
#define SB(b, h) ((4 + (b) * 2 + (h)) * 16384)
#define STAGE(P, BASE, br, kt) do { const char* g_ = (BASE) + ((long)(br) * K + (long)(kt) * 64) * 2;                        \
    __builtin_amdgcn_global_load_lds((const unsigned*)(g_ + so0), (unsigned*)(stw + (P)), 16, 0, 0);                          \
    __builtin_amdgcn_global_load_lds((const unsigned*)(g_ + so1), (unsigned*)(stw + (P) + 8192), 16, 0, 0); } while (0)
#define LDA(dst, b, h) _Pragma("unroll") for (int m = 0; m < 4; ++m) _Pragma("unroll") for (int k = 0; k < 2; ++k) \
    dst[m][k] = *reinterpret_cast<const bf16x8*>(aRd + ((b) * 2 + (h)) * 16384 + (m * 2 + k) * 1024)
#define LDB(dst, b, h) _Pragma("unroll") for (int n = 0; n < 2; ++n) _Pragma("unroll") for (int k = 0; k < 2; ++k) \
    dst[n][k] = *reinterpret_cast<const bf16x8*>(bRd + ((b) * 2 + (h)) * 16384 + (n * 2 + k) * 1024)
#define MMA(ai, bj, At_, Bt_) do { __builtin_amdgcn_s_setprio(1);                                                          \
    _Pragma("unroll") for (int m = 0; m < 4; ++m) _Pragma("unroll") for (int n = 0; n < 2; ++n) _Pragma("unroll") for (int k = 0; k < 2; ++k) \
      acc[ai][bj][m][n] = __builtin_amdgcn_mfma_f32_16x16x32_bf16(At_[m][k], Bt_[n][k], acc[ai][bj][m][n], 0, 0, 0);       \
    __builtin_amdgcn_s_setprio(0); } while (0)
#define WAIT_V(n) asm volatile("s_waitcnt vmcnt(" #n ")" ::: "memory")
#define WAIT_L(n) asm volatile("s_waitcnt lgkmcnt(" #n ")" ::: "memory")
#define BAR __builtin_amdgcn_s_barrier()
#define SCHED __builtin_amdgcn_sched_barrier(0)
  bf16x8 At[4][2], B0[2][2], B1[2][2];
  const int nt = K / 64;
  STAGE(SB(0, 0), Bb, 0, 0); STAGE(SA(0, 0), Ab, 0, 0);
  STAGE(SB(0, 1), Bb, 128, 0); STAGE(SA(0, 1), Ab, 128, 0);
  if (wr == 1) BAR;
  WAIT_V(4); BAR;
  STAGE(SB(1, 0), Bb, 0, 1); STAGE(SA(1, 0), Ab, 0, 1); STAGE(SB(1, 1), Bb, 128, 1);
  WAIT_V(6); BAR;
  for (int t = 0; t < nt - 2; t += 2) {
    LDB(B0, 0, 0); SCHED; LDA(At, 0, 0); STAGE(SA(1, 1), Ab, 128, t + 1);
    WAIT_L(8); BAR; WAIT_L(0); MMA(0, 0, At, B0); BAR; SCHED;
    LDB(B1, 0, 1); STAGE(SB(0, 0), Bb, 0, t + 2);
    BAR; WAIT_L(0); MMA(0, 1, At, B1); BAR;
    LDA(At, 0, 1); STAGE(SA(0, 0), Ab, 0, t + 2);
    BAR; WAIT_L(0); MMA(1, 0, At, B0); BAR; SCHED;
    STAGE(SB(0, 1), Bb, 128, t + 2);
    WAIT_V(6); BAR; MMA(1, 1, At, B1); BAR;
    LDB(B0, 1, 0); SCHED; LDA(At, 1, 0); STAGE(SA(0, 1), Ab, 128, t + 2);
    WAIT_L(8); BAR; WAIT_L(0); MMA(0, 0, At, B0); BAR; SCHED;
    LDB(B1, 1, 1); STAGE(SB(1, 0), Bb, 0, t + 3);
    BAR; WAIT_L(0); MMA(0, 1, At, B1); BAR;
    LDA(At, 1, 1); STAGE(SA(1, 0), Ab, 0, t + 3);
    BAR; WAIT_L(0); MMA(1, 0, At, B0); BAR; SCHED;
    STAGE(SB(1, 1), Bb, 128, t + 3);
    WAIT_V(6); BAR; MMA(1, 1, At, B1); BAR;
  }
  { LDB(B0, 0, 0); LDA(At, 0, 0); STAGE(SA(1, 1), Ab, 128, nt - 1);
    BAR; WAIT_L(0); MMA(0, 0, At, B0); BAR;
    LDB(B1, 0, 1); BAR; WAIT_L(0); MMA(0, 1, At, B1); BAR;
    LDA(At, 0, 1); WAIT_V(4); BAR; WAIT_L(0); MMA(1, 0, At, B0); MMA(1, 1, At, B1); BAR; }
  { LDB(B0, 1, 0); LDA(At, 1, 0); WAIT_V(2); BAR; WAIT_L(0); MMA(0, 0, At, B0); BAR;
    LDB(B1, 1, 1); WAIT_V(0); BAR; WAIT_L(0); MMA(0, 1, At, B1); BAR;
    LDA(At, 1, 1); BAR; WAIT_L(0); MMA(1, 0, At, B0); MMA(1, 1, At, B1); BAR; }
  if (wr == 0) BAR;
#undef SA
#undef SB
#undef STAGE
#undef LDA
#undef LDB
#undef MMA
#undef WAIT_V
#undef WAIT_L
#undef BAR
#undef SCHED
}


DI void zero_acc8(f32x4 (&acc)[2][2][4][2]) {
#pragma unroll
  for (int a = 0; a < 2; ++a)
#pragma unroll
    for (int b = 0; b < 2; ++b)
#pragma unroll
      for (int m = 0; m < 4; ++m)
#pragma unroll
        for (int n = 0; n < 2; ++n) acc[a][b][m][n] = f32x4{0.f, 0.f, 0.f, 0.f};
}

constexpr int CSTR = 132;
DI void accq_to_lds(const f32x4 (&q)[4][2], float* sC) {
  const int tid = opaque_tid(), wid = tid >> 6, lane = tid & 63, wr = wid >> 2, wc = wid & 3, fr = lane & 15, fq = lane >> 4;
#pragma unroll
  for (int m = 0; m < 4; ++m)
#pragma unroll
    for (int n = 0; n < 2; ++n)
#pragma unroll
      for (int j = 0; j < 4; ++j) sC[(wr * 64 + m * 16 + fq * 4 + j) * CSTR + wc * 32 + n * 16 + fr] = q[m][n][j];
}
constexpr int SC2_OFF = 128 * CSTR;
template <class EPI>
DI void tile_epilogue2(const f32x4 (&acc)[2][2][4][2], float* sC, EPI epi) {
  __syncthreads();
  accq_to_lds(acc[0][0], sC);
  __syncthreads();
  accq_to_lds(acc[0][1], sC + SC2_OFF);
  epi(0, sC);
  __syncthreads();
  accq_to_lds(acc[1][0], sC);
  epi(1, sC + SC2_OFF);
  __syncthreads();
  accq_to_lds(acc[1][1], sC + SC2_OFF);
  epi(2, sC);
  __syncthreads();
  epi(3, sC + SC2_OFF);
  __syncthreads();
}

template <class F>
DI void epi_rows(const float* sC, F f) {
  const int tx = opaque_tid();
#pragma unroll
  for (int i = 0; i < 4; ++i) {
    const int c = tx + 512 * i, row = c >> 4, cc = (c & 15) * 8;
    const float4 a = *(const float4*)(sC + row * CSTR + cc), b = *(const float4*)(sC + row * CSTR + cc + 4);
    const float v[8] = {a.x, a.y, a.z, a.w, b.x, b.y, b.z, b.w};
    f(i, row, cc, v);
  }
}
DI float4 ldnt4(const float* p) { float4 r; r.x = __builtin_nontemporal_load(p); r.y = __builtin_nontemporal_load(p + 1); r.z = __builtin_nontemporal_load(p + 2); r.w = __builtin_nontemporal_load(p + 3); return r; }
DI void store8(bf16_t* p, const float (&v)[8]) { *(bf16x8*)p = pack8(v[0], v[1], v[2], v[3], v[4], v[5], v[6], v[7]); }
DI void store8_nt(bf16_t* p, const float (&v)[8]) { __builtin_nontemporal_store(pack8(v[0], v[1], v[2], v[3], v[4], v[5], v[6], v[7]), (bf16x8*)p); }
DI void epi_vt(const float* sC, bf16_t* VT, int m0, int head0, int c0, int ncol_log2) {
  const int b = m0 >> 12, s0 = m0 & 4095;
  const int nitems = 16 << ncol_log2;
  for (int c = opaque_tid(); c < nitems; c += 512) {
    const int col = c & ((1 << ncol_log2) - 1), rc = c >> ncol_log2;
    float v[8];
#pragma unroll
    for (int j = 0; j < 8; ++j) v[j] = sC[(rc * 8 + j) * CSTR + c0 + col];
    const int head = head0 + (col >> 6), d = col & 63;
    store8(VT + ((size_t)((b * 8 + head) * 64 + d)) * SEQL + s0 + rc * 8, v);
  }
}
DI void rope8(const float* sC, const float* ROPE, int tok, int row, int cc, float (&v)[8]) {
  const float* pr = sC + row * CSTR + (cc ^ 16);
  const bool upper = (cc & 16) != 0;
  const int f0 = cc & 15;
  const float* tb = ROPE + (size_t)tok * 32;
#pragma unroll
  for (int j = 0; j < 8; ++j) {
    const float o = pr[j], cs = tb[f0 + j], sn = tb[16 + f0 + j];
    v[j] = upper ? (o * sn + v[j] * cs) : (v[j] * cs - o * sn);
  }
}

DI void wconv_unit(const float* __restrict__ src, int Nsrc, int K, bf16_t* __restrict__ dst, const float* __restrict__ gain, int ng, int kg, int mode, float* tile, const int tid) {
  {
    const int k = tid >> 2, cq = tid & 3;
    const int n = ng * 64 + cq * 16;
    int sc = n;
    if (mode == 1) { sc = (n < 2688) ? n : (n < 5248 ? n + 32 : (n < 5280 ? n - 2560 : -1)); }
    const int kk = kg * 64 + k;
    float4 v[4];
    if (sc >= 0) {
      const float* sp = src + (size_t)kk * Nsrc + sc;
#pragma unroll
      for (int i = 0; i < 4; ++i) v[i] = ldnt4(sp + 4 * i);
      if (gain) { const float g = gain[kk];
#pragma unroll
        for (int i = 0; i < 4; ++i) { v[i].x *= g; v[i].y *= g; v[i].z *= g; v[i].w *= g; } }
    } else {
#pragma unroll
      for (int i = 0; i < 4; ++i) v[i] = make_float4(0.f, 0.f, 0.f, 0.f);
    }
    float* tp = tile + k * 65 + cq * 16;
#pragma unroll
    for (int i = 0; i < 4; ++i) { tp[4 * i] = v[i].x; tp[4 * i + 1] = v[i].y; tp[4 * i + 2] = v[i].z; tp[4 * i + 3] = v[i].w; }
  }
  __syncthreads();
  {
    const int n = tid >> 2, kc = tid & 3;
    float o[16];
#pragma unroll
    for (int j = 0; j < 16; ++j) o[j] = tile[(kc * 16 + j) * 65 + n];
    bf16_t* dp = dst + (size_t)(ng * 64 + n) * K + kg * 64 + kc * 16;
    *(bf16x8*)dp = pack8(o[0], o[1], o[2], o[3], o[4], o[5], o[6], o[7]);
    *(bf16x8*)(dp + 8) = pack8(o[8], o[9], o[10], o[11], o[12], o[13], o[14], o[15]);
  }
  __syncthreads();
}

DI void phase_prep(const Params& p, char* smem) {
  if (blockIdx.x == 0 && threadIdx.x < 16) { p.counter()[threadIdx.x] = 0; }
  for (int i = blockIdx.x * NTHREADS + threadIdx.x; i < 2 * NTOK; i += gridDim.x * NTHREADS) p.SSQ()[i] = 0.f;
  const int half = threadIdx.x >> 8, tid = threadIdx.x & 255;
  constexpr int U_MOD = 96 * 4, U_WIN = 84 * 16, U_WUQ = 12 * 6, U_WUKV = 16 * 4, U_WA = 16 * 8, U_WB = 16 * 8, U_WO = 16 * 16, U_ROPE = 1024;
  constexpr int U_TOTAL = U_MOD + U_ROPE + U_WIN + U_WUQ + U_WUKV + U_WA + U_WB + U_WO;
  float* tile = (float*)smem + half * (64 * 65 + 64);
  for (int up = blockIdx.x; up < U_TOTAL / 2; up += gridDim.x) {
    int v = 2 * up + half;
    if (v < U_MOD) {
      const int cg32 = v >> 2, kq = v & 3, n0 = cg32 * 32;
      const int kgp = tid >> 5, col = tid & 31;
      const int kb = kq * 256 + kgp * 32;
      float a0 = 0.f, a1 = 0.f, a2 = 0.f, a3 = 0.f;
      const float* wp = p.w_ada + (size_t)kb * 3072 + n0 + col;
      float wv[32];
#pragma unroll
      for (int kk = 0; kk < 32; ++kk) wv[kk] = __builtin_nontemporal_load(wp + (size_t)kk * 3072);
#pragma unroll
      for (int kk = 0; kk < 32; ++kk) {
        a0 += wv[kk] * p.c[kb + kk]; a1 += wv[kk] * p.c[1024 + kb + kk]; a2 += wv[kk] * p.c[2048 + kb + kk]; a3 += wv[kk] * p.c[3072 + kb + kk];
      }
      float* red = (float*)smem + half * 1024;
      red[(kgp * 4 + 0) * 32 + col] = a0; red[(kgp * 4 + 1) * 32 + col] = a1; red[(kgp * 4 + 2) * 32 + col] = a2; red[(kgp * 4 + 3) * 32 + col] = a3;
      __syncthreads();
      if (tid < 128) {
        const int b = tid >> 5, cc = tid & 31;
        float s = (kq == 0) ? p.b_ada[n0 + cc] : 0.f;
#pragma unroll
        for (int g = 0; g < 8; ++g) s += red[(g * 4 + b) * 32 + cc];
        p.MOD()[(size_t)(b * 3072 + n0 + cc) * 4 + kq] = s;
      }
      __syncthreads();
      continue;
    }
    v -= U_MOD;
    if (v < U_WIN) { wconv_unit(p.w_in, INW, 1024, p.WinT(), nullptr, v >> 4, v & 15, 1, tile, tid); continue; }
    v -= U_WIN;
    if (v < U_WUQ) { wconv_unit(p.w_uq, 768, 384, p.WuqT(), p.q_gain, v / 6, v % 6, 0, tile, tid); continue; }
    v -= U_WUQ;
    if (v < U_WUKV) { wconv_unit(p.w_ukv, 1024, 256, p.WukvT(), p.kv_gain, v >> 2, v & 3, 0, tile, tid); continue; }
    v -= U_WUKV;
    if (v < U_WA) { wconv_unit(p.w_a, 1024, 512, p.WaT(), nullptr, v >> 3, v & 7, 0, tile, tid); continue; }
    v -= U_WA;
    if (v < U_WB) { wconv_unit(p.w_b, 1024, 512, p.WbT(), nullptr, v >> 3, v & 7, 0, tile, tid); continue; }
    v -= U_WB;
    if (v < U_WO) { wconv_unit(p.w_out, 1024, 1024, p.WoT(), nullptr, v >> 4, v & 15, 0, tile, tid); continue; }
    v -= U_WO;
    {
      const int idx = v * 256 + tid, tok = idx >> 4, i = idx & 15;
      const float ang = (float)p.pos[tok] * c_invfreq[i];
      double t = (double)ang * 0.15915494309189535;
      t -= rint(t);
      const float tf = (float)t;
      p.ROPE()[(size_t)tok * 32 + i] = __builtin_amdgcn_cosf(tf);
      p.ROPE()[(size_t)tok * 32 + 16 + i] = __builtin_amdgcn_sinf(tf);
    }
  }
}

DI float mod_get(const float* MOD, int b, int n) { const float4 q = *(const float4*)(MOD + (size_t)(b * 3072 + n) * 4); return (q.x + q.y) + (q.z + q.w); }

DI void phase_h(const Params& p, char* smem) {
  const int tid = opaque_tid(), lane = tid & 63, w = tid >> 6;
  float* gs = (float*)smem;
  float* sh = gs + 1024;
  const int xq = blockIdx.x & 7, lb = blockIdx.x >> 3, nlb = gridDim.x >> 3;
  const bool xmap = (gridDim.x & 7) == 0;
  for (int rgi = xmap ? lb : (int)blockIdx.x; rgi < (xmap ? 32 : NTOK / 64); rgi += (xmap ? nlb : (int)gridDim.x)) {
    const int rg = xmap ? (32 * xq + rgi) : rgi;
    const int b = (rg * 64) >> 12;
    __syncthreads();
#pragma unroll
    for (int i = 0; i < 2; ++i) {
      const int k = tid + 512 * i;
      gs[k] = p.norm_gain[k] * (1.f + mod_get(p.MOD(), b, 1024 + k));
      sh[k] = mod_get(p.MOD(), b, k);
    }
    __syncthreads();
#pragma unroll 2
    for (int rr = 0; rr < 8; ++rr) {
      const int row = rg * 64 + w * 8 + rr;
      const float* xr = p.x + (size_t)row * DM;
      float4 v[4];
      float ss = 0.f;
#pragma unroll
      for (int i = 0; i < 2; ++i) {
        const int e = 8 * (lane + 64 * i);
        v[2 * i] = ldnt4(xr + e);
        v[2 * i + 1] = ldnt4(xr + e + 4);
        ss += v[2 * i].x * v[2 * i].x + v[2 * i].y * v[2 * i].y + v[2 * i].z * v[2 * i].z + v[2 * i].w * v[2 * i].w;
        ss += v[2 * i + 1].x * v[2 * i + 1].x + v[2 * i + 1].y * v[2 * i + 1].y + v[2 * i + 1].z * v[2 * i + 1].z + v[2 * i + 1].w * v[2 * i + 1].w;
      }
#pragma unroll
      for (int o = 32; o >= 1; o >>= 1) ss += __shfl_xor(ss, o);
      const float rn = __builtin_amdgcn_rsqf(ss * (1.f / DM) + EPSN);
#pragma unroll
      for (int i = 0; i < 2; ++i) {
        const int e = 8 * (lane + 64 * i);
        const float4 g0 = *(const float4*)(gs + e), g1 = *(const float4*)(gs + e + 4);
        const float4 s0 = *(const float4*)(sh + e), s1 = *(const float4*)(sh + e + 4);
        *(bf16x8*)(p.Hb() + (size_t)row * DM + e) =
            pack8(v[2 * i].x * rn * g0.x + s0.x, v[2 * i].y * rn * g0.y + s0.y, v[2 * i].z * rn * g0.z + s0.z, v[2 * i].w * rn * g0.w + s0.w,
                  v[2 * i + 1].x * rn * g1.x + s1.x, v[2 * i + 1].y * rn * g1.y + s1.y, v[2 * i + 1].z * rn * g1.z + s1.z, v[2 * i + 1].w * rn * g1.w + s1.w);
      }
    }
  }
  __syncthreads();
}

DI void g1_epi(const Params& p, const float* sC, const int m0, const int n0, const int ct, const bool do_ssq) {
    if (ct < 4) {
      epi_rows(sC, [&](int, int row, int cc, const float (&v)[8]) {
        float o[8];
#pragma unroll
        for (int j = 0; j < 8; ++j) o[j] = v[j] * QS_SCALE;
        store8(p.Qsb() + (size_t)(m0 + row) * 512 + n0 + cc, o); });
    } else if (ct < 8) {
      epi_rows(sC, [&](int, int row, int cc, const float (&v)[8]) { store8(p.Ksb() + (size_t)(m0 + row) * 512 + n0 - 512 + cc, v); });
    } else if (ct < 12) {
      epi_vt(sC, p.VTsb(), m0, (n0 - 1024) >> 6, 0, 7);
    } else if (ct < 16) {
      epi_rows(sC, [&](int, int row, int cc, const float (&v)[8]) {
        float o[8];
#pragma unroll
        for (int j = 0; j < 8; ++j) o[j] = siluf_fast(v[j]);
        store8(p.Zsb() + (size_t)(m0 + row) * 512 + n0 - 1536 + cc, o); });
    } else if (ct < 19) {
      epi_rows(sC, [&](int, int row, int cc, const float (&v)[8]) {
        store8(p.CQ() + (size_t)(m0 + row) * 384 + n0 - 2048 + cc, v);
        float q = 0.f;
#pragma unroll
        for (int j = 0; j < 8; ++j) q += v[j] * v[j];
        q += __shfl_xor(q, 1); q += __shfl_xor(q, 2); q += __shfl_xor(q, 4); q += __shfl_xor(q, 8);
        if (do_ssq && (threadIdx.x & 15) == 0) atomicAdd(p.SSQ() + m0 + row, q); });
    } else if (ct < 21) {
      epi_rows(sC, [&](int, int row, int cc, const float (&v)[8]) {
        store8(p.CKV() + (size_t)(m0 + row) * 256 + n0 - 2432 + cc, v);
        float q = 0.f;
#pragma unroll
        for (int j = 0; j < 8; ++j) q += v[j] * v[j];
        q += __shfl_xor(q, 1); q += __shfl_xor(q, 2); q += __shfl_xor(q, 4); q += __shfl_xor(q, 8);
        if (do_ssq && (threadIdx.x & 15) == 0) atomicAdd(p.SSQ() + NTOK + m0 + row, q); });
    } else if (ct < 25) {
      epi_rows(sC, [&](int, int row, int cc, const float (&v)[8]) {
        float o[8];
#pragma unroll
        for (int j = 0; j < 8; ++j) o[j] = siluf_fast(v[j]);
        store8(p.Zmla() + (size_t)(m0 + row) * 512 + n0 - 2688 + cc, o); });
    } else if (ct < 33) {
      epi_rows(sC, [&](int, int row, int cc, const float (&v)[8]) {
        float o[8];
#pragma unroll
        for (int j = 0; j < 8; ++j) o[j] = sigmoidf_fast(v[j]);
        store8_nt(p.GA() + (size_t)(m0 + row) * 1024 + n0 - 3200 + cc, o); });
    } else if (ct < 41) {
      epi_rows(sC, [&](int, int row, int cc, const float (&v)[8]) {
        float o[8];
#pragma unroll
        for (int j = 0; j < 8; ++j) o[j] = sigmoidf_fast(v[j]);
        store8_nt(p.GB() + (size_t)(m0 + row) * 1024 + n0 - 4224 + cc, o); });
    } else {
      epi_rows(sC, [&](int, int row, int cc, const float (&v)[8]) {
        if (cc < 32) {
          float o[8];
#pragma unroll
          for (int j = 0; j < 8; ++j) o[j] = v[j];
          rope8(sC, p.ROPE(), m0 + row, row, cc, o);
          store8(p.KPE() + (size_t)(m0 + row) * 32 + cc, o);
        } });
    }
}

DI void g1_tile(const Params& p, char* smem, const int rt, const int ct2, const bool do_ssq) {
  bf16_t* shm = (bf16_t*)smem;
  float* sC = (float*)smem;
  const int m0 = rt * 256, n0 = ct2 * 256;
  f32x4 acc[2][2][4][2];
  zero_acc8(acc);
  gemm8_tile(p.Hb() + (size_t)m0 * DM, p.WinT() + (size_t)n0 * DM, DM, shm, acc);
  tile_epilogue2(acc, sC, [&](const int qd, const float* sq) {
    g1_epi(p, sq, m0 + (qd >> 1) * 128, n0 + (qd & 1) * 128, ct2 * 2 + (qd & 1), do_ssq); });
}

constexpr int G1_NCT = 20;
DI void phase_g1(const Params& p, char* smem, bool do_ssq = true) {
  const int xq = blockIdx.x & 7, lb = blockIdx.x >> 3, nlb = gridDim.x >> 3;
  const bool xmap = (gridDim.x & 7) == 0;
  for (int t = xmap ? lb : (int)blockIdx.x; t < (xmap ? 8 * G1_NCT : 64 * G1_NCT); t += (xmap ? nlb : (int)gridDim.x)) {
    int rt, ct2;
    if (xmap) { ct2 = t >> 3; rt = 8 * xq + (t & 7); } else { rt = t / G1_NCT; ct2 = t % G1_NCT; }
    g1_tile(p, smem, rt, ct2, do_ssq);
  }
}

DI void g2_epi_q(const Params& p, const float* sC, const float* rsq, const int m0, const int n0) {
  epi_rows(sC, [&](int, int row, int cc, const float (&v)[8]) {
    const int col = n0 + cc;
    float o[8];
#pragma unroll
    for (int j = 0; j < 8; ++j) o[j] = v[j];
    if (((col >> 5) % 3) == 2) rope8(sC, p.ROPE(), m0 + row, row, cc, o);
    const float sc = rsq[row] * QM_SCALE;
#pragma unroll
    for (int j = 0; j < 8; ++j) o[j] *= sc;
    store8(p.Qmla() + (size_t)(m0 + row) * 768 + col, o);
  });
}
DI void g2_epi_kv(const Params& p, const float* sC, const float* rsq, const int m0, const int head) {
  epi_rows(sC, [&](int, int row, int cc, const float (&v)[8]) {
    if (cc < 64) {
      const float sc = rsq[row];
      float o[8];
#pragma unroll
      for (int j = 0; j < 8; ++j) o[j] = v[j] * sc;
      store8(p.Knope() + (size_t)(m0 + row) * 512 + head * 64 + cc, o);
    } });
  const int b = m0 >> 12, s0 = m0 & 4095;
  for (int c = opaque_tid(); c < 1024; c += 512) {
    const int col = c & 63, rc = c >> 6;
    float v[8];
#pragma unroll
    for (int j = 0; j < 8; ++j) v[j] = sC[(rc * 8 + j) * CSTR + 64 + col] * rsq[rc * 8 + j];
    store8(p.VTmla() + ((size_t)((b * 8 + head) * 64 + col)) * SEQL + s0 + rc * 8, v);
  }
}

DI void g2_tile(const Params& p, char* smem, const bool isq, const int rt, const int ct) {
  bf16_t* shm = (bf16_t*)smem;
  float* sC = (float*)smem;
  float* rs = (float*)(smem + RS_OFF);
  const int m0 = rt * 256, n0 = ct * 256;
  f32x4 acc[2][2][4][2];
  zero_acc8(acc);
  if (isq) {
    if (threadIdx.x < 256) rs[threadIdx.x] = __builtin_amdgcn_rsqf(p.SSQ()[m0 + threadIdx.x] * (1.f / 384.f) + EPSN);
    gemm8_tile(p.CQ() + (size_t)m0 * 384, p.WuqT() + (size_t)n0 * 384, 384, shm, acc);
    tile_epilogue2(acc, sC, [&](const int qd, const float* sq) {
      g2_epi_q(p, sq, rs + (qd >> 1) * 128, m0 + (qd >> 1) * 128, n0 + (qd & 1) * 128); });
  } else {
    if (threadIdx.x < 256) rs[threadIdx.x] = __builtin_amdgcn_rsqf(p.SSQ()[NTOK + m0 + threadIdx.x] * (1.f / 256.f) + EPSN);
    gemm8_tile(p.CKV() + (size_t)m0 * 256, p.WukvT() + (size_t)n0 * 256, 256, shm, acc);
    tile_epilogue2(acc, sC, [&](const int qd, const float* sq) {
      g2_epi_kv(p, sq, rs + (qd >> 1) * 128, m0 + (qd >> 1) * 128, ct * 2 + (qd & 1)); });
  }
  __syncthreads();
}

DI void phase_g2(const Params& p, char* smem) {
  const int xq = blockIdx.x & 7, lb = blockIdx.x >> 3, nlb = gridDim.x >> 3;
  if ((gridDim.x & 7) == 0 && nlb == 32) {
    if (lb < 8) {
      g1_tile(p, smem, 8 * xq + lb, G1_NCT, false);
      const int v2 = 24 + lb;
      g2_tile(p, smem, false, 8 * xq + (v2 & 7), v2 >> 3);
      return;
    }
    const int v = lb - 8;
    g2_tile(p, smem, true, 8 * xq + (v & 7), v >> 3);
    g2_tile(p, smem, false, 8 * xq + (v & 7), v >> 3);
  } else {
    for (int tt = blockIdx.x; tt < 64 + 192 + 256; tt += gridDim.x) {
      if (tt < 64) g1_tile(p, smem, tt, G1_NCT, false);
      else if (tt < 256) { const int v = tt - 64; g2_tile(p, smem, true, v / 3, v % 3); }
      else { const int v = tt - 256; g2_tile(p, smem, false, v >> 2, v & 3); }
    }
  }
}

constexpr int VSTR = 68;

template <bool MLA>
DI void attn_item(const Params& p, int b, int h, int qb, char* smem, int* pre_ctr, int& pre_raw) {
  constexpr int DK = MLA ? 96 : 64;
  constexpr int KSTR = MLA ? 104 : 72;
  constexpr int NKS = DK / 16;
  bf16_t* sK = (bf16_t*)smem;
  bf16_t* sV = sK + 2 * 64 * KSTR;
  const int tid = threadIdx.x, lane = tid & 63, w = tid >> 6, r = lane & 31, hh = lane >> 5;
  const int tokb = b * SEQL;
  const int tok0 = tokb + qb * 256;
  const int qw = qb * 256 + w * 32;

  bf16x8 qf[NKS];
  {
    const bf16_t* qptr = MLA ? (p.Qmla() + (size_t)(tok0 + w * 32 + r) * 768 + h * 96 + hh * 8) : (p.Qsb() + (size_t)(tok0 + w * 32 + r) * 512 + h * 64 + hh * 8);
#pragma unroll
    for (int ks = 0; ks < NKS; ++ks) qf[ks] = *(const bf16x8*)(qptr + ks * 16);
  }
  u32x2* zbuf = (u32x2*)(smem + 65536);
  u32x2 zpre[8];
  {
    const bf16_t* zg0 = (MLA ? p.Zmla() : p.Zsb()) + (size_t)(tok0 + w * 32 + r) * 512 + h * 64 + 4 * hh;
#pragma unroll
    for (int i = 0; i < 8; ++i) zpre[i] = *(const u32x2*)(zg0 + (i >> 2) * 32 + 8 * (i & 3));
  }
  bf16x8 tf[2];
  if (!MLA) {
#pragma unroll
    for (int st = 0; st < 2; ++st)
#pragma unroll
      for (int e = 0; e < 8; ++e) { const int j = 16 * st + 8 * (e >> 2) + 4 * hh + (e & 3); tf[st][e] = (j >= r) ? (short)0x3F80 : (short)0; }
  }

  f32x16 oacc[2];
#pragma unroll
  for (int i = 0; i < 16; ++i) { oacc[0][i] = 0.f; oacc[1][i] = 0.f; }
  float carry = 0.f;
  float mrun = 0.f, lrun = 0.f;

  const bf16_t* Kg = MLA ? p.Knope() : p.Ksb();
  const bf16_t* VTg = (MLA ? p.VTmla() : p.VTsb()) + (size_t)((b * 8 + h) * 64) * SEQL;
  const int nt = 4 * qb + 4;

  uint4 xk0, xv0, xp, yk0, yv0, yp;
  xp = make_uint4(0, 0, 0, 0); yp = xp;
  const int prow = tid >> 3, pch = tid & 7;
  const bf16_t* kgp = Kg + (size_t)(tokb + prow) * 512 + h * 64 + pch * 8;
  const bf16_t* vgp = VTg + (size_t)prow * SEQL + pch * 8;
  const bf16_t* pgp = p.KPE() + (size_t)(tokb + ((tid & 255) >> 2)) * 32 + (tid & 3) * 8;
#define ATT_GLOAD(P, kt_)                                                          \
  {                                                                                \
    const int kt__ = (kt_);                                                        \
    P##k0 = *(const uint4*)(kgp + (size_t)(kt__ * 64) * 512);                      \
    P##v0 = *(const uint4*)(vgp + kt__ * 64);                                      \
    if (MLA && tid < 256) P##p = *(const uint4*)(pgp + (size_t)(kt__ * 64) * 32);  \
  }
#define ATT_SWRITE(P, buf_)                                                        \
  {                                                                                \
    bf16_t* dK = sK + (buf_) * 64 * KSTR;                                          \
    bf16_t* dV = sV + (buf_) * 64 * VSTR;                                          \
    *(uint4*)(dK + prow * KSTR + pch * 8) = P##k0;                                 \
    uint2* dv0 = (uint2*)(dV + prow * VSTR + pch * 8);                             \
    dv0[0] = make_uint2(P##v0.x, P##v0.y); dv0[1] = make_uint2(P##v0.z, P##v0.w);  \
    if (MLA && tid < 256) *(uint4*)(dK + (tid >> 2) * KSTR + 64 + (tid & 3) * 8) = P##p; \
  }
#define ATT_KT(i_) (MLA ? (i_) : (nt - 1 - (i_)))

  ATT_GLOAD(x, ATT_KT(0));
  ATT_GLOAD(y, ATT_KT(1));
  ATT_SWRITE(x, 0);
#pragma unroll
  for (int i = 0; i < 8; ++i) zbuf[i * 512 + tid] = zpre[i];
  __syncthreads();
  bool alive = true;
  for (int it0 = 0; alive; it0 += 2) {
#pragma unroll
   for (int half = 0; half < 2; ++half) {
    const int it = it0 + half;
    const int kt = ATT_KT(it);
    const int cur = half;
    const bool more = (it + 1 < nt);
    if (it + 2 < nt) { if (half == 0) ATT_GLOAD(x, ATT_KT(it + 2)) else ATT_GLOAD(y, ATT_KT(it + 2)) }
    const bf16_t* cK = sK + cur * 64 * KSTR;
    const bf16_t* cV = sV + cur * 64 * VSTR;
    if (MLA) {
      if (kt * 64 <= qw + 31) {
        f32x16 s0, s1;
        {
          const float sinit = -mrun;
#pragma unroll
          for (int i = 0; i < 16; ++i) { s0[i] = sinit; s1[i] = sinit; }
        }
        __builtin_amdgcn_s_setprio(1);
#pragma unroll
        for (int ks = 0; ks < NKS; ++ks) {
          const bf16x8 k0 = *(const bf16x8*)(cK + r * KSTR + ks * 16 + hh * 8);
          const bf16x8 k1 = *(const bf16x8*)(cK + (32 + r) * KSTR + ks * 16 + hh * 8);
          s0 = MFMA(k0, qf[ks], s0);
          s1 = MFMA(k1, qf[ks], s1);
        }
        __builtin_amdgcn_s_setprio(0);
        if (kt * 64 + 63 > qw) {
          const int lim = qw + r - kt * 64;
#pragma unroll
          for (int i = 0; i < 16; ++i) { if (crow(i, hh) > lim) s0[i] = -1e30f; if (32 + crow(i, hh) > lim) s1[i] = -1e30f; }
        }
        float m0 = fmaxf(fmaxf(s0[0], s0[1]), s0[2]), m1 = fmaxf(fmaxf(s1[0], s1[1]), s1[2]);
#pragma unroll
        for (int i = 3; i < 15; i += 2) { m0 = fmaxf(fmaxf(m0, s0[i]), s0[i + 1]); m1 = fmaxf(fmaxf(m1, s1[i]), s1[i + 1]); }
        float mloc = fmaxf(fmaxf(m0, s0[15]), fmaxf(m1, s1[15]));
        mloc = half_max(mloc);
        const bool first = (it == 0);
        const float delta = first ? mloc : fmaxf(mloc, 0.f);
        if (first || __builtin_amdgcn_ballot_w64(delta > 0.f) != 0ull) {
          const float alpha = first ? 0.f : __builtin_amdgcn_exp2f(-delta);
          mrun += delta;
          lrun *= alpha;
#pragma unroll
          for (int i = 0; i < 16; ++i) { oacc[0][i] *= alpha; oacc[1][i] *= alpha; s0[i] -= delta; s1[i] -= delta; }
        }
        float ps0 = 0.f, ps1 = 0.f;
#pragma unroll
        for (int i = 0; i < 16; ++i) { s0[i] = __builtin_amdgcn_exp2f(s0[i]); s1[i] = __builtin_amdgcn_exp2f(s1[i]); ps0 += s0[i]; ps1 += s1[i]; }
        lrun += ps0 + ps1;
        bf16x8 pf4[4];
        pf4[0] = pack8(s0[0], s0[1], s0[2], s0[3], s0[4], s0[5], s0[6], s0[7]);
        pf4[1] = pack8(s0[8], s0[9], s0[10], s0[11], s0[12], s0[13], s0[14], s0[15]);
        pf4[2] = pack8(s1[0], s1[1], s1[2], s1[3], s1[4], s1[5], s1[6], s1[7]);
        pf4[3] = pack8(s1[8], s1[9], s1[10], s1[11], s1[12], s1[13], s1[14], s1[15]);
        __builtin_amdgcn_s_setprio(1);
#pragma unroll
        for (int st = 0; st < 4; ++st)
#pragma unroll
          for (int dt = 0; dt < 2; ++dt) {
            const bf16_t* vp = cV + (dt * 32 + r) * VSTR + st * 16 + 4 * hh;
            const s16x4 lo = *(const s16x4*)vp;
            const s16x4 hi = *(const s16x4*)(vp + 8);
            const bf16x8 vf = __builtin_shufflevector(lo, hi, 0, 1, 2, 3, 4, 5, 6, 7);
            oacc[dt] = MFMA(vf, pf4[st], oacc[dt]);
          }
        __builtin_amdgcn_s_setprio(0);
      }
    } else
#pragma unroll
    for (int si = 0; si < 2; ++si) {
      const int sub = MLA ? si : (1 - si);
      const int kb = kt * 64 + sub * 32;
      if (kb > qw) continue;
      const bool diag = (kb == qw);
      f32x16 s;
      {
        const float sinit = MLA ? -mrun : 0.f;
#pragma unroll
        for (int i = 0; i < 16; ++i) s[i] = sinit;
      }
      __builtin_amdgcn_s_setprio(1);
#pragma unroll
      for (int ks = 0; ks < NKS; ++ks) {
        const bf16x8 kf = *(const bf16x8*)(cK + (sub * 32 + r) * KSTR + ks * 16 + hh * 8);
        s = MFMA(kf, qf[ks], s);
      }
      __builtin_amdgcn_s_setprio(0);
      bf16x8 pf[2];
      if (!MLA) {
        float sp[16];
        float tsum = 0.f;
#pragma unroll
        for (int i = 0; i < 16; ++i) {
          const float z = s[i];
          float v = __builtin_amdgcn_logf(1.f + __builtin_amdgcn_exp2f(fminf(z, 126.f)));
          if (diag && !(crow(i, hh) < r)) v = 0.f;
          sp[i] = v;
          tsum += v;
        }
        f32x16 cacc;
#pragma unroll
        for (int i = 0; i < 16; ++i) cacc[i] = carry;
        cacc = MFMA(tf[0], pack8(sp[0], sp[1], sp[2], sp[3], sp[4], sp[5], sp[6], sp[7]), cacc);
        cacc = MFMA(tf[1], pack8(sp[8], sp[9], sp[10], sp[11], sp[12], sp[13], sp[14], sp[15]), cacc);
        float pr[16];
#pragma unroll
        for (int i = 0; i < 16; ++i) {
          float v = __builtin_amdgcn_exp2f(s[i] - cacc[i]);
          if (diag && !(crow(i, hh) < r)) v = 0.f;
          pr[i] = v;
        }
        carry += half_sum(tsum);
        pf[0] = pack8(pr[0], pr[1], pr[2], pr[3], pr[4], pr[5], pr[6], pr[7]);
        pf[1] = pack8(pr[8], pr[9], pr[10], pr[11], pr[12], pr[13], pr[14], pr[15]);
      } else {
        if (diag) {
#pragma unroll
          for (int i = 0; i < 16; ++i) if (!(crow(i, hh) <= r)) s[i] = -1e30f;
        }
        float mloc = fmaxf(fmaxf(s[0], s[1]), s[2]);
#pragma unroll
        for (int i = 3; i < 15; i += 2) mloc = fmaxf(fmaxf(mloc, s[i]), s[i + 1]);
        mloc = fmaxf(mloc, s[15]);
        mloc = half_max(mloc);
        const bool first = (it == 0) && (si == 0);
        const float delta = first ? mloc : fmaxf(mloc, 0.f);
        if (first || __builtin_amdgcn_ballot_w64(delta > 0.f) != 0ull) {
          const float alpha = first ? 0.f : __builtin_amdgcn_exp2f(-delta);
          mrun += delta;
          lrun *= alpha;
#pragma unroll
          for (int i = 0; i < 16; ++i) { oacc[0][i] *= alpha; oacc[1][i] *= alpha; s[i] -= delta; }
        }
        float pr[16];
        float ps0 = 0.f, ps1 = 0.f;
#pragma unroll
        for (int i = 0; i < 16; i += 2) { pr[i] = __builtin_amdgcn_exp2f(s[i]); pr[i + 1] = __builtin_amdgcn_exp2f(s[i + 1]); ps0 += pr[i]; ps1 += pr[i + 1]; }
        lrun += ps0 + ps1;
        pf[0] = pack8(pr[0], pr[1], pr[2], pr[3], pr[4], pr[5], pr[6], pr[7]);
        pf[1] = pack8(pr[8], pr[9], pr[10], pr[11], pr[12], pr[13], pr[14], pr[15]);
      }
      __builtin_amdgcn_s_setprio(1);
#pragma unroll
      for (int dt = 0; dt < 2; ++dt)
#pragma unroll
        for (int st = 0; st < 2; ++st) {
          const bf16_t* vp = cV + (dt * 32 + r) * VSTR + sub * 32 + st * 16 + 4 * hh;
          const s16x4 lo = *(const s16x4*)vp;
          const s16x4 hi = *(const s16x4*)(vp + 8);
          const bf16x8 vf = __builtin_shufflevector(lo, hi, 0, 1, 2, 3, 4, 5, 6, 7);
          oacc[dt] = MFMA(vf, pf[st], oacc[dt]);
        }
      __builtin_amdgcn_s_setprio(0);
    }
    if (more) { if (half == 0) ATT_SWRITE(y, 1) else ATT_SWRITE(x, 0) }
    if (!MLA) {
      int* flg = (int*)(smem + SMEM_BYTES - 128) + (it & 1) * 8;
      const bool wok = (__builtin_amdgcn_ballot_w64(carry >= 160.f) == ~0ull);
      if (lane == 0) flg[w] = wok ? 1 : 0;
      __syncthreads();
      alive = more && ((flg[0] & flg[1] & flg[2] & flg[3] & flg[4] & flg[5] & flg[6] & flg[7]) == 0);
    } else {
      __syncthreads();
      alive = more;
    }
    if (!alive) break;
   }
  }
#undef ATT_GLOAD
#undef ATT_SWRITE
#undef ATT_KT
  if (threadIdx.x == 0 && pre_ctr) pre_raw = atomicAdd(pre_ctr, 1);
  float inv = 1.f;
  if (MLA) { const float lt = half_sum(lrun); inv = 1.f / lt; }
  const int tok = tok0 + w * 32 + r;
  bf16_t* og = (MLA ? p.OBg() : p.OAg()) + (size_t)tok * 512 + h * 64;
#pragma unroll
  for (int dt = 0; dt < 2; ++dt)
#pragma unroll
    for (int g = 0; g < 4; ++g) {
      const int d = dt * 32 + 8 * g + 4 * hh;
      const u32x2 zz = zbuf[(dt * 4 + g) * 512 + tid];
      const float z0 = __uint_as_float(zz[0] << 16), z1 = __uint_as_float(zz[0] & 0xffff0000u);
      const float z2 = __uint_as_float(zz[1] << 16), z3 = __uint_as_float(zz[1] & 0xffff0000u);
      u32x2 o;
      o[0] = pk2(oacc[dt][4 * g] * inv * z0, oacc[dt][4 * g + 1] * inv * z1);
      o[1] = pk2(oacc[dt][4 * g + 2] * inv * z2, oacc[dt][4 * g + 3] * inv * z3);
      *(u32x2*)(og + d) = o;
    }
}

DI void phase_attn(const Params& p, char* smem, int cbase, int only) {
  int* s_item = (int*)(smem + SMEM_BYTES - 16);
  const int q0 = blockIdx.x & 7;
  int qi = 0;
  int pre_raw = 0;
  bool has_pre = false;
  for (;;) {
    if (threadIdx.x < 64) {
      int item = -1;
      while (qi < 8) {
        const int q = (q0 + qi) & 7;
        int idx = 0;
        if (has_pre) { idx = pre_raw; has_pre = false; }
        else if (threadIdx.x == 0) idx = atomicAdd(p.counter() + cbase + q, 1);
        idx = __builtin_amdgcn_readfirstlane(idx);
        if (idx < 128) { item = q * 256 + idx; break; }
        const int lq = (q0 + (threadIdx.x & 7)) & 7;
        const int head = __hip_atomic_load(p.counter() + cbase + lq, __ATOMIC_RELAXED, __HIP_MEMORY_SCOPE_AGENT);
        const unsigned long long avail = __builtin_amdgcn_ballot_w64((threadIdx.x < 8) && (head < 128) && ((int)(threadIdx.x & 7) > qi));
        if (avail == 0ull) { qi = 8; break; }
        qi = __builtin_ctzll(avail);
      }
      if (threadIdx.x == 0) *s_item = item;
    }
    __syncthreads();
    const int item = *s_item;
    __syncthreads();
    if (item < 0) break;
    const int q = item >> 8, idx = item & 255;
    const int i2 = idx & 63;
    const int bh = q + 8 * (i2 & 3);
    const int qb = 15 - (i2 >> 2);
    int* pre_ctr = p.counter() + cbase + ((q0 + qi) & 7);
    if (idx < 64) { if (only != 2) { attn_item<true>(p, bh >> 3, bh & 7, qb, smem, pre_ctr, pre_raw); has_pre = true; } }
    else { if (only != 1) { attn_item<false>(p, bh >> 3, bh & 7, qb, smem, pre_ctr, pre_raw); has_pre = true; } }
  }
}

DI void g3_pre_a(const Params& p, const int m0, const int n0, u32x4 (&g)[4]) {
  const int txo = opaque_tid();
#pragma unroll
  for (int i = 0; i < 4; ++i) {
    const int c = txo + 512 * i, row = c >> 4, cc = (c & 15) * 8;
    g[i] = *(const u32x4*)(p.GA() + (size_t)(m0 + row) * 1024 + n0 + cc);
  }
}
DI void g3_epi_a(const Params& p, const float* sC, const int m0, const int n0, const u32x4 (&gq)[4]) {
  const int txo = opaque_tid();
#pragma unroll
  for (int i = 0; i < 4; ++i) {
    const int c = txo + 512 * i, row = c >> 4, cc = (c & 15) * 8;
    const u32x4 g = gq[i];
    const float4 a = *(const float4*)(sC + row * CSTR + cc), b = *(const float4*)(sC + row * CSTR + cc + 4);
    u32x4 y;
    y[0] = pk2(a.x * __uint_as_float(g[0] << 16), a.y * __uint_as_float(g[0] & 0xffff0000u));
    y[1] = pk2(a.z * __uint_as_float(g[1] << 16), a.w * __uint_as_float(g[1] & 0xffff0000u));
    y[2] = pk2(b.x * __uint_as_float(g[2] << 16), b.y * __uint_as_float(g[2] & 0xffff0000u));
    y[3] = pk2(b.z * __uint_as_float(g[3] << 16), b.w * __uint_as_float(g[3] & 0xffff0000u));
    *(u32x4*)(p.MERGED() + (size_t)(m0 + row) * 1024 + n0 + cc) = y;
  }
}
DI void g3_pre_b(const Params& p, const int m0, const int n0, u32x4 (&g)[4], u32x4 (&y)[4]) {
  const int txo2 = opaque_tid();
#pragma unroll
  for (int i = 0; i < 4; ++i) {
    const int c = txo2 + 512 * i, row = c >> 4, cc = (c & 15) * 8;
    g[i] = *(const u32x4*)(p.GB() + (size_t)(m0 + row) * 1024 + n0 + cc);
    y[i] = *(const u32x4*)(p.MERGED() + (size_t)(m0 + row) * 1024 + n0 + cc);
  }
}
DI void g3_epi_b(const Params& p, const float* sC, const int m0, const int n0, const u32x4 (&gq)[4], const u32x4 (&yq)[4]) {
  const int txo2 = opaque_tid();
#pragma unroll
  for (int i = 0; i < 4; ++i) {
    const int c = txo2 + 512 * i, row = c >> 4, cc = (c & 15) * 8;
    const u32x4 g = gq[i];
    const u32x4 yv = yq[i];
    const float4 a = *(const float4*)(sC + row * CSTR + cc), b = *(const float4*)(sC + row * CSTR + cc + 4);
    u32x4 o;
    o[0] = pk2(__uint_as_float(yv[0] << 16) + a.x * __uint_as_float(g[0] << 16), __uint_as_float(yv[0] & 0xffff0000u) + a.y * __uint_as_float(g[0] & 0xffff0000u));
    o[1] = pk2(__uint_as_float(yv[1] << 16) + a.z * __uint_as_float(g[1] << 16), __uint_as_float(yv[1] & 0xffff0000u) + a.w * __uint_as_float(g[1] & 0xffff0000u));
    o[2] = pk2(__uint_as_float(yv[2] << 16) + b.x * __uint_as_float(g[2] << 16), __uint_as_float(yv[2] & 0xffff0000u) + b.y * __uint_as_float(g[2] & 0xffff0000u));
    o[3] = pk2(__uint_as_float(yv[3] << 16) + b.z * __uint_as_float(g[3] << 16), __uint_as_float(yv[3] & 0xffff0000u) + b.w * __uint_as_float(g[3] & 0xffff0000u));
    *(u32x4*)(p.MERGED() + (size_t)(m0 + row) * 1024 + n0 + cc) = o;
  }
}
DI void phase_g3(const Params& p, char* smem) {
  bf16_t* shm = (bf16_t*)smem;
  float* sC = (float*)smem;
  const int xq = blockIdx.x & 7, lb = blockIdx.x >> 3, nlb = gridDim.x >> 3;
  const bool xmap = (gridDim.x & 7) == 0;
  for (int t = xmap ? lb : (int)blockIdx.x; t < (xmap ? 32 : 256); t += (xmap ? nlb : (int)gridDim.x)) {
    const int rt = xmap ? (8 * xq + (t & 7)) : (t >> 2), ct = xmap ? (t >> 3) : (t & 3);
    const int m0 = rt * 256, n0 = ct * 256;
    f32x4 acc[2][2][4][2];
    zero_acc8(acc);
    gemm8_tile(p.OAg() + (size_t)m0 * 512, p.WaT() + (size_t)n0 * 512, 512, shm, acc);
#pragma unroll
    for (int ai = 0; ai < 2; ++ai)
#pragma unroll
      for (int bj = 0; bj < 2; ++bj) {
        u32x4 gq[4];
        g3_pre_a(p, m0 + ai * 128, n0 + bj * 128, gq);
        __syncthreads();
        accq_to_lds(acc[ai][bj], sC);
        __syncthreads();
        g3_epi_a(p, sC, m0 + ai * 128, n0 + bj * 128, gq);
      }
    __syncthreads();
    zero_acc8(acc);
    gemm8_tile(p.OBg() + (size_t)m0 * 512, p.WbT() + (size_t)n0 * 512, 512, shm, acc);
#pragma unroll
    for (int ai = 0; ai < 2; ++ai)
#pragma unroll
      for (int bj = 0; bj < 2; ++bj) {
        u32x4 gq[4], yq[4];
        g3_pre_b(p, m0 + ai * 128, n0 + bj * 128, gq, yq);
        __syncthreads();
        accq_to_lds(acc[ai][bj], sC);
        __syncthreads();
        g3_epi_b(p, sC, m0 + ai * 128, n0 + bj * 128, gq, yq);
      }
    __syncthreads();
  }
}

DI void g4_pre(const Params& p, const int m0, const int n0, float4 (&xq)[8]) {
  const int txo = opaque_tid();
#pragma unroll
  for (int i = 0; i < 4; ++i) {
    const int c = txo + 512 * i, row = c >> 4, cc = (c & 15) * 8;
    const size_t go = (size_t)(m0 + row) * 1024 + n0 + cc;
    xq[2 * i] = ldnt4(p.x + go); xq[2 * i + 1] = ldnt4(p.x + go + 4);
  }
}
DI void g4_epi(const Params& p, const float* sC, const float* gt, const int m0, const int n0, const float4 (&xq)[8]) {
  const int txo = opaque_tid();
#pragma unroll
  for (int i = 0; i < 4; ++i) {
    const int c = txo + 512 * i, row = c >> 4, cc = (c & 15) * 8;
    const size_t go = (size_t)(m0 + row) * 1024 + n0 + cc;
    const float4 x0 = xq[2 * i], x1 = xq[2 * i + 1];
    const float4 a = *(const float4*)(sC + row * CSTR + cc), b = *(const float4*)(sC + row * CSTR + cc + 4);
    const float4 g0 = *(const float4*)(gt + cc), g1 = *(const float4*)(gt + cc + 4);
    float4 o0, o1;
    o0.x = x0.x + g0.x * a.x; o0.y = x0.y + g0.y * a.y; o0.z = x0.z + g0.z * a.z; o0.w = x0.w + g0.w * a.w;
    o1.x = x1.x + g1.x * b.x; o1.y = x1.y + g1.y * b.y; o1.z = x1.z + g1.z * b.z; o1.w = x1.w + g1.w * b.w;
    *(float4*)(p.out + go) = o0;
    *(float4*)(p.out + go + 4) = o1;
  }
}
DI void phase_g4(const Params& p, char* smem) {
  bf16_t* shm = (bf16_t*)smem;
  float* sC = (float*)smem;
  float* rs = (float*)(smem + RS_OFF);
  const int xq = blockIdx.x & 7, lb = blockIdx.x >> 3, nlb = gridDim.x >> 3;
  const bool xmap = (gridDim.x & 7) == 0;
  for (int t = xmap ? lb : (int)blockIdx.x; t < (xmap ? 32 : 256); t += (xmap ? nlb : (int)gridDim.x)) {
    const int rt = xmap ? (8 * xq + (t & 7)) : (t >> 2), ct = xmap ? (t >> 3) : (t & 3);
    const int m0 = rt * 256, n0 = ct * 256;
    f32x4 acc[2][2][4][2];
    zero_acc8(acc);
    if (threadIdx.x < 256) rs[threadIdx.x] = mod_get(p.MOD(), m0 >> 12, 2048 + n0 + threadIdx.x);
    gemm8_tile(p.MERGED() + (size_t)m0 * 1024, p.WoT() + (size_t)n0 * 1024, 1024, shm, acc);
#pragma unroll
    for (int ai = 0; ai < 2; ++ai)
#pragma unroll
      for (int bj = 0; bj < 2; ++bj) {
        float4 xq[8];
        g4_pre(p, m0 + ai * 128, n0 + bj * 128, xq);
        __syncthreads();
        accq_to_lds(acc[ai][bj], sC);
        __syncthreads();
        g4_epi(p, sC, rs + bj * 128, m0 + ai * 128, n0 + bj * 128, xq);
      }
    __syncthreads();
  }
}

DI void phase_final(const Params& p) {
  const int lane = threadIdx.x & 63, w = threadIdx.x >> 6;
  const int gw = blockIdx.x * 8 + w, nw = gridDim.x * 8;
  for (int row = gw; row < NTOK; row += nw) {
    float* xr = p.out + (size_t)row * DM;
    float4 v[4];
    float ss = 0.f;
#pragma unroll
    for (int i = 0; i < 4; ++i) {
      v[i] = *(const float4*)(xr + 4 * (lane + 64 * i));
      ss += v[i].x * v[i].x + v[i].y * v[i].y + v[i].z * v[i].z + v[i].w * v[i].w;
    }
#pragma unroll
    for (int o = 32; o >= 1; o >>= 1) ss += __shfl_xor(ss, o);
    const float rn = __builtin_amdgcn_rsqf(ss * (1.f / DM) + EPSN);
#pragma unroll
    for (int i = 0; i < 4; ++i) {
      const int e = 4 * (lane + 64 * i);
      const float4 g = *(const float4*)(p.fgain + e);
      float4 o;
      o.x = v[i].x * rn * g.x; o.y = v[i].y * rn * g.y; o.z = v[i].z * rn * g.z; o.w = v[i].w * rn * g.w;
      __builtin_nontemporal_store(o.x, xr + e); __builtin_nontemporal_store(o.y, xr + e + 1); __builtin_nontemporal_store(o.z, xr + e + 2); __builtin_nontemporal_store(o.w, xr + e + 3);
    }
  }
}

template <int PH>
__global__ void __launch_bounds__(NTHREADS, 2) mega_kernel(Params p) {
  __shared__ __attribute__((aligned(16))) char smem[SMEM_BYTES];
  if (PH < 0) {
    if (p.ws == nullptr) cg::this_grid().sync();
    volatile LAS unsigned* xst = (volatile LAS unsigned*)(smem + SMEM_BYTES - 32);
    if (threadIdx.x == 0) { xst[0] = 0u; xst[1] = 0u; }
    __syncthreads();
    (void)xcd_barrier_post(p.bar(), xst);
    phase_prep(p, smem); xcd_barrier(p.bar(), (volatile LAS unsigned*)(smem + SMEM_BYTES - 32));
#if PROBE_DUP == 4
    phase_prep(p, smem); xcd_barrier(p.bar(), (volatile LAS unsigned*)(smem + SMEM_BYTES - 32));
#endif
    phase_h(p, smem); xcd_barrier(p.bar(), (volatile LAS unsigned*)(smem + SMEM_BYTES - 32));
#if PROBE_DUP == 5
    phase_h(p, smem); xcd_barrier(p.bar(), (volatile LAS unsigned*)(smem + SMEM_BYTES - 32));
#endif
    phase_g1(p, smem); xcd_barrier(p.bar(), (volatile LAS unsigned*)(smem + SMEM_BYTES - 32));
#if PROBE_DUP == 1
    phase_g1(p, smem, false); xcd_barrier(p.bar(), (volatile LAS unsigned*)(smem + SMEM_BYTES - 32));
#endif
    phase_g2(p, smem); xcd_barrier(p.bar(), (volatile LAS unsigned*)(smem + SMEM_BYTES - 32));
#if PROBE_DUP == 8
    phase_g2(p, smem); xcd_barrier(p.bar(), (volatile LAS unsigned*)(smem + SMEM_BYTES - 32));
#endif
    phase_attn(p, smem, 0, 0); xcd_barrier(p.bar(), (volatile LAS unsigned*)(smem + SMEM_BYTES - 32));
#if PROBE_DUP == 2
    phase_attn(p, smem, 8, 1); xcd_barrier(p.bar(), (volatile LAS unsigned*)(smem + SMEM_BYTES - 32));
#endif
#if PROBE_DUP == 3
    phase_attn(p, smem, 8, 2); xcd_barrier(p.bar(), (volatile LAS unsigned*)(smem + SMEM_BYTES - 32));
#endif
    phase_g3(p, smem); xcd_barrier(p.bar(), (volatile LAS unsigned*)(smem + SMEM_BYTES - 32));
#if PROBE_DUP == 6
    phase_g3(p, smem); xcd_barrier(p.bar(), (volatile LAS unsigned*)(smem + SMEM_BYTES - 32));
#endif
    phase_g4(p, smem); xcd_barrier(p.bar(), (volatile LAS unsigned*)(smem + SMEM_BYTES - 32));
#if PROBE_DUP == 7
    phase_g4(p, smem); xcd_barrier(p.bar(), (volatile LAS unsigned*)(smem + SMEM_BYTES - 32));
#endif
    phase_final(p);
  } else {
    if (PH == 0) phase_prep(p, smem);
    if (PH == 1) phase_h(p, smem);
    if (PH == 2) phase_g1(p, smem);
    if (PH == 3) phase_g2(p, smem);
    if (PH == 4) phase_attn(p, smem, 0, 0);
    if (PH == 5) phase_g3(p, smem);
    if (PH == 6) phase_g4(p, smem);
    if (PH == 7) phase_final(p);
  }
}

#ifndef PROBE_DUP
#define PROBE_DUP 0
#endif
#ifndef MK_SPLIT
#define MK_SPLIT 0
#endif

extern "C" void kernel_launch(void* const* d_in, const int* in_sizes, int n_in, void* d_out, int out_size, void* d_ws, size_t ws_size, hipStream_t stream) {
  Params p{};
  p.x = (const float*)d_in[0]; p.c = (const float*)d_in[1]; p.pos = (const int*)d_in[2];
  p.w_ada = (const float*)d_in[3]; p.b_ada = (const float*)d_in[4]; p.norm_gain = (const float*)d_in[5];
  p.w_in = (const float*)d_in[6]; p.q_gain = (const float*)d_in[7]; p.w_uq = (const float*)d_in[8];
  p.kv_gain = (const float*)d_in[9]; p.w_ukv = (const float*)d_in[10]; p.w_a = (const float*)d_in[11];
  p.w_b = (const float*)d_in[12]; p.w_out = (const float*)d_in[13]; p.fgain = (const float*)d_in[14];
  p.out = (float*)d_out;
  p.ws = (char*)d_ws;
  if (WS_NEED > ws_size) { fprintf(stderr, "workspace too small: need %zu have %zu\n", (size_t)WS_NEED, ws_size); return; }

  static int grid_blocks = 0;
  if (!grid_blocks) {
    int dev = 0, cus = 0, per_cu = 0;
    hipGetDevice(&dev);
    hipDeviceGetAttribute(&cus, hipDeviceAttributeMultiprocessorCount, dev);
    hipOccupancyMaxActiveBlocksPerMultiprocessor(&per_cu, mega_kernel<-1>, NTHREADS, 0);
    per_cu = 1;
    grid_blocks = cus * per_cu;
  }
#if MK_SPLIT
  mega_kernel<0><<<grid_blocks, NTHREADS, 0, stream>>>(p);
  mega_kernel<1><<<grid_blocks, NTHREADS, 0, stream>>>(p);
  mega_kernel<2><<<grid_blocks, NTHREADS, 0, stream>>>(p);
  mega_kernel<3><<<grid_blocks, NTHREADS, 0, stream>>>(p);
  mega_kernel<4><<<grid_blocks, NTHREADS, 0, stream>>>(p);
  mega_kernel<5><<<grid_blocks, NTHREADS, 0, stream>>>(p);
  mega_kernel<6><<<grid_blocks, NTHREADS, 0, stream>>>(p);
  mega_kernel<7><<<grid_blocks, NTHREADS, 0, stream>>>(p);
#else
  hipMemsetAsync((char*)d_ws + OFF_bar, 0, XCD_BAR_WORDS * 4, stream);
  void* args[] = {&p};
  hipError_t e = hipLaunchCooperativeKernel((void*)mega_kernel<-1>, dim3(grid_blocks), dim3(NTHREADS), args, 0, stream);
  if (e != hipSuccess) fprintf(stderr, "cooperative launch failed: %s (grid %d)\n", hipGetErrorString(e), grid_blocks);
#endif
}
```

```cpp
#include <hip/hip_runtime.h>
#include <hip/hip_cooperative_groups.h>
#include <stdint.h>
#include <stdio.h>
namespace cg = cooperative_groups;
#ifndef PROBE_DUP
#define PROBE_DUP 0
#endif

#define DI __device__ __forceinline__
typedef unsigned short bf16_t;
typedef __attribute__((ext_vector_type(8))) short bf16x8;
typedef __attribute__((ext_vector_type(4))) short s16x4;
typedef __attribute__((ext_vector_type(16))) float f32x16;
typedef __attribute__((ext_vector_type(2))) float f32x2;
typedef __attribute__((ext_vector_type(2))) __bf16 bf16x2v;
typedef __attribute__((ext_vector_type(4))) unsigned u32x4;
typedef __attribute__((ext_vector_type(2))) unsigned u32x2;
typedef __attribute__((ext_vector_type(4))) float f32x4;
#define MFMA(a, b, c) __builtin_amdgcn_mfma_f32_32x32x16_bf16((a), (b), (c), 0, 0, 0)

constexpr int NTOK = 16384, SEQL = 4096, DM = 1024;
constexpr int INW = 5280, INWP = 5376;
constexpr int NTHREADS = 512;
constexpr float LOG2E = 1.4426950408889634f;
constexpr float QS_SCALE = 0.125f * 1.4426950408889634f;
constexpr float QM_SCALE = 1.4426950408889634f / 9.797958971132712f;
constexpr float EPSN = 1e-6f;

constexpr int XCD_BAR_WORDS_C = 3456;
constexpr size_t al256(size_t v) { return (v + 255) & ~(size_t)255; }
constexpr size_t OFF_counter = 0;
constexpr size_t OFF_bar = OFF_counter + al256(256);
constexpr size_t OFF_MOD = OFF_bar + al256(XCD_BAR_WORDS_C * 4);
constexpr size_t OFF_ROPE = OFF_MOD + al256(4 * 3072 * 4 * 4);
constexpr size_t OFF_SSQ = OFF_ROPE + al256((size_t)NTOK * 32 * 4);
constexpr size_t OFF_Hb = OFF_SSQ + al256((size_t)2 * NTOK * 4);
constexpr size_t OFF_Qmla = OFF_Hb + al256((size_t)NTOK * 1024 * 2);
constexpr size_t OFF_WuqT = OFF_Qmla + al256((size_t)NTOK * 768 * 2);
constexpr size_t OFF_WukvT = OFF_WuqT + al256((size_t)768 * 384 * 2);
constexpr size_t OFF_WaT = OFF_WukvT + al256((size_t)1024 * 256 * 2);
constexpr size_t OFF_WbT = OFF_WaT + al256((size_t)1024 * 512 * 2);
constexpr size_t OFF_WoT = OFF_WbT + al256((size_t)1024 * 512 * 2);
constexpr size_t OFF_Qsb = OFF_WoT + al256((size_t)1024 * 1024 * 2);
constexpr size_t OFF_Ksb = OFF_Qsb + al256((size_t)NTOK * 512 * 2);
constexpr size_t OFF_VTsb = OFF_Ksb + al256((size_t)NTOK * 512 * 2);
constexpr size_t OFF_Zsb = OFF_VTsb + al256((size_t)NTOK * 512 * 2);
constexpr size_t OFF_OAg = OFF_Zsb + al256((size_t)NTOK * 512 * 2);
constexpr size_t OFF_OBg = OFF_OAg + al256((size_t)NTOK * 512 * 2);
constexpr size_t OFF_Zmla = OFF_OBg + al256((size_t)NTOK * 512 * 2);
constexpr size_t OFF_KPE = OFF_Zmla + al256((size_t)NTOK * 512 * 2);
constexpr size_t OFF_Knope = OFF_KPE + al256((size_t)NTOK * 32 * 2);
constexpr size_t OFF_VTmla = OFF_Knope + al256((size_t)NTOK * 512 * 2);
constexpr size_t OFF_WinT = OFF_VTmla + al256((size_t)NTOK * 512 * 2);
constexpr size_t WS_NEED = OFF_WinT + al256((size_t)INWP * 1024 * 2);
struct Params {
  const float *x, *c; const int* pos;
  const float *w_ada, *b_ada, *norm_gain, *w_in, *q_gain, *w_uq, *kv_gain, *w_ukv, *w_a, *w_b, *w_out, *fgain;
  float* out;
  char* ws;
  DI int* counter() const { return (int*)(ws + OFF_counter); }
  DI unsigned* bar() const { return (unsigned*)(ws + OFF_bar); }
  DI float* MOD() const { return (float*)(ws + OFF_MOD); }
  DI float* ROPE() const { return (float*)(ws + OFF_ROPE); }
  DI float* SSQ() const { return (float*)(ws + OFF_SSQ); }
  DI bf16_t* Hb() const { return (bf16_t*)(ws + OFF_Hb); }
  DI bf16_t* Qmla() const { return (bf16_t*)(ws + OFF_Qmla); }
  DI bf16_t* WuqT() const { return (bf16_t*)(ws + OFF_WuqT); }
  DI bf16_t* WukvT() const { return (bf16_t*)(ws + OFF_WukvT); }
  DI bf16_t* WaT() const { return (bf16_t*)(ws + OFF_WaT); }
  DI bf16_t* WbT() const { return (bf16_t*)(ws + OFF_WbT); }
  DI bf16_t* WoT() const { return (bf16_t*)(ws + OFF_WoT); }
  DI bf16_t* Qsb() const { return (bf16_t*)(ws + OFF_Qsb); }
  DI bf16_t* Ksb() const { return (bf16_t*)(ws + OFF_Ksb); }
  DI bf16_t* VTsb() const { return (bf16_t*)(ws + OFF_VTsb); }
  DI bf16_t* Zsb() const { return (bf16_t*)(ws + OFF_Zsb); }
  DI bf16_t* OAg() const { return (bf16_t*)(ws + OFF_OAg); }
  DI bf16_t* OBg() const { return (bf16_t*)(ws + OFF_OBg); }
  DI bf16_t* Zmla() const { return (bf16_t*)(ws + OFF_Zmla); }
  DI bf16_t* KPE() const { return (bf16_t*)(ws + OFF_KPE); }
  DI bf16_t* Knope() const { return (bf16_t*)(ws + OFF_Knope); }
  DI bf16_t* VTmla() const { return (bf16_t*)(ws + OFF_VTmla); }
  DI bf16_t* MERGED() const { return Hb(); }
  DI bf16_t* WinT() const { return (bf16_t*)(ws + OFF_WinT); }
  DI bf16_t* CQ() const { return OAg(); }
  DI bf16_t* CKV() const { return OBg(); }
  DI bf16_t* GA() const { return (bf16_t*)out; }
  DI bf16_t* GB() const { return (bf16_t*)out + (size_t)NTOK * 1024; }
};


__device__ const float c_invfreq[16] = {
  1.0f, 0.5623413251903491f, 0.31622776601683794f, 0.1778279410038923f, 0.1f, 0.05623413251903491f, 0.03162277660168379f,
  0.01778279410038923f, 0.01f, 0.005623413251903491f, 0.0031622776601683794f, 0.001778279410038923f, 0.001f,
  0.0005623413251903491f, 0.00031622776601683794f, 0.0001778279410038923f};

DI unsigned pk2(float a, float b) { f32x2 v = {a, b}; bf16x2v r = __builtin_convertvector(v, bf16x2v); return __builtin_bit_cast(unsigned, r); }
DI bf16_t tobf(float a) { return (bf16_t)(pk2(a, 0.f) & 0xffffu); }
DI float bf2f(unsigned short u) { return __uint_as_float(((unsigned)u) << 16); }
DI bf16x8 pack8(float a0, float a1, float a2, float a3, float a4, float a5, float a6, float a7) {
  u32x4 p; p[0] = pk2(a0, a1); p[1] = pk2(a2, a3); p[2] = pk2(a4, a5); p[3] = pk2(a6, a7);
  return __builtin_bit_cast(bf16x8, p);
}
DI int crow(int reg, int h) { return (reg & 3) + 8 * (reg >> 2) + 4 * h; }
DI int opaque_tid() { int t = threadIdx.x; asm volatile("" : "+v"(t)); return t; }
DI float half_max(float v) {
  unsigned u = __float_as_uint(v);
  auto r = __builtin_amdgcn_permlane32_swap(u, u, false, false);
  return fmaxf(__uint_as_float(r[0]), __uint_as_float(r[1]));
}
DI float half_sum(float v) {
  unsigned u = __float_as_uint(v);
  auto r = __builtin_amdgcn_permlane32_swap(u, u, false, false);
  return __uint_as_float(r[0]) + __uint_as_float(r[1]);
}
DI float sigmoidf_fast(float v) { return __builtin_amdgcn_rcpf(1.f + __builtin_amdgcn_exp2f(-v * LOG2E)); }
DI float siluf_fast(float v) { return v * sigmoidf_fast(v); }

#define XB_TMO      128
#define XB_XCNT(j)  (256  + 64 * (j))
#define XB_XSUB(j)  (1280 + 64 * (j))
#define XB_XGEN(j)  (2304 + 64 * (j))
#define XB_TOP      3328
#define XB_TOPGEN   3392
#define XCD_BAR_WORDS 3456
#define XB_SPIN_CAP (1u << 18)
#define LAS __attribute__((address_space(3)))
DI unsigned xb_ld(unsigned* p)              { return __hip_atomic_load(p, __ATOMIC_RELAXED, __HIP_MEMORY_SCOPE_AGENT); }
DI unsigned xb_add(unsigned* p, unsigned v) { return __hip_atomic_fetch_add(p, v, __ATOMIC_RELAXED, __HIP_MEMORY_SCOPE_AGENT); }
DI unsigned xb_xcc_id() { return (unsigned)__builtin_amdgcn_s_getreg((3 << 11) | 20) & 0xFu; }
#define XB_SPIN(cond, bar) do { unsigned _sp = 0; while (cond) { __builtin_amdgcn_s_sleep(1); \
    if ((++_sp & 255u) == 0u) { if (xb_ld(&(bar)[XB_TMO])) break; if (_sp > XB_SPIN_CAP) { atomicAdd(&(bar)[XB_TMO], 1u); break; } } } } while (0)
struct XcdBarrier { unsigned* bar; unsigned x; volatile LAS unsigned* st; };
DI XcdBarrier xcd_barrier_post(unsigned* bar, volatile LAS unsigned* st) {
  XcdBarrier b; b.bar = bar; b.x = xb_xcc_id(); b.st = st;
  if (threadIdx.x == 0) (void)xb_add(&bar[XB_XCNT(b.x)], 1u);
  return b;
}
DI void xcd_barrier_complete(unsigned* bar, unsigned x, unsigned& nloc, unsigned& nx) {
  const unsigned G = gridDim.x * gridDim.y * gridDim.z;
  unsigned sum, cnt, mine, sp = 0u;
  for (;;) {
    sum = 0u; cnt = 0u; mine = 0u;
#pragma unroll
    for (unsigned j = 0; j < 16; ++j) { const unsigned c = xb_ld(&bar[XB_XCNT(j)]); sum += c; cnt += (c > 0u) ? 1u : 0u; mine = (j == x) ? c : mine; }
    if (sum == G) break;
    __builtin_amdgcn_s_sleep(1);
    if ((++sp & 255u) == 0u) { if (xb_ld(&bar[XB_TMO])) break; if (sp > XB_SPIN_CAP) { atomicAdd(&bar[XB_TMO], 1u); break; } }
  }
  nloc = mine > 0u ? mine : 1u; nx = cnt > 0u ? cnt : 1u;
}
DI void xcd_barrier(unsigned* bar_, volatile LAS unsigned* st_) {
  XcdBarrier b; b.bar = bar_; b.st = st_; b.x = 0;
  asm volatile("s_waitcnt vmcnt(0)" ::: "memory");
  __syncthreads();
  if (threadIdx.x == 0) {
    unsigned* bar = b.bar;
    b.x = xb_xcc_id();
    __builtin_amdgcn_s_waitcnt(0);
    unsigned nloc = b.st[0], nx = b.st[1];
    if (nloc == 0u) { xcd_barrier_complete(bar, b.x, nloc, nx); b.st[0] = nloc; b.st[1] = nx; }
    const unsigned old = xb_add(&bar[XB_XSUB(b.x)], 1u);
    const unsigned gen = old / nloc;
    if (old + 1u == (gen + 1u) * nloc) {
      __builtin_amdgcn_fence(__ATOMIC_RELEASE, "agent");
      asm volatile("s_waitcnt vmcnt(0)" ::: "memory");
      const unsigned og = xb_add(&bar[XB_TOP], 1u);
      const unsigned tg = og / nx;
      if (og + 1u == (tg + 1u) * nx) xb_add(&bar[XB_TOPGEN], 1u);
      else XB_SPIN(xb_ld(&bar[XB_TOPGEN]) == tg, bar);
      __builtin_amdgcn_fence(__ATOMIC_ACQUIRE, "agent");
      xb_add(&bar[XB_XGEN(b.x)], 1u);
      asm volatile("s_waitcnt vmcnt(0)" ::: "memory");
    } else {
      XB_SPIN(xb_ld(&bar[XB_XGEN(b.x)]) == gen, bar);
      __builtin_amdgcn_fence(__ATOMIC_ACQUIRE, "agent");
      asm volatile("s_waitcnt vmcnt(0)" ::: "memory");
    }
  }
  __syncthreads();
}

constexpr int GSTR = 72;
constexpr int GBUF = 128 * GSTR;
constexpr int RS_OFF = 135168;
constexpr int SMEM_BYTES = RS_OFF + 4096;

constexpr int G8_HT = 128 * 64;
DI int lds_byte(int r, int c) { const int st = (r >> 4) * 2 + (c >> 5), rr = r & 15, cc = c & 31, ob = rr * 64 + cc * 2; return st * 1024 + (ob ^ (((ob >> 9) & 1) << 5)); }
DI void stage_rc(int b, int& R, int& C) { const int st = b / 1024, sb = b % 1024, swz = sb ^ (((sb >> 9) & 1) << 5); R = (st >> 1) * 16 + swz / 64; C = (st & 1) * 32 + (swz % 64) / 2; }

DI void gemm8_tile(const bf16_t* __restrict__ A, const bf16_t* __restrict__ Bt, const int K, bf16_t* shm, f32x4 (&acc)[2][2][4][2]) {
  const int tid = opaque_tid();
  const int wid = tid >> 6, lane = tid & 63, wr = wid >> 2, wc = wid & 3, fr = lane & 15, fq = lane >> 4;
  const int swz = (fr * 64 + fq * 16) ^ ((fr >> 3) << 5);
  const char* aRd = (const char*)shm + swz + wr * 8192;
  const char* bRd = (const char*)shm + 65536 + swz + wc * 4096;
  int sr0, sc0, sr1, sc1;
  stage_rc(tid * 16, sr0, sc0);
  stage_rc(tid * 16 + 8192, sr1, sc1);
  const unsigned so0 = (unsigned)(sr0 * K + sc0) * 2u, so1 = (unsigned)(sr1 * K + sc1) * 2u;
  char* const stw = (char*)shm + __builtin_amdgcn_readfirstlane(tid & ~63) * 16;
  const char* const Ab = (const char*)A;
  const char* const Bb = (const char*)Bt;
#define SA(b, h) (((b) * 2 + (h)) * 16384)
#define SB(b, h) ((4 + (b) * 2 + (h)) * 16384)
#define STAGE(P, BASE, br, kt) do { const char* g_ = (BASE) + ((long)(br) * K + (long)(kt) * 64) * 2;                        \
    __builtin_amdgcn_global_load_lds((const unsigned*)(g_ + so0), (unsigned*)(stw + (P)), 16, 0, 0);                          \
    __builtin_amdgcn_global_load_lds((const unsigned*)(g_ + so1), (unsigned*)(stw + (P) + 8192), 16, 0, 0); } while (0)
#define LDA(dst, b, h) _Pragma("unroll") for (int m = 0; m < 4; ++m) _Pragma("unroll") for (int k = 0; k < 2; ++k) \
    dst[m][k] = *reinterpret_cast<const bf16x8*>(aRd + ((b) * 2 + (h)) * 16384 + (m * 2 + k) * 1024)
#define LDB(dst, b, h) _Pragma("unroll") for (int n = 0; n < 2; ++n) _Pragma("unroll") for (int k = 0; k < 2; ++k) \
    dst[n][k] = *reinterpret_cast<const bf16x8*>(bRd + ((b) * 2 + (h)) * 16384 + (n * 2 + k) * 1024)
#define MMA(ai, bj, At_, Bt_) do { __builtin_amdgcn_s_setprio(1);                                                          \
    _Pragma("unroll") for (int m = 0; m < 4; ++m) _Pragma("unroll") for (int n = 0; n < 2; ++n) _Pragma("unroll") for (int k = 0; k < 2; ++k) \
      acc[ai][bj][m][n] = __builtin_amdgcn_mfma_f32_16x16x32_bf16(At_[m][k], Bt_[n][k], acc[ai][bj][m][n], 0, 0, 0);       \
    __builtin_amdgcn_s_setprio(0); } while (0)
#define WAIT_V(n) asm volatile("s_waitcnt vmcnt(" #n ")" ::: "memory")
#define WAIT_L(n) asm volatile("s_waitcnt lgkmcnt(" #n ")" ::: "memory")
#define BAR __builtin_amdgcn_s_barrier()
#define SCHED __builtin_amdgcn_sched_barrier(0)
  bf16x8 At[4][2], B0[2][2], B1[2][2];
  const int nt = K / 64;
  STAGE(SB(0, 0), Bb, 0, 0); STAGE(SA(0, 0), Ab, 0, 0);
  STAGE(SB(0, 1), Bb, 128, 0); STAGE(SA(0, 1), Ab, 128, 0);
  if (wr == 1) BAR;
  WAIT_V(4); BAR;
  STAGE(SB(1, 0), Bb, 0, 1); STAGE(SA(1, 0), Ab, 0, 1); STAGE(SB(1, 1), Bb, 128, 1);
  WAIT_V(6); BAR;
  for (int t = 0; t < nt - 2; t += 2) {
    LDB(B0, 0, 0); SCHED; LDA(At, 0, 0); STAGE(SA(1, 1), Ab, 128, t + 1);
    WAIT_L(8); BAR; WAIT_L(0); MMA(0, 0, At, B0); BAR; SCHED;
    LDB(B1, 0, 1); STAGE(SB(0, 0), Bb, 0, t + 2);
    BAR; WAIT_L(0); MMA(0, 1, At, B1); BAR;
    LDA(At, 0, 1); STAGE(SA(0, 0), Ab, 0, t + 2);
    BAR; WAIT_L(0); MMA(1, 0, At, B0); BAR; SCHED;
    STAGE(SB(0, 1), Bb, 128, t + 2);
    WAIT_V(6); BAR; MMA(1, 1, At, B1); BAR;
    LDB(B0, 1, 0); SCHED; LDA(At, 1, 0); STAGE(SA(0, 1), Ab, 128, t + 2);
    WAIT_L(8); BAR; WAIT_L(0); MMA(0, 0, At, B0); BAR; SCHED;
    LDB(B1, 1, 1); STAGE(SB(1, 0), Bb, 0, t + 3);
    BAR; WAIT_L(0); MMA(0, 1, At, B1); BAR;
    LDA(At, 1, 1); STAGE(SA(1, 0), Ab, 0, t + 3);
    BAR; WAIT_L(0); MMA(1, 0, At, B0); BAR; SCHED;
    STAGE(SB(1, 1), Bb, 128, t + 3);
    WAIT_V(6); BAR; MMA(1, 1, At, B1); BAR;
  }
  { LDB(B0, 0, 0); LDA(At, 0, 0); STAGE(SA(1, 1), Ab, 128, nt - 1);
    BAR; WAIT_L(0); MMA(0, 0, At, B0); BAR;
    LDB(B1, 0, 1); BAR; WAIT_L(0); MMA(0, 1, At, B1); BAR;
    LDA(At, 0, 1); WAIT_V(4); BAR; WAIT_L(0); MMA(1, 0, At, B0); MMA(1, 1, At, B1); BAR; }
  { LDB(B0, 1, 0); LDA(At, 1, 0); WAIT_V(2); BAR; WAIT_L(0); MMA(0, 0, At, B0); BAR;
    LDB(B1, 1, 1); WAIT_V(0); BAR; WAIT_L(0); MMA(0, 1, At, B1); BAR;
    LDA(At, 1, 1); BAR; WAIT_L(0); MMA(1, 0, At, B0); MMA(1, 1, At, B1); BAR; }
  if (wr == 0) BAR;
#undef SA
#undef SB
#undef STAGE
#undef LDA
#undef LDB
#undef MMA
#undef WAIT_V
#undef WAIT_L
#undef BAR
#undef SCHED
}


DI void zero_acc8(f32x4 (&acc)[2][2][4][2]) {
#pragma unroll
  for (int a = 0; a < 2; ++a)
#pragma unroll
    for (int b = 0; b < 2; ++b)
#pragma unroll
      for (int m = 0; m < 4; ++m)
#pragma unroll
        for (int n = 0; n < 2; ++n) acc[a][b][m][n] = f32x4{0.f, 0.f, 0.f, 0.f};
}

constexpr int CSTR = 132;
DI void accq_to_lds(const f32x4 (&q)[4][2], float* sC) {
  const int tid = opaque_tid(), wid = tid >> 6, lane = tid & 63, wr = wid >> 2, wc = wid & 3, fr = lane & 15, fq = lane >> 4;
#pragma unroll
  for (int m = 0; m < 4; ++m)
#pragma unroll
    for (int n = 0; n < 2; ++n)
#pragma unroll
      for (int j = 0; j < 4; ++j) sC[(wr * 64 + m * 16 + fq * 4 + j) * CSTR + wc * 32 + n * 16 + fr] = q[m][n][j];
}
constexpr int SC2_OFF = 128 * CSTR;
template <class EPI>
DI void tile_epilogue2(const f32x4 (&acc)[2][2][4][2], float* sC, EPI epi) {
  __syncthreads();
  accq_to_lds(acc[0][0], sC);
  __syncthreads();
  accq_to_lds(acc[0][1], sC + SC2_OFF);
  epi(0, sC);
  __syncthreads();
  accq_to_lds(acc[1][0], sC);
  epi(1, sC + SC2_OFF);
  __syncthreads();
  accq_to_lds(acc[1][1], sC + SC2_OFF);
  epi(2, sC);
  __syncthreads();
  epi(3, sC + SC2_OFF);
  __syncthreads();
}

template <class F>
DI void epi_rows(const float* sC, F f) {
  const int tx = opaque_tid();
#pragma unroll
  for (int i = 0; i < 4; ++i) {
    const int c = tx + 512 * i, row = c >> 4, cc = (c & 15) * 8;
    const float4 a = *(const float4*)(sC + row * CSTR + cc), b = *(const float4*)(sC + row * CSTR + cc + 4);
    const float v[8] = {a.x, a.y, a.z, a.w, b.x, b.y, b.z, b.w};
    f(i, row, cc, v);
  }
}
DI float4 ldnt4(const float* p) { float4 r; r.x = __builtin_nontemporal_load(p); r.y = __builtin_nontemporal_load(p + 1); r.z = __builtin_nontemporal_load(p + 2); r.w = __builtin_nontemporal_load(p + 3); return r; }
DI void store8(bf16_t* p, const float (&v)[8]) { *(bf16x8*)p = pack8(v[0], v[1], v[2], v[3], v[4], v[5], v[6], v[7]); }
DI void store8_nt(bf16_t* p, const float (&v)[8]) { __builtin_nontemporal_store(pack8(v[0], v[1], v[2], v[3], v[4], v[5], v[6], v[7]), (bf16x8*)p); }
DI void epi_vt(const float* sC, bf16_t* VT, int m0, int head0, int c0, int ncol_log2) {
  const int b = m0 >> 12, s0 = m0 & 4095;
  const int nitems = 16 << ncol_log2;
  for (int c = opaque_tid(); c < nitems; c += 512) {
    const int col = c & ((1 << ncol_log2) - 1), rc = c >> ncol_log2;
    float v[8];
#pragma unroll
    for (int j = 0; j < 8; ++j) v[j] = sC[(rc * 8 + j) * CSTR + c0 + col];
    const int head = head0 + (col >> 6), d = col & 63;
    store8(VT + ((size_t)((b * 8 + head) * 64 + d)) * SEQL + s0 + rc * 8, v);
  }
}
DI void rope8(const float* sC, const float* ROPE, int tok, int row, int cc, float (&v)[8]) {
  const float* pr = sC + row * CSTR + (cc ^ 16);
  const bool upper = (cc & 16) != 0;
  const int f0 = cc & 15;
  const float* tb = ROPE + (size_t)tok * 32;
#pragma unroll
  for (int j = 0; j < 8; ++j) {
    const float o = pr[j], cs = tb[f0 + j], sn = tb[16 + f0 + j];
    v[j] = upper ? (o * sn + v[j] * cs) : (v[j] * cs - o * sn);
  }
}

DI void wconv_unit(const float* __restrict__ src, int Nsrc, int K, bf16_t* __restrict__ dst, const float* __restrict__ gain, int ng, int kg, int mode, float* tile, const int tid) {
  {
    const int k = tid >> 2, cq = tid & 3;
    const int n = ng * 64 + cq * 16;
    int sc = n;
    if (mode == 1) { sc = (n < 2688) ? n : (n < 5248 ? n + 32 : (n < 5280 ? n - 2560 : -1)); }
    const int kk = kg * 64 + k;
    float4 v[4];
    if (sc >= 0) {
      const float* sp = src + (size_t)kk * Nsrc + sc;
#pragma unroll
      for (int i = 0; i < 4; ++i) v[i] = ldnt4(sp + 4 * i);
      if (gain) { const float g = gain[kk];
#pragma unroll
        for (int i = 0; i < 4; ++i) { v[i].x *= g; v[i].y *= g; v[i].z *= g; v[i].w *= g; } }
    } else {
#pragma unroll
      for (int i = 0; i < 4; ++i) v[i] = make_float4(0.f, 0.f, 0.f, 0.f);
    }
    float* tp = tile + k * 65 + cq * 16;
#pragma unroll
    for (int i = 0; i < 4; ++i) { tp[4 * i] = v[i].x; tp[4 * i + 1] = v[i].y; tp[4 * i + 2] = v[i].z; tp[4 * i + 3] = v[i].w; }
  }
  __syncthreads();
  {
    const int n = tid >> 2, kc = tid & 3;
    float o[16];
#pragma unroll
    for (int j = 0; j < 16; ++j) o[j] = tile[(kc * 16 + j) * 65 + n];
    bf16_t* dp = dst + (size_t)(ng * 64 + n) * K + kg * 64 + kc * 16;
    *(bf16x8*)dp = pack8(o[0], o[1], o[2], o[3], o[4], o[5], o[6], o[7]);
    *(bf16x8*)(dp + 8) = pack8(o[8], o[9], o[10], o[11], o[12], o[13], o[14], o[15]);
  }
  __syncthreads();
}

DI void phase_prep(const Params& p, char* smem) {
  if (blockIdx.x == 0 && threadIdx.x < 16) { p.counter()[threadIdx.x] = 0; }
  for (int i = blockIdx.x * NTHREADS + threadIdx.x; i < 2 * NTOK; i += gridDim.x * NTHREADS) p.SSQ()[i] = 0.f;
  const int half = threadIdx.x >> 8, tid = threadIdx.x & 255;
  constexpr int U_MOD = 96 * 4, U_WIN = 84 * 16, U_WUQ = 12 * 6, U_WUKV = 16 * 4, U_WA = 16 * 8, U_WB = 16 * 8, U_WO = 16 * 16, U_ROPE = 1024;
  constexpr int U_TOTAL = U_MOD + U_ROPE + U_WIN + U_WUQ + U_WUKV + U_WA + U_WB + U_WO;
  float* tile = (float*)smem + half * (64 * 65 + 64);
  for (int up = blockIdx.x; up < U_TOTAL / 2; up += gridDim.x) {
    int v = 2 * up + half;
    if (v < U_MOD) {
      const int cg32 = v >> 2, kq = v & 3, n0 = cg32 * 32;
      const int kgp = tid >> 5, col = tid & 31;
      const int kb = kq * 256 + kgp * 32;
      float a0 = 0.f, a1 = 0.f, a2 = 0.f, a3 = 0.f;
      const float* wp = p.w_ada + (size_t)kb * 3072 + n0 + col;
      float wv[32];
#pragma unroll
      for (int kk = 0; kk < 32; ++kk) wv[kk] = __builtin_nontemporal_load(wp + (size_t)kk * 3072);
#pragma unroll
      for (int kk = 0; kk < 32; ++kk) {
        a0 += wv[kk] * p.c[kb + kk]; a1 += wv[kk] * p.c[1024 + kb + kk]; a2 += wv[kk] * p.c[2048 + kb + kk]; a3 += wv[kk] * p.c[3072 + kb + kk];
      }
      float* red = (float*)smem + half * 1024;
      red[(kgp * 4 + 0) * 32 + col] = a0; red[(kgp * 4 + 1) * 32 + col] = a1; red[(kgp * 4 + 2) * 32 + col] = a2; red[(kgp * 4 + 3) * 32 + col] = a3;
      __syncthreads();
      if (tid < 128) {
        const int b = tid >> 5, cc = tid & 31;
        float s = (kq == 0) ? p.b_ada[n0 + cc] : 0.f;
#pragma unroll
        for (int g = 0; g < 8; ++g) s += red[(g * 4 + b) * 32 + cc];
        p.MOD()[(size_t)(b * 3072 + n0 + cc) * 4 + kq] = s;
      }
      __syncthreads();
      continue;
    }
    v -= U_MOD;
    if (v < U_WIN) { wconv_unit(p.w_in, INW, 1024, p.WinT(), nullptr, v >> 4, v & 15, 1, tile, tid); continue; }
    v -= U_WIN;
    if (v < U_WUQ) { wconv_unit(p.w_uq, 768, 384, p.WuqT(), p.q_gain, v / 6, v % 6, 0, tile, tid); continue; }
    v -= U_WUQ;
    if (v < U_WUKV) { wconv_unit(p.w_ukv, 1024, 256, p.WukvT(), p.kv_gain, v >> 2, v & 3, 0, tile, tid); continue; }
    v -= U_WUKV;
    if (v < U_WA) { wconv_unit(p.w_a, 1024, 512, p.WaT(), nullptr, v >> 3, v & 7, 0, tile, tid); continue; }
    v -= U_WA;
    if (v < U_WB) { wconv_unit(p.w_b, 1024, 512, p.WbT(), nullptr, v >> 3, v & 7, 0, tile, tid); continue; }
    v -= U_WB;
    if (v < U_WO) { wconv_unit(p.w_out, 1024, 1024, p.WoT(), nullptr, v >> 4, v & 15, 0, tile, tid); continue; }
    v -= U_WO;
    {
      const int idx = v * 256 + tid, tok = idx >> 4, i = idx & 15;
      const float ang = (float)p.pos[tok] * c_invfreq[i];
      double t = (double)ang * 0.15915494309189535;
      t -= rint(t);
      const float tf = (float)t;
      p.ROPE()[(size_t)tok * 32 + i] = __builtin_amdgcn_cosf(tf);
      p.ROPE()[(size_t)tok * 32 + 16 + i] = __builtin_amdgcn_sinf(tf);
    }
  }
}

DI float mod_get(const float* MOD, int b, int n) { const float4 q = *(const float4*)(MOD + (size_t)(b * 3072 + n) * 4); return (q.x + q.y) + (q.z + q.w); }

DI void phase_h(const Params& p, char* smem) {
  const int tid = opaque_tid(), lane = tid & 63, w = tid >> 6;
  float* gs = (float*)smem;
  float* sh = gs + 1024;
  const int xq = blockIdx.x & 7, lb = blockIdx.x >> 3, nlb = gridDim.x >> 3;
  const bool xmap = (gridDim.x & 7) == 0;
  for (int rgi = xmap ? lb : (int)blockIdx.x; rgi < (xmap ? 32 : NTOK / 64); rgi += (xmap ? nlb : (int)gridDim.x)) {
    const int rg = xmap ? (32 * xq + rgi) : rgi;
    const int b = (rg * 64) >> 12;
    __syncthreads();
#pragma unroll
    for (int i = 0; i < 2; ++i) {
      const int k = tid + 512 * i;
      gs[k] = p.norm_gain[k] * (1.f + mod_get(p.MOD(), b, 1024 + k));
      sh[k] = mod_get(p.MOD(), b, k);
    }
    __syncthreads();
#pragma unroll 4
    for (int rr = 0; rr < 8; ++rr) {
      const int row = rg * 64 + w * 8 + rr;
      const float* xr = p.x + (size_t)row * DM;
      float4 v[4];
      float ss = 0.f;
#pragma unroll
      for (int i = 0; i < 2; ++i) {
        const int e = 8 * (lane + 64 * i);
        v[2 * i] = ldnt4(xr + e);
        v[2 * i + 1] = ldnt4(xr + e + 4);
        ss += v[2 * i].x * v[2 * i].x + v[2 * i].y * v[2 * i].y + v[2 * i].z * v[2 * i].z + v[2 * i].w * v[2 * i].w;
        ss += v[2 * i + 1].x * v[2 * i + 1].x + v[2 * i + 1].y * v[2 * i + 1].y + v[2 * i + 1].z * v[2 * i + 1].z + v[2 * i + 1].w * v[2 * i + 1].w;
      }
#pragma unroll
      for (int o = 32; o >= 1; o >>= 1) ss += __shfl_xor(ss, o);
      const float rn = __builtin_amdgcn_rsqf(ss * (1.f / DM) + EPSN);
#pragma unroll
      for (int i = 0; i < 2; ++i) {
        const int e = 8 * (lane + 64 * i);
        const float4 g0 = *(const float4*)(gs + e), g1 = *(const float4*)(gs + e + 4);
        const float4 s0 = *(const float4*)(sh + e), s1 = *(const float4*)(sh + e + 4);
        *(bf16x8*)(p.Hb() + (size_t)row * DM + e) =
            pack8(v[2 * i].x * rn * g0.x + s0.x, v[2 * i].y * rn * g0.y + s0.y, v[2 * i].z * rn * g0.z + s0.z, v[2 * i].w * rn * g0.w + s0.w,
                  v[2 * i + 1].x * rn * g1.x + s1.x, v[2 * i + 1].y * rn * g1.y + s1.y, v[2 * i + 1].z * rn * g1.z + s1.z, v[2 * i + 1].w * rn * g1.w + s1.w);
      }
    }
  }
  __syncthreads();
}

DI void g1_epi(const Params& p, const float* sC, const int m0, const int n0, const int ct, const bool do_ssq) {
    if (ct < 4) {
      epi_rows(sC, [&](int, int row, int cc, const float (&v)[8]) {
        float o[8];
#pragma unroll
        for (int j = 0; j < 8; ++j) o[j] = v[j] * QS_SCALE;
        store8(p.Qsb() + (size_t)(m0 + row) * 512 + n0 + cc, o); });
    } else if (ct < 8) {
      epi_rows(sC, [&](int, int row, int cc, const float (&v)[8]) { store8(p.Ksb() + (size_t)(m0 + row) * 512 + n0 - 512 + cc, v); });
    } else if (ct < 12) {
      epi_vt(sC, p.VTsb(), m0, (n0 - 1024) >> 6, 0, 7);
    } else if (ct < 16) {
      epi_rows(sC, [&](int, int row, int cc, const float (&v)[8]) {
        float o[8];
#pragma unroll
        for (int j = 0; j < 8; ++j) o[j] = siluf_fast(v[j]);
        store8(p.Zsb() + (size_t)(m0 + row) * 512 + n0 - 1536 + cc, o); });
    } else if (ct < 19) {
      epi_rows(sC, [&](int, int row, int cc, const float (&v)[8]) {
        store8(p.CQ() + (size_t)(m0 + row) * 384 + n0 - 2048 + cc, v);
        float q = 0.f;
#pragma unroll
        for (int j = 0; j < 8; ++j) q += v[j] * v[j];
        q += __shfl_xor(q, 1); q += __shfl_xor(q, 2); q += __shfl_xor(q, 4); q += __shfl_xor(q, 8);
        if (do_ssq && (threadIdx.x & 15) == 0) atomicAdd(p.SSQ() + m0 + row, q); });
    } else if (ct < 21) {
      epi_rows(sC, [&](int, int row, int cc, const float (&v)[8]) {
        store8(p.CKV() + (size_t)(m0 + row) * 256 + n0 - 2432 + cc, v);
        float q = 0.f;
#pragma unroll
        for (int j = 0; j < 8; ++j) q += v[j] * v[j];
        q += __shfl_xor(q, 1); q += __shfl_xor(q, 2); q += __shfl_xor(q, 4); q += __shfl_xor(q, 8);
        if (do_ssq && (threadIdx.x & 15) == 0) atomicAdd(p.SSQ() + NTOK + m0 + row, q); });
    } else if (ct < 25) {
      epi_rows(sC, [&](int, int row, int cc, const float (&v)[8]) {
        float o[8];
#pragma unroll
        for (int j = 0; j < 8; ++j) o[j] = siluf_fast(v[j]);
        store8(p.Zmla() + (size_t)(m0 + row) * 512 + n0 - 2688 + cc, o); });
    } else if (ct < 33) {
      epi_rows(sC, [&](int, int row, int cc, const float (&v)[8]) {
        float o[8];
#pragma unroll
        for (int j = 0; j < 8; ++j) o[j] = sigmoidf_fast(v[j]);
        store8_nt(p.GA() + (size_t)(m0 + row) * 1024 + n0 - 3200 + cc, o); });
    } else if (ct < 41) {
      epi_rows(sC, [&](int, int row, int cc, const float (&v)[8]) {
        float o[8];
#pragma unroll
        for (int j = 0; j < 8; ++j) o[j] = sigmoidf_fast(v[j]);
        store8_nt(p.GB() + (size_t)(m0 + row) * 1024 + n0 - 4224 + cc, o); });
    } else {
      epi_rows(sC, [&](int, int row, int cc, const float (&v)[8]) {
        if (cc < 32) {
          float o[8];
#pragma unroll
          for (int j = 0; j < 8; ++j) o[j] = v[j];
          rope8(sC, p.ROPE(), m0 + row, row, cc, o);
          store8(p.KPE() + (size_t)(m0 + row) * 32 + cc, o);
        } });
    }
}

DI void g1_tile(const Params& p, char* smem, const int rt, const int ct2, const bool do_ssq) {
  bf16_t* shm = (bf16_t*)smem;
  float* sC = (float*)smem;
  const int m0 = rt * 256, n0 = ct2 * 256;
  f32x4 acc[2][2][4][2];
  zero_acc8(acc);
  gemm8_tile(p.Hb() + (size_t)m0 * DM, p.WinT() + (size_t)n0 * DM, DM, shm, acc);
  tile_epilogue2(acc, sC, [&](const int qd, const float* sq) {
    g1_epi(p, sq, m0 + (qd >> 1) * 128, n0 + (qd & 1) * 128, ct2 * 2 + (qd & 1), do_ssq); });
}

constexpr int G1_NCT = 20;
DI void phase_g1(const Params& p, char* smem, bool do_ssq = true) {
  const int xq = blockIdx.x & 7, lb = blockIdx.x >> 3, nlb = gridDim.x >> 3;
  const bool xmap = (gridDim.x & 7) == 0;
  for (int t = xmap ? lb : (int)blockIdx.x; t < (xmap ? 8 * G1_NCT : 64 * G1_NCT); t += (xmap ? nlb : (int)gridDim.x)) {
    int rt, ct2;
    if (xmap) { ct2 = t >> 3; rt = 8 * xq + (t & 7); } else { rt = t / G1_NCT; ct2 = t % G1_NCT; }
    g1_tile(p, smem, rt, ct2, do_ssq);
  }
}

DI void g2_epi_q(const Params& p, const float* sC, const float* rsq, const int m0, const int n0) {
  epi_rows(sC, [&](int, int row, int cc, const float (&v)[8]) {
    const int col = n0 + cc;
    float o[8];
#pragma unroll
    for (int j = 0; j < 8; ++j) o[j] = v[j];
    if (((col >> 5) % 3) == 2) rope8(sC, p.ROPE(), m0 + row, row, cc, o);
    const float sc = rsq[row] * QM_SCALE;
#pragma unroll
    for (int j = 0; j < 8; ++j) o[j] *= sc;
    store8(p.Qmla() + (size_t)(m0 + row) * 768 + col, o);
  });
}
DI void g2_epi_kv(const Params& p, const float* sC, const float* rsq, const int m0, const int head) {
  epi_rows(sC, [&](int, int row, int cc, const float (&v)[8]) {
    if (cc < 64) {
      const float sc = rsq[row];
      float o[8];
#pragma unroll
      for (int j = 0; j < 8; ++j) o[j] = v[j] * sc;
      store8(p.Knope() + (size_t)(m0 + row) * 512 + head * 64 + cc, o);
    } });
  const int b = m0 >> 12, s0 = m0 & 4095;
  for (int c = opaque_tid(); c < 1024; c += 512) {
    const int col = c & 63, rc = c >> 6;
    float v[8];
#pragma unroll
    for (int j = 0; j < 8; ++j) v[j] = sC[(rc * 8 + j) * CSTR + 64 + col] * rsq[rc * 8 + j];
    store8(p.VTmla() + ((size_t)((b * 8 + head) * 64 + col)) * SEQL + s0 + rc * 8, v);
  }
}

DI void g2_tile(const Params& p, char* smem, const bool isq, const int rt, const int ct) {
  bf16_t* shm = (bf16_t*)smem;
  float* sC = (float*)smem;
  float* rs = (float*)(smem + RS_OFF);
  const int m0 = rt * 256, n0 = ct * 256;
  f32x4 acc[2][2][4][2];
  zero_acc8(acc);
  if (isq) {
    if (threadIdx.x < 256) rs[threadIdx.x] = __builtin_amdgcn_rsqf(p.SSQ()[m0 + threadIdx.x] * (1.f / 384.f) + EPSN);
    gemm8_tile(p.CQ() + (size_t)m0 * 384, p.WuqT() + (size_t)n0 * 384, 384, shm, acc);
    tile_epilogue2(acc, sC, [&](const int qd, const float* sq) {
      g2_epi_q(p, sq, rs + (qd >> 1) * 128, m0 + (qd >> 1) * 128, n0 + (qd & 1) * 128); });
  } else {
    if (threadIdx.x < 256) rs[threadIdx.x] = __builtin_amdgcn_rsqf(p.SSQ()[NTOK + m0 + threadIdx.x] * (1.f / 256.f) + EPSN);
    gemm8_tile(p.CKV() + (size_t)m0 * 256, p.WukvT() + (size_t)n0 * 256, 256, shm, acc);
    tile_epilogue2(acc, sC, [&](const int qd, const float* sq) {
      g2_epi_kv(p, sq, rs + (qd >> 1) * 128, m0 + (qd >> 1) * 128, ct * 2 + (qd & 1)); });
  }
  __syncthreads();
}

DI void phase_g2(const Params& p, char* smem) {
  const int xq = blockIdx.x & 7, lb = blockIdx.x >> 3, nlb = gridDim.x >> 3;
  if ((gridDim.x & 7) == 0 && nlb == 32) {
    if (lb < 8) {
      g1_tile(p, smem, 8 * xq + lb, G1_NCT, false);
      const int v2 = 24 + lb;
      g2_tile(p, smem, false, 8 * xq + (v2 & 7), v2 >> 3);
      return;
    }
    const int v = lb - 8;
    g2_tile(p, smem, true, 8 * xq + (v & 7), v >> 3);
    g2_tile(p, smem, false, 8 * xq + (v & 7), v >> 3);
  } else {
    for (int tt = blockIdx.x; tt < 64 + 192 + 256; tt += gridDim.x) {
      if (tt < 64) g1_tile(p, smem, tt, G1_NCT, false);
      else if (tt < 256) { const int v = tt - 64; g2_tile(p, smem, true, v / 3, v % 3); }
      else { const int v = tt - 256; g2_tile(p, smem, false, v >> 2, v & 3); }
    }
  }
}

constexpr int VSTR = 68;

template <bool MLA>
DI void attn_item(const Params& p, int b, int h, int qb, char* smem, int* pre_ctr, int& pre_raw) {
  constexpr int DK = MLA ? 96 : 64;
  constexpr int KSTR = MLA ? 104 : 72;
  constexpr int NKS = DK / 16;
  bf16_t* sK = (bf16_t*)smem;
  bf16_t* sV = sK + 2 * 64 * KSTR;
  const int tid = threadIdx.x, lane = tid & 63, w = tid >> 6, r = lane & 31, hh = lane >> 5;
  const int tokb = b * SEQL;
  const int tok0 = tokb + qb * 256;
  const int qw = qb * 256 + w * 32;

  bf16x8 qf[NKS];
  {
    const bf16_t* qptr = MLA ? (p.Qmla() + (size_t)(tok0 + w * 32 + r) * 768 + h * 96 + hh * 8) : (p.Qsb() + (size_t)(tok0 + w * 32 + r) * 512 + h * 64 + hh * 8);
#pragma unroll
    for (int ks = 0; ks < NKS; ++ks) qf[ks] = *(const bf16x8*)(qptr + ks * 16);
  }
  u32x2* zbuf = (u32x2*)(smem + 65536);
  u32x2 zpre[8];
  {
    const bf16_t* zg0 = (MLA ? p.Zmla() : p.Zsb()) + (size_t)(tok0 + w * 32 + r) * 512 + h * 64 + 4 * hh;
#pragma unroll
    for (int i = 0; i < 8; ++i) zpre[i] = *(const u32x2*)(zg0 + (i >> 2) * 32 + 8 * (i & 3));
  }
  bf16x8 tf[2];
  if (!MLA) {
#pragma unroll
    for (int st = 0; st < 2; ++st)
#pragma unroll
      for (int e = 0; e < 8; ++e) { const int j = 16 * st + 8 * (e >> 2) + 4 * hh + (e & 3); tf[st][e] = (j >= r) ? (short)0x3F80 : (short)0; }
  }

  f32x16 oacc[2];
#pragma unroll
  for (int i = 0; i < 16; ++i) { oacc[0][i] = 0.f; oacc[1][i] = 0.f; }
  float carry = 0.f;
  float mrun = 0.f, lrun = 0.f;

  const bf16_t* Kg = MLA ? p.Knope() : p.Ksb();
  const bf16_t* VTg = (MLA ? p.VTmla() : p.VTsb()) + (size_t)((b * 8 + h) * 64) * SEQL;
  const int nt = 4 * qb + 4;

  uint4 xk0, xv0, xp, yk0, yv0, yp;
  xp = make_uint4(0, 0, 0, 0); yp = xp;
  const int prow = tid >> 3, pch = tid & 7;
  const bf16_t* kgp = Kg + (size_t)(tokb + prow) * 512 + h * 64 + pch * 8;
  const bf16_t* vgp = VTg + (size_t)prow * SEQL + pch * 8;
  const bf16_t* pgp = p.KPE() + (size_t)(tokb + ((tid & 255) >> 2)) * 32 + (tid & 3) * 8;
#define ATT_GLOAD(P, kt_)                                                          \
  {                                                                                \
    const int kt__ = (kt_);                                                        \
    P##k0 = *(const uint4*)(kgp + (size_t)(kt__ * 64) * 512);                      \
    P##v0 = *(const uint4*)(vgp + kt__ * 64);                                      \
    if (MLA && tid < 256) P##p = *(const uint4*)(pgp + (size_t)(kt__ * 64) * 32);  \
  }
#define ATT_SWRITE(P, buf_)                                                        \
  {                                                                                \
    bf16_t* dK = sK + (buf_) * 64 * KSTR;                                          \
    bf16_t* dV = sV + (buf_) * 64 * VSTR;                                          \
    *(uint4*)(dK + prow * KSTR + pch * 8) = P##k0;                                 \
    uint2* dv0 = (uint2*)(dV + prow * VSTR + pch * 8);                             \
    dv0[0] = make_uint2(P##v0.x, P##v0.y); dv0[1] = make_uint2(P##v0.z, P##v0.w);  \
    if (MLA && tid < 256) *(uint4*)(dK + (tid >> 2) * KSTR + 64 + (tid & 3) * 8) = P##p; \
  }
#define ATT_KT(i_) (MLA ? (i_) : (nt - 1 - (i_)))

  ATT_GLOAD(x, ATT_KT(0));
  ATT_GLOAD(y, ATT_KT(1));
  ATT_SWRITE(x, 0);
#pragma unroll
  for (int i = 0; i < 8; ++i) zbuf[i * 512 + tid] = zpre[i];
  __syncthreads();
  bool alive = true;
  for (int it0 = 0; alive; it0 += 2) {
#pragma unroll
   for (int half = 0; half < 2; ++half) {
    const int it = it0 + half;
    const int kt = ATT_KT(it);
    const int cur = half;
    const bool more = (it + 1 < nt);
    if (it + 2 < nt) { if (half == 0) ATT_GLOAD(x, ATT_KT(it + 2)) else ATT_GLOAD(y, ATT_KT(it + 2)) }
    const bf16_t* cK = sK + cur * 64 * KSTR;
    const bf16_t* cV = sV + cur * 64 * VSTR;
    if (MLA) {
      if (kt * 64 <= qw + 31) {
        f32x16 s0, s1;
        {
          const float sinit = -mrun;
#pragma unroll
          for (int i = 0; i < 16; ++i) { s0[i] = sinit; s1[i] = sinit; }
        }
        __builtin_amdgcn_s_setprio(1);
#pragma unroll
        for (int ks = 0; ks < NKS; ++ks) {
          const bf16x8 k0 = *(const bf16x8*)(cK + r * KSTR + ks * 16 + hh * 8);
          const bf16x8 k1 = *(const bf16x8*)(cK + (32 + r) * KSTR + ks * 16 + hh * 8);
          s0 = MFMA(k0, qf[ks], s0);
          s1 = MFMA(k1, qf[ks], s1);
        }
        __builtin_amdgcn_s_setprio(0);
        if (kt * 64 + 63 > qw) {
          const int lim = qw + r - kt * 64;
#pragma unroll
          for (int i = 0; i < 16; ++i) { if (crow(i, hh) > lim) s0[i] = -1e30f; if (32 + crow(i, hh) > lim) s1[i] = -1e30f; }
        }
        float m0 = fmaxf(fmaxf(s0[0], s0[1]), s0[2]), m1 = fmaxf(fmaxf(s1[0], s1[1]), s1[2]);
#pragma unroll
        for (int i = 3; i < 15; i += 2) { m0 = fmaxf(fmaxf(m0, s0[i]), s0[i + 1]); m1 = fmaxf(fmaxf(m1, s1[i]), s1[i + 1]); }
        float mloc = fmaxf(fmaxf(m0, s0[15]), fmaxf(m1, s1[15]));
        mloc = half_max(mloc);
        const bool first = (it == 0);
        const float delta = first ? mloc : fmaxf(mloc, 0.f);
        if (first || __builtin_amdgcn_ballot_w64(delta > 0.f) != 0ull) {
          const float alpha = first ? 0.f : __builtin_amdgcn_exp2f(-delta);
          mrun += delta;
          lrun *= alpha;
#pragma unroll
          for (int i = 0; i < 16; ++i) { oacc[0][i] *= alpha; oacc[1][i] *= alpha; s0[i] -= delta; s1[i] -= delta; }
        }
        float ps0 = 0.f, ps1 = 0.f;
#pragma unroll
        for (int i = 0; i < 16; ++i) { s0[i] = __builtin_amdgcn_exp2f(s0[i]); s1[i] = __builtin_amdgcn_exp2f(s1[i]); ps0 += s0[i]; ps1 += s1[i]; }
        lrun += ps0 + ps1;
        bf16x8 pf4[4];
        pf4[0] = pack8(s0[0], s0[1], s0[2], s0[3], s0[4], s0[5], s0[6], s0[7]);
        pf4[1] = pack8(s0[8], s0[9], s0[10], s0[11], s0[12], s0[13], s0[14], s0[15]);
        pf4[2] = pack8(s1[0], s1[1], s1[2], s1[3], s1[4], s1[5], s1[6], s1[7]);
        pf4[3] = pack8(s1[8], s1[9], s1[10], s1[11], s1[12], s1[13], s1[14], s1[15]);
        __builtin_amdgcn_s_setprio(1);
#pragma unroll
        for (int st = 0; st < 4; ++st)
#pragma unroll
          for (int dt = 0; dt < 2; ++dt) {
            const bf16_t* vp = cV + (dt * 32 + r) * VSTR + st * 16 + 4 * hh;
            const s16x4 lo = *(const s16x4*)vp;
            const s16x4 hi = *(const s16x4*)(vp + 8);
            const bf16x8 vf = __builtin_shufflevector(lo, hi, 0, 1, 2, 3, 4, 5, 6, 7);
            oacc[dt] = MFMA(vf, pf4[st], oacc[dt]);
          }
        __builtin_amdgcn_s_setprio(0);
      }
    } else
#pragma unroll
    for (int si = 0; si < 2; ++si) {
      const int sub = MLA ? si : (1 - si);
      const int kb = kt * 64 + sub * 32;
      if (kb > qw) continue;
      const bool diag = (kb == qw);
      f32x16 s;
      {
        const float sinit = MLA ? -mrun : 0.f;
#pragma unroll
        for (int i = 0; i < 16; ++i) s[i] = sinit;
      }
      __builtin_amdgcn_s_setprio(1);
#pragma unroll
      for (int ks = 0; ks < NKS; ++ks) {
        const bf16x8 kf = *(const bf16x8*)(cK + (sub * 32 + r) * KSTR + ks * 16 + hh * 8);
        s = MFMA(kf, qf[ks], s);
      }
      __builtin_amdgcn_s_setprio(0);
      bf16x8 pf[2];
      if (!MLA) {
        float sp[16];
        float tsum = 0.f;
#pragma unroll
        for (int i = 0; i < 16; ++i) {
          const float z = s[i];
          float v = __builtin_amdgcn_logf(1.f + __builtin_amdgcn_exp2f(fminf(z, 126.f)));
          if (diag && !(crow(i, hh) < r)) v = 0.f;
          sp[i] = v;
          tsum += v;
        }
        f32x16 cacc;
#pragma unroll
        for (int i = 0; i < 16; ++i) cacc[i] = carry;
        cacc = MFMA(tf[0], pack8(sp[0], sp[1], sp[2], sp[3], sp[4], sp[5], sp[6], sp[7]), cacc);
        cacc = MFMA(tf[1], pack8(sp[8], sp[9], sp[10], sp[11], sp[12], sp[13], sp[14], sp[15]), cacc);
        float pr[16];
#pragma unroll
        for (int i = 0; i < 16; ++i) {
          float v = __builtin_amdgcn_exp2f(s[i] - cacc[i]);
          if (diag && !(crow(i, hh) < r)) v = 0.f;
          pr[i] = v;
        }
        carry += half_sum(tsum);
        pf[0] = pack8(pr[0], pr[1], pr[2], pr[3], pr[4], pr[5], pr[6], pr[7]);
        pf[1] = pack8(pr[8], pr[9], pr[10], pr[11], pr[12], pr[13], pr[14], pr[15]);
      } else {
        if (diag) {
#pragma unroll
          for (int i = 0; i < 16; ++i) if (!(crow(i, hh) <= r)) s[i] = -1e30f;
        }
        float mloc = fmaxf(fmaxf(s[0], s[1]), s[2]);
#pragma unroll
        for (int i = 3; i < 15; i += 2) mloc = fmaxf(fmaxf(mloc, s[i]), s[i + 1]);
        mloc = fmaxf(mloc, s[15]);
        mloc = half_max(mloc);
        const bool first = (it == 0) && (si == 0);
        const float delta = first ? mloc : fmaxf(mloc, 0.f);
        if (first || __builtin_amdgcn_ballot_w64(delta > 0.f) != 0ull) {
          const float alpha = first ? 0.f : __builtin_amdgcn_exp2f(-delta);
          mrun += delta;
          lrun *= alpha;
#pragma unroll
          for (int i = 0; i < 16; ++i) { oacc[0][i] *= alpha; oacc[1][i] *= alpha; s[i] -= delta; }
        }
        float pr[16];
        float ps0 = 0.f, ps1 = 0.f;
#pragma unroll
        for (int i = 0; i < 16; i += 2) { pr[i] = __builtin_amdgcn_exp2f(s[i]); pr[i + 1] = __builtin_amdgcn_exp2f(s[i + 1]); ps0 += pr[i]; ps1 += pr[i + 1]; }
        lrun += ps0 + ps1;
        pf[0] = pack8(pr[0], pr[1], pr[2], pr[3], pr[4], pr[5], pr[6], pr[7]);
        pf[1] = pack8(pr[8], pr[9], pr[10], pr[11], pr[12], pr[13], pr[14], pr[15]);
      }
      __builtin_amdgcn_s_setprio(1);
#pragma unroll
      for (int dt = 0; dt < 2; ++dt)
#pragma unroll
        for (int st = 0; st < 2; ++st) {
          const bf16_t* vp = cV + (dt * 32 + r) * VSTR + sub * 32 + st * 16 + 4 * hh;
          const s16x4 lo = *(const s16x4*)vp;
          const s16x4 hi = *(const s16x4*)(vp + 8);
          const bf16x8 vf = __builtin_shufflevector(lo, hi, 0, 1, 2, 3, 4, 5, 6, 7);
          oacc[dt] = MFMA(vf, pf[st], oacc[dt]);
        }
      __builtin_amdgcn_s_setprio(0);
    }
    if (more) { if (half == 0) ATT_SWRITE(y, 1) else ATT_SWRITE(x, 0) }
    if (!MLA) {
      int* flg = (int*)(smem + SMEM_BYTES - 128) + (it & 1) * 8;
      const bool wok = (__builtin_amdgcn_ballot_w64(carry >= 160.f) == ~0ull);
      if (lane == 0) flg[w] = wok ? 1 : 0;
      __syncthreads();
      alive = more && ((flg[0] & flg[1] & flg[2] & flg[3] & flg[4] & flg[5] & flg[6] & flg[7]) == 0);
    } else {
      __syncthreads();
      alive = more;
    }
    if (!alive) break;
   }
  }
#undef ATT_GLOAD
#undef ATT_SWRITE
#undef ATT_KT
  if (threadIdx.x == 0 && pre_ctr) pre_raw = atomicAdd(pre_ctr, 1);
  float inv = 1.f;
  if (MLA) { const float lt = half_sum(lrun); inv = 1.f / lt; }
  const int tok = tok0 + w * 32 + r;
  bf16_t* og = (MLA ? p.OBg() : p.OAg()) + (size_t)tok * 512 + h * 64;
#pragma unroll
  for (int dt = 0; dt < 2; ++dt)
#pragma unroll
    for (int g = 0; g < 4; ++g) {
      const int d = dt * 32 + 8 * g + 4 * hh;
      const u32x2 zz = zbuf[(dt * 4 + g) * 512 + tid];
      const float z0 = __uint_as_float(zz[0] << 16), z1 = __uint_as_float(zz[0] & 0xffff0000u);
      const float z2 = __uint_as_float(zz[1] << 16), z3 = __uint_as_float(zz[1] & 0xffff0000u);
      u32x2 o;
      o[0] = pk2(oacc[dt][4 * g] * inv * z0, oacc[dt][4 * g + 1] * inv * z1);
      o[1] = pk2(oacc[dt][4 * g + 2] * inv * z2, oacc[dt][4 * g + 3] * inv * z3);
      *(u32x2*)(og + d) = o;
    }
}

DI void phase_attn(const Params& p, char* smem, int cbase, int only) {
  int* s_item = (int*)(smem + SMEM_BYTES - 16);
  const int q0 = blockIdx.x & 7;
  int qi = 0;
  int pre_raw = 0;
  bool has_pre = false;
  for (;;) {
    if (threadIdx.x < 64) {
      int item = -1;
      while (qi < 8) {
        const int q = (q0 + qi) & 7;
        int idx = 0;
        if (has_pre) { idx = pre_raw; has_pre = false; }
        else if (threadIdx.x == 0) idx = atomicAdd(p.counter() + cbase + q, 1);
        idx = __builtin_amdgcn_readfirstlane(idx);
        if (idx < 128) { item = q * 256 + idx; break; }
        const int lq = (q0 + (threadIdx.x & 7)) & 7;
        const int head = __hip_atomic_load(p.counter() + cbase + lq, __ATOMIC_RELAXED, __HIP_MEMORY_SCOPE_AGENT);
        const unsigned long long avail = __builtin_amdgcn_ballot_w64((threadIdx.x < 8) && (head < 128) && ((int)(threadIdx.x & 7) > qi));
        if (avail == 0ull) { qi = 8; break; }
        qi = __builtin_ctzll(avail);
      }
      if (threadIdx.x == 0) *s_item = item;
    }
    __syncthreads();
    const int item = *s_item;
    __syncthreads();
    if (item < 0) break;
    const int q = item >> 8, idx = item & 255;
    const int i2 = idx & 63;
    const int bh = q + 8 * (i2 & 3);
    const int qb = 15 - (i2 >> 2);
    int* pre_ctr = p.counter() + cbase + ((q0 + qi) & 7);
    if (idx < 64) { if (only != 2) { attn_item<true>(p, bh >> 3, bh & 7, qb, smem, pre_ctr, pre_raw); has_pre = true; } }
    else { if (only != 1) { attn_item<false>(p, bh >> 3, bh & 7, qb, smem, pre_ctr, pre_raw); has_pre = true; } }
  }
}

DI void g3_pre_a(const Params& p, const int m0, const int n0, u32x4 (&g)[4]) {
  const int txo = opaque_tid();
#pragma unroll
  for (int i = 0; i < 4; ++i) {
    const int c = txo + 512 * i, row = c >> 4, cc = (c & 15) * 8;
    g[i] = *(const u32x4*)(p.GA() + (size_t)(m0 + row) * 1024 + n0 + cc);
  }
}
DI void g3_epi_a(const Params& p, const float* sC, const int m0, const int n0, const u32x4 (&gq)[4]) {
  const int txo = opaque_tid();
#pragma unroll
  for (int i = 0; i < 4; ++i) {
    const int c = txo + 512 * i, row = c >> 4, cc = (c & 15) * 8;
    const u32x4 g = gq[i];
    const float4 a = *(const float4*)(sC + row * CSTR + cc), b = *(const float4*)(sC + row * CSTR + cc + 4);
    u32x4 y;
    y[0] = pk2(a.x * __uint_as_float(g[0] << 16), a.y * __uint_as_float(g[0] & 0xffff0000u));
    y[1] = pk2(a.z * __uint_as_float(g[1] << 16), a.w * __uint_as_float(g[1] & 0xffff0000u));
    y[2] = pk2(b.x * __uint_as_float(g[2] << 16), b.y * __uint_as_float(g[2] & 0xffff0000u));
    y[3] = pk2(b.z * __uint_as_float(g[3] << 16), b.w * __uint_as_float(g[3] & 0xffff0000u));
    *(u32x4*)(p.MERGED() + (size_t)(m0 + row) * 1024 + n0 + cc) = y;
  }
}
DI void g3_pre_b(const Params& p, const int m0, const int n0, u32x4 (&g)[4], u32x4 (&y)[4]) {
  const int txo2 = opaque_tid();
#pragma unroll
  for (int i = 0; i < 4; ++i) {
    const int c = txo2 + 512 * i, row = c >> 4, cc = (c & 15) * 8;
    g[i] = *(const u32x4*)(p.GB() + (size_t)(m0 + row) * 1024 + n0 + cc);
    y[i] = *(const u32x4*)(p.MERGED() + (size_t)(m0 + row) * 1024 + n0 + cc);
  }
}
DI void g3_epi_b(const Params& p, const float* sC, const int m0, const int n0, const u32x4 (&gq)[4], const u32x4 (&yq)[4]) {
  const int txo2 = opaque_tid();
#pragma unroll
  for (int i = 0; i < 4; ++i) {
    const int c = txo2 + 512 * i, row = c >> 4, cc = (c & 15) * 8;
    const u32x4 g = gq[i];
    const u32x4 yv = yq[i];
    const float4 a = *(const float4*)(sC + row * CSTR + cc), b = *(const float4*)(sC + row * CSTR + cc + 4);
    u32x4 o;
    o[0] = pk2(__uint_as_float(yv[0] << 16) + a.x * __uint_as_float(g[0] << 16), __uint_as_float(yv[0] & 0xffff0000u) + a.y * __uint_as_float(g[0] & 0xffff0000u));
    o[1] = pk2(__uint_as_float(yv[1] << 16) + a.z * __uint_as_float(g[1] << 16), __uint_as_float(yv[1] & 0xffff0000u) + a.w * __uint_as_float(g[1] & 0xffff0000u));
    o[2] = pk2(__uint_as_float(yv[2] << 16) + b.x * __uint_as_float(g[2] << 16), __uint_as_float(yv[2] & 0xffff0000u) + b.y * __uint_as_float(g[2] & 0xffff0000u));
    o[3] = pk2(__uint_as_float(yv[3] << 16) + b.z * __uint_as_float(g[3] << 16), __uint_as_float(yv[3] & 0xffff0000u) + b.w * __uint_as_float(g[3] & 0xffff0000u));
    *(u32x4*)(p.MERGED() + (size_t)(m0 + row) * 1024 + n0 + cc) = o;
  }
}
DI void phase_g3(const Params& p, char* smem) {
  bf16_t* shm = (bf16_t*)smem;
  float* sC = (float*)smem;
  const int xq = blockIdx.x & 7, lb = blockIdx.x >> 3, nlb = gridDim.x >> 3;
  const bool xmap = (gridDim.x & 7) == 0;
  for (int t = xmap ? lb : (int)blockIdx.x; t < (xmap ? 32 : 256); t += (xmap ? nlb : (int)gridDim.x)) {
    const int rt = xmap ? (8 * xq + (t & 7)) : (t >> 2), ct = xmap ? (t >> 3) : (t & 3);
    const int m0 = rt * 256, n0 = ct * 256;
    f32x4 acc[2][2][4][2];
    zero_acc8(acc);
    gemm8_tile(p.OAg() + (size_t)m0 * 512, p.WaT() + (size_t)n0 * 512, 512, shm, acc);
#pragma unroll
    for (int ai = 0; ai < 2; ++ai)
#pragma unroll
      for (int bj = 0; bj < 2; ++bj) {
        u32x4 gq[4];
        g3_pre_a(p, m0 + ai * 128, n0 + bj * 128, gq);
        __syncthreads();
        accq_to_lds(acc[ai][bj], sC);
        __syncthreads();
        g3_epi_a(p, sC, m0 + ai * 128, n0 + bj * 128, gq);
      }
    __syncthreads();
    zero_acc8(acc);
    gemm8_tile(p.OBg() + (size_t)m0 * 512, p.WbT() + (size_t)n0 * 512, 512, shm, acc);
#pragma unroll
    for (int ai = 0; ai < 2; ++ai)
#pragma unroll
      for (int bj = 0; bj < 2; ++bj) {
        u32x4 gq[4], yq[4];
        g3_pre_b(p, m0 + ai * 128, n0 + bj * 128, gq, yq);
        __syncthreads();
        accq_to_lds(acc[ai][bj], sC);
        __syncthreads();
        g3_epi_b(p, sC, m0 + ai * 128, n0 + bj * 128, gq, yq);
      }
    __syncthreads();
  }
}

DI void g4_pre(const Params& p, const int m0, const int n0, float4 (&xq)[8]) {
  const int txo = opaque_tid();
#pragma unroll
  for (int i = 0; i < 4; ++i) {
    const int c = txo + 512 * i, row = c >> 4, cc = (c & 15) * 8;
    const size_t go = (size_t)(m0 + row) * 1024 + n0 + cc;
    xq[2 * i] = ldnt4(p.x + go); xq[2 * i + 1] = ldnt4(p.x + go + 4);
  }
}
DI void g4_epi(const Params& p, const float* sC, const float* gt, const int m0, const int n0, const float4 (&xq)[8]) {
  const int txo = opaque_tid();
#pragma unroll
  for (int i = 0; i < 4; ++i) {
    const int c = txo + 512 * i, row = c >> 4, cc = (c & 15) * 8;
    const size_t go = (size_t)(m0 + row) * 1024 + n0 + cc;
    const float4 x0 = xq[2 * i], x1 = xq[2 * i + 1];
    const float4 a = *(const float4*)(sC + row * CSTR + cc), b = *(const float4*)(sC + row * CSTR + cc + 4);
    const float4 g0 = *(const float4*)(gt + cc), g1 = *(const float4*)(gt + cc + 4);
    float4 o0, o1;
    o0.x = x0.x + g0.x * a.x; o0.y = x0.y + g0.y * a.y; o0.z = x0.z + g0.z * a.z; o0.w = x0.w + g0.w * a.w;
    o1.x = x1.x + g1.x * b.x; o1.y = x1.y + g1.y * b.y; o1.z = x1.z + g1.z * b.z; o1.w = x1.w + g1.w * b.w;
    *(float4*)(p.out + go) = o0;
    *(float4*)(p.out + go + 4) = o1;
  }
}
DI void phase_g4(const Params& p, char* smem) {
  bf16_t* shm = (bf16_t*)smem;
  float* sC = (float*)smem;
  float* rs = (float*)(smem + RS_OFF);
  const int xq = blockIdx.x & 7, lb = blockIdx.x >> 3, nlb = gridDim.x >> 3;
  const bool xmap = (gridDim.x & 7) == 0;
  for (int t = xmap ? lb : (int)blockIdx.x; t < (xmap ? 32 : 256); t += (xmap ? nlb : (int)gridDim.x)) {
    const int rt = xmap ? (8 * xq + (t & 7)) : (t >> 2), ct = xmap ? (t >> 3) : (t & 3);
    const int m0 = rt * 256, n0 = ct * 256;
    f32x4 acc[2][2][4][2];
    zero_acc8(acc);
    if (threadIdx.x < 256) rs[threadIdx.x] = mod_get(p.MOD(), m0 >> 12, 2048 + n0 + threadIdx.x);
    gemm8_tile(p.MERGED() + (size_t)m0 * 1024, p.WoT() + (size_t)n0 * 1024, 1024, shm, acc);
#pragma unroll
    for (int ai = 0; ai < 2; ++ai)
#pragma unroll
      for (int bj = 0; bj < 2; ++bj) {
        float4 xq[8];
        g4_pre(p, m0 + ai * 128, n0 + bj * 128, xq);
        __syncthreads();
        accq_to_lds(acc[ai][bj], sC);
        __syncthreads();
        g4_epi(p, sC, rs + bj * 128, m0 + ai * 128, n0 + bj * 128, xq);
      }
    __syncthreads();
  }
}

DI void phase_final(const Params& p) {
  const int lane = threadIdx.x & 63, w = threadIdx.x >> 6;
  const int gw = blockIdx.x * 8 + w, nw = gridDim.x * 8;
  for (int row = gw; row < NTOK; row += nw) {
    float* xr = p.out + (size_t)row * DM;
    float4 v[4];
    float ss = 0.f;
#pragma unroll
    for (int i = 0; i < 4; ++i) {
      v[i] = *(const float4*)(xr + 4 * (lane + 64 * i));
      ss += v[i].x * v[i].x + v[i].y * v[i].y + v[i].z * v[i].z + v[i].w * v[i].w;
    }
#pragma unroll
    for (int o = 32; o >= 1; o >>= 1) ss += __shfl_xor(ss, o);
    const float rn = __builtin_amdgcn_rsqf(ss * (1.f / DM) + EPSN);
#pragma unroll
    for (int i = 0; i < 4; ++i) {
      const int e = 4 * (lane + 64 * i);
      const float4 g = *(const float4*)(p.fgain + e);
      float4 o;
      o.x = v[i].x * rn * g.x; o.y = v[i].y * rn * g.y; o.z = v[i].z * rn * g.z; o.w = v[i].w * rn * g.w;
      __builtin_nontemporal_store(o.x, xr + e); __builtin_nontemporal_store(o.y, xr + e + 1); __builtin_nontemporal_store(o.z, xr + e + 2); __builtin_nontemporal_store(o.w, xr + e + 3);
    }
  }
}

template <int PH>
__global__ void __launch_bounds__(NTHREADS, 2) mega_kernel(Params p) {
  __shared__ __attribute__((aligned(16))) char smem[SMEM_BYTES];
  if (PH < 0) {
    if (p.ws == nullptr) cg::this_grid().sync();
    volatile LAS unsigned* xst = (volatile LAS unsigned*)(smem + SMEM_BYTES - 32);
    if (threadIdx.x == 0) { xst[0] = 0u; xst[1] = 0u; }
    __syncthreads();
    (void)xcd_barrier_post(p.bar(), xst);
    phase_prep(p, smem); xcd_barrier(p.bar(), (volatile LAS unsigned*)(smem + SMEM_BYTES - 32));
#if PROBE_DUP == 4
    phase_prep(p, smem); xcd_barrier(p.bar(), (volatile LAS unsigned*)(smem + SMEM_BYTES - 32));
#endif
    phase_h(p, smem); xcd_barrier(p.bar(), (volatile LAS unsigned*)(smem + SMEM_BYTES - 32));
#if PROBE_DUP == 5
    phase_h(p, smem); xcd_barrier(p.bar(), (volatile LAS unsigned*)(smem + SMEM_BYTES - 32));
#endif
    phase_g1(p, smem); xcd_barrier(p.bar(), (volatile LAS unsigned*)(smem + SMEM_BYTES - 32));
#if PROBE_DUP == 1
    phase_g1(p, smem, false); xcd_barrier(p.bar(), (volatile LAS unsigned*)(smem + SMEM_BYTES - 32));
#endif
    phase_g2(p, smem); xcd_barrier(p.bar(), (volatile LAS unsigned*)(smem + SMEM_BYTES - 32));
#if PROBE_DUP == 8
    phase_g2(p, smem); xcd_barrier(p.bar(), (volatile LAS unsigned*)(smem + SMEM_BYTES - 32));
#endif
    phase_attn(p, smem, 0, 0); xcd_barrier(p.bar(), (volatile LAS unsigned*)(smem + SMEM_BYTES - 32));
#if PROBE_DUP == 2
    phase_attn(p, smem, 8, 1); xcd_barrier(p.bar(), (volatile LAS unsigned*)(smem + SMEM_BYTES - 32));
#endif
#if PROBE_DUP == 3
    phase_attn(p, smem, 8, 2); xcd_barrier(p.bar(), (volatile LAS unsigned*)(smem + SMEM_BYTES - 32));
#endif
    phase_g3(p, smem); xcd_barrier(p.bar(), (volatile LAS unsigned*)(smem + SMEM_BYTES - 32));
#if PROBE_DUP == 6
    phase_g3(p, smem); xcd_barrier(p.bar(), (volatile LAS unsigned*)(smem + SMEM_BYTES - 32));
#endif
    phase_g4(p, smem); xcd_barrier(p.bar(), (volatile LAS unsigned*)(smem + SMEM_BYTES - 32));
#if PROBE_DUP == 7
    phase_g4(p, smem); xcd_barrier(p.bar(), (volatile LAS unsigned*)(smem + SMEM_BYTES - 32));
#endif
    phase_final(p);
  } else {
    if (PH == 0) phase_prep(p, smem);
    if (PH == 1) phase_h(p, smem);
    if (PH == 2) phase_g1(p, smem);
    if (PH == 3) phase_g2(p, smem);
    if (PH == 4) phase_attn(p, smem, 0, 0);
    if (PH == 5) phase_g3(p, smem);
    if (PH == 6) phase_g4(p, smem);
    if (PH == 7) phase_final(p);
  }
}

#ifndef PROBE_DUP
#define PROBE_DUP 0
#endif
#ifndef MK_SPLIT
#define MK_SPLIT 0
#endif

extern "C" void kernel_launch(void* const* d_in, const int* in_sizes, int n_in, void* d_out, int out_size, void* d_ws, size_t ws_size, hipStream_t stream) {
  Params p{};
  p.x = (const float*)d_in[0]; p.c = (const float*)d_in[1]; p.pos = (const int*)d_in[2];
  p.w_ada = (const float*)d_in[3]; p.b_ada = (const float*)d_in[4]; p.norm_gain = (const float*)d_in[5];
  p.w_in = (const float*)d_in[6]; p.q_gain = (const float*)d_in[7]; p.w_uq = (const float*)d_in[8];
  p.kv_gain = (const float*)d_in[9]; p.w_ukv = (const float*)d_in[10]; p.w_a = (const float*)d_in[11];
  p.w_b = (const float*)d_in[12]; p.w_out = (const float*)d_in[13]; p.fgain = (const float*)d_in[14];
  p.out = (float*)d_out;
  p.ws = (char*)d_ws;
  if (WS_NEED > ws_size) { fprintf(stderr, "workspace too small: need %zu have %zu\n", (size_t)WS_NEED, ws_size); return; }

  static int grid_blocks = 0;
  if (!grid_blocks) {
    int dev = 0, cus = 0, per_cu = 0;
    hipGetDevice(&dev);
    hipDeviceGetAttribute(&cus, hipDeviceAttributeMultiprocessorCount, dev);
    hipOccupancyMaxActiveBlocksPerMultiprocessor(&per_cu, mega_kernel<-1>, NTHREADS, 0);
    per_cu = 1;
    grid_blocks = cus * per_cu;
  }
#if MK_SPLIT
  mega_kernel<0><<<grid_blocks, NTHREADS, 0, stream>>>(p);
  mega_kernel<1><<<grid_blocks, NTHREADS, 0, stream>>>(p);
  mega_kernel<2><<<grid_blocks, NTHREADS, 0, stream>>>(p);
  mega_kernel<3><<<grid_blocks, NTHREADS, 0, stream>>>(p);
  mega_kernel<4><<<grid_blocks, NTHREADS, 0, stream>>>(p);
  mega_kernel<5><<<grid_blocks, NTHREADS, 0, stream>>>(p);
  mega_kernel<6><<<grid_blocks, NTHREADS, 0, stream>>>(p);
  mega_kernel<7><<<grid_blocks, NTHREADS, 0, stream>>>(p);
#else
  hipMemsetAsync((char*)d_ws + OFF_bar, 0, XCD_BAR_WORDS * 4, stream);
  void* args[] = {&p};
  hipError_t e = hipLaunchCooperativeKernel((void*)mega_kernel<-1>, dim3(grid_blocks), dim3(NTHREADS), args, 0, stream);
  if (e != hipSuccess) fprintf(stderr, "cooperative launch failed: %s (grid %d)\n", hipGetErrorString(e), grid_blocks);
#endif
}
```

```cpp
#include <hip/hip_runtime.h>
#include <hip/hip_cooperative_groups.h>
#include <stdint.h>
#include <stdio.h>
namespace cg = cooperative_groups;
#ifndef PROBE_DUP
#define PROBE_DUP 0
#endif

#define DI __device__ __forceinline__
typedef unsigned short bf16_t;
typedef __attribute__((ext_vector_type(8))) short bf16x8;
typedef __attribute__((ext_vector_type(4))) short s16x4;
typedef __attribute__((ext_vector_type(16))) float f32x16;
typedef __attribute__((ext_vector_type(2))) float f32x2;
typedef __attribute__((ext_vector_type(2))) __bf16 bf16x2v;
typedef __attribute__((ext_vector_type(4))) unsigned u32x4;
typedef __attribute__((ext_vector_type(2))) unsigned u32x2;
typedef __attribute__((ext_vector_type(4))) float f32x4;
#define MFMA(a, b, c) __builtin_amdgcn_mfma_f32_32x32x16_bf16((a), (b), (c), 0, 0, 0)

constexpr int NTOK = 16384, SEQL = 4096, DM = 1024;
constexpr int INW = 5280, INWP = 5376;
constexpr int NTHREADS = 512;
constexpr float LOG2E = 1.4426950408889634f;
constexpr float QS_SCALE = 0.125f * 1.4426950408889634f;
constexpr float QM_SCALE = 1.4426950408889634f / 9.797958971132712f;
constexpr float EPSN = 1e-6f;

constexpr int XCD_BAR_WORDS_C = 3456;
constexpr size_t al256(size_t v) { return (v + 255) & ~(size_t)255; }
constexpr size_t OFF_counter = 0;
constexpr size_t OFF_bar = OFF_counter + al256(256);
constexpr size_t OFF_MOD = OFF_bar + al256(XCD_BAR_WORDS_C * 4);
constexpr size_t OFF_ROPE = OFF_MOD + al256(4 * 3072 * 4 * 4);
constexpr size_t OFF_SSQ = OFF_ROPE + al256((size_t)NTOK * 32 * 4);
constexpr size_t OFF_Hb = OFF_SSQ + al256((size_t)2 * NTOK * 4);
constexpr size_t OFF_Qmla = OFF_Hb + al256((size_t)NTOK * 1024 * 2);
constexpr size_t OFF_WuqT = OFF_Qmla + al256((size_t)NTOK * 768 * 2);
constexpr size_t OFF_WukvT = OFF_WuqT + al256((size_t)768 * 384 * 2);
constexpr size_t OFF_WaT = OFF_WukvT + al256((size_t)1024 * 256 * 2);
constexpr size_t OFF_WbT = OFF_WaT + al256((size_t)1024 * 512 * 2);
constexpr size_t OFF_WoT = OFF_WbT + al256((size_t)1024 * 512 * 2);
constexpr size_t OFF_Qsb = OFF_WoT + al256((size_t)1024 * 1024 * 2);
constexpr size_t OFF_Ksb = OFF_Qsb + al256((size_t)NTOK * 512 * 2);
constexpr size_t OFF_VTsb = OFF_Ksb + al256((size_t)NTOK * 512 * 2);
constexpr size_t OFF_Zsb = OFF_VTsb + al256((size_t)NTOK * 512 * 2);
constexpr size_t OFF_OAg = OFF_Zsb + al256((size_t)NTOK * 512 * 2);
constexpr size_t OFF_OBg = OFF_OAg + al256((size_t)NTOK * 512 * 2);
constexpr size_t OFF_Zmla = OFF_OBg + al256((size_t)NTOK * 512 * 2);
constexpr size_t OFF_KPE = OFF_Zmla + al256((size_t)NTOK * 512 * 2);
constexpr size_t OFF_Knope = OFF_KPE + al256((size_t)NTOK * 32 * 2);
constexpr size_t OFF_VTmla = OFF_Knope + al256((size_t)NTOK * 512 * 2);
constexpr size_t OFF_WinT = OFF_VTmla + al256((size_t)NTOK * 512 * 2);
constexpr size_t WS_NEED = OFF_WinT + al256((size_t)INWP * 1024 * 2);
struct Params {
  const float *x, *c; const int* pos;
  const float *w_ada, *b_ada, *norm_gain, *w_in, *q_gain, *w_uq, *kv_gain, *w_ukv, *w_a, *w_b, *w_out, *fgain;
  float* out;
  char* ws;
  DI int* counter() const { return (int*)(ws + OFF_counter); }
  DI unsigned* bar() const { return (unsigned*)(ws + OFF_bar); }
  DI float* MOD() const { return (float*)(ws + OFF_MOD); }
  DI float* ROPE() const { return (float*)(ws + OFF_ROPE); }
  DI float* SSQ() const { return (float*)(ws + OFF_SSQ); }
  DI bf16_t* Hb() const { return (bf16_t*)(ws + OFF_Hb); }
  DI bf16_t* Qmla() const { return (bf16_t*)(ws + OFF_Qmla); }
  DI bf16_t* WuqT() const { return (bf16_t*)(ws + OFF_WuqT); }
  DI bf16_t* WukvT() const { return (bf16_t*)(ws + OFF_WukvT); }
  DI bf16_t* WaT() const { return (bf16_t*)(ws + OFF_WaT); }
  DI bf16_t* WbT() const { return (bf16_t*)(ws + OFF_WbT); }
  DI bf16_t* WoT() const { return (bf16_t*)(ws + OFF_WoT); }
  DI bf16_t* Qsb() const { return (bf16_t*)(ws + OFF_Qsb); }
  DI bf16_t* Ksb() const { return (bf16_t*)(ws + OFF_Ksb); }
  DI bf16_t* VTsb() const { return (bf16_t*)(ws + OFF_VTsb); }
  DI bf16_t* Zsb() const { return (bf16_t*)(ws + OFF_Zsb); }
  DI bf16_t* OAg() const { return (bf16_t*)(ws + OFF_OAg); }
  DI bf16_t* OBg() const { return (bf16_t*)(ws + OFF_OBg); }
  DI bf16_t* Zmla() const { return (bf16_t*)(ws + OFF_Zmla); }
  DI bf16_t* KPE() const { return (bf16_t*)(ws + OFF_KPE); }
  DI bf16_t* Knope() const { return (bf16_t*)(ws + OFF_Knope); }
  DI bf16_t* VTmla() const { return (bf16_t*)(ws + OFF_VTmla); }
  DI bf16_t* MERGED() const { return Hb(); }
  DI bf16_t* WinT() const { return (bf16_t*)(ws + OFF_WinT); }
  DI bf16_t* CQ() const { return OAg(); }
  DI bf16_t* CKV() const { return OBg(); }
  DI bf16_t* GA() const { return (bf16_t*)out; }
  DI bf16_t* GB() const { return (bf16_t*)out + (size_t)NTOK * 1024; }
};


__device__ const float c_invfreq[16] = {
  1.0f, 0.5623413251903491f, 0.31622776601683794f, 0.1778279410038923f, 0.1f, 0.05623413251903491f, 0.03162277660168379f,
  0.01778279410038923f, 0.01f, 0.005623413251903491f, 0.0031622776601683794f, 0.001778279410038923f, 0.001f,
  0.0005623413251903491f, 0.00031622776601683794f, 0.0001778279410038923f};

DI unsigned pk2(float a, float b) { f32x2 v = {a, b}; bf16x2v r = __builtin_convertvector(v, bf16x2v); return __builtin_bit_cast(unsigned, r); }
DI bf16_t tobf(float a) { return (bf16_t)(pk2(a, 0.f) & 0xffffu); }
DI float bf2f(unsigned short u) { return __uint_as_float(((unsigned)u) << 16); }
DI bf16x8 pack8(float a0, float a1, float a2, float a3, float a4, float a5, float a6, float a7) {
  u32x4 p; p[0] = pk2(a0, a1); p[1] = pk2(a2, a3); p[2] = pk2(a4, a5); p[3] = pk2(a6, a7);
  return __builtin_bit_cast(bf16x8, p);
}
DI int crow(int reg, int h) { return (reg & 3) + 8 * (reg >> 2) + 4 * h; }
DI int opaque_tid() { int t = threadIdx.x; asm volatile("" : "+v"(t)); return t; }
DI float half_max(float v) {
  unsigned u = __float_as_uint(v);
  auto r = __builtin_amdgcn_permlane32_swap(u, u, false, false);
  return fmaxf(__uint_as_float(r[0]), __uint_as_float(r[1]));
}
DI float half_sum(float v) {
  unsigned u = __float_as_uint(v);
  auto r = __builtin_amdgcn_permlane32_swap(u, u, false, false);
  return __uint_as_float(r[0]) + __uint_as_float(r[1]);
}
DI float sigmoidf_fast(float v) { return __builtin_amdgcn_rcpf(1.f + __builtin_amdgcn_exp2f(-v * LOG2E)); }
DI float siluf_fast(float v) { return v * sigmoidf_fast(v); }

#define XB_TMO      128
#define XB_XCNT(j)  (256  + 64 * (j))
#define XB_XSUB(j)  (1280 + 64 * (j))
#define XB_XGEN(j)  (2304 + 64 * (j))
#define XB_TOP      3328
#define XB_TOPGEN   3392
#define XCD_BAR_WORDS 3456
#define XB_SPIN_CAP (1u << 18)
#define LAS __attribute__((address_space(3)))
DI unsigned xb_ld(unsigned* p)              { return __hip_atomic_load(p, __ATOMIC_RELAXED, __HIP_MEMORY_SCOPE_AGENT); }
DI unsigned xb_add(unsigned* p, unsigned v) { return __hip_atomic_fetch_add(p, v, __ATOMIC_RELAXED, __HIP_MEMORY_SCOPE_AGENT); }
DI unsigned xb_xcc_id() { return (unsigned)__builtin_amdgcn_s_getreg((3 << 11) | 20) & 0xFu; }
#define XB_SPIN(cond, bar) do { unsigned _sp = 0; while (cond) { __builtin_amdgcn_s_sleep(1); \
    if ((++_sp & 255u) == 0u) { if (xb_ld(&(bar)[XB_TMO])) break; if (_sp > XB_SPIN_CAP) { atomicAdd(&(bar)[XB_TMO], 1u); break; } } } } while (0)
struct XcdBarrier { unsigned* bar; unsigned x; volatile LAS unsigned* st; };
DI XcdBarrier xcd_barrier_post(unsigned* bar, volatile LAS unsigned* st) {
  XcdBarrier b; b.bar = bar; b.x = xb_xcc_id(); b.st = st;
  if (threadIdx.x == 0) (void)xb_add(&bar[XB_XCNT(b.x)], 1u);
  return b;
}
DI void xcd_barrier_complete(unsigned* bar, unsigned x, unsigned& nloc, unsigned& nx) {
  const unsigned G = gridDim.x * gridDim.y * gridDim.z;
  unsigned sum, cnt, mine, sp = 0u;
  for (;;) {
    sum = 0u; cnt = 0u; mine = 0u;
#pragma unroll
    for (unsigned j = 0; j < 16; ++j) { const unsigned c = xb_ld(&bar[XB_XCNT(j)]); sum += c; cnt += (c > 0u) ? 1u : 0u; mine = (j == x) ? c : mine; }
    if (sum == G) break;
    __builtin_amdgcn_s_sleep(1);
    if ((++sp & 255u) == 0u) { if (xb_ld(&bar[XB_TMO])) break; if (sp > XB_SPIN_CAP) { atomicAdd(&bar[XB_TMO], 1u); break; } }
  }
  nloc = mine > 0u ? mine : 1u; nx = cnt > 0u ? cnt : 1u;
}
DI void xcd_barrier(unsigned* bar_, volatile LAS unsigned* st_) {
  XcdBarrier b; b.bar = bar_; b.st = st_; b.x = 0;
  asm volatile("s_waitcnt vmcnt(0)" ::: "memory");
  __syncthreads();
  if (threadIdx.x == 0) {
    unsigned* bar = b.bar;
    b.x = xb_xcc_id();
    __builtin_amdgcn_s_waitcnt(0);
    unsigned nloc = b.st[0], nx = b.st[1];
    if (nloc == 0u) { xcd_barrier_complete(bar, b.x, nloc, nx); b.st[0] = nloc; b.st[1] = nx; }
    const unsigned old = xb_add(&bar[XB_XSUB(b.x)], 1u);
    const unsigned gen = old / nloc;
    if (old + 1u == (gen + 1u) * nloc) {
      __builtin_amdgcn_fence(__ATOMIC_RELEASE, "agent");
      asm volatile("s_waitcnt vmcnt(0)" ::: "memory");
      const unsigned og = xb_add(&bar[XB_TOP], 1u);
      const unsigned tg = og / nx;
      if (og + 1u == (tg + 1u) * nx) xb_add(&bar[XB_TOPGEN], 1u);
      else XB_SPIN(xb_ld(&bar[XB_TOPGEN]) == tg, bar);
      __builtin_amdgcn_fence(__ATOMIC_ACQUIRE, "agent");
      xb_add(&bar[XB_XGEN(b.x)], 1u);
      asm volatile("s_waitcnt vmcnt(0)" ::: "memory");
    } else {
      XB_SPIN(xb_ld(&bar[XB_XGEN(b.x)]) == gen, bar);
      __builtin_amdgcn_fence(__ATOMIC_ACQUIRE, "agent");
      asm volatile("s_waitcnt vmcnt(0)" ::: "memory");
    }
  }
  __syncthreads();
}

constexpr int GSTR = 72;
constexpr int GBUF = 128 * GSTR;
constexpr int RS_OFF = 135168;
constexpr int SMEM_BYTES = RS_OFF + 4096;

constexpr int G8_HT = 128 * 64;
DI int lds_byte(int r, int c) { const int st = (r >> 4) * 2 + (c >> 5), rr = r & 15, cc = c & 31, ob = rr * 64 + cc * 2; return st * 1024 + (ob ^ (((ob >> 9) & 1) << 5)); }
DI void stage_rc(int b, int& R, int& C) { const int st = b / 1024, sb = b % 1024, swz = sb ^ (((sb >> 9) & 1) << 5); R = (st >> 1) * 16 + swz / 64; C = (st & 1) * 32 + (swz % 64) / 2; }

DI void gemm8_tile(const bf16_t* __restrict__ A, const bf16_t* __restrict__ Bt, const int K, bf16_t* shm, f32x4 (&acc)[2][2][4][2]) {
  const int tid = opaque_tid();
  const int wid = tid >> 6, lane = tid & 63, wr = wid >> 2, wc = wid & 3, fr = lane & 15, fq = lane >> 4;
  const int swz = (fr * 64 + fq * 16) ^ ((fr >> 3) << 5);
  const char* aRd = (const char*)shm + swz + wr * 8192;
  const char* bRd = (const char*)shm + 65536 + swz + wc * 4096;
  int sr0, sc0, sr1, sc1;
  stage_rc(tid * 16, sr0, sc0);
  stage_rc(tid * 16 + 8192, sr1, sc1);
  const unsigned so0 = (unsigned)(sr0 * K + sc0) * 2u, so1 = (unsigned)(sr1 * K + sc1) * 2u;
  char* const stw = (char*)shm + __builtin_amdgcn_readfirstlane(tid & ~63) * 16;
  const char* const Ab = (const char*)A;
  const char* const Bb = (const char*)Bt;
#define SA(b, h) (((b) * 2 + (h)) * 16384)
#define SB(b, h) ((4 + (b) * 2 + (h)) * 16384)
#define STAGE(P, BASE, br, kt) do { const char* g_ = (BASE) + ((long)(br) * K + (long)(kt) * 64) * 2;                        \
    __builtin_amdgcn_global_load_lds((const unsigned*)(g_ + so0), (unsigned*)(stw + (P)), 16, 0, 0);                          \
    __builtin_amdgcn_global_load_lds((const unsigned*)(g_ + so1), (unsigned*)(stw + (P) + 8192), 16, 0, 0); } while (0)
#define LDA(dst, b, h) _Pragma("unroll") for (int m = 0; m < 4; ++m) _Pragma("unroll") for (int k = 0; k < 2; ++k) \
    dst[m][k] = *reinterpret_cast<const bf16x8*>(aRd + ((b) * 2 + (h)) * 16384 + (m * 2 + k) * 1024)
#define LDB(dst, b, h) _Pragma("unroll") for (int n = 0; n < 2; ++n) _Pragma("unroll") for (int k = 0; k < 2; ++k) \
    dst[n][k] = *reinterpret_cast<const bf16x8*>(bRd + ((b) * 2 + (h)) * 16384 + (n * 2 + k) * 1024)
#define MMA(ai, bj, At_, Bt_) do { __builtin_amdgcn_s_setprio(1);                                                          \
    _Pragma("unroll") for (int m = 0; m < 4; ++m) _Pragma("unroll") for (int n = 0; n < 2; ++n) _Pragma("unroll") for (int k = 0; k < 2; ++k) \
      acc[ai][bj][m][n] = __builtin_amdgcn_mfma_f32_16x16x32_bf16(At_[m][k], Bt_[n][k], acc[ai][bj][m][n], 0, 0, 0);       \
    __builtin_amdgcn_s_setprio(0); } while (0)
#define WAIT_V(n) asm volatile("s_waitcnt vmcnt(" #n ")" ::: "memory")
#define WAIT_L(n) asm volatile("s_waitcnt lgkmcnt(" #n ")" ::: "memory")
#define BAR __builtin_amdgcn_s_barrier()
#define SCHED __builtin_amdgcn_sched_barrier(0)
  bf16x8 At[4][2], B0[2][2], B1[2][2];
  const int nt = K / 64;
  STAGE(SB(0, 0), Bb, 0, 0); STAGE(SA(0, 0), Ab, 0, 0);
  STAGE(SB(0, 1), Bb, 128, 0); STAGE(SA(0, 1), Ab, 128, 0);
  if (wr == 1) BAR;
  WAIT_V(4); BAR;
  STAGE(SB(1, 0), Bb, 0, 1); STAGE(SA(1, 0), Ab, 0, 1); STAGE(SB(1, 1), Bb, 128, 1);
  WAIT_V(6); BAR;
  for (int t = 0; t < nt - 2; t += 2) {
    LDB(B0, 0, 0); SCHED; LDA(At, 0, 0); STAGE(SA(1, 1), Ab, 128, t + 1);
    WAIT_L(8); BAR; WAIT_L(0); MMA(0, 0, At, B0); BAR; SCHED;
    LDB(B1, 0, 1); STAGE(SB(0, 0), Bb, 0, t + 2);
    BAR; WAIT_L(0); MMA(0, 1, At, B1); BAR;
    LDA(At, 0, 1); STAGE(SA(0, 0), Ab, 0, t + 2);
    BAR; WAIT_L(0); MMA(1, 0, At, B0); BAR; SCHED;
    STAGE(SB(0, 1), Bb, 128, t + 2);
    WAIT_V(6); BAR; MMA(1, 1, At, B1); BAR;
    LDB(B0, 1, 0); SCHED; LDA(At, 1, 0); STAGE(SA(0, 1), Ab, 128, t + 2);
    WAIT_L(8); BAR; WAIT_L(0); MMA(0, 0, At, B0); BAR; SCHED;
    LDB(B1, 1, 1); STAGE(SB(1, 0), Bb, 0, t + 3);
    BAR; WAIT_L(0); MMA(0, 1, At, B1); BAR;
    LDA(At, 1, 1); STAGE(SA(1, 0), Ab, 0, t + 3);
    BAR; WAIT_L(0); MMA(1, 0, At, B0); BAR; SCHED;
    STAGE(SB(1, 1), Bb, 128, t + 3);
    WAIT_V(6); BAR; MMA(1, 1, At, B1); BAR;
  }
  { LDB(B0, 0, 0); LDA(At, 0, 0); STAGE(SA(1, 1), Ab, 128, nt - 1);
    BAR; WAIT_L(0); MMA(0, 0, At, B0); BAR;
    LDB(B1, 0, 1); BAR; WAIT_L(0); MMA(0, 1, At, B1); BAR;
    LDA(At, 0, 1); WAIT_V(4); BAR; WAIT_L(0); MMA(1, 0, At, B0); MMA(1, 1, At, B1); BAR; }
  { LDB(B0, 1, 0); LDA(At, 1, 0); WAIT_V(2); BAR; WAIT_L(0); MMA(0, 0, At, B0); BAR;
    LDB(B1, 1, 1); WAIT_V(0); BAR; WAIT_L(0); MMA(0, 1, At, B1); BAR;
    LDA(At, 1, 1); BAR; WAIT_L(0); MMA(1, 0, At, B0); MMA(1, 1, At, B1); BAR; }
  if (wr == 0) BAR;
#undef SA
#undef SB
#undef STAGE
#undef LDA
#undef LDB
#undef MMA
#undef WAIT_V
#undef WAIT_L
#undef BAR
#undef SCHED
}


DI void zero_acc8(f32x4 (&acc)[2][2][4][2]) {
#pragma unroll
  for (int a = 0; a < 2; ++a)
#pragma unroll
    for (int b = 0; b < 2; ++b)
#pragma unroll
      for (int m = 0; m < 4; ++m)
#pragma unroll
        for (int n = 0; n < 2; ++n) acc[a][b][m][n] = f32x4{0.f, 0.f, 0.f, 0.f};
}

constexpr int CSTR = 132;
DI void accq_to_lds(const f32x4 (&q)[4][2], float* sC) {
  const int tid = opaque_tid(), wid = tid >> 6, lane = tid & 63, wr = wid >> 2, wc = wid & 3, fr = lane & 15, fq = lane >> 4;
#pragma unroll
  for (int m = 0; m < 4; ++m)
#pragma unroll
    for (int n = 0; n < 2; ++n)
#pragma unroll
      for (int j = 0; j < 4; ++j) sC[(wr * 64 + m * 16 + fq * 4 + j) * CSTR + wc * 32 + n * 16 + fr] = q[m][n][j];
}
constexpr int SC2_OFF = 128 * CSTR;
template <class EPI>
DI void tile_epilogue2(const f32x4 (&acc)[2][2][4][2], float* sC, EPI epi) {
  __syncthreads();
  accq_to_lds(acc[0][0], sC);
  __syncthreads();
  accq_to_lds(acc[0][1], sC + SC2_OFF);
  epi(0, sC);
  __syncthreads();
  accq_to_lds(acc[1][0], sC);
  epi(1, sC + SC2_OFF);
  __syncthreads();
  accq_to_lds(acc[1][1], sC + SC2_OFF);
  epi(2, sC);
  __syncthreads();
  epi(3, sC + SC2_OFF);
  __syncthreads();
}

template <class F>
DI void epi_rows(const float* sC, F f) {
  const int tx = opaque_tid();
#pragma unroll
  for (int i = 0; i < 4; ++i) {
    const int c = tx + 512 * i, row = c >> 4, cc = (c & 15) * 8;
    const float4 a = *(const float4*)(sC + row * CSTR + cc), b = *(const float4*)(sC + row * CSTR + cc + 4);
    const float v[8] = {a.x, a.y, a.z, a.w, b.x, b.y, b.z, b.w};
    f(i, row, cc, v);
  }
}
DI float4 ldnt4(const float* p) { float4 r; r.x = __builtin_nontemporal_load(p); r.y = __builtin_nontemporal_load(p + 1); r.z = __builtin_nontemporal_load(p + 2); r.w = __builtin_nontemporal_load(p + 3); return r; }
DI void store8(bf16_t* p, const float (&v)[8]) { *(bf16x8*)p = pack8(v[0], v[1], v[2], v[3], v[4], v[5], v[6], v[7]); }
DI void store8_nt(bf16_t* p, const float (&v)[8]) { __builtin_nontemporal_store(pack8(v[0], v[1], v[2], v[3], v[4], v[5], v[6], v[7]), (bf16x8*)p); }
DI void epi_vt(const float* sC, bf16_t* VT, int m0, int head0, int c0, int ncol_log2) {
  const int b = m0 >> 12, s0 = m0 & 4095;
  const int nitems = 16 << ncol_log2;
  for (int c = opaque_tid(); c < nitems; c += 512) {
    const int col = c & ((1 << ncol_log2) - 1), rc = c >> ncol_log2;
    float v[8];
#pragma unroll
    for (int j = 0; j < 8; ++j) v[j] = sC[(rc * 8 + j) * CSTR + c0 + col];
    const int head = head0 + (col >> 6), d = col & 63;
    store8(VT + ((size_t)((b * 8 + head) * 64 + d)) * SEQL + s0 + rc * 8, v);
  }
}
DI void rope8(const float* sC, const float* ROPE, int tok, int row, int cc, float (&v)[8]) {
  const float* pr = sC + row * CSTR + (cc ^ 16);
  const bool upper = (cc & 16) != 0;
  const int f0 = cc & 15;
  const float* tb = ROPE + (size_t)tok * 32;
#pragma unroll
  for (int j = 0; j < 8; ++j) {
    const float o = pr[j], cs = tb[f0 + j], sn = tb[16 + f0 + j];
    v[j] = upper ? (o * sn + v[j] * cs) : (v[j] * cs - o * sn);
  }
}

DI void wconv_unit(const float* __restrict__ src, int Nsrc, int K, bf16_t* __restrict__ dst, const float* __restrict__ gain, int ng, int kg, int mode, float* tile, const int tid) {
  {
    const int k = tid >> 2, cq = tid & 3;
    const int n = ng * 64 + cq * 16;
    int sc = n;
    if (mode == 1) { sc = (n < 2688) ? n : (n < 5248 ? n + 32 : (n < 5280 ? n - 2560 : -1)); }
    const int kk = kg * 64 + k;
    float4 v[4];
    if (sc >= 0) {
      const float* sp = src + (size_t)kk * Nsrc + sc;
#pragma unroll
      for (int i = 0; i < 4; ++i) v[i] = ldnt4(sp + 4 * i);
      if (gain) { const float g = gain[kk];
#pragma unroll
        for (int i = 0; i < 4; ++i) { v[i].x *= g; v[i].y *= g; v[i].z *= g; v[i].w *= g; } }
    } else {
#pragma unroll
      for (int i = 0; i < 4; ++i) v[i] = make_float4(0.f, 0.f, 0.f, 0.f);
    }
    float* tp = tile + k * 65 + cq * 16;
#pragma unroll
    for (int i = 0; i < 4; ++i) { tp[4 * i] = v[i].x; tp[4 * i + 1] = v[i].y; tp[4 * i + 2] = v[i].z; tp[4 * i + 3] = v[i].w; }
  }
  __syncthreads();
  {
    const int n = tid >> 2, kc = tid & 3;
    float o[16];
#pragma unroll
    for (int j = 0; j < 16; ++j) o[j] = tile[(kc * 16 + j) * 65 + n];
    bf16_t* dp = dst + (size_t)(ng * 64 + n) * K + kg * 64 + kc * 16;
    *(bf16x8*)dp = pack8(o[0], o[1], o[2], o[3], o[4], o[5], o[6], o[7]);
    *(bf16x8*)(dp + 8) = pack8(o[8], o[9], o[10], o[11], o[12], o[13], o[14], o[15]);
  }
  __syncthreads();
}

DI void phase_prep(const Params& p, char* smem) {
  if (blockIdx.x == 0 && threadIdx.x < 16) { p.counter()[threadIdx.x] = 0; }
  for (int i = blockIdx.x * NTHREADS + threadIdx.x; i < 2 * NTOK; i += gridDim.x * NTHREADS) p.SSQ()[i] = 0.f;
  const int half = threadIdx.x >> 8, tid = threadIdx.x & 255;
  constexpr int U_MOD = 96 * 4, U_WIN = 84 * 16, U_WUQ = 12 * 6, U_WUKV = 16 * 4, U_WA = 16 * 8, U_WB = 16 * 8, U_WO = 16 * 16, U_ROPE = 1024;
  constexpr int U_TOTAL = U_MOD + U_ROPE + U_WIN + U_WUQ + U_WUKV + U_WA + U_WB + U_WO;
  float* tile = (float*)smem + half * (64 * 65 + 64);
  for (int up = blockIdx.x; up < U_TOTAL / 2; up += gridDim.x) {
    int v = 2 * up + half;
    if (v < U_MOD) {
      const int cg32 = v >> 2, kq = v & 3, n0 = cg32 * 32;
      const int kgp = tid >> 5, col = tid & 31;
      const int kb = kq * 256 + kgp * 32;
      float a0 = 0.f, a1 = 0.f, a2 = 0.f, a3 = 0.f;
      const float* wp = p.w_ada + (size_t)kb * 3072 + n0 + col;
      float wv[32];
#pragma unroll
      for (int kk = 0; kk < 32; ++kk) wv[kk] = __builtin_nontemporal_load(wp + (size_t)kk * 3072);
#pragma unroll
      for (int kk = 0; kk < 32; ++kk) {
        a0 += wv[kk] * p.c[kb + kk]; a1 += wv[kk] * p.c[1024 + kb + kk]; a2 += wv[kk] * p.c[2048 + kb + kk]; a3 += wv[kk] * p.c[3072 + kb + kk];
      }
      float* red = (float*)smem + half * 1024;
      red[(kgp * 4 + 0) * 32 + col] = a0; red[(kgp * 4 + 1) * 32 + col] = a1; red[(kgp * 4 + 2) * 32 + col] = a2; red[(kgp * 4 + 3) * 32 + col] = a3;
      __syncthreads();
      if (tid < 128) {
        const int b = tid >> 5, cc = tid & 31;
        float s = (kq == 0) ? p.b_ada[n0 + cc] : 0.f;
#pragma unroll
        for (int g = 0; g < 8; ++g) s += red[(g * 4 + b) * 32 + cc];
        p.MOD()[(size_t)(b * 3072 + n0 + cc) * 4 + kq] = s;
      }
      __syncthreads();
      continue;
    }
    v -= U_MOD;
    if (v < U_WIN) { wconv_unit(p.w_in, INW, 1024, p.WinT(), nullptr, v >> 4, v & 15, 1, tile, tid); continue; }
    v -= U_WIN;
    if (v < U_WUQ) { wconv_unit(p.w_uq, 768, 384, p.WuqT(), p.q_gain, v / 6, v % 6, 0, tile, tid); continue; }
    v -= U_WUQ;
    if (v < U_WUKV) { wconv_unit(p.w_ukv, 1024, 256, p.WukvT(), p.kv_gain, v >> 2, v & 3, 0, tile, tid); continue; }
    v -= U_WUKV;
    if (v < U_WA) { wconv_unit(p.w_a, 1024, 512, p.WaT(), nullptr, v >> 3, v & 7, 0, tile, tid); continue; }
    v -= U_WA;
    if (v < U_WB) { wconv_unit(p.w_b, 1024, 512, p.WbT(), nullptr, v >> 3, v & 7, 0, tile, tid); continue; }
    v -= U_WB;
    if (v < U_WO) { wconv_unit(p.w_out, 1024, 1024, p.WoT(), nullptr, v >> 4, v & 15, 0, tile, tid); continue; }
    v -= U_WO;
    {
      const int idx = v * 256 + tid, tok = idx >> 4, i = idx & 15;
      const float ang = (float)p.pos[tok] * c_invfreq[i];
      double t = (double)ang * 0.15915494309189535;
      t -= rint(t);
      const float tf = (float)t;
      p.ROPE()[(size_t)tok * 32 + i] = __builtin_amdgcn_cosf(tf);
      p.ROPE()[(size_t)tok * 32 + 16 + i] = __builtin_amdgcn_sinf(tf);
    }
  }
}

DI float mod_get(const float* MOD, int b, int n) { const float4 q = *(const float4*)(MOD + (size_t)(b * 3072 + n) * 4); return (q.x + q.y) + (q.z + q.w); }

DI void phase_h(const Params& p, char* smem) {
  const int tid = opaque_tid(), lane = tid & 63, w = tid >> 6;
  float* gs = (float*)smem;
  float* sh = gs + 1024;
  const int xq = blockIdx.x & 7, lb = blockIdx.x >> 3, nlb = gridDim.x >> 3;
  const bool xmap = (gridDim.x & 7) == 0;
  for (int rgi = xmap ? lb : (int)blockIdx.x; rgi < (xmap ? 32 : NTOK / 64); rgi += (xmap ? nlb : (int)gridDim.x)) {
    const int rg = xmap ? (32 * xq + rgi) : rgi;
    const int b = (rg * 64) >> 12;
    __syncthreads();
#pragma unroll
    for (int i = 0; i < 2; ++i) {
      const int k = tid + 512 * i;
      gs[k] = p.norm_gain[k] * (1.f + mod_get(p.MOD(), b, 1024 + k));
      sh[k] = mod_get(p.MOD(), b, k);
    }
    __syncthreads();
#pragma unroll 4
    for (int rr = 0; rr < 8; ++rr) {
      const int row = rg * 64 + w * 8 + rr;
      const float* xr = p.x + (size_t)row * DM;
      float4 v[4];
      float ss = 0.f;
#pragma unroll
      for (int i = 0; i < 2; ++i) {
        const int e = 8 * (lane + 64 * i);
        v[2 * i] = ldnt4(xr + e);
        v[2 * i + 1] = ldnt4(xr + e + 4);
        ss += v[2 * i].x * v[2 * i].x + v[2 * i].y * v[2 * i].y + v[2 * i].z * v[2 * i].z + v[2 * i].w * v[2 * i].w;
        ss += v[2 * i + 1].x * v[2 * i + 1].x + v[2 * i + 1].y * v[2 * i + 1].y + v[2 * i + 1].z * v[2 * i + 1].z + v[2 * i + 1].w * v[2 * i + 1].w;
      }
#pragma unroll
      for (int o = 32; o >= 1; o >>= 1) ss += __shfl_xor(ss, o);
      const float rn = __builtin_amdgcn_rsqf(ss * (1.f / DM) + EPSN);
#pragma unroll
      for (int i = 0; i < 2; ++i) {
        const int e = 8 * (lane + 64 * i);
        const float4 g0 = *(const float4*)(gs + e), g1 = *(const float4*)(gs + e + 4);
        const float4 s0 = *(const float4*)(sh + e), s1 = *(const float4*)(sh + e + 4);
        *(bf16x8*)(p.Hb() + (size_t)row * DM + e) =
            pack8(v[2 * i].x * rn * g0.x + s0.x, v[2 * i].y * rn * g0.y + s0.y, v[2 * i].z * rn * g0.z + s0.z, v[2 * i].w * rn * g0.w + s0.w,
                  v[2 * i + 1].x * rn * g1.x + s1.x, v[2 * i + 1].y * rn * g1.y + s1.y, v[2 * i + 1].z * rn * g1.z + s1.z, v[2 * i + 1].w * rn * g1.w + s1.w);
      }
    }
  }
  __syncthreads();
}

DI void g1_epi(const Params& p, const float* sC, const int m0, const int n0, const int ct, const bool do_ssq) {
    if (ct < 4) {
      epi_rows(sC, [&](int, int row, int cc, const float (&v)[8]) {
        float o[8];
#pragma unroll
        for (int j = 0; j < 8; ++j) o[j] = v[j] * QS_SCALE;
        store8(p.Qsb() + (size_t)(m0 + row) * 512 + n0 + cc, o); });
    } else if (ct < 8) {
      epi_rows(sC, [&](int, int row, int cc, const float (&v)[8]) { store8(p.Ksb() + (size_t)(m0 + row) * 512 + n0 - 512 + cc, v); });
    } else if (ct < 12) {
      epi_vt(sC, p.VTsb(), m0, (n0 - 1024) >> 6, 0, 7);
    } else if (ct < 16) {
      epi_rows(sC, [&](int, int row, int cc, const float (&v)[8]) {
        float o[8];
#pragma unroll
        for (int j = 0; j < 8; ++j) o[j] = siluf_fast(v[j]);
        store8(p.Zsb() + (size_t)(m0 + row) * 512 + n0 - 1536 + cc, o); });
    } else if (ct < 19) {
      epi_rows(sC, [&](int, int row, int cc, const float (&v)[8]) {
        store8(p.CQ() + (size_t)(m0 + row) * 384 + n0 - 2048 + cc, v);
        float q = 0.f;
#pragma unroll
        for (int j = 0; j < 8; ++j) q += v[j] * v[j];
        q += __shfl_xor(q, 1); q += __shfl_xor(q, 2); q += __shfl_xor(q, 4); q += __shfl_xor(q, 8);
        if (do_ssq && (threadIdx.x & 15) == 0) atomicAdd(p.SSQ() + m0 + row, q); });
    } else if (ct < 21) {
      epi_rows(sC, [&](int, int row, int cc, const float (&v)[8]) {
        store8(p.CKV() + (size_t)(m0 + row) * 256 + n0 - 2432 + cc, v);
        float q = 0.f;
#pragma unroll
        for (int j = 0; j < 8; ++j) q += v[j] * v[j];
        q += __shfl_xor(q, 1); q += __shfl_xor(q, 2); q += __shfl_xor(q, 4); q += __shfl_xor(q, 8);
        if (do_ssq && (threadIdx.x & 15) == 0) atomicAdd(p.SSQ() + NTOK + m0 + row, q); });
    } else if (ct < 25) {
      epi_rows(sC, [&](int, int row, int cc, const float (&v)[8]) {
        float o[8];
#pragma unroll
        for (int j = 0; j < 8; ++j) o[j] = siluf_fast(v[j]);
        store8(p.Zmla() + (size_t)(m0 + row) * 512 + n0 - 2688 + cc, o); });
    } else if (ct < 33) {
      epi_rows(sC, [&](int, int row, int cc, const float (&v)[8]) {
        float o[8];
#pragma unroll
        for (int j = 0; j < 8; ++j) o[j] = sigmoidf_fast(v[j]);
        store8_nt(p.GA() + (size_t)(m0 + row) * 1024 + n0 - 3200 + cc, o); });
    } else if (ct < 41) {
      epi_rows(sC, [&](int, int row, int cc, const float (&v)[8]) {
        float o[8];
#pragma unroll
        for (int j = 0; j < 8; ++j) o[j] = sigmoidf_fast(v[j]);
        store8_nt(p.GB() + (size_t)(m0 + row) * 1024 + n0 - 4224 + cc, o); });
    } else {
      epi_rows(sC, [&](int, int row, int cc, const float (&v)[8]) {
        if (cc < 32) {
          float o[8];
#pragma unroll
          for (int j = 0; j < 8; ++j) o[j] = v[j];
          rope8(sC, p.ROPE(), m0 + row, row, cc, o);
          store8(p.KPE() + (size_t)(m0 + row) * 32 + cc, o);
        } });
    }
}

DI void g1_tile(const Params& p, char* smem, const int rt, const int ct2, const bool do_ssq) {
  bf16_t* shm = (bf16_t*)smem;
  float* sC = (float*)smem;
  const int m0 = rt * 256, n0 = ct2 * 256;
  f32x4 acc[2][2][4][2];
  zero_acc8(acc);
  gemm8_tile(p.Hb() + (size_t)m0 * DM, p.WinT() + (size_t)n0 * DM, DM, shm, acc);
  tile_epilogue2(acc, sC, [&](const int qd, const float* sq) {
    g1_epi(p, sq, m0 + (qd >> 1) * 128, n0 + (qd & 1) * 128, ct2 * 2 + (qd & 1), do_ssq); });
}

constexpr int G1_NCT = 20;
DI void phase_g1(const Params& p, char* smem, bool do_ssq = true) {
  const int xq = blockIdx.x & 7, lb = blockIdx.x >> 3, nlb = gridDim.x >> 3;
  const bool xmap = (gridDim.x & 7) == 0;
  for (int t = xmap ? lb : (int)blockIdx.x; t < (xmap ? 8 * G1_NCT : 64 * G1_NCT); t += (xmap ? nlb : (int)gridDim.x)) {
    int rt, ct2;
    if (xmap) { ct2 = t >> 3; rt = 8 * xq + (t & 7); } else { rt = t / G1_NCT; ct2 = t % G1_NCT; }
    g1_tile(p, smem, rt, ct2, do_ssq);
  }
}

DI void g2_epi_q(const Params& p, const float* sC, const float* rsq, const int m0, const int n0) {
  epi_rows(sC, [&](int, int row, int cc, const float (&v)[8]) {
    const int col = n0 + cc;
    float o[8];
#pragma unroll
    for (int j = 0; j < 8; ++j) o[j] = v[j];
    if (((col >> 5) % 3) == 2) rope8(sC, p.ROPE(), m0 + row, row, cc, o);
    const float sc = rsq[row] * QM_SCALE;
#pragma unroll
    for (int j = 0; j < 8; ++j) o[j] *= sc;
    store8(p.Qmla() + (size_t)(m0 + row) * 768 + col, o);
  });
}
DI void g2_epi_kv(const Params& p, const float* sC, const float* rsq, const int m0, const int head) {
  epi_rows(sC, [&](int, int row, int cc, const float (&v)[8]) {
    if (cc < 64) {
      const float sc = rsq[row];
      float o[8];
#pragma unroll
      for (int j = 0; j < 8; ++j) o[j] = v[j] * sc;
      store8(p.Knope() + (size_t)(m0 + row) * 512 + head * 64 + cc, o);
    } });
  const int b = m0 >> 12, s0 = m0 & 4095;
  for (int c = opaque_tid(); c < 1024; c += 512) {
    const int col = c & 63, rc = c >> 6;
    float v[8];
#pragma unroll
    for (int j = 0; j < 8; ++j) v[j] = sC[(rc * 8 + j) * CSTR + 64 + col] * rsq[rc * 8 + j];
    store8(p.VTmla() + ((size_t)((b * 8 + head) * 64 + col)) * SEQL + s0 + rc * 8, v);
  }
}

DI void g2_tile(const Params& p, char* smem, const bool isq, const int rt, const int ct) {
  bf16_t* shm = (bf16_t*)smem;
  float* sC = (float*)smem;
  float* rs = (float*)(smem + RS_OFF);
  const int m0 = rt * 256, n0 = ct * 256;
  f32x4 acc[2][2][4][2];
  zero_acc8(acc);
  if (isq) {
    if (threadIdx.x < 256) rs[threadIdx.x] = __builtin_amdgcn_rsqf(p.SSQ()[m0 + threadIdx.x] * (1.f / 384.f) + EPSN);
    gemm8_tile(p.CQ() + (size_t)m0 * 384, p.WuqT() + (size_t)n0 * 384, 384, shm, acc);
    tile_epilogue2(acc, sC, [&](const int qd, const float* sq) {
      g2_epi_q(p, sq, rs + (qd >> 1) * 128, m0 + (qd >> 1) * 128, n0 + (qd & 1) * 128); });
  } else {
    if (threadIdx.x < 256) rs[threadIdx.x] = __builtin_amdgcn_rsqf(p.SSQ()[NTOK + m0 + threadIdx.x] * (1.f / 256.f) + EPSN);
    gemm8_tile(p.CKV() + (size_t)m0 * 256, p.WukvT() + (size_t)n0 * 256, 256, shm, acc);
    tile_epilogue2(acc, sC, [&](const int qd, const float* sq) {
      g2_epi_kv(p, sq, rs + (qd >> 1) * 128, m0 + (qd >> 1) * 128, ct * 2 + (qd & 1)); });
  }
  __syncthreads();
}

DI void phase_g2(const Params& p, char* smem) {
  const int xq = blockIdx.x & 7, lb = blockIdx.x >> 3, nlb = gridDim.x >> 3;
  if ((gridDim.x & 7) == 0 && nlb == 32) {
    if (lb < 8) {
      g1_tile(p, smem, 8 * xq + lb, G1_NCT, false);
      const int v2 = 24 + lb;
      g2_tile(p, smem, false, 8 * xq + (v2 & 7), v2 >> 3);
      return;
    }
    const int v = lb - 8;
    g2_tile(p, smem, true, 8 * xq + (v & 7), v >> 3);
    g2_tile(p, smem, false, 8 * xq + (v & 7), v >> 3);
  } else {
    for (int tt = blockIdx.x; tt < 64 + 192 + 256; tt += gridDim.x) {
      if (tt < 64) g1_tile(p, smem, tt, G1_NCT, false);
      else if (tt < 256) { const int v = tt - 64; g2_tile(p, smem, true, v / 3, v % 3); }
      else { const int v = tt - 256; g2_tile(p, smem, false, v >> 2, v & 3); }
    }
  }
}

constexpr int VSTR = 68;

template <bool MLA>
DI void attn_item(const Params& p, int b, int h, int qb, char* smem, int* pre_ctr, int& pre_raw) {
  constexpr int DK = MLA ? 96 : 64;
  constexpr int KSTR = MLA ? 104 : 72;
  constexpr int NKS = DK / 16;
  bf16_t* sK = (bf16_t*)smem;
  bf16_t* sV = sK + 2 * 64 * KSTR;
  const int tid = threadIdx.x, lane = tid & 63, w = tid >> 6, r = lane & 31, hh = lane >> 5;
  const int tokb = b * SEQL;
  const int tok0 = tokb + qb * 256;
  const int qw = qb * 256 + w * 32;

  bf16x8 qf[NKS];
  {
    const bf16_t* qptr = MLA ? (p.Qmla() + (size_t)(tok0 + w * 32 + r) * 768 + h * 96 + hh * 8) : (p.Qsb() + (size_t)(tok0 + w * 32 + r) * 512 + h * 64 + hh * 8);
#pragma unroll
    for (int ks = 0; ks < NKS; ++ks) qf[ks] = *(const bf16x8*)(qptr + ks * 16);
  }
  u32x2* zbuf = (u32x2*)(smem + 65536);
  u32x2 zpre[8];
  {
    const bf16_t* zg0 = (MLA ? p.Zmla() : p.Zsb()) + (size_t)(tok0 + w * 32 + r) * 512 + h * 64 + 4 * hh;
#pragma unroll
    for (int i = 0; i < 8; ++i) zpre[i] = *(const u32x2*)(zg0 + (i >> 2) * 32 + 8 * (i & 3));
  }
  bf16x8 tf[2];
  if (!MLA) {
#pragma unroll
    for (int st = 0; st < 2; ++st)
#pragma unroll
      for (int e = 0; e < 8; ++e) { const int j = 16 * st + 8 * (e >> 2) + 4 * hh + (e & 3); tf[st][e] = (j >= r) ? (short)0x3F80 : (short)0; }
  }

  f32x16 oacc[2];
#pragma unroll
  for (int i = 0; i < 16; ++i) { oacc[0][i] = 0.f; oacc[1][i] = 0.f; }
  float carry = 0.f;
  float mrun = 0.f, lrun = 0.f;

  const bf16_t* Kg = MLA ? p.Knope() : p.Ksb();
  const bf16_t* VTg = (MLA ? p.VTmla() : p.VTsb()) + (size_t)((b * 8 + h) * 64) * SEQL;
  const int nt = 4 * qb + 4;

  uint4 xk0, xv0, xp, yk0, yv0, yp;
  xp = make_uint4(0, 0, 0, 0); yp = xp;
  const int prow = tid >> 3, pch = tid & 7;
  const bf16_t* kgp = Kg + (size_t)(tokb + prow) * 512 + h * 64 + pch * 8;
  const bf16_t* vgp = VTg + (size_t)prow * SEQL + pch * 8;
  const bf16_t* pgp = p.KPE() + (size_t)(tokb + ((tid & 255) >> 2)) * 32 + (tid & 3) * 8;
#define ATT_GLOAD(P, kt_)                                                          \
  {                                                                                \
    const int kt__ = (kt_);                                                        \
    P##k0 = *(const uint4*)(kgp + (size_t)(kt__ * 64) * 512);                      \
    P##v0 = *(const uint4*)(vgp + kt__ * 64);                                      \
    if (MLA && tid < 256) P##p = *(const uint4*)(pgp + (size_t)(kt__ * 64) * 32);  \
  }
#define ATT_SWRITE(P, buf_)                                                        \
  {                                                                                \
    bf16_t* dK = sK + (buf_) * 64 * KSTR;                                          \
    bf16_t* dV = sV + (buf_) * 64 * VSTR;                                          \
    *(uint4*)(dK + prow * KSTR + pch * 8) = P##k0;                                 \
    uint2* dv0 = (uint2*)(dV + prow * VSTR + pch * 8);                             \
    dv0[0] = make_uint2(P##v0.x, P##v0.y); dv0[1] = make_uint2(P##v0.z, P##v0.w);  \
    if (MLA && tid < 256) *(uint4*)(dK + (tid >> 2) * KSTR + 64 + (tid & 3) * 8) = P##p; \
  }
#define ATT_KT(i_) (MLA ? (i_) : (nt - 1 - (i_)))

  ATT_GLOAD(x, ATT_KT(0));
  ATT_GLOAD(y, ATT_KT(1));
  ATT_SWRITE(x, 0);
#pragma unroll
  for (int i = 0; i < 8; ++i) zbuf[i * 512 + tid] = zpre[i];
  __syncthreads();
  bool alive = true;
  for (int it0 = 0; alive; it0 += 2) {
#pragma unroll
   for (int half = 0; half < 2; ++half) {
    const int it = it0 + half;
    const int kt = ATT_KT(it);
    const int cur = half;
    const bool more = (it + 1 < nt);
    if (it + 2 < nt) { if (half == 0) ATT_GLOAD(x, ATT_KT(it + 2)) else ATT_GLOAD(y, ATT_KT(it + 2)) }
    const bf16_t* cK = sK + cur * 64 * KSTR;
    const bf16_t* cV = sV + cur * 64 * VSTR;
    if (MLA) {
      if (kt * 64 <= qw + 31) {
        f32x16 s0, s1;
        {
          const float sinit = -mrun;
#pragma unroll
          for (int i = 0; i < 16; ++i) { s0[i] = sinit; s1[i] = sinit; }
        }
#pragma unroll
        for (int ks = 0; ks < NKS; ++ks) {
          const bf16x8 k0 = *(const bf16x8*)(cK + r * KSTR + ks * 16 + hh * 8);
          const bf16x8 k1 = *(const bf16x8*)(cK + (32 + r) * KSTR + ks * 16 + hh * 8);
          s0 = MFMA(k0, qf[ks], s0);
          s1 = MFMA(k1, qf[ks], s1);
        }

        if (kt * 64 + 63 > qw) {
          const int lim = qw + r - kt * 64;
#pragma unroll
          for (int i = 0; i < 16; ++i) { if (crow(i, hh) > lim) s0[i] = -1e30f; if (32 + crow(i, hh) > lim) s1[i] = -1e30f; }
        }
        float m0 = fmaxf(fmaxf(s0[0], s0[1]), s0[2]), m1 = fmaxf(fmaxf(s1[0], s1[1]), s1[2]);
#pragma unroll
        for (int i = 3; i < 15; i += 2) { m0 = fmaxf(fmaxf(m0, s0[i]), s0[i + 1]); m1 = fmaxf(fmaxf(m1, s1[i]), s1[i + 1]); }
        float mloc = fmaxf(fmaxf(m0, s0[15]), fmaxf(m1, s1[15]));
        mloc = half_max(mloc);
        const bool first = (it == 0);
        const float delta = first ? mloc : fmaxf(mloc, 0.f);
        if (first || __builtin_amdgcn_ballot_w64(delta > 0.f) != 0ull) {
          const float alpha = first ? 0.f : __builtin_amdgcn_exp2f(-delta);
          mrun += delta;
          lrun *= alpha;
#pragma unroll
          for (int i = 0; i < 16; ++i) { oacc[0][i] *= alpha; oacc[1][i] *= alpha; s0[i] -= delta; s1[i] -= delta; }
        }
        float ps0 = 0.f, ps1 = 0.f;
#pragma unroll
        for (int i = 0; i < 16; ++i) { s0[i] = __builtin_amdgcn_exp2f(s0[i]); s1[i] = __builtin_amdgcn_exp2f(s1[i]); ps0 += s0[i]; ps1 += s1[i]; }
        lrun += ps0 + ps1;
        bf16x8 pf4[4];
        pf4[0] = pack8(s0[0], s0[1], s0[2], s0[3], s0[4], s0[5], s0[6], s0[7]);
        pf4[1] = pack8(s0[8], s0[9], s0[10], s0[11], s0[12], s0[13], s0[14], s0[15]);
        pf4[2] = pack8(s1[0], s1[1], s1[2], s1[3], s1[4], s1[5], s1[6], s1[7]);
        pf4[3] = pack8(s1[8], s1[9], s1[10], s1[11], s1[12], s1[13], s1[14], s1[15]);

#pragma unroll
        for (int st = 0; st < 4; ++st)
#pragma unroll
          for (int dt = 0; dt < 2; ++dt) {
            const bf16_t* vp = cV + (dt * 32 + r) * VSTR + st * 16 + 4 * hh;
            const s16x4 lo = *(const s16x4*)vp;
            const s16x4 hi = *(const s16x4*)(vp + 8);
            const bf16x8 vf = __builtin_shufflevector(lo, hi, 0, 1, 2, 3, 4, 5, 6, 7);
            oacc[dt] = MFMA(vf, pf4[st], oacc[dt]);
          }

      }
    } else
#pragma unroll
    for (int si = 0; si < 2; ++si) {
      const int sub = MLA ? si : (1 - si);
      const int kb = kt * 64 + sub * 32;
      if (kb > qw) continue;
      const bool diag = (kb == qw);
      f32x16 s;
      {
        const float sinit = MLA ? -mrun : 0.f;
#pragma unroll
        for (int i = 0; i < 16; ++i) s[i] = sinit;
      }
      __builtin_amdgcn_s_setprio(1);
#pragma unroll
      for (int ks = 0; ks < NKS; ++ks) {
        const bf16x8 kf = *(const bf16x8*)(cK + (sub * 32 + r) * KSTR + ks * 16 + hh * 8);
        s = MFMA(kf, qf[ks], s);
      }
      __builtin_amdgcn_s_setprio(0);
      bf16x8 pf[2];
      if (!MLA) {
        float sp[16];
        float tsum = 0.f;
#pragma unroll
        for (int i = 0; i < 16; ++i) {
          const float z = s[i];
          float v = __builtin_amdgcn_logf(1.f + __builtin_amdgcn_exp2f(fminf(z, 126.f)));
          if (diag && !(crow(i, hh) < r)) v = 0.f;
          sp[i] = v;
          tsum += v;
        }
        f32x16 cacc;
#pragma unroll
        for (int i = 0; i < 16; ++i) cacc[i] = carry;
        cacc = MFMA(tf[0], pack8(sp[0], sp[1], sp[2], sp[3], sp[4], sp[5], sp[6], sp[7]), cacc);
        cacc = MFMA(tf[1], pack8(sp[8], sp[9], sp[10], sp[11], sp[12], sp[13], sp[14], sp[15]), cacc);
        float pr[16];
#pragma unroll
        for (int i = 0; i < 16; ++i) {
          float v = __builtin_amdgcn_exp2f(s[i] - cacc[i]);
          if (diag && !(crow(i, hh) < r)) v = 0.f;
          pr[i] = v;
        }
        carry += half_sum(tsum);
        pf[0] = pack8(pr[0], pr[1], pr[2], pr[3], pr[4], pr[5], pr[6], pr[7]);
        pf[1] = pack8(pr[8], pr[9], pr[10], pr[11], pr[12], pr[13], pr[14], pr[15]);
      } else {
        if (diag) {
#pragma unroll
          for (int i = 0; i < 16; ++i) if (!(crow(i, hh) <= r)) s[i] = -1e30f;
        }
        float mloc = fmaxf(fmaxf(s[0], s[1]), s[2]);
#pragma unroll
        for (int i = 3; i < 15; i += 2) mloc = fmaxf(fmaxf(mloc, s[i]), s[i + 1]);
        mloc = fmaxf(mloc, s[15]);
        mloc = half_max(mloc);
        const bool first = (it == 0) && (si == 0);
        const float delta = first ? mloc : fmaxf(mloc, 0.f);
        if (first || __builtin_amdgcn_ballot_w64(delta > 0.f) != 0ull) {
          const float alpha = first ? 0.f : __builtin_amdgcn_exp2f(-delta);
          mrun += delta;
          lrun *= alpha;
#pragma unroll
          for (int i = 0; i < 16; ++i) { oacc[0][i] *= alpha; oacc[1][i] *= alpha; s[i] -= delta; }
        }
        float pr[16];
        float ps0 = 0.f, ps1 = 0.f;
#pragma unroll
        for (int i = 0; i < 16; i += 2) { pr[i] = __builtin_amdgcn_exp2f(s[i]); pr[i + 1] = __builtin_amdgcn_exp2f(s[i + 1]); ps0 += pr[i]; ps1 += pr[i + 1]; }
        lrun += ps0 + ps1;
        pf[0] = pack8(pr[0], pr[1], pr[2], pr[3], pr[4], pr[5], pr[6], pr[7]);
        pf[1] = pack8(pr[8], pr[9], pr[10], pr[11], pr[12], pr[13], pr[14], pr[15]);
      }
      __builtin_amdgcn_s_setprio(1);
#pragma unroll
      for (int dt = 0; dt < 2; ++dt)
#pragma unroll
        for (int st = 0; st < 2; ++st) {
          const bf16_t* vp = cV + (dt * 32 + r) * VSTR + sub * 32 + st * 16 + 4 * hh;
          const s16x4 lo = *(const s16x4*)vp;
          const s16x4 hi = *(const s16x4*)(vp + 8);
          const bf16x8 vf = __builtin_shufflevector(lo, hi, 0, 1, 2, 3, 4, 5, 6, 7);
          oacc[dt] = MFMA(vf, pf[st], oacc[dt]);
        }
      __builtin_amdgcn_s_setprio(0);
    }
    if (more) { if (half == 0) ATT_SWRITE(y, 1) else ATT_SWRITE(x, 0) }
    if (!MLA) {
      int* flg = (int*)(smem + SMEM_BYTES - 128) + (it & 1) * 8;
      const bool wok = (__builtin_amdgcn_ballot_w64(carry >= 160.f) == ~0ull);
      if (lane == 0) flg[w] = wok ? 1 : 0;
      __syncthreads();
      alive = more && ((flg[0] & flg[1] & flg[2] & flg[3] & flg[4] & flg[5] & flg[6] & flg[7]) == 0);
    } else {
      __syncthreads();
      alive = more;
    }
    if (!alive) break;
   }
  }
#undef ATT_GLOAD
#undef ATT_SWRITE
#undef ATT_KT
  if (threadIdx.x == 0 && pre_ctr) pre_raw = atomicAdd(pre_ctr, 1);
  float inv = 1.f;
  if (MLA) { const float lt = half_sum(lrun); inv = 1.f / lt; }
  const int tok = tok0 + w * 32 + r;
  bf16_t* og = (MLA ? p.OBg() : p.OAg()) + (size_t)tok * 512 + h * 64;
#pragma unroll
  for (int dt = 0; dt < 2; ++dt)
#pragma unroll
    for (int g = 0; g < 4; ++g) {
      const int d = dt * 32 + 8 * g + 4 * hh;
      const u32x2 zz = zbuf[(dt * 4 + g) * 512 + tid];
      const float z0 = __uint_as_float(zz[0] << 16), z1 = __uint_as_float(zz[0] & 0xffff0000u);
      const float z2 = __uint_as_float(zz[1] << 16), z3 = __uint_as_float(zz[1] & 0xffff0000u);
      u32x2 o;
      o[0] = pk2(oacc[dt][4 * g] * inv * z0, oacc[dt][4 * g + 1] * inv * z1);
      o[1] = pk2(oacc[dt][4 * g + 2] * inv * z2, oacc[dt][4 * g + 3] * inv * z3);
      *(u32x2*)(og + d) = o;
    }
}

DI void phase_attn(const Params& p, char* smem, int cbase, int only) {
  int* s_item = (int*)(smem + SMEM_BYTES - 16);
  const int q0 = blockIdx.x & 7;
  int qi = 0;
  int pre_raw = 0;
  bool has_pre = false;
  for (;;) {
    if (threadIdx.x < 64) {
      int item = -1;
      while (qi < 8) {
        const int q = (q0 + qi) & 7;
        int idx = 0;
        if (has_pre) { idx = pre_raw; has_pre = false; }
        else if (threadIdx.x == 0) idx = atomicAdd(p.counter() + cbase + q, 1);
        idx = __builtin_amdgcn_readfirstlane(idx);
        if (idx < 128) { item = q * 256 + idx; break; }
        const int lq = (q0 + (threadIdx.x & 7)) & 7;
        const int head = __hip_atomic_load(p.counter() + cbase + lq, __ATOMIC_RELAXED, __HIP_MEMORY_SCOPE_AGENT);
        const unsigned long long avail = __builtin_amdgcn_ballot_w64((threadIdx.x < 8) && (head < 128) && ((int)(threadIdx.x & 7) > qi));
        if (avail == 0ull) { qi = 8; break; }
        qi = __builtin_ctzll(avail);
      }
      if (threadIdx.x == 0) *s_item = item;
    }
    __syncthreads();
    const int item = *s_item;
    __syncthreads();
    if (item < 0) break;
    const int q = item >> 8, idx = item & 255;
    const int i2 = idx & 63;
    const int bh = q + 8 * (i2 & 3);
    const int qb = 15 - (i2 >> 2);
    int* pre_ctr = p.counter() + cbase + ((q0 + qi) & 7);
    if (idx < 64) { if (only != 2) { attn_item<true>(p, bh >> 3, bh & 7, qb, smem, pre_ctr, pre_raw); has_pre = true; } }
    else { if (only != 1) { attn_item<false>(p, bh >> 3, bh & 7, qb, smem, pre_ctr, pre_raw); has_pre = true; } }
  }
}

DI void g3_pre_a(const Params& p, const int m0, const int n0, u32x4 (&g)[4]) {
  const int txo = opaque_tid();
#pragma unroll
  for (int i = 0; i < 4; ++i) {
    const int c = txo + 512 * i, row = c >> 4, cc = (c & 15) * 8;
    g[i] = *(const u32x4*)(p.GA() + (size_t)(m0 + row) * 1024 + n0 + cc);
  }
}
DI void g3_epi_a(const Params& p, const float* sC, const int m0, const int n0, const u32x4 (&gq)[4]) {
  const int txo = opaque_tid();
#pragma unroll
  for (int i = 0; i < 4; ++i) {
    const int c = txo + 512 * i, row = c >> 4, cc = (c & 15) * 8;
    const u32x4 g = gq[i];
    const float4 a = *(const float4*)(sC + row * CSTR + cc), b = *(const float4*)(sC + row * CSTR + cc + 4);
    u32x4 y;
    y[0] = pk2(a.x * __uint_as_float(g[0] << 16), a.y * __uint_as_float(g[0] & 0xffff0000u));
    y[1] = pk2(a.z * __uint_as_float(g[1] << 16), a.w * __uint_as_float(g[1] & 0xffff0000u));
    y[2] = pk2(b.x * __uint_as_float(g[2] << 16), b.y * __uint_as_float(g[2] & 0xffff0000u));
    y[3] = pk2(b.z * __uint_as_float(g[3] << 16), b.w * __uint_as_float(g[3] & 0xffff0000u));
    *(u32x4*)(p.MERGED() + (size_t)(m0 + row) * 1024 + n0 + cc) = y;
  }
}
DI void g3_pre_b(const Params& p, const int m0, const int n0, u32x4 (&g)[4], u32x4 (&y)[4]) {
  const int txo2 = opaque_tid();
#pragma unroll
  for (int i = 0; i < 4; ++i) {
    const int c = txo2 + 512 * i, row = c >> 4, cc = (c & 15) * 8;
    g[i] = *(const u32x4*)(p.GB() + (size_t)(m0 + row) * 1024 + n0 + cc);
    y[i] = *(const u32x4*)(p.MERGED() + (size_t)(m0 + row) * 1024 + n0 + cc);
  }
}
DI void g3_epi_b(const Params& p, const float* sC, const int m0, const int n0, const u32x4 (&gq)[4], const u32x4 (&yq)[4]) {
  const int txo2 = opaque_tid();
#pragma unroll
  for (int i = 0; i < 4; ++i) {
    const int c = txo2 + 512 * i, row = c >> 4, cc = (c & 15) * 8;
    const u32x4 g = gq[i];
    const u32x4 yv = yq[i];
    const float4 a = *(const float4*)(sC + row * CSTR + cc), b = *(const float4*)(sC + row * CSTR + cc + 4);
    u32x4 o;
    o[0] = pk2(__uint_as_float(yv[0] << 16) + a.x * __uint_as_float(g[0] << 16), __uint_as_float(yv[0] & 0xffff0000u) + a.y * __uint_as_float(g[0] & 0xffff0000u));
    o[1] = pk2(__uint_as_float(yv[1] << 16) + a.z * __uint_as_float(g[1] << 16), __uint_as_float(yv[1] & 0xffff0000u) + a.w * __uint_as_float(g[1] & 0xffff0000u));
    o[2] = pk2(__uint_as_float(yv[2] << 16) + b.x * __uint_as_float(g[2] << 16), __uint_as_float(yv[2] & 0xffff0000u) + b.y * __uint_as_float(g[2] & 0xffff0000u));
    o[3] = pk2(__uint_as_float(yv[3] << 16) + b.z * __uint_as_float(g[3] << 16), __uint_as_float(yv[3] & 0xffff0000u) + b.w * __uint_as_float(g[3] & 0xffff0000u));
    *(u32x4*)(p.MERGED() + (size_t)(m0 + row) * 1024 + n0 + cc) = o;
  }
}
DI void phase_g3(const Params& p, char* smem) {
  bf16_t* shm = (bf16_t*)smem;
  float* sC = (float*)smem;
  const int xq = blockIdx.x & 7, lb = blockIdx.x >> 3, nlb = gridDim.x >> 3;
  const bool xmap = (gridDim.x & 7) == 0;
  for (int t = xmap ? lb : (int)blockIdx.x; t < (xmap ? 32 : 256); t += (xmap ? nlb : (int)gridDim.x)) {
    const int rt = xmap ? (8 * xq + (t & 7)) : (t >> 2), ct = xmap ? (t >> 3) : (t & 3);
    const int m0 = rt * 256, n0 = ct * 256;
    f32x4 acc[2][2][4][2];
    zero_acc8(acc);
    gemm8_tile(p.OAg() + (size_t)m0 * 512, p.WaT() + (size_t)n0 * 512, 512, shm, acc);
#pragma unroll
    for (int ai = 0; ai < 2; ++ai)
#pragma unroll
      for (int bj = 0; bj < 2; ++bj) {
        u32x4 gq[4];
        g3_pre_a(p, m0 + ai * 128, n0 + bj * 128, gq);
        __syncthreads();
        accq_to_lds(acc[ai][bj], sC);
        __syncthreads();
        g3_epi_a(p, sC, m0 + ai * 128, n0 + bj * 128, gq);
      }
    __syncthreads();
    zero_acc8(acc);
    gemm8_tile(p.OBg() + (size_t)m0 * 512, p.WbT() + (size_t)n0 * 512, 512, shm, acc);
#pragma unroll
    for (int ai = 0; ai < 2; ++ai)
#pragma unroll
      for (int bj = 0; bj < 2; ++bj) {
        u32x4 gq[4], yq[4];
        g3_pre_b(p, m0 + ai * 128, n0 + bj * 128, gq, yq);
        __syncthreads();
        accq_to_lds(acc[ai][bj], sC);
        __syncthreads();
        g3_epi_b(p, sC, m0 + ai * 128, n0 + bj * 128, gq, yq);
      }
    __syncthreads();
  }
}

DI void g4_pre(const Params& p, const int m0, const int n0, float4 (&xq)[8]) {
  const int txo = opaque_tid();
#pragma unroll
  for (int i = 0; i < 4; ++i) {
    const int c = txo + 512 * i, row = c >> 4, cc = (c & 15) * 8;
    const size_t go = (size_t)(m0 + row) * 1024 + n0 + cc;
    xq[2 * i] = ldnt4(p.x + go); xq[2 * i + 1] = ldnt4(p.x + go + 4);
  }
}
DI void g4_epi(const Params& p, const float* sC, const float* gt, const int m0, const int n0, const float4 (&xq)[8]) {
  const int txo = opaque_tid();
#pragma unroll
  for (int i = 0; i < 4; ++i) {
    const int c = txo + 512 * i, row = c >> 4, cc = (c & 15) * 8;
    const size_t go = (size_t)(m0 + row) * 1024 + n0 + cc;
    const float4 x0 = xq[2 * i], x1 = xq[2 * i + 1];
    const float4 a = *(const float4*)(sC + row * CSTR + cc), b = *(const float4*)(sC + row * CSTR + cc + 4);
    const float4 g0 = *(const float4*)(gt + cc), g1 = *(const float4*)(gt + cc + 4);
    float4 o0, o1;
    o0.x = x0.x + g0.x * a.x; o0.y = x0.y + g0.y * a.y; o0.z = x0.z + g0.z * a.z; o0.w = x0.w + g0.w * a.w;
    o1.x = x1.x + g1.x * b.x; o1.y = x1.y + g1.y * b.y; o1.z = x1.z + g1.z * b.z; o1.w = x1.w + g1.w * b.w;
    *(float4*)(p.out + go) = o0;
    *(float4*)(p.out + go + 4) = o1;
  }
}
DI void phase_g4(const Params& p, char* smem) {
  bf16_t* shm = (bf16_t*)smem;
  float* sC = (float*)smem;
  float* rs = (float*)(smem + RS_OFF);
  const int xq = blockIdx.x & 7, lb = blockIdx.x >> 3, nlb = gridDim.x >> 3;
  const bool xmap = (gridDim.x & 7) == 0;
  for (int t = xmap ? lb : (int)blockIdx.x; t < (xmap ? 32 : 256); t += (xmap ? nlb : (int)gridDim.x)) {
    const int rt = xmap ? (8 * xq + (t & 7)) : (t >> 2), ct = xmap ? (t >> 3) : (t & 3);
    const int m0 = rt * 256, n0 = ct * 256;
    f32x4 acc[2][2][4][2];
    zero_acc8(acc);
    if (threadIdx.x < 256) rs[threadIdx.x] = mod_get(p.MOD(), m0 >> 12, 2048 + n0 + threadIdx.x);
    gemm8_tile(p.MERGED() + (size_t)m0 * 1024, p.WoT() + (size_t)n0 * 1024, 1024, shm, acc);
#pragma unroll
    for (int ai = 0; ai < 2; ++ai)
#pragma unroll
      for (int bj = 0; bj < 2; ++bj) {
        float4 xq[8];
        g4_pre(p, m0 + ai * 128, n0 + bj * 128, xq);
        __syncthreads();
        accq_to_lds(acc[ai][bj], sC);
        __syncthreads();
        g4_epi(p, sC, rs + bj * 128, m0 + ai * 128, n0 + bj * 128, xq);
      }
    __syncthreads();
  }
}

DI void phase_final(const Params& p) {
  const int lane = threadIdx.x & 63, w = threadIdx.x >> 6;
  const int gw = blockIdx.x * 8 + w, nw = gridDim.x * 8;
  for (int row = gw; row < NTOK; row += nw) {
    float* xr = p.out + (size_t)row * DM;
    float4 v[4];
    float ss = 0.f;
#pragma unroll
    for (int i = 0; i < 4; ++i) {
      v[i] = *(const float4*)(xr + 4 * (lane + 64 * i));
      ss += v[i].x * v[i].x + v[i].y * v[i].y + v[i].z * v[i].z + v[i].w * v[i].w;
    }
#pragma unroll
    for (int o = 32; o >= 1; o >>= 1) ss += __shfl_xor(ss, o);
    const float rn = __builtin_amdgcn_rsqf(ss * (1.f / DM) + EPSN);
#pragma unroll
    for (int i = 0; i < 4; ++i) {
      const int e = 4 * (lane + 64 * i);
      const float4 g = *(const float4*)(p.fgain + e);
      float4 o;
      o.x = v[i].x * rn * g.x; o.y = v[i].y * rn * g.y; o.z = v[i].z * rn * g.z; o.w = v[i].w * rn * g.w;
      __builtin_nontemporal_store(o.x, xr + e); __builtin_nontemporal_store(o.y, xr + e + 1); __builtin_nontemporal_store(o.z, xr + e + 2); __builtin_nontemporal_store(o.w, xr + e + 3);
    }
  }
}

template <int PH>
__global__ void __launch_bounds__(NTHREADS, 2) mega_kernel(Params p) {
  __shared__ __attribute__((aligned(16))) char smem[SMEM_BYTES];
  if (PH < 0) {
    if (p.ws == nullptr) cg::this_grid().sync();
    volatile LAS unsigned* xst = (volatile LAS unsigned*)(smem + SMEM_BYTES - 32);
    if (threadIdx.x == 0) { xst[0] = 0u; xst[1] = 0u; }
    __syncthreads();
    (void)xcd_barrier_post(p.bar(), xst);
    phase_prep(p, smem); xcd_barrier(p.bar(), (volatile LAS unsigned*)(smem + SMEM_BYTES - 32));
#if PROBE_DUP == 4
    phase_prep(p, smem); xcd_barrier(p.bar(), (volatile LAS unsigned*)(smem + SMEM_BYTES - 32));
#endif
    phase_h(p, smem); xcd_barrier(p.bar(), (volatile LAS unsigned*)(smem + SMEM_BYTES - 32));
#if PROBE_DUP == 5
    phase_h(p, smem); xcd_barrier(p.bar(), (volatile LAS unsigned*)(smem + SMEM_BYTES - 32));
#endif
    phase_g1(p, smem); xcd_barrier(p.bar(), (volatile LAS unsigned*)(smem + SMEM_BYTES - 32));
#if PROBE_DUP == 1
    phase_g1(p, smem, false); xcd_barrier(p.bar(), (volatile LAS unsigned*)(smem + SMEM_BYTES - 32));
#endif
    phase_g2(p, smem); xcd_barrier(p.bar(), (volatile LAS unsigned*)(smem + SMEM_BYTES - 32));
#if PROBE_DUP == 8
    phase_g2(p, smem); xcd_barrier(p.bar(), (volatile LAS unsigned*)(smem + SMEM_BYTES - 32));
#endif
    phase_attn(p, smem, 0, 0); xcd_barrier(p.bar(), (volatile LAS unsigned*)(smem + SMEM_BYTES - 32));
#if PROBE_DUP == 2
    phase_attn(p, smem, 8, 1); xcd_barrier(p.bar(), (volatile LAS unsigned*)(smem + SMEM_BYTES - 32));
#endif
#if PROBE_DUP == 3
    phase_attn(p, smem, 8, 2); xcd_barrier(p.bar(), (volatile LAS unsigned*)(smem + SMEM_BYTES - 32));
#endif
    phase_g3(p, smem); xcd_barrier(p.bar(), (volatile LAS unsigned*)(smem + SMEM_BYTES - 32));
#if PROBE_DUP == 6
    phase_g3(p, smem); xcd_barrier(p.bar(), (volatile LAS unsigned*)(smem + SMEM_BYTES - 32));
#endif
    phase_g4(p, smem); xcd_barrier(p.bar(), (volatile LAS unsigned*)(smem + SMEM_BYTES - 32));
#if PROBE_DUP == 7
    phase_g4(p, smem); xcd_barrier(p.bar(), (volatile LAS unsigned*)(smem + SMEM_BYTES - 32));
#endif
    phase_final(p);
  } else {
    if (PH == 0) phase_prep(p, smem);
    if (PH == 1) phase_h(p, smem);
    if (PH == 2) phase_g1(p, smem);
    if (PH == 3) phase_g2(p, smem);
    if (PH == 4) phase_attn(p, smem, 0, 0);
    if (PH == 5) phase_g3(p, smem);
    if (PH == 6) phase_g4(p, smem);
    if (PH == 7) phase_final(p);
  }
}

#ifndef PROBE_DUP
#define PROBE_DUP 0
#endif
#ifndef MK_SPLIT
#define MK_SPLIT 0
#endif

extern "C" void kernel_launch(void* const* d_in, const int* in_sizes, int n_in, void* d_out, int out_size, void* d_ws, size_t ws_size, hipStream_t stream) {
  Params p{};
  p.x = (const float*)d_in[0]; p.c = (const float*)d_in[1]; p.pos = (const int*)d_in[2];
  p.w_ada = (const float*)d_in[3]; p.b_ada = (const float*)d_in[4]; p.norm_gain = (const float*)d_in[5];
  p.w_in = (const float*)d_in[6]; p.q_gain = (const float*)d_in[7]; p.w_uq = (const float*)d_in[8];
  p.kv_gain = (const float*)d_in[9]; p.w_ukv = (const float*)d_in[10]; p.w_a = (const float*)d_in[11];
  p.w_b = (const float*)d_in[12]; p.w_out = (const float*)d_in[13]; p.fgain = (const float*)d_in[14];
  p.out = (float*)d_out;
  p.ws = (char*)d_ws;
  if (WS_NEED > ws_size) { fprintf(stderr, "workspace too small: need %zu have %zu\n", (size_t)WS_NEED, ws_size); return; }

  static int grid_blocks = 0;
  if (!grid_blocks) {
    int dev = 0, cus = 0, per_cu = 0;
    hipGetDevice(&dev);
    hipDeviceGetAttribute(&cus, hipDeviceAttributeMultiprocessorCount, dev);
    hipOccupancyMaxActiveBlocksPerMultiprocessor(&per_cu, mega_kernel<-1>, NTHREADS, 0);
    per_cu = 1;
    grid_blocks = cus * per_cu;
  }
#if MK_SPLIT
  mega_kernel<0><<<grid_blocks, NTHREADS, 0, stream>>>(p);
  mega_kernel<1><<<grid_blocks, NTHREADS, 0, stream>>>(p);
  mega_kernel<2><<<grid_blocks, NTHREADS, 0, stream>>>(p);
  mega_kernel<3><<<grid_blocks, NTHREADS, 0, stream>>>(p);
  mega_kernel<4><<<grid_blocks, NTHREADS, 0, stream>>>(p);
  mega_kernel<5><<<grid_blocks, NTHREADS, 0, stream>>>(p);
  mega_kernel<6><<<grid_blocks, NTHREADS, 0, stream>>>(p);
  mega_kernel<7><<<grid_blocks, NTHREADS, 0, stream>>>(p);
#else
  hipMemsetAsync((char*)d_ws + OFF_bar, 0, XCD_BAR_WORDS * 4, stream);
  void* args[] = {&p};
  hipError_t e = hipLaunchCooperativeKernel((void*)mega_kernel<-1>, dim3(grid_blocks), dim3(NTHREADS), args, 0, stream);
  if (e != hipSuccess) fprintf(stderr, "cooperative launch failed: %s (grid %d)\n", hipGetErrorString(e), grid_blocks);
#endif
}
```

```cpp
#include <hip/hip_runtime.h>
#include <hip/hip_cooperative_groups.h>
#include <stdint.h>
#include <stdio.h>
namespace cg = cooperative_groups;
#ifndef PROBE_DUP
#define PROBE_DUP 0
#endif

#define DI __device__ __forceinline__
typedef unsigned short bf16_t;
typedef __attribute__((ext_vector_type(8))) short bf16x8;
typedef __attribute__((ext_vector_type(4))) short s16x4;
typedef __attribute__((ext_vector_type(16))) float f32x16;
typedef __attribute__((ext_vector_type(2))) float f32x2;
typedef __attribute__((ext_vector_type(2))) __bf16 bf16x2v;
typedef __attribute__((ext_vector_type(4))) unsigned u32x4;
typedef __attribute__((ext_vector_type(2))) unsigned u32x2;
typedef __attribute__((ext_vector_type(4))) float f32x4;
#define MFMA(a, b, c) __builtin_amdgcn_mfma_f32_32x32x16_bf16((a), (b), (c), 0, 0, 0)

constexpr int NTOK = 16384, SEQL = 4096, DM = 1024;
constexpr int INW = 5280, INWP = 5376;
constexpr int NTHREADS = 512;
constexpr float LOG2E = 1.4426950408889634f;
constexpr float QS_SCALE = 0.125f * 1.4426950408889634f;
constexpr float QM_SCALE = 1.4426950408889634f / 9.797958971132712f;
constexpr float EPSN = 1e-6f;

constexpr int XCD_BAR_WORDS_C = 3456;
constexpr size_t al256(size_t v) { return (v + 255) & ~(size_t)255; }
constexpr size_t OFF_counter = 0;
constexpr size_t OFF_bar = OFF_counter + al256(256);
constexpr size_t OFF_MOD = OFF_bar + al256(XCD_BAR_WORDS_C * 4);
constexpr size_t OFF_ROPE = OFF_MOD + al256(4 * 3072 * 4 * 4);
constexpr size_t OFF_SSQ = OFF_ROPE + al256((size_t)NTOK * 32 * 4);
constexpr size_t OFF_Hb = OFF_SSQ + al256((size_t)2 * NTOK * 4);
constexpr size_t OFF_Qmla = OFF_Hb + al256((size_t)NTOK * 1024 * 2);
constexpr size_t OFF_WuqT = OFF_Qmla + al256((size_t)NTOK * 768 * 2);
constexpr size_t OFF_WukvT = OFF_WuqT + al256((size_t)768 * 384 * 2);
constexpr size_t OFF_WaT = OFF_WukvT + al256((size_t)1024 * 256 * 2);
constexpr size_t OFF_WbT = OFF_WaT + al256((size_t)1024 * 512 * 2);
constexpr size_t OFF_WoT = OFF_WbT + al256((size_t)1024 * 512 * 2);
constexpr size_t OFF_Qsb = OFF_WoT + al256((size_t)1024 * 1024 * 2);
constexpr size_t OFF_Ksb = OFF_Qsb + al256((size_t)NTOK * 512 * 2);
constexpr size_t OFF_VTsb = OFF_Ksb + al256((size_t)NTOK * 512 * 2);
constexpr size_t OFF_Zsb = OFF_VTsb + al256((size_t)NTOK * 512 * 2);
constexpr size_t OFF_OAg = OFF_Zsb + al256((size_t)NTOK * 512 * 2);
constexpr size_t OFF_OBg = OFF_OAg + al256((size_t)NTOK * 512 * 2);
constexpr size_t OFF_Zmla = OFF_OBg + al256((size_t)NTOK * 512 * 2);
constexpr size_t OFF_KPE = OFF_Zmla + al256((size_t)NTOK * 512 * 2);
constexpr size_t OFF_Knope = OFF_KPE + al256((size_t)NTOK * 32 * 2);
constexpr size_t OFF_VTmla = OFF_Knope + al256((size_t)NTOK * 512 * 2);
constexpr size_t OFF_WinT = OFF_VTmla + al256((size_t)NTOK * 512 * 2);
constexpr size_t WS_NEED = OFF_WinT + al256((size_t)INWP * 1024 * 2);
struct Params {
  const float *x, *c; const int* pos;
  const float *w_ada, *b_ada, *norm_gain, *w_in, *q_gain, *w_uq, *kv_gain, *w_ukv, *w_a, *w_b, *w_out, *fgain;
  float* out;
  char* ws;
  DI int* counter() const { return (int*)(ws + OFF_counter); }
  DI unsigned* bar() const { return (unsigned*)(ws + OFF_bar); }
  DI float* MOD() const { return (float*)(ws + OFF_MOD); }
  DI float* ROPE() const { return (float*)(ws + OFF_ROPE); }
  DI float* SSQ() const { return (float*)(ws + OFF_SSQ); }
  DI bf16_t* Hb() const { return (bf16_t*)(ws + OFF_Hb); }
  DI bf16_t* Qmla() const { return (bf16_t*)(ws + OFF_Qmla); }
  DI bf16_t* WuqT() const { return (bf16_t*)(ws + OFF_WuqT); }
  DI bf16_t* WukvT() const { return (bf16_t*)(ws + OFF_WukvT); }
  DI bf16_t* WaT() const { return (bf16_t*)(ws + OFF_WaT); }
  DI bf16_t* WbT() const { return (bf16_t*)(ws + OFF_WbT); }
  DI bf16_t* WoT() const { return (bf16_t*)(ws + OFF_WoT); }
  DI bf16_t* Qsb() const { return (bf16_t*)(ws + OFF_Qsb); }
  DI bf16_t* Ksb() const { return (bf16_t*)(ws + OFF_Ksb); }
  DI bf16_t* VTsb() const { return (bf16_t*)(ws + OFF_VTsb); }
  DI bf16_t* Zsb() const { return (bf16_t*)(ws + OFF_Zsb); }
  DI bf16_t* OAg() const { return (bf16_t*)(ws + OFF_OAg); }
  DI bf16_t* OBg() const { return (bf16_t*)(ws + OFF_OBg); }
  DI bf16_t* Zmla() const { return (bf16_t*)(ws + OFF_Zmla); }
  DI bf16_t* KPE() const { return (bf16_t*)(ws + OFF_KPE); }
  DI bf16_t* Knope() const { return (bf16_t*)(ws + OFF_Knope); }
  DI bf16_t* VTmla() const { return (bf16_t*)(ws + OFF_VTmla); }
  DI bf16_t* MERGED() const { return Hb(); }
  DI bf16_t* WinT() const { return (bf16_t*)(ws + OFF_WinT); }
  DI bf16_t* CQ() const { return OAg(); }
  DI bf16_t* CKV() const { return OBg(); }
  DI bf16_t* GA() const { return (bf16_t*)out; }
  DI bf16_t* GB() const { return (bf16_t*)out + (size_t)NTOK * 1024; }
};


__device__ const float c_invfreq[16] = {
  1.0f, 0.5623413251903491f, 0.31622776601683794f, 0.1778279410038923f, 0.1f, 0.05623413251903491f, 0.03162277660168379f,
  0.01778279410038923f, 0.01f, 0.005623413251903491f, 0.0031622776601683794f, 0.001778279410038923f, 0.001f,
  0.0005623413251903491f, 0.00031622776601683794f, 0.0001778279410038923f};

DI unsigned pk2(float a, float b) { f32x2 v = {a, b}; bf16x2v r = __builtin_convertvector(v, bf16x2v); return __builtin_bit_cast(unsigned, r); }
DI bf16_t tobf(float a) { return (bf16_t)(pk2(a, 0.f) & 0xffffu); }
DI float bf2f(unsigned short u) { return __uint_as_float(((unsigned)u) << 16); }
DI bf16x8 pack8(float a0, float a1, float a2, float a3, float a4, float a5, float a6, float a7) {
  u32x4 p; p[0] = pk2(a0, a1); p[1] = pk2(a2, a3); p[2] = pk2(a4, a5); p[3] = pk2(a6, a7);
  return __builtin_bit_cast(bf16x8, p);
}
DI int crow(int reg, int h) { return (reg & 3) + 8 * (reg >> 2) + 4 * h; }
DI int opaque_tid() { int t = threadIdx.x; asm volatile("" : "+v"(t)); return t; }
DI float half_max(float v) {
  unsigned u = __float_as_uint(v);
  auto r = __builtin_amdgcn_permlane32_swap(u, u, false, false);
  return fmaxf(__uint_as_float(r[0]), __uint_as_float(r[1]));
}
DI float half_sum(float v) {
  unsigned u = __float_as_uint(v);
  auto r = __builtin_amdgcn_permlane32_swap(u, u, false, false);
  return __uint_as_float(r[0]) + __uint_as_float(r[1]);
}
DI float sigmoidf_fast(float v) { return __builtin_amdgcn_rcpf(1.f + __builtin_amdgcn_exp2f(-v * LOG2E)); }
DI float siluf_fast(float v) { return v * sigmoidf_fast(v); }

#define XB_TMO      128
#define XB_XCNT(j)  (256  + 64 * (j))
#define XB_XSUB(j)  (1280 + 64 * (j))
#define XB_XGEN(j)  (2304 + 64 * (j))
#define XB_TOP      3328
#define XB_TOPGEN   3392
#define XCD_BAR_WORDS 3456
#define XB_SPIN_CAP (1u << 18)
#define LAS __attribute__((address_space(3)))
DI unsigned xb_ld(unsigned* p)              { return __hip_atomic_load(p, __ATOMIC_RELAXED, __HIP_MEMORY_SCOPE_AGENT); }
DI unsigned xb_add(unsigned* p, unsigned v) { return __hip_atomic_fetch_add(p, v, __ATOMIC_RELAXED, __HIP_MEMORY_SCOPE_AGENT); }
DI unsigned xb_xcc_id() { return (unsigned)__builtin_amdgcn_s_getreg((3 << 11) | 20) & 0xFu; }
#define XB_SPIN(cond, bar) do { unsigned _sp = 0; while (cond) { __builtin_amdgcn_s_sleep(1); \
    if ((++_sp & 255u) == 0u) { if (xb_ld(&(bar)[XB_TMO])) break; if (_sp > XB_SPIN_CAP) { atomicAdd(&(bar)[XB_TMO], 1u); break; } } } } while (0)
struct XcdBarrier { unsigned* bar; unsigned x; volatile LAS unsigned* st; };
DI XcdBarrier xcd_barrier_post(unsigned* bar, volatile LAS unsigned* st) {
  XcdBarrier b; b.bar = bar; b.x = xb_xcc_id(); b.st = st;
  if (threadIdx.x == 0) (void)xb_add(&bar[XB_XCNT(b.x)], 1u);
  return b;
}
DI void xcd_barrier_complete(unsigned* bar, unsigned x, unsigned& nloc, unsigned& nx) {
  const unsigned G = gridDim.x * gridDim.y * gridDim.z;
  unsigned sum, cnt, mine, sp = 0u;
  for (;;) {
    sum = 0u; cnt = 0u; mine = 0u;
#pragma unroll
    for (unsigned j = 0; j < 16; ++j) { const unsigned c = xb_ld(&bar[XB_XCNT(j)]); sum += c; cnt += (c > 0u) ? 1u : 0u; mine = (j == x) ? c : mine; }
    if (sum == G) break;
    __builtin_amdgcn_s_sleep(1);
    if ((++sp & 255u) == 0u) { if (xb_ld(&bar[XB_TMO])) break; if (sp > XB_SPIN_CAP) { atomicAdd(&bar[XB_TMO], 1u); break; } }
  }
  nloc = mine > 0u ? mine : 1u; nx = cnt > 0u ? cnt : 1u;
}
DI void xcd_barrier(unsigned* bar_, volatile LAS unsigned* st_) {
  XcdBarrier b; b.bar = bar_; b.st = st_; b.x = 0;
  asm volatile("s_waitcnt vmcnt(0)" ::: "memory");
  __syncthreads();
  if (threadIdx.x == 0) {
    unsigned* bar = b.bar;
    b.x = xb_xcc_id();
    __builtin_amdgcn_s_waitcnt(0);
    unsigned nloc = b.st[0], nx = b.st[1];
    if (nloc == 0u) { xcd_barrier_complete(bar, b.x, nloc, nx); b.st[0] = nloc; b.st[1] = nx; }
    const unsigned old = xb_add(&bar[XB_XSUB(b.x)], 1u);
    const unsigned gen = old / nloc;
    if (old + 1u == (gen + 1u) * nloc) {
      __builtin_amdgcn_fence(__ATOMIC_RELEASE, "agent");
      asm volatile("s_waitcnt vmcnt(0)" ::: "memory");
      const unsigned og = xb_add(&bar[XB_TOP], 1u);
      const unsigned tg = og / nx;
      if (og + 1u == (tg + 1u) * nx) xb_add(&bar[XB_TOPGEN], 1u);
      else XB_SPIN(xb_ld(&bar[XB_TOPGEN]) == tg, bar);
      __builtin_amdgcn_fence(__ATOMIC_ACQUIRE, "agent");
      xb_add(&bar[XB_XGEN(b.x)], 1u);
      asm volatile("s_waitcnt vmcnt(0)" ::: "memory");
    } else {
      XB_SPIN(xb_ld(&bar[XB_XGEN(b.x)]) == gen, bar);
      __builtin_amdgcn_fence(__ATOMIC_ACQUIRE, "agent");
      asm volatile("s_waitcnt vmcnt(0)" ::: "memory");
    }
  }
  __syncthreads();
}

constexpr int GSTR = 72;
constexpr int GBUF = 128 * GSTR;
constexpr int RS_OFF = 135168;
constexpr int SMEM_BYTES = RS_OFF + 4096;

constexpr int G8_HT = 128 * 64;
DI int lds_byte(int r, int c) { const int st = (r >> 4) * 2 + (c >> 5), rr = r & 15, cc = c & 31, ob = rr * 64 + cc * 2; return st * 1024 + (ob ^ (((ob >> 9) & 1) << 5)); }
DI void stage_rc(int b, int& R, int& C) { const int st = b / 1024, sb = b % 1024, swz = sb ^ (((sb >> 9) & 1) << 5); R = (st >> 1) * 16 + swz / 64; C = (st & 1) * 32 + (swz % 64) / 2; }

DI void gemm8_tile(const bf16_t* __restrict__ A, const bf16_t* __restrict__ Bt, const int K, bf16_t* shm, f32x4 (&acc)[2][2][4][2]) {
  const int tid = opaque_tid();
  const int wid = tid >> 6, lane = tid & 63, wr = wid >> 2, wc = wid & 3, fr = lane & 15, fq = lane >> 4;
  const int swz = (fr * 64 + fq * 16) ^ ((fr >> 3) << 5);
  const char* aRd = (const char*)shm + swz + wr * 8192;
  const char* bRd = (const char*)shm + 65536 + swz + wc * 4096;
  int sr0, sc0, sr1, sc1;
  stage_rc(tid * 16, sr0, sc0);
  stage_rc(tid * 16 + 8192, sr1, sc1);
  const unsigned so0 = (unsigned)(sr0 * K + sc0) * 2u, so1 = (unsigned)(sr1 * K + sc1) * 2u;
  char* const stw = (char*)shm + __builtin_amdgcn_readfirstlane(tid & ~63) * 16;
  const char* const Ab = (const char*)A;
  const char* const Bb = (const char*)Bt;
#define SA(b, h) (((b) * 2 + (h)) * 16384)
#define SB(b, h) ((4 + (b) * 2 + (h)) * 16384)
#define STAGE(P, BASE, br, kt) do { const char* g_ = (BASE) + ((long)(br) * K + (long)(kt) * 64) * 2;                        \
    __builtin_amdgcn_global_load_lds((const unsigned*)(g_ + so0), (unsigned*)(stw + (P)), 16, 0, 0);                          \
    __builtin_amdgcn_global_load_lds((const unsigned*)(g_ + so1), (unsigned*)(stw + (P) + 8192), 16, 0, 0); } while (0)
#define LDA(dst, b, h) _Pragma("unroll") for (int m = 0; m < 4; ++m) _Pragma("unroll") for (int k = 0; k < 2; ++k) \
    dst[m][k] = *reinterpret_cast<const bf16x8*>(aRd + ((b) * 2 + (h)) * 16384 + (m * 2 + k) * 1024)
#define LDB(dst, b, h) _Pragma("unroll") for (int n = 0; n < 2; ++n) _Pragma("unroll") for (int k = 0; k < 2; ++k) \
    dst[n][k] = *reinterpret_cast<const bf16x8*>(bRd + ((b) * 2 + (h)) * 16384 + (n * 2 + k) * 1024)
#define MMA(ai, bj, At_, Bt_) do { __builtin_amdgcn_s_setprio(1);                                                          \
    _Pragma("unroll") for (int m = 0; m < 4; ++m) _Pragma("unroll") for (int n = 0; n < 2; ++n) _Pragma("unroll") for (int k = 0; k < 2; ++k) \
      acc[ai][bj][m][n] = __builtin_amdgcn_mfma_f32_16x16x32_bf16(At_[m][k], Bt_[n][k], acc[ai][bj][m][n], 0, 0, 0);       \
    __builtin_amdgcn_s_setprio(0); } while (0)
#define WAIT_V(n) asm volatile("s_waitcnt vmcnt(" #n ")" ::: "memory")
#define WAIT_L(n) asm volatile("s_waitcnt lgkmcnt(" #n ")" ::: "memory")
#define BAR __builtin_amdgcn_s_barrier()
#define SCHED __builtin_amdgcn_sched_barrier(0)
  bf16x8 At[4][2], B0[2][2], B1[2][2];
  const int nt = K / 64;
  STAGE(SB(0, 0), Bb, 0, 0); STAGE(SA(0, 0), Ab, 0, 0);
  STAGE(SB(0, 1), Bb, 128, 0); STAGE(SA(0, 1), Ab, 128, 0);
  if (wr == 1) BAR;
  WAIT_V(4); BAR;
  STAGE(SB(1, 0), Bb, 0, 1); STAGE(SA(1, 0), Ab, 0, 1); STAGE(SB(1, 1), Bb, 128, 1);
  WAIT_V(6); BAR;
  for (int t = 0; t < nt - 2; t += 2) {
    LDB(B0, 0, 0); SCHED; LDA(At, 0, 0); STAGE(SA(1, 1), Ab, 128, t + 1);
    WAIT_L(8); BAR; WAIT_L(0); MMA(0, 0, At, B0); BAR; SCHED;
    LDB(B1, 0, 1); STAGE(SB(0, 0), Bb, 0, t + 2);
    BAR; WAIT_L(0); MMA(0, 1, At, B1); BAR;
    LDA(At, 0, 1); STAGE(SA(0, 0), Ab, 0, t + 2);
    BAR; WAIT_L(0); MMA(1, 0, At, B0); BAR; SCHED;
    STAGE(SB(0, 1), Bb, 128, t + 2);
    WAIT_V(6); BAR; MMA(1, 1, At, B1); BAR;
    LDB(B0, 1, 0); SCHED; LDA(At, 1, 0); STAGE(SA(0, 1), Ab, 128, t + 2);
    WAIT_L(8); BAR; WAIT_L(0); MMA(0, 0, At, B0); BAR; SCHED;
    LDB(B1, 1, 1); STAGE(SB(1, 0), Bb, 0, t + 3);
    BAR; WAIT_L(0); MMA(0, 1, At, B1); BAR;
    LDA(At, 1, 1); STAGE(SA(1, 0), Ab, 0, t + 3);
    BAR; WAIT_L(0); MMA(1, 0, At, B0); BAR; SCHED;
    STAGE(SB(1, 1), Bb, 128, t + 3);
    WAIT_V(6); BAR; MMA(1, 1, At, B1); BAR;
  }
  { LDB(B0, 0, 0); LDA(At, 0, 0); STAGE(SA(1, 1), Ab, 128, nt - 1);
    BAR; WAIT_L(0); MMA(0, 0, At, B0); BAR;
    LDB(B1, 0, 1); BAR; WAIT_L(0); MMA(0, 1, At, B1); BAR;
    LDA(At, 0, 1); WAIT_V(4); BAR; WAIT_L(0); MMA(1, 0, At, B0); MMA(1, 1, At, B1); BAR; }
  { LDB(B0, 1, 0); LDA(At, 1, 0); WAIT_V(2); BAR; WAIT_L(0); MMA(0, 0, At, B0); BAR;
    LDB(B1, 1, 1); WAIT_V(0); BAR; WAIT_L(0); MMA(0, 1, At, B1); BAR;
    LDA(At, 1, 1); BAR; WAIT_L(0); MMA(1, 0, At, B0); MMA(1, 1, At, B1); BAR; }
  if (wr == 0) BAR;
#undef SA
#undef SB
#undef STAGE
#undef LDA
#undef LDB
#undef MMA
#undef WAIT_V
#undef WAIT_L
#undef BAR
#undef SCHED
}


DI void zero_acc8(f32x4 (&acc)[2][2][4][2]) {
#pragma unroll
  for (int a = 0; a < 2; ++a)
#pragma unroll
    for (int b = 0; b < 2; ++b)
#pragma unroll
      for (int m = 0; m < 4; ++m)
#pragma unroll
        for (int n = 0; n < 2; ++n) acc[a][b][m][n] = f32x4{0.f, 0.f, 0.f, 0.f};
}

constexpr int CSTR = 132;
DI void accq_to_lds(const f32x4 (&q)[4][2], float* sC) {
  const int tid = opaque_tid(), wid = tid >> 6, lane = tid & 63, wr = wid >> 2, wc = wid & 3, fr = lane & 15, fq = lane >> 4;
#pragma unroll
  for (int m = 0; m < 4; ++m)
#pragma unroll
    for (int n = 0; n < 2; ++n)
#pragma unroll
      for (int j = 0; j < 4; ++j) sC[(wr * 64 + m * 16 + fq * 4 + j) * CSTR + wc * 32 + n * 16 + fr] = q[m][n][j];
}
constexpr int SC2_OFF = 128 * CSTR;
template <class EPI>
DI void tile_epilogue2(const f32x4 (&acc)[2][2][4][2], float* sC, EPI epi) {
  __syncthreads();
  accq_to_lds(acc[0][0], sC);
  __syncthreads();
  accq_to_lds(acc[0][1], sC + SC2_OFF);
  epi(0, sC);
  __syncthreads();
  accq_to_lds(acc[1][0], sC);
  epi(1, sC + SC2_OFF);
  __syncthreads();
  accq_to_lds(acc[1][1], sC + SC2_OFF);
  epi(2, sC);
  __syncthreads();
  epi(3, sC + SC2_OFF);
  __syncthreads();
}

template <class F>
DI void epi_rows(const float* sC, F f) {
  const int tx = opaque_tid();
#pragma unroll
  for (int i = 0; i < 4; ++i) {
    const int c = tx + 512 * i, row = c >> 4, cc = (c & 15) * 8;
    const float4 a = *(const float4*)(sC + row * CSTR + cc), b = *(const float4*)(sC + row * CSTR + cc + 4);
    const float v[8] = {a.x, a.y, a.z, a.w, b.x, b.y, b.z, b.w};
    f(i, row, cc, v);
  }
}
DI float4 ldnt4(const float* p) { float4 r; r.x = __builtin_nontemporal_load(p); r.y = __builtin_nontemporal_load(p + 1); r.z = __builtin_nontemporal_load(p + 2); r.w = __builtin_nontemporal_load(p + 3); return r; }
DI void store8(bf16_t* p, const float (&v)[8]) { *(bf16x8*)p = pack8(v[0], v[1], v[2], v[3], v[4], v[5], v[6], v[7]); }
DI void store8_nt(bf16_t* p, const float (&v)[8]) { __builtin_nontemporal_store(pack8(v[0], v[1], v[2], v[3], v[4], v[5], v[6], v[7]), (bf16x8*)p); }
DI void epi_vt(const float* sC, bf16_t* VT, int m0, int head0, int c0, int ncol_log2) {
  const int b = m0 >> 12, s0 = m0 & 4095;
  const int nitems = 16 << ncol_log2;
  for (int c = opaque_tid(); c < nitems; c += 512) {
    const int col = c & ((1 << ncol_log2) - 1), rc = c >> ncol_log2;
    float v[8];
#pragma unroll
    for (int j = 0; j < 8; ++j) v[j] = sC[(rc * 8 + j) * CSTR + c0 + col];
    const int head = head0 + (col >> 6), d = col & 63;
    store8(VT + ((size_t)((b * 8 + head) * 64 + d)) * SEQL + s0 + rc * 8, v);
  }
}
DI void rope8(const float* sC, const float* ROPE, int tok, int row, int cc, float (&v)[8]) {
  const float* pr = sC + row * CSTR + (cc ^ 16);
  const bool upper = (cc & 16) != 0;
  const int f0 = cc & 15;
  const float* tb = ROPE + (size_t)tok * 32;
#pragma unroll
  for (int j = 0; j < 8; ++j) {
    const float o = pr[j], cs = tb[f0 + j], sn = tb[16 + f0 + j];
    v[j] = upper ? (o * sn + v[j] * cs) : (v[j] * cs - o * sn);
  }
}

DI void wconv_unit(const float* __restrict__ src, int Nsrc, int K, bf16_t* __restrict__ dst, const float* __restrict__ gain, int ng, int kg, int mode, float* tile, const int tid) {
  {
    const int k = tid >> 2, cq = tid & 3;
    const int n = ng * 64 + cq * 16;
    int sc = n;
    if (mode == 1) { sc = (n < 2688) ? n : (n < 5248 ? n + 32 : (n < 5280 ? n - 2560 : -1)); }
    const int kk = kg * 64 + k;
    float4 v[4];
    if (sc >= 0) {
      const float* sp = src + (size_t)kk * Nsrc + sc;
#pragma unroll
      for (int i = 0; i < 4; ++i) v[i] = ldnt4(sp + 4 * i);
      if (gain) { const float g = gain[kk];
#pragma unroll
        for (int i = 0; i < 4; ++i) { v[i].x *= g; v[i].y *= g; v[i].z *= g; v[i].w *= g; } }
    } else {
#pragma unroll
      for (int i = 0; i < 4; ++i) v[i] = make_float4(0.f, 0.f, 0.f, 0.f);
    }
    float* tp = tile + k * 65 + cq * 16;
#pragma unroll
    for (int i = 0; i < 4; ++i) { tp[4 * i] = v[i].x; tp[4 * i + 1] = v[i].y; tp[4 * i + 2] = v[i].z; tp[4 * i + 3] = v[i].w; }
  }
  __syncthreads();
  {
    const int n = tid >> 2, kc = tid & 3;
    float o[16];
#pragma unroll
    for (int j = 0; j < 16; ++j) o[j] = tile[(kc * 16 + j) * 65 + n];
    bf16_t* dp = dst + (size_t)(ng * 64 + n) * K + kg * 64 + kc * 16;
    *(bf16x8*)dp = pack8(o[0], o[1], o[2], o[3], o[4], o[5], o[6], o[7]);
    *(bf16x8*)(dp + 8) = pack8(o[8], o[9], o[10], o[11], o[12], o[13], o[14], o[15]);
  }
  __syncthreads();
}

DI void phase_prep(const Params& p, char* smem) {
  if (blockIdx.x == 0 && threadIdx.x < 16) { p.counter()[threadIdx.x] = 0; }
  for (int i = blockIdx.x * NTHREADS + threadIdx.x; i < 2 * NTOK; i += gridDim.x * NTHREADS) p.SSQ()[i] = 0.f;
  const int half = threadIdx.x >> 8, tid = threadIdx.x & 255;
  constexpr int U_MOD = 96 * 4, U_WIN = 84 * 16, U_WUQ = 12 * 6, U_WUKV = 16 * 4, U_WA = 16 * 8, U_WB = 16 * 8, U_WO = 16 * 16, U_ROPE = 1024;
  constexpr int U_TOTAL = U_MOD + U_ROPE + U_WIN + U_WUQ + U_WUKV + U_WA + U_WB + U_WO;
  float* tile = (float*)smem + half * (64 * 65 + 64);
  for (int up = blockIdx.x; up < U_TOTAL / 2; up += gridDim.x) {
    int v = 2 * up + half;
    if (v < U_MOD) {
      const int cg32 = v >> 2, kq = v & 3, n0 = cg32 * 32;
      const int kgp = tid >> 5, col = tid & 31;
      const int kb = kq * 256 + kgp * 32;
      float a0 = 0.f, a1 = 0.f, a2 = 0.f, a3 = 0.f;
      const float* wp = p.w_ada + (size_t)kb * 3072 + n0 + col;
      float wv[32];
#pragma unroll
      for (int kk = 0; kk < 32; ++kk) wv[kk] = __builtin_nontemporal_load(wp + (size_t)kk * 3072);
#pragma unroll
      for (int kk = 0; kk < 32; ++kk) {
        a0 += wv[kk] * p.c[kb + kk]; a1 += wv[kk] * p.c[1024 + kb + kk]; a2 += wv[kk] * p.c[2048 + kb + kk]; a3 += wv[kk] * p.c[3072 + kb + kk];
      }
      float* red = (float*)smem + half * 1024;
      red[(kgp * 4 + 0) * 32 + col] = a0; red[(kgp * 4 + 1) * 32 + col] = a1; red[(kgp * 4 + 2) * 32 + col] = a2; red[(kgp * 4 + 3) * 32 + col] = a3;
      __syncthreads();
      if (tid < 128) {
        const int b = tid >> 5, cc = tid & 31;
        float s = (kq == 0) ? p.b_ada[n0 + cc] : 0.f;
#pragma unroll
        for (int g = 0; g < 8; ++g) s += red[(g * 4 + b) * 32 + cc];
        p.MOD()[(size_t)(b * 3072 + n0 + cc) * 4 + kq] = s;
      }
      __syncthreads();
      continue;
    }
    v -= U_MOD;
    if (v < U_WIN) { wconv_unit(p.w_in, INW, 1024, p.WinT(), nullptr, v >> 4, v & 15, 1, tile, tid); continue; }
    v -= U_WIN;
    if (v < U_WUQ) { wconv_unit(p.w_uq, 768, 384, p.WuqT(), p.q_gain, v / 6, v % 6, 0, tile, tid); continue; }
    v -= U_WUQ;
    if (v < U_WUKV) { wconv_unit(p.w_ukv, 1024, 256, p.WukvT(), p.kv_gain, v >> 2, v & 3, 0, tile, tid); continue; }
    v -= U_WUKV;
    if (v < U_WA) { wconv_unit(p.w_a, 1024, 512, p.WaT(), nullptr, v >> 3, v & 7, 0, tile, tid); continue; }
    v -= U_WA;
    if (v < U_WB) { wconv_unit(p.w_b, 1024, 512, p.WbT(), nullptr, v >> 3, v & 7, 0, tile, tid); continue; }
    v -= U_WB;
    if (v < U_WO) { wconv_unit(p.w_out, 1024, 1024, p.WoT(), nullptr, v >> 4, v & 15, 0, tile, tid); continue; }
    v -= U_WO;
    {
      const int idx = v * 256 + tid, tok = idx >> 4, i = idx & 15;
      const float ang = (float)p.pos[tok] * c_invfreq[i];
      double t = (double)ang * 0.15915494309189535;
      t -= rint(t);
      const float tf = (float)t;
      p.ROPE()[(size_t)tok * 32 + i] = __builtin_amdgcn_cosf(tf);
      p.ROPE()[(size_t)tok * 32 + 16 + i] = __builtin_amdgcn_sinf(tf);
    }
  }
}

DI float mod_get(const float* MOD, int b, int n) { const float4 q = *(const float4*)(MOD + (size_t)(b * 3072 + n) * 4); return (q.x + q.y) + (q.z + q.w); }

DI void phase_h(const Params& p, char* smem) {
  const int tid = opaque_tid(), lane = tid & 63, w = tid >> 6;
  float* gs = (float*)smem;
  float* sh = gs + 1024;
  const int xq = blockIdx.x & 7, lb = blockIdx.x >> 3, nlb = gridDim.x >> 3;
  const bool xmap = (gridDim.x & 7) == 0;
  for (int rgi = xmap ? lb : (int)blockIdx.x; rgi < (xmap ? 32 : NTOK / 64); rgi += (xmap ? nlb : (int)gridDim.x)) {
    const int rg = xmap ? (32 * xq + rgi) : rgi;
    const int b = (rg * 64) >> 12;
    __syncthreads();
#pragma unroll
    for (int i = 0; i < 2; ++i) {
      const int k = tid + 512 * i;
      gs[k] = p.norm_gain[k] * (1.f + mod_get(p.MOD(), b, 1024 + k));
      sh[k] = mod_get(p.MOD(), b, k);
    }
    __syncthreads();
#pragma unroll 4
    for (int rr = 0; rr < 8; ++rr) {
      const int row = rg * 64 + w * 8 + rr;
      const float* xr = p.x + (size_t)row * DM;
      float4 v[4];
      float ss = 0.f;
#pragma unroll
      for (int i = 0; i < 2; ++i) {
        const int e = 8 * (lane + 64 * i);
        v[2 * i] = ldnt4(xr + e);
        v[2 * i + 1] = ldnt4(xr + e + 4);
        ss += v[2 * i].x * v[2 * i].x + v[2 * i].y * v[2 * i].y + v[2 * i].z * v[2 * i].z + v[2 * i].w * v[2 * i].w;
        ss += v[2 * i + 1].x * v[2 * i + 1].x + v[2 * i + 1].y * v[2 * i + 1].y + v[2 * i + 1].z * v[2 * i + 1].z + v[2 * i + 1].w * v[2 * i + 1].w;
      }
#pragma unroll
      for (int o = 32; o >= 1; o >>= 1) ss += __shfl_xor(ss, o);
      const float rn = __builtin_amdgcn_rsqf(ss * (1.f / DM) + EPSN);
#pragma unroll
      for (int i = 0; i < 2; ++i) {
        const int e = 8 * (lane + 64 * i);
        const float4 g0 = *(const float4*)(gs + e), g1 = *(const float4*)(gs + e + 4);
        const float4 s0 = *(const float4*)(sh + e), s1 = *(const float4*)(sh + e + 4);
        *(bf16x8*)(p.Hb() + (size_t)row * DM + e) =
            pack8(v[2 * i].x * rn * g0.x + s0.x, v[2 * i].y * rn * g0.y + s0.y, v[2 * i].z * rn * g0.z + s0.z, v[2 * i].w * rn * g0.w + s0.w,
                  v[2 * i + 1].x * rn * g1.x + s1.x, v[2 * i + 1].y * rn * g1.y + s1.y, v[2 * i + 1].z * rn * g1.z + s1.z, v[2 * i + 1].w * rn * g1.w + s1.w);
      }
    }
  }
  __syncthreads();
}

DI void g1_epi(const Params& p, const float* sC, const int m0, const int n0, const int ct, const bool do_ssq) {
    if (ct < 4) {
      epi_rows(sC, [&](int, int row, int cc, const float (&v)[8]) {
        float o[8];
#pragma unroll
        for (int j = 0; j < 8; ++j) o[j] = v[j] * QS_SCALE;
        store8(p.Qsb() + (size_t)(m0 + row) * 512 + n0 + cc, o); });
    } else if (ct < 8) {
      epi_rows(sC, [&](int, int row, int cc, const float (&v)[8]) { store8(p.Ksb() + (size_t)(m0 + row) * 512 + n0 - 512 + cc, v); });
    } else if (ct < 12) {
      epi_vt(sC, p.VTsb(), m0, (n0 - 1024) >> 6, 0, 7);
    } else if (ct < 16) {
      epi_rows(sC, [&](int, int row, int cc, const float (&v)[8]) {
        float o[8];
#pragma unroll
        for (int j = 0; j < 8; ++j) o[j] = siluf_fast(v[j]);
        store8(p.Zsb() + (size_t)(m0 + row) * 512 + n0 - 1536 + cc, o); });
    } else if (ct < 19) {
      epi_rows(sC, [&](int, int row, int cc, const float (&v)[8]) {
        store8(p.CQ() + (size_t)(m0 + row) * 384 + n0 - 2048 + cc, v);
        float q = 0.f;
#pragma unroll
        for (int j = 0; j < 8; ++j) q += v[j] * v[j];
        q += __shfl_xor(q, 1); q += __shfl_xor(q, 2); q += __shfl_xor(q, 4); q += __shfl_xor(q, 8);
        if (do_ssq && (threadIdx.x & 15) == 0) atomicAdd(p.SSQ() + m0 + row, q); });
    } else if (ct < 21) {
      epi_rows(sC, [&](int, int row, int cc, const float (&v)[8]) {
        store8(p.CKV() + (size_t)(m0 + row) * 256 + n0 - 2432 + cc, v);
        float q = 0.f;
#pragma unroll
        for (int j = 0; j < 8; ++j) q += v[j] * v[j];
        q += __shfl_xor(q, 1); q += __shfl_xor(q, 2); q += __shfl_xor(q, 4); q += __shfl_xor(q, 8);
        if (do_ssq && (threadIdx.x & 15) == 0) atomicAdd(p.SSQ() + NTOK + m0 + row, q); });
    } else if (ct < 25) {
      epi_rows(sC, [&](int, int row, int cc, const float (&v)[8]) {
        float o[8];
#pragma unroll
        for (int j = 0; j < 8; ++j) o[j] = siluf_fast(v[j]);
        store8(p.Zmla() + (size_t)(m0 + row) * 512 + n0 - 2688 + cc, o); });
    } else if (ct < 33) {
      epi_rows(sC, [&](int, int row, int cc, const float (&v)[8]) {
        float o[8];
#pragma unroll
        for (int j = 0; j < 8; ++j) o[j] = sigmoidf_fast(v[j]);
        store8_nt(p.GA() + (size_t)(m0 + row) * 1024 + n0 - 3200 + cc, o); });
    } else if (ct < 41) {
      epi_rows(sC, [&](int, int row, int cc, const float (&v)[8]) {
        float o[8];
#pragma unroll
        for (int j = 0; j < 8; ++j) o[j] = sigmoidf_fast(v[j]);
        store8_nt(p.GB() + (size_t)(m0 + row) * 1024 + n0 - 4224 + cc, o); });
    } else {
      epi_rows(sC, [&](int, int row, int cc, const float (&v)[8]) {
        if (cc < 32) {
          float o[8];
#pragma unroll
          for (int j = 0; j < 8; ++j) o[j] = v[j];
          rope8(sC, p.ROPE(), m0 + row, row, cc, o);
          store8(p.KPE() + (size_t)(m0 + row) * 32 + cc, o);
        } });
    }
}

DI void g1_tile(const Params& p, char* smem, const int rt, const int ct2, const bool do_ssq) {
  bf16_t* shm = (bf16_t*)smem;
  float* sC = (float*)smem;
  const int m0 = rt * 256, n0 = ct2 * 256;
  f32x4 acc[2][2][4][2];
  zero_acc8(acc);
  gemm8_tile(p.Hb() + (size_t)m0 * DM, p.WinT() + (size_t)n0 * DM, DM, shm, acc);
  tile_epilogue2(acc, sC, [&](const int qd, const float* sq) {
    g1_epi(p, sq, m0 + (qd >> 1) * 128, n0 + (qd & 1) * 128, ct2 * 2 + (qd & 1), do_ssq); });
}

constexpr int G1_NCT = 20;
DI void phase_g1(const Params& p, char* smem, bool do_ssq = true) {
  const int xq = blockIdx.x & 7, lb = blockIdx.x >> 3, nlb = gridDim.x >> 3;
  const bool xmap = (gridDim.x & 7) == 0;
  for (int t = xmap ? lb : (int)blockIdx.x; t < (xmap ? 8 * G1_NCT : 64 * G1_NCT); t += (xmap ? nlb : (int)gridDim.x)) {
    int rt, ct2;
    if (xmap) { ct2 = t >> 3; rt = 8 * xq + (t & 7); } else { rt = t / G1_NCT; ct2 = t % G1_NCT; }
    g1_tile(p, smem, rt, ct2, do_ssq);
  }
}

DI void g2_epi_q(const Params& p, const float* sC, const float* rsq, const int m0, const int n0) {
  epi_rows(sC, [&](int, int row, int cc, const float (&v)[8]) {
    const int col = n0 + cc;
    float o[8];
#pragma unroll
    for (int j = 0; j < 8; ++j) o[j] = v[j];
    if (((col >> 5) % 3) == 2) rope8(sC, p.ROPE(), m0 + row, row, cc, o);
    const float sc = rsq[row] * QM_SCALE;
#pragma unroll
    for (int j = 0; j < 8; ++j) o[j] *= sc;
    store8(p.Qmla() + (size_t)(m0 + row) * 768 + col, o);
  });
}
DI void g2_epi_kv(const Params& p, const float* sC, const float* rsq, const int m0, const int head) {
  epi_rows(sC, [&](int, int row, int cc, const float (&v)[8]) {
    if (cc < 64) {
      const float sc = rsq[row];
      float o[8];
#pragma unroll
      for (int j = 0; j < 8; ++j) o[j] = v[j] * sc;
      store8(p.Knope() + (size_t)(m0 + row) * 512 + head * 64 + cc, o);
    } });
  const int b = m0 >> 12, s0 = m0 & 4095;
  for (int c = opaque_tid(); c < 1024; c += 512) {
    const int col = c & 63, rc = c >> 6;
    float v[8];
#pragma unroll
    for (int j = 0; j < 8; ++j) v[j] = sC[(rc * 8 + j) * CSTR + 64 + col] * rsq[rc * 8 + j];
    store8(p.VTmla() + ((size_t)((b * 8 + head) * 64 + col)) * SEQL + s0 + rc * 8, v);
  }
}

DI void g2_tile(const Params& p, char* smem, const bool isq, const int rt, const int ct) {
  bf16_t* shm = (bf16_t*)smem;
  float* sC = (float*)smem;
  float* rs = (float*)(smem + RS_OFF);
  const int m0 = rt * 256, n0 = ct * 256;
  f32x4 acc[2][2][4][2];
  zero_acc8(acc);
  if (isq) {
    if (threadIdx.x < 256) rs[threadIdx.x] = __builtin_amdgcn_rsqf(p.SSQ()[m0 + threadIdx.x] * (1.f / 384.f) + EPSN);
    gemm8_tile(p.CQ() + (size_t)m0 * 384, p.WuqT() + (size_t)n0 * 384, 384, shm, acc);
    tile_epilogue2(acc, sC, [&](const int qd, const float* sq) {
      g2_epi_q(p, sq, rs + (qd >> 1) * 128, m0 + (qd >> 1) * 128, n0 + (qd & 1) * 128); });
  } else {
    if (threadIdx.x < 256) rs[threadIdx.x] = __builtin_amdgcn_rsqf(p.SSQ()[NTOK + m0 + threadIdx.x] * (1.f / 256.f) + EPSN);
    gemm8_tile(p.CKV() + (size_t)m0 * 256, p.WukvT() + (size_t)n0 * 256, 256, shm, acc);
    tile_epilogue2(acc, sC, [&](const int qd, const float* sq) {
      g2_epi_kv(p, sq, rs + (qd >> 1) * 128, m0 + (qd >> 1) * 128, ct * 2 + (qd & 1)); });
  }
  __syncthreads();
}

DI void phase_g2(const Params& p, char* smem) {
  const int xq = blockIdx.x & 7, lb = blockIdx.x >> 3, nlb = gridDim.x >> 3;
  if ((gridDim.x & 7) == 0 && nlb == 32) {
    if (lb < 8) {
      g1_tile(p, smem, 8 * xq + lb, G1_NCT, false);
      const int v2 = 24 + lb;
      g2_tile(p, smem, false, 8 * xq + (v2 & 7), v2 >> 3);
      return;
    }
    const int v = lb - 8;
    g2_tile(p, smem, true, 8 * xq + (v & 7), v >> 3);
    g2_tile(p, smem, false, 8 * xq + (v & 7), v >> 3);
  } else {
    for (int tt = blockIdx.x; tt < 64 + 192 + 256; tt += gridDim.x) {
      if (tt < 64) g1_tile(p, smem, tt, G1_NCT, false);
      else if (tt < 256) { const int v = tt - 64; g2_tile(p, smem, true, v / 3, v % 3); }
      else { const int v = tt - 256; g2_tile(p, smem, false, v >> 2, v & 3); }
    }
  }
}

constexpr int VSTR = 68;

template <bool MLA>
DI void attn_item(const Params& p, int b, int h, int qb, char* smem, int* pre_ctr, int& pre_raw) {
  constexpr int DK = MLA ? 96 : 64;
  constexpr int KSTR = MLA ? 104 : 72;
  constexpr int NKS = DK / 16;
  bf16_t* sK = (bf16_t*)smem;
  bf16_t* sV = sK + 2 * 64 * KSTR;
  const int tid = threadIdx.x, lane = tid & 63, w = tid >> 6, r = lane & 31, hh = lane >> 5;
  const int tokb = b * SEQL;
  const int tok0 = tokb + qb * 256;
  const int qw = qb * 256 + w * 32;

  bf16x8 qf[NKS];
  {
    const bf16_t* qptr = MLA ? (p.Qmla() + (size_t)(tok0 + w * 32 + r) * 768 + h * 96 + hh * 8) : (p.Qsb() + (size_t)(tok0 + w * 32 + r) * 512 + h * 64 + hh * 8);
#pragma unroll
    for (int ks = 0; ks < NKS; ++ks) qf[ks] = *(const bf16x8*)(qptr + ks * 16);
  }
  u32x2* zbuf = (u32x2*)(smem + 65536);
  u32x2 zpre[8];
  {
    const bf16_t* zg0 = (MLA ? p.Zmla() : p.Zsb()) + (size_t)(tok0 + w * 32 + r) * 512 + h * 64 + 4 * hh;
#pragma unroll
    for (int i = 0; i < 8; ++i) zpre[i] = *(const u32x2*)(zg0 + (i >> 2) * 32 + 8 * (i & 3));
  }
  bf16x8 tf[2];
  if (!MLA) {
#pragma unroll
    for (int st = 0; st < 2; ++st)
#pragma unroll
      for (int e = 0; e < 8; ++e) { const int j = 16 * st + 8 * (e >> 2) + 4 * hh + (e & 3); tf[st][e] = (j >= r) ? (short)0x3F80 : (short)0; }
  }

  f32x16 oacc[2];
#pragma unroll
  for (int i = 0; i < 16; ++i) { oacc[0][i] = 0.f; oacc[1][i] = 0.f; }
  float carry = 0.f;
  float mrun = 0.f, lrun = 0.f;

  const bf16_t* Kg = MLA ? p.Knope() : p.Ksb();
  const bf16_t* VTg = (MLA ? p.VTmla() : p.VTsb()) + (size_t)((b * 8 + h) * 64) * SEQL;
  const int nt = 4 * qb + 4;

  uint4 xk0, xv0, xp, yk0, yv0, yp;
  xp = make_uint4(0, 0, 0, 0); yp = xp;
  const int prow = tid >> 3, pch = tid & 7;
  const bf16_t* kgp = Kg + (size_t)(tokb + prow) * 512 + h * 64 + pch * 8;
  const bf16_t* vgp = VTg + (size_t)prow * SEQL + pch * 8;
  const bf16_t* pgp = p.KPE() + (size_t)(tokb + ((tid & 255) >> 2)) * 32 + (tid & 3) * 8;
#define ATT_GLOAD(P, kt_)                                                          \
  {                                                                                \
    const int kt__ = (kt_);                                                        \
    P##k0 = *(const uint4*)(kgp + (size_t)(kt__ * 64) * 512);                      \
    P##v0 = *(const uint4*)(vgp + kt__ * 64);                                      \
    if (MLA && tid < 256) P##p = *(const uint4*)(pgp + (size_t)(kt__ * 64) * 32);  \
  }
#define ATT_SWRITE(P, buf_)                                                        \
  {                                                                                \
    bf16_t* dK = sK + (buf_) * 64 * KSTR;                                          \
    bf16_t* dV = sV + (buf_) * 64 * VSTR;                                          \
    *(uint4*)(dK + prow * KSTR + pch * 8) = P##k0;                                 \
    uint2* dv0 = (uint2*)(dV + prow * VSTR + pch * 8);                             \
    dv0[0] = make_uint2(P##v0.x, P##v0.y); dv0[1] = make_uint2(P##v0.z, P##v0.w);  \
    if (MLA && tid < 256) *(uint4*)(dK + (tid >> 2) * KSTR + 64 + (tid & 3) * 8) = P##p; \
  }
#define ATT_KT(i_) (MLA ? (i_) : (nt - 1 - (i_)))

  ATT_GLOAD(x, ATT_KT(0));
  ATT_GLOAD(y, ATT_KT(1));
  ATT_SWRITE(x, 0);
#pragma unroll
  for (int i = 0; i < 8; ++i) zbuf[i * 512 + tid] = zpre[i];
  __syncthreads();
  bool alive = true;
  for (int it0 = 0; alive; it0 += 2) {
#pragma unroll
   for (int half = 0; half < 2; ++half) {
    const int it = it0 + half;
    const int kt = ATT_KT(it);
    const int cur = half;
    const bool more = (it + 1 < nt);
    if (it + 2 < nt) { if (half == 0) ATT_GLOAD(x, ATT_KT(it + 2)) else ATT_GLOAD(y, ATT_KT(it + 2)) }
    const bf16_t* cK = sK + cur * 64 * KSTR;
    const bf16_t* cV = sV + cur * 64 * VSTR;
    if (MLA) {
      if (kt * 64 <= qw + 31) {
        f32x16 s0, s1;
        {
          const float sinit = -mrun;
#pragma unroll
          for (int i = 0; i < 16; ++i) { s0[i] = sinit; s1[i] = sinit; }
        }
#pragma unroll
        for (int ks = 0; ks < NKS; ++ks) {
          const bf16x8 k0 = *(const bf16x8*)(cK + r * KSTR + ks * 16 + hh * 8);
          const bf16x8 k1 = *(const bf16x8*)(cK + (32 + r) * KSTR + ks * 16 + hh * 8);
          s0 = MFMA(k0, qf[ks], s0);
          s1 = MFMA(k1, qf[ks], s1);
        }

        if (kt * 64 + 63 > qw) {
          const int lim = qw + r - kt * 64;
#pragma unroll
          for (int i = 0; i < 16; ++i) { if (crow(i, hh) > lim) s0[i] = -1e30f; if (32 + crow(i, hh) > lim) s1[i] = -1e30f; }
        }
        float m0 = fmaxf(fmaxf(s0[0], s0[1]), s0[2]), m1 = fmaxf(fmaxf(s1[0], s1[1]), s1[2]);
#pragma unroll
        for (int i = 3; i < 15; i += 2) { m0 = fmaxf(fmaxf(m0, s0[i]), s0[i + 1]); m1 = fmaxf(fmaxf(m1, s1[i]), s1[i + 1]); }
        float mloc = fmaxf(fmaxf(m0, s0[15]), fmaxf(m1, s1[15]));
        mloc = half_max(mloc);
        const bool first = (it == 0);
        const float delta = first ? mloc : fmaxf(mloc, 0.f);
        if (first || __builtin_amdgcn_ballot_w64(delta > 0.f) != 0ull) {
          const float alpha = first ? 0.f : __builtin_amdgcn_exp2f(-delta);
          mrun += delta;
          lrun *= alpha;
#pragma unroll
          for (int i = 0; i < 16; ++i) { oacc[0][i] *= alpha; oacc[1][i] *= alpha; s0[i] -= delta; s1[i] -= delta; }
        }
        float ps0 = 0.f, ps1 = 0.f;
#pragma unroll
        for (int i = 0; i < 16; ++i) { s0[i] = __builtin_amdgcn_exp2f(s0[i]); s1[i] = __builtin_amdgcn_exp2f(s1[i]); ps0 += s0[i]; ps1 += s1[i]; }
        lrun += ps0 + ps1;
        bf16x8 pf4[4];
        pf4[0] = pack8(s0[0], s0[1], s0[2], s0[3], s0[4], s0[5], s0[6], s0[7]);
        pf4[1] = pack8(s0[8], s0[9], s0[10], s0[11], s0[12], s0[13], s0[14], s0[15]);
        pf4[2] = pack8(s1[0], s1[1], s1[2], s1[3], s1[4], s1[5], s1[6], s1[7]);
        pf4[3] = pack8(s1[8], s1[9], s1[10], s1[11], s1[12], s1[13], s1[14], s1[15]);

#pragma unroll
        for (int st = 0; st < 4; ++st)
#pragma unroll
          for (int dt = 0; dt < 2; ++dt) {
            const bf16_t* vp = cV + (dt * 32 + r) * VSTR + st * 16 + 4 * hh;
            const s16x4 lo = *(const s16x4*)vp;
            const s16x4 hi = *(const s16x4*)(vp + 8);
            const bf16x8 vf = __builtin_shufflevector(lo, hi, 0, 1, 2, 3, 4, 5, 6, 7);
            oacc[dt] = MFMA(vf, pf4[st], oacc[dt]);
          }

      }
    } else
#pragma unroll
    for (int si = 0; si < 2; ++si) {
      const int sub = MLA ? si : (1 - si);
      const int kb = kt * 64 + sub * 32;
      if (kb > qw) continue;
      const bool diag = (kb == qw);
      f32x16 s;
      {
        const float sinit = MLA ? -mrun : 0.f;
#pragma unroll
        for (int i = 0; i < 16; ++i) s[i] = sinit;
      }

#pragma unroll
      for (int ks = 0; ks < NKS; ++ks) {
        const bf16x8 kf = *(const bf16x8*)(cK + (sub * 32 + r) * KSTR + ks * 16 + hh * 8);
        s = MFMA(kf, qf[ks], s);
      }

      bf16x8 pf[2];
      if (!MLA) {
        float sp[16];
        float tsum = 0.f;
#pragma unroll
        for (int i = 0; i < 16; ++i) {
          const float z = s[i];
          float v = __builtin_amdgcn_logf(1.f + __builtin_amdgcn_exp2f(fminf(z, 126.f)));
          if (diag && !(crow(i, hh) < r)) v = 0.f;
          sp[i] = v;
          tsum += v;
        }
        f32x16 cacc;
#pragma unroll
        for (int i = 0; i < 16; ++i) cacc[i] = carry;
        cacc = MFMA(tf[0], pack8(sp[0], sp[1], sp[2], sp[3], sp[4], sp[5], sp[6], sp[7]), cacc);
        cacc = MFMA(tf[1], pack8(sp[8], sp[9], sp[10], sp[11], sp[12], sp[13], sp[14], sp[15]), cacc);
        float pr[16];
#pragma unroll
        for (int i = 0; i < 16; ++i) {
          float v = __builtin_amdgcn_exp2f(s[i] - cacc[i]);
          if (diag && !(crow(i, hh) < r)) v = 0.f;
          pr[i] = v;
        }
        carry += half_sum(tsum);
        pf[0] = pack8(pr[0], pr[1], pr[2], pr[3], pr[4], pr[5], pr[6], pr[7]);
        pf[1] = pack8(pr[8], pr[9], pr[10], pr[11], pr[12], pr[13], pr[14], pr[15]);
      } else {
        if (diag) {
#pragma unroll
          for (int i = 0; i < 16; ++i) if (!(crow(i, hh) <= r)) s[i] = -1e30f;
        }
        float mloc = fmaxf(fmaxf(s[0], s[1]), s[2]);
#pragma unroll
        for (int i = 3; i < 15; i += 2) mloc = fmaxf(fmaxf(mloc, s[i]), s[i + 1]);
        mloc = fmaxf(mloc, s[15]);
        mloc = half_max(mloc);
        const bool first = (it == 0) && (si == 0);
        const float delta = first ? mloc : fmaxf(mloc, 0.f);
        if (first || __builtin_amdgcn_ballot_w64(delta > 0.f) != 0ull) {
          const float alpha = first ? 0.f : __builtin_amdgcn_exp2f(-delta);
          mrun += delta;
          lrun *= alpha;
#pragma unroll
          for (int i = 0; i < 16; ++i) { oacc[0][i] *= alpha; oacc[1][i] *= alpha; s[i] -= delta; }
        }
        float pr[16];
        float ps0 = 0.f, ps1 = 0.f;
#pragma unroll
        for (int i = 0; i < 16; i += 2) { pr[i] = __builtin_amdgcn_exp2f(s[i]); pr[i + 1] = __builtin_amdgcn_exp2f(s[i + 1]); ps0 += pr[i]; ps1 += pr[i + 1]; }
        lrun += ps0 + ps1;
        pf[0] = pack8(pr[0], pr[1], pr[2], pr[3], pr[4], pr[5], pr[6], pr[7]);
        pf[1] = pack8(pr[8], pr[9], pr[10], pr[11], pr[12], pr[13], pr[14], pr[15]);
      }

#pragma unroll
      for (int dt = 0; dt < 2; ++dt)
#pragma unroll
        for (int st = 0; st < 2; ++st) {
          const bf16_t* vp = cV + (dt * 32 + r) * VSTR + sub * 32 + st * 16 + 4 * hh;
          const s16x4 lo = *(const s16x4*)vp;
          const s16x4 hi = *(const s16x4*)(vp + 8);
          const bf16x8 vf = __builtin_shufflevector(lo, hi, 0, 1, 2, 3, 4, 5, 6, 7);
          oacc[dt] = MFMA(vf, pf[st], oacc[dt]);
        }

    }
    if (more) { if (half == 0) ATT_SWRITE(y, 1) else ATT_SWRITE(x, 0) }
    if (!MLA) {
      int* flg = (int*)(smem + SMEM_BYTES - 128) + (it & 1) * 8;
      const bool wok = (__builtin_amdgcn_ballot_w64(carry >= 160.f) == ~0ull);
      if (lane == 0) flg[w] = wok ? 1 : 0;
      __syncthreads();
      alive = more && ((flg[0] & flg[1] & flg[2] & flg[3] & flg[4] & flg[5] & flg[6] & flg[7]) == 0);
    } else {
      __syncthreads();
      alive = more;
    }
    if (!alive) break;
   }
  }
#undef ATT_GLOAD
#undef ATT_SWRITE
#undef ATT_KT
  if (threadIdx.x == 0 && pre_ctr) pre_raw = atomicAdd(pre_ctr, 1);
  float inv = 1.f;
  if (MLA) { const float lt = half_sum(lrun); inv = 1.f / lt; }
  const int tok = tok0 + w * 32 + r;
  bf16_t* og = (MLA ? p.OBg() : p.OAg()) + (size_t)tok * 512 + h * 64;
#pragma unroll
  for (int dt = 0; dt < 2; ++dt)
#pragma unroll
    for (int g = 0; g < 4; ++g) {
      const int d = dt * 32 + 8 * g + 4 * hh;
      const u32x2 zz = zbuf[(dt * 4 + g) * 512 + tid];
      const float z0 = __uint_as_float(zz[0] << 16), z1 = __uint_as_float(zz[0] & 0xffff0000u);
      const float z2 = __uint_as_float(zz[1] << 16), z3 = __uint_as_float(zz[1] & 0xffff0000u);
      u32x2 o;
      o[0] = pk2(oacc[dt][4 * g] * inv * z0, oacc[dt][4 * g + 1] * inv * z1);
      o[1] = pk2(oacc[dt][4 * g + 2] * inv * z2, oacc[dt][4 * g + 3] * inv * z3);
      *(u32x2*)(og + d) = o;
    }
}

DI void phase_attn(const Params& p, char* smem, int cbase, int only) {
  int* s_item = (int*)(smem + SMEM_BYTES - 16);
  const int q0 = blockIdx.x & 7;
  int qi = 0;
  int pre_raw = 0;
  bool has_pre = false;
  for (;;) {
    if (threadIdx.x < 64) {
      int item = -1;
      while (qi < 8) {
        const int q = (q0 + qi) & 7;
        int idx = 0;
        if (has_pre) { idx = pre_raw; has_pre = false; }
        else if (threadIdx.x == 0) idx = atomicAdd(p.counter() + cbase + q, 1);
        idx = __builtin_amdgcn_readfirstlane(idx);
        if (idx < 128) { item = q * 256 + idx; break; }
        const int lq = (q0 + (threadIdx.x & 7)) & 7;
        const int head = __hip_atomic_load(p.counter() + cbase + lq, __ATOMIC_RELAXED, __HIP_MEMORY_SCOPE_AGENT);
        const unsigned long long avail = __builtin_amdgcn_ballot_w64((threadIdx.x < 8) && (head < 128) && ((int)(threadIdx.x & 7) > qi));
        if (avail == 0ull) { qi = 8; break; }
        qi = __builtin_ctzll(avail);
      }
      if (threadIdx.x == 0) *s_item = item;
    }
    __syncthreads();
    const int item = *s_item;
    __syncthreads();
    if (item < 0) break;
    const int q = item >> 8, idx = item & 255;
    const int i2 = idx & 63;
    const int bh = q + 8 * (i2 & 3);
    const int qb = 15 - (i2 >> 2);
    int* pre_ctr = p.counter() + cbase + ((q0 + qi) & 7);
    if (idx < 64) { if (only != 2) { attn_item<true>(p, bh >> 3, bh & 7, qb, smem, pre_ctr, pre_raw); has_pre = true; } }
    else { if (only != 1) { attn_item<false>(p, bh >> 3, bh & 7, qb, smem, pre_ctr, pre_raw); has_pre = true; } }
  }
}

DI void g3_pre_a(const Params& p, const int m0, const int n0, u32x4 (&g)[4]) {
  const int txo = opaque_tid();
#pragma unroll
  for (int i = 0; i < 4; ++i) {
    const int c = txo + 512 * i, row = c >> 4, cc = (c & 15) * 8;
    g[i] = *(const u32x4*)(p.GA() + (size_t)(m0 + row) * 1024 + n0 + cc);
  }
}
DI void g3_epi_a(const Params& p, const float* sC, const int m0, const int n0, const u32x4 (&gq)[4]) {
  const int txo = opaque_tid();
#pragma unroll
  for (int i = 0; i < 4; ++i) {
    const int c = txo + 512 * i, row = c >> 4, cc = (c & 15) * 8;
    const u32x4 g = gq[i];
    const float4 a = *(const float4*)(sC + row * CSTR + cc), b = *(const float4*)(sC + row * CSTR + cc + 4);
    u32x4 y;
    y[0] = pk2(a.x * __uint_as_float(g[0] << 16), a.y * __uint_as_float(g[0] & 0xffff0000u));
    y[1] = pk2(a.z * __uint_as_float(g[1] << 16), a.w * __uint_as_float(g[1] & 0xffff0000u));
    y[2] = pk2(b.x * __uint_as_float(g[2] << 16), b.y * __uint_as_float(g[2] & 0xffff0000u));
    y[3] = pk2(b.z * __uint_as_float(g[3] << 16), b.w * __uint_as_float(g[3] & 0xffff0000u));
    *(u32x4*)(p.MERGED() + (size_t)(m0 + row) * 1024 + n0 + cc) = y;
  }
}
DI void g3_pre_b(const Params& p, const int m0, const int n0, u32x4 (&g)[4], u32x4 (&y)[4]) {
  const int txo2 = opaque_tid();
#pragma unroll
  for (int i = 0; i < 4; ++i) {
    const int c = txo2 + 512 * i, row = c >> 4, cc = (c & 15) * 8;
    g[i] = *(const u32x4*)(p.GB() + (size_t)(m0 + row) * 1024 + n0 + cc);
    y[i] = *(const u32x4*)(p.MERGED() + (size_t)(m0 + row) * 1024 + n0 + cc);
  }
}
DI void g3_epi_b(const Params& p, const float* sC, const int m0, const int n0, const u32x4 (&gq)[4], const u32x4 (&yq)[4]) {
  const int txo2 = opaque_tid();
#pragma unroll
  for (int i = 0; i < 4; ++i) {
    const int c = txo2 + 512 * i, row = c >> 4, cc = (c & 15) * 8;
    const u32x4 g = gq[i];
    const u32x4 yv = yq[i];
    const float4 a = *(const float4*)(sC + row * CSTR + cc), b = *(const float4*)(sC + row * CSTR + cc + 4);
    u32x4 o;
    o[0] = pk2(__uint_as_float(yv[0] << 16) + a.x * __uint_as_float(g[0] << 16), __uint_as_float(yv[0] & 0xffff0000u) + a.y * __uint_as_float(g[0] & 0xffff0000u));
    o[1] = pk2(__uint_as_float(yv[1] << 16) + a.z * __uint_as_float(g[1] << 16), __uint_as_float(yv[1] & 0xffff0000u) + a.w * __uint_as_float(g[1] & 0xffff0000u));
    o[2] = pk2(__uint_as_float(yv[2] << 16) + b.x * __uint_as_float(g[2] << 16), __uint_as_float(yv[2] & 0xffff0000u) + b.y * __uint_as_float(g[2] & 0xffff0000u));
    o[3] = pk2(__uint_as_float(yv[3] << 16) + b.z * __uint_as_float(g[3] << 16), __uint_as_float(yv[3] & 0xffff0000u) + b.w * __uint_as_float(g[3] & 0xffff0000u));
    *(u32x4*)(p.MERGED() + (size_t)(m0 + row) * 1024 + n0 + cc) = o;
  }
}
DI void phase_g3(const Params& p, char* smem) {
  bf16_t* shm = (bf16_t*)smem;
  float* sC = (float*)smem;
  const int xq = blockIdx.x & 7, lb = blockIdx.x >> 3, nlb = gridDim.x >> 3;
  const bool xmap = (gridDim.x & 7) == 0;
  for (int t = xmap ? lb : (int)blockIdx.x; t < (xmap ? 32 : 256); t += (xmap ? nlb : (int)gridDim.x)) {
    const int rt = xmap ? (8 * xq + (t & 7)) : (t >> 2), ct = xmap ? (t >> 3) : (t & 3);
    const int m0 = rt * 256, n0 = ct * 256;
    f32x4 acc[2][2][4][2];
    zero_acc8(acc);
    gemm8_tile(p.OAg() + (size_t)m0 * 512, p.WaT() + (size_t)n0 * 512, 512, shm, acc);
#pragma unroll
    for (int ai = 0; ai < 2; ++ai)
#pragma unroll
      for (int bj = 0; bj < 2; ++bj) {
        u32x4 gq[4];
        g3_pre_a(p, m0 + ai * 128, n0 + bj * 128, gq);
        __syncthreads();
        accq_to_lds(acc[ai][bj], sC);
        __syncthreads();
        g3_epi_a(p, sC, m0 + ai * 128, n0 + bj * 128, gq);
      }
    __syncthreads();
    zero_acc8(acc);
    gemm8_tile(p.OBg() + (size_t)m0 * 512, p.WbT() + (size_t)n0 * 512, 512, shm, acc);
#pragma unroll
    for (int ai = 0; ai < 2; ++ai)
#pragma unroll
      for (int bj = 0; bj < 2; ++bj) {
        u32x4 gq[4], yq[4];
        g3_pre_b(p, m0 + ai * 128, n0 + bj * 128, gq, yq);
        __syncthreads();
        accq_to_lds(acc[ai][bj], sC);
        __syncthreads();
        g3_epi_b(p, sC, m0 + ai * 128, n0 + bj * 128, gq, yq);
      }
    __syncthreads();
  }
}

DI void g4_pre(const Params& p, const int m0, const int n0, float4 (&xq)[8]) {
  const int txo = opaque_tid();
#pragma unroll
  for (int i = 0; i < 4; ++i) {
    const int c = txo + 512 * i, row = c >> 4, cc = (c & 15) * 8;
    const size_t go = (size_t)(m0 + row) * 1024 + n0 + cc;
    xq[2 * i] = ldnt4(p.x + go); xq[2 * i + 1] = ldnt4(p.x + go + 4);
  }
}
DI void g4_epi(const Params& p, const float* sC, const float* gt, const int m0, const int n0, const float4 (&xq)[8]) {
  const int txo = opaque_tid();
#pragma unroll
  for (int i = 0; i < 4; ++i) {
    const int c = txo + 512 * i, row = c >> 4, cc = (c & 15) * 8;
    const size_t go = (size_t)(m0 + row) * 1024 + n0 + cc;
    const float4 x0 = xq[2 * i], x1 = xq[2 * i + 1];
    const float4 a = *(const float4*)(sC + row * CSTR + cc), b = *(const float4*)(sC + row * CSTR + cc + 4);
    const float4 g0 = *(const float4*)(gt + cc), g1 = *(const float4*)(gt + cc + 4);
    float4 o0, o1;
    o0.x = x0.x + g0.x * a.x; o0.y = x0.y + g0.y * a.y; o0.z = x0.z + g0.z * a.z; o0.w = x0.w + g0.w * a.w;
    o1.x = x1.x + g1.x * b.x; o1.y = x1.y + g1.y * b.y; o1.z = x1.z + g1.z * b.z; o1.w = x1.w + g1.w * b.w;
    *(float4*)(p.out + go) = o0;
    *(float4*)(p.out + go + 4) = o1;
  }
}
DI void phase_g4(const Params& p, char* smem) {
  bf16_t* shm = (bf16_t*)smem;
  float* sC = (float*)smem;
  float* rs = (float*)(smem + RS_OFF);
  const int xq = blockIdx.x & 7, lb = blockIdx.x >> 3, nlb = gridDim.x >> 3;
  const bool xmap = (gridDim.x & 7) == 0;
  for (int t = xmap ? lb : (int)blockIdx.x; t < (xmap ? 32 : 256); t += (xmap ? nlb : (int)gridDim.x)) {
    const int rt = xmap ? (8 * xq + (t & 7)) : (t >> 2), ct = xmap ? (t >> 3) : (t & 3);
    const int m0 = rt * 256, n0 = ct * 256;
    f32x4 acc[2][2][4][2];
    zero_acc8(acc);
    if (threadIdx.x < 256) rs[threadIdx.x] = mod_get(p.MOD(), m0 >> 12, 2048 + n0 + threadIdx.x);
    gemm8_tile(p.MERGED() + (size_t)m0 * 1024, p.WoT() + (size_t)n0 * 1024, 1024, shm, acc);
#pragma unroll
    for (int ai = 0; ai < 2; ++ai)
#pragma unroll
      for (int bj = 0; bj < 2; ++bj) {
        float4 xq[8];
        g4_pre(p, m0 + ai * 128, n0 + bj * 128, xq);
        __syncthreads();
        accq_to_lds(acc[ai][bj], sC);
        __syncthreads();
        g4_epi(p, sC, rs + bj * 128, m0 + ai * 128, n0 + bj * 128, xq);
      }
    __syncthreads();
  }
}

DI void phase_final(const Params& p) {
  const int lane = threadIdx.x & 63, w = threadIdx.x >> 6;
  const int gw = blockIdx.x * 8 + w, nw = gridDim.x * 8;
  for (int row = gw; row < NTOK; row += nw) {
    float* xr = p.out + (size_t)row * DM;
    float4 v[4];
    float ss = 0.f;
#pragma unroll
    for (int i = 0; i < 4; ++i) {
      v[i] = *(const float4*)(xr + 4 * (lane + 64 * i));
      ss += v[i].x * v[i].x + v[i].y * v[i].y + v[i].z * v[i].z + v[i].w * v[i].w;
    }
#pragma unroll
    for (int o = 32; o >= 1; o >>= 1) ss += __shfl_xor(ss, o);
    const float rn = __builtin_amdgcn_rsqf(ss * (1.f / DM) + EPSN);
#pragma unroll
    for (int i = 0; i < 4; ++i) {
      const int e = 4 * (lane + 64 * i);
      const float4 g = *(const float4*)(p.fgain + e);
      float4 o;
      o.x = v[i].x * rn * g.x; o.y = v[i].y * rn * g.y; o.z = v[i].z * rn * g.z; o.w = v[i].w * rn * g.w;
      __builtin_nontemporal_store(o.x, xr + e); __builtin_nontemporal_store(o.y, xr + e + 1); __builtin_nontemporal_store(o.z, xr + e + 2); __builtin_nontemporal_store(o.w, xr + e + 3);
    }
  }
}

template <int PH>
__global__ void __launch_bounds__(NTHREADS, 2) mega_kernel(Params p) {
  __shared__ __attribute__((aligned(16))) char smem[SMEM_BYTES];
  if (PH < 0) {
    if (p.ws == nullptr) cg::this_grid().sync();
    volatile LAS unsigned* xst = (volatile LAS unsigned*)(smem + SMEM_BYTES - 32);
    if (threadIdx.x == 0) { xst[0] = 0u; xst[1] = 0u; }
    __syncthreads();
    (void)xcd_barrier_post(p.bar(), xst);
    phase_prep(p, smem); xcd_barrier(p.bar(), (volatile LAS unsigned*)(smem + SMEM_BYTES - 32));
#if PROBE_DUP == 4
    phase_prep(p, smem); xcd_barrier(p.bar(), (volatile LAS unsigned*)(smem + SMEM_BYTES - 32));
#endif
    phase_h(p, smem); xcd_barrier(p.bar(), (volatile LAS unsigned*)(smem + SMEM_BYTES - 32));
#if PROBE_DUP == 5
    phase_h(p, smem); xcd_barrier(p.bar(), (volatile LAS unsigned*)(smem + SMEM_BYTES - 32));
#endif
    phase_g1(p, smem); xcd_barrier(p.bar(), (volatile LAS unsigned*)(smem + SMEM_BYTES - 32));
#if PROBE_DUP == 1
    phase_g1(p, smem, false); xcd_barrier(p.bar(), (volatile LAS unsigned*)(smem + SMEM_BYTES - 32));
#endif
    phase_g2(p, smem); xcd_barrier(p.bar(), (volatile LAS unsigned*)(smem + SMEM_BYTES - 32));
#if PROBE_DUP == 8
    phase_g2(p, smem); xcd_barrier(p.bar(), (volatile LAS unsigned*)(smem + SMEM_BYTES - 32));
#endif
    phase_attn(p, smem, 0, 0); xcd_barrier(p.bar(), (volatile LAS unsigned*)(smem + SMEM_BYTES - 32));
#if PROBE_DUP == 2
    phase_attn(p, smem, 8, 1); xcd_barrier(p.bar(), (volatile LAS unsigned*)(smem + SMEM_BYTES - 32));
#endif
#if PROBE_DUP == 3
    phase_attn(p, smem, 8, 2); xcd_barrier(p.bar(), (volatile LAS unsigned*)(smem + SMEM_BYTES - 32));
#endif
    phase_g3(p, smem); xcd_barrier(p.bar(), (volatile LAS unsigned*)(smem + SMEM_BYTES - 32));
#if PROBE_DUP == 6
    phase_g3(p, smem); xcd_barrier(p.bar(), (volatile LAS unsigned*)(smem + SMEM_BYTES - 32));
#endif
    phase_g4(p, smem); xcd_barrier(p.bar(), (volatile LAS unsigned*)(smem + SMEM_BYTES - 32));
#if PROBE_DUP == 7
    phase_g4(p, smem); xcd_barrier(p.bar(), (volatile LAS unsigned*)(smem + SMEM_BYTES - 32));
#endif
    phase_final(p);
  } else {
    if (PH == 0) phase_prep(p, smem);
    if (PH == 1) phase_h(p, smem);
    if (PH == 2) phase_g1(p, smem);
    if (PH == 3) phase_g2(p, smem);
    if (PH == 4) phase_attn(p, smem, 0, 0);
    if (PH == 5) phase_g3(p, smem);
    if (PH == 6) phase_g4(p, smem);
    if (PH == 7) phase_final(p);
  }
}

#ifndef PROBE_DUP
#define PROBE_DUP 0
#endif
#ifndef MK_SPLIT
#define MK_SPLIT 0
#endif

extern "C" void kernel_launch(void* const* d_in, const int* in_sizes, int n_in, void* d_out, int out_size, void* d_ws, size_t ws_size, hipStream_t stream) {
  Params p{};
  p.x = (const float*)d_in[0]; p.c = (const float*)d_in[1]; p.pos = (const int*)d_in[2];
  p.w_ada = (const float*)d_in[3]; p.b_ada = (const float*)d_in[4]; p.norm_gain = (const float*)d_in[5];
  p.w_in = (const float*)d_in[6]; p.q_gain = (const float*)d_in[7]; p.w_uq = (const float*)d_in[8];
  p.kv_gain = (const float*)d_in[9]; p.w_ukv = (const float*)d_in[10]; p.w_a = (const float*)d_in[11];
  p.w_b = (const float*)d_in[12]; p.w_out = (const float*)d_in[13]; p.fgain = (const float*)d_in[14];
  p.out = (float*)d_out;
  p.ws = (char*)d_ws;
  if (WS_NEED > ws_size) { fprintf(stderr, "workspace too small: need %zu have %zu\n", (size_t)WS_NEED, ws_size); return; }

  static int grid_blocks = 0;
  if (!grid_blocks) {
    int dev = 0, cus = 0, per_cu = 0;
    hipGetDevice(&dev);
    hipDeviceGetAttribute(&cus, hipDeviceAttributeMultiprocessorCount, dev);
    hipOccupancyMaxActiveBlocksPerMultiprocessor(&per_cu, mega_kernel<-1>, NTHREADS, 0);
    per_cu = 1;
    grid_blocks = cus * per_cu;
  }
#if MK_SPLIT
  mega_kernel<0><<<grid_blocks, NTHREADS, 0, stream>>>(p);
  mega_kernel<1><<<grid_blocks, NTHREADS, 0, stream>>>(p);
  mega_kernel<2><<<grid_blocks, NTHREADS, 0, stream>>>(p);
  mega_kernel<3><<<grid_blocks, NTHREADS, 0, stream>>>(p);
  mega_kernel<4><<<grid_blocks, NTHREADS, 0, stream>>>(p);
  mega_kernel<5><<<grid_blocks, NTHREADS, 0, stream>>>(p);
  mega_kernel<6><<<grid_blocks, NTHREADS, 0, stream>>>(p);
  mega_kernel<7><<<grid_blocks, NTHREADS, 0, stream>>>(p);
#else
  hipMemsetAsync((char*)d_ws + OFF_bar, 0, XCD_BAR_WORDS * 4, stream);
  void* args[] = {&p};
  hipError_t e = hipLaunchCooperativeKernel((void*)mega_kernel<-1>, dim3(grid_blocks), dim3(NTHREADS), args, 0, stream);
  if (e != hipSuccess) fprintf(stderr, "cooperative launch failed: %s (grid %d)\n", hipGetErrorString(e), grid_blocks);
#endif
}
```
